# Optimizing an MI355X kernel written in HIP

```python
import jax
import jax.numpy as jnp
from jax import lax
import numpy as np

D_MODEL = 1024
BATCH = 16
SEQ = 2048
DEPTH = 2

GRID_W = 64
CTX_LEN = 256
N_MOD = 6

NA_HEADS = 8
NA_HEAD_DIM = 64
NA_WIN_ROWS = 8
NA_WIN_COLS = 16
NA_QCOLS = 16
NA_KCOLS = NA_QCOLS + NA_WIN_COLS

MLA_HEADS = 8
MLA_NOPE = 64
MLA_ROPE = 32
MLA_QK_DIM = MLA_NOPE + MLA_ROPE
MLA_V_DIM = 64
MLA_Q_LORA = 384
MLA_KV_LORA = 256
MLA_QBLOCK = 128
ROPE_BASE = 10000.0

NA_WIDTH = NA_HEADS * NA_HEAD_DIM
MLA_WIDTH = MLA_HEADS * MLA_V_DIM
IN_COLS = 3 * NA_WIDTH + MLA_Q_LORA + MLA_KV_LORA + MLA_ROPE + 2 * D_MODEL
IN_SPLITS = (3 * NA_WIDTH, 3 * NA_WIDTH + MLA_Q_LORA, 3 * NA_WIDTH + MLA_Q_LORA + MLA_KV_LORA, 3 * NA_WIDTH + MLA_Q_LORA + MLA_KV_LORA + MLA_ROPE)

N_EXPERTS = 64
N_GROUPS = 8
EXPERTS_PER_GROUP = N_EXPERTS // N_GROUPS
TOP_K = 2
D_EXPERT = 1024
MOE_BLOCK = 128

RMS_EPS = 1e-6
NEG_INF = -1e30

kernel_name = 'hybrid_dit_natten_mla_grouped_moe'


def rmsnorm(x, g):
    x32 = x.astype(jnp.float32)
    y = x32 * lax.rsqrt(jnp.mean(x32 * x32, axis=-1, keepdims=True) + RMS_EPS)
    return (y * g.astype(jnp.float32)).astype(x.dtype)


def modulate(h, shift, scale):
    return h * (1 + scale) + shift


def rotate(x, pos):
    m = x.shape[-1] // 2
    inv = ROPE_BASE ** (-jnp.arange(m, dtype=jnp.float32) / m)
    ang = pos.astype(jnp.float32)[:, None] * inv[None, :]
    cos = jnp.cos(ang)[None, :, None, :]
    sin = jnp.sin(ang)[None, :, None, :]
    x32 = x.astype(jnp.float32)
    x1, x2 = x32[..., :m], x32[..., m:]
    return jnp.concatenate([x1 * cos - x2 * sin, x1 * sin + x2 * cos], axis=-1).astype(x.dtype)


def axial_rope_tail(x, prow, pcol):
    half = MLA_ROPE // 2
    xn, xr = x[..., :MLA_NOPE], x[..., MLA_NOPE:]
    xr = jnp.concatenate([rotate(xr[..., :half], prow), rotate(xr[..., half:], pcol)], axis=-1)
    return jnp.concatenate([xn, xr], axis=-1)


def mixer_inputs(h, w_in_l, na_q_g_l, na_k_g_l, cq_g, w_uq_l, ckv_g, w_ukv_l, q_g, k_g):
    B, N, _ = h.shape
    z = jnp.einsum('bnd,dc->bnc', h, w_in_l)
    za, zcq, zckv, zkr, zg = jnp.split(z, IN_SPLITS, axis=-1)
    za = za.reshape(B, N, 3, NA_HEADS, NA_HEAD_DIM)
    qa = rmsnorm(za[:, :, 0], na_q_g_l)
    ka = rmsnorm(za[:, :, 1], na_k_g_l)
    va = za[:, :, 2]
    q = jnp.einsum('bnr,rc->bnc', rmsnorm(zcq, cq_g), w_uq_l).reshape(B, N, MLA_HEADS, MLA_QK_DIM)
    kv = jnp.einsum('bnr,rc->bnc', rmsnorm(zckv, ckv_g), w_ukv_l).reshape(B, N, MLA_HEADS, MLA_NOPE + MLA_V_DIM)
    k_rope = jnp.broadcast_to(zkr[:, :, None, :], (B, N, MLA_HEADS, MLA_ROPE))
    qb = rmsnorm(q, q_g)
    kb = rmsnorm(jnp.concatenate([kv[..., :MLA_NOPE], k_rope], axis=-1), k_g)
    vb = kv[..., MLA_NOPE:]
    ga, gb = jnp.split(zg, 2, axis=-1)
    return qa, ka, va, qb, kb, vb, ga, gb


def neighbourhood_attention(q, k, v, k_ctx, v_ctx, rpb, n_rows):
    B, S, H, dh = q.shape
    kr = min(NA_WIN_ROWS, n_rows)
    ncb = GRID_W // NA_QCOLS
    scale = dh ** -0.5
    j = jnp.arange(ncb)
    kcs = jnp.clip(j * NA_QCOLS - NA_WIN_COLS // 2, 0, GRID_W - NA_KCOLS)
    col_idx = kcs[:, None] + jnp.arange(NA_KCOLS)[None, :]
    qcol = j[:, None] * NA_QCOLS + jnp.arange(NA_QCOLS)[None, :]
    cs = jnp.clip(qcol - NA_WIN_COLS // 2, 0, GRID_W - NA_WIN_COLS)
    kcol = col_idx[:, None, :]
    valid = (kcol >= cs[..., None]) & (kcol < cs[..., None] + NA_WIN_COLS)
    dc_idx = jnp.clip(kcol - qcol[..., None] + NA_WIN_COLS - 1, 0, 2 * NA_WIN_COLS - 2)
    rpb_cols = rpb[:, :, dc_idx].astype(jnp.float32)
    k_g = k.reshape(B, n_rows, GRID_W, H, dh)
    v_g = v.reshape(B, n_rows, GRID_W, H, dh)
    q_rows = q.reshape(B, n_rows, ncb, NA_QCOLS, H, dh).transpose(1, 0, 2, 3, 4, 5)
    n_loc = kr * NA_KCOLS

    def row_step(args):
        r, qr = args
        rs = jnp.clip(r - kr // 2, 0, n_rows - kr)
        k_blk = jnp.take(lax.dynamic_slice_in_dim(k_g, rs, kr, axis=1), col_idx, axis=2)
        v_blk = jnp.take(lax.dynamic_slice_in_dim(v_g, rs, kr, axis=1), col_idx, axis=2)
        dr_idx = rs + jnp.arange(kr) - r + NA_WIN_ROWS - 1
        bias = jnp.take(rpb_cols, dr_idx, axis=1).transpose(0, 2, 3, 1, 4)
        s_loc = jnp.einsum('bnqhd,brnkhd->bhnqrk', qr, k_blk).astype(jnp.float32) * scale + bias
        s_loc = jnp.where(valid[:, :, None, :], s_loc, NEG_INF)
        s_ctx = jnp.einsum('bnqhd,bchd->bhnqc', qr, k_ctx).astype(jnp.float32) * scale
        s = jnp.concatenate([s_loc.reshape(B, H, ncb, NA_QCOLS, n_loc), s_ctx], axis=-1)
        p = jax.nn.softmax(s, axis=-1).astype(v.dtype)
        p_loc = p[..., :n_loc].reshape(B, H, ncb, NA_QCOLS, kr, NA_KCOLS)
        o = jnp.einsum('bhnqrk,brnkhd->bnqhd', p_loc, v_blk)
        return o + jnp.einsum('bhnqc,bchd->bnqhd', p[..., n_loc:], v_ctx)

    o = lax.map(row_step, (jnp.arange(n_rows), q_rows))
    return o.transpose(1, 0, 2, 3, 4, 5).reshape(B, S, H * dh)


def mla_attention(q, k, v, k_ctx, v_ctx):
    B, S, H, dq = q.shape
    scale = dq ** -0.5
    nb = S // MLA_QBLOCK
    q_blocks = q.reshape(B, nb, MLA_QBLOCK, H, dq).transpose(1, 0, 2, 3, 4)

    def block_step(qi):
        s = jnp.concatenate([jnp.einsum('bqhd,bkhd->bhqk', qi, k), jnp.einsum('bqhd,bchd->bhqc', qi, k_ctx)], axis=-1)
        p = jax.nn.softmax(s.astype(jnp.float32) * scale, axis=-1).astype(v.dtype)
        return jnp.einsum('bhqk,bkhd->bqhd', p[..., :S], v) + jnp.einsum('bhqc,bchd->bqhd', p[..., S:], v_ctx)

    o = lax.map(block_step, q_blocks)
    return o.transpose(1, 0, 2, 3, 4).reshape(B, S, H * v.shape[-1])


def dense_attention(q, k, v):
    B, N, H, dq = q.shape
    s = jnp.einsum('bqhd,bkhd->bhqk', q, k).astype(jnp.float32) * dq ** -0.5
    p = jax.nn.softmax(s, axis=-1).astype(v.dtype)
    return jnp.einsum('bhqk,bkhd->bqhd', p, v).reshape(B, N, H * v.shape[-1])


def merge_branches(oa, ob, ga, gb, w_oa_l, w_ob_l, w_out_l):
    y = jax.nn.sigmoid(ga) * jnp.einsum('bnc,cd->bnd', oa, w_oa_l) + jax.nn.sigmoid(gb) * jnp.einsum('bnc,cd->bnd', ob, w_ob_l)
    return jnp.einsum('bnd,de->bne', y, w_out_l)


def moe_ffn(h, w_router, router_bias, w1_l, w3_l, w2_l):
    T, D = h.shape
    M = T * TOP_K
    s = jax.nn.sigmoid(jnp.einsum('td,de->te', h, w_router).astype(jnp.float32))
    biased = (s + router_bias.astype(jnp.float32)).reshape(T, N_GROUPS, EXPERTS_PER_GROUP)
    group_score = lax.top_k(biased, TOP_K)[0].sum(axis=-1)
    g_sel = jnp.argmax(group_score, axis=-1)
    in_group = jnp.take_along_axis(biased, g_sel[:, None, None], axis=1)[:, 0]
    _, local = lax.top_k(in_group, TOP_K)
    expert = (g_sel[:, None] * EXPERTS_PER_GROUP + local).astype(jnp.int32)
    gw = jnp.take_along_axis(s, expert, axis=1)
    gw = gw / jnp.sum(gw, axis=-1, keepdims=True)
    e_flat = expert.reshape(-1)
    tok = jnp.repeat(jnp.arange(T, dtype=jnp.int32), TOP_K)
    order = jnp.argsort(e_flat)
    e_sorted = e_flat[order]
    tok_sorted = tok[order]
    w_sorted = gw.reshape(-1)[order]
    counts = jnp.bincount(e_flat, length=N_EXPERTS).astype(jnp.int32)
    padded = ((counts + MOE_BLOCK - 1) // MOE_BLOCK) * MOE_BLOCK
    start = jnp.cumsum(counts) - counts
    pad_end = jnp.cumsum(padded)
    pad_start = pad_end - padded
    dest = pad_start[e_sorted] + (jnp.arange(M, dtype=jnp.int32) - start[e_sorted])
    n_blocks = -(-M // MOE_BLOCK) + N_EXPERTS
    slot_tok = jnp.full((n_blocks * MOE_BLOCK,), T, jnp.int32).at[dest].set(tok_sorted)
    h_pad = jnp.concatenate([h, jnp.zeros((1, D), h.dtype)], axis=0)
    xin = h_pad[slot_tok].reshape(n_blocks, MOE_BLOCK, D)
    block_expert = jnp.minimum(jnp.searchsorted(pad_end, jnp.arange(n_blocks, dtype=jnp.int32) * MOE_BLOCK, side='right'), N_EXPERTS - 1)

    def expert_block(args):
        xb, e = args
        return (jax.nn.silu(xb @ w1_l[e]) * (xb @ w3_l[e])) @ w2_l[e]

    y = lax.map(expert_block, (xin, block_expert)).reshape(-1, D)
    y_sorted = y[dest] * w_sorted[:, None].astype(h.dtype)
    return jax.ops.segment_sum(y_sorted, tok_sorted, num_segments=T)


def setup_inputs(seed: int = 0) -> dict:
    key = jax.random.key(seed)
    ks = jax.random.split(key, 32)
    f32 = jnp.float32
    L, D = DEPTH, D_MODEL

    def nrm(k, shape, scale):
        return jax.random.normal(k, shape, f32) * scale

    return {
        'x': nrm(ks[0], (BATCH, SEQ, D), 1.0),
        'c': nrm(ks[1], (BATCH, D), 1.0),
        'ctx': nrm(ks[2], (BATCH, CTX_LEN, D), 1.0),
        'c_ctx': nrm(ks[3], (D,), 1.0),
        'w_ada': nrm(ks[4], (L, D, N_MOD * D), 0.5 * D ** -0.5),
        'b_ada': nrm(ks[5], (L, N_MOD * D), 0.02),
        'norm_mix_g': 1.0 + nrm(ks[6], (L, D), 0.1),
        'norm_ffn_g': 1.0 + nrm(ks[7], (L, D), 0.1),
        'w_in': nrm(ks[8], (L, D, IN_COLS), D ** -0.5),
        'na_q_g': 1.0 + nrm(ks[9], (L, NA_HEAD_DIM), 0.1),
        'na_k_g': 1.0 + nrm(ks[10], (L, NA_HEAD_DIM), 0.1),
        'na_rpb': nrm(ks[11], (L, NA_HEADS, 2 * NA_WIN_ROWS - 1, 2 * NA_WIN_COLS - 1), 0.5),
        'mla_cq_g': 1.0 + nrm(ks[12], (L, MLA_Q_LORA), 0.1),
        'w_uq': nrm(ks[13], (L, MLA_Q_LORA, MLA_HEADS * MLA_QK_DIM), MLA_Q_LORA ** -0.5),
        'mla_ckv_g': 1.0 + nrm(ks[14], (L, MLA_KV_LORA), 0.1),
        'w_ukv': nrm(ks[15], (L, MLA_KV_LORA, MLA_HEADS * (MLA_NOPE + MLA_V_DIM)), MLA_KV_LORA ** -0.5),
        'mla_q_g': 1.0 + nrm(ks[16], (L, MLA_QK_DIM), 0.1),
        'mla_k_g': 1.0 + nrm(ks[17], (L, MLA_QK_DIM), 0.1),
        'w_oa': nrm(ks[18], (L, NA_WIDTH, D), NA_WIDTH ** -0.5),
        'w_ob': nrm(ks[19], (L, MLA_WIDTH, D), MLA_WIDTH ** -0.5),
        'w_out': nrm(ks[20], (L, D, D), D ** -0.5),
        'w_router': nrm(ks[21], (D, N_EXPERTS), D ** -0.5),
        'router_bias': nrm(ks[22], (N_EXPERTS,), 0.01),
        'w1': nrm(ks[23], (L, N_EXPERTS, D, D_EXPERT), D ** -0.5),
        'w3': nrm(ks[24], (L, N_EXPERTS, D, D_EXPERT), D ** -0.5),
        'w2': nrm(ks[25], (L, N_EXPERTS, D_EXPERT, D), D_EXPERT ** -0.5),
    }


def reference(x, c, ctx, c_ctx, w_ada, b_ada, norm_mix_g, norm_ffn_g, w_in, na_q_g, na_k_g, na_rpb,
              mla_cq_g, w_uq, mla_ckv_g, w_ukv, mla_q_g, mla_k_g, w_oa, w_ob, w_out,
              w_router, router_bias, w1, w3, w2):
    B, S, D = x.shape
    n_rows = S // GRID_W
    pos = jnp.arange(S, dtype=jnp.int32)
    prow = pos // GRID_W
    pcol = pos % GRID_W
    xc = ctx
    sc = jax.nn.silu(c)
    scc = jax.nn.silu(c_ctx)[None, :]
    for l in range(DEPTH):
        last = l == DEPTH - 1
        mod_x = (sc @ w_ada[l] + b_ada[l])[:, None, :]
        mod_c = (scc @ w_ada[l] + b_ada[l])[:, None, :]
        sh_m, sc_m, g_m, sh_f, sc_f, g_f = jnp.split(mod_x, N_MOD, axis=-1)
        shc_m, scc_m, gc_m, shc_f, scc_f, gc_f = jnp.split(mod_c, N_MOD, axis=-1)

        hx = modulate(rmsnorm(x, norm_mix_g[l]), sh_m, sc_m)
        hc = modulate(rmsnorm(xc, norm_mix_g[l]), shc_m, scc_m)
        lw = (w_in[l], na_q_g[l], na_k_g[l], mla_cq_g[l], w_uq[l], mla_ckv_g[l], w_ukv[l], mla_q_g[l], mla_k_g[l])
        qa_x, ka_x, va_x, qb_x, kb_x, vb_x, ga_x, gb_x = mixer_inputs(hx, *lw)
        qa_c, ka_c, va_c, qb_c, kb_c, vb_c, ga_c, gb_c = mixer_inputs(hc, *lw)
        qb_x = axial_rope_tail(qb_x, prow, pcol)
        kb_x = axial_rope_tail(kb_x, prow, pcol)
        oa_x = neighbourhood_attention(qa_x, ka_x, va_x, ka_c, va_c, na_rpb[l], n_rows)
        ob_x = mla_attention(qb_x, kb_x, vb_x, kb_c, vb_c)
        x = x + g_m * merge_branches(oa_x, ob_x, ga_x, gb_x, w_oa[l], w_ob[l], w_out[l])
        if not last:
            oa_c = dense_attention(qa_c, ka_c, va_c)
            ob_c = dense_attention(qb_c, kb_c, vb_c)
            xc = xc + gc_m * merge_branches(oa_c, ob_c, ga_c, gb_c, w_oa[l], w_ob[l], w_out[l])

        hx2 = modulate(rmsnorm(x, norm_ffn_g[l]), sh_f, sc_f).reshape(-1, D)
        if last:
            y = moe_ffn(hx2, w_router, router_bias, w1[l], w3[l], w2[l])
            x = x + g_f * y.reshape(B, S, D)
        else:
            hc2 = modulate(rmsnorm(xc, norm_ffn_g[l]), shc_f, scc_f).reshape(-1, D)
            y = moe_ffn(jnp.concatenate([hx2, hc2], axis=0), w_router, router_bias, w1[l], w3[l], w2[l])
            x = x + g_f * y[:B * S].reshape(B, S, D)
            xc = xc + gc_f * y[B * S:].reshape(B, xc.shape[1], D)
    return x
```

```cpp
#include <hip/hip_runtime.h>
#include <hip/hip_bf16.h>
#include <cstdio>
#include <cstdint>

#ifndef MK_SPLIT
#define MK_SPLIT 0
#endif

#define LAS __attribute__((address_space(3)))
#define GAS __attribute__((address_space(1)))
typedef unsigned short bf16_t;
typedef short bf16x8 __attribute__((ext_vector_type(8)));
typedef short s16x4 __attribute__((ext_vector_type(4)));
typedef float f32x4 __attribute__((ext_vector_type(4)));
typedef float f32x2 __attribute__((ext_vector_type(2)));
typedef float f32x16 __attribute__((ext_vector_type(16)));
typedef unsigned u32x4 __attribute__((ext_vector_type(4)));
typedef unsigned u32x2 __attribute__((ext_vector_type(2)));
#define RLX_AGENT __ATOMIC_RELAXED, __HIP_MEMORY_SCOPE_AGENT

constexpr int DM = 1024, NB = 16, SEQ = 2048, TX = NB * SEQ, CTXL = 256, TC = NB * CTXL, TALL = TX + TC;
constexpr int NHEAD = 8, GRIDW = 64;
constexpr int INC = 4256, INP = 4352;
constexpr int NEXP = 64, NMODC = 6 * DM;
constexpr int QLORA = 384, KVLORA = 256, QKD = 96, ROPED = 32;
constexpr int MT_X = TX / 256, MT_ALL = TALL / 256;
constexpr int NSLOT_MAX = 2 * TALL + NEXP * 256;
constexpr float RMS_EPS = 1e-6f;
constexpr int NLAYER = 2;

constexpr size_t al256(size_t x) { return (x + 255) & ~(size_t)255; }
constexpr size_t WS_CTL = 0, CTL_BYTES = 1u << 20;
constexpr size_t WS_MOD   = WS_CTL + CTL_BYTES;
constexpr size_t WS_ROPE  = WS_MOD + al256((size_t)NLAYER * 17 * NMODC * 4);
constexpr size_t WS_RSCQ  = WS_ROPE + al256(64 * 8 * 2 * 4);
constexpr size_t WS_RSCKV = WS_RSCQ + al256((size_t)TALL * 4);
constexpr size_t WS_SSKR  = WS_RSCKV + al256((size_t)TALL * 4);
constexpr size_t WS_TOKE  = WS_SSKR + al256((size_t)TALL * 4);
constexpr size_t WS_TOKW  = WS_TOKE + al256((size_t)TALL * 8);
constexpr size_t WS_TOKP  = WS_TOKW + al256((size_t)TALL * 8);
constexpr size_t WS_RSTD2 = WS_TOKP + al256((size_t)TALL * 8);
constexpr size_t WS_TILEE = WS_RSTD2 + al256((size_t)TALL * 4);
constexpr size_t WS_OFFS  = WS_TILEE + al256(512 * 4);
constexpr size_t WS_WIN   = WS_OFFS + al256(128 * 4);
constexpr size_t WS_WUQ   = WS_WIN + al256((size_t)NLAYER * INP * DM * 2);
constexpr size_t WS_WUKV  = WS_WUQ + al256((size_t)NLAYER * 1024 * QLORA * 2);
constexpr size_t WS_WOA   = WS_WUKV + al256((size_t)NLAYER * 1024 * KVLORA * 2);
constexpr size_t WS_WOB   = WS_WOA + al256((size_t)NLAYER * 1024 * 512 * 2);
constexpr size_t WS_WOUT  = WS_WOB + al256((size_t)NLAYER * 1024 * 512 * 2);
constexpr size_t WS_W13   = WS_WOUT + al256((size_t)NLAYER * 1024 * 1024 * 2);
constexpr size_t WS_W2    = WS_W13 + al256((size_t)NLAYER * NEXP * 2048 * 1024 * 2);
constexpr size_t WS_H     = WS_W2 + al256((size_t)NLAYER * NEXP * 1024 * 1024 * 2);
constexpr size_t WS_XC    = WS_H + al256((size_t)TALL * DM * 2);
constexpr size_t WS_ACT   = WS_XC + al256((size_t)TC * DM * 4);
constexpr size_t WS_QA    = WS_ACT;
constexpr size_t WS_KA    = WS_QA + al256((size_t)TALL * 512 * 2);
constexpr size_t WS_VA    = WS_KA + al256((size_t)TALL * 512 * 2);
constexpr size_t WS_ZCQ   = WS_VA + al256((size_t)TALL * 512 * 2);
constexpr size_t WS_ZCKV  = WS_ZCQ + al256((size_t)TALL * QLORA * 2);
constexpr size_t WS_ZKR   = WS_ZCKV + al256((size_t)TALL * KVLORA * 2);
constexpr size_t WS_GATES = WS_ZKR + al256((size_t)TALL * ROPED * 2);
constexpr size_t WS_QB    = WS_GATES + al256((size_t)TALL * 2048 * 2);
constexpr size_t WS_KB    = WS_QB + al256((size_t)TALL * 768 * 2);
constexpr size_t WS_VB    = WS_KB + al256((size_t)TALL * 768 * 2);
constexpr size_t WS_OA    = WS_VB + al256((size_t)TALL * 512 * 2);
constexpr size_t WS_OB    = WS_OA + al256((size_t)TALL * 512 * 2);
constexpr size_t WS_Y     = WS_OB + al256((size_t)TALL * 512 * 2);
constexpr size_t WS_MIX_END = WS_Y + al256((size_t)TALL * DM * 2);
constexpr size_t WS_HS    = WS_ACT;
constexpr size_t WS_HMID  = WS_HS + al256((size_t)NSLOT_MAX * DM * 2);
constexpr size_t WS_YS    = WS_HMID + al256((size_t)NSLOT_MAX * DM * 2);
constexpr size_t WS_MOE_END = WS_YS + al256((size_t)NSLOT_MAX * DM * 2);
constexpr size_t WS_END   = (WS_MIX_END > WS_MOE_END) ? WS_MIX_END : WS_MOE_END;

constexpr int CW_BAR = 4096;
constexpr int CW_CNT = 16384;

constexpr int RING_BYTES = 131072;
constexpr int EPI_OFF = RING_BYTES;
constexpr int MISC_OFF = RING_BYTES + 24576;
constexpr int LDS_BYTES = 160 * 1024;

__device__ __forceinline__ unsigned cvt_pk_bf16(float lo, float hi) { unsigned r; asm volatile("v_cvt_pk_bf16_f32 %0, %1, %2" : "=v"(r) : "v"(lo), "v"(hi)); return r; }
__device__ __forceinline__ float bf_lo(unsigned w) { return __uint_as_float(w << 16); }
__device__ __forceinline__ float bf_hi(unsigned w) { return __uint_as_float(w & 0xffff0000u); }
__device__ __forceinline__ float wave_sum(float v) {
#pragma unroll
    for (int o = 1; o < 64; o <<= 1) v += __shfl_xor(v, o);
    return v;
}
__device__ __forceinline__ float sigmoidf_(float x) { return __builtin_amdgcn_rcpf(1.0f + __expf(-x)); }
__device__ __forceinline__ int ld_i32_agent(const int* p) { return (int)__hip_atomic_load((const unsigned*)p, RLX_AGENT); }
#define XB_TMO      128
#define XB_XCNT(j)  (256  + 64 * (j))
#define XB_XSUB(j)  (1280 + 64 * (j))
#define XB_XGEN(j)  (2304 + 64 * (j))
#define XB_TOP      3328
#define XB_TOPGEN   3392
#define XCD_BAR_WORDS 3456
#define XB_SPIN_CAP (1u << 18)

__device__ __forceinline__ unsigned xb_ld(unsigned* p)              { return __hip_atomic_load(p, __ATOMIC_RELAXED, __HIP_MEMORY_SCOPE_AGENT); }
__device__ __forceinline__ unsigned xb_add(unsigned* p, unsigned v) { return __hip_atomic_fetch_add(p, v, __ATOMIC_RELAXED, __HIP_MEMORY_SCOPE_AGENT); }
__device__ __forceinline__ unsigned xb_xcc_id() { return (unsigned)__builtin_amdgcn_s_getreg((3 << 11) | 20) & 0xFu; }
#define XB_SPIN(cond, bar) do { unsigned _sp = 0; while (cond) { __builtin_amdgcn_s_sleep(1); \
    if ((++_sp & 255u) == 0u) { if (xb_ld(&(bar)[XB_TMO])) break; if (_sp > XB_SPIN_CAP) { atomicAdd(&(bar)[XB_TMO], 1u); break; } } } } while (0)

struct XcdBarrier {
    unsigned* bar; unsigned x;
    volatile LAS unsigned* st;
};

__device__ __forceinline__ XcdBarrier xcd_barrier_post(unsigned* bar, volatile LAS unsigned* st) {
    XcdBarrier b; b.bar = bar; b.x = xb_xcc_id(); b.st = st;
    if (threadIdx.x == 0) (void)xb_add(&bar[XB_XCNT(b.x)], 1u);
    return b;
}
__device__ __forceinline__ void xcd_barrier_complete(unsigned* bar, unsigned x, unsigned& nloc, unsigned& nx) {
    const unsigned G = gridDim.x * gridDim.y * gridDim.z;
    unsigned sum, cnt, mine, sp = 0u;
    for (;;) {
        sum = 0u; cnt = 0u; mine = 0u;
#pragma unroll
        for (unsigned j = 0; j < 16; ++j) { const unsigned c = xb_ld(&bar[XB_XCNT(j)]); sum += c; cnt += (c > 0u) ? 1u : 0u; mine = (j == x) ? c : mine; }
        if (sum == G) break;
        __builtin_amdgcn_s_sleep(1);
        if ((++sp & 255u) == 0u) { if (xb_ld(&bar[XB_TMO])) break; if (sp > XB_SPIN_CAP) { atomicAdd(&bar[XB_TMO], 1u); break; } }
    }
    nloc = mine > 0u ? mine : 1u; nx = cnt > 0u ? cnt : 1u;
}

__device__ __forceinline__ void xcd_barrier(const XcdBarrier& b) {
    asm volatile("s_waitcnt vmcnt(0)" ::: "memory");
    __syncthreads();
    if (threadIdx.x == 0) {
        unsigned* bar = b.bar;
        __builtin_amdgcn_s_waitcnt(0);
        unsigned nloc = b.st[0], nx = b.st[1];
        if (nloc == 0u) { xcd_barrier_complete(bar, b.x, nloc, nx); b.st[0] = nloc; b.st[1] = nx; }
        const unsigned old = xb_add(&bar[XB_XSUB(b.x)], 1u);
        const unsigned gen = old / nloc;
        if (old + 1u == (gen + 1u) * nloc) {
            __builtin_amdgcn_fence(__ATOMIC_RELEASE, "agent");
            asm volatile("s_waitcnt vmcnt(0)" ::: "memory");
            const unsigned og = xb_add(&bar[XB_TOP], 1u);
            const unsigned tg = og / nx;
            if (og + 1u == (tg + 1u) * nx) xb_add(&bar[XB_TOPGEN], 1u);
            else XB_SPIN(xb_ld(&bar[XB_TOPGEN]) == tg, bar);
            __builtin_amdgcn_fence(__ATOMIC_ACQUIRE, "agent");
            xb_add(&bar[XB_XGEN(b.x)], 1u);
            asm volatile("s_waitcnt vmcnt(0)" ::: "memory");
        } else {
            XB_SPIN(xb_ld(&bar[XB_XGEN(b.x)]) == gen, bar);
            __builtin_amdgcn_fence(__ATOMIC_ACQUIRE, "agent");
            asm volatile("s_waitcnt vmcnt(0)" ::: "memory");
        }
    }
    __syncthreads();
}

namespace pg8 {
constexpr int BM = 256, BK = 64, HALF = 128, HTB = HALF * BK * 2  , STAGE_BYTES = 8 * HTB, NXCD = 8, WGM = 8;
__host__ __device__ __forceinline__ int lds_byte(int r, int c) { const int st = (r >> 4) * 2 + (c >> 5), rr = r & 15, cc = c & 31, ob = rr * 64 + cc * 2; return st * 1024 + (ob ^ (((ob >> 9) & 1) << 5)); }
__host__ __device__ __forceinline__ void stage_rc(int b, int& R, int& C) { const int st = b / 1024, sb = b % 1024, swz = sb ^ (((sb >> 9) & 1) << 5); R = (st >> 1) * 16 + swz / 64; C = (st & 1) * 32 + (swz % 64) / 2; }
__host__ __device__ __forceinline__ int perm32(int rho) { const int n = rho >> 4, i = rho & 15; return 8 * (i >> 2) + 4 * n + (i & 3); }

struct Unit { int pm, pn, kind, e; };

__device__ __forceinline__ void rect_tile(int wgid_in, int nM, int nN, int& pm, int& pn) {
    const int nwg = nM * nN; int wgid = wgid_in;
    { const int q = nwg / NXCD, r = nwg % NXCD, xcd = wgid % NXCD, off = wgid / NXCD; wgid = (xcd < r ? xcd * (q + 1) : r * (q + 1) + (xcd - r) * q) + off; }
    const int nig = WGM * nN, gid = wgid / nig, fm = gid * WGM, gsz = (nM - fm) < WGM ? (nM - fm) : WGM;
    pm = fm + ((wgid % nig) % gsz); pn = (wgid % nig) / gsz;
}

template <class Epi, class Sched>
__device__ __forceinline__ void gemm_phase(LAS unsigned char* lds, const int K, const Sched& S, const Epi& E) {
    int tid = threadIdx.x; asm volatile("" : "+v"(tid));
    const int wid = __builtin_amdgcn_readfirstlane(tid >> 6), lane = tid & 63, wr = wid >> 2, wc = wid & 3, fr = lane & 15, fq = lane >> 4;
    const int nt = K / BK;
    unsigned voffA[2], voffB[2];
#pragma unroll
    for (int i = 0; i < 2; ++i) { int R, C; stage_rc(tid * 16 + i * 8192, R, C); const int Rb = Epi::PERM ? ((R & ~31) + perm32(R & 31)) : R;
        voffA[i] = (unsigned)(R * K + C) * 2u; voffB[i] = (unsigned)(Rb * K + C) * 2u; }
    const size_t kstep = (size_t)(BK * 2);
    const size_t hstep = (size_t)HALF * K * 2;
    const unsigned ldsw = (unsigned)wid * 1024u;
    const int aoff = lds_byte(wr * 64 + fr, fq * 8), boff = lds_byte(wc * 32 + fr, fq * 8);
#define PG8_SA(b, h) (((b) * 2 + (h)) * HTB)
#define PG8_SB(b, h) ((4 + (b) * 2 + (h)) * HTB)
#define PG8_STAGE(bufoff, gbase, voff) do { _Pragma("unroll") for (int _i = 0; _i < 2; ++_i) \
        __builtin_amdgcn_global_load_lds((const unsigned*)((const char*)(gbase) + (voff)[_i]), (LAS unsigned*)(lds + (bufoff) + ldsw + _i * 8192), 16, 0, 0); } while (0)
#define PG8_LDA(dst, b, h) do { _Pragma("unroll") for (int m = 0; m < 4; ++m) _Pragma("unroll") for (int k = 0; k < 2; ++k) dst[m][k] = *(const LAS bf16x8*)(lds + PG8_SA(b, h) + aoff + m * 2048 + k * 1024); } while (0)
#define PG8_LDB(dst, b, h) do { _Pragma("unroll") for (int n = 0; n < 2; ++n) _Pragma("unroll") for (int k = 0; k < 2; ++k) dst[n][k] = *(const LAS bf16x8*)(lds + PG8_SB(b, h) + boff + n * 2048 + k * 1024); } while (0)
#define PG8_MMA(ai, bj, At, Bt) do { __builtin_amdgcn_s_setprio(1); _Pragma("unroll") for (int m = 0; m < 4; ++m) _Pragma("unroll") for (int n = 0; n < 2; ++n) _Pragma("unroll") for (int k = 0; k < 2; ++k) \
        acc[ai][bj][m][n] = __builtin_amdgcn_mfma_f32_16x16x32_bf16(Bt[n][k], At[m][k], acc[ai][bj][m][n], 0, 0, 0); __builtin_amdgcn_s_setprio(0); } while (0)
#define PG8_WAIT_V(n) asm volatile("s_waitcnt vmcnt(" #n ")" ::: "memory")
#define PG8_WAIT_L(n) asm volatile("s_waitcnt lgkmcnt(" #n ")" ::: "memory")
#define PG8_BAR __builtin_amdgcn_s_barrier()
#define PG8_SCHED __builtin_amdgcn_sched_barrier(0)
    Unit cur, nxt; int ui = 0;
    if (!S.next(0, cur)) return;
    f32x4 acc[2][2][4][2];
#pragma unroll
    for (int a = 0; a < 2; ++a)
#pragma unroll
        for (int b = 0; b < 2; ++b)
#pragma unroll
            for (int m = 0; m < 4; ++m)
#pragma unroll
                for (int n = 0; n < 2; ++n) acc[a][b][m][n] = (f32x4){0.f, 0.f, 0.f, 0.f};
    bf16x8 At[4][2], B0[2][2], B1[2][2];
    const char* cA = S.a_ptr(cur); const char* cB = S.b_ptr(cur);
    PG8_STAGE(PG8_SB(0, 0), cB, voffB); PG8_STAGE(PG8_SB(0, 1), cB + hstep, voffB); PG8_STAGE(PG8_SA(0, 0), cA, voffA); PG8_STAGE(PG8_SA(0, 1), cA + hstep, voffA);
    if (wr == 1) PG8_BAR;
    PG8_WAIT_V(2); PG8_BAR;
    PG8_STAGE(PG8_SB(1, 0), cB + kstep, voffB); PG8_STAGE(PG8_SA(1, 0), cA + kstep, voffA); PG8_STAGE(PG8_SB(1, 1), cB + hstep + kstep, voffB);
    PG8_WAIT_V(6); PG8_BAR;
    for (;;) {
        const bool has_next = S.next(ui + 1, nxt);
        const char* nA = has_next ? S.a_ptr(nxt) : cA; const char* nB = has_next ? S.b_ptr(nxt) : cB;
#pragma unroll 1
        for (int t = 0; t < nt; t += 2) {
            const bool last = (t == nt - 2);
            const char* a1 = cA + (size_t)(t + 1) * kstep;
            const char* a2 = last ? nA : cA + (size_t)(t + 2) * kstep; const char* b2 = last ? nB : cB + (size_t)(t + 2) * kstep;
            const char* a3 = a2 + kstep; const char* b3 = b2 + kstep;
            PG8_LDB(B0, 0, 0); PG8_LDB(B1, 0, 1); PG8_SCHED; PG8_LDA(At, 0, 0); PG8_STAGE(PG8_SA(1, 1), a1 + hstep, voffA);
            PG8_WAIT_V(8); PG8_WAIT_L(0); PG8_BAR; PG8_MMA(0, 0, At, B0); PG8_MMA(0, 1, At, B1); PG8_BAR; PG8_SCHED;
            PG8_LDA(At, 0, 1); PG8_STAGE(PG8_SB(0, 0), b2, voffB); PG8_STAGE(PG8_SB(0, 1), b2 + hstep, voffB); PG8_STAGE(PG8_SA(0, 0), a2, voffA);
            PG8_WAIT_V(8); PG8_WAIT_L(0); PG8_BAR; PG8_MMA(1, 0, At, B0); PG8_MMA(1, 1, At, B1); PG8_BAR; PG8_SCHED;
            PG8_LDB(B0, 1, 0); PG8_LDB(B1, 1, 1); PG8_SCHED; PG8_LDA(At, 1, 0); PG8_STAGE(PG8_SA(0, 1), a2 + hstep, voffA);
            PG8_WAIT_V(8); PG8_WAIT_L(0); PG8_BAR; PG8_MMA(0, 0, At, B0); PG8_MMA(0, 1, At, B1); PG8_BAR; PG8_SCHED;
            PG8_LDA(At, 1, 1); PG8_STAGE(PG8_SB(1, 0), b3, voffB); PG8_STAGE(PG8_SB(1, 1), b3 + hstep, voffB); PG8_STAGE(PG8_SA(1, 0), a3, voffA);
            PG8_WAIT_V(8); PG8_WAIT_L(0); PG8_BAR; PG8_MMA(1, 0, At, B0); PG8_MMA(1, 1, At, B1); PG8_BAR; PG8_SCHED;
        }
        if (wr == 0) PG8_BAR;
        { int tz = threadIdx.x; asm volatile("" : "+v"(tz));
          const int wid2 = __builtin_amdgcn_readfirstlane(tz >> 6), lane2 = tz & 63; E(acc, cur, wid2 >> 2, wid2 & 3, lane2 & 15, lane2 >> 4); }
        if (!has_next) break;
        if (!(Epi::CHAIN && cur.kind == 0)) {
#pragma unroll
            for (int a = 0; a < 2; ++a)
#pragma unroll
                for (int b = 0; b < 2; ++b)
#pragma unroll
                    for (int m = 0; m < 4; ++m)
#pragma unroll
                        for (int n = 0; n < 2; ++n) acc[a][b][m][n] = (f32x4){0.f, 0.f, 0.f, 0.f};
        }
        cur = nxt; cA = nA; cB = nB; ++ui;
        if (wr == 1) PG8_BAR;
    }
    PG8_WAIT_V(0);
    PG8_BAR;
#undef PG8_SA
#undef PG8_SB
#undef PG8_STAGE
#undef PG8_LDA
#undef PG8_LDB
#undef PG8_MMA
#undef PG8_WAIT_V
#undef PG8_WAIT_L
#undef PG8_BAR
#undef PG8_SCHED
}
}
namespace pg8 {
__device__ __forceinline__ u32x4 pack8(const f32x4 a, const f32x4 b) { u32x4 w; w.x = cvt_pk_bf16(a[0], a[1]); w.y = cvt_pk_bf16(a[2], a[3]); w.z = cvt_pk_bf16(b[0], b[1]); w.w = cvt_pk_bf16(b[2], b[3]); return w; }
__device__ __forceinline__ float sumsq4(const f32x4 a) { return (a[0] * a[0] + a[1] * a[1]) + (a[2] * a[2] + a[3] * a[3]); }
#define EPI_BAR() do { asm volatile("s_waitcnt lgkmcnt(0)" ::: "memory"); __builtin_amdgcn_s_barrier(); asm volatile("" ::: "memory"); } while (0)

struct EpiIn {
    static constexpr bool PERM = true, CHAIN = false;
    bf16_t *QA, *KA, *VA, *ZCQ, *ZCKV, *ZKR, *GATES; const float *qg, *kg;
    __device__ __forceinline__ void operator()(f32x4 (&acc)[2][2][4][2], const Unit& u, int wr, int wc, int fr, int fq) const {
        const int row0 = u.pm * BM + wr * 64 + fr, pn = u.pn;
        if (pn < 4) {
            const float* g = (pn < 2) ? qg : kg; bf16_t* dst = (pn < 2) ? QA : KA; const int head = 4 * (pn & 1) + wc;
            f32x4 gv[2][2];
#pragma unroll
            for (int bj = 0; bj < 2; ++bj)
#pragma unroll
                for (int n = 0; n < 2; ++n) gv[bj][n] = *(const f32x4*)(g + 32 * bj + 8 * fq + 4 * n);
#pragma unroll
            for (int ai = 0; ai < 2; ++ai)
#pragma unroll
                for (int m = 0; m < 4; ++m) {
                    const size_t row = (size_t)(row0 + ai * HALF + m * 16);
                    float ss = (sumsq4(acc[ai][0][m][0]) + sumsq4(acc[ai][0][m][1])) + (sumsq4(acc[ai][1][m][0]) + sumsq4(acc[ai][1][m][1]));
                    ss += __shfl_xor(ss, 16); ss += __shfl_xor(ss, 32);
                    const float rstd = rsqrtf(ss * (1.0f / 64.0f) + RMS_EPS);
#pragma unroll
                    for (int bj = 0; bj < 2; ++bj)
                        *(u32x4*)(dst + row * 512 + head * 64 + 32 * bj + 8 * fq) = pack8(acc[ai][bj][m][0] * rstd * gv[bj][0], acc[ai][bj][m][1] * rstd * gv[bj][1]);
                }
        } else if (pn >= 9) {
#pragma unroll
            for (int ai = 0; ai < 2; ++ai)
#pragma unroll
                for (int m = 0; m < 4; ++m) {
                    const size_t row = (size_t)(row0 + ai * HALF + m * 16);
#pragma unroll
                    for (int bj = 0; bj < 2; ++bj) { f32x4 a = acc[ai][bj][m][0], b = acc[ai][bj][m][1];
#pragma unroll
                        for (int j = 0; j < 4; ++j) { a[j] = sigmoidf_(a[j]); b[j] = sigmoidf_(b[j]); }
                        *(u32x4*)(GATES + row * 2048 + (pn - 9) * 256 + 128 * bj + 32 * wc + 8 * fq) = pack8(a, b); }
                }
        } else {
#pragma unroll
            for (int ai = 0; ai < 2; ++ai)
#pragma unroll
                for (int m = 0; m < 4; ++m) {
                    const size_t row = (size_t)(row0 + ai * HALF + m * 16);
#pragma unroll
                    for (int bj = 0; bj < 2; ++bj) {
                        const u32x4 w = pack8(acc[ai][bj][m][0], acc[ai][bj][m][1]); const int cc = 128 * bj + 32 * wc + 8 * fq;
                        if (pn < 6) *(u32x4*)(VA + row * 512 + (pn - 4) * 256 + cc) = w;
                        else if (pn == 6) *(u32x4*)(ZCQ + row * QLORA + cc) = w;
                        else if (pn == 8) *(u32x4*)(ZCKV + row * KVLORA + cc) = w;
                        else { if (bj == 0) *(u32x4*)(ZCQ + row * QLORA + 256 + cc) = w; else if (wc == 0) *(u32x4*)(ZKR + row * ROPED + 8 * fq) = w; }
                    }
                }
        }
    }
};

__device__ __forceinline__ void rope8(float (&v)[8], const float* rope, int s  , int fq) {
    const int pos = (fq < 2) ? (s >> 6) : (s & 63);
    const f32x4 c0 = *(const f32x4*)(rope + pos * 8), c1 = *(const f32x4*)(rope + pos * 8 + 4), s0 = *(const f32x4*)(rope + 512 + pos * 8), s1 = *(const f32x4*)(rope + 512 + pos * 8 + 4);
    const float cs[8] = {c0[0], c0[1], c0[2], c0[3], c1[0], c1[1], c1[2], c1[3]}, sn[8] = {s0[0], s0[1], s0[2], s0[3], s1[0], s1[1], s1[2], s1[3]};
#pragma unroll
    for (int i = 0; i < 8; ++i) { const float o = __shfl_xor(v[i], 16); v[i] = (fq & 1) ? (o * sn[i] + v[i] * cs[i]) : (v[i] * cs[i] - o * sn[i]); }
}

struct EpiQ {
    static constexpr bool PERM = true, CHAIN = false;
    bf16_t* QB; const float *rs, *g, *rope; LAS float* P;
    __device__ __forceinline__ void operator()(f32x4 (&acc)[2][2][4][2], const Unit& u, int wr, int wc, int fr, int fq) const {
        const int row0 = u.pm * BM + wr * 64 + fr; const bool isx = u.pm < MT_X;
#ifdef EQ_TRIVIAL
#pragma unroll
        for (int ai = 0; ai < 2; ++ai)
#pragma unroll
            for (int m = 0; m < 4; ++m) { const size_t row = (size_t)(row0 + ai * HALF + m * 16);
#pragma unroll
                for (int bj = 0; bj < 2; ++bj) *(u32x4*)(QB + row * 768 + (2 * u.pn + bj) * QKD + 32 * wc + 8 * fq) = pack8(acc[ai][bj][m][0], acc[ai][bj][m][1]); }
        return;
#endif
#pragma unroll
        for (int ai = 0; ai < 2; ++ai)
#pragma unroll
            for (int m = 0; m < 4; ++m) {
                const float r = rs[row0 + ai * HALF + m * 16]; const int rl = ai * 64 + m * 16 + fr;
#pragma unroll
                for (int bj = 0; bj < 2; ++bj) {
                    float ss = (sumsq4(acc[ai][bj][m][0]) + sumsq4(acc[ai][bj][m][1])) * (r * r); ss += __shfl_xor(ss, 16); ss += __shfl_xor(ss, 32);
                    if (fq == 0) P[((wr * 128 + rl) * 2 + bj) * 4 + wc] = ss; }
                asm volatile("" ::: "memory");
            }
        EPI_BAR();
        if (wc < 3) {
            const f32x4 g0 = *(const f32x4*)(g + 32 * wc + 8 * fq), g1 = *(const f32x4*)(g + 32 * wc + 8 * fq + 4);
#pragma unroll
            for (int ai = 0; ai < 2; ++ai)
#pragma unroll
                for (int m = 0; m < 4; ++m) {
                    const int row = row0 + ai * HALF + m * 16, rl = ai * 64 + m * 16 + fr; const float r = rs[row];
#pragma unroll
                    for (int bj = 0; bj < 2; ++bj) {
                        const f32x4 p = *(const LAS f32x4*)(P + ((wr * 128 + rl) * 2 + bj) * 4);
                        const float rstd = r * rsqrtf(((p[0] + p[1]) + p[2]) * (1.0f / 96.0f) + RMS_EPS);
                        const f32x4 a = acc[ai][bj][m][0] * rstd * g0, b = acc[ai][bj][m][1] * rstd * g1;
                        float v[8] = {a[0], a[1], a[2], a[3], b[0], b[1], b[2], b[3]};
#ifndef EQ_NOROPE
                        if (wc == 2 && isx) rope8(v, rope, row & (SEQ - 1), fq);
#endif
                        u32x4 w; w.x = cvt_pk_bf16(v[0], v[1]); w.y = cvt_pk_bf16(v[2], v[3]); w.z = cvt_pk_bf16(v[4], v[5]); w.w = cvt_pk_bf16(v[6], v[7]);
                        *(u32x4*)(QB + (size_t)row * 768 + (2 * u.pn + bj) * QKD + 32 * wc + 8 * fq) = w;
                    }
                    asm volatile("" ::: "memory");
                }
        }
    }
};

struct EpiKV {
    static constexpr bool PERM = true, CHAIN = false;
    bf16_t *KB, *VB; const bf16_t* ZKR; const float *rs, *sskr, *g, *rope; LAS float* P;
    __device__ __forceinline__ void operator()(f32x4 (&acc)[2][2][4][2], const Unit& u, int wr, int wc, int fr, int fq) const {
        const int row0 = u.pm * BM + wr * 64 + fr; const bool isx = u.pm < MT_X;
#pragma unroll
        for (int ai = 0; ai < 2; ++ai)
#pragma unroll
            for (int m = 0; m < 4; ++m) {
                const float r = rs[row0 + ai * HALF + m * 16]; const int rl = ai * 64 + m * 16 + fr;
                if (wc < 2) {
#pragma unroll
                    for (int bj = 0; bj < 2; ++bj) { float ss = (sumsq4(acc[ai][bj][m][0]) + sumsq4(acc[ai][bj][m][1])) * (r * r); ss += __shfl_xor(ss, 16); ss += __shfl_xor(ss, 32);
                        if (fq == 0) P[((wr * 128 + rl) * 2 + bj) * 4 + wc] = ss; } }
                asm volatile("" ::: "memory");
            }
        EPI_BAR();
        const int gofs = (wc < 2) ? (32 * wc + 8 * fq) : (64 + 8 * fq);
        const f32x4 g0 = *(const f32x4*)(g + gofs), g1 = *(const f32x4*)(g + gofs + 4);
#pragma unroll
        for (int ai = 0; ai < 2; ++ai)
#pragma unroll
            for (int m = 0; m < 4; ++m) {
                const int row = row0 + ai * HALF + m * 16, rl = ai * 64 + m * 16 + fr;
                const float skr = sskr[row], rr = rs[row];
                u32x4 zk = (u32x4){0u, 0u, 0u, 0u}; if (wc == 2) zk = *(const u32x4*)(ZKR + (size_t)row * ROPED + 8 * fq);
#pragma unroll
                for (int bj = 0; bj < 2; ++bj) {
                    const int head = 2 * u.pn + bj;
                    const f32x4 p = *(const LAS f32x4*)(P + ((wr * 128 + rl) * 2 + bj) * 4);
                    const float rstd = rsqrtf(((p[0] + p[1]) + skr) * (1.0f / 96.0f) + RMS_EPS);
                    if (wc < 2) {
                        *(u32x4*)(KB + (size_t)row * 768 + head * QKD + 32 * wc + 8 * fq) = pack8(acc[ai][bj][m][0] * (rr * rstd) * g0, acc[ai][bj][m][1] * (rr * rstd) * g1);
                    } else {
                        *(u32x4*)(VB + (size_t)row * 512 + head * 64 + 32 * (wc - 2) + 8 * fq) = pack8(acc[ai][bj][m][0] * rr, acc[ai][bj][m][1] * rr);
                        if (wc == 2) {
                            float v[8] = {bf_lo(zk.x) * rstd * g0[0], bf_hi(zk.x) * rstd * g0[1], bf_lo(zk.y) * rstd * g0[2], bf_hi(zk.y) * rstd * g0[3],
                                          bf_lo(zk.z) * rstd * g1[0], bf_hi(zk.z) * rstd * g1[1], bf_lo(zk.w) * rstd * g1[2], bf_hi(zk.w) * rstd * g1[3]};
                            if (isx) rope8(v, rope, row & (SEQ - 1), fq);
                            u32x4 w; w.x = cvt_pk_bf16(v[0], v[1]); w.y = cvt_pk_bf16(v[2], v[3]); w.z = cvt_pk_bf16(v[4], v[5]); w.w = cvt_pk_bf16(v[6], v[7]);
                            *(u32x4*)(KB + (size_t)row * 768 + head * QKD + 64 + 8 * fq) = w;
                        }
                    }
                }
                asm volatile("" ::: "memory");
            }
    }
};

struct EpiMerge {
    static constexpr bool PERM = true, CHAIN = true;
    const bf16_t* GATES; bf16_t* Y;
    __device__ __forceinline__ void operator()(f32x4 (&acc)[2][2][4][2], const Unit& u, int wr, int wc, int fr, int fq) const {
        const int row0 = u.pm * BM + wr * 64 + fr;
#pragma unroll
        for (int ai = 0; ai < 2; ++ai)
#pragma unroll
            for (int m = 0; m < 4; ++m) {
                const size_t row = (size_t)(row0 + ai * HALF + m * 16);
#pragma unroll
                for (int bj = 0; bj < 2; ++bj) {
                    const int col = u.pn * 256 + 128 * bj + 32 * wc + 8 * fq;
                    const u32x4 gb = *(const u32x4*)(GATES + row * 2048 + 1024 + col);
                    const f32x4 b0 = (f32x4){bf_lo(gb.x), bf_hi(gb.x), bf_lo(gb.y), bf_hi(gb.y)}, b1 = (f32x4){bf_lo(gb.z), bf_hi(gb.z), bf_lo(gb.w), bf_hi(gb.w)};
                    if (u.kind == 0) {
                        const u32x4 ga = *(const u32x4*)(GATES + row * 2048 + col);
                        const f32x4 a0 = (f32x4){bf_lo(ga.x), bf_hi(ga.x), bf_lo(ga.y), bf_hi(ga.y)}, a1 = (f32x4){bf_lo(ga.z), bf_hi(ga.z), bf_lo(ga.w), bf_hi(ga.w)};
#pragma unroll
                        for (int j = 0; j < 4; ++j) { acc[ai][bj][m][0][j] *= a0[j] * __builtin_amdgcn_rcpf(b0[j]); acc[ai][bj][m][1][j] *= a1[j] * __builtin_amdgcn_rcpf(b1[j]); }
                    } else {
                        *(u32x4*)(Y + row * 1024 + col) = pack8(acc[ai][bj][m][0] * b0, acc[ai][bj][m][1] * b1);
                    }
                }
            }
    }
};

struct EpiOut {
    static constexpr bool PERM = false, CHAIN = false;
    const float* xsrc; float* xdst; const float* csrc; float* cdst; const float* mod  ; int goff;
    __device__ __forceinline__ void operator()(f32x4 (&acc)[2][2][4][2], const Unit& u, int wr, int wc, int fr, int fq) const {
        const bool isx = u.pm < MT_X;
        const int rowt = (isx ? u.pm : u.pm - MT_X) * BM + wr * 64 + fr;
        const float* src = isx ? xsrc : csrc; float* dst = isx ? xdst : cdst;
        const float* gm = mod + (size_t)(isx ? (u.pm >> 3) : 16) * NMODC + goff;
        const int col0 = u.pn * BM + wc * 32 + 4 * fq;
        f32x4 gv[2][2];
#pragma unroll
        for (int bj = 0; bj < 2; ++bj)
#pragma unroll
            for (int n = 0; n < 2; ++n) gv[bj][n] = *(const f32x4*)(gm + col0 + bj * HALF + n * 16);
#pragma unroll
        for (int ai = 0; ai < 2; ++ai)
#pragma unroll
            for (int m = 0; m < 4; ++m) { const size_t off = (size_t)(rowt + ai * HALF + m * 16) * DM + col0;
#pragma unroll
                for (int bj = 0; bj < 2; ++bj)
#pragma unroll
                    for (int n = 0; n < 2; ++n) { const f32x4 xs = *(const f32x4*)(src + off + bj * HALF + n * 16); *(f32x4*)(dst + off + bj * HALF + n * 16) = xs + gv[bj][n] * acc[ai][bj][m][n]; }
            }
    }
};

struct EpiMoe1 {
    static constexpr bool PERM = true, CHAIN = false;
    bf16_t* HM;
    __device__ __forceinline__ void operator()(f32x4 (&acc)[2][2][4][2], const Unit& u, int wr, int wc, int fr, int fq) const {
        const int row0 = u.pm * BM + wr * 64 + fr;
#pragma unroll
        for (int ai = 0; ai < 2; ++ai)
#pragma unroll
            for (int m = 0; m < 4; ++m) { const size_t row = (size_t)(row0 + ai * HALF + m * 16);
#pragma unroll
                for (int bj = 0; bj < 2; ++bj) { const f32x4 p = acc[ai][bj][m][0], q = acc[ai][bj][m][1];
                    const float h0 = p[0] * sigmoidf_(p[0]) * p[1], h1 = p[2] * sigmoidf_(p[2]) * p[3], h2 = q[0] * sigmoidf_(q[0]) * q[1], h3 = q[2] * sigmoidf_(q[2]) * q[3];
                    u32x2 w; w.x = cvt_pk_bf16(h0, h1); w.y = cvt_pk_bf16(h2, h3);
                    *(u32x2*)(HM + row * DM + u.pn * 128 + 64 * bj + 16 * wc + 4 * fq) = w; }
            }
    }
};
struct EpiMoe2 {
    static constexpr bool PERM = true, CHAIN = false;
    bf16_t* YS;
    __device__ __forceinline__ void operator()(f32x4 (&acc)[2][2][4][2], const Unit& u, int wr, int wc, int fr, int fq) const {
        const int row0 = u.pm * BM + wr * 64 + fr;
#pragma unroll
        for (int ai = 0; ai < 2; ++ai)
#pragma unroll
            for (int m = 0; m < 4; ++m) { const size_t row = (size_t)(row0 + ai * HALF + m * 16);
#pragma unroll
                for (int bj = 0; bj < 2; ++bj) *(u32x4*)(YS + row * DM + u.pn * 256 + 128 * bj + 32 * wc + 8 * fq) = pack8(acc[ai][bj][m][0], acc[ai][bj][m][1]); }
    }
};

struct SchedRect {
    const char* A; const char* B; size_t tstep; int nM, nN, G, c, nM2, pn2, npn2;
    __device__ __forceinline__ bool next(int i, Unit& u) const {
        const int L = i * G + c, mainc = nM * nN; u.kind = 0; u.e = 0;
        if (L < mainc) { rect_tile(L, nM, nN, u.pm, u.pn); return true; }
        const int Lx = L - mainc; if (Lx >= nM2 * npn2) return false;
        u.pm = nM + Lx / npn2; u.pn = pn2 + Lx % npn2; return true;
    }
    __device__ __forceinline__ const char* a_ptr(const Unit& u) const { return A + (size_t)u.pm * tstep; }
    __device__ __forceinline__ const char* b_ptr(const Unit& u) const { return B + (size_t)u.pn * tstep; }
};
struct SchedMerge {
    const char *OA, *OB, *WA, *WB; size_t tstep; int nM, nN, G, c;
    __device__ __forceinline__ bool next(int i, Unit& u) const {
        const int L = (i >> 1) * G + c; if (L >= nM * nN) return false;
        rect_tile(L, nM, nN, u.pm, u.pn); u.kind = i & 1; u.e = 0; return true;
    }
    __device__ __forceinline__ const char* a_ptr(const Unit& u) const { return (u.kind ? OB : OA) + (size_t)u.pm * tstep; }
    __device__ __forceinline__ const char* b_ptr(const Unit& u) const { return (u.kind ? WB : WA) + (size_t)u.pn * tstep; }
};
struct SchedMoe {
    const char* A; const char* W; size_t tstepA, wstride, tstepB; const int* tile_e; int ntile, nN, G, c;
    __device__ __forceinline__ bool next(int i, Unit& u) const {
        const int L = i * G + c; if (L >= ntile * nN) return false;
        rect_tile(L, ntile, nN, u.pm, u.pn); u.kind = 0;
        u.e = __builtin_amdgcn_readfirstlane(ld_i32_agent(tile_e + u.pm)); return true;
    }
    __device__ __forceinline__ const char* a_ptr(const Unit& u) const { return A + (size_t)u.pm * tstepA; }
    __device__ __forceinline__ const char* b_ptr(const Unit& u) const { return W + (size_t)u.e * wstride + (size_t)u.pn * tstepB; }
};
}
namespace att {
constexpr int NW = 8, QBLK = 32, KVBLK = 64, DV = 64;
constexpr int SHM_V = KVBLK * DV * 2  , SHM_K = KVBLK * 256  ;
constexpr int LDS_VOFF = 0, LDS_KOFF = 2 * SHM_V, LDS_WS = LDS_KOFF + 2 * SHM_K, LDS_OST = LDS_WS + NW * 64 * 4, LDS_BIAS = LDS_OST + NW * 4096, LDS_MASK = LDS_BIAS + 4096, LDS_END = LDS_MASK + 64 * 64 * 4;
constexpr int BIAS_PAD = 64;
static_assert(LDS_END <= RING_BYTES, "attention LDS map");
#define KSWZ(row, colB) ((row) * 256 + ((colB) ^ (((row) & 7) << 4)))
#define SBAR() __builtin_amdgcn_sched_barrier(0)
__device__ __forceinline__ int crow(int r, int hi) { return (r & 3) + 8 * (r >> 2) + 4 * hi; }
__device__ __forceinline__ int v_st(int k, int c) { const int kk = (k & ~0xC) | ((k & 4) << 1) | ((k & 8) >> 1); return ((kk >> 3) * 2 + (c >> 5)) * 512 + ((kk & 7) * 32 + (c & 31)) * 2; }
__device__ __forceinline__ int v_rd_base(int lane) { return ((lane & 3) << 3) | (((lane >> 2) & 3) << 6) | (((lane >> 4) & 1) << 5) | (((lane >> 5) & 1) << 8); }
constexpr int v_rd_off(int d0, int ks, int half) { return ((2 * ks + half) * 2 + d0) * 512; }
template <int OFF> __device__ __forceinline__ s16x4 tr_read(int vb) { s16x4 r; asm volatile("ds_read_b64_tr_b16 %0, %1 offset:%2" : "=&v"(r) : "v"(vb), "i"(OFF) : "memory"); return r; }

template <int D0> __device__ __forceinline__ void pv_one(f32x16& od, int vb, bf16x8 pa0, bf16x8 pa1, bf16x8 pa2, bf16x8 pa3) {
    const s16x4 l0 = tr_read<v_rd_off(D0, 0, 0)>(vb), h0 = tr_read<v_rd_off(D0, 0, 1)>(vb), l1 = tr_read<v_rd_off(D0, 1, 0)>(vb), h1 = tr_read<v_rd_off(D0, 1, 1)>(vb);
    const s16x4 l2 = tr_read<v_rd_off(D0, 2, 0)>(vb), h2 = tr_read<v_rd_off(D0, 2, 1)>(vb), l3 = tr_read<v_rd_off(D0, 3, 0)>(vb), h3 = tr_read<v_rd_off(D0, 3, 1)>(vb);
    asm volatile("s_waitcnt lgkmcnt(0)" ::: "memory"); SBAR();
#define PK(L, H) (bf16x8){L[0], L[1], L[2], L[3], H[0], H[1], H[2], H[3]}
    od = __builtin_amdgcn_mfma_f32_32x32x16_bf16(pa0, PK(l0, h0), od, 0, 0, 0);
    od = __builtin_amdgcn_mfma_f32_32x32x16_bf16(pa1, PK(l1, h1), od, 0, 0, 0);
    od = __builtin_amdgcn_mfma_f32_32x32x16_bf16(pa2, PK(l2, h2), od, 0, 0, 0);
    od = __builtin_amdgcn_mfma_f32_32x32x16_bf16(pa3, PK(l3, h3), od, 0, 0, 0);
#undef PK
}
__device__ __forceinline__ void pv_all(f32x16* o, int vb, bf16x8 pa0, bf16x8 pa1, bf16x8 pa2, bf16x8 pa3) { pv_one<0>(o[0], vb, pa0, pa1, pa2, pa3); pv_one<1>(o[1], vb, pa0, pa1, pa2, pa3); }

__device__ __forceinline__ void partialSM(f32x16& p0, f32x16& p1, float& m_reg, float& alpha, const float C, const float THRS) {
    float pmax = p0[0];
#pragma unroll
    for (int r = 1; r < 16; ++r) pmax = fmaxf(pmax, p0[r]);
#pragma unroll
    for (int r = 0; r < 16; ++r) pmax = fmaxf(pmax, p1[r]);
    { auto rr = __builtin_amdgcn_permlane32_swap(__float_as_uint(pmax), __float_as_uint(pmax), false, false); pmax = fmaxf(__uint_as_float(rr[0]), __uint_as_float(rr[1])); }
    float mn;
    if (__builtin_expect(__all(pmax - m_reg <= THRS), 1)) { mn = m_reg; alpha = 1.f; }
    else { mn = fmaxf(m_reg, pmax); alpha = __builtin_amdgcn_exp2f((m_reg - mn) * C); m_reg = mn; }
    const float mnC = -mn * C;
#pragma unroll
    for (int r = 0; r < 16; ++r) p0[r] = fmaf(p0[r], C, mnC);
#pragma unroll
    for (int r = 0; r < 16; ++r) p1[r] = fmaf(p1[r], C, mnC);
#pragma unroll
    for (int r = 0; r < 16; ++r) p0[r] = __builtin_amdgcn_exp2f(p0[r]);
}
__device__ __forceinline__ void finishSM(f32x16& p0, f32x16& p1, float alpha, float& l_reg, bf16x8& pa0, bf16x8& pa1, bf16x8& pa2, bf16x8& pa3) {
#pragma unroll
    for (int r = 0; r < 16; ++r) p1[r] = __builtin_amdgcn_exp2f(p1[r]);
    float ps = 0;
#pragma unroll
    for (int r = 0; r < 16; ++r) ps += p0[r];
#pragma unroll
    for (int r = 0; r < 16; ++r) ps += p1[r];
    { auto rr = __builtin_amdgcn_permlane32_swap(__float_as_uint(ps), __float_as_uint(ps), false, false); ps = __uint_as_float(rr[0]) + __uint_as_float(rr[1]); }
    l_reg = l_reg * alpha + ps;
#define PK4(P, BASE, OUT) do { unsigned a0 = cvt_pk_bf16(P[BASE + 0], P[BASE + 1]), a1 = cvt_pk_bf16(P[BASE + 2], P[BASE + 3]);   \
    unsigned b0 = cvt_pk_bf16(P[BASE + 4], P[BASE + 5]), b1 = cvt_pk_bf16(P[BASE + 6], P[BASE + 7]);                              \
    auto r0 = __builtin_amdgcn_permlane32_swap(a0, b0, false, false); auto r1 = __builtin_amdgcn_permlane32_swap(a1, b1, false, false); \
    u32x4 w = {r0[0], r1[0], r0[1], r1[1]}; OUT = *reinterpret_cast<bf16x8*>(&w); } while (0)
    PK4(p0, 0, pa0); PK4(p0, 8, pa1); PK4(p1, 0, pa2); PK4(p1, 8, pa3);
#undef PK4
}
template <int DQK> __device__ __forceinline__ void qkt(f32x16& p0, f32x16& p1, const char* Ks, const bf16x8* qr, int r32, int hi) {
    p0 = f32x16{}; p1 = f32x16{};
#pragma unroll
    for (int d0 = 0; d0 < DQK / 16; ++d0) { const int cb = (d0 * 16 + hi * 8) * 2;
        const bf16x8 b0 = *reinterpret_cast<const bf16x8*>(Ks + KSWZ(r32, cb));
        const bf16x8 b1 = *reinterpret_cast<const bf16x8*>(Ks + KSWZ(32 + r32, cb));
        p0 = __builtin_amdgcn_mfma_f32_32x32x16_bf16(b0, qr[d0], p0, 0, 0, 0);
        p1 = __builtin_amdgcn_mfma_f32_32x32x16_bf16(b1, qr[d0], p1, 0, 0, 0); }
}

struct UnitArgs {
    const bf16_t* Q; int ldq; int qcol;
    const bf16_t* K; int ldk; int kcol;
    const bf16_t* V; int vcol;
    bf16_t* O; int ocol;
    int q0;
    int ctx0, loc0;
    int NT;
    int masked;
    int band, krow0;
    const float* bias;
    float C;
};

__device__ __forceinline__ void na_mask(f32x16& p0, f32x16& p1, const LAS float* bt, const LAS float* mk, int kr, int qrow, int qc, int hi) {
    const int rs = min(max(qrow - 4, 0), 24);
    if (!((kr >= rs) && (kr < rs + 8))) {
#pragma unroll
        for (int r = 0; r < 16; ++r) { p0[r] = -1e30f; p1[r] = -1e30f; }
        return;
    }
    const LAS float* b = bt + BIAS_PAD + (kr - qrow + 7) * 31 + (15 - qc) + 4 * hi;
    const LAS float* mq = mk + qc * 64 + 4 * hi;
#pragma unroll
    for (int g = 0; g < 4; ++g) {
        const f32x4 m0 = *(const LAS f32x4*)(mq + 8 * g), m1 = *(const LAS f32x4*)(mq + 32 + 8 * g);
#pragma unroll
        for (int j = 0; j < 4; ++j) { p0[4 * g + j] = (p0[4 * g + j] + b[8 * g + j]) + m0[j]; p1[4 * g + j] = (p1[4 * g + j] + b[32 + 8 * g + j]) + m1[j]; }
    }
}
__device__ __forceinline__ void na_mask_table(char* lds) {
    LAS float* mk = (LAS float*)(lds + LDS_MASK);
    int t0 = threadIdx.x; asm volatile("" : "+v"(t0));
    for (int i = t0; i < 64 * 64; i += 512) { const int qc = i >> 6, kc = i & 63, cs = min(max(qc - 8, 0), 48); mk[i] = ((unsigned)(kc - cs) < 16u) ? 0.f : -1e30f; }
}

template <int DQK>
__device__ __forceinline__ void attn_unit(const UnitArgs& A, char* lds) {
    int tid = threadIdx.x; asm volatile("" : "+v"(tid));
    const int wid = tid >> 6, lane = tid & 63, r32 = lane & 31, hi = lane >> 5;
    char* V_lds = lds + LDS_VOFF; char* K_lds = lds + LDS_KOFF;
    float* ws = (float*)(lds + LDS_WS) + wid * 64; float* li_l = ws; float* al_l = ws + 32;
    const LAS float* bt = (const LAS float*)(lds + LDS_BIAS); const LAS float* mk = (const LAS float*)(lds + LDS_MASK);
    const float C = A.C, THRS = 8.0f * 1.4426950408889634f / C;
    float m_reg = -1e30f, l_reg = 0; f32x16 o[2] = {}; bf16x8 qr[DQK / 16];
    if (A.masked) { for (int i = tid; i < 1024; i += 512) { const int k = i - BIAS_PAD; ((LAS float*)(lds + LDS_BIAS))[i] = (k >= 0 && k < 15 * 31) ? A.bias[k] * (1.4426950408889634f / C) : 0.f; } }
    const bf16_t* Qw = A.Q + (size_t)(A.q0 + wid * QBLK + r32) * A.ldq + A.qcol + hi * 8;
#pragma unroll
    for (int d0 = 0; d0 < DQK / 16; ++d0) qr[d0] = *reinterpret_cast<const bf16x8*>(Qw + d0 * 16);
    constexpr int CPR = DQK / 8; constexpr bool K2 = (64 * CPR > 512);
    const int vkey = tid >> 3, vc = (tid & 7) * 8, vst = v_st(vkey, vc);
    const int k0key = tid / CPR, k0c = tid % CPR, k1id = tid + 512, k1key = k1id / CPR, k1c = k1id % CPR; const bool k1on = K2 && (k1id < 64 * CPR);
    const int vb0 = (int)(uintptr_t)V_lds + v_rd_base(lane);
    const int qrow = 4 * A.band + (wid >> 1), qc = 32 * (wid & 1) + r32;
    bf16x8 sv, sk0, sk1 = {};
#define TROW(t) (((t) < 4) ? (A.ctx0 + 64 * (t)) : (A.loc0 + 64 * ((t) - 4)))
#define SLOAD(t) do { const int _r0 = TROW(t); sv = *reinterpret_cast<const bf16x8*>(A.V + (size_t)(_r0 + vkey) * 512 + A.vcol + vc); \
        sk0 = *reinterpret_cast<const bf16x8*>(A.K + (size_t)(_r0 + k0key) * A.ldk + A.kcol + k0c * 8); \
        if (k1on) sk1 = *reinterpret_cast<const bf16x8*>(A.K + (size_t)(_r0 + k1key) * A.ldk + A.kcol + k1c * 8); } while (0)
#define SWRITE(b) do { *reinterpret_cast<bf16x8*>(V_lds + (b) * SHM_V + vst) = sv; *reinterpret_cast<bf16x8*>(K_lds + (b) * SHM_K + KSWZ(k0key, k0c * 16)) = sk0; \
        if (k1on) *reinterpret_cast<bf16x8*>(K_lds + (b) * SHM_K + KSWZ(k1key, k1c * 16)) = sk1; } while (0)
#define RESC(a) do { if (__any((a) < 1.f)) { if (hi == 0) al_l[r32] = (a); asm volatile("s_waitcnt lgkmcnt(0)" ::: "memory"); \
        _Pragma("unroll") for (int d = 0; d < 2; ++d) _Pragma("unroll") for (int r = 0; r < 16; ++r) o[d][r] *= al_l[crow(r, hi)]; } } while (0)
#define MASK(P0, P1, t) do { if (A.masked && (t) >= 4) na_mask(P0, P1, bt, mk, A.krow0 + (t) - 4, qrow, qc, hi); } while (0)
    f32x16 pA0, pA1, pB0, pB1; float alA, alB; bf16x8 pa0, pa1, pa2, pa3; const int NT = A.NT;
    SLOAD(0); SWRITE(0); __syncthreads();
    qkt<DQK>(pA0, pA1, K_lds, qr, r32, hi); MASK(pA0, pA1, 0); partialSM(pA0, pA1, m_reg, alA, C, THRS);
    SLOAD(1); SWRITE(1); __syncthreads();
    for (int j = 1; j + 1 < NT; j += 2) {
        SBAR(); qkt<DQK>(pB0, pB1, K_lds + SHM_K, qr, r32, hi); MASK(pB0, pB1, j);
        finishSM(pA0, pA1, alA, l_reg, pa0, pa1, pa2, pa3); SBAR();
        SLOAD(j + 1); SBAR();
        pv_all(o, vb0, pa0, pa1, pa2, pa3); partialSM(pB0, pB1, m_reg, alB, C, THRS);
        __syncthreads(); SWRITE(0);
        RESC(alB); __syncthreads();
        SBAR(); qkt<DQK>(pA0, pA1, K_lds, qr, r32, hi); MASK(pA0, pA1, j + 1);
        finishSM(pB0, pB1, alB, l_reg, pa0, pa1, pa2, pa3); SBAR();
        SLOAD(j + 2); SBAR();
        pv_all(o, vb0 + SHM_V, pa0, pa1, pa2, pa3); partialSM(pA0, pA1, m_reg, alA, C, THRS);
        __syncthreads(); SWRITE(1);
        RESC(alA); __syncthreads();
    }
    SBAR(); qkt<DQK>(pB0, pB1, K_lds + SHM_K, qr, r32, hi); MASK(pB0, pB1, NT - 1);
    finishSM(pA0, pA1, alA, l_reg, pa0, pa1, pa2, pa3); SBAR();
    pv_all(o, vb0, pa0, pa1, pa2, pa3); partialSM(pB0, pB1, m_reg, alB, C, THRS);
    __syncthreads(); RESC(alB);
    finishSM(pB0, pB1, alB, l_reg, pa0, pa1, pa2, pa3); SBAR();
    pv_all(o, vb0 + SHM_V, pa0, pa1, pa2, pa3);
    if (hi == 0) li_l[r32] = l_reg; asm volatile("s_waitcnt lgkmcnt(0)" ::: "memory");
    float rli[16];
#pragma unroll
    for (int r = 0; r < 16; ++r) rli[r] = __builtin_amdgcn_rcpf(li_l[crow(r, hi)]);
    bf16_t* stg = (bf16_t*)(lds + LDS_OST) + wid * 2048;
#pragma unroll
    for (int r = 0; r < 16; ++r) { const int orow = crow(r, hi);
#pragma unroll
        for (int d0 = 0; d0 < 2; ++d0) { const unsigned w = cvt_pk_bf16(o[d0][r] * rli[r], 0.f); stg[orow * 64 + d0 * 32 + r32] = (bf16_t)(w & 0xffffu); } }
    asm volatile("s_waitcnt lgkmcnt(0)" ::: "memory");
    bf16_t* Ow = A.O + (size_t)(A.q0 + wid * QBLK) * 512 + A.ocol;
#pragma unroll
    for (int i = 0; i < 4; ++i) { const int row = i * 8 + (lane >> 3), ch = lane & 7; const u32x4 v = *(const u32x4*)(stg + row * 64 + ch * 8); *(u32x4*)(Ow + (size_t)row * 512 + ch * 8) = v; }
    __syncthreads();
#undef TROW
#undef SLOAD
#undef SWRITE
#undef RESC
#undef MASK
}
#undef KSWZ
#undef SBAR
}
struct Frame {
    LAS unsigned char* lds;
    int tid, lane, wave, vcu, G;
};
#define CAS __attribute__((address_space(4)))
__device__ __forceinline__ const CAS char* karg() { return (const CAS char*)__builtin_amdgcn_kernarg_segment_ptr(); }
template <int I> __device__ __forceinline__ const float* in_ptr() { unsigned off = I * 8; asm volatile("" : "+s"(off)); return *(const float* const CAS*)(karg() + off); }
__device__ __forceinline__ float* out_ptr() { unsigned off = 26 * 8; asm volatile("" : "+s"(off)); return *(float* const CAS*)(karg() + off); }
__device__ __forceinline__ unsigned char* ws_ptr() { unsigned off = 27 * 8; asm volatile("" : "+s"(off)); return *(unsigned char* const CAS*)(karg() + off); }
enum { I_X = 0, I_C, I_CTX, I_CCTX, I_WADA, I_BADA, I_NMIXG, I_NFFNG, I_WIN, I_NAQG, I_NAKG, I_RPB, I_CQG, I_WUQ, I_CKVG, I_WUKV, I_QG, I_KG, I_WOA, I_WOB, I_WOUT, I_WR, I_RB, I_W1, I_W3, I_W2 };

#define LDS_WAIT() asm volatile("s_waitcnt lgkmcnt(0)" ::: "memory")

__device__ __forceinline__ int win_src_col(int np) {
    const int pn = np >> 8, cc = np & 255;
    if (pn < 4) { const int part = pn >> 1, tq = pn & 1, bj = cc >> 7, wc = (cc >> 5) & 3, i = cc & 31; return part * 512 + (4 * tq + wc) * 64 + 32 * bj + i; }
    if (pn < 6) return 1024 + (pn - 4) * 256 + cc;
    if (pn == 6) return 1536 + cc;
    if (pn == 7) return cc < 128 ? 1792 + cc : (cc < 160 ? 2176 + (cc - 128) : -1);
    if (pn == 8) return 1920 + cc;
    return 2208 + (pn - 9) * 256 + cc;
}
__device__ __forceinline__ void conv_item(const float* src, size_t ld, int dcol, int dstep, const float* gain, bf16_t* WT, int K, int k0, int n0, LAS float* scr, int lane) {
    const int kr = lane >> 4;
#pragma unroll 4
    for (int i = 0; i < 16; ++i) { const int kk = 4 * i + kr;
        f32x4 v = (f32x4){0.f, 0.f, 0.f, 0.f};
        if (src) v = *(const f32x4*)(src + (size_t)(k0 + kk) * ld);
        if (gain) v = v * gain[k0 + kk];
        LAS float* s = scr + kk * 65 + dcol; s[0] = v[0]; s[dstep] = v[1]; s[2 * dstep] = v[2]; s[3 * dstep] = v[3]; }
    LDS_WAIT(); asm volatile("" ::: "memory");
    const int c = lane & 7;
#pragma unroll
    for (int j = 0; j < 8; ++j) { const int n = (lane >> 3) + 8 * j; const LAS float* s = scr + (8 * c) * 65 + n;
        u32x4 o; o.x = cvt_pk_bf16(s[0 * 65], s[1 * 65]); o.y = cvt_pk_bf16(s[2 * 65], s[3 * 65]); o.z = cvt_pk_bf16(s[4 * 65], s[5 * 65]); o.w = cvt_pk_bf16(s[6 * 65], s[7 * 65]);
        *(u32x4*)(WT + (size_t)(n0 + n) * K + k0 + 8 * c) = o; }
    LDS_WAIT(); asm volatile("" ::: "memory");
}
__device__ __forceinline__ void p0_convert(Frame& F) {
    LAS float* scr = (LAS float*)(F.lds + F.wave * 16640);
    const int gw = F.vcu * 8 + F.wave, NGW = F.G * 8, lane = F.lane, q16 = lane & 15;
    constexpr int I_IN = 16 * 68, I_UQ = 6 * 16, I_UKV = 4 * 16, I_OA = 8 * 16, I_OUT = 16 * 16, I_13 = 16 * 32 * NEXP, I_2 = 16 * 16 * NEXP;
    constexpr int PER_L = I_IN + I_UQ + I_UKV + 2 * I_OA + I_OUT + I_13 + I_2;
    unsigned char* const ws = ws_ptr();
    for (int it = gw; it < NLAYER * PER_L; it += NGW) {
        const int l = it / PER_L; int r = it - l * PER_L;
        if (r < I_IN) { const int kb = r / 68, nb = r % 68, sc = win_src_col(nb * 64 + 4 * q16);
            conv_item(sc >= 0 ? in_ptr<I_WIN>() + (size_t)l * DM * INC + sc : nullptr, INC, 4 * q16, 1, nullptr, (bf16_t*)(ws + WS_WIN) + (size_t)l * INP * DM, DM, kb * 64, nb * 64, scr, lane); continue; } r -= I_IN;
        if (r < I_UQ) { const int kb = r / 16, nb = r % 16, np = nb * 64 + 4 * q16, hh = np >> 7, dd = np & 127;
            conv_item(dd < QKD ? in_ptr<I_WUQ>() + (size_t)l * QLORA * 768 + hh * QKD + dd : nullptr, 768, 4 * q16, 1, in_ptr<I_CQG>() + l * QLORA, (bf16_t*)(ws + WS_WUQ) + (size_t)l * 1024 * QLORA, QLORA, kb * 64, nb * 64, scr, lane); continue; } r -= I_UQ;
        if (r < I_UKV) { const int kb = r / 16, nb = r % 16;
            conv_item(in_ptr<I_WUKV>() + (size_t)l * KVLORA * 1024 + nb * 64 + 4 * q16, 1024, 4 * q16, 1, in_ptr<I_CKVG>() + l * KVLORA, (bf16_t*)(ws + WS_WUKV) + (size_t)l * 1024 * KVLORA, KVLORA, kb * 64, nb * 64, scr, lane); continue; } r -= I_UKV;
        if (r < 2 * I_OA) { const int w = r / I_OA, rr = r % I_OA, kb = rr / 16, nb = rr % 16;
            conv_item((w ? in_ptr<I_WOB>() : in_ptr<I_WOA>()) + (size_t)l * 512 * DM + nb * 64 + 4 * q16, DM, 4 * q16, 1, nullptr, (bf16_t*)(ws + (w ? WS_WOB : WS_WOA)) + (size_t)l * 1024 * 512, 512, kb * 64, nb * 64, scr, lane); continue; } r -= 2 * I_OA;
        if (r < I_OUT) { const int kb = r / 16, nb = r % 16;
            conv_item(in_ptr<I_WOUT>() + (size_t)l * DM * DM + nb * 64 + 4 * q16, DM, 4 * q16, 1, nullptr, (bf16_t*)(ws + WS_WOUT) + (size_t)l * DM * DM, DM, kb * 64, nb * 64, scr, lane); continue; } r -= I_OUT;
        if (r < I_13) { const int e = r / 512, rr = r % 512, kb = rr / 32, nb = rr % 32;
            const float* base = ((q16 < 8) ? in_ptr<I_W1>() : in_ptr<I_W3>()) + ((size_t)l * NEXP + e) * DM * DM + nb * 32 + 4 * (q16 & 7);
            conv_item(base, DM, 8 * (q16 & 7) + (q16 >> 3), 2, nullptr, (bf16_t*)(ws + WS_W13) + ((size_t)l * NEXP + e) * 2048 * DM, DM, kb * 64, nb * 64, scr, lane); continue; } r -= I_13;
        { const int e = r / 256, rr = r % 256, kb = rr / 16, nb = rr % 16;
            conv_item(in_ptr<I_W2>() + ((size_t)l * NEXP + e) * DM * DM + nb * 64 + 4 * q16, DM, 4 * q16, 1, nullptr, (bf16_t*)(ws + WS_W2) + ((size_t)l * NEXP + e) * DM * DM, DM, kb * 64, nb * 64, scr, lane); }
    }
}
__device__ __forceinline__ void p0_ada(Frame& F) {
    if ((int)blockIdx.x >= 2 * 96) return;
    unsigned char* const ws = ws_ptr(); const float* const cin = in_ptr<I_C>(); const float* const cctx = in_ptr<I_CCTX>(); const float* const wada = in_ptr<I_WADA>(); const float* const bada = in_ptr<I_BADA>();
    LAS float* sct = (LAS float*)F.lds;
    LAS float* red = (LAS float*)(F.lds + 1024 * 20 * 4);
    for (int idx = F.tid; idx < 17 * 1024; idx += 512) { const int r = idx >> 10, d = idx & 1023; const float v = (r < 16) ? cin[r * DM + d] : cctx[d]; sct[d * 20 + r] = v * (1.0f / (1.0f + expf(-v))); }
    __syncthreads();
    float* MOD = (float*)(ws + WS_MOD);
    for (int task = blockIdx.x; task < 2 * 96; task += F.G) {
        const int l = task / 96, cb = task % 96, col = cb * 64 + F.lane;
        const float* wa = wada + (size_t)l * DM * NMODC + col;
        float acc[17];
#pragma unroll
        for (int r = 0; r < 17; ++r) acc[r] = 0.f;
        for (int k = F.wave * 128; k < F.wave * 128 + 128; ++k) { const float wv = wa[(size_t)k * NMODC];
#pragma unroll
            for (int r = 0; r < 17; ++r) acc[r] += sct[k * 20 + r] * wv; }
#pragma unroll
        for (int r = 0; r < 17; ++r) red[(F.wave * 17 + r) * 64 + F.lane] = acc[r];
        __syncthreads();
        for (int idx = F.tid; idx < 17 * 64; idx += 512) { const int r = idx >> 6, cl = idx & 63; float s = bada[l * NMODC + cb * 64 + cl];
#pragma unroll
            for (int w = 0; w < 8; ++w) s += red[(w * 17 + r) * 64 + cl];
            MOD[((size_t)l * 17 + r) * NMODC + cb * 64 + cl] = s; }
        __syncthreads();
    }
    if (blockIdx.x == 0) { float* rope = (float*)(ws + WS_ROPE); const int pos = F.tid >> 3, i = F.tid & 7;
        const float inv = exp2f(-(float)i * 0.125f * 13.287712379549449f);
        const float ang = (float)pos * inv; const float rev = ang * 0.15915494309189535f, fr = rev - floorf(rev); rope[pos * 8 + i] = __builtin_amdgcn_cosf(fr); rope[512 + pos * 8 + i] = __builtin_amdgcn_sinf(fr); }
}

__device__ __forceinline__ void load_row(const float* xrow, int lane, f32x4 (&v)[4]) {
#pragma unroll
    for (int j = 0; j < 4; ++j) v[j] = *((const f32x4*)xrow + lane + 64 * j);
}
__device__ __forceinline__ float row_rstd(const f32x4 (&v)[4]) {
    float s = 0.f;
#pragma unroll
    for (int j = 0; j < 4; ++j) s += (v[j][0] * v[j][0] + v[j][1] * v[j][1]) + (v[j][2] * v[j][2] + v[j][3] * v[j][3]);
    return rsqrtf(wave_sum(s) * (1.0f / DM) + RMS_EPS);
}
__device__ __forceinline__ void normmod(const f32x4 (&v)[4], float rstd, const float* g, const float* sh, const float* sc, int lane, f32x4 (&h)[4]) {
#pragma unroll
    for (int j = 0; j < 4; ++j) { const f32x4 gv = *((const f32x4*)g + lane + 64 * j), shv = *((const f32x4*)sh + lane + 64 * j), scv = *((const f32x4*)sc + lane + 64 * j);
        h[j] = v[j] * rstd * gv * (scv + 1.0f) + shv; }
}
__device__ __forceinline__ void store_row_bf16(bf16_t* orow, int lane, const f32x4 (&h)[4]) {
#pragma unroll
    for (int j = 0; j < 4; ++j) { u32x2 w; w.x = cvt_pk_bf16(h[j][0], h[j][1]); w.y = cvt_pk_bf16(h[j][2], h[j][3]); *((u32x2*)orow + lane + 64 * j) = w; }
}
__device__ __forceinline__ void p0_hrows(Frame& F) {
    unsigned char* const ws = ws_ptr(); const float* const xin = in_ptr<I_X>(); const float* const cxin = in_ptr<I_CTX>(); const float* const gmix = in_ptr<I_NMIXG>();
    const int gw = F.vcu * 8 + F.wave, NGW = F.G * 8; const float* MOD = (const float*)(ws + WS_MOD); bf16_t* H = (bf16_t*)(ws + WS_H);
    for (int t = gw; t < TALL; t += NGW) {
        const float* xr = (t < TX) ? xin + (size_t)t * DM : cxin + (size_t)(t - TX) * DM;
        const float* md = MOD + (size_t)((t < TX) ? (t >> 11) : 16) * NMODC;
        f32x4 v[4], h[4]; load_row(xr, F.lane, v); const float rstd = row_rstd(v);
        normmod(v, rstd, gmix, md, md + DM, F.lane, h); store_row_bf16(H + (size_t)t * DM, F.lane, h);
    }
}
__device__ __forceinline__ void stats_phase(Frame& F, int ntok) {
    unsigned char* const ws = ws_ptr();
    const int gw = F.vcu * 8 + F.wave, NGW = F.G * 8, lane = F.lane;
    const bf16_t* ZCQ = (const bf16_t*)(ws + WS_ZCQ); const bf16_t* ZCKV = (const bf16_t*)(ws + WS_ZCKV); const bf16_t* ZKR = (const bf16_t*)(ws + WS_ZKR);
    float* RSCQ = (float*)(ws + WS_RSCQ); float* RSCKV = (float*)(ws + WS_RSCKV); float* SSKR = (float*)(ws + WS_SSKR);
    for (int t = gw; t < ntok; t += NGW) {
        float a = 0.f, b = 0.f, c = 0.f;
        if (lane < 48) { const u32x4 w = *(const u32x4*)(ZCQ + (size_t)t * QLORA + 8 * lane); a = (bf_lo(w.x) * bf_lo(w.x) + bf_hi(w.x) * bf_hi(w.x)) + (bf_lo(w.y) * bf_lo(w.y) + bf_hi(w.y) * bf_hi(w.y)) + (bf_lo(w.z) * bf_lo(w.z) + bf_hi(w.z) * bf_hi(w.z)) + (bf_lo(w.w) * bf_lo(w.w) + bf_hi(w.w) * bf_hi(w.w)); }
        if (lane < 32) { const u32x4 w = *(const u32x4*)(ZCKV + (size_t)t * KVLORA + 8 * lane); b = (bf_lo(w.x) * bf_lo(w.x) + bf_hi(w.x) * bf_hi(w.x)) + (bf_lo(w.y) * bf_lo(w.y) + bf_hi(w.y) * bf_hi(w.y)) + (bf_lo(w.z) * bf_lo(w.z) + bf_hi(w.z) * bf_hi(w.z)) + (bf_lo(w.w) * bf_lo(w.w) + bf_hi(w.w) * bf_hi(w.w)); }
        if (lane < 4) { const u32x4 w = *(const u32x4*)(ZKR + (size_t)t * ROPED + 8 * lane); c = (bf_lo(w.x) * bf_lo(w.x) + bf_hi(w.x) * bf_hi(w.x)) + (bf_lo(w.y) * bf_lo(w.y) + bf_hi(w.y) * bf_hi(w.y)) + (bf_lo(w.z) * bf_lo(w.z) + bf_hi(w.z) * bf_hi(w.z)) + (bf_lo(w.w) * bf_lo(w.w) + bf_hi(w.w) * bf_hi(w.w)); }
        a = wave_sum(a); b = wave_sum(b); c = wave_sum(c);
        if (lane == 0) { RSCQ[t] = rsqrtf(a * (1.0f / QLORA) + RMS_EPS); RSCKV[t] = rsqrtf(b * (1.0f / KVLORA) + RMS_EPS); SSKR[t] = c; }
    }
}

__device__ __forceinline__ void route_phase(Frame& F, int l, int ntok) {
    unsigned char* const ws = ws_ptr(); const float* const xcur = out_ptr();
    LAS float* h2t = (LAS float*)F.lds;
    LAS float* part = (LAS float*)(F.lds + 65536);
    LAS float* logit = (LAS float*)(F.lds + 65536 + 32768);
    const float* MOD = (const float*)(ws + WS_MOD) + (size_t)l * 17 * NMODC; const float* XC = (const float*)(ws + WS_XC);
    const float* g = in_ptr<I_NFFNG>() + l * DM; const float* wr = in_ptr<I_WR>(); const float rbias = in_ptr<I_RB>()[F.lane];
    int* TOKE = (int*)(ws + WS_TOKE); float* TOKW = (float*)(ws + WS_TOKW); int* TOKP = (int*)(ws + WS_TOKP); float* RSTD2 = (float*)(ws + WS_RSTD2);
    unsigned* cnt = (unsigned*)(ws + WS_CTL) + CW_CNT + l * 2048;
    const int lane = F.lane, w = F.wave;
    for (int it = blockIdx.x; it < ntok / 16; it += F.G) {
        const int T0 = it * 16;
#pragma unroll
        for (int tt = 0; tt < 2; ++tt) { const int tl = 2 * w + tt, t = T0 + tl;
            const float* xr = (t < TX) ? xcur + (size_t)t * DM : XC + (size_t)(t - TX) * DM; const float* md = MOD + (size_t)((t < TX) ? (t >> 11) : 16) * NMODC;
            f32x4 v[4], h[4]; load_row(xr, lane, v); const float rstd = row_rstd(v); if (lane == 0) RSTD2[t] = rstd;
            normmod(v, rstd, g, md + 3 * DM, md + 4 * DM, lane, h);
#pragma unroll
            for (int j = 0; j < 4; ++j)
#pragma unroll
                for (int q = 0; q < 4; ++q) h2t[(4 * lane + 256 * j + q) * 16 + tl] = h[j][q];
        }
        __syncthreads();
        { float acc[16];
#pragma unroll
          for (int t = 0; t < 16; ++t) acc[t] = 0.f;
          for (int d = w * 128; d < w * 128 + 128; ++d) { const float wv = wr[d * NEXP + lane];
              const f32x4 h0 = *(const LAS f32x4*)(h2t + d * 16), h1 = *(const LAS f32x4*)(h2t + d * 16 + 4), h2 = *(const LAS f32x4*)(h2t + d * 16 + 8), h3 = *(const LAS f32x4*)(h2t + d * 16 + 12);
#pragma unroll
              for (int q = 0; q < 4; ++q) { acc[q] += h0[q] * wv; acc[4 + q] += h1[q] * wv; acc[8 + q] += h2[q] * wv; acc[12 + q] += h3[q] * wv; } }
#pragma unroll
          for (int t = 0; t < 16; ++t) part[(w * 16 + t) * 64 + lane] = acc[t]; }
        __syncthreads();
#pragma unroll
        for (int k = 0; k < 2; ++k) { const int idx = F.tid + 512 * k, t = idx >> 6, e = idx & 63; float s = 0.f;
#pragma unroll
            for (int ww = 0; ww < 8; ++ww) s += part[(ww * 16 + t) * 64 + e];
            logit[t * 64 + e] = s; }
        __syncthreads();
#pragma unroll
        for (int tt = 0; tt < 2; ++tt) { const int tl = 2 * w + tt, t = T0 + tl;
            const float sg = 1.0f / (1.0f + expf(-logit[tl * 64 + lane])); const float bs = sg + rbias;
            float m1 = -3.0e38f, m2 = -3.0e38f; int i1 = 0, i2 = 0;
#pragma unroll
            for (int j = 0; j < 8; ++j) { const float vv = __shfl(bs, (lane & ~7) + j); if (vv > m1) { m2 = m1; i2 = i1; m1 = vv; i1 = j; } else if (vv > m2) { m2 = vv; i2 = j; } }
            const float gs = m1 + m2; float best = -3.0e38f; int gsel = 0;
#pragma unroll
            for (int j = 0; j < 8; ++j) { const float vv = __shfl(gs, 8 * j); if (vv > best) { best = vv; gsel = j; } }
            const int e1 = gsel * 8 + __shfl(i1, gsel * 8), e2 = gsel * 8 + __shfl(i2, gsel * 8);
            const float s1 = __shfl(sg, e1), s2 = __shfl(sg, e2), inv = 1.0f / (s1 + s2);
            if (lane == 0) { const int p1 = (int)atomicAdd(cnt + e1 * 16, 1u), p2 = (int)atomicAdd(cnt + e2 * 16, 1u);
                TOKE[2 * t] = e1; TOKE[2 * t + 1] = e2; TOKW[2 * t] = s1 * inv; TOKW[2 * t + 1] = s2 * inv; TOKP[2 * t] = p1; TOKP[2 * t + 1] = p2; }
        }
        __syncthreads();
    }
}
__device__ __forceinline__ void expert_offsets(Frame& F, unsigned char* ws, int l, LAS int* offl, bool publish) {
    if (F.wave == 0) {
        const unsigned c = __hip_atomic_load((unsigned*)(ws + WS_CTL) + CW_CNT + l * 2048 + F.lane * 16, RLX_AGENT);
        const int pad = (int)((c + 255u) & ~255u); int incl = pad;
#pragma unroll
        for (int o = 1; o < 64; o <<= 1) { const int v = __shfl_up(incl, o); if (F.lane >= o) incl += v; }
        offl[F.lane] = incl - pad; if (F.lane == 63) offl[64] = incl;
        if (publish) { int* TILEE = (int*)(ws + WS_TILEE); for (int t = (incl - pad) >> 8; t < (incl >> 8); ++t) TILEE[t] = F.lane; if (F.lane == 63) TILEE[511] = incl >> 8; }
    }
    __syncthreads();
}
__device__ __forceinline__ void scatter_phase(Frame& F, int l, int ntok) {
    unsigned char* const ws = ws_ptr(); const float* const xcur = out_ptr();
    LAS int* offl = (LAS int*)(F.lds + 1024);
    expert_offsets(F, ws, l, offl, blockIdx.x == 0);
    const int gw = F.vcu * 8 + F.wave, NGW = F.G * 8, lane = F.lane;
    const float* MOD = (const float*)(ws + WS_MOD) + (size_t)l * 17 * NMODC; const float* XC = (const float*)(ws + WS_XC); const float* g = in_ptr<I_NFFNG>() + l * DM;
    const int* TOKE = (const int*)(ws + WS_TOKE); const int* TOKP = (const int*)(ws + WS_TOKP); const float* RSTD2 = (const float*)(ws + WS_RSTD2); bf16_t* HS = (bf16_t*)(ws + WS_HS);
    for (int t = gw; t < ntok; t += NGW) {
        const float* xr = (t < TX) ? xcur + (size_t)t * DM : XC + (size_t)(t - TX) * DM; const float* md = MOD + (size_t)((t < TX) ? (t >> 11) : 16) * NMODC;
        f32x4 v[4], h[4]; load_row(xr, lane, v); normmod(v, RSTD2[t], g, md + 3 * DM, md + 4 * DM, lane, h);
        const int s1 = offl[TOKE[2 * t]] + TOKP[2 * t], s2 = offl[TOKE[2 * t + 1]] + TOKP[2 * t + 1];
        store_row_bf16(HS + (size_t)s1 * DM, lane, h); store_row_bf16(HS + (size_t)s2 * DM, lane, h);
    }
}
__device__ __forceinline__ void combine_phase(Frame& F, int l, int ntok, bool last) {
    unsigned char* const ws = ws_ptr(); float* const xcur = out_ptr();
    LAS int* offl = (LAS int*)(F.lds + 1024);
    expert_offsets(F, ws, l, offl, false);
    const int gw = F.vcu * 8 + F.wave, NGW = F.G * 8, lane = F.lane;
    const float* MOD = (const float*)(ws + WS_MOD) + (size_t)l * 17 * NMODC; float* XC = (float*)(ws + WS_XC);
    const int* TOKE = (const int*)(ws + WS_TOKE); const int* TOKP = (const int*)(ws + WS_TOKP); const float* TOKW = (const float*)(ws + WS_TOKW);
    const bf16_t* YS = (const bf16_t*)(ws + WS_YS); bf16_t* H = (bf16_t*)(ws + WS_H);
    for (int t = gw; t < ntok; t += NGW) {
        float* xr = (t < TX) ? xcur + (size_t)t * DM : XC + (size_t)(t - TX) * DM; const int bi = (t < TX) ? (t >> 11) : 16; const float* md = MOD + (size_t)bi * NMODC;
        const int s1 = offl[TOKE[2 * t]] + TOKP[2 * t], s2 = offl[TOKE[2 * t + 1]] + TOKP[2 * t + 1]; const float w1 = TOKW[2 * t], w2 = TOKW[2 * t + 1];
        f32x4 v[4]; load_row(xr, lane, v);
#pragma unroll
        for (int j = 0; j < 4; ++j) { const u32x2 a = *((const u32x2*)(YS + (size_t)s1 * DM) + lane + 64 * j), b = *((const u32x2*)(YS + (size_t)s2 * DM) + lane + 64 * j);
            const f32x4 gf = *((const f32x4*)(md + 5 * DM) + lane + 64 * j);
            const f32x4 y = (f32x4){bf_lo(a.x), bf_hi(a.x), bf_lo(a.y), bf_hi(a.y)} * w1 + (f32x4){bf_lo(b.x), bf_hi(b.x), bf_lo(b.y), bf_hi(b.y)} * w2;
            v[j] = v[j] + gf * y; *((f32x4*)xr + lane + 64 * j) = v[j]; }
        if (!last) { const float* md2 = MOD + (size_t)17 * NMODC + (size_t)bi * NMODC; f32x4 h[4]; const float rstd = row_rstd(v);
            normmod(v, rstd, in_ptr<I_NMIXG>() + (l + 1) * DM, md2, md2 + DM, lane, h); store_row_bf16(H + (size_t)t * DM, lane, h); }
    }
}
constexpr int NPHASE = 2 + 11 * NLAYER;
struct Args { const float* in[26]; float* out; unsigned char* ws; int ph_lo, ph_hi; };

__device__ __attribute__((noinline)) void grid_barrier_fn(GAS unsigned* barw, unsigned x, LAS unsigned* st) { XcdBarrier b; b.bar = (unsigned*)barw; b.x = x; b.st = (volatile LAS unsigned*)st; xcd_barrier(b); }

__global__ void __launch_bounds__(512, 2) fwd_kernel(Args args) {
    extern __shared__ __attribute__((aligned(16))) unsigned char lds_raw[];
    Frame F;
    F.lds = (LAS unsigned char*)lds_raw;
    F.tid = threadIdx.x; F.lane = F.tid & 63; F.wave = __builtin_amdgcn_readfirstlane(F.tid >> 6);
    F.G = gridDim.x; { const int bx = blockIdx.x; F.vcu = (F.G % 8 == 0) ? (bx % 8) * (F.G / 8) + bx / 8 : bx; }
    volatile LAS unsigned* MISC = (volatile LAS unsigned*)(F.lds + MISC_OFF);
    if (F.tid < 64) MISC[F.tid] = 0u;
    __syncthreads();
    const int lo = args.ph_lo, hi = args.ph_hi;
#if MK_SPLIT
#define GRID_BAR() do { } while (0)
#else
    XcdBarrier bar = xcd_barrier_post((unsigned*)(ws_ptr() + WS_CTL) + CW_BAR, MISC + 8);
#define GRID_BAR() grid_barrier_fn((GAS unsigned*)bar.bar, bar.x, (LAS unsigned*)bar.st)
#endif
#ifndef PH_MASK
#define PH_MASK 0xFFFFFFFFu
#endif
#define PHK(k) ((k) < 2 ? (k) : 2 + ((k) - 2) % 11)
#define IN(k) (((PH_MASK >> PHK(k)) & 1u) && lo <= (k) && (k) < hi)
#define SEAM(k) do { if (IN(k) && IN((k) + 1)) GRID_BAR(); } while (0)
#define FRESH() Frame Fp = F; int G = F.G, c = (int)blockIdx.x; asm volatile("" : "+v"(Fp.tid), "+v"(Fp.lane)); asm volatile("" : "+s"(Fp.wave), "+s"(Fp.vcu), "+s"(Fp.G), "+s"(G), "+s"(c))

    if (IN(0)) { FRESH(); (void)G; (void)c; p0_convert(Fp); __syncthreads(); p0_ada(Fp); }
    SEAM(0);
    if (IN(1)) { FRESH(); (void)G; (void)c; p0_hrows(Fp); }
    SEAM(1);

    for (int l = 0; l < NLAYER; ++l) {
        const int base = 2 + 11 * l; const bool last = (l == NLAYER - 1);
        const int mt_act = last ? MT_X : MT_ALL;
        const int ntok = last ? TX : TALL;
        if (IN(base + 0)) {
            FRESH(); unsigned char* const ws = ws_ptr();
            pg8::SchedRect S{(const char*)(ws + WS_H), (const char*)((bf16_t*)(ws + WS_WIN) + (size_t)l * INP * DM), (size_t)256 * DM * 2, mt_act, 17, G, c, MT_ALL - mt_act, 2, 7};
            pg8::EpiIn E{(bf16_t*)(ws + WS_QA), (bf16_t*)(ws + WS_KA), (bf16_t*)(ws + WS_VA), (bf16_t*)(ws + WS_ZCQ), (bf16_t*)(ws + WS_ZCKV), (bf16_t*)(ws + WS_ZKR), (bf16_t*)(ws + WS_GATES),
                         in_ptr<I_NAQG>() + l * 64, in_ptr<I_NAKG>() + l * 64};
            pg8::gemm_phase(Fp.lds, DM, S, E);
        }
        SEAM(base + 0);
        if (IN(base + 1)) { FRESH(); (void)G; (void)c; stats_phase(Fp, TALL); }
        SEAM(base + 1);
        if (IN(base + 2)) {
            FRESH();
#ifndef NO_EQ
            { unsigned char* const ws = ws_ptr();
              pg8::SchedRect S{(const char*)(ws + WS_ZCQ), (const char*)((bf16_t*)(ws + WS_WUQ) + (size_t)l * 1024 * QLORA), (size_t)256 * QLORA * 2, mt_act, 4, G, c, 0, 0, 1};
              pg8::EpiQ E{(bf16_t*)(ws + WS_QB), (const float*)(ws + WS_RSCQ), in_ptr<I_QG>() + l * QKD, (const float*)(ws + WS_ROPE), (LAS float*)(Fp.lds + EPI_OFF)};
              pg8::gemm_phase(Fp.lds, QLORA, S, E); }
#endif
#ifndef NO_EKV
            { unsigned char* const ws = ws_ptr();
              pg8::SchedRect S{(const char*)(ws + WS_ZCKV), (const char*)((bf16_t*)(ws + WS_WUKV) + (size_t)l * 1024 * KVLORA), (size_t)256 * KVLORA * 2, MT_ALL, 4, G, c, 0, 0, 1};
              pg8::EpiKV E{(bf16_t*)(ws + WS_KB), (bf16_t*)(ws + WS_VB), (const bf16_t*)(ws + WS_ZKR), (const float*)(ws + WS_RSCKV), (const float*)(ws + WS_SSKR), in_ptr<I_KG>() + l * QKD, (const float*)(ws + WS_ROPE), (LAS float*)(Fp.lds + EPI_OFF)};
              pg8::gemm_phase(Fp.lds, KVLORA, S, E); }
#endif
        }
        SEAM(base + 2);
        if (IN(base + 3)) {
            FRESH(); (void)c;
            const float C64 = 0.125f * 1.4426950408889634f, C96 = 0.10206207261596575f * 1.4426950408889634f;
            { unsigned char* const ws = ws_ptr();
              for (int u = Fp.vcu; u < 1024 + 256; u += G) {
                att::UnitArgs A; A.Q = (const bf16_t*)(ws + WS_QB); A.ldq = 768; A.K = (const bf16_t*)(ws + WS_KB); A.ldk = 768; A.V = (const bf16_t*)(ws + WS_VB); A.O = (bf16_t*)(ws + WS_OB);
                A.masked = 0; A.band = 0; A.krow0 = 0; A.bias = nullptr; A.C = C96;
                if (u < 1024) { const int bh = u >> 3, qb = u & 7, b = bh >> 3, h = bh & 7;
                    A.qcol = h * QKD; A.kcol = h * QKD; A.vcol = h * 64; A.ocol = h * 64; A.q0 = b * SEQ + qb * 256; A.ctx0 = TX + b * CTXL; A.loc0 = b * SEQ; A.NT = 36; }
                else { const int v = u - 1024; if (last || !(v & 1)) continue; const int bh = v >> 1, b = bh >> 3, h = bh & 7;
                    A.qcol = h * QKD; A.kcol = h * QKD; A.vcol = h * 64; A.ocol = h * 64; A.q0 = TX + b * CTXL; A.ctx0 = TX + b * CTXL; A.loc0 = 0; A.NT = 4; }
                att::attn_unit<96>(A, (char*)lds_raw);
              } }
            { unsigned char* const ws = ws_ptr(); const float* const rpb = in_ptr<I_RPB>();
              att::na_mask_table((char*)lds_raw);
              for (int u = Fp.vcu; u < 1024 + 256; u += G) {
                att::UnitArgs A; A.Q = (const bf16_t*)(ws + WS_QA); A.ldq = 512; A.K = (const bf16_t*)(ws + WS_KA); A.ldk = 512; A.V = (const bf16_t*)(ws + WS_VA); A.O = (bf16_t*)(ws + WS_OA); A.C = C64;
                if (u < 1024) { const int bh = u >> 3, band = u & 7, b = bh >> 3, h = bh & 7;
                    A.qcol = h * 64; A.kcol = h * 64; A.vcol = h * 64; A.ocol = h * 64; A.q0 = b * SEQ + band * 256; A.ctx0 = TX + b * CTXL;
                    A.krow0 = min(max(4 * band - 4, 0), 20); A.loc0 = b * SEQ + 64 * A.krow0; A.NT = 16; A.masked = 1; A.band = band; A.bias = rpb + ((size_t)l * NHEAD + h) * 15 * 31; }
                else { const int v = u - 1024; if (last || (v & 1)) continue; const int bh = v >> 1, b = bh >> 3, h = bh & 7;
                    A.qcol = h * 64; A.kcol = h * 64; A.vcol = h * 64; A.ocol = h * 64; A.q0 = TX + b * CTXL; A.ctx0 = TX + b * CTXL; A.loc0 = 0; A.NT = 4; A.masked = 0; A.band = 0; A.krow0 = 0; A.bias = nullptr; }
                att::attn_unit<64>(A, (char*)lds_raw);
              } }
        }
        SEAM(base + 3);
        if (IN(base + 4)) {
            FRESH(); unsigned char* const ws = ws_ptr();
            pg8::SchedMerge S{(const char*)(ws + WS_OA), (const char*)(ws + WS_OB), (const char*)((bf16_t*)(ws + WS_WOA) + (size_t)l * 1024 * 512), (const char*)((bf16_t*)(ws + WS_WOB) + (size_t)l * 1024 * 512),
                              (size_t)256 * 512 * 2, mt_act, 4, G, c};
            pg8::EpiMerge E{(const bf16_t*)(ws + WS_GATES), (bf16_t*)(ws + WS_Y)};
            pg8::gemm_phase(Fp.lds, 512, S, E);
        }
        SEAM(base + 4);
        if (IN(base + 5)) {
            FRESH(); unsigned char* const ws = ws_ptr(); float* const outp = out_ptr();
            pg8::SchedRect S{(const char*)(ws + WS_Y), (const char*)((bf16_t*)(ws + WS_WOUT) + (size_t)l * DM * DM), (size_t)256 * DM * 2, mt_act, 4, G, c, 0, 0, 1};
            pg8::EpiOut E{(l == 0) ? in_ptr<I_X>() : (const float*)outp, outp, in_ptr<I_CTX>(), (float*)(ws + WS_XC), (const float*)(ws + WS_MOD) + (size_t)l * 17 * NMODC, 2 * DM};
            pg8::gemm_phase(Fp.lds, DM, S, E);
        }
        SEAM(base + 5);
        if (IN(base + 6)) { FRESH(); (void)G; (void)c; route_phase(Fp, l, ntok); }
        SEAM(base + 6);
        if (IN(base + 7)) { FRESH(); (void)G; (void)c; scatter_phase(Fp, l, ntok); }
        SEAM(base + 7);
        if (IN(base + 8)) {
            FRESH(); unsigned char* const ws = ws_ptr();
            const int ntile = __builtin_amdgcn_readfirstlane(ld_i32_agent((const int*)(ws + WS_TILEE) + 511));
            pg8::SchedMoe S{(const char*)(ws + WS_HS), (const char*)((bf16_t*)(ws + WS_W13) + (size_t)l * NEXP * 2048 * DM), (size_t)256 * DM * 2, (size_t)2048 * DM * 2, (size_t)256 * DM * 2,
                            (const int*)(ws + WS_TILEE), ntile, 8, G, c};
            pg8::EpiMoe1 E{(bf16_t*)(ws + WS_HMID)};
            pg8::gemm_phase(Fp.lds, DM, S, E);
        }
        SEAM(base + 8);
        if (IN(base + 9)) {
            FRESH(); unsigned char* const ws = ws_ptr();
            const int ntile = __builtin_amdgcn_readfirstlane(ld_i32_agent((const int*)(ws + WS_TILEE) + 511));
            pg8::SchedMoe S{(const char*)(ws + WS_HMID), (const char*)((bf16_t*)(ws + WS_W2) + (size_t)l * NEXP * DM * DM), (size_t)256 * DM * 2, (size_t)DM * DM * 2, (size_t)256 * DM * 2,
                            (const int*)(ws + WS_TILEE), ntile, 4, G, c};
            pg8::EpiMoe2 E{(bf16_t*)(ws + WS_YS)};
            pg8::gemm_phase(Fp.lds, DM, S, E);
        }
        SEAM(base + 9);
        if (IN(base + 10)) { FRESH(); (void)G; (void)c; combine_phase(Fp, l, ntok, last); }
        if (!last) SEAM(base + 10);
    }
#undef IN
#undef SEAM
#undef GRID_BAR
}

extern "C" void kernel_launch(void* const* d_in, const int* in_sizes, int n_in, void* d_out, int out_size, void* d_ws, size_t ws_size, hipStream_t stream) {
    static int grid = 0;
    if (grid == 0) {
        if (n_in != 26 || out_size != TX * DM || ws_size < WS_END) { fprintf(stderr, "kernel_launch: unexpected problem (n_in %d, out %d, ws %zu < %zu); nothing launched\n", n_in, out_size, ws_size, (size_t)WS_END); grid = -1; return; }
        int dev = 0, cus = 0, per_cu = 0;
        if (hipGetDevice(&dev) != hipSuccess || hipDeviceGetAttribute(&cus, hipDeviceAttributeMultiprocessorCount, dev) != hipSuccess) { grid = -1; return; }
        if (hipFuncSetAttribute((const void*)fwd_kernel, hipFuncAttributeMaxDynamicSharedMemorySize, LDS_BYTES) != hipSuccess) { fprintf(stderr, "kernel_launch: hipFuncSetAttribute failed\n"); grid = -1; return; }
        if (hipOccupancyMaxActiveBlocksPerMultiprocessor(&per_cu, (const void*)fwd_kernel, 512, LDS_BYTES) != hipSuccess || per_cu < 1) fprintf(stderr, "kernel_launch: occupancy query reports %d blocks per CU\n", per_cu);
        (void)hipGetLastError();
        grid = cus;
    }
    if (grid < 0) return;
    (void)in_sizes;
    (void)hipMemsetAsync((char*)d_ws + WS_CTL, 0, CTL_BYTES, stream);
    Args a{};
    for (int i = 0; i < 26; ++i) a.in[i] = (const float*)d_in[i];
    a.out = (float*)d_out; a.ws = (unsigned char*)d_ws;
#if MK_SPLIT
    for (int p = 0; p < NPHASE; ++p) { a.ph_lo = p; a.ph_hi = p + 1; hipLaunchKernelGGL(fwd_kernel, dim3(grid), dim3(512), LDS_BYTES, stream, a); }
#else
    a.ph_lo = 0; a.ph_hi = NPHASE;
    hipLaunchKernelGGL(fwd_kernel, dim3(grid), dim3(512), LDS_BYTES, stream, a);
#endif
    const hipError_t le = hipPeekAtLastError();
    if (le != hipSuccess) fprintf(stderr, "kernel_launch: launch failed: %s\n", hipGetErrorName(le));
}
```

```cpp
#include <hip/hip_runtime.h>
#include <hip/hip_bf16.h>
#include <cstdio>
#include <cstdint>

#ifndef MK_SPLIT
#define MK_SPLIT 0
#endif

#define LAS __attribute__((address_space(3)))
#define GAS __attribute__((address_space(1)))
typedef unsigned short bf16_t;
typedef short bf16x8 __attribute__((ext_vector_type(8)));
typedef short s16x4 __attribute__((ext_vector_type(4)));
typedef float f32x4 __attribute__((ext_vector_type(4)));
typedef float f32x2 __attribute__((ext_vector_type(2)));
typedef float f32x16 __attribute__((ext_vector_type(16)));
typedef unsigned u32x4 __attribute__((ext_vector_type(4)));
typedef unsigned u32x2 __attribute__((ext_vector_type(2)));
#define RLX_AGENT __ATOMIC_RELAXED, __HIP_MEMORY_SCOPE_AGENT

constexpr int DM = 1024, NB = 16, SEQ = 2048, TX = NB * SEQ, CTXL = 256, TC = NB * CTXL, TALL = TX + TC;
constexpr int NHEAD = 8, GRIDW = 64;
constexpr int INC = 4256, INP = 4352;
constexpr int NEXP = 64, NMODC = 6 * DM;
constexpr int QLORA = 384, KVLORA = 256, QKD = 96, ROPED = 32;
constexpr int MT_X = TX / 256, MT_ALL = TALL / 256;
constexpr int NSLOT_MAX = 2 * TALL + NEXP * 256;
constexpr float RMS_EPS = 1e-6f;
constexpr int NLAYER = 2;

constexpr size_t al256(size_t x) { return (x + 255) & ~(size_t)255; }
constexpr size_t WS_CTL = 0, CTL_BYTES = 1u << 20;
constexpr size_t WS_MOD   = WS_CTL + CTL_BYTES;
constexpr size_t WS_ROPE  = WS_MOD + al256((size_t)NLAYER * 17 * NMODC * 4);
constexpr size_t WS_RSCQ  = WS_ROPE + al256(64 * 8 * 2 * 4);
constexpr size_t WS_RSCKV = WS_RSCQ + al256((size_t)TALL * 4);
constexpr size_t WS_SSKR  = WS_RSCKV + al256((size_t)TALL * 4);
constexpr size_t WS_TOKE  = WS_SSKR + al256((size_t)TALL * 4);
constexpr size_t WS_TOKW  = WS_TOKE + al256((size_t)TALL * 8);
constexpr size_t WS_TOKP  = WS_TOKW + al256((size_t)TALL * 8);
constexpr size_t WS_RSTD2 = WS_TOKP + al256((size_t)TALL * 8);
constexpr size_t WS_TILEE = WS_RSTD2 + al256((size_t)TALL * 4);
constexpr size_t WS_OFFS  = WS_TILEE + al256(512 * 4);
constexpr size_t WS_WIN   = WS_OFFS + al256(128 * 4);
constexpr size_t WS_WUQ   = WS_WIN + al256((size_t)NLAYER * INP * DM * 2);
constexpr size_t WS_WUKV  = WS_WUQ + al256((size_t)NLAYER * 1024 * QLORA * 2);
constexpr size_t WS_WOA   = WS_WUKV + al256((size_t)NLAYER * 1024 * KVLORA * 2);
constexpr size_t WS_WOB   = WS_WOA + al256((size_t)NLAYER * 1024 * 512 * 2);
constexpr size_t WS_WOUT  = WS_WOB + al256((size_t)NLAYER * 1024 * 512 * 2);
constexpr size_t WS_W13   = WS_WOUT + al256((size_t)NLAYER * 1024 * 1024 * 2);
constexpr size_t WS_W2    = WS_W13 + al256((size_t)NLAYER * NEXP * 2048 * 1024 * 2);
constexpr size_t WS_H     = WS_W2 + al256((size_t)NLAYER * NEXP * 1024 * 1024 * 2);
constexpr size_t WS_XC    = WS_H + al256((size_t)TALL * DM * 2);
constexpr size_t WS_ACT   = WS_XC + al256((size_t)TC * DM * 4);
constexpr size_t WS_QA    = WS_ACT;
constexpr size_t WS_KA    = WS_QA + al256((size_t)TALL * 512 * 2);
constexpr size_t WS_VA    = WS_KA + al256((size_t)TALL * 512 * 2);
constexpr size_t WS_ZCQ   = WS_VA + al256((size_t)TALL * 512 * 2);
constexpr size_t WS_ZCKV  = WS_ZCQ + al256((size_t)TALL * QLORA * 2);
constexpr size_t WS_ZKR   = WS_ZCKV + al256((size_t)TALL * KVLORA * 2);
constexpr size_t WS_GATES = WS_ZKR + al256((size_t)TALL * ROPED * 2);
constexpr size_t WS_QB    = WS_GATES + al256((size_t)TALL * 2048 * 2);
constexpr size_t WS_KB    = WS_QB + al256((size_t)TALL * 768 * 2);
constexpr size_t WS_VB    = WS_KB + al256((size_t)TALL * 768 * 2);
constexpr size_t WS_OA    = WS_VB + al256((size_t)TALL * 512 * 2);
constexpr size_t WS_OB    = WS_OA + al256((size_t)TALL * 512 * 2);
constexpr size_t WS_Y     = WS_OB + al256((size_t)TALL * 512 * 2);
constexpr size_t WS_MIX_END = WS_Y + al256((size_t)TALL * DM * 2);
constexpr size_t WS_HS    = WS_ACT;
constexpr size_t WS_HMID  = WS_HS + al256((size_t)NSLOT_MAX * DM * 2);
constexpr size_t WS_YS    = WS_HMID + al256((size_t)NSLOT_MAX * DM * 2);
constexpr size_t WS_MOE_END = WS_YS + al256((size_t)NSLOT_MAX * DM * 2);
constexpr size_t WS_END   = (WS_MIX_END > WS_MOE_END) ? WS_MIX_END : WS_MOE_END;

constexpr int CW_BAR = 4096;
constexpr int CW_CNT = 16384;

constexpr int RING_BYTES = 131072;
constexpr int EPI_OFF = RING_BYTES;
constexpr int MISC_OFF = RING_BYTES + 24576;
constexpr int LDS_BYTES = 160 * 1024;

__device__ __forceinline__ unsigned cvt_pk_bf16(float lo, float hi) { unsigned r; asm volatile("v_cvt_pk_bf16_f32 %0, %1, %2" : "=v"(r) : "v"(lo), "v"(hi)); return r; }
__device__ __forceinline__ float bf_lo(unsigned w) { return __uint_as_float(w << 16); }
__device__ __forceinline__ float bf_hi(unsigned w) { return __uint_as_float(w & 0xffff0000u); }
__device__ __forceinline__ float wave_sum(float v) {
#pragma unroll
    for (int o = 1; o < 64; o <<= 1) v += __shfl_xor(v, o);
    return v;
}
__device__ __forceinline__ float sigmoidf_(float x) { return __builtin_amdgcn_rcpf(1.0f + __expf(-x)); }
__device__ __forceinline__ int ld_i32_agent(const int* p) { return (int)__hip_atomic_load((const unsigned*)p, RLX_AGENT); }
#define XB_TMO      128
#define XB_XCNT(j)  (256  + 64 * (j))
#define XB_XSUB(j)  (1280 + 64 * (j))
#define XB_XGEN(j)  (2304 + 64 * (j))
#define XB_TOP      3328
#define XB_TOPGEN   3392
#define XCD_BAR_WORDS 3456
#define XB_SPIN_CAP (1u << 18)

__device__ __forceinline__ unsigned xb_ld(unsigned* p)              { return __hip_atomic_load(p, __ATOMIC_RELAXED, __HIP_MEMORY_SCOPE_AGENT); }
__device__ __forceinline__ unsigned xb_add(unsigned* p, unsigned v) { return __hip_atomic_fetch_add(p, v, __ATOMIC_RELAXED, __HIP_MEMORY_SCOPE_AGENT); }
__device__ __forceinline__ unsigned xb_xcc_id() { return (unsigned)__builtin_amdgcn_s_getreg((3 << 11) | 20) & 0xFu; }
#define XB_SPIN(cond, bar) do { unsigned _sp = 0; while (cond) { __builtin_amdgcn_s_sleep(1); \
    if ((++_sp & 255u) == 0u) { if (xb_ld(&(bar)[XB_TMO])) break; if (_sp > XB_SPIN_CAP) { atomicAdd(&(bar)[XB_TMO], 1u); break; } } } } while (0)

struct XcdBarrier {
    unsigned* bar; unsigned x;
    volatile LAS unsigned* st;
};

__device__ __forceinline__ XcdBarrier xcd_barrier_post(unsigned* bar, volatile LAS unsigned* st) {
    XcdBarrier b; b.bar = bar; b.x = xb_xcc_id(); b.st = st;
    if (threadIdx.x == 0) (void)xb_add(&bar[XB_XCNT(b.x)], 1u);
    return b;
}
__device__ __forceinline__ void xcd_barrier_complete(unsigned* bar, unsigned x, unsigned& nloc, unsigned& nx) {
    const unsigned G = gridDim.x * gridDim.y * gridDim.z;
    unsigned sum, cnt, mine, sp = 0u;
    for (;;) {
        sum = 0u; cnt = 0u; mine = 0u;
#pragma unroll
        for (unsigned j = 0; j < 16; ++j) { const unsigned c = xb_ld(&bar[XB_XCNT(j)]); sum += c; cnt += (c > 0u) ? 1u : 0u; mine = (j == x) ? c : mine; }
        if (sum == G) break;
        __builtin_amdgcn_s_sleep(1);
        if ((++sp & 255u) == 0u) { if (xb_ld(&bar[XB_TMO])) break; if (sp > XB_SPIN_CAP) { atomicAdd(&bar[XB_TMO], 1u); break; } }
    }
    nloc = mine > 0u ? mine : 1u; nx = cnt > 0u ? cnt : 1u;
}

__device__ __forceinline__ void xcd_barrier(const XcdBarrier& b) {
    asm volatile("s_waitcnt vmcnt(0)" ::: "memory");
    __syncthreads();
    if (threadIdx.x == 0) {
        unsigned* bar = b.bar;
        __builtin_amdgcn_s_waitcnt(0);
        unsigned nloc = b.st[0], nx = b.st[1];
        if (nloc == 0u) { xcd_barrier_complete(bar, b.x, nloc, nx); b.st[0] = nloc; b.st[1] = nx; }
        const unsigned old = xb_add(&bar[XB_XSUB(b.x)], 1u);
        const unsigned gen = old / nloc;
        if (old + 1u == (gen + 1u) * nloc) {
            __builtin_amdgcn_fence(__ATOMIC_RELEASE, "agent");
            asm volatile("s_waitcnt vmcnt(0)" ::: "memory");
            const unsigned og = xb_add(&bar[XB_TOP], 1u);
            const unsigned tg = og / nx;
            if (og + 1u == (tg + 1u) * nx) xb_add(&bar[XB_TOPGEN], 1u);
            else XB_SPIN(xb_ld(&bar[XB_TOPGEN]) == tg, bar);
            __builtin_amdgcn_fence(__ATOMIC_ACQUIRE, "agent");
            xb_add(&bar[XB_XGEN(b.x)], 1u);
            asm volatile("s_waitcnt vmcnt(0)" ::: "memory");
        } else {
            XB_SPIN(xb_ld(&bar[XB_XGEN(b.x)]) == gen, bar);
            __builtin_amdgcn_fence(__ATOMIC_ACQUIRE, "agent");
            asm volatile("s_waitcnt vmcnt(0)" ::: "memory");
        }
    }
    __syncthreads();
}

namespace pg8 {
constexpr int BM = 256, BK = 64, HALF = 128, HTB = HALF * BK * 2  , STAGE_BYTES = 8 * HTB, NXCD = 8, WGM = 8;
__host__ __device__ __forceinline__ int lds_byte(int r, int c) { const int st = (r >> 4) * 2 + (c >> 5), rr = r & 15, cc = c & 31, ob = rr * 64 + cc * 2; return st * 1024 + (ob ^ (((ob >> 9) & 1) << 5)); }
__host__ __device__ __forceinline__ void stage_rc(int b, int& R, int& C) { const int st = b / 1024, sb = b % 1024, swz = sb ^ (((sb >> 9) & 1) << 5); R = (st >> 1) * 16 + swz / 64; C = (st & 1) * 32 + (swz % 64) / 2; }
__host__ __device__ __forceinline__ int perm32(int rho) { const int n = rho >> 4, i = rho & 15; return 8 * (i >> 2) + 4 * n + (i & 3); }

struct Unit { int pm, pn, kind, e; };

__device__ __forceinline__ void rect_tile(int wgid_in, int nM, int nN, int& pm, int& pn) {
    const int nwg = nM * nN; int wgid = wgid_in;
    { const int q = nwg / NXCD, r = nwg % NXCD, xcd = wgid % NXCD, off = wgid / NXCD; wgid = (xcd < r ? xcd * (q + 1) : r * (q + 1) + (xcd - r) * q) + off; }
    const int nig = WGM * nN, gid = wgid / nig, fm = gid * WGM, gsz = (nM - fm) < WGM ? (nM - fm) : WGM;
    pm = fm + ((wgid % nig) % gsz); pn = (wgid % nig) / gsz;
}

template <class Epi, class Sched>
__device__ __forceinline__ void gemm_phase(LAS unsigned char* lds, const int K, const Sched& S, const Epi& E) {
    int tid = threadIdx.x; asm volatile("" : "+v"(tid));
    const int wid = __builtin_amdgcn_readfirstlane(tid >> 6), lane = tid & 63, wr = wid >> 2, wc = wid & 3, fr = lane & 15, fq = lane >> 4;
    const int nt = K / BK;
    unsigned voffA[2], voffB[2];
#pragma unroll
    for (int i = 0; i < 2; ++i) { int R, C; stage_rc(tid * 16 + i * 8192, R, C); const int Rb = Epi::PERM ? ((R & ~31) + perm32(R & 31)) : R;
        voffA[i] = (unsigned)(R * K + C) * 2u; voffB[i] = (unsigned)(Rb * K + C) * 2u; }
    const size_t kstep = (size_t)(BK * 2);
    const size_t hstep = (size_t)HALF * K * 2;
    const unsigned ldsw = (unsigned)wid * 1024u;
    const int aoff = lds_byte(wr * 64 + fr, fq * 8), boff = lds_byte(wc * 32 + fr, fq * 8);
#define PG8_SA(b, h) (((b) * 2 + (h)) * HTB)
#define PG8_SB(b, h) ((4 + (b) * 2 + (h)) * HTB)
#define PG8_STAGE(bufoff, gbase, voff) do { _Pragma("unroll") for (int _i = 0; _i < 2; ++_i) \
        __builtin_amdgcn_global_load_lds((const unsigned*)((const char*)(gbase) + (voff)[_i]), (LAS unsigned*)(lds + (bufoff) + ldsw + _i * 8192), 16, 0, 0); } while (0)
#define PG8_LDA(dst, b, h) do { _Pragma("unroll") for (int m = 0; m < 4; ++m) _Pragma("unroll") for (int k = 0; k < 2; ++k) dst[m][k] = *(const LAS bf16x8*)(lds + PG8_SA(b, h) + aoff + m * 2048 + k * 1024); } while (0)
#define PG8_LDB(dst, b, h) do { _Pragma("unroll") for (int n = 0; n < 2; ++n) _Pragma("unroll") for (int k = 0; k < 2; ++k) dst[n][k] = *(const LAS bf16x8*)(lds + PG8_SB(b, h) + boff + n * 2048 + k * 1024); } while (0)
#define PG8_MMA(ai, bj, At, Bt) do { __builtin_amdgcn_s_setprio(1); _Pragma("unroll") for (int m = 0; m < 4; ++m) _Pragma("unroll") for (int n = 0; n < 2; ++n) _Pragma("unroll") for (int k = 0; k < 2; ++k) \
        acc[ai][bj][m][n] = __builtin_amdgcn_mfma_f32_16x16x32_bf16(Bt[n][k], At[m][k], acc[ai][bj][m][n], 0, 0, 0); __builtin_amdgcn_s_setprio(0); } while (0)
#define PG8_WAIT_V(n) asm volatile("s_waitcnt vmcnt(" #n ")" ::: "memory")
#define PG8_WAIT_L(n) asm volatile("s_waitcnt lgkmcnt(" #n ")" ::: "memory")
#define PG8_BAR __builtin_amdgcn_s_barrier()
#define PG8_SCHED __builtin_amdgcn_sched_barrier(0)
    Unit cur, nxt; int ui = 0;
    if (!S.next(0, cur)) return;
    f32x4 acc[2][2][4][2];
#pragma unroll
    for (int a = 0; a < 2; ++a)
#pragma unroll
        for (int b = 0; b < 2; ++b)
#pragma unroll
            for (int m = 0; m < 4; ++m)
#pragma unroll
                for (int n = 0; n < 2; ++n) acc[a][b][m][n] = (f32x4){0.f, 0.f, 0.f, 0.f};
    bf16x8 At[4][2], B0[2][2], B1[2][2];
    const char* cA = S.a_ptr(cur); const char* cB = S.b_ptr(cur);
    PG8_STAGE(PG8_SB(0, 0), cB, voffB); PG8_STAGE(PG8_SB(0, 1), cB + hstep, voffB); PG8_STAGE(PG8_SA(0, 0), cA, voffA); PG8_STAGE(PG8_SA(0, 1), cA + hstep, voffA);
    if (wr == 1) PG8_BAR;
    PG8_WAIT_V(2); PG8_BAR;
    PG8_STAGE(PG8_SB(1, 0), cB + kstep, voffB); PG8_STAGE(PG8_SA(1, 0), cA + kstep, voffA); PG8_STAGE(PG8_SB(1, 1), cB + hstep + kstep, voffB);
    PG8_WAIT_V(6); PG8_BAR;
    for (;;) {
        const bool has_next = S.next(ui + 1, nxt);
        const char* nA = has_next ? S.a_ptr(nxt) : cA; const char* nB = has_next ? S.b_ptr(nxt) : cB;
#pragma unroll 1
        for (int t = 0; t < nt; t += 2) {
            const bool last = (t == nt - 2);
            const char* a1 = cA + (size_t)(t + 1) * kstep;
            const char* a2 = last ? nA : cA + (size_t)(t + 2) * kstep; const char* b2 = last ? nB : cB + (size_t)(t + 2) * kstep;
            const char* a3 = a2 + kstep; const char* b3 = b2 + kstep;
            PG8_LDB(B0, 0, 0); PG8_LDB(B1, 0, 1); PG8_SCHED; PG8_LDA(At, 0, 0); PG8_STAGE(PG8_SA(1, 1), a1 + hstep, voffA);
            PG8_WAIT_V(8); PG8_WAIT_L(0); PG8_BAR; PG8_MMA(0, 0, At, B0); PG8_MMA(0, 1, At, B1); PG8_BAR; PG8_SCHED;
            PG8_LDA(At, 0, 1); PG8_STAGE(PG8_SB(0, 0), b2, voffB); PG8_STAGE(PG8_SB(0, 1), b2 + hstep, voffB); PG8_STAGE(PG8_SA(0, 0), a2, voffA);
            PG8_WAIT_V(8); PG8_WAIT_L(0); PG8_BAR; PG8_MMA(1, 0, At, B0); PG8_MMA(1, 1, At, B1); PG8_BAR; PG8_SCHED;
            PG8_LDB(B0, 1, 0); PG8_LDB(B1, 1, 1); PG8_SCHED; PG8_LDA(At, 1, 0); PG8_STAGE(PG8_SA(0, 1), a2 + hstep, voffA);
            PG8_WAIT_V(8); PG8_WAIT_L(0); PG8_BAR; PG8_MMA(0, 0, At, B0); PG8_MMA(0, 1, At, B1); PG8_BAR; PG8_SCHED;
            PG8_LDA(At, 1, 1); PG8_STAGE(PG8_SB(1, 0), b3, voffB); PG8_STAGE(PG8_SB(1, 1), b3 + hstep, voffB); PG8_STAGE(PG8_SA(1, 0), a3, voffA);
            PG8_WAIT_V(8); PG8_WAIT_L(0); PG8_BAR; PG8_MMA(1, 0, At, B0); PG8_MMA(1, 1, At, B1); PG8_BAR; PG8_SCHED;
        }
        if (wr == 0) PG8_BAR;
        { int tz = threadIdx.x; asm volatile("" : "+v"(tz));
          const int wid2 = __builtin_amdgcn_readfirstlane(tz >> 6), lane2 = tz & 63; E(acc, cur, wid2 >> 2, wid2 & 3, lane2 & 15, lane2 >> 4); }
        if (!has_next) break;
        if (!(Epi::CHAIN && cur.kind == 0)) {
#pragma unroll
            for (int a = 0; a < 2; ++a)
#pragma unroll
                for (int b = 0; b < 2; ++b)
#pragma unroll
                    for (int m = 0; m < 4; ++m)
#pragma unroll
                        for (int n = 0; n < 2; ++n) acc[a][b][m][n] = (f32x4){0.f, 0.f, 0.f, 0.f};
        }
        cur = nxt; cA = nA; cB = nB; ++ui;
        if (wr == 1) PG8_BAR;
    }
    PG8_WAIT_V(0);
    PG8_BAR;
#undef PG8_SA
#undef PG8_SB
#undef PG8_STAGE
#undef PG8_LDA
#undef PG8_LDB
#undef PG8_MMA
#undef PG8_WAIT_V
#undef PG8_WAIT_L
#undef PG8_BAR
#undef PG8_SCHED
}
}
namespace pg8 {
__device__ __forceinline__ u32x4 pack8(const f32x4 a, const f32x4 b) { u32x4 w; w.x = cvt_pk_bf16(a[0], a[1]); w.y = cvt_pk_bf16(a[2], a[3]); w.z = cvt_pk_bf16(b[0], b[1]); w.w = cvt_pk_bf16(b[2], b[3]); return w; }
__device__ __forceinline__ float sumsq4(const f32x4 a) { return (a[0] * a[0] + a[1] * a[1]) + (a[2] * a[2] + a[3] * a[3]); }
#define EPI_BAR() do { asm volatile("s_waitcnt lgkmcnt(0)" ::: "memory"); __builtin_amdgcn_s_barrier(); asm volatile("" ::: "memory"); } while (0)

struct EpiIn {
    static constexpr bool PERM = true, CHAIN = false;
    bf16_t *QA, *KA, *VA, *ZCQ, *ZCKV, *ZKR, *GATES; const float *qg, *kg;
    __device__ __forceinline__ void operator()(f32x4 (&acc)[2][2][4][2], const Unit& u, int wr, int wc, int fr, int fq) const {
        const int row0 = u.pm * BM + wr * 64 + fr, pn = u.pn;
        if (pn < 4) {
            const float* g = (pn < 2) ? qg : kg; bf16_t* dst = (pn < 2) ? QA : KA; const int head = 4 * (pn & 1) + wc;
            f32x4 gv[2][2];
#pragma unroll
            for (int bj = 0; bj < 2; ++bj)
#pragma unroll
                for (int n = 0; n < 2; ++n) gv[bj][n] = *(const f32x4*)(g + 32 * bj + 8 * fq + 4 * n);
#pragma unroll
            for (int ai = 0; ai < 2; ++ai)
#pragma unroll
                for (int m = 0; m < 4; ++m) {
                    const size_t row = (size_t)(row0 + ai * HALF + m * 16);
                    float ss = (sumsq4(acc[ai][0][m][0]) + sumsq4(acc[ai][0][m][1])) + (sumsq4(acc[ai][1][m][0]) + sumsq4(acc[ai][1][m][1]));
                    ss += __shfl_xor(ss, 16); ss += __shfl_xor(ss, 32);
                    const float rstd = rsqrtf(ss * (1.0f / 64.0f) + RMS_EPS);
#pragma unroll
                    for (int bj = 0; bj < 2; ++bj)
                        *(u32x4*)(dst + row * 512 + head * 64 + 32 * bj + 8 * fq) = pack8(acc[ai][bj][m][0] * rstd * gv[bj][0], acc[ai][bj][m][1] * rstd * gv[bj][1]);
                }
        } else if (pn >= 9) {
#pragma unroll
            for (int ai = 0; ai < 2; ++ai)
#pragma unroll
                for (int m = 0; m < 4; ++m) {
                    const size_t row = (size_t)(row0 + ai * HALF + m * 16);
#pragma unroll
                    for (int bj = 0; bj < 2; ++bj) { f32x4 a = acc[ai][bj][m][0], b = acc[ai][bj][m][1];
#pragma unroll
                        for (int j = 0; j < 4; ++j) { a[j] = sigmoidf_(a[j]); b[j] = sigmoidf_(b[j]); }
                        *(u32x4*)(GATES + row * 2048 + (pn - 9) * 256 + 128 * bj + 32 * wc + 8 * fq) = pack8(a, b); }
                }
        } else {
#pragma unroll
            for (int ai = 0; ai < 2; ++ai)
#pragma unroll
                for (int m = 0; m < 4; ++m) {
                    const size_t row = (size_t)(row0 + ai * HALF + m * 16);
#pragma unroll
                    for (int bj = 0; bj < 2; ++bj) {
                        const u32x4 w = pack8(acc[ai][bj][m][0], acc[ai][bj][m][1]); const int cc = 128 * bj + 32 * wc + 8 * fq;
                        if (pn < 6) *(u32x4*)(VA + row * 512 + (pn - 4) * 256 + cc) = w;
                        else if (pn == 6) *(u32x4*)(ZCQ + row * QLORA + cc) = w;
                        else if (pn == 8) *(u32x4*)(ZCKV + row * KVLORA + cc) = w;
                        else { if (bj == 0) *(u32x4*)(ZCQ + row * QLORA + 256 + cc) = w; else if (wc == 0) *(u32x4*)(ZKR + row * ROPED + 8 * fq) = w; }
                    }
                }
        }
    }
};

__device__ __forceinline__ void rope8(float (&v)[8], const float* rope, int s  , int fq) {
    const int pos = (fq < 2) ? (s >> 6) : (s & 63);
    const f32x4 c0 = *(const f32x4*)(rope + pos * 8), c1 = *(const f32x4*)(rope + pos * 8 + 4), s0 = *(const f32x4*)(rope + 512 + pos * 8), s1 = *(const f32x4*)(rope + 512 + pos * 8 + 4);
    const float cs[8] = {c0[0], c0[1], c0[2], c0[3], c1[0], c1[1], c1[2], c1[3]}, sn[8] = {s0[0], s0[1], s0[2], s0[3], s1[0], s1[1], s1[2], s1[3]};
#pragma unroll
    for (int i = 0; i < 8; ++i) { const float o = __shfl_xor(v[i], 16); v[i] = (fq & 1) ? (o * sn[i] + v[i] * cs[i]) : (v[i] * cs[i] - o * sn[i]); }
}

struct EpiQ {
    static constexpr bool PERM = true, CHAIN = false;
    bf16_t* QB; const float *rs, *g, *rope; LAS float* P;
    __device__ __forceinline__ void operator()(f32x4 (&acc)[2][2][4][2], const Unit& u, int wr, int wc, int fr, int fq) const {
        const int row0 = u.pm * BM + wr * 64 + fr; const bool isx = u.pm < MT_X;
#ifdef EQ_TRIVIAL
#pragma unroll
        for (int ai = 0; ai < 2; ++ai)
#pragma unroll
            for (int m = 0; m < 4; ++m) { const size_t row = (size_t)(row0 + ai * HALF + m * 16);
#pragma unroll
                for (int bj = 0; bj < 2; ++bj) *(u32x4*)(QB + row * 768 + (2 * u.pn + bj) * QKD + 32 * wc + 8 * fq) = pack8(acc[ai][bj][m][0], acc[ai][bj][m][1]); }
        return;
#endif
#pragma unroll
        for (int ai = 0; ai < 2; ++ai)
#pragma unroll
            for (int m = 0; m < 4; ++m) {
                const float r = rs[row0 + ai * HALF + m * 16]; const int rl = ai * 64 + m * 16 + fr;
#pragma unroll
                for (int bj = 0; bj < 2; ++bj) {
                    float ss = (sumsq4(acc[ai][bj][m][0]) + sumsq4(acc[ai][bj][m][1])) * (r * r); ss += __shfl_xor(ss, 16); ss += __shfl_xor(ss, 32);
                    if (fq == 0) P[((wr * 128 + rl) * 2 + bj) * 4 + wc] = ss; }
                asm volatile("" ::: "memory");
            }
        EPI_BAR();
        if (wc < 3) {
            const f32x4 g0 = *(const f32x4*)(g + 32 * wc + 8 * fq), g1 = *(const f32x4*)(g + 32 * wc + 8 * fq + 4);
#pragma unroll
            for (int ai = 0; ai < 2; ++ai)
#pragma unroll
                for (int m = 0; m < 4; ++m) {
                    const int row = row0 + ai * HALF + m * 16, rl = ai * 64 + m * 16 + fr; const float r = rs[row];
#pragma unroll
                    for (int bj = 0; bj < 2; ++bj) {
                        const f32x4 p = *(const LAS f32x4*)(P + ((wr * 128 + rl) * 2 + bj) * 4);
                        const float rstd = r * rsqrtf(((p[0] + p[1]) + p[2]) * (1.0f / 96.0f) + RMS_EPS);
                        const f32x4 a = acc[ai][bj][m][0] * rstd * g0, b = acc[ai][bj][m][1] * rstd * g1;
                        float v[8] = {a[0], a[1], a[2], a[3], b[0], b[1], b[2], b[3]};
#ifndef EQ_NOROPE
                        if (wc == 2 && isx) rope8(v, rope, row & (SEQ - 1), fq);
#endif
                        u32x4 w; w.x = cvt_pk_bf16(v[0], v[1]); w.y = cvt_pk_bf16(v[2], v[3]); w.z = cvt_pk_bf16(v[4], v[5]); w.w = cvt_pk_bf16(v[6], v[7]);
                        *(u32x4*)(QB + (size_t)row * 768 + (2 * u.pn + bj) * QKD + 32 * wc + 8 * fq) = w;
                    }
                    asm volatile("" ::: "memory");
                }
        }
    }
};

struct EpiKV {
    static constexpr bool PERM = true, CHAIN = false;
    bf16_t *KB, *VB; const bf16_t* ZKR; const float *rs, *sskr, *g, *rope; LAS float* P;
    __device__ __forceinline__ void operator()(f32x4 (&acc)[2][2][4][2], const Unit& u, int wr, int wc, int fr, int fq) const {
        const int row0 = u.pm * BM + wr * 64 + fr; const bool isx = u.pm < MT_X;
#pragma unroll
        for (int ai = 0; ai < 2; ++ai)
#pragma unroll
            for (int m = 0; m < 4; ++m) {
                const float r = rs[row0 + ai * HALF + m * 16]; const int rl = ai * 64 + m * 16 + fr;
                if (wc < 2) {
#pragma unroll
                    for (int bj = 0; bj < 2; ++bj) { float ss = (sumsq4(acc[ai][bj][m][0]) + sumsq4(acc[ai][bj][m][1])) * (r * r); ss += __shfl_xor(ss, 16); ss += __shfl_xor(ss, 32);
                        if (fq == 0) P[((wr * 128 + rl) * 2 + bj) * 4 + wc] = ss; } }
                asm volatile("" ::: "memory");
            }
        EPI_BAR();
        const int gofs = (wc < 2) ? (32 * wc + 8 * fq) : (64 + 8 * fq);
        const f32x4 g0 = *(const f32x4*)(g + gofs), g1 = *(const f32x4*)(g + gofs + 4);
#pragma unroll
        for (int ai = 0; ai < 2; ++ai)
#pragma unroll
            for (int m = 0; m < 4; ++m) {
                const int row = row0 + ai * HALF + m * 16, rl = ai * 64 + m * 16 + fr;
                const float skr = sskr[row], rr = rs[row];
                u32x4 zk = (u32x4){0u, 0u, 0u, 0u}; if (wc == 2) zk = *(const u32x4*)(ZKR + (size_t)row * ROPED + 8 * fq);
#pragma unroll
                for (int bj = 0; bj < 2; ++bj) {
                    const int head = 2 * u.pn + bj;
                    const f32x4 p = *(const LAS f32x4*)(P + ((wr * 128 + rl) * 2 + bj) * 4);
                    const float rstd = rsqrtf(((p[0] + p[1]) + skr) * (1.0f / 96.0f) + RMS_EPS);
                    if (wc < 2) {
                        *(u32x4*)(KB + (size_t)row * 768 + head * QKD + 32 * wc + 8 * fq) = pack8(acc[ai][bj][m][0] * (rr * rstd) * g0, acc[ai][bj][m][1] * (rr * rstd) * g1);
                    } else {
                        *(u32x4*)(VB + (size_t)row * 512 + head * 64 + 32 * (wc - 2) + 8 * fq) = pack8(acc[ai][bj][m][0] * rr, acc[ai][bj][m][1] * rr);
                        if (wc == 2) {
                            float v[8] = {bf_lo(zk.x) * rstd * g0[0], bf_hi(zk.x) * rstd * g0[1], bf_lo(zk.y) * rstd * g0[2], bf_hi(zk.y) * rstd * g0[3],
                                          bf_lo(zk.z) * rstd * g1[0], bf_hi(zk.z) * rstd * g1[1], bf_lo(zk.w) * rstd * g1[2], bf_hi(zk.w) * rstd * g1[3]};
                            if (isx) rope8(v, rope, row & (SEQ - 1), fq);
                            u32x4 w; w.x = cvt_pk_bf16(v[0], v[1]); w.y = cvt_pk_bf16(v[2], v[3]); w.z = cvt_pk_bf16(v[4], v[5]); w.w = cvt_pk_bf16(v[6], v[7]);
                            *(u32x4*)(KB + (size_t)row * 768 + head * QKD + 64 + 8 * fq) = w;
                        }
                    }
                }
                asm volatile("" ::: "memory");
            }
    }
};

struct EpiMerge {
    static constexpr bool PERM = true, CHAIN = true;
    const bf16_t* GATES; bf16_t* Y;
    __device__ __forceinline__ void operator()(f32x4 (&acc)[2][2][4][2], const Unit& u, int wr, int wc, int fr, int fq) const {
        const int row0 = u.pm * BM + wr * 64 + fr;
#pragma unroll
        for (int ai = 0; ai < 2; ++ai)
#pragma unroll
            for (int m = 0; m < 4; ++m) {
                const size_t row = (size_t)(row0 + ai * HALF + m * 16);
#pragma unroll
                for (int bj = 0; bj < 2; ++bj) {
                    const int col = u.pn * 256 + 128 * bj + 32 * wc + 8 * fq;
                    const u32x4 gb = *(const u32x4*)(GATES + row * 2048 + 1024 + col);
                    const f32x4 b0 = (f32x4){bf_lo(gb.x), bf_hi(gb.x), bf_lo(gb.y), bf_hi(gb.y)}, b1 = (f32x4){bf_lo(gb.z), bf_hi(gb.z), bf_lo(gb.w), bf_hi(gb.w)};
                    if (u.kind == 0) {
                        const u32x4 ga = *(const u32x4*)(GATES + row * 2048 + col);
                        const f32x4 a0 = (f32x4){bf_lo(ga.x), bf_hi(ga.x), bf_lo(ga.y), bf_hi(ga.y)}, a1 = (f32x4){bf_lo(ga.z), bf_hi(ga.z), bf_lo(ga.w), bf_hi(ga.w)};
#pragma unroll
                        for (int j = 0; j < 4; ++j) { acc[ai][bj][m][0][j] *= a0[j] * __builtin_amdgcn_rcpf(b0[j]); acc[ai][bj][m][1][j] *= a1[j] * __builtin_amdgcn_rcpf(b1[j]); }
                    } else {
                        *(u32x4*)(Y + row * 1024 + col) = pack8(acc[ai][bj][m][0] * b0, acc[ai][bj][m][1] * b1);
                    }
                }
            }
    }
};

struct EpiOut {
    static constexpr bool PERM = false, CHAIN = false;
    const float* xsrc; float* xdst; const float* csrc; float* cdst; const float* mod  ; int goff;
    __device__ __forceinline__ void operator()(f32x4 (&acc)[2][2][4][2], const Unit& u, int wr, int wc, int fr, int fq) const {
        const bool isx = u.pm < MT_X;
        const int rowt = (isx ? u.pm : u.pm - MT_X) * BM + wr * 64 + fr;
        const float* src = isx ? xsrc : csrc; float* dst = isx ? xdst : cdst;
        const float* gm = mod + (size_t)(isx ? (u.pm >> 3) : 16) * NMODC + goff;
        const int col0 = u.pn * BM + wc * 32 + 4 * fq;
        f32x4 gv[2][2];
#pragma unroll
        for (int bj = 0; bj < 2; ++bj)
#pragma unroll
            for (int n = 0; n < 2; ++n) gv[bj][n] = *(const f32x4*)(gm + col0 + bj * HALF + n * 16);
#pragma unroll
        for (int ai = 0; ai < 2; ++ai)
#pragma unroll
            for (int m = 0; m < 4; ++m) { const size_t off = (size_t)(rowt + ai * HALF + m * 16) * DM + col0;
#pragma unroll
                for (int bj = 0; bj < 2; ++bj)
#pragma unroll
                    for (int n = 0; n < 2; ++n) { const f32x4 xs = *(const f32x4*)(src + off + bj * HALF + n * 16); *(f32x4*)(dst + off + bj * HALF + n * 16) = xs + gv[bj][n] * acc[ai][bj][m][n]; }
            }
    }
};

struct EpiMoe1 {
    static constexpr bool PERM = true, CHAIN = false;
    bf16_t* HM;
    __device__ __forceinline__ void operator()(f32x4 (&acc)[2][2][4][2], const Unit& u, int wr, int wc, int fr, int fq) const {
        const int row0 = u.pm * BM + wr * 64 + fr;
#pragma unroll
        for (int ai = 0; ai < 2; ++ai)
#pragma unroll
            for (int m = 0; m < 4; ++m) { const size_t row = (size_t)(row0 + ai * HALF + m * 16);
#pragma unroll
                for (int bj = 0; bj < 2; ++bj) { const f32x4 p = acc[ai][bj][m][0], q = acc[ai][bj][m][1];
                    const float h0 = p[0] * sigmoidf_(p[0]) * p[1], h1 = p[2] * sigmoidf_(p[2]) * p[3], h2 = q[0] * sigmoidf_(q[0]) * q[1], h3 = q[2] * sigmoidf_(q[2]) * q[3];
                    u32x2 w; w.x = cvt_pk_bf16(h0, h1); w.y = cvt_pk_bf16(h2, h3);
                    *(u32x2*)(HM + row * DM + u.pn * 128 + 64 * bj + 16 * wc + 4 * fq) = w; }
            }
    }
};
struct EpiMoe2 {
    static constexpr bool PERM = true, CHAIN = false;
    bf16_t* YS;
    __device__ __forceinline__ void operator()(f32x4 (&acc)[2][2][4][2], const Unit& u, int wr, int wc, int fr, int fq) const {
        const int row0 = u.pm * BM + wr * 64 + fr;
#pragma unroll
        for (int ai = 0; ai < 2; ++ai)
#pragma unroll
            for (int m = 0; m < 4; ++m) { const size_t row = (size_t)(row0 + ai * HALF + m * 16);
#pragma unroll
                for (int bj = 0; bj < 2; ++bj) *(u32x4*)(YS + row * DM + u.pn * 256 + 128 * bj + 32 * wc + 8 * fq) = pack8(acc[ai][bj][m][0], acc[ai][bj][m][1]); }
    }
};

struct SchedRect {
    const char* A; const char* B; size_t tstep; int nM, nN, G, c, nM2, pn2, npn2;
    __device__ __forceinline__ bool next(int i, Unit& u) const {
        const int L = i * G + c, mainc = nM * nN; u.kind = 0; u.e = 0;
        if (L < mainc) { rect_tile(L, nM, nN, u.pm, u.pn); return true; }
        const int Lx = L - mainc; if (Lx >= nM2 * npn2) return false;
        u.pm = nM + Lx / npn2; u.pn = pn2 + Lx % npn2; return true;
    }
    __device__ __forceinline__ const char* a_ptr(const Unit& u) const { return A + (size_t)u.pm * tstep; }
    __device__ __forceinline__ const char* b_ptr(const Unit& u) const { return B + (size_t)u.pn * tstep; }
};
struct SchedMerge {
    const char *OA, *OB, *WA, *WB; size_t tstep; int nM, nN, G, c;
    __device__ __forceinline__ bool next(int i, Unit& u) const {
        const int L = (i >> 1) * G + c; if (L >= nM * nN) return false;
        rect_tile(L, nM, nN, u.pm, u.pn); u.kind = i & 1; u.e = 0; return true;
    }
    __device__ __forceinline__ const char* a_ptr(const Unit& u) const { return (u.kind ? OB : OA) + (size_t)u.pm * tstep; }
    __device__ __forceinline__ const char* b_ptr(const Unit& u) const { return (u.kind ? WB : WA) + (size_t)u.pn * tstep; }
};
struct SchedMoe {
    const char* A; const char* W; size_t tstepA, wstride, tstepB; const int* tile_e; int ntile, nN, G, c;
    __device__ __forceinline__ bool next(int i, Unit& u) const {
        const int L = i * G + c; if (L >= ntile * nN) return false;
        rect_tile(L, ntile, nN, u.pm, u.pn); u.kind = 0;
        u.e = __builtin_amdgcn_readfirstlane(ld_i32_agent(tile_e + u.pm)); return true;
    }
    __device__ __forceinline__ const char* a_ptr(const Unit& u) const { return A + (size_t)u.pm * tstepA; }
    __device__ __forceinline__ const char* b_ptr(const Unit& u) const { return W + (size_t)u.e * wstride + (size_t)u.pn * tstepB; }
};
}
namespace att {
constexpr int NW = 8, QBLK = 32, KVBLK = 64, DV = 64;
constexpr int SHM_V = KVBLK * DV * 2  , SHM_K = KVBLK * 256  ;
constexpr int LDS_VOFF = 0, LDS_KOFF = 2 * SHM_V, LDS_WS = LDS_KOFF + 2 * SHM_K, LDS_OST = LDS_WS + NW * 64 * 4, LDS_BIAS = LDS_OST + NW * 4096, LDS_MASK = LDS_BIAS + 4096, LDS_END = LDS_MASK + 64 * 64 * 4;
constexpr int BIAS_PAD = 64;
static_assert(LDS_END <= RING_BYTES, "attention LDS map");
#define KSWZ(row, colB) ((row) * 256 + ((colB) ^ (((row) & 7) << 4)))
#define SBAR() __builtin_amdgcn_sched_barrier(0)
__device__ __forceinline__ int crow(int r, int hi) { return (r & 3) + 8 * (r >> 2) + 4 * hi; }
__device__ __forceinline__ int v_st(int k, int c) { const int kk = (k & ~0xC) | ((k & 4) << 1) | ((k & 8) >> 1); return ((kk >> 3) * 2 + (c >> 5)) * 512 + ((kk & 7) * 32 + (c & 31)) * 2; }
__device__ __forceinline__ int v_rd_base(int lane) { return ((lane & 3) << 3) | (((lane >> 2) & 3) << 6) | (((lane >> 4) & 1) << 5) | (((lane >> 5) & 1) << 8); }
constexpr int v_rd_off(int d0, int ks, int half) { return ((2 * ks + half) * 2 + d0) * 512; }
template <int OFF> __device__ __forceinline__ s16x4 tr_read(int vb) { s16x4 r; asm volatile("ds_read_b64_tr_b16 %0, %1 offset:%2" : "=&v"(r) : "v"(vb), "i"(OFF) : "memory"); return r; }

template <int D0> __device__ __forceinline__ void pv_one(f32x16& od, int vb, bf16x8 pa0, bf16x8 pa1, bf16x8 pa2, bf16x8 pa3) {
    const s16x4 l0 = tr_read<v_rd_off(D0, 0, 0)>(vb), h0 = tr_read<v_rd_off(D0, 0, 1)>(vb), l1 = tr_read<v_rd_off(D0, 1, 0)>(vb), h1 = tr_read<v_rd_off(D0, 1, 1)>(vb);
    const s16x4 l2 = tr_read<v_rd_off(D0, 2, 0)>(vb), h2 = tr_read<v_rd_off(D0, 2, 1)>(vb), l3 = tr_read<v_rd_off(D0, 3, 0)>(vb), h3 = tr_read<v_rd_off(D0, 3, 1)>(vb);
    asm volatile("s_waitcnt lgkmcnt(0)" ::: "memory"); SBAR();
#define PK(L, H) (bf16x8){L[0], L[1], L[2], L[3], H[0], H[1], H[2], H[3]}
    od = __builtin_amdgcn_mfma_f32_32x32x16_bf16(pa0, PK(l0, h0), od, 0, 0, 0);
    od = __builtin_amdgcn_mfma_f32_32x32x16_bf16(pa1, PK(l1, h1), od, 0, 0, 0);
    od = __builtin_amdgcn_mfma_f32_32x32x16_bf16(pa2, PK(l2, h2), od, 0, 0, 0);
    od = __builtin_amdgcn_mfma_f32_32x32x16_bf16(pa3, PK(l3, h3), od, 0, 0, 0);
#undef PK
}
__device__ __forceinline__ void pv_all(f32x16* o, int vb, bf16x8 pa0, bf16x8 pa1, bf16x8 pa2, bf16x8 pa3) { pv_one<0>(o[0], vb, pa0, pa1, pa2, pa3); pv_one<1>(o[1], vb, pa0, pa1, pa2, pa3); }

__device__ __forceinline__ void partialSM(f32x16& p0, f32x16& p1, float& m_reg, float& alpha, const float C, const float THRS) {
    float pmax = p0[0];
#pragma unroll
    for (int r = 1; r < 16; ++r) pmax = fmaxf(pmax, p0[r]);
#pragma unroll
    for (int r = 0; r < 16; ++r) pmax = fmaxf(pmax, p1[r]);
    { auto rr = __builtin_amdgcn_permlane32_swap(__float_as_uint(pmax), __float_as_uint(pmax), false, false); pmax = fmaxf(__uint_as_float(rr[0]), __uint_as_float(rr[1])); }
    float mn;
    if (__builtin_expect(__all(pmax - m_reg <= THRS), 1)) { mn = m_reg; alpha = 1.f; }
    else { mn = fmaxf(m_reg, pmax); alpha = __builtin_amdgcn_exp2f((m_reg - mn) * C); m_reg = mn; }
    const float mnC = -mn * C;
#pragma unroll
    for (int r = 0; r < 16; ++r) p0[r] = fmaf(p0[r], C, mnC);
#pragma unroll
    for (int r = 0; r < 16; ++r) p1[r] = fmaf(p1[r], C, mnC);
#pragma unroll
    for (int r = 0; r < 16; ++r) p0[r] = __builtin_amdgcn_exp2f(p0[r]);
}
__device__ __forceinline__ void finishSM(f32x16& p0, f32x16& p1, float alpha, float& l_reg, bf16x8& pa0, bf16x8& pa1, bf16x8& pa2, bf16x8& pa3) {
#pragma unroll
    for (int r = 0; r < 16; ++r) p1[r] = __builtin_amdgcn_exp2f(p1[r]);
    float ps = 0;
#pragma unroll
    for (int r = 0; r < 16; ++r) ps += p0[r];
#pragma unroll
    for (int r = 0; r < 16; ++r) ps += p1[r];
    { auto rr = __builtin_amdgcn_permlane32_swap(__float_as_uint(ps), __float_as_uint(ps), false, false); ps = __uint_as_float(rr[0]) + __uint_as_float(rr[1]); }
    l_reg = l_reg * alpha + ps;
#define PK4(P, BASE, OUT) do { unsigned a0 = cvt_pk_bf16(P[BASE + 0], P[BASE + 1]), a1 = cvt_pk_bf16(P[BASE + 2], P[BASE + 3]);   \
    unsigned b0 = cvt_pk_bf16(P[BASE + 4], P[BASE + 5]), b1 = cvt_pk_bf16(P[BASE + 6], P[BASE + 7]);                              \
    auto r0 = __builtin_amdgcn_permlane32_swap(a0, b0, false, false); auto r1 = __builtin_amdgcn_permlane32_swap(a1, b1, false, false); \
    u32x4 w = {r0[0], r1[0], r0[1], r1[1]}; OUT = *reinterpret_cast<bf16x8*>(&w); } while (0)
    PK4(p0, 0, pa0); PK4(p0, 8, pa1); PK4(p1, 0, pa2); PK4(p1, 8, pa3);
#undef PK4
}
template <int DQK> __device__ __forceinline__ void qkt(f32x16& p0, f32x16& p1, const char* Ks, const bf16x8* qr, int r32, int hi) {
    p0 = f32x16{}; p1 = f32x16{};
#pragma unroll
    for (int d0 = 0; d0 < DQK / 16; ++d0) { const int cb = (d0 * 16 + hi * 8) * 2;
        const bf16x8 b0 = *reinterpret_cast<const bf16x8*>(Ks + KSWZ(r32, cb));
        const bf16x8 b1 = *reinterpret_cast<const bf16x8*>(Ks + KSWZ(32 + r32, cb));
        p0 = __builtin_amdgcn_mfma_f32_32x32x16_bf16(b0, qr[d0], p0, 0, 0, 0);
        p1 = __builtin_amdgcn_mfma_f32_32x32x16_bf16(b1, qr[d0], p1, 0, 0, 0); }
}

struct UnitArgs {
    const bf16_t* Q; int ldq; int qcol;
    const bf16_t* K; int ldk; int kcol;
    const bf16_t* V; int vcol;
    bf16_t* O; int ocol;
    int q0;
    int ctx0, loc0;
    int NT;
    int masked;
    int band, krow0;
    const float* bias;
    float C;
};

__device__ __forceinline__ void na_mask(f32x16& p0, f32x16& p1, const LAS float* bt, const LAS float* mk, int kr, int qrow, int qc, int hi) {
    const int rs = min(max(qrow - 4, 0), 24);
    if (!((kr >= rs) && (kr < rs + 8))) {
#pragma unroll
        for (int r = 0; r < 16; ++r) { p0[r] = -1e30f; p1[r] = -1e30f; }
        return;
    }
    const LAS float* b = bt + BIAS_PAD + (kr - qrow + 7) * 31 + (15 - qc) + 4 * hi;
    const LAS float* mq = mk + qc * 64 + 4 * hi;
#pragma unroll
    for (int g = 0; g < 4; ++g) {
        const f32x4 m0 = *(const LAS f32x4*)(mq + 8 * g), m1 = *(const LAS f32x4*)(mq + 32 + 8 * g);
#pragma unroll
        for (int j = 0; j < 4; ++j) { p0[4 * g + j] = (p0[4 * g + j] + b[8 * g + j]) + m0[j]; p1[4 * g + j] = (p1[4 * g + j] + b[32 + 8 * g + j]) + m1[j]; }
    }
}
__device__ __forceinline__ void na_mask_table(char* lds) {
    LAS float* mk = (LAS float*)(lds + LDS_MASK);
    int t0 = threadIdx.x; asm volatile("" : "+v"(t0));
    for (int i = t0; i < 64 * 64; i += 512) { const int qc = i >> 6, kc = i & 63, cs = min(max(qc - 8, 0), 48); mk[i] = ((unsigned)(kc - cs) < 16u) ? 0.f : -1e30f; }
}

template <int DQK>
__device__ __forceinline__ void attn_unit(const UnitArgs& A, char* lds) {
    int tid = threadIdx.x; asm volatile("" : "+v"(tid));
    const int wid = tid >> 6, lane = tid & 63, r32 = lane & 31, hi = lane >> 5;
    char* V_lds = lds + LDS_VOFF; char* K_lds = lds + LDS_KOFF;
    float* ws = (float*)(lds + LDS_WS) + wid * 64; float* li_l = ws; float* al_l = ws + 32;
    const LAS float* bt = (const LAS float*)(lds + LDS_BIAS); const LAS float* mk = (const LAS float*)(lds + LDS_MASK);
    const float C = A.C, THRS = 8.0f * 1.4426950408889634f / C;
    float m_reg = -1e30f, l_reg = 0; f32x16 o[2] = {}; bf16x8 qr[DQK / 16];
    if (A.masked) { for (int i = tid; i < 1024; i += 512) { const int k = i - BIAS_PAD; ((LAS float*)(lds + LDS_BIAS))[i] = (k >= 0 && k < 15 * 31) ? A.bias[k] * (1.4426950408889634f / C) : 0.f; } }
    const bf16_t* Qw = A.Q + (size_t)(A.q0 + wid * QBLK + r32) * A.ldq + A.qcol + hi * 8;
#pragma unroll
    for (int d0 = 0; d0 < DQK / 16; ++d0) qr[d0] = *reinterpret_cast<const bf16x8*>(Qw + d0 * 16);
    constexpr int CPR = DQK / 8; constexpr bool K2 = (64 * CPR > 512);
    const int vkey = tid >> 3, vc = (tid & 7) * 8, vst = v_st(vkey, vc);
    const int k0key = tid / CPR, k0c = tid % CPR, k1id = tid + 512, k1key = k1id / CPR, k1c = k1id % CPR; const bool k1on = K2 && (k1id < 64 * CPR);
    const int vb0 = (int)(uintptr_t)V_lds + v_rd_base(lane);
    const int qrow = 4 * A.band + (wid >> 1), qc = 32 * (wid & 1) + r32;
    bf16x8 sv, sk0, sk1 = {};
#define TROW(t) (((t) < 4) ? (A.ctx0 + 64 * (t)) : (A.loc0 + 64 * ((t) - 4)))
#define SLOAD(t) do { const int _r0 = TROW(t); sv = *reinterpret_cast<const bf16x8*>(A.V + (size_t)(_r0 + vkey) * 512 + A.vcol + vc); \
        sk0 = *reinterpret_cast<const bf16x8*>(A.K + (size_t)(_r0 + k0key) * A.ldk + A.kcol + k0c * 8); \
        if (k1on) sk1 = *reinterpret_cast<const bf16x8*>(A.K + (size_t)(_r0 + k1key) * A.ldk + A.kcol + k1c * 8); } while (0)
#define SWRITE(b) do { *reinterpret_cast<bf16x8*>(V_lds + (b) * SHM_V + vst) = sv; *reinterpret_cast<bf16x8*>(K_lds + (b) * SHM_K + KSWZ(k0key, k0c * 16)) = sk0; \
        if (k1on) *reinterpret_cast<bf16x8*>(K_lds + (b) * SHM_K + KSWZ(k1key, k1c * 16)) = sk1; } while (0)
#define RESC(a) do { if (__any((a) < 1.f)) { if (hi == 0) al_l[r32] = (a); asm volatile("s_waitcnt lgkmcnt(0)" ::: "memory"); \
        _Pragma("unroll") for (int d = 0; d < 2; ++d) _Pragma("unroll") for (int r = 0; r < 16; ++r) o[d][r] *= al_l[crow(r, hi)]; } } while (0)
#define MASK(P0, P1, t) do { if (A.masked && (t) >= 4) na_mask(P0, P1, bt, mk, A.krow0 + (t) - 4, qrow, qc, hi); } while (0)
    f32x16 pA0, pA1, pB0, pB1; float alA, alB; bf16x8 pa0, pa1, pa2, pa3; const int NT = A.NT;
    SLOAD(0); SWRITE(0); __syncthreads();
    qkt<DQK>(pA0, pA1, K_lds, qr, r32, hi); MASK(pA0, pA1, 0); partialSM(pA0, pA1, m_reg, alA, C, THRS);
    SLOAD(1); SWRITE(1); __syncthreads();
    for (int j = 1; j + 1 < NT; j += 2) {
        SBAR(); qkt<DQK>(pB0, pB1, K_lds + SHM_K, qr, r32, hi); MASK(pB0, pB1, j);
        finishSM(pA0, pA1, alA, l_reg, pa0, pa1, pa2, pa3); SBAR();
        SLOAD(j + 1); SBAR();
        pv_all(o, vb0, pa0, pa1, pa2, pa3); partialSM(pB0, pB1, m_reg, alB, C, THRS);
        __syncthreads(); SWRITE(0);
        RESC(alB); __syncthreads();
        SBAR(); qkt<DQK>(pA0, pA1, K_lds, qr, r32, hi); MASK(pA0, pA1, j + 1);
        finishSM(pB0, pB1, alB, l_reg, pa0, pa1, pa2, pa3); SBAR();
        SLOAD(j + 2); SBAR();
        pv_all(o, vb0 + SHM_V, pa0, pa1, pa2, pa3); partialSM(pA0, pA1, m_reg, alA, C, THRS);
        __syncthreads(); SWRITE(1);
        RESC(alA); __syncthreads();
    }
    SBAR(); qkt<DQK>(pB0, pB1, K_lds + SHM_K, qr, r32, hi); MASK(pB0, pB1, NT - 1);
    finishSM(pA0, pA1, alA, l_reg, pa0, pa1, pa2, pa3); SBAR();
    pv_all(o, vb0, pa0, pa1, pa2, pa3); partialSM(pB0, pB1, m_reg, alB, C, THRS);
    __syncthreads(); RESC(alB);
    finishSM(pB0, pB1, alB, l_reg, pa0, pa1, pa2, pa3); SBAR();
    pv_all(o, vb0 + SHM_V, pa0, pa1, pa2, pa3);
    if (hi == 0) li_l[r32] = l_reg; asm volatile("s_waitcnt lgkmcnt(0)" ::: "memory");
    float rli[16];
#pragma unroll
    for (int r = 0; r < 16; ++r) rli[r] = __builtin_amdgcn_rcpf(li_l[crow(r, hi)]);
    bf16_t* stg = (bf16_t*)(lds + LDS_OST) + wid * 2048;
#pragma unroll
    for (int r = 0; r < 16; ++r) { const int orow = crow(r, hi);
#pragma unroll
        for (int d0 = 0; d0 < 2; ++d0) { const unsigned w = cvt_pk_bf16(o[d0][r] * rli[r], 0.f); stg[orow * 64 + d0 * 32 + r32] = (bf16_t)(w & 0xffffu); } }
    asm volatile("s_waitcnt lgkmcnt(0)" ::: "memory");
    bf16_t* Ow = A.O + (size_t)(A.q0 + wid * QBLK) * 512 + A.ocol;
#pragma unroll
    for (int i = 0; i < 4; ++i) { const int row = i * 8 + (lane >> 3), ch = lane & 7; const u32x4 v = *(const u32x4*)(stg + row * 64 + ch * 8); *(u32x4*)(Ow + (size_t)row * 512 + ch * 8) = v; }
    __syncthreads();
#undef TROW
#undef SLOAD
#undef SWRITE
#undef RESC
#undef MASK
}
#undef KSWZ
#undef SBAR
}
struct Frame {
    LAS unsigned char* lds;
    int tid, lane, wave, vcu, G;
};
#define CAS __attribute__((address_space(4)))
__device__ __forceinline__ const CAS char* karg() { return (const CAS char*)__builtin_amdgcn_kernarg_segment_ptr(); }
template <int I> __device__ __forceinline__ const float* in_ptr() { unsigned off = I * 8; asm volatile("" : "+s"(off)); return *(const float* const CAS*)(karg() + off); }
__device__ __forceinline__ float* out_ptr() { unsigned off = 26 * 8; asm volatile("" : "+s"(off)); return *(float* const CAS*)(karg() + off); }
__device__ __forceinline__ unsigned char* ws_ptr() { unsigned off = 27 * 8; asm volatile("" : "+s"(off)); return *(unsigned char* const CAS*)(karg() + off); }
enum { I_X = 0, I_C, I_CTX, I_CCTX, I_WADA, I_BADA, I_NMIXG, I_NFFNG, I_WIN, I_NAQG, I_NAKG, I_RPB, I_CQG, I_WUQ, I_CKVG, I_WUKV, I_QG, I_KG, I_WOA, I_WOB, I_WOUT, I_WR, I_RB, I_W1, I_W3, I_W2 };

#define LDS_WAIT() asm volatile("s_waitcnt lgkmcnt(0)" ::: "memory")

__device__ __forceinline__ int win_src_col(int np) {
    const int pn = np >> 8, cc = np & 255;
    if (pn < 4) { const int part = pn >> 1, tq = pn & 1, bj = cc >> 7, wc = (cc >> 5) & 3, i = cc & 31; return part * 512 + (4 * tq + wc) * 64 + 32 * bj + i; }
    if (pn < 6) return 1024 + (pn - 4) * 256 + cc;
    if (pn == 6) return 1536 + cc;
    if (pn == 7) return cc < 128 ? 1792 + cc : (cc < 160 ? 2176 + (cc - 128) : -1);
    if (pn == 8) return 1920 + cc;
    return 2208 + (pn - 9) * 256 + cc;
}
__device__ __forceinline__ void conv_item(const float* src, size_t ld, int dcol, int dstep, const float* gain, bf16_t* WT, int K, int k0, int n0, LAS float* scr, int lane) {
    const int kr = lane >> 4;
#pragma unroll 4
    for (int i = 0; i < 16; ++i) { const int kk = 4 * i + kr;
        f32x4 v = (f32x4){0.f, 0.f, 0.f, 0.f};
        if (src) v = *(const f32x4*)(src + (size_t)(k0 + kk) * ld);
        if (gain) v = v * gain[k0 + kk];
        LAS float* s = scr + kk * 65 + dcol; s[0] = v[0]; s[dstep] = v[1]; s[2 * dstep] = v[2]; s[3 * dstep] = v[3]; }
    LDS_WAIT(); asm volatile("" ::: "memory");
    const int c = lane & 7;
#pragma unroll
    for (int j = 0; j < 8; ++j) { const int n = (lane >> 3) + 8 * j; const LAS float* s = scr + (8 * c) * 65 + n;
        u32x4 o; o.x = cvt_pk_bf16(s[0 * 65], s[1 * 65]); o.y = cvt_pk_bf16(s[2 * 65], s[3 * 65]); o.z = cvt_pk_bf16(s[4 * 65], s[5 * 65]); o.w = cvt_pk_bf16(s[6 * 65], s[7 * 65]);
        *(u32x4*)(WT + (size_t)(n0 + n) * K + k0 + 8 * c) = o; }
    LDS_WAIT(); asm volatile("" ::: "memory");
}
__device__ __forceinline__ void p0_convert(Frame& F) {
    LAS float* scr = (LAS float*)(F.lds + F.wave * 16640);
    const int gw = F.vcu * 8 + F.wave, NGW = F.G * 8, lane = F.lane, q16 = lane & 15;
    constexpr int I_IN = 16 * 68, I_UQ = 6 * 16, I_UKV = 4 * 16, I_OA = 8 * 16, I_OUT = 16 * 16, I_13 = 16 * 32 * NEXP, I_2 = 16 * 16 * NEXP;
    constexpr int PER_L = I_IN + I_UQ + I_UKV + 2 * I_OA + I_OUT + I_13 + I_2;
    unsigned char* const ws = ws_ptr();
    for (int it = gw; it < NLAYER * PER_L; it += NGW) {
        const int l = it / PER_L; int r = it - l * PER_L;
        if (r < I_IN) { const int kb = r / 68, nb = r % 68, sc = win_src_col(nb * 64 + 4 * q16);
            conv_item(sc >= 0 ? in_ptr<I_WIN>() + (size_t)l * DM * INC + sc : nullptr, INC, 4 * q16, 1, nullptr, (bf16_t*)(ws + WS_WIN) + (size_t)l * INP * DM, DM, kb * 64, nb * 64, scr, lane); continue; } r -= I_IN;
        if (r < I_UQ) { const int kb = r / 16, nb = r % 16, np = nb * 64 + 4 * q16, hh = np >> 7, dd = np & 127;
            conv_item(dd < QKD ? in_ptr<I_WUQ>() + (size_t)l * QLORA * 768 + hh * QKD + dd : nullptr, 768, 4 * q16, 1, in_ptr<I_CQG>() + l * QLORA, (bf16_t*)(ws + WS_WUQ) + (size_t)l * 1024 * QLORA, QLORA, kb * 64, nb * 64, scr, lane); continue; } r -= I_UQ;
        if (r < I_UKV) { const int kb = r / 16, nb = r % 16;
            conv_item(in_ptr<I_WUKV>() + (size_t)l * KVLORA * 1024 + nb * 64 + 4 * q16, 1024, 4 * q16, 1, in_ptr<I_CKVG>() + l * KVLORA, (bf16_t*)(ws + WS_WUKV) + (size_t)l * 1024 * KVLORA, KVLORA, kb * 64, nb * 64, scr, lane); continue; } r -= I_UKV;
        if (r < 2 * I_OA) { const int w = r / I_OA, rr = r % I_OA, kb = rr / 16, nb = rr % 16;
            conv_item((w ? in_ptr<I_WOB>() : in_ptr<I_WOA>()) + (size_t)l * 512 * DM + nb * 64 + 4 * q16, DM, 4 * q16, 1, nullptr, (bf16_t*)(ws + (w ? WS_WOB : WS_WOA)) + (size_t)l * 1024 * 512, 512, kb * 64, nb * 64, scr, lane); continue; } r -= 2 * I_OA;
        if (r < I_OUT) { const int kb = r / 16, nb = r % 16;
            conv_item(in_ptr<I_WOUT>() + (size_t)l * DM * DM + nb * 64 + 4 * q16, DM, 4 * q16, 1, nullptr, (bf16_t*)(ws + WS_WOUT) + (size_t)l * DM * DM, DM, kb * 64, nb * 64, scr, lane); continue; } r -= I_OUT;
        if (r < I_13) { const int e = r / 512, rr = r % 512, kb = rr / 32, nb = rr % 32;
            const float* base = ((q16 < 8) ? in_ptr<I_W1>() : in_ptr<I_W3>()) + ((size_t)l * NEXP + e) * DM * DM + nb * 32 + 4 * (q16 & 7);
            conv_item(base, DM, 8 * (q16 & 7) + (q16 >> 3), 2, nullptr, (bf16_t*)(ws + WS_W13) + ((size_t)l * NEXP + e) * 2048 * DM, DM, kb * 64, nb * 64, scr, lane); continue; } r -= I_13;
        { const int e = r / 256, rr = r % 256, kb = rr / 16, nb = rr % 16;
            conv_item(in_ptr<I_W2>() + ((size_t)l * NEXP + e) * DM * DM + nb * 64 + 4 * q16, DM, 4 * q16, 1, nullptr, (bf16_t*)(ws + WS_W2) + ((size_t)l * NEXP + e) * DM * DM, DM, kb * 64, nb * 64, scr, lane); }
    }
}
__device__ __forceinline__ void p0_ada(Frame& F) {
    if ((int)blockIdx.x >= 2 * 96) return;
    unsigned char* const ws = ws_ptr(); const float* const cin = in_ptr<I_C>(); const float* const cctx = in_ptr<I_CCTX>(); const float* const wada = in_ptr<I_WADA>(); const float* const bada = in_ptr<I_BADA>();
    LAS float* sct = (LAS float*)F.lds;
    LAS float* red = (LAS float*)(F.lds + 1024 * 20 * 4);
    for (int idx = F.tid; idx < 17 * 1024; idx += 512) { const int r = idx >> 10, d = idx & 1023; const float v = (r < 16) ? cin[r * DM + d] : cctx[d]; sct[d * 20 + r] = v * (1.0f / (1.0f + expf(-v))); }
    __syncthreads();
    float* MOD = (float*)(ws + WS_MOD);
    for (int task = blockIdx.x; task < 2 * 96; task += F.G) {
        const int l = task / 96, cb = task % 96, col = cb * 64 + F.lane;
        const float* wa = wada + (size_t)l * DM * NMODC + col;
        float acc[17];
#pragma unroll
        for (int r = 0; r < 17; ++r) acc[r] = 0.f;
        for (int k = F.wave * 128; k < F.wave * 128 + 128; ++k) { const float wv = wa[(size_t)k * NMODC];
#pragma unroll
            for (int r = 0; r < 17; ++r) acc[r] += sct[k * 20 + r] * wv; }
#pragma unroll
        for (int r = 0; r < 17; ++r) red[(F.wave * 17 + r) * 64 + F.lane] = acc[r];
        __syncthreads();
        for (int idx = F.tid; idx < 17 * 64; idx += 512) { const int r = idx >> 6, cl = idx & 63; float s = bada[l * NMODC + cb * 64 + cl];
#pragma unroll
            for (int w = 0; w < 8; ++w) s += red[(w * 17 + r) * 64 + cl];
            MOD[((size_t)l * 17 + r) * NMODC + cb * 64 + cl] = s; }
        __syncthreads();
    }
    if (blockIdx.x == 0) { float* rope = (float*)(ws + WS_ROPE); const int pos = F.tid >> 3, i = F.tid & 7;
        const float inv = exp2f(-(float)i * 0.125f * 13.287712379549449f);
        const float ang = (float)pos * inv; const float rev = ang * 0.15915494309189535f, fr = rev - floorf(rev); rope[pos * 8 + i] = __builtin_amdgcn_cosf(fr); rope[512 + pos * 8 + i] = __builtin_amdgcn_sinf(fr); }
}

__device__ __forceinline__ void load_row(const float* xrow, int lane, f32x4 (&v)[4]) {
#pragma unroll
    for (int j = 0; j < 4; ++j) v[j] = *((const f32x4*)xrow + lane + 64 * j);
}
__device__ __forceinline__ float row_rstd(const f32x4 (&v)[4]) {
    float s = 0.f;
#pragma unroll
    for (int j = 0; j < 4; ++j) s += (v[j][0] * v[j][0] + v[j][1] * v[j][1]) + (v[j][2] * v[j][2] + v[j][3] * v[j][3]);
    return rsqrtf(wave_sum(s) * (1.0f / DM) + RMS_EPS);
}
__device__ __forceinline__ void normmod(const f32x4 (&v)[4], float rstd, const float* g, const float* sh, const float* sc, int lane, f32x4 (&h)[4]) {
#pragma unroll
    for (int j = 0; j < 4; ++j) { const f32x4 gv = *((const f32x4*)g + lane + 64 * j), shv = *((const f32x4*)sh + lane + 64 * j), scv = *((const f32x4*)sc + lane + 64 * j);
        h[j] = v[j] * rstd * gv * (scv + 1.0f) + shv; }
}
__device__ __forceinline__ void store_row_bf16(bf16_t* orow, int lane, const f32x4 (&h)[4]) {
#pragma unroll
    for (int j = 0; j < 4; ++j) { u32x2 w; w.x = cvt_pk_bf16(h[j][0], h[j][1]); w.y = cvt_pk_bf16(h[j][2], h[j][3]); *((u32x2*)orow + lane + 64 * j) = w; }
}
__device__ __forceinline__ void p0_hrows(Frame& F) {
    unsigned char* const ws = ws_ptr(); const float* const xin = in_ptr<I_X>(); const float* const cxin = in_ptr<I_CTX>(); const float* const gmix = in_ptr<I_NMIXG>();
    const int gw = F.vcu * 8 + F.wave, NGW = F.G * 8; const float* MOD = (const float*)(ws + WS_MOD); bf16_t* H = (bf16_t*)(ws + WS_H);
    for (int t = gw; t < TALL; t += NGW) {
        const float* xr = (t < TX) ? xin + (size_t)t * DM : cxin + (size_t)(t - TX) * DM;
        const float* md = MOD + (size_t)((t < TX) ? (t >> 11) : 16) * NMODC;
        f32x4 v[4], h[4]; load_row(xr, F.lane, v); const float rstd = row_rstd(v);
        normmod(v, rstd, gmix, md, md + DM, F.lane, h); store_row_bf16(H + (size_t)t * DM, F.lane, h);
    }
}
__device__ __forceinline__ void stats_phase(Frame& F, int ntok) {
    unsigned char* const ws = ws_ptr();
    const int gw = F.vcu * 8 + F.wave, NGW = F.G * 8, lane = F.lane;
    const bf16_t* ZCQ = (const bf16_t*)(ws + WS_ZCQ); const bf16_t* ZCKV = (const bf16_t*)(ws + WS_ZCKV); const bf16_t* ZKR = (const bf16_t*)(ws + WS_ZKR);
    float* RSCQ = (float*)(ws + WS_RSCQ); float* RSCKV = (float*)(ws + WS_RSCKV); float* SSKR = (float*)(ws + WS_SSKR);
    for (int t = gw; t < ntok; t += NGW) {
        float a = 0.f, b = 0.f, c = 0.f;
        if (lane < 48) { const u32x4 w = *(const u32x4*)(ZCQ + (size_t)t * QLORA + 8 * lane); a = (bf_lo(w.x) * bf_lo(w.x) + bf_hi(w.x) * bf_hi(w.x)) + (bf_lo(w.y) * bf_lo(w.y) + bf_hi(w.y) * bf_hi(w.y)) + (bf_lo(w.z) * bf_lo(w.z) + bf_hi(w.z) * bf_hi(w.z)) + (bf_lo(w.w) * bf_lo(w.w) + bf_hi(w.w) * bf_hi(w.w)); }
        if (lane < 32) { const u32x4 w = *(const u32x4*)(ZCKV + (size_t)t * KVLORA + 8 * lane); b = (bf_lo(w.x) * bf_lo(w.x) + bf_hi(w.x) * bf_hi(w.x)) + (bf_lo(w.y) * bf_lo(w.y) + bf_hi(w.y) * bf_hi(w.y)) + (bf_lo(w.z) * bf_lo(w.z) + bf_hi(w.z) * bf_hi(w.z)) + (bf_lo(w.w) * bf_lo(w.w) + bf_hi(w.w) * bf_hi(w.w)); }
        if (lane < 4) { const u32x4 w = *(const u32x4*)(ZKR + (size_t)t * ROPED + 8 * lane); c = (bf_lo(w.x) * bf_lo(w.x) + bf_hi(w.x) * bf_hi(w.x)) + (bf_lo(w.y) * bf_lo(w.y) + bf_hi(w.y) * bf_hi(w.y)) + (bf_lo(w.z) * bf_lo(w.z) + bf_hi(w.z) * bf_hi(w.z)) + (bf_lo(w.w) * bf_lo(w.w) + bf_hi(w.w) * bf_hi(w.w)); }
        a = wave_sum(a); b = wave_sum(b); c = wave_sum(c);
        if (lane == 0) { RSCQ[t] = rsqrtf(a * (1.0f / QLORA) + RMS_EPS); RSCKV[t] = rsqrtf(b * (1.0f / KVLORA) + RMS_EPS); SSKR[t] = c; }
    }
}

__device__ __forceinline__ void route_phase(Frame& F, int l, int ntok) {
    unsigned char* const ws = ws_ptr(); const float* const xcur = out_ptr();
    LAS float* h2t = (LAS float*)F.lds;
    LAS float* part = (LAS float*)(F.lds + 65536);
    LAS float* logit = (LAS float*)(F.lds + 65536 + 32768);
    const float* MOD = (const float*)(ws + WS_MOD) + (size_t)l * 17 * NMODC; const float* XC = (const float*)(ws + WS_XC);
    const float* g = in_ptr<I_NFFNG>() + l * DM; const float* wr = in_ptr<I_WR>(); const float rbias = in_ptr<I_RB>()[F.lane];
    int* TOKE = (int*)(ws + WS_TOKE); float* TOKW = (float*)(ws + WS_TOKW); int* TOKP = (int*)(ws + WS_TOKP); float* RSTD2 = (float*)(ws + WS_RSTD2);
    unsigned* cnt = (unsigned*)(ws + WS_CTL) + CW_CNT + l * 2048;
    const int lane = F.lane, w = F.wave;
    float wv[128];
#pragma unroll
    for (int i = 0; i < 128; ++i) wv[i] = wr[(w * 128 + i) * NEXP + lane];
    for (int it = blockIdx.x; it < ntok / 16; it += F.G) {
        const int T0 = it * 16;
#pragma unroll
        for (int tt = 0; tt < 2; ++tt) { const int tl = 2 * w + tt, t = T0 + tl;
            const float* xr = (t < TX) ? xcur + (size_t)t * DM : XC + (size_t)(t - TX) * DM; const float* md = MOD + (size_t)((t < TX) ? (t >> 11) : 16) * NMODC;
            f32x4 v[4], h[4]; load_row(xr, lane, v); const float rstd = row_rstd(v); if (lane == 0) RSTD2[t] = rstd;
            normmod(v, rstd, g, md + 3 * DM, md + 4 * DM, lane, h);
#pragma unroll
            for (int j = 0; j < 4; ++j) *(LAS f32x4*)(h2t + tl * DM + 4 * lane + 256 * j) = h[j];
        }
        __syncthreads();
        { float acc[16];
#pragma unroll
          for (int t = 0; t < 16; ++t) acc[t] = 0.f;
#pragma unroll
          for (int gq = 0; gq < 32; ++gq) {
#pragma unroll
              for (int hf = 0; hf < 2; ++hf) {
                  f32x4 hv[8];
#pragma unroll
                  for (int t = 0; t < 8; ++t) hv[t] = *(const LAS f32x4*)(h2t + (8 * hf + t) * DM + w * 128 + 4 * gq);
#pragma unroll
                  for (int t = 0; t < 8; ++t)
#pragma unroll
                      for (int q = 0; q < 4; ++q) acc[8 * hf + t] += hv[t][q] * wv[4 * gq + q];
              }
          }
#pragma unroll
          for (int t = 0; t < 16; ++t) part[(w * 16 + t) * 64 + lane] = acc[t]; }
        __syncthreads();
#pragma unroll
        for (int k = 0; k < 2; ++k) { const int idx = F.tid + 512 * k, t = idx >> 6, e = idx & 63; float s = 0.f;
#pragma unroll
            for (int ww = 0; ww < 8; ++ww) s += part[(ww * 16 + t) * 64 + e];
            logit[t * 64 + e] = s; }
        __syncthreads();
#pragma unroll
        for (int tt = 0; tt < 2; ++tt) { const int tl = 2 * w + tt, t = T0 + tl;
            const float sg = 1.0f / (1.0f + expf(-logit[tl * 64 + lane])); const float bs = sg + rbias;
            float m1 = -3.0e38f, m2 = -3.0e38f; int i1 = 0, i2 = 0;
#pragma unroll
            for (int j = 0; j < 8; ++j) { const float vv = __shfl(bs, (lane & ~7) + j); if (vv > m1) { m2 = m1; i2 = i1; m1 = vv; i1 = j; } else if (vv > m2) { m2 = vv; i2 = j; } }
            const float gs = m1 + m2; float best = -3.0e38f; int gsel = 0;
#pragma unroll
            for (int j = 0; j < 8; ++j) { const float vv = __shfl(gs, 8 * j); if (vv > best) { best = vv; gsel = j; } }
            const int e1 = gsel * 8 + __shfl(i1, gsel * 8), e2 = gsel * 8 + __shfl(i2, gsel * 8);
            const float s1 = __shfl(sg, e1), s2 = __shfl(sg, e2), inv = 1.0f / (s1 + s2);
            if (lane == 0) { const int p1 = (int)atomicAdd(cnt + e1 * 16, 1u), p2 = (int)atomicAdd(cnt + e2 * 16, 1u);
                TOKE[2 * t] = e1; TOKE[2 * t + 1] = e2; TOKW[2 * t] = s1 * inv; TOKW[2 * t + 1] = s2 * inv; TOKP[2 * t] = p1; TOKP[2 * t + 1] = p2; }
        }
        __syncthreads();
    }
}
__device__ __forceinline__ void expert_offsets(Frame& F, unsigned char* ws, int l, LAS int* offl, bool publish) {
    if (F.wave == 0) {
        const unsigned c = __hip_atomic_load((unsigned*)(ws + WS_CTL) + CW_CNT + l * 2048 + F.lane * 16, RLX_AGENT);
        const int pad = (int)((c + 255u) & ~255u); int incl = pad;
#pragma unroll
        for (int o = 1; o < 64; o <<= 1) { const int v = __shfl_up(incl, o); if (F.lane >= o) incl += v; }
        offl[F.lane] = incl - pad; if (F.lane == 63) offl[64] = incl;
        if (publish) { int* TILEE = (int*)(ws + WS_TILEE); for (int t = (incl - pad) >> 8; t < (incl >> 8); ++t) TILEE[t] = F.lane; if (F.lane == 63) TILEE[511] = incl >> 8; }
    }
    __syncthreads();
}
__device__ __forceinline__ void scatter_phase(Frame& F, int l, int ntok) {
    unsigned char* const ws = ws_ptr(); const float* const xcur = out_ptr();
    LAS int* offl = (LAS int*)(F.lds + 1024);
    expert_offsets(F, ws, l, offl, blockIdx.x == 0);
    const int gw = F.vcu * 8 + F.wave, NGW = F.G * 8, lane = F.lane;
    const float* MOD = (const float*)(ws + WS_MOD) + (size_t)l * 17 * NMODC; const float* XC = (const float*)(ws + WS_XC); const float* g = in_ptr<I_NFFNG>() + l * DM;
    const int* TOKE = (const int*)(ws + WS_TOKE); const int* TOKP = (const int*)(ws + WS_TOKP); const float* RSTD2 = (const float*)(ws + WS_RSTD2); bf16_t* HS = (bf16_t*)(ws + WS_HS);
    for (int t = gw; t < ntok; t += NGW) {
        const float* xr = (t < TX) ? xcur + (size_t)t * DM : XC + (size_t)(t - TX) * DM; const float* md = MOD + (size_t)((t < TX) ? (t >> 11) : 16) * NMODC;
        f32x4 v[4], h[4]; load_row(xr, lane, v); normmod(v, RSTD2[t], g, md + 3 * DM, md + 4 * DM, lane, h);
        const int s1 = offl[TOKE[2 * t]] + TOKP[2 * t], s2 = offl[TOKE[2 * t + 1]] + TOKP[2 * t + 1];
        store_row_bf16(HS + (size_t)s1 * DM, lane, h); store_row_bf16(HS + (size_t)s2 * DM, lane, h);
    }
}
__device__ __forceinline__ void combine_phase(Frame& F, int l, int ntok, bool last) {
    unsigned char* const ws = ws_ptr(); float* const xcur = out_ptr();
    LAS int* offl = (LAS int*)(F.lds + 1024);
    expert_offsets(F, ws, l, offl, false);
    const int gw = F.vcu * 8 + F.wave, NGW = F.G * 8, lane = F.lane;
    const float* MOD = (const float*)(ws + WS_MOD) + (size_t)l * 17 * NMODC; float* XC = (float*)(ws + WS_XC);
    const int* TOKE = (const int*)(ws + WS_TOKE); const int* TOKP = (const int*)(ws + WS_TOKP); const float* TOKW = (const float*)(ws + WS_TOKW);
    const bf16_t* YS = (const bf16_t*)(ws + WS_YS); bf16_t* H = (bf16_t*)(ws + WS_H);
    for (int t = gw; t < ntok; t += NGW) {
        float* xr = (t < TX) ? xcur + (size_t)t * DM : XC + (size_t)(t - TX) * DM; const int bi = (t < TX) ? (t >> 11) : 16; const float* md = MOD + (size_t)bi * NMODC;
        const int s1 = offl[TOKE[2 * t]] + TOKP[2 * t], s2 = offl[TOKE[2 * t + 1]] + TOKP[2 * t + 1]; const float w1 = TOKW[2 * t], w2 = TOKW[2 * t + 1];
        f32x4 v[4]; load_row(xr, lane, v);
#pragma unroll
        for (int j = 0; j < 4; ++j) { const u32x2 a = *((const u32x2*)(YS + (size_t)s1 * DM) + lane + 64 * j), b = *((const u32x2*)(YS + (size_t)s2 * DM) + lane + 64 * j);
            const f32x4 gf = *((const f32x4*)(md + 5 * DM) + lane + 64 * j);
            const f32x4 y = (f32x4){bf_lo(a.x), bf_hi(a.x), bf_lo(a.y), bf_hi(a.y)} * w1 + (f32x4){bf_lo(b.x), bf_hi(b.x), bf_lo(b.y), bf_hi(b.y)} * w2;
            v[j] = v[j] + gf * y; *((f32x4*)xr + lane + 64 * j) = v[j]; }
        if (!last) { const float* md2 = MOD + (size_t)17 * NMODC + (size_t)bi * NMODC; f32x4 h[4]; const float rstd = row_rstd(v);
            normmod(v, rstd, in_ptr<I_NMIXG>() + (l + 1) * DM, md2, md2 + DM, lane, h); store_row_bf16(H + (size_t)t * DM, lane, h); }
    }
}
constexpr int NPHASE = 2 + 11 * NLAYER;
struct Args { const float* in[26]; float* out; unsigned char* ws; int ph_lo, ph_hi; };

__device__ __attribute__((noinline)) void grid_barrier_fn(GAS unsigned* barw, unsigned x, LAS unsigned* st) { XcdBarrier b; b.bar = (unsigned*)barw; b.x = x; b.st = (volatile LAS unsigned*)st; xcd_barrier(b); }

__global__ void __launch_bounds__(512, 2) fwd_kernel(Args args) {
    extern __shared__ __attribute__((aligned(16))) unsigned char lds_raw[];
    Frame F;
    F.lds = (LAS unsigned char*)lds_raw;
    F.tid = threadIdx.x; F.lane = F.tid & 63; F.wave = __builtin_amdgcn_readfirstlane(F.tid >> 6);
    F.G = gridDim.x; { const int bx = blockIdx.x; F.vcu = (F.G % 8 == 0) ? (bx % 8) * (F.G / 8) + bx / 8 : bx; }
    volatile LAS unsigned* MISC = (volatile LAS unsigned*)(F.lds + MISC_OFF);
    if (F.tid < 64) MISC[F.tid] = 0u;
    __syncthreads();
    const int lo = args.ph_lo, hi = args.ph_hi;
#if MK_SPLIT
#define GRID_BAR() do { } while (0)
#else
    XcdBarrier bar = xcd_barrier_post((unsigned*)(ws_ptr() + WS_CTL) + CW_BAR, MISC + 8);
#define GRID_BAR() grid_barrier_fn((GAS unsigned*)bar.bar, bar.x, (LAS unsigned*)bar.st)
#endif
#ifndef PH_MASK
#define PH_MASK 0xFFFFFFFFu
#endif
#define PHK(k) ((k) < 2 ? (k) : 2 + ((k) - 2) % 11)
#define IN(k) (((PH_MASK >> PHK(k)) & 1u) && lo <= (k) && (k) < hi)
#ifndef PH_DUP
#define PH_DUP 0u
#endif
#define REP0(k) for (int rep_ = 0; rep_ < (((PH_DUP >> (k)) & 1u) ? 2 : 1); ++rep_)
#define REPL(n) for (int rep_ = 0; rep_ < ((((PH_DUP >> (2 + (n))) & 1u) && ((n) != 5 || l == 0)) ? 2 : 1); ++rep_)
#define SEAM(k) do { if (IN(k) && IN((k) + 1)) GRID_BAR(); } while (0)
#define FRESH() Frame Fp = F; int G = F.G, c = (int)blockIdx.x; asm volatile("" : "+v"(Fp.tid), "+v"(Fp.lane)); asm volatile("" : "+s"(Fp.wave), "+s"(Fp.vcu), "+s"(Fp.G), "+s"(G), "+s"(c))

    if (IN(0)) REP0(0) { FRESH(); (void)G; (void)c; p0_convert(Fp); __syncthreads(); p0_ada(Fp); }
    SEAM(0);
    if (IN(1)) REP0(1) { FRESH(); (void)G; (void)c; p0_hrows(Fp); }
    SEAM(1);

    for (int l = 0; l < NLAYER; ++l) {
        const int base = 2 + 11 * l; const bool last = (l == NLAYER - 1);
        const int mt_act = last ? MT_X : MT_ALL;
        const int ntok = last ? TX : TALL;
        if (IN(base + 0)) REPL(0) {
            FRESH(); unsigned char* const ws = ws_ptr();
            pg8::SchedRect S{(const char*)(ws + WS_H), (const char*)((bf16_t*)(ws + WS_WIN) + (size_t)l * INP * DM), (size_t)256 * DM * 2, mt_act, 17, G, c, MT_ALL - mt_act, 2, 7};
            pg8::EpiIn E{(bf16_t*)(ws + WS_QA), (bf16_t*)(ws + WS_KA), (bf16_t*)(ws + WS_VA), (bf16_t*)(ws + WS_ZCQ), (bf16_t*)(ws + WS_ZCKV), (bf16_t*)(ws + WS_ZKR), (bf16_t*)(ws + WS_GATES),
                         in_ptr<I_NAQG>() + l * 64, in_ptr<I_NAKG>() + l * 64};
            pg8::gemm_phase(Fp.lds, DM, S, E);
        }
        SEAM(base + 0);
        if (IN(base + 1)) REPL(1) { FRESH(); (void)G; (void)c; stats_phase(Fp, TALL); }
        SEAM(base + 1);
        if (IN(base + 2)) REPL(2) {
            FRESH();
#ifndef NO_EQ
            { unsigned char* const ws = ws_ptr();
              pg8::SchedRect S{(const char*)(ws + WS_ZCQ), (const char*)((bf16_t*)(ws + WS_WUQ) + (size_t)l * 1024 * QLORA), (size_t)256 * QLORA * 2, mt_act, 4, G, c, 0, 0, 1};
              pg8::EpiQ E{(bf16_t*)(ws + WS_QB), (const float*)(ws + WS_RSCQ), in_ptr<I_QG>() + l * QKD, (const float*)(ws + WS_ROPE), (LAS float*)(Fp.lds + EPI_OFF)};
              pg8::gemm_phase(Fp.lds, QLORA, S, E); }
#endif
#ifndef NO_EKV
            { unsigned char* const ws = ws_ptr();
              pg8::SchedRect S{(const char*)(ws + WS_ZCKV), (const char*)((bf16_t*)(ws + WS_WUKV) + (size_t)l * 1024 * KVLORA), (size_t)256 * KVLORA * 2, MT_ALL, 4, G, c, 0, 0, 1};
              pg8::EpiKV E{(bf16_t*)(ws + WS_KB), (bf16_t*)(ws + WS_VB), (const bf16_t*)(ws + WS_ZKR), (const float*)(ws + WS_RSCKV), (const float*)(ws + WS_SSKR), in_ptr<I_KG>() + l * QKD, (const float*)(ws + WS_ROPE), (LAS float*)(Fp.lds + EPI_OFF)};
              pg8::gemm_phase(Fp.lds, KVLORA, S, E); }
#endif
        }
        SEAM(base + 2);
        if (IN(base + 3)) REPL(3) {
            FRESH(); (void)c;
            const float C64 = 0.125f * 1.4426950408889634f, C96 = 0.10206207261596575f * 1.4426950408889634f;
            { unsigned char* const ws = ws_ptr();
              for (int u = Fp.vcu; u < 1024 + 256; u += G) {
                att::UnitArgs A; A.Q = (const bf16_t*)(ws + WS_QB); A.ldq = 768; A.K = (const bf16_t*)(ws + WS_KB); A.ldk = 768; A.V = (const bf16_t*)(ws + WS_VB); A.O = (bf16_t*)(ws + WS_OB);
                A.masked = 0; A.band = 0; A.krow0 = 0; A.bias = nullptr; A.C = C96;
                if (u < 1024) { const int bh = u >> 3, qb = u & 7, b = bh >> 3, h = bh & 7;
                    A.qcol = h * QKD; A.kcol = h * QKD; A.vcol = h * 64; A.ocol = h * 64; A.q0 = b * SEQ + qb * 256; A.ctx0 = TX + b * CTXL; A.loc0 = b * SEQ; A.NT = 36; }
                else { const int v = u - 1024; if (last || !(v & 1)) continue; const int bh = v >> 1, b = bh >> 3, h = bh & 7;
                    A.qcol = h * QKD; A.kcol = h * QKD; A.vcol = h * 64; A.ocol = h * 64; A.q0 = TX + b * CTXL; A.ctx0 = TX + b * CTXL; A.loc0 = 0; A.NT = 4; }
                att::attn_unit<96>(A, (char*)lds_raw);
              } }
            { unsigned char* const ws = ws_ptr(); const float* const rpb = in_ptr<I_RPB>();
              att::na_mask_table((char*)lds_raw);
              for (int u = Fp.vcu; u < 1024 + 256; u += G) {
                att::UnitArgs A; A.Q = (const bf16_t*)(ws + WS_QA); A.ldq = 512; A.K = (const bf16_t*)(ws + WS_KA); A.ldk = 512; A.V = (const bf16_t*)(ws + WS_VA); A.O = (bf16_t*)(ws + WS_OA); A.C = C64;
                if (u < 1024) { const int bh = u >> 3, band = u & 7, b = bh >> 3, h = bh & 7;
                    A.qcol = h * 64; A.kcol = h * 64; A.vcol = h * 64; A.ocol = h * 64; A.q0 = b * SEQ + band * 256; A.ctx0 = TX + b * CTXL;
                    A.krow0 = min(max(4 * band - 4, 0), 20); A.loc0 = b * SEQ + 64 * A.krow0; A.NT = 16; A.masked = 1; A.band = band; A.bias = rpb + ((size_t)l * NHEAD + h) * 15 * 31; }
                else { const int v = u - 1024; if (last || (v & 1)) continue; const int bh = v >> 1, b = bh >> 3, h = bh & 7;
                    A.qcol = h * 64; A.kcol = h * 64; A.vcol = h * 64; A.ocol = h * 64; A.q0 = TX + b * CTXL; A.ctx0 = TX + b * CTXL; A.loc0 = 0; A.NT = 4; A.masked = 0; A.band = 0; A.krow0 = 0; A.bias = nullptr; }
                att::attn_unit<64>(A, (char*)lds_raw);
              } }
        }
        SEAM(base + 3);
        if (IN(base + 4)) REPL(4) {
            FRESH(); unsigned char* const ws = ws_ptr();
            pg8::SchedMerge S{(const char*)(ws + WS_OA), (const char*)(ws + WS_OB), (const char*)((bf16_t*)(ws + WS_WOA) + (size_t)l * 1024 * 512), (const char*)((bf16_t*)(ws + WS_WOB) + (size_t)l * 1024 * 512),
                              (size_t)256 * 512 * 2, mt_act, 4, G, c};
            pg8::EpiMerge E{(const bf16_t*)(ws + WS_GATES), (bf16_t*)(ws + WS_Y)};
            pg8::gemm_phase(Fp.lds, 512, S, E);
        }
        SEAM(base + 4);
        if (IN(base + 5)) REPL(5) {
            FRESH(); unsigned char* const ws = ws_ptr(); float* const outp = out_ptr();
            pg8::SchedRect S{(const char*)(ws + WS_Y), (const char*)((bf16_t*)(ws + WS_WOUT) + (size_t)l * DM * DM), (size_t)256 * DM * 2, mt_act, 4, G, c, 0, 0, 1};
            pg8::EpiOut E{(l == 0) ? in_ptr<I_X>() : (const float*)outp, outp, in_ptr<I_CTX>(), (float*)(ws + WS_XC), (const float*)(ws + WS_MOD) + (size_t)l * 17 * NMODC, 2 * DM};
            pg8::gemm_phase(Fp.lds, DM, S, E);
        }
        SEAM(base + 5);
        if (IN(base + 6)) REPL(6) { FRESH(); (void)G; (void)c; route_phase(Fp, l, ntok); }
        SEAM(base + 6);
        if (IN(base + 7)) REPL(7) { FRESH(); (void)G; (void)c; scatter_phase(Fp, l, ntok); }
        SEAM(base + 7);
        if (IN(base + 8)) REPL(8) {
            FRESH(); unsigned char* const ws = ws_ptr();
            const int ntile = __builtin_amdgcn_readfirstlane(ld_i32_agent((const int*)(ws + WS_TILEE) + 511));
            pg8::SchedMoe S{(const char*)(ws + WS_HS), (const char*)((bf16_t*)(ws + WS_W13) + (size_t)l * NEXP * 2048 * DM), (size_t)256 * DM * 2, (size_t)2048 * DM * 2, (size_t)256 * DM * 2,
                            (const int*)(ws + WS_TILEE), ntile, 8, G, c};
            pg8::EpiMoe1 E{(bf16_t*)(ws + WS_HMID)};
            pg8::gemm_phase(Fp.lds, DM, S, E);
        }
        SEAM(base + 8);
        if (IN(base + 9)) REPL(9) {
            FRESH(); unsigned char* const ws = ws_ptr();
            const int ntile = __builtin_amdgcn_readfirstlane(ld_i32_agent((const int*)(ws + WS_TILEE) + 511));
            pg8::SchedMoe S{(const char*)(ws + WS_HMID), (const char*)((bf16_t*)(ws + WS_W2) + (size_t)l * NEXP * DM * DM), (size_t)256 * DM * 2, (size_t)DM * DM * 2, (size_t)256 * DM * 2,
                            (const int*)(ws + WS_TILEE), ntile, 4, G, c};
            pg8::EpiMoe2 E{(bf16_t*)(ws + WS_YS)};
            pg8::gemm_phase(Fp.lds, DM, S, E);
        }
        SEAM(base + 9);
        if (IN(base + 10)) REPL(10) { FRESH(); (void)G; (void)c; combine_phase(Fp, l, ntok, last); }
        if (!last) SEAM(base + 10);
    }
#undef IN
#undef SEAM
#undef GRID_BAR
}

extern "C" void kernel_launch(void* const* d_in, const int* in_sizes, int n_in, void* d_out, int out_size, void* d_ws, size_t ws_size, hipStream_t stream) {
    static int grid = 0;
    if (grid == 0) {
        if (n_in != 26 || out_size != TX * DM || ws_size < WS_END) { fprintf(stderr, "kernel_launch: unexpected problem (n_in %d, out %d, ws %zu < %zu); nothing launched\n", n_in, out_size, ws_size, (size_t)WS_END); grid = -1; return; }
        int dev = 0, cus = 0, per_cu = 0;
        if (hipGetDevice(&dev) != hipSuccess || hipDeviceGetAttribute(&cus, hipDeviceAttributeMultiprocessorCount, dev) != hipSuccess) { grid = -1; return; }
        if (hipFuncSetAttribute((const void*)fwd_kernel, hipFuncAttributeMaxDynamicSharedMemorySize, LDS_BYTES) != hipSuccess) { fprintf(stderr, "kernel_launch: hipFuncSetAttribute failed\n"); grid = -1; return; }
        if (hipOccupancyMaxActiveBlocksPerMultiprocessor(&per_cu, (const void*)fwd_kernel, 512, LDS_BYTES) != hipSuccess || per_cu < 1) fprintf(stderr, "kernel_launch: occupancy query reports %d blocks per CU\n", per_cu);
        (void)hipGetLastError();
        grid = cus;
    }
    if (grid < 0) return;
    (void)in_sizes;
    (void)hipMemsetAsync((char*)d_ws + WS_CTL, 0, CTL_BYTES, stream);
    Args a{};
    for (int i = 0; i < 26; ++i) a.in[i] = (const float*)d_in[i];
    a.out = (float*)d_out; a.ws = (unsigned char*)d_ws;
#if MK_SPLIT
    for (int p = 0; p < NPHASE; ++p) { a.ph_lo = p; a.ph_hi = p + 1; hipLaunchKernelGGL(fwd_kernel, dim3(grid), dim3(512), LDS_BYTES, stream, a); }
#else
    a.ph_lo = 0; a.ph_hi = NPHASE;
    hipLaunchKernelGGL(fwd_kernel, dim3(grid), dim3(512), LDS_BYTES, stream, a);
#endif
    const hipError_t le = hipPeekAtLastError();
    if (le != hipSuccess) fprintf(stderr, "kernel_launch: launch failed: %s\n", hipGetErrorName(le));
}
```

```cpp
#include <hip/hip_runtime.h>
#include <hip/hip_bf16.h>
#include <cstdio>
#include <cstdint>

#ifndef MK_SPLIT
#define MK_SPLIT 0
#endif

#define LAS __attribute__((address_space(3)))
#define GAS __attribute__((address_space(1)))
typedef unsigned short bf16_t;
typedef short bf16x8 __attribute__((ext_vector_type(8)));
typedef short s16x4 __attribute__((ext_vector_type(4)));
typedef float f32x4 __attribute__((ext_vector_type(4)));
typedef float f32x2 __attribute__((ext_vector_type(2)));
typedef float f32x16 __attribute__((ext_vector_type(16)));
typedef unsigned u32x4 __attribute__((ext_vector_type(4)));
typedef unsigned u32x2 __attribute__((ext_vector_type(2)));
#define RLX_AGENT __ATOMIC_RELAXED, __HIP_MEMORY_SCOPE_AGENT

constexpr int DM = 1024, NB = 16, SEQ = 2048, TX = NB * SEQ, CTXL = 256, TC = NB * CTXL, TALL = TX + TC;
constexpr int NHEAD = 8, GRIDW = 64;
constexpr int INC = 4256, INP = 4352;
constexpr int NEXP = 64, NMODC = 6 * DM;
constexpr int QLORA = 384, KVLORA = 256, QKD = 96, ROPED = 32;
constexpr int MT_X = TX / 256, MT_ALL = TALL / 256;
constexpr int NSLOT_MAX = 2 * TALL + NEXP * 256;
constexpr float RMS_EPS = 1e-6f;
constexpr int NLAYER = 2;

constexpr size_t al256(size_t x) { return (x + 255) & ~(size_t)255; }
constexpr size_t WS_CTL = 0, CTL_BYTES = 1u << 20;
constexpr size_t WS_MOD   = WS_CTL + CTL_BYTES;
constexpr size_t WS_ROPE  = WS_MOD + al256((size_t)NLAYER * 17 * NMODC * 4);
constexpr size_t WS_RSCQ  = WS_ROPE + al256(64 * 8 * 2 * 4);
constexpr size_t WS_RSCKV = WS_RSCQ + al256((size_t)TALL * 4);
constexpr size_t WS_SSKR  = WS_RSCKV + al256((size_t)TALL * 4);
constexpr size_t WS_TOKE  = WS_SSKR + al256((size_t)TALL * 4);
constexpr size_t WS_TOKW  = WS_TOKE + al256((size_t)TALL * 8);
constexpr size_t WS_TOKP  = WS_TOKW + al256((size_t)TALL * 8);
constexpr size_t WS_RSTD2 = WS_TOKP + al256((size_t)TALL * 8);
constexpr size_t WS_TILEE = WS_RSTD2 + al256((size_t)TALL * 4);
constexpr size_t WS_OFFS  = WS_TILEE + al256(512 * 4);
constexpr size_t WS_WIN   = WS_OFFS + al256(128 * 4);
constexpr size_t WS_WUQ   = WS_WIN + al256((size_t)NLAYER * INP * DM * 2);
constexpr size_t WS_WUKV  = WS_WUQ + al256((size_t)NLAYER * 1024 * QLORA * 2);
constexpr size_t WS_WOA   = WS_WUKV + al256((size_t)NLAYER * 1024 * KVLORA * 2);
constexpr size_t WS_WOB   = WS_WOA + al256((size_t)NLAYER * 1024 * 512 * 2);
constexpr size_t WS_WOUT  = WS_WOB + al256((size_t)NLAYER * 1024 * 512 * 2);
constexpr size_t WS_W13   = WS_WOUT + al256((size_t)NLAYER * 1024 * 1024 * 2);
constexpr size_t WS_W2    = WS_W13 + al256((size_t)NLAYER * NEXP * 2048 * 1024 * 2);
constexpr size_t WS_H     = WS_W2 + al256((size_t)NLAYER * NEXP * 1024 * 1024 * 2);
constexpr size_t WS_XC    = WS_H + al256((size_t)TALL * DM * 2);
constexpr size_t WS_ACT   = WS_XC + al256((size_t)TC * DM * 4);
constexpr size_t WS_QA    = WS_ACT;
constexpr size_t WS_KA    = WS_QA + al256((size_t)TALL * 512 * 2);
constexpr size_t WS_VA    = WS_KA + al256((size_t)TALL * 512 * 2);
constexpr size_t WS_ZCQ   = WS_VA + al256((size_t)TALL * 512 * 2);
constexpr size_t WS_ZCKV  = WS_ZCQ + al256((size_t)TALL * QLORA * 2);
constexpr size_t WS_ZKR   = WS_ZCKV + al256((size_t)TALL * KVLORA * 2);
constexpr size_t WS_GATES = WS_ZKR + al256((size_t)TALL * ROPED * 2);
constexpr size_t WS_QB    = WS_GATES + al256((size_t)TALL * 2048 * 2);
constexpr size_t WS_KB    = WS_QB + al256((size_t)TALL * 768 * 2);
constexpr size_t WS_VB    = WS_KB + al256((size_t)TALL * 768 * 2);
constexpr size_t WS_OA    = WS_VB + al256((size_t)TALL * 512 * 2);
constexpr size_t WS_OB    = WS_OA + al256((size_t)TALL * 512 * 2);
constexpr size_t WS_Y     = WS_OB + al256((size_t)TALL * 512 * 2);
constexpr size_t WS_MIX_END = WS_Y + al256((size_t)TALL * DM * 2);
constexpr size_t WS_HS    = WS_ACT;
constexpr size_t WS_HMID  = WS_HS + al256((size_t)NSLOT_MAX * DM * 2);
constexpr size_t WS_YS    = WS_HMID + al256((size_t)NSLOT_MAX * DM * 2);
constexpr size_t WS_MOE_END = WS_YS + al256((size_t)NSLOT_MAX * DM * 2);
constexpr size_t WS_END   = (WS_MIX_END > WS_MOE_END) ? WS_MIX_END : WS_MOE_END;

constexpr int CW_BAR = 4096;
constexpr int CW_CNT = 16384;

constexpr int RING_BYTES = 131072;
constexpr int EPI_OFF = RING_BYTES;
constexpr int MISC_OFF = RING_BYTES + 24576;
constexpr int LDS_BYTES = 160 * 1024;

__device__ __forceinline__ unsigned cvt_pk_bf16(float lo, float hi) { unsigned r; asm volatile("v_cvt_pk_bf16_f32 %0, %1, %2" : "=v"(r) : "v"(lo), "v"(hi)); return r; }
__device__ __forceinline__ float bf_lo(unsigned w) { return __uint_as_float(w << 16); }
__device__ __forceinline__ float bf_hi(unsigned w) { return __uint_as_float(w & 0xffff0000u); }
__device__ __forceinline__ float wave_sum(float v) {
#pragma unroll
    for (int o = 1; o < 64; o <<= 1) v += __shfl_xor(v, o);
    return v;
}
__device__ __forceinline__ float sigmoidf_(float x) { return __builtin_amdgcn_rcpf(1.0f + __expf(-x)); }
__device__ __forceinline__ int ld_i32_agent(const int* p) { return (int)__hip_atomic_load((const unsigned*)p, RLX_AGENT); }
#define XB_TMO      128
#define XB_XCNT(j)  (256  + 64 * (j))
#define XB_XSUB(j)  (1280 + 64 * (j))
#define XB_XGEN(j)  (2304 + 64 * (j))
#define XB_TOP      3328
#define XB_TOPGEN   3392
#define XCD_BAR_WORDS 3456
#define XB_SPIN_CAP (1u << 18)

__device__ __forceinline__ unsigned xb_ld(unsigned* p)              { return __hip_atomic_load(p, __ATOMIC_RELAXED, __HIP_MEMORY_SCOPE_AGENT); }
__device__ __forceinline__ unsigned xb_add(unsigned* p, unsigned v) { return __hip_atomic_fetch_add(p, v, __ATOMIC_RELAXED, __HIP_MEMORY_SCOPE_AGENT); }
__device__ __forceinline__ unsigned xb_xcc_id() { return (unsigned)__builtin_amdgcn_s_getreg((3 << 11) | 20) & 0xFu; }
#define XB_SPIN(cond, bar) do { unsigned _sp = 0; while (cond) { __builtin_amdgcn_s_sleep(1); \
    if ((++_sp & 255u) == 0u) { if (xb_ld(&(bar)[XB_TMO])) break; if (_sp > XB_SPIN_CAP) { atomicAdd(&(bar)[XB_TMO], 1u); break; } } } } while (0)

struct XcdBarrier {
    unsigned* bar; unsigned x;
    volatile LAS unsigned* st;
};

__device__ __forceinline__ XcdBarrier xcd_barrier_post(unsigned* bar, volatile LAS unsigned* st) {
    XcdBarrier b; b.bar = bar; b.x = xb_xcc_id(); b.st = st;
    if (threadIdx.x == 0) (void)xb_add(&bar[XB_XCNT(b.x)], 1u);
    return b;
}
__device__ __forceinline__ void xcd_barrier_complete(unsigned* bar, unsigned x, unsigned& nloc, unsigned& nx) {
    const unsigned G = gridDim.x * gridDim.y * gridDim.z;
    unsigned sum, cnt, mine, sp = 0u;
    for (;;) {
        sum = 0u; cnt = 0u; mine = 0u;
#pragma unroll
        for (unsigned j = 0; j < 16; ++j) { const unsigned c = xb_ld(&bar[XB_XCNT(j)]); sum += c; cnt += (c > 0u) ? 1u : 0u; mine = (j == x) ? c : mine; }
        if (sum == G) break;
        __builtin_amdgcn_s_sleep(1);
        if ((++sp & 255u) == 0u) { if (xb_ld(&bar[XB_TMO])) break; if (sp > XB_SPIN_CAP) { atomicAdd(&bar[XB_TMO], 1u); break; } }
    }
    nloc = mine > 0u ? mine : 1u; nx = cnt > 0u ? cnt : 1u;
}

__device__ __forceinline__ void xcd_barrier(const XcdBarrier& b) {
    asm volatile("s_waitcnt vmcnt(0)" ::: "memory");
    __syncthreads();
    if (threadIdx.x == 0) {
        unsigned* bar = b.bar;
        __builtin_amdgcn_s_waitcnt(0);
        unsigned nloc = b.st[0], nx = b.st[1];
        if (nloc == 0u) { xcd_barrier_complete(bar, b.x, nloc, nx); b.st[0] = nloc; b.st[1] = nx; }
        const unsigned old = xb_add(&bar[XB_XSUB(b.x)], 1u);
        const unsigned gen = old / nloc;
        if (old + 1u == (gen + 1u) * nloc) {
            __builtin_amdgcn_fence(__ATOMIC_RELEASE, "agent");
            asm volatile("s_waitcnt vmcnt(0)" ::: "memory");
            const unsigned og = xb_add(&bar[XB_TOP], 1u);
            const unsigned tg = og / nx;
            if (og + 1u == (tg + 1u) * nx) xb_add(&bar[XB_TOPGEN], 1u);
            else XB_SPIN(xb_ld(&bar[XB_TOPGEN]) == tg, bar);
            __builtin_amdgcn_fence(__ATOMIC_ACQUIRE, "agent");
            xb_add(&bar[XB_XGEN(b.x)], 1u);
            asm volatile("s_waitcnt vmcnt(0)" ::: "memory");
        } else {
            XB_SPIN(xb_ld(&bar[XB_XGEN(b.x)]) == gen, bar);
            __builtin_amdgcn_fence(__ATOMIC_ACQUIRE, "agent");
            asm volatile("s_waitcnt vmcnt(0)" ::: "memory");
        }
    }
    __syncthreads();
}

namespace pg8 {
constexpr int BM = 256, BK = 64, HALF = 128, HTB = HALF * BK * 2  , STAGE_BYTES = 8 * HTB, NXCD = 8, WGM = 8;
__host__ __device__ __forceinline__ int lds_byte(int r, int c) { const int st = (r >> 4) * 2 + (c >> 5), rr = r & 15, cc = c & 31, ob = rr * 64 + cc * 2; return st * 1024 + (ob ^ (((ob >> 9) & 1) << 5)); }
__host__ __device__ __forceinline__ void stage_rc(int b, int& R, int& C) { const int st = b / 1024, sb = b % 1024, swz = sb ^ (((sb >> 9) & 1) << 5); R = (st >> 1) * 16 + swz / 64; C = (st & 1) * 32 + (swz % 64) / 2; }
__host__ __device__ __forceinline__ int perm32(int rho) { const int n = rho >> 4, i = rho & 15; return 8 * (i >> 2) + 4 * n + (i & 3); }

struct Unit { int pm, pn, kind, e; };

__device__ __forceinline__ void rect_tile(int wgid_in, int nM, int nN, int& pm, int& pn) {
    const int nwg = nM * nN; int wgid = wgid_in;
    { const int q = nwg / NXCD, r = nwg % NXCD, xcd = wgid % NXCD, off = wgid / NXCD; wgid = (xcd < r ? xcd * (q + 1) : r * (q + 1) + (xcd - r) * q) + off; }
    const int nig = WGM * nN, gid = wgid / nig, fm = gid * WGM, gsz = (nM - fm) < WGM ? (nM - fm) : WGM;
    pm = fm + ((wgid % nig) % gsz); pn = (wgid % nig) / gsz;
}

template <class Epi, class Sched>
__device__ __forceinline__ void gemm_phase(LAS unsigned char* lds, const int K, const Sched& S, const Epi& E) {
    int tid = threadIdx.x; asm volatile("" : "+v"(tid));
    const int wid = __builtin_amdgcn_readfirstlane(tid >> 6), lane = tid & 63, wr = wid >> 2, wc = wid & 3, fr = lane & 15, fq = lane >> 4;
    const int nt = K / BK;
    unsigned voffA[2], voffB[2];
#pragma unroll
    for (int i = 0; i < 2; ++i) { int R, C; stage_rc(tid * 16 + i * 8192, R, C); const int Rb = Epi::PERM ? ((R & ~31) + perm32(R & 31)) : R;
        voffA[i] = (unsigned)(R * K + C) * 2u; voffB[i] = (unsigned)(Rb * K + C) * 2u; }
    const size_t kstep = (size_t)(BK * 2);
    const size_t hstep = (size_t)HALF * K * 2;
    const unsigned ldsw = (unsigned)wid * 1024u;
    const int aoff = lds_byte(wr * 64 + fr, fq * 8), boff = lds_byte(wc * 32 + fr, fq * 8);
#define PG8_SA(b, h) (((b) * 2 + (h)) * HTB)
#define PG8_SB(b, h) ((4 + (b) * 2 + (h)) * HTB)
#define PG8_STAGE(bufoff, gbase, voff) do { _Pragma("unroll") for (int _i = 0; _i < 2; ++_i) \
        __builtin_amdgcn_global_load_lds((const unsigned*)((const char*)(gbase) + (voff)[_i]), (LAS unsigned*)(lds + (bufoff) + ldsw + _i * 8192), 16, 0, 0); } while (0)
#define PG8_LDA(dst, b, h) do { _Pragma("unroll") for (int m = 0; m < 4; ++m) _Pragma("unroll") for (int k = 0; k < 2; ++k) dst[m][k] = *(const LAS bf16x8*)(lds + PG8_SA(b, h) + aoff + m * 2048 + k * 1024); } while (0)
#define PG8_LDB(dst, b, h) do { _Pragma("unroll") for (int n = 0; n < 2; ++n) _Pragma("unroll") for (int k = 0; k < 2; ++k) dst[n][k] = *(const LAS bf16x8*)(lds + PG8_SB(b, h) + boff + n * 2048 + k * 1024); } while (0)
#define PG8_MMA(ai, bj, At, Bt) do { __builtin_amdgcn_s_setprio(1); _Pragma("unroll") for (int m = 0; m < 4; ++m) _Pragma("unroll") for (int n = 0; n < 2; ++n) _Pragma("unroll") for (int k = 0; k < 2; ++k) \
        acc[ai][bj][m][n] = __builtin_amdgcn_mfma_f32_16x16x32_bf16(Bt[n][k], At[m][k], acc[ai][bj][m][n], 0, 0, 0); __builtin_amdgcn_s_setprio(0); } while (0)
#define PG8_WAIT_V(n) asm volatile("s_waitcnt vmcnt(" #n ")" ::: "memory")
#define PG8_WAIT_L(n) asm volatile("s_waitcnt lgkmcnt(" #n ")" ::: "memory")
#define PG8_BAR __builtin_amdgcn_s_barrier()
#define PG8_SCHED __builtin_amdgcn_sched_barrier(0)
    Unit cur, nxt; int ui = 0;
    if (!S.next(0, cur)) return;
    f32x4 acc[2][2][4][2];
#pragma unroll
    for (int a = 0; a < 2; ++a)
#pragma unroll
        for (int b = 0; b < 2; ++b)
#pragma unroll
            for (int m = 0; m < 4; ++m)
#pragma unroll
                for (int n = 0; n < 2; ++n) acc[a][b][m][n] = (f32x4){0.f, 0.f, 0.f, 0.f};
    bf16x8 At[4][2], B0[2][2], B1[2][2];
    const char* cA = S.a_ptr(cur); const char* cB = S.b_ptr(cur);
    PG8_STAGE(PG8_SB(0, 0), cB, voffB); PG8_STAGE(PG8_SB(0, 1), cB + hstep, voffB); PG8_STAGE(PG8_SA(0, 0), cA, voffA); PG8_STAGE(PG8_SA(0, 1), cA + hstep, voffA);
    if (wr == 1) PG8_BAR;
    PG8_WAIT_V(2); PG8_BAR;
    PG8_STAGE(PG8_SB(1, 0), cB + kstep, voffB); PG8_STAGE(PG8_SA(1, 0), cA + kstep, voffA); PG8_STAGE(PG8_SB(1, 1), cB + hstep + kstep, voffB);
    PG8_WAIT_V(6); PG8_BAR;
    for (;;) {
        const bool has_next = S.next(ui + 1, nxt);
        const char* nA = has_next ? S.a_ptr(nxt) : cA; const char* nB = has_next ? S.b_ptr(nxt) : cB;
#pragma unroll 1
        for (int t = 0; t < nt; t += 2) {
            const bool last = (t == nt - 2);
            const char* a1 = cA + (size_t)(t + 1) * kstep;
            const char* a2 = last ? nA : cA + (size_t)(t + 2) * kstep; const char* b2 = last ? nB : cB + (size_t)(t + 2) * kstep;
            const char* a3 = a2 + kstep; const char* b3 = b2 + kstep;
            PG8_LDB(B0, 0, 0); PG8_LDB(B1, 0, 1); PG8_SCHED; PG8_LDA(At, 0, 0); PG8_STAGE(PG8_SA(1, 1), a1 + hstep, voffA);
            PG8_WAIT_V(8); PG8_WAIT_L(0); PG8_BAR; PG8_MMA(0, 0, At, B0); PG8_MMA(0, 1, At, B1); PG8_BAR; PG8_SCHED;
            PG8_LDA(At, 0, 1); PG8_STAGE(PG8_SB(0, 0), b2, voffB); PG8_STAGE(PG8_SB(0, 1), b2 + hstep, voffB); PG8_STAGE(PG8_SA(0, 0), a2, voffA);
            PG8_WAIT_V(8); PG8_WAIT_L(0); PG8_BAR; PG8_MMA(1, 0, At, B0); PG8_MMA(1, 1, At, B1); PG8_BAR; PG8_SCHED;
            PG8_LDB(B0, 1, 0); PG8_LDB(B1, 1, 1); PG8_SCHED; PG8_LDA(At, 1, 0); PG8_STAGE(PG8_SA(0, 1), a2 + hstep, voffA);
            PG8_WAIT_V(8); PG8_WAIT_L(0); PG8_BAR; PG8_MMA(0, 0, At, B0); PG8_MMA(0, 1, At, B1); PG8_BAR; PG8_SCHED;
            PG8_LDA(At, 1, 1); PG8_STAGE(PG8_SB(1, 0), b3, voffB); PG8_STAGE(PG8_SB(1, 1), b3 + hstep, voffB); PG8_STAGE(PG8_SA(1, 0), a3, voffA);
            PG8_WAIT_V(8); PG8_WAIT_L(0); PG8_BAR; PG8_MMA(1, 0, At, B0); PG8_MMA(1, 1, At, B1); PG8_BAR; PG8_SCHED;
        }
        if (wr == 0) PG8_BAR;
        { int tz = threadIdx.x; asm volatile("" : "+v"(tz));
          const int wid2 = __builtin_amdgcn_readfirstlane(tz >> 6), lane2 = tz & 63; E(acc, cur, wid2 >> 2, wid2 & 3, lane2 & 15, lane2 >> 4); }
        if (!has_next) break;
        if (!(Epi::CHAIN && cur.kind == 0)) {
#pragma unroll
            for (int a = 0; a < 2; ++a)
#pragma unroll
                for (int b = 0; b < 2; ++b)
#pragma unroll
                    for (int m = 0; m < 4; ++m)
#pragma unroll
                        for (int n = 0; n < 2; ++n) acc[a][b][m][n] = (f32x4){0.f, 0.f, 0.f, 0.f};
        }
        cur = nxt; cA = nA; cB = nB; ++ui;
        if (wr == 1) PG8_BAR;
    }
    PG8_WAIT_V(0);
    PG8_BAR;
#undef PG8_SA
#undef PG8_SB
#undef PG8_STAGE
#undef PG8_LDA
#undef PG8_LDB
#undef PG8_MMA
#undef PG8_WAIT_V
#undef PG8_WAIT_L
#undef PG8_BAR
#undef PG8_SCHED
}
}
namespace pg8 {
__device__ __forceinline__ u32x4 pack8(const f32x4 a, const f32x4 b) { u32x4 w; w.x = cvt_pk_bf16(a[0], a[1]); w.y = cvt_pk_bf16(a[2], a[3]); w.z = cvt_pk_bf16(b[0], b[1]); w.w = cvt_pk_bf16(b[2], b[3]); return w; }
__device__ __forceinline__ float sumsq4(const f32x4 a) { return (a[0] * a[0] + a[1] * a[1]) + (a[2] * a[2] + a[3] * a[3]); }
#define EPI_BAR() do { asm volatile("s_waitcnt lgkmcnt(0)" ::: "memory"); __builtin_amdgcn_s_barrier(); asm volatile("" ::: "memory"); } while (0)

struct EpiIn {
    static constexpr bool PERM = true, CHAIN = false;
    bf16_t *QA, *KA, *VA, *ZCQ, *ZCKV, *ZKR, *GATES; const float *qg, *kg;
    __device__ __forceinline__ void operator()(f32x4 (&acc)[2][2][4][2], const Unit& u, int wr, int wc, int fr, int fq) const {
        const int row0 = u.pm * BM + wr * 64 + fr, pn = u.pn;
        if (pn < 4) {
            const float* g = (pn < 2) ? qg : kg; bf16_t* dst = (pn < 2) ? QA : KA; const int head = 4 * (pn & 1) + wc;
            f32x4 gv[2][2];
#pragma unroll
            for (int bj = 0; bj < 2; ++bj)
#pragma unroll
                for (int n = 0; n < 2; ++n) gv[bj][n] = *(const f32x4*)(g + 32 * bj + 8 * fq + 4 * n);
#pragma unroll
            for (int ai = 0; ai < 2; ++ai)
#pragma unroll
                for (int m = 0; m < 4; ++m) {
                    const size_t row = (size_t)(row0 + ai * HALF + m * 16);
                    float ss = (sumsq4(acc[ai][0][m][0]) + sumsq4(acc[ai][0][m][1])) + (sumsq4(acc[ai][1][m][0]) + sumsq4(acc[ai][1][m][1]));
                    ss += __shfl_xor(ss, 16); ss += __shfl_xor(ss, 32);
                    const float rstd = rsqrtf(ss * (1.0f / 64.0f) + RMS_EPS);
#pragma unroll
                    for (int bj = 0; bj < 2; ++bj)
                        *(u32x4*)(dst + row * 512 + head * 64 + 32 * bj + 8 * fq) = pack8(acc[ai][bj][m][0] * rstd * gv[bj][0], acc[ai][bj][m][1] * rstd * gv[bj][1]);
                }
        } else if (pn >= 9) {
#pragma unroll
            for (int ai = 0; ai < 2; ++ai)
#pragma unroll
                for (int m = 0; m < 4; ++m) {
                    const size_t row = (size_t)(row0 + ai * HALF + m * 16);
#pragma unroll
                    for (int bj = 0; bj < 2; ++bj) { f32x4 a = acc[ai][bj][m][0], b = acc[ai][bj][m][1];
#pragma unroll
                        for (int j = 0; j < 4; ++j) { a[j] = sigmoidf_(a[j]); b[j] = sigmoidf_(b[j]); }
                        *(u32x4*)(GATES + row * 2048 + (pn - 9) * 256 + 128 * bj + 32 * wc + 8 * fq) = pack8(a, b); }
                }
        } else {
#pragma unroll
            for (int ai = 0; ai < 2; ++ai)
#pragma unroll
                for (int m = 0; m < 4; ++m) {
                    const size_t row = (size_t)(row0 + ai * HALF + m * 16);
#pragma unroll
                    for (int bj = 0; bj < 2; ++bj) {
                        const u32x4 w = pack8(acc[ai][bj][m][0], acc[ai][bj][m][1]); const int cc = 128 * bj + 32 * wc + 8 * fq;
                        if (pn < 6) *(u32x4*)(VA + row * 512 + (pn - 4) * 256 + cc) = w;
                        else if (pn == 6) *(u32x4*)(ZCQ + row * QLORA + cc) = w;
                        else if (pn == 8) *(u32x4*)(ZCKV + row * KVLORA + cc) = w;
                        else { if (bj == 0) *(u32x4*)(ZCQ + row * QLORA + 256 + cc) = w; else if (wc == 0) *(u32x4*)(ZKR + row * ROPED + 8 * fq) = w; }
                    }
                }
        }
    }
};

__device__ __forceinline__ void rope8(float (&v)[8], const float* rope, int s  , int fq) {
    const int pos = (fq < 2) ? (s >> 6) : (s & 63);
    const f32x4 c0 = *(const f32x4*)(rope + pos * 8), c1 = *(const f32x4*)(rope + pos * 8 + 4), s0 = *(const f32x4*)(rope + 512 + pos * 8), s1 = *(const f32x4*)(rope + 512 + pos * 8 + 4);
    const float cs[8] = {c0[0], c0[1], c0[2], c0[3], c1[0], c1[1], c1[2], c1[3]}, sn[8] = {s0[0], s0[1], s0[2], s0[3], s1[0], s1[1], s1[2], s1[3]};
#pragma unroll
    for (int i = 0; i < 8; ++i) { const float o = __shfl_xor(v[i], 16); v[i] = (fq & 1) ? (o * sn[i] + v[i] * cs[i]) : (v[i] * cs[i] - o * sn[i]); }
}

struct EpiQ {
    static constexpr bool PERM = true, CHAIN = false;
    bf16_t* QB; const float *rs, *g, *rope; LAS float* P;
    __device__ __forceinline__ void operator()(f32x4 (&acc)[2][2][4][2], const Unit& u, int wr, int wc, int fr, int fq) const {
        const int row0 = u.pm * BM + wr * 64 + fr; const bool isx = u.pm < MT_X;
#ifdef EQ_TRIVIAL
#pragma unroll
        for (int ai = 0; ai < 2; ++ai)
#pragma unroll
            for (int m = 0; m < 4; ++m) { const size_t row = (size_t)(row0 + ai * HALF + m * 16);
#pragma unroll
                for (int bj = 0; bj < 2; ++bj) *(u32x4*)(QB + row * 768 + (2 * u.pn + bj) * QKD + 32 * wc + 8 * fq) = pack8(acc[ai][bj][m][0], acc[ai][bj][m][1]); }
        return;
#endif
#pragma unroll
        for (int ai = 0; ai < 2; ++ai)
#pragma unroll
            for (int m = 0; m < 4; ++m) {
                const float r = rs[row0 + ai * HALF + m * 16]; const int rl = ai * 64 + m * 16 + fr;
#pragma unroll
                for (int bj = 0; bj < 2; ++bj) {
                    float ss = (sumsq4(acc[ai][bj][m][0]) + sumsq4(acc[ai][bj][m][1])) * (r * r); ss += __shfl_xor(ss, 16); ss += __shfl_xor(ss, 32);
                    if (fq == 0) P[((wr * 128 + rl) * 2 + bj) * 4 + wc] = ss; }
                asm volatile("" ::: "memory");
            }
        EPI_BAR();
        if (wc < 3) {
            const f32x4 g0 = *(const f32x4*)(g + 32 * wc + 8 * fq), g1 = *(const f32x4*)(g + 32 * wc + 8 * fq + 4);
#pragma unroll
            for (int ai = 0; ai < 2; ++ai)
#pragma unroll
                for (int m = 0; m < 4; ++m) {
                    const int row = row0 + ai * HALF + m * 16, rl = ai * 64 + m * 16 + fr; const float r = rs[row];
#pragma unroll
                    for (int bj = 0; bj < 2; ++bj) {
                        const f32x4 p = *(const LAS f32x4*)(P + ((wr * 128 + rl) * 2 + bj) * 4);
                        const float rstd = r * rsqrtf(((p[0] + p[1]) + p[2]) * (1.0f / 96.0f) + RMS_EPS);
                        const f32x4 a = acc[ai][bj][m][0] * rstd * g0, b = acc[ai][bj][m][1] * rstd * g1;
                        float v[8] = {a[0], a[1], a[2], a[3], b[0], b[1], b[2], b[3]};
#ifndef EQ_NOROPE
                        if (wc == 2 && isx) rope8(v, rope, row & (SEQ - 1), fq);
#endif
                        u32x4 w; w.x = cvt_pk_bf16(v[0], v[1]); w.y = cvt_pk_bf16(v[2], v[3]); w.z = cvt_pk_bf16(v[4], v[5]); w.w = cvt_pk_bf16(v[6], v[7]);
                        *(u32x4*)(QB + (size_t)row * 768 + (2 * u.pn + bj) * QKD + 32 * wc + 8 * fq) = w;
                    }
                    asm volatile("" ::: "memory");
                }
        }
    }
};

struct EpiKV {
    static constexpr bool PERM = true, CHAIN = false;
    bf16_t *KB, *VB; const bf16_t* ZKR; const float *rs, *sskr, *g, *rope; LAS float* P;
    __device__ __forceinline__ void operator()(f32x4 (&acc)[2][2][4][2], const Unit& u, int wr, int wc, int fr, int fq) const {
        const int row0 = u.pm * BM + wr * 64 + fr; const bool isx = u.pm < MT_X;
#pragma unroll
        for (int ai = 0; ai < 2; ++ai)
#pragma unroll
            for (int m = 0; m < 4; ++m) {
                const float r = rs[row0 + ai * HALF + m * 16]; const int rl = ai * 64 + m * 16 + fr;
                if (wc < 2) {
#pragma unroll
                    for (int bj = 0; bj < 2; ++bj) { float ss = (sumsq4(acc[ai][bj][m][0]) + sumsq4(acc[ai][bj][m][1])) * (r * r); ss += __shfl_xor(ss, 16); ss += __shfl_xor(ss, 32);
                        if (fq == 0) P[((wr * 128 + rl) * 2 + bj) * 4 + wc] = ss; } }
                asm volatile("" ::: "memory");
            }
        EPI_BAR();
        const int gofs = (wc < 2) ? (32 * wc + 8 * fq) : (64 + 8 * fq);
        const f32x4 g0 = *(const f32x4*)(g + gofs), g1 = *(const f32x4*)(g + gofs + 4);
#pragma unroll
        for (int ai = 0; ai < 2; ++ai)
#pragma unroll
            for (int m = 0; m < 4; ++m) {
                const int row = row0 + ai * HALF + m * 16, rl = ai * 64 + m * 16 + fr;
                const float skr = sskr[row], rr = rs[row];
                u32x4 zk = (u32x4){0u, 0u, 0u, 0u}; if (wc == 2) zk = *(const u32x4*)(ZKR + (size_t)row * ROPED + 8 * fq);
#pragma unroll
                for (int bj = 0; bj < 2; ++bj) {
                    const int head = 2 * u.pn + bj;
                    const f32x4 p = *(const LAS f32x4*)(P + ((wr * 128 + rl) * 2 + bj) * 4);
                    const float rstd = rsqrtf(((p[0] + p[1]) + skr) * (1.0f / 96.0f) + RMS_EPS);
                    if (wc < 2) {
                        *(u32x4*)(KB + (size_t)row * 768 + head * QKD + 32 * wc + 8 * fq) = pack8(acc[ai][bj][m][0] * (rr * rstd) * g0, acc[ai][bj][m][1] * (rr * rstd) * g1);
                    } else {
                        *(u32x4*)(VB + (size_t)row * 512 + head * 64 + 32 * (wc - 2) + 8 * fq) = pack8(acc[ai][bj][m][0] * rr, acc[ai][bj][m][1] * rr);
                        if (wc == 2) {
                            float v[8] = {bf_lo(zk.x) * rstd * g0[0], bf_hi(zk.x) * rstd * g0[1], bf_lo(zk.y) * rstd * g0[2], bf_hi(zk.y) * rstd * g0[3],
                                          bf_lo(zk.z) * rstd * g1[0], bf_hi(zk.z) * rstd * g1[1], bf_lo(zk.w) * rstd * g1[2], bf_hi(zk.w) * rstd * g1[3]};
                            if (isx) rope8(v, rope, row & (SEQ - 1), fq);
                            u32x4 w; w.x = cvt_pk_bf16(v[0], v[1]); w.y = cvt_pk_bf16(v[2], v[3]); w.z = cvt_pk_bf16(v[4], v[5]); w.w = cvt_pk_bf16(v[6], v[7]);
                            *(u32x4*)(KB + (size_t)row * 768 + head * QKD + 64 + 8 * fq) = w;
                        }
                    }
                }
                asm volatile("" ::: "memory");
            }
    }
};

struct EpiMerge {
    static constexpr bool PERM = true, CHAIN = true;
    const bf16_t* GATES; bf16_t* Y;
    __device__ __forceinline__ void operator()(f32x4 (&acc)[2][2][4][2], const Unit& u, int wr, int wc, int fr, int fq) const {
        const int row0 = u.pm * BM + wr * 64 + fr;
#pragma unroll
        for (int ai = 0; ai < 2; ++ai)
#pragma unroll
            for (int m = 0; m < 4; ++m) {
                const size_t row = (size_t)(row0 + ai * HALF + m * 16);
#pragma unroll
                for (int bj = 0; bj < 2; ++bj) {
                    const int col = u.pn * 256 + 128 * bj + 32 * wc + 8 * fq;
                    const u32x4 gb = *(const u32x4*)(GATES + row * 2048 + 1024 + col);
                    const f32x4 b0 = (f32x4){bf_lo(gb.x), bf_hi(gb.x), bf_lo(gb.y), bf_hi(gb.y)}, b1 = (f32x4){bf_lo(gb.z), bf_hi(gb.z), bf_lo(gb.w), bf_hi(gb.w)};
                    if (u.kind == 0) {
                        const u32x4 ga = *(const u32x4*)(GATES + row * 2048 + col);
                        const f32x4 a0 = (f32x4){bf_lo(ga.x), bf_hi(ga.x), bf_lo(ga.y), bf_hi(ga.y)}, a1 = (f32x4){bf_lo(ga.z), bf_hi(ga.z), bf_lo(ga.w), bf_hi(ga.w)};
#pragma unroll
                        for (int j = 0; j < 4; ++j) { acc[ai][bj][m][0][j] *= a0[j] * __builtin_amdgcn_rcpf(b0[j]); acc[ai][bj][m][1][j] *= a1[j] * __builtin_amdgcn_rcpf(b1[j]); }
                    } else {
                        *(u32x4*)(Y + row * 1024 + col) = pack8(acc[ai][bj][m][0] * b0, acc[ai][bj][m][1] * b1);
                    }
                }
            }
    }
};

struct EpiOut {
    static constexpr bool PERM = false, CHAIN = false;
    const float* xsrc; float* xdst; const float* csrc; float* cdst; const float* mod  ; int goff;
    __device__ __forceinline__ void operator()(f32x4 (&acc)[2][2][4][2], const Unit& u, int wr, int wc, int fr, int fq) const {
        const bool isx = u.pm < MT_X;
        const int rowt = (isx ? u.pm : u.pm - MT_X) * BM + wr * 64 + fr;
        const float* src = isx ? xsrc : csrc; float* dst = isx ? xdst : cdst;
        const float* gm = mod + (size_t)(isx ? (u.pm >> 3) : 16) * NMODC + goff;
        const int col0 = u.pn * BM + wc * 32 + 4 * fq;
        f32x4 gv[2][2];
#pragma unroll
        for (int bj = 0; bj < 2; ++bj)
#pragma unroll
            for (int n = 0; n < 2; ++n) gv[bj][n] = *(const f32x4*)(gm + col0 + bj * HALF + n * 16);
#pragma unroll
        for (int ai = 0; ai < 2; ++ai)
#pragma unroll
            for (int m = 0; m < 4; ++m) { const size_t off = (size_t)(rowt + ai * HALF + m * 16) * DM + col0;
#pragma unroll
                for (int bj = 0; bj < 2; ++bj)
#pragma unroll
                    for (int n = 0; n < 2; ++n) { const f32x4 xs = *(const f32x4*)(src + off + bj * HALF + n * 16); *(f32x4*)(dst + off + bj * HALF + n * 16) = xs + gv[bj][n] * acc[ai][bj][m][n]; }
            }
    }
};

struct EpiMoe1 {
    static constexpr bool PERM = true, CHAIN = false;
    bf16_t* HM;
    __device__ __forceinline__ void operator()(f32x4 (&acc)[2][2][4][2], const Unit& u, int wr, int wc, int fr, int fq) const {
        const int row0 = u.pm * BM + wr * 64 + fr;
#pragma unroll
        for (int ai = 0; ai < 2; ++ai)
#pragma unroll
            for (int m = 0; m < 4; ++m) { const size_t row = (size_t)(row0 + ai * HALF + m * 16);
#pragma unroll
                for (int bj = 0; bj < 2; ++bj) { const f32x4 p = acc[ai][bj][m][0], q = acc[ai][bj][m][1];
                    const float h0 = p[0] * sigmoidf_(p[0]) * p[1], h1 = p[2] * sigmoidf_(p[2]) * p[3], h2 = q[0] * sigmoidf_(q[0]) * q[1], h3 = q[2] * sigmoidf_(q[2]) * q[3];
                    u32x2 w; w.x = cvt_pk_bf16(h0, h1); w.y = cvt_pk_bf16(h2, h3);
                    *(u32x2*)(HM + row * DM + u.pn * 128 + 64 * bj + 16 * wc + 4 * fq) = w; }
            }
    }
};
struct EpiMoe2 {
    static constexpr bool PERM = true, CHAIN = false;
    bf16_t* YS;
    __device__ __forceinline__ void operator()(f32x4 (&acc)[2][2][4][2], const Unit& u, int wr, int wc, int fr, int fq) const {
        const int row0 = u.pm * BM + wr * 64 + fr;
#pragma unroll
        for (int ai = 0; ai < 2; ++ai)
#pragma unroll
            for (int m = 0; m < 4; ++m) { const size_t row = (size_t)(row0 + ai * HALF + m * 16);
#pragma unroll
                for (int bj = 0; bj < 2; ++bj) *(u32x4*)(YS + row * DM + u.pn * 256 + 128 * bj + 32 * wc + 8 * fq) = pack8(acc[ai][bj][m][0], acc[ai][bj][m][1]); }
    }
};

struct SchedRect {
    const char* A; const char* B; size_t tstep; int nM, nN, G, c, nM2, pn2, npn2;
    __device__ __forceinline__ bool next(int i, Unit& u) const {
        const int L = i * G + c, mainc = nM * nN; u.kind = 0; u.e = 0;
        if (L < mainc) { rect_tile(L, nM, nN, u.pm, u.pn); return true; }
        const int Lx = L - mainc; if (Lx >= nM2 * npn2) return false;
        u.pm = nM + Lx / npn2; u.pn = pn2 + Lx % npn2; return true;
    }
    __device__ __forceinline__ const char* a_ptr(const Unit& u) const { return A + (size_t)u.pm * tstep; }
    __device__ __forceinline__ const char* b_ptr(const Unit& u) const { return B + (size_t)u.pn * tstep; }
};
struct SchedMerge {
    const char *OA, *OB, *WA, *WB; size_t tstep; int nM, nN, G, c;
    __device__ __forceinline__ bool next(int i, Unit& u) const {
        const int L = (i >> 1) * G + c; if (L >= nM * nN) return false;
        rect_tile(L, nM, nN, u.pm, u.pn); u.kind = i & 1; u.e = 0; return true;
    }
    __device__ __forceinline__ const char* a_ptr(const Unit& u) const { return (u.kind ? OB : OA) + (size_t)u.pm * tstep; }
    __device__ __forceinline__ const char* b_ptr(const Unit& u) const { return (u.kind ? WB : WA) + (size_t)u.pn * tstep; }
};
struct SchedMoe {
    const char* A; const char* W; size_t tstepA, wstride, tstepB; const LAS int* tile_e  ; int ntile, nN, G, c;
    __device__ __forceinline__ bool next(int i, Unit& u) const {
        const int L = i * G + c; if (L >= ntile * nN) return false;
        rect_tile(L, ntile, nN, u.pm, u.pn); u.kind = 0;
        u.e = __builtin_amdgcn_readfirstlane(tile_e[u.pm]); return true;
    }
    __device__ __forceinline__ const char* a_ptr(const Unit& u) const { return A + (size_t)u.pm * tstepA; }
    __device__ __forceinline__ const char* b_ptr(const Unit& u) const { return W + (size_t)u.e * wstride + (size_t)u.pn * tstepB; }
};
}
namespace att {
constexpr int NW = 8, QBLK = 32, KVBLK = 64, DV = 64;
constexpr int SHM_V = 16384, SHM_K = 16384;
constexpr int LDS_VOFF = 0, LDS_KOFF = 2 * SHM_V, LDS_WS = LDS_KOFF + 2 * SHM_K, LDS_OST = LDS_WS + NW * 64 * 4, LDS_BIAS = LDS_OST + NW * 4096, LDS_MASK = LDS_BIAS + 16 * 128 * 4, LDS_END = LDS_MASK + 64 * 64 * 4;
static_assert(LDS_END <= RING_BYTES, "attention LDS map");
template <int DQK> struct KL { static constexpr int PITCH = (DQK == 64) ? 128 : 256; };
#define KSWZ(row, colB) ((row) * KL<DQK>::PITCH + ((colB) ^ (((row) & 7) << 4)))
#define SBAR() __builtin_amdgcn_sched_barrier(0)
__device__ __forceinline__ int crow(int r, int hi) { return (r & 3) + 8 * (r >> 2) + 4 * hi; }
__device__ __forceinline__ int v_st(int k, int c) { const int kk = (k & ~0xC) | ((k & 4) << 1) | ((k & 8) >> 1); return ((kk >> 3) * 2 + (c >> 5)) * 512 + ((kk & 7) * 32 + (c & 31)) * 2; }
__device__ __forceinline__ int v_rd_base(int lane, int c) { const int hi = (lane >> 5) & 1, g = c + hi;
    return ((lane & 3) << 3) | (((lane >> 2) & 3) << 6) | (((lane >> 4) & 1) << 5) | ((g & 1) << 8) | ((g >> 1) << 11); }
constexpr int v_rd_off(int d0, int ks, int half) { return ((2 * ks + half) * 2 + d0) * 512; }
template <int OFF> __device__ __forceinline__ s16x4 tr_read(int vb) { s16x4 r; asm volatile("ds_read_b64_tr_b16 %0, %1 offset:%2" : "=&v"(r) : "v"(vb), "i"(OFF) : "memory"); return r; }

template <int D0> __device__ __forceinline__ void pv_one(f32x16& od, int vbA, int vbB, bf16x8 pa0, bf16x8 pa1, bf16x8 pa2, bf16x8 pa3) {
    const s16x4 l0 = tr_read<v_rd_off(D0, 0, 0)>(vbA), h0 = tr_read<v_rd_off(D0, 0, 1)>(vbA), l1 = tr_read<v_rd_off(D0, 1, 0)>(vbA), h1 = tr_read<v_rd_off(D0, 1, 1)>(vbA);
    const s16x4 l2 = tr_read<v_rd_off(D0, 0, 0)>(vbB), h2 = tr_read<v_rd_off(D0, 0, 1)>(vbB), l3 = tr_read<v_rd_off(D0, 1, 0)>(vbB), h3 = tr_read<v_rd_off(D0, 1, 1)>(vbB);
    asm volatile("s_waitcnt lgkmcnt(0)" ::: "memory"); SBAR();
#define PK(L, H) (bf16x8){L[0], L[1], L[2], L[3], H[0], H[1], H[2], H[3]}
    od = __builtin_amdgcn_mfma_f32_32x32x16_bf16(pa0, PK(l0, h0), od, 0, 0, 0);
    od = __builtin_amdgcn_mfma_f32_32x32x16_bf16(pa1, PK(l1, h1), od, 0, 0, 0);
    od = __builtin_amdgcn_mfma_f32_32x32x16_bf16(pa2, PK(l2, h2), od, 0, 0, 0);
    od = __builtin_amdgcn_mfma_f32_32x32x16_bf16(pa3, PK(l3, h3), od, 0, 0, 0);
#undef PK
}
__device__ __forceinline__ void pv_all(f32x16* o, int vbA, int vbB, bf16x8 pa0, bf16x8 pa1, bf16x8 pa2, bf16x8 pa3) { pv_one<0>(o[0], vbA, vbB, pa0, pa1, pa2, pa3); pv_one<1>(o[1], vbA, vbB, pa0, pa1, pa2, pa3); }

#define MX3(a, b, c) __builtin_fmaxf(__builtin_fmaxf((a), (b)), (c))
template <bool FIRST>
__device__ __forceinline__ void partialSM(f32x16& p0, f32x16& p1, float& m_reg, float& alpha, f32x16& negm, const float THR2) {
    float a = MX3(p0[0], p0[1], p1[0]), b = MX3(p0[2], p0[3], p1[1]); a = MX3(a, p1[2], p1[3]);
#pragma unroll
    for (int r = 4; r < 16; r += 4) { a = MX3(a, p0[r], p0[r + 1]); b = MX3(b, p0[r + 2], p0[r + 3]); a = MX3(a, p1[r], p1[r + 1]); b = MX3(b, p1[r + 2], p1[r + 3]); }
    float pmax = __builtin_fmaxf(a, b);
    { auto rr = __builtin_amdgcn_permlane32_swap(__float_as_uint(pmax), __float_as_uint(pmax), false, false); pmax = __builtin_fmaxf(__uint_as_float(rr[0]), __uint_as_float(rr[1])); }
    alpha = 1.f;
    if (FIRST || !__builtin_expect(__all(pmax <= THR2), 1)) {
        const float dl = FIRST ? pmax : __builtin_fmaxf(pmax, 0.f);
        m_reg += dl; alpha = FIRST ? 1.f : __builtin_amdgcn_exp2f(-dl);
#pragma unroll
        for (int r = 0; r < 16; ++r) { p0[r] -= dl; p1[r] -= dl; }
#pragma unroll
        for (int r = 0; r < 16; ++r) negm[r] = -m_reg;
    }
#pragma unroll
    for (int r = 0; r < 16; ++r) p0[r] = __builtin_amdgcn_exp2f(p0[r]);
}
__device__ __forceinline__ void finishSM(f32x16& p0, f32x16& p1, float alpha, float& l_reg, bf16x8& pa0, bf16x8& pa1, bf16x8& pa2, bf16x8& pa3) {
#pragma unroll
    for (int r = 0; r < 16; ++r) p1[r] = __builtin_amdgcn_exp2f(p1[r]);
    float ps = 0;
#pragma unroll
    for (int r = 0; r < 16; ++r) ps += p0[r];
#pragma unroll
    for (int r = 0; r < 16; ++r) ps += p1[r];
    { auto rr = __builtin_amdgcn_permlane32_swap(__float_as_uint(ps), __float_as_uint(ps), false, false); ps = __uint_as_float(rr[0]) + __uint_as_float(rr[1]); }
    l_reg = l_reg * alpha + ps;
#define PK4(P, BASE, OUT) do { unsigned a0 = cvt_pk_bf16(P[BASE + 0], P[BASE + 1]), a1 = cvt_pk_bf16(P[BASE + 2], P[BASE + 3]);   \
    unsigned b0 = cvt_pk_bf16(P[BASE + 4], P[BASE + 5]), b1 = cvt_pk_bf16(P[BASE + 6], P[BASE + 7]);                              \
    auto r0 = __builtin_amdgcn_permlane32_swap(a0, b0, false, false); auto r1 = __builtin_amdgcn_permlane32_swap(a1, b1, false, false); \
    u32x4 w = {r0[0], r1[0], r0[1], r1[1]}; OUT = *reinterpret_cast<bf16x8*>(&w); } while (0)
    PK4(p0, 0, pa0); PK4(p0, 8, pa1); PK4(p1, 0, pa2); PK4(p1, 8, pa3);
#undef PK4
}
template <int DQK> __device__ __forceinline__ void qkt(f32x16& p0, f32x16& p1, const char* Ks, int rowA, int rowB, const bf16x8* qr, const f32x16& negm, int hi) {
#pragma unroll
    for (int d0 = 0; d0 < DQK / 16; ++d0) { const int cb = (d0 * 16 + hi * 8) * 2;
        const bf16x8 b0 = *reinterpret_cast<const bf16x8*>(Ks + KSWZ(rowA, cb));
        const bf16x8 b1 = *reinterpret_cast<const bf16x8*>(Ks + KSWZ(rowB, cb));
        if (d0 == 0) { p0 = __builtin_amdgcn_mfma_f32_32x32x16_bf16(b0, qr[0], negm, 0, 0, 0); p1 = __builtin_amdgcn_mfma_f32_32x32x16_bf16(b1, qr[0], negm, 0, 0, 0); }
        else { p0 = __builtin_amdgcn_mfma_f32_32x32x16_bf16(b0, qr[d0], p0, 0, 0, 0); p1 = __builtin_amdgcn_mfma_f32_32x32x16_bf16(b1, qr[d0], p1, 0, 0, 0); } }
}

struct UnitArgs {
    const bf16_t* Q; int ldq; int qcol;
    const bf16_t* K; int ldk; int kcol;
    const bf16_t* V; int vcol;
    bf16_t* O; int ocol;
    int q0;
    int ctx0, loc0;
    int NT;
    int masked;
    int band, krow0;
    const float* bias;
    float C;
};

__device__ __forceinline__ void na_mask(f32x16& p0, f32x16& p1, const LAS float* bt, const LAS float* mk, int krA, int qrow, int qc, int kc0, int hi) {
    const int rs = min(max(qrow - 4, 0), 24);
    const int drA = ((krA >= rs) && (krA < rs + 8)) ? (krA - qrow + 7) : 15, drB = ((krA + 1 >= rs) && (krA + 1 < rs + 8)) ? (krA + 1 - qrow + 7) : 15;
    const LAS float* bA = bt + drA * 128 + (kc0 + 4 * hi - qc + 64); const LAS float* bB = bt + drB * 128 + (kc0 + 4 * hi - qc + 64);
    const LAS float* mq = mk + qc * 64 + kc0 + 4 * hi;
#pragma unroll
    for (int g = 0; g < 4; ++g) {
        const f32x4 m0 = *(const LAS f32x4*)(mq + 8 * g);
#pragma unroll
        for (int j = 0; j < 4; ++j) { p0[4 * g + j] = (p0[4 * g + j] + bA[8 * g + j]) + m0[j]; p1[4 * g + j] = (p1[4 * g + j] + bB[8 * g + j]) + m0[j]; }
    }
}
__device__ __forceinline__ void na_mask_table(char* lds) {
    LAS float* mk = (LAS float*)(lds + LDS_MASK);
    int t0 = threadIdx.x; asm volatile("" : "+v"(t0));
    for (int i = t0; i < 64 * 64; i += 512) { const int qc = i >> 6, kc = i & 63, cs = min(max(qc - 8, 0), 48); mk[i] = ((unsigned)(kc - cs) < 16u) ? 0.f : -1e30f; }
}

template <int DQK>
__device__ __forceinline__ void attn_unit(const UnitArgs& A, char* lds) {
    int tid = threadIdx.x; asm volatile("" : "+v"(tid));
    const int wid = tid >> 6, lane = tid & 63, r32 = lane & 31, hi = lane >> 5;
    char* V_lds = lds + LDS_VOFF; char* K_lds = lds + LDS_KOFF;
    float* ws = (float*)(lds + LDS_WS) + wid * 64; float* li_l = ws; float* al_l = ws + 32;
    const LAS float* bt = (const LAS float*)(lds + LDS_BIAS); const LAS float* mk = (const LAS float*)(lds + LDS_MASK);
    const float C = A.C, THR2 = 8.0f * 1.4426950408889634f;
    const bool msk = (DQK == 64) && A.masked;
    float m_reg = 0.f, l_reg = 0; f32x16 o[2] = {}; bf16x8 qr[DQK / 16]; f32x16 negm = f32x16{};
    if (msk) { for (int i = tid; i < 16 * 128; i += 512) { const int dr = i >> 7, d = (i & 127) - 64;
            ((LAS float*)(lds + LDS_BIAS))[i] = (dr == 15) ? -1e30f : ((d >= -15 && d <= 15) ? A.bias[dr * 31 + d + 15] * 1.4426950408889634f : 0.f); } }
    const int qrow = 4 * A.band + 2 * (wid >> 2) + (r32 >> 4), qc = 16 * (wid & 3) + (r32 & 15);
    const int kc0 = msk ? min(max(16 * (wid & 3) - 8, 0), 32) : 0;
    const int qtok = msk ? (A.q0 + 64 * (2 * (wid >> 2) + (r32 >> 4)) + qc) : (A.q0 + wid * QBLK + r32);
    const bf16_t* Qw = A.Q + (size_t)qtok * A.ldq + A.qcol + hi * 8;
#pragma unroll
    for (int d0 = 0; d0 < DQK / 16; ++d0) { const u32x4 w = *reinterpret_cast<const u32x4*>(Qw + d0 * 16);
        u32x4 t; t.x = cvt_pk_bf16(bf_lo(w.x) * C, bf_hi(w.x) * C); t.y = cvt_pk_bf16(bf_lo(w.y) * C, bf_hi(w.y) * C); t.z = cvt_pk_bf16(bf_lo(w.z) * C, bf_hi(w.z) * C); t.w = cvt_pk_bf16(bf_lo(w.w) * C, bf_hi(w.w) * C);
        qr[d0] = *reinterpret_cast<bf16x8*>(&t); }
    constexpr int CPR = DQK / 8;
    const int v0key = tid >> 3, vc = (tid & 7) * 8, vst0 = v_st(v0key, vc), vst1 = 8192 + vst0;
    const int k0key = tid / CPR, k0c = tid % CPR, k1id = tid + 512, k1key = k1id / CPR, k1c = k1id % CPR;
    const int vbS = (int)(uintptr_t)V_lds + v_rd_base(lane, 0);
    const int vbM = (int)(uintptr_t)V_lds + v_rd_base(lane, kc0 >> 3);
    bf16x8 sv0, sv1 = {}, sk0, sk1 = {};
#define LOCAL(t) (msk && (t) >= 4)
#define TROW(t) (((t) < 4) ? (A.ctx0 + 64 * (t)) : (A.loc0 + (msk ? 128 : 64) * ((t) - 4)))
#define K1ON(t) ((DQK == 96) ? (tid < 256) : LOCAL(t))
#define SLOAD(t) do { const int _r0 = TROW(t); sv0 = *reinterpret_cast<const bf16x8*>(A.V + (size_t)(_r0 + v0key) * 512 + A.vcol + vc); \
        sk0 = *reinterpret_cast<const bf16x8*>(A.K + (size_t)(_r0 + k0key) * A.ldk + A.kcol + k0c * 8); \
        if (K1ON(t)) sk1 = *reinterpret_cast<const bf16x8*>(A.K + (size_t)(_r0 + k1key) * A.ldk + A.kcol + k1c * 8); \
        if (LOCAL(t)) sv1 = *reinterpret_cast<const bf16x8*>(A.V + (size_t)(_r0 + 64 + v0key) * 512 + A.vcol + vc); } while (0)
#define SWRITE(b, t) do { *reinterpret_cast<bf16x8*>(V_lds + (b) * SHM_V + vst0) = sv0; *reinterpret_cast<bf16x8*>(K_lds + (b) * SHM_K + KSWZ(k0key, k0c * 16)) = sk0; \
        if (K1ON(t)) *reinterpret_cast<bf16x8*>(K_lds + (b) * SHM_K + KSWZ(k1key, k1c * 16)) = sk1; \
        if (LOCAL(t)) *reinterpret_cast<bf16x8*>(V_lds + (b) * SHM_V + vst1) = sv1; } while (0)
#define RESC(a) do { if (__any((a) < 1.f)) { if (hi == 0) al_l[r32] = (a); asm volatile("s_waitcnt lgkmcnt(0)" ::: "memory"); \
        _Pragma("unroll") for (int d = 0; d < 2; ++d) _Pragma("unroll") for (int r = 0; r < 16; ++r) o[d][r] *= al_l[crow(r, hi)]; } } while (0)
#define QKT(P0, P1, b, t) do { const int _ra = LOCAL(t) ? (kc0 + r32) : r32, _rb = LOCAL(t) ? (64 + kc0 + r32) : (32 + r32); \
        qkt<DQK>(P0, P1, K_lds + (b) * SHM_K, _ra, _rb, qr, negm, hi); if (LOCAL(t)) na_mask(P0, P1, bt, mk, A.krow0 + 2 * ((t) - 4), qrow, qc, kc0, hi); } while (0)
#define PV(b, t) do { const int _va = (LOCAL(t) ? vbM : vbS) + (b) * SHM_V, _vb = _va + (LOCAL(t) ? 8192 : 4096); pv_all(o, _va, _vb, pa0, pa1, pa2, pa3); } while (0)
    f32x16 pA0, pA1, pB0, pB1; float alA, alB; bf16x8 pa0, pa1, pa2, pa3; const int NT = A.NT;
    SLOAD(0); SWRITE(0, 0); __syncthreads();
    QKT(pA0, pA1, 0, 0); partialSM<true>(pA0, pA1, m_reg, alA, negm, THR2);
    SLOAD(1); SWRITE(1, 1); __syncthreads();
    for (int j = 1; j + 1 < NT; j += 2) {
        SBAR(); QKT(pB0, pB1, 1, j);
        finishSM(pA0, pA1, alA, l_reg, pa0, pa1, pa2, pa3); SBAR();
        SLOAD(j + 1); SBAR();
        PV(0, j - 1); partialSM<false>(pB0, pB1, m_reg, alB, negm, THR2);
        __syncthreads(); SWRITE(0, j + 1);
        RESC(alB); __syncthreads();
        SBAR(); QKT(pA0, pA1, 0, j + 1);
        finishSM(pB0, pB1, alB, l_reg, pa0, pa1, pa2, pa3); SBAR();
        SLOAD(j + 2); SBAR();
        PV(1, j); partialSM<false>(pA0, pA1, m_reg, alA, negm, THR2);
        __syncthreads(); SWRITE(1, j + 2);
        RESC(alA); __syncthreads();
    }
    SBAR(); QKT(pB0, pB1, 1, NT - 1);
    finishSM(pA0, pA1, alA, l_reg, pa0, pa1, pa2, pa3); SBAR();
    PV(0, NT - 2); partialSM<false>(pB0, pB1, m_reg, alB, negm, THR2);
    __syncthreads(); RESC(alB);
    finishSM(pB0, pB1, alB, l_reg, pa0, pa1, pa2, pa3); SBAR();
    PV(1, NT - 1);
    if (hi == 0) li_l[r32] = l_reg; asm volatile("s_waitcnt lgkmcnt(0)" ::: "memory");
    float rli[16];
#pragma unroll
    for (int r = 0; r < 16; ++r) rli[r] = __builtin_amdgcn_rcpf(li_l[crow(r, hi)]);
    bf16_t* stg = (bf16_t*)(lds + LDS_OST) + wid * 2048;
#pragma unroll
    for (int r = 0; r < 16; ++r) { const int orow = crow(r, hi);
#pragma unroll
        for (int d0 = 0; d0 < 2; ++d0) { const unsigned w = cvt_pk_bf16(o[d0][r] * rli[r], 0.f); stg[orow * 64 + d0 * 32 + r32] = (bf16_t)(w & 0xffffu); } }
    asm volatile("s_waitcnt lgkmcnt(0)" ::: "memory");
#pragma unroll
    for (int i = 0; i < 4; ++i) { const int row = i * 8 + (lane >> 3), ch = lane & 7; const u32x4 v = *(const u32x4*)(stg + row * 64 + ch * 8);
        const int otok = msk ? (A.q0 + 64 * (2 * (wid >> 2) + (row >> 4)) + 16 * (wid & 3) + (row & 15)) : (A.q0 + wid * QBLK + row);
        *(u32x4*)(A.O + (size_t)otok * 512 + A.ocol + ch * 8) = v; }
    __syncthreads();
#undef LOCAL
#undef TROW
#undef K1ON
#undef SLOAD
#undef SWRITE
#undef RESC
#undef QKT
#undef PV
}
#undef KSWZ
#undef SBAR
}
struct Frame {
    LAS unsigned char* lds;
    int tid, lane, wave, vcu, G;
};
#define CAS __attribute__((address_space(4)))
__device__ __forceinline__ const CAS char* karg() { return (const CAS char*)__builtin_amdgcn_kernarg_segment_ptr(); }
template <int I> __device__ __forceinline__ const float* in_ptr() { unsigned off = I * 8; asm volatile("" : "+s"(off)); return *(const float* const CAS*)(karg() + off); }
__device__ __forceinline__ float* out_ptr() { unsigned off = 26 * 8; asm volatile("" : "+s"(off)); return *(float* const CAS*)(karg() + off); }
__device__ __forceinline__ unsigned char* ws_ptr() { unsigned off = 27 * 8; asm volatile("" : "+s"(off)); return *(unsigned char* const CAS*)(karg() + off); }
enum { I_X = 0, I_C, I_CTX, I_CCTX, I_WADA, I_BADA, I_NMIXG, I_NFFNG, I_WIN, I_NAQG, I_NAKG, I_RPB, I_CQG, I_WUQ, I_CKVG, I_WUKV, I_QG, I_KG, I_WOA, I_WOB, I_WOUT, I_WR, I_RB, I_W1, I_W3, I_W2 };

#define LDS_WAIT() asm volatile("s_waitcnt lgkmcnt(0)" ::: "memory")

__device__ __forceinline__ int win_src_col(int np) {
    const int pn = np >> 8, cc = np & 255;
    if (pn < 4) { const int part = pn >> 1, tq = pn & 1, bj = cc >> 7, wc = (cc >> 5) & 3, i = cc & 31; return part * 512 + (4 * tq + wc) * 64 + 32 * bj + i; }
    if (pn < 6) return 1024 + (pn - 4) * 256 + cc;
    if (pn == 6) return 1536 + cc;
    if (pn == 7) return cc < 128 ? 1792 + cc : (cc < 160 ? 2176 + (cc - 128) : -1);
    if (pn == 8) return 1920 + cc;
    return 2208 + (pn - 9) * 256 + cc;
}
__device__ __forceinline__ void conv_item(const float* src, size_t ld, int dcol, int dstep, const float* gain, bf16_t* WT, int K, int k0, int n0, LAS float* scr, int lane) {
    const int kr = lane >> 4;
    f32x4 v[16];
#pragma unroll
    for (int i = 0; i < 16; ++i) { v[i] = (f32x4){0.f, 0.f, 0.f, 0.f}; if (src) v[i] = __builtin_nontemporal_load((const f32x4*)(src + (size_t)(k0 + 4 * i + kr) * ld)); }
#pragma unroll
    for (int i = 0; i < 16; ++i) { const int kk = 4 * i + kr;
        if (gain) v[i] = v[i] * gain[k0 + kk];
        LAS float* s = scr + kk * 65 + dcol; s[0] = v[i][0]; s[dstep] = v[i][1]; s[2 * dstep] = v[i][2]; s[3 * dstep] = v[i][3]; }
    LDS_WAIT(); asm volatile("" ::: "memory");
    const int c = lane & 7;
#pragma unroll
    for (int j = 0; j < 8; ++j) { const int n = (lane >> 3) + 8 * j; const LAS float* s = scr + (8 * c) * 65 + n;
        u32x4 o; o.x = cvt_pk_bf16(s[0 * 65], s[1 * 65]); o.y = cvt_pk_bf16(s[2 * 65], s[3 * 65]); o.z = cvt_pk_bf16(s[4 * 65], s[5 * 65]); o.w = cvt_pk_bf16(s[6 * 65], s[7 * 65]);
        *(u32x4*)(WT + (size_t)(n0 + n) * K + k0 + 8 * c) = o; }
    LDS_WAIT(); asm volatile("" ::: "memory");
}
__device__ __forceinline__ void p0_convert(Frame& F) {
    LAS float* scr = (LAS float*)(F.lds + F.wave * 16640);
    const int gw = F.vcu * 8 + F.wave, NGW = F.G * 8, lane = F.lane, q16 = lane & 15;
    constexpr int I_IN = 16 * 68, I_UQ = 6 * 16, I_UKV = 4 * 16, I_OA = 8 * 16, I_OUT = 16 * 16, I_13 = 16 * 32 * NEXP, I_2 = 16 * 16 * NEXP;
    constexpr int PER_L = I_IN + I_UQ + I_UKV + 2 * I_OA + I_OUT + I_13 + I_2;
    unsigned char* const ws = ws_ptr();
    for (int it = gw; it < NLAYER * PER_L; it += NGW) {
        const int l = it / PER_L; int r = it - l * PER_L;
        if (r < I_IN) { const int kb = r / 68, nb = r % 68, sc = win_src_col(nb * 64 + 4 * q16);
            conv_item(sc >= 0 ? in_ptr<I_WIN>() + (size_t)l * DM * INC + sc : nullptr, INC, 4 * q16, 1, nullptr, (bf16_t*)(ws + WS_WIN) + (size_t)l * INP * DM, DM, kb * 64, nb * 64, scr, lane); continue; } r -= I_IN;
        if (r < I_UQ) { const int kb = r / 16, nb = r % 16, np = nb * 64 + 4 * q16, hh = np >> 7, dd = np & 127;
            conv_item(dd < QKD ? in_ptr<I_WUQ>() + (size_t)l * QLORA * 768 + hh * QKD + dd : nullptr, 768, 4 * q16, 1, in_ptr<I_CQG>() + l * QLORA, (bf16_t*)(ws + WS_WUQ) + (size_t)l * 1024 * QLORA, QLORA, kb * 64, nb * 64, scr, lane); continue; } r -= I_UQ;
        if (r < I_UKV) { const int kb = r / 16, nb = r % 16;
            conv_item(in_ptr<I_WUKV>() + (size_t)l * KVLORA * 1024 + nb * 64 + 4 * q16, 1024, 4 * q16, 1, in_ptr<I_CKVG>() + l * KVLORA, (bf16_t*)(ws + WS_WUKV) + (size_t)l * 1024 * KVLORA, KVLORA, kb * 64, nb * 64, scr, lane); continue; } r -= I_UKV;
        if (r < 2 * I_OA) { const int w = r / I_OA, rr = r % I_OA, kb = rr / 16, nb = rr % 16;
            conv_item((w ? in_ptr<I_WOB>() : in_ptr<I_WOA>()) + (size_t)l * 512 * DM + nb * 64 + 4 * q16, DM, 4 * q16, 1, nullptr, (bf16_t*)(ws + (w ? WS_WOB : WS_WOA)) + (size_t)l * 1024 * 512, 512, kb * 64, nb * 64, scr, lane); continue; } r -= 2 * I_OA;
        if (r < I_OUT) { const int kb = r / 16, nb = r % 16;
            conv_item(in_ptr<I_WOUT>() + (size_t)l * DM * DM + nb * 64 + 4 * q16, DM, 4 * q16, 1, nullptr, (bf16_t*)(ws + WS_WOUT) + (size_t)l * DM * DM, DM, kb * 64, nb * 64, scr, lane); continue; } r -= I_OUT;
        if (r < I_13) { const int e = r / 512, rr = r % 512, kb = rr / 32, nb = rr % 32;
            const float* base = ((q16 < 8) ? in_ptr<I_W1>() : in_ptr<I_W3>()) + ((size_t)l * NEXP + e) * DM * DM + nb * 32 + 4 * (q16 & 7);
            conv_item(base, DM, 8 * (q16 & 7) + (q16 >> 3), 2, nullptr, (bf16_t*)(ws + WS_W13) + ((size_t)l * NEXP + e) * 2048 * DM, DM, kb * 64, nb * 64, scr, lane); continue; } r -= I_13;
        { const int e = r / 256, rr = r % 256, kb = rr / 16, nb = rr % 16;
            conv_item(in_ptr<I_W2>() + ((size_t)l * NEXP + e) * DM * DM + nb * 64 + 4 * q16, DM, 4 * q16, 1, nullptr, (bf16_t*)(ws + WS_W2) + ((size_t)l * NEXP + e) * DM * DM, DM, kb * 64, nb * 64, scr, lane); }
    }
}
__device__ __forceinline__ void p0_ada(Frame& F) {
    if ((int)blockIdx.x >= 2 * 96) return;
    unsigned char* const ws = ws_ptr(); const float* const cin = in_ptr<I_C>(); const float* const cctx = in_ptr<I_CCTX>(); const float* const wada = in_ptr<I_WADA>(); const float* const bada = in_ptr<I_BADA>();
    LAS float* sct = (LAS float*)F.lds;
    LAS float* red = (LAS float*)(F.lds + 1024 * 20 * 4);
    for (int idx = F.tid; idx < 17 * 1024; idx += 512) { const int r = idx >> 10, d = idx & 1023; const float v = (r < 16) ? cin[r * DM + d] : cctx[d]; sct[d * 20 + r] = v * (1.0f / (1.0f + expf(-v))); }
    __syncthreads();
    float* MOD = (float*)(ws + WS_MOD);
    for (int task = blockIdx.x; task < 2 * 96; task += F.G) {
        const int l = task / 96, cb = task % 96, col = cb * 64 + F.lane;
        const float* wa = wada + (size_t)l * DM * NMODC + col;
        float acc[17];
#pragma unroll
        for (int r = 0; r < 17; ++r) acc[r] = 0.f;
        for (int k = F.wave * 128; k < F.wave * 128 + 128; ++k) { const float wv = wa[(size_t)k * NMODC];
#pragma unroll
            for (int r = 0; r < 17; ++r) acc[r] += sct[k * 20 + r] * wv; }
#pragma unroll
        for (int r = 0; r < 17; ++r) red[(F.wave * 17 + r) * 64 + F.lane] = acc[r];
        __syncthreads();
        for (int idx = F.tid; idx < 17 * 64; idx += 512) { const int r = idx >> 6, cl = idx & 63; float s = bada[l * NMODC + cb * 64 + cl];
#pragma unroll
            for (int w = 0; w < 8; ++w) s += red[(w * 17 + r) * 64 + cl];
            MOD[((size_t)l * 17 + r) * NMODC + cb * 64 + cl] = s; }
        __syncthreads();
    }
    if (blockIdx.x == 0) { float* rope = (float*)(ws + WS_ROPE); const int pos = F.tid >> 3, i = F.tid & 7;
        const float inv = exp2f(-(float)i * 0.125f * 13.287712379549449f);
        const float ang = (float)pos * inv; const float rev = ang * 0.15915494309189535f, fr = rev - floorf(rev); rope[pos * 8 + i] = __builtin_amdgcn_cosf(fr); rope[512 + pos * 8 + i] = __builtin_amdgcn_sinf(fr); }
}

__device__ __forceinline__ void load_row(const float* xrow, int lane, f32x4 (&v)[4]) {
#pragma unroll
    for (int j = 0; j < 4; ++j) v[j] = *((const f32x4*)xrow + lane + 64 * j);
}
__device__ __forceinline__ float row_rstd(const f32x4 (&v)[4]) {
    float s = 0.f;
#pragma unroll
    for (int j = 0; j < 4; ++j) s += (v[j][0] * v[j][0] + v[j][1] * v[j][1]) + (v[j][2] * v[j][2] + v[j][3] * v[j][3]);
    return rsqrtf(wave_sum(s) * (1.0f / DM) + RMS_EPS);
}
__device__ __forceinline__ void normmod(const f32x4 (&v)[4], float rstd, const float* g, const float* sh, const float* sc, int lane, f32x4 (&h)[4]) {
#pragma unroll
    for (int j = 0; j < 4; ++j) { const f32x4 gv = *((const f32x4*)g + lane + 64 * j), shv = *((const f32x4*)sh + lane + 64 * j), scv = *((const f32x4*)sc + lane + 64 * j);
        h[j] = v[j] * rstd * gv * (scv + 1.0f) + shv; }
}
__device__ __forceinline__ void store_row_bf16(bf16_t* orow, int lane, const f32x4 (&h)[4]) {
#pragma unroll
    for (int j = 0; j < 4; ++j) { u32x2 w; w.x = cvt_pk_bf16(h[j][0], h[j][1]); w.y = cvt_pk_bf16(h[j][2], h[j][3]); *((u32x2*)orow + lane + 64 * j) = w; }
}
__device__ __forceinline__ void p0_hrows(Frame& F) {
    unsigned char* const ws = ws_ptr(); const float* const xin = in_ptr<I_X>(); const float* const cxin = in_ptr<I_CTX>(); const float* const gmix = in_ptr<I_NMIXG>();
    const int gw = F.vcu * 8 + F.wave, NGW = F.G * 8; const float* MOD = (const float*)(ws + WS_MOD); bf16_t* H = (bf16_t*)(ws + WS_H);
    for (int t = gw; t < TALL; t += NGW) {
        const float* xr = (t < TX) ? xin + (size_t)t * DM : cxin + (size_t)(t - TX) * DM;
        const float* md = MOD + (size_t)((t < TX) ? (t >> 11) : 16) * NMODC;
        f32x4 v[4], h[4]; load_row(xr, F.lane, v); const float rstd = row_rstd(v);
        normmod(v, rstd, gmix, md, md + DM, F.lane, h); store_row_bf16(H + (size_t)t * DM, F.lane, h);
    }
}
__device__ __forceinline__ void stats_phase(Frame& F, int ntok) {
    unsigned char* const ws = ws_ptr();
    const int gw = F.vcu * 8 + F.wave, NGW = F.G * 8, lane = F.lane;
    const bf16_t* ZCQ = (const bf16_t*)(ws + WS_ZCQ); const bf16_t* ZCKV = (const bf16_t*)(ws + WS_ZCKV); const bf16_t* ZKR = (const bf16_t*)(ws + WS_ZKR);
    float* RSCQ = (float*)(ws + WS_RSCQ); float* RSCKV = (float*)(ws + WS_RSCKV); float* SSKR = (float*)(ws + WS_SSKR);
    for (int t = gw; t < ntok; t += NGW) {
        float a = 0.f, b = 0.f, c = 0.f;
        if (lane < 48) { const u32x4 w = *(const u32x4*)(ZCQ + (size_t)t * QLORA + 8 * lane); a = (bf_lo(w.x) * bf_lo(w.x) + bf_hi(w.x) * bf_hi(w.x)) + (bf_lo(w.y) * bf_lo(w.y) + bf_hi(w.y) * bf_hi(w.y)) + (bf_lo(w.z) * bf_lo(w.z) + bf_hi(w.z) * bf_hi(w.z)) + (bf_lo(w.w) * bf_lo(w.w) + bf_hi(w.w) * bf_hi(w.w)); }
        if (lane < 32) { const u32x4 w = *(const u32x4*)(ZCKV + (size_t)t * KVLORA + 8 * lane); b = (bf_lo(w.x) * bf_lo(w.x) + bf_hi(w.x) * bf_hi(w.x)) + (bf_lo(w.y) * bf_lo(w.y) + bf_hi(w.y) * bf_hi(w.y)) + (bf_lo(w.z) * bf_lo(w.z) + bf_hi(w.z) * bf_hi(w.z)) + (bf_lo(w.w) * bf_lo(w.w) + bf_hi(w.w) * bf_hi(w.w)); }
        if (lane < 4) { const u32x4 w = *(const u32x4*)(ZKR + (size_t)t * ROPED + 8 * lane); c = (bf_lo(w.x) * bf_lo(w.x) + bf_hi(w.x) * bf_hi(w.x)) + (bf_lo(w.y) * bf_lo(w.y) + bf_hi(w.y) * bf_hi(w.y)) + (bf_lo(w.z) * bf_lo(w.z) + bf_hi(w.z) * bf_hi(w.z)) + (bf_lo(w.w) * bf_lo(w.w) + bf_hi(w.w) * bf_hi(w.w)); }
        a = wave_sum(a); b = wave_sum(b); c = wave_sum(c);
        if (lane == 0) { RSCQ[t] = rsqrtf(a * (1.0f / QLORA) + RMS_EPS); RSCKV[t] = rsqrtf(b * (1.0f / KVLORA) + RMS_EPS); SSKR[t] = c; }
    }
}

__device__ __forceinline__ void route_phase(Frame& F, int l, int ntok) {
    unsigned char* const ws = ws_ptr(); const float* const xcur = out_ptr();
    LAS float* h2t = (LAS float*)F.lds;
    LAS float* part = (LAS float*)(F.lds + 65536);
    LAS float* logit = (LAS float*)(F.lds + 65536 + 32768);
    const float* MOD = (const float*)(ws + WS_MOD) + (size_t)l * 17 * NMODC; const float* XC = (const float*)(ws + WS_XC);
    const float* g = in_ptr<I_NFFNG>() + l * DM; const float* wr = in_ptr<I_WR>(); const float rbias = in_ptr<I_RB>()[F.lane];
    int* TOKE = (int*)(ws + WS_TOKE); float* TOKW = (float*)(ws + WS_TOKW); int* TOKP = (int*)(ws + WS_TOKP); float* RSTD2 = (float*)(ws + WS_RSTD2);
    unsigned* cnt = (unsigned*)(ws + WS_CTL) + CW_CNT + l * 2048;
    const int lane = F.lane, w = F.wave;
    float wv[128];
#pragma unroll
    for (int i = 0; i < 128; ++i) wv[i] = wr[(w * 128 + i) * NEXP + lane];
    for (int it = blockIdx.x; it < ntok / 16; it += F.G) {
        const int T0 = it * 16;
#pragma unroll
        for (int tt = 0; tt < 2; ++tt) { const int tl = 2 * w + tt, t = T0 + tl;
            const float* xr = (t < TX) ? xcur + (size_t)t * DM : XC + (size_t)(t - TX) * DM; const float* md = MOD + (size_t)((t < TX) ? (t >> 11) : 16) * NMODC;
            f32x4 v[4], h[4]; load_row(xr, lane, v); const float rstd = row_rstd(v); if (lane == 0) RSTD2[t] = rstd;
            normmod(v, rstd, g, md + 3 * DM, md + 4 * DM, lane, h);
#pragma unroll
            for (int j = 0; j < 4; ++j) *(LAS f32x4*)(h2t + tl * DM + 4 * lane + 256 * j) = h[j];
        }
        __syncthreads();
        { float acc[16];
#pragma unroll
          for (int t = 0; t < 16; ++t) acc[t] = 0.f;
#pragma unroll
          for (int gq = 0; gq < 32; ++gq) {
#pragma unroll
              for (int hf = 0; hf < 2; ++hf) {
                  f32x4 hv[8];
#pragma unroll
                  for (int t = 0; t < 8; ++t) hv[t] = *(const LAS f32x4*)(h2t + (8 * hf + t) * DM + w * 128 + 4 * gq);
#pragma unroll
                  for (int t = 0; t < 8; ++t)
#pragma unroll
                      for (int q = 0; q < 4; ++q) acc[8 * hf + t] += hv[t][q] * wv[4 * gq + q];
              }
          }
#pragma unroll
          for (int t = 0; t < 16; ++t) part[(w * 16 + t) * 64 + lane] = acc[t]; }
        __syncthreads();
#pragma unroll
        for (int k = 0; k < 2; ++k) { const int idx = F.tid + 512 * k, t = idx >> 6, e = idx & 63; float s = 0.f;
#pragma unroll
            for (int ww = 0; ww < 8; ++ww) s += part[(ww * 16 + t) * 64 + e];
            logit[t * 64 + e] = s; }
        __syncthreads();
#pragma unroll
        for (int tt = 0; tt < 2; ++tt) { const int tl = 2 * w + tt, t = T0 + tl;
            const float sg = 1.0f / (1.0f + expf(-logit[tl * 64 + lane])); const float bs = sg + rbias;
            float m1 = -3.0e38f, m2 = -3.0e38f; int i1 = 0, i2 = 0;
#pragma unroll
            for (int j = 0; j < 8; ++j) { const float vv = __shfl(bs, (lane & ~7) + j); if (vv > m1) { m2 = m1; i2 = i1; m1 = vv; i1 = j; } else if (vv > m2) { m2 = vv; i2 = j; } }
            const float gs = m1 + m2; float best = -3.0e38f; int gsel = 0;
#pragma unroll
            for (int j = 0; j < 8; ++j) { const float vv = __shfl(gs, 8 * j); if (vv > best) { best = vv; gsel = j; } }
            const int e1 = gsel * 8 + __shfl(i1, gsel * 8), e2 = gsel * 8 + __shfl(i2, gsel * 8);
            const float s1 = __shfl(sg, e1), s2 = __shfl(sg, e2), inv = 1.0f / (s1 + s2);
            if (lane == 0) { const int p1 = (int)atomicAdd(cnt + e1 * 16, 1u), p2 = (int)atomicAdd(cnt + e2 * 16, 1u);
                TOKE[2 * t] = e1; TOKE[2 * t + 1] = e2; TOKW[2 * t] = s1 * inv; TOKW[2 * t + 1] = s2 * inv; TOKP[2 * t] = p1; TOKP[2 * t + 1] = p2; }
        }
        __syncthreads();
    }
}
__device__ __forceinline__ void expert_offsets(Frame& F, unsigned char* ws, int l, LAS int* offl, bool publish) {
    if (F.wave == 0) {
        const unsigned c = __hip_atomic_load((unsigned*)(ws + WS_CTL) + CW_CNT + l * 2048 + F.lane * 16, RLX_AGENT);
        const int pad = (int)((c + 255u) & ~255u); int incl = pad;
#pragma unroll
        for (int o = 1; o < 64; o <<= 1) { const int v = __shfl_up(incl, o); if (F.lane >= o) incl += v; }
        offl[F.lane] = incl - pad; if (F.lane == 63) offl[64] = incl;
        if (publish) { int* TILEE = (int*)(ws + WS_TILEE); for (int t = (incl - pad) >> 8; t < (incl >> 8); ++t) TILEE[t] = F.lane; if (F.lane == 63) TILEE[511] = incl >> 8; }
    }
    __syncthreads();
}
__device__ __forceinline__ void scatter_phase(Frame& F, int l, int ntok) {
    unsigned char* const ws = ws_ptr(); const float* const xcur = out_ptr();
    LAS int* offl = (LAS int*)(F.lds + 1024);
    expert_offsets(F, ws, l, offl, blockIdx.x == 0);
    const int gw = F.vcu * 8 + F.wave, NGW = F.G * 8, lane = F.lane;
    const float* MOD = (const float*)(ws + WS_MOD) + (size_t)l * 17 * NMODC; const float* XC = (const float*)(ws + WS_XC); const float* g = in_ptr<I_NFFNG>() + l * DM;
    const int* TOKE = (const int*)(ws + WS_TOKE); const int* TOKP = (const int*)(ws + WS_TOKP); const float* RSTD2 = (const float*)(ws + WS_RSTD2); bf16_t* HS = (bf16_t*)(ws + WS_HS);
    for (int t = gw; t < ntok; t += NGW) {
        const float* xr = (t < TX) ? xcur + (size_t)t * DM : XC + (size_t)(t - TX) * DM; const float* md = MOD + (size_t)((t < TX) ? (t >> 11) : 16) * NMODC;
        f32x4 v[4], h[4]; load_row(xr, lane, v); normmod(v, RSTD2[t], g, md + 3 * DM, md + 4 * DM, lane, h);
        const int s1 = offl[TOKE[2 * t]] + TOKP[2 * t], s2 = offl[TOKE[2 * t + 1]] + TOKP[2 * t + 1];
        store_row_bf16(HS + (size_t)s1 * DM, lane, h); store_row_bf16(HS + (size_t)s2 * DM, lane, h);
    }
}
__device__ __forceinline__ void combine_phase(Frame& F, int l, int ntok, bool last) {
    unsigned char* const ws = ws_ptr(); float* const xcur = out_ptr();
    LAS int* offl = (LAS int*)(F.lds + 1024);
    expert_offsets(F, ws, l, offl, false);
    const int gw = F.vcu * 8 + F.wave, NGW = F.G * 8, lane = F.lane;
    const float* MOD = (const float*)(ws + WS_MOD) + (size_t)l * 17 * NMODC; float* XC = (float*)(ws + WS_XC);
    const int* TOKE = (const int*)(ws + WS_TOKE); const int* TOKP = (const int*)(ws + WS_TOKP); const float* TOKW = (const float*)(ws + WS_TOKW);
    const bf16_t* YS = (const bf16_t*)(ws + WS_YS); bf16_t* H = (bf16_t*)(ws + WS_H);
    for (int t = gw; t < ntok; t += NGW) {
        float* xr = (t < TX) ? xcur + (size_t)t * DM : XC + (size_t)(t - TX) * DM; const int bi = (t < TX) ? (t >> 11) : 16; const float* md = MOD + (size_t)bi * NMODC;
        const int s1 = offl[TOKE[2 * t]] + TOKP[2 * t], s2 = offl[TOKE[2 * t + 1]] + TOKP[2 * t + 1]; const float w1 = TOKW[2 * t], w2 = TOKW[2 * t + 1];
        f32x4 v[4]; load_row(xr, lane, v);
#pragma unroll
        for (int j = 0; j < 4; ++j) { const u32x2 a = *((const u32x2*)(YS + (size_t)s1 * DM) + lane + 64 * j), b = *((const u32x2*)(YS + (size_t)s2 * DM) + lane + 64 * j);
            const f32x4 gf = *((const f32x4*)(md + 5 * DM) + lane + 64 * j);
            const f32x4 y = (f32x4){bf_lo(a.x), bf_hi(a.x), bf_lo(a.y), bf_hi(a.y)} * w1 + (f32x4){bf_lo(b.x), bf_hi(b.x), bf_lo(b.y), bf_hi(b.y)} * w2;
            v[j] = v[j] + gf * y; *((f32x4*)xr + lane + 64 * j) = v[j]; }
        if (!last) { const float* md2 = MOD + (size_t)17 * NMODC + (size_t)bi * NMODC; f32x4 h[4]; const float rstd = row_rstd(v);
            normmod(v, rstd, in_ptr<I_NMIXG>() + (l + 1) * DM, md2, md2 + DM, lane, h); store_row_bf16(H + (size_t)t * DM, lane, h); }
    }
}
constexpr int NPHASE = 2 + 11 * NLAYER;
struct Args { const float* in[26]; float* out; unsigned char* ws; int ph_lo, ph_hi; };

__device__ __attribute__((noinline)) void grid_barrier_fn(GAS unsigned* barw, unsigned x, LAS unsigned* st) { XcdBarrier b; b.bar = (unsigned*)barw; b.x = x; b.st = (volatile LAS unsigned*)st; xcd_barrier(b); }

__global__ void __launch_bounds__(512, 2) fwd_kernel(Args args) {
    extern __shared__ __attribute__((aligned(16))) unsigned char lds_raw[];
    Frame F;
    F.lds = (LAS unsigned char*)lds_raw;
    F.tid = threadIdx.x; F.lane = F.tid & 63; F.wave = __builtin_amdgcn_readfirstlane(F.tid >> 6);
    F.G = gridDim.x; { const int bx = blockIdx.x; F.vcu = (F.G % 8 == 0) ? (bx % 8) * (F.G / 8) + bx / 8 : bx; }
    volatile LAS unsigned* MISC = (volatile LAS unsigned*)(F.lds + MISC_OFF);
    if (F.tid < 64) MISC[F.tid] = 0u;
    __syncthreads();
    const int lo = args.ph_lo, hi = args.ph_hi;
#if MK_SPLIT
#define GRID_BAR() do { } while (0)
#else
    XcdBarrier bar = xcd_barrier_post((unsigned*)(ws_ptr() + WS_CTL) + CW_BAR, MISC + 8);
#define GRID_BAR() grid_barrier_fn((GAS unsigned*)bar.bar, bar.x, (LAS unsigned*)bar.st)
#endif
#ifndef PH_MASK
#define PH_MASK 0xFFFFFFFFu
#endif
#define PHK(k) ((k) < 2 ? (k) : 2 + ((k) - 2) % 11)
#define IN(k) (((PH_MASK >> PHK(k)) & 1u) && lo <= (k) && (k) < hi)
#ifndef PH_DUP
#define PH_DUP 0u
#endif
#define REP0(k) for (int rep_ = 0; rep_ < (((PH_DUP >> (k)) & 1u) ? 2 : 1); ++rep_)
#define REPL(n) for (int rep_ = 0; rep_ < ((((PH_DUP >> (2 + (n))) & 1u) && ((n) != 5 || l == 0)) ? 2 : 1); ++rep_)
#define SEAM(k) do { if (IN(k) && IN((k) + 1)) GRID_BAR(); } while (0)
#define FRESH() Frame Fp = F; int G = F.G, c = (int)blockIdx.x; asm volatile("" : "+v"(Fp.tid), "+v"(Fp.lane)); asm volatile("" : "+s"(Fp.wave), "+s"(Fp.vcu), "+s"(Fp.G), "+s"(G), "+s"(c))

    if (IN(0)) REP0(0) { FRESH(); (void)G; (void)c; p0_convert(Fp); __syncthreads(); p0_ada(Fp); }
    SEAM(0);
    if (IN(1)) REP0(1) { FRESH(); (void)G; (void)c; p0_hrows(Fp); }
    SEAM(1);

    for (int l = 0; l < NLAYER; ++l) {
        const int base = 2 + 11 * l; const bool last = (l == NLAYER - 1);
        const int mt_act = last ? MT_X : MT_ALL;
        const int ntok = last ? TX : TALL;
        if (IN(base + 0)) REPL(0) {
            FRESH(); unsigned char* const ws = ws_ptr();
            pg8::SchedRect S{(const char*)(ws + WS_H), (const char*)((bf16_t*)(ws + WS_WIN) + (size_t)l * INP * DM), (size_t)256 * DM * 2, mt_act, 17, G, c, MT_ALL - mt_act, 2, 7};
            pg8::EpiIn E{(bf16_t*)(ws + WS_QA), (bf16_t*)(ws + WS_KA), (bf16_t*)(ws + WS_VA), (bf16_t*)(ws + WS_ZCQ), (bf16_t*)(ws + WS_ZCKV), (bf16_t*)(ws + WS_ZKR), (bf16_t*)(ws + WS_GATES),
                         in_ptr<I_NAQG>() + l * 64, in_ptr<I_NAKG>() + l * 64};
            pg8::gemm_phase(Fp.lds, DM, S, E);
        }
        SEAM(base + 0);
        if (IN(base + 1)) REPL(1) { FRESH(); (void)G; (void)c; stats_phase(Fp, TALL); }
        SEAM(base + 1);
        if (IN(base + 2)) REPL(2) {
            FRESH();
#ifndef NO_EQ
            { unsigned char* const ws = ws_ptr();
              pg8::SchedRect S{(const char*)(ws + WS_ZCQ), (const char*)((bf16_t*)(ws + WS_WUQ) + (size_t)l * 1024 * QLORA), (size_t)256 * QLORA * 2, mt_act, 4, G, c, 0, 0, 1};
              pg8::EpiQ E{(bf16_t*)(ws + WS_QB), (const float*)(ws + WS_RSCQ), in_ptr<I_QG>() + l * QKD, (const float*)(ws + WS_ROPE), (LAS float*)(Fp.lds + EPI_OFF)};
              pg8::gemm_phase(Fp.lds, QLORA, S, E); }
#endif
#ifndef NO_EKV
            { unsigned char* const ws = ws_ptr();
              pg8::SchedRect S{(const char*)(ws + WS_ZCKV), (const char*)((bf16_t*)(ws + WS_WUKV) + (size_t)l * 1024 * KVLORA), (size_t)256 * KVLORA * 2, MT_ALL, 4, G, c, 0, 0, 1};
              pg8::EpiKV E{(bf16_t*)(ws + WS_KB), (bf16_t*)(ws + WS_VB), (const bf16_t*)(ws + WS_ZKR), (const float*)(ws + WS_RSCKV), (const float*)(ws + WS_SSKR), in_ptr<I_KG>() + l * QKD, (const float*)(ws + WS_ROPE), (LAS float*)(Fp.lds + EPI_OFF)};
              pg8::gemm_phase(Fp.lds, KVLORA, S, E); }
#endif
        }
        SEAM(base + 2);
        if (IN(base + 3)) REPL(3) {
            FRESH(); (void)c;
            const float C64 = 0.125f * 1.4426950408889634f, C96 = 0.10206207261596575f * 1.4426950408889634f;
            for (int r2_ = 0; r2_ < (((PH_DUP >> 20) & 1u) ? 2 : 1); ++r2_)
            { unsigned char* const ws = ws_ptr();
              for (int u = Fp.vcu; u < 1024 + 256; u += G) {
                att::UnitArgs A; A.Q = (const bf16_t*)(ws + WS_QB); A.ldq = 768; A.K = (const bf16_t*)(ws + WS_KB); A.ldk = 768; A.V = (const bf16_t*)(ws + WS_VB); A.O = (bf16_t*)(ws + WS_OB);
                A.masked = 0; A.band = 0; A.krow0 = 0; A.bias = nullptr; A.C = C96;
                if (u < 1024) { const int bh = u >> 3, qb = u & 7, b = bh >> 3, h = bh & 7;
                    A.qcol = h * QKD; A.kcol = h * QKD; A.vcol = h * 64; A.ocol = h * 64; A.q0 = b * SEQ + qb * 256; A.ctx0 = TX + b * CTXL; A.loc0 = b * SEQ; A.NT = 36; }
                else { const int v = u - 1024; if (last || !(v & 1)) continue; const int bh = v >> 1, b = bh >> 3, h = bh & 7;
                    A.qcol = h * QKD; A.kcol = h * QKD; A.vcol = h * 64; A.ocol = h * 64; A.q0 = TX + b * CTXL; A.ctx0 = TX + b * CTXL; A.loc0 = 0; A.NT = 4; }
                att::attn_unit<96>(A, (char*)lds_raw);
              } }
            for (int r3_ = 0; r3_ < (((PH_DUP >> 21) & 1u) ? 2 : 1); ++r3_)
            { unsigned char* const ws = ws_ptr(); const float* const rpb = in_ptr<I_RPB>();
              att::na_mask_table((char*)lds_raw);
              for (int u = Fp.vcu; u < 1024 + 256; u += G) {
                att::UnitArgs A; A.Q = (const bf16_t*)(ws + WS_QA); A.ldq = 512; A.K = (const bf16_t*)(ws + WS_KA); A.ldk = 512; A.V = (const bf16_t*)(ws + WS_VA); A.O = (bf16_t*)(ws + WS_OA); A.C = C64;
                if (u < 1024) { const int bh = u >> 3, band = u & 7, b = bh >> 3, h = bh & 7;
                    A.qcol = h * 64; A.kcol = h * 64; A.vcol = h * 64; A.ocol = h * 64; A.q0 = b * SEQ + band * 256; A.ctx0 = TX + b * CTXL;
                    A.krow0 = min(max(4 * band - 4, 0), 20); A.loc0 = b * SEQ + 64 * A.krow0; A.NT = 10; A.masked = 1; A.band = band; A.bias = rpb + ((size_t)l * NHEAD + h) * 15 * 31; }
                else { const int v = u - 1024; if (last || (v & 1)) continue; const int bh = v >> 1, b = bh >> 3, h = bh & 7;
                    A.qcol = h * 64; A.kcol = h * 64; A.vcol = h * 64; A.ocol = h * 64; A.q0 = TX + b * CTXL; A.ctx0 = TX + b * CTXL; A.loc0 = 0; A.NT = 4; A.masked = 0; A.band = 0; A.krow0 = 0; A.bias = nullptr; }
                att::attn_unit<64>(A, (char*)lds_raw);
              } }
        }
        SEAM(base + 3);
        if (IN(base + 4)) REPL(4) {
            FRESH(); unsigned char* const ws = ws_ptr();
            pg8::SchedMerge S{(const char*)(ws + WS_OA), (const char*)(ws + WS_OB), (const char*)((bf16_t*)(ws + WS_WOA) + (size_t)l * 1024 * 512), (const char*)((bf16_t*)(ws + WS_WOB) + (size_t)l * 1024 * 512),
                              (size_t)256 * 512 * 2, mt_act, 4, G, c};
            pg8::EpiMerge E{(const bf16_t*)(ws + WS_GATES), (bf16_t*)(ws + WS_Y)};
            pg8::gemm_phase(Fp.lds, 512, S, E);
        }
        SEAM(base + 4);
        if (IN(base + 5)) REPL(5) {
            FRESH(); unsigned char* const ws = ws_ptr(); float* const outp = out_ptr();
            pg8::SchedRect S{(const char*)(ws + WS_Y), (const char*)((bf16_t*)(ws + WS_WOUT) + (size_t)l * DM * DM), (size_t)256 * DM * 2, mt_act, 4, G, c, 0, 0, 1};
            pg8::EpiOut E{(l == 0) ? in_ptr<I_X>() : (const float*)outp, outp, in_ptr<I_CTX>(), (float*)(ws + WS_XC), (const float*)(ws + WS_MOD) + (size_t)l * 17 * NMODC, 2 * DM};
            pg8::gemm_phase(Fp.lds, DM, S, E);
        }
        SEAM(base + 5);
        if (IN(base + 6)) REPL(6) { FRESH(); (void)G; (void)c; route_phase(Fp, l, ntok); }
        SEAM(base + 6);
        if (IN(base + 7)) REPL(7) { FRESH(); (void)G; (void)c; scatter_phase(Fp, l, ntok); }
        SEAM(base + 7);
        if (IN(base + 8)) REPL(8) {
            FRESH(); unsigned char* const ws = ws_ptr();
            LAS int* const tle = (LAS int*)(Fp.lds + EPI_OFF + 16384); tle[Fp.tid] = ld_i32_agent((const int*)(ws + WS_TILEE) + Fp.tid); __syncthreads();
            const int ntile = __builtin_amdgcn_readfirstlane(tle[511]);
            pg8::SchedMoe S{(const char*)(ws + WS_HS), (const char*)((bf16_t*)(ws + WS_W13) + (size_t)l * NEXP * 2048 * DM), (size_t)256 * DM * 2, (size_t)2048 * DM * 2, (size_t)256 * DM * 2,
                            tle, ntile, 8, G, c};
            pg8::EpiMoe1 E{(bf16_t*)(ws + WS_HMID)};
            pg8::gemm_phase(Fp.lds, DM, S, E);
        }
        SEAM(base + 8);
        if (IN(base + 9)) REPL(9) {
            FRESH(); unsigned char* const ws = ws_ptr();
            LAS int* const tle = (LAS int*)(Fp.lds + EPI_OFF + 16384); tle[Fp.tid] = ld_i32_agent((const int*)(ws + WS_TILEE) + Fp.tid); __syncthreads();
            const int ntile = __builtin_amdgcn_readfirstlane(tle[511]);
            pg8::SchedMoe S{(const char*)(ws + WS_HMID), (const char*)((bf16_t*)(ws + WS_W2) + (size_t)l * NEXP * DM * DM), (size_t)256 * DM * 2, (size_t)DM * DM * 2, (size_t)256 * DM * 2,
                            tle, ntile, 4, G, c};
            pg8::EpiMoe2 E{(bf16_t*)(ws + WS_YS)};
            pg8::gemm_phase(Fp.lds, DM, S, E);
        }
        SEAM(base + 9);
        if (IN(base + 10)) REPL(10) { FRESH(); (void)G; (void)c; combine_phase(Fp, l, ntok, last); }
        if (!last) SEAM(base + 10);
    }
#undef IN
#undef SEAM
#undef GRID_BAR
}

extern "C" void kernel_launch(void* const* d_in, const int* in_sizes, int n_in, void* d_out, int out_size, void* d_ws, size_t ws_size, hipStream_t stream) {
    static int grid = 0;
    if (grid == 0) {
        if (n_in != 26 || out_size != TX * DM || ws_size < WS_END) { fprintf(stderr, "kernel_launch: unexpected problem (n_in %d, out %d, ws %zu < %zu); nothing launched\n", n_in, out_size, ws_size, (size_t)WS_END); grid = -1; return; }
        int dev = 0, cus = 0, per_cu = 0;
        if (hipGetDevice(&dev) != hipSuccess || hipDeviceGetAttribute(&cus, hipDeviceAttributeMultiprocessorCount, dev) != hipSuccess) { grid = -1; return; }
        if (hipFuncSetAttribute((const void*)fwd_kernel, hipFuncAttributeMaxDynamicSharedMemorySize, LDS_BYTES) != hipSuccess) { fprintf(stderr, "kernel_launch: hipFuncSetAttribute failed\n"); grid = -1; return; }
        if (hipOccupancyMaxActiveBlocksPerMultiprocessor(&per_cu, (const void*)fwd_kernel, 512, LDS_BYTES) != hipSuccess || per_cu < 1) fprintf(stderr, "kernel_launch: occupancy query reports %d blocks per CU\n", per_cu);
        (void)hipGetLastError();
        grid = cus;
    }
    if (grid < 0) return;
    (void)in_sizes;
    (void)hipMemsetAsync((char*)d_ws + WS_CTL, 0, CTL_BYTES, stream);
    Args a{};
    for (int i = 0; i < 26; ++i) a.in[i] = (const float*)d_in[i];
    a.out = (float*)d_out; a.ws = (unsigned char*)d_ws;
#if MK_SPLIT
    for (int p = 0; p < NPHASE; ++p) { a.ph_lo = p; a.ph_hi = p + 1; hipLaunchKernelGGL(fwd_kernel, dim3(grid), dim3(512), LDS_BYTES, stream, a); }
#else
    a.ph_lo = 0; a.ph_hi = NPHASE;
    hipLaunchKernelGGL(fwd_kernel, dim3(grid), dim3(512), LDS_BYTES, stream, a);
#endif
    const hipError_t le = hipPeekAtLastError();
    if (le != hipSuccess) fprintf(stderr, "kernel_launch: launch failed: %s\n", hipGetErrorName(le));
}
```

```cpp
#include <hip/hip_runtime.h>
#include <hip/hip_bf16.h>
#include <cstdio>
#include <cstdint>

#ifndef MK_SPLIT
#define MK_SPLIT 0
#endif

#define LAS __attribute__((address_space(3)))
#define GAS __attribute__((address_space(1)))
typedef unsigned short bf16_t;
typedef short bf16x8 __attribute__((ext_vector_type(8)));
typedef short s16x4 __attribute__((ext_vector_type(4)));
typedef float f32x4 __attribute__((ext_vector_type(4)));
typedef float f32x2 __attribute__((ext_vector_type(2)));
typedef float f32x16 __attribute__((ext_vector_type(16)));
typedef unsigned u32x4 __attribute__((ext_vector_type(4)));
typedef unsigned u32x2 __attribute__((ext_vector_type(2)));
#define RLX_AGENT __ATOMIC_RELAXED, __HIP_MEMORY_SCOPE_AGENT

constexpr int DM = 1024, NB = 16, SEQ = 2048, TX = NB * SEQ, CTXL = 256, TC = NB * CTXL, TALL = TX + TC;
constexpr int NHEAD = 8, GRIDW = 64;
constexpr int INC = 4256, INP = 4352;
constexpr int NEXP = 64, NMODC = 6 * DM;
constexpr int QLORA = 384, KVLORA = 256, QKD = 96, ROPED = 32;
constexpr int MT_X = TX / 256, MT_ALL = TALL / 256;
constexpr int NSLOT_MAX = 2 * TALL + NEXP * 256;
constexpr float RMS_EPS = 1e-6f;
constexpr int NLAYER = 2;
constexpr float F8_SW = 64.f, F8_SH = 16.f, F8_SM = 4.f;

constexpr size_t al256(size_t x) { return (x + 255) & ~(size_t)255; }
constexpr size_t WS_CTL = 0, CTL_BYTES = 1u << 20;
constexpr size_t WS_MOD   = WS_CTL + CTL_BYTES;
constexpr size_t WS_ROPE  = WS_MOD + al256((size_t)NLAYER * 17 * NMODC * 4);
constexpr size_t WS_RSCQ  = WS_ROPE + al256(64 * 8 * 2 * 4);
constexpr size_t WS_RSCKV = WS_RSCQ + al256((size_t)TALL * 4);
constexpr size_t WS_SSKR  = WS_RSCKV + al256((size_t)TALL * 4);
constexpr size_t WS_TOKE  = WS_SSKR + al256((size_t)TALL * 4);
constexpr size_t WS_TOKW  = WS_TOKE + al256((size_t)TALL * 8);
constexpr size_t WS_TOKP  = WS_TOKW + al256((size_t)TALL * 8);
constexpr size_t WS_RSTD2 = WS_TOKP + al256((size_t)TALL * 8);
constexpr size_t WS_TILEE = WS_RSTD2 + al256((size_t)TALL * 4);
constexpr size_t WS_OFFS  = WS_TILEE + al256(512 * 4);
constexpr size_t WS_WIN   = WS_OFFS + al256(128 * 4);
constexpr size_t WS_WUQ   = WS_WIN + al256((size_t)NLAYER * INP * DM * 2);
constexpr size_t WS_WUKV  = WS_WUQ + al256((size_t)NLAYER * 1024 * QLORA * 2);
constexpr size_t WS_WOA   = WS_WUKV + al256((size_t)NLAYER * 1024 * KVLORA * 2);
constexpr size_t WS_WOB   = WS_WOA + al256((size_t)NLAYER * 1024 * 512 * 2);
constexpr size_t WS_WOUT  = WS_WOB + al256((size_t)NLAYER * 1024 * 512 * 2);
constexpr size_t WS_W13   = WS_WOUT + al256((size_t)NLAYER * 1024 * 1024 * 2);
constexpr size_t WS_W2    = WS_W13 + al256((size_t)NLAYER * NEXP * 2048 * 1024 * 2);
constexpr size_t WS_H     = WS_W2 + al256((size_t)NLAYER * NEXP * 1024 * 1024 * 2);
constexpr size_t WS_XC    = WS_H + al256((size_t)TALL * DM * 2);
constexpr size_t WS_ACT   = WS_XC + al256((size_t)TC * DM * 4);
constexpr size_t WS_QA    = WS_ACT;
constexpr size_t WS_KA    = WS_QA + al256((size_t)TALL * 512 * 2);
constexpr size_t WS_VA    = WS_KA + al256((size_t)TALL * 512 * 2);
constexpr size_t WS_ZCQ   = WS_VA + al256((size_t)TALL * 512 * 2);
constexpr size_t WS_ZCKV  = WS_ZCQ + al256((size_t)TALL * QLORA * 2);
constexpr size_t WS_ZKR   = WS_ZCKV + al256((size_t)TALL * KVLORA * 2);
constexpr size_t WS_GATES = WS_ZKR + al256((size_t)TALL * ROPED * 2);
constexpr size_t WS_QB    = WS_GATES + al256((size_t)TALL * 2048 * 2);
constexpr size_t WS_KB    = WS_QB + al256((size_t)TALL * 768 * 2);
constexpr size_t WS_VB    = WS_KB + al256((size_t)TALL * 768 * 2);
constexpr size_t WS_OA    = WS_VB + al256((size_t)TALL * 512 * 2);
constexpr size_t WS_OB    = WS_OA + al256((size_t)TALL * 512 * 2);
constexpr size_t WS_Y     = WS_OB + al256((size_t)TALL * 512 * 2);
constexpr size_t WS_MIX_END = WS_Y + al256((size_t)TALL * DM * 2);
constexpr size_t WS_HS    = WS_ACT;
constexpr size_t WS_HMID  = WS_HS + al256((size_t)NSLOT_MAX * DM * 2);
constexpr size_t WS_YS    = WS_HMID + al256((size_t)NSLOT_MAX * DM * 2);
constexpr size_t WS_MOE_END = WS_YS + al256((size_t)NSLOT_MAX * DM * 2);
constexpr size_t WS_END   = (WS_MIX_END > WS_MOE_END) ? WS_MIX_END : WS_MOE_END;

constexpr int CW_BAR = 4096;
constexpr int CW_CNT = 16384;

constexpr int RING_BYTES = 131072;
constexpr int EPI_OFF = RING_BYTES;
constexpr int MISC_OFF = RING_BYTES + 24576;
constexpr int LDS_BYTES = 160 * 1024;

__device__ __forceinline__ unsigned cvt_pk_bf16(float lo, float hi) { unsigned r; asm volatile("v_cvt_pk_bf16_f32 %0, %1, %2" : "=v"(r) : "v"(lo), "v"(hi)); return r; }
__device__ __forceinline__ unsigned cvt_pk4_fp8(float a, float b, float c, float d) {
    a = __builtin_amdgcn_fmed3f(a, -448.f, 448.f); b = __builtin_amdgcn_fmed3f(b, -448.f, 448.f); c = __builtin_amdgcn_fmed3f(c, -448.f, 448.f); d = __builtin_amdgcn_fmed3f(d, -448.f, 448.f);
    int w = 0; w = __builtin_amdgcn_cvt_pk_fp8_f32(a, b, w, false); w = __builtin_amdgcn_cvt_pk_fp8_f32(c, d, w, true); return (unsigned)w; }
__device__ __forceinline__ float bf_lo(unsigned w) { return __uint_as_float(w << 16); }
__device__ __forceinline__ float bf_hi(unsigned w) { return __uint_as_float(w & 0xffff0000u); }
__device__ __forceinline__ float wave_sum(float v) {
#pragma unroll
    for (int o = 1; o < 64; o <<= 1) v += __shfl_xor(v, o);
    return v;
}
__device__ __forceinline__ float sigmoidf_(float x) { return __builtin_amdgcn_rcpf(1.0f + __expf(-x)); }
__device__ __forceinline__ int ld_i32_agent(const int* p) { return (int)__hip_atomic_load((const unsigned*)p, RLX_AGENT); }
#define XB_TMO      128
#define XB_XCNT(j)  (256  + 64 * (j))
#define XB_XSUB(j)  (1280 + 64 * (j))
#define XB_XGEN(j)  (2304 + 64 * (j))
#define XB_TOP      3328
#define XB_TOPGEN   3392
#define XCD_BAR_WORDS 3456
#define XB_SPIN_CAP (1u << 18)

__device__ __forceinline__ unsigned xb_ld(unsigned* p)              { return __hip_atomic_load(p, __ATOMIC_RELAXED, __HIP_MEMORY_SCOPE_AGENT); }
__device__ __forceinline__ unsigned xb_add(unsigned* p, unsigned v) { return __hip_atomic_fetch_add(p, v, __ATOMIC_RELAXED, __HIP_MEMORY_SCOPE_AGENT); }
__device__ __forceinline__ unsigned xb_xcc_id() { return (unsigned)__builtin_amdgcn_s_getreg((3 << 11) | 20) & 0xFu; }
#define XB_SPIN(cond, bar) do { unsigned _sp = 0; while (cond) { __builtin_amdgcn_s_sleep(1); \
    if ((++_sp & 255u) == 0u) { if (xb_ld(&(bar)[XB_TMO])) break; if (_sp > XB_SPIN_CAP) { atomicAdd(&(bar)[XB_TMO], 1u); break; } } } } while (0)

struct XcdBarrier {
    unsigned* bar; unsigned x;
    volatile LAS unsigned* st;
};

__device__ __forceinline__ XcdBarrier xcd_barrier_post(unsigned* bar, volatile LAS unsigned* st) {
    XcdBarrier b; b.bar = bar; b.x = xb_xcc_id(); b.st = st;
    if (threadIdx.x == 0) (void)xb_add(&bar[XB_XCNT(b.x)], 1u);
    return b;
}
__device__ __forceinline__ void xcd_barrier_complete(unsigned* bar, unsigned x, unsigned& nloc, unsigned& nx) {
    const unsigned G = gridDim.x * gridDim.y * gridDim.z;
    unsigned sum, cnt, mine, sp = 0u;
    for (;;) {
        sum = 0u; cnt = 0u; mine = 0u;
#pragma unroll
        for (unsigned j = 0; j < 16; ++j) { const unsigned c = xb_ld(&bar[XB_XCNT(j)]); sum += c; cnt += (c > 0u) ? 1u : 0u; mine = (j == x) ? c : mine; }
        if (sum == G) break;
        __builtin_amdgcn_s_sleep(1);
        if ((++sp & 255u) == 0u) { if (xb_ld(&bar[XB_TMO])) break; if (sp > XB_SPIN_CAP) { atomicAdd(&bar[XB_TMO], 1u); break; } }
    }
    nloc = mine > 0u ? mine : 1u; nx = cnt > 0u ? cnt : 1u;
}

__device__ __forceinline__ void xcd_barrier(const XcdBarrier& b) {
    asm volatile("s_waitcnt vmcnt(0)" ::: "memory");
    __syncthreads();
    if (threadIdx.x == 0) {
        unsigned* bar = b.bar;
        __builtin_amdgcn_s_waitcnt(0);
        unsigned nloc = b.st[0], nx = b.st[1];
        if (nloc == 0u) { xcd_barrier_complete(bar, b.x, nloc, nx); b.st[0] = nloc; b.st[1] = nx; }
        const unsigned old = xb_add(&bar[XB_XSUB(b.x)], 1u);
        const unsigned gen = old / nloc;
        if (old + 1u == (gen + 1u) * nloc) {
            __builtin_amdgcn_fence(__ATOMIC_RELEASE, "agent");
            asm volatile("s_waitcnt vmcnt(0)" ::: "memory");
            const unsigned og = xb_add(&bar[XB_TOP], 1u);
            const unsigned tg = og / nx;
            if (og + 1u == (tg + 1u) * nx) xb_add(&bar[XB_TOPGEN], 1u);
            else XB_SPIN(xb_ld(&bar[XB_TOPGEN]) == tg, bar);
            __builtin_amdgcn_fence(__ATOMIC_ACQUIRE, "agent");
            xb_add(&bar[XB_XGEN(b.x)], 1u);
            asm volatile("s_waitcnt vmcnt(0)" ::: "memory");
        } else {
            XB_SPIN(xb_ld(&bar[XB_XGEN(b.x)]) == gen, bar);
            __builtin_amdgcn_fence(__ATOMIC_ACQUIRE, "agent");
            asm volatile("s_waitcnt vmcnt(0)" ::: "memory");
        }
    }
    __syncthreads();
}

namespace pg8 {
constexpr int BM = 256, BK = 64, HALF = 128, HTB = HALF * BK * 2  , STAGE_BYTES = 8 * HTB, NXCD = 8, WGM = 8;
__host__ __device__ __forceinline__ int lds_byte(int r, int c) { const int st = (r >> 4) * 2 + (c >> 5), rr = r & 15, cc = c & 31, ob = rr * 64 + cc * 2; return st * 1024 + (ob ^ (((ob >> 9) & 1) << 5)); }
__host__ __device__ __forceinline__ void stage_rc(int b, int& R, int& C) { const int st = b / 1024, sb = b % 1024, swz = sb ^ (((sb >> 9) & 1) << 5); R = (st >> 1) * 16 + swz / 64; C = (st & 1) * 32 + (swz % 64) / 2; }
__host__ __device__ __forceinline__ int perm32(int rho) { const int n = rho >> 4, i = rho & 15; return 8 * (i >> 2) + 4 * n + (i & 3); }

struct Unit { int pm, pn, kind, e; };

__device__ __forceinline__ void rect_tile(int wgid_in, int nM, int nN, int& pm, int& pn) {
    const int nwg = nM * nN; int wgid = wgid_in;
    { const int q = nwg / NXCD, r = nwg % NXCD, xcd = wgid % NXCD, off = wgid / NXCD; wgid = (xcd < r ? xcd * (q + 1) : r * (q + 1) + (xcd - r) * q) + off; }
    const int nig = WGM * nN, gid = wgid / nig, fm = gid * WGM, gsz = (nM - fm) < WGM ? (nM - fm) : WGM;
    pm = fm + ((wgid % nig) % gsz); pn = (wgid % nig) / gsz;
}

typedef int i32x8 __attribute__((ext_vector_type(8)));
template <bool F8 = false, class Epi, class Sched>
__device__ __forceinline__ void gemm_phase(LAS unsigned char* lds, const int K, const Sched& S, const Epi& E) {
    int tid = threadIdx.x; asm volatile("" : "+v"(tid));
    const int wid = __builtin_amdgcn_readfirstlane(tid >> 6), lane = tid & 63, wr = wid >> 2, wc = wid & 3, fr = lane & 15, fq = lane >> 4;
    const int nt = K / BK;
    unsigned voffA[2], voffB[2];
#pragma unroll
    for (int i = 0; i < 2; ++i) { int R, C; stage_rc(tid * 16 + i * 8192, R, C); const int Rb = Epi::PERM ? ((R & ~31) + perm32(R & 31)) : R;
        voffA[i] = (unsigned)(R * K + C) * 2u; voffB[i] = (unsigned)(Rb * K + C) * 2u; }
    const size_t kstep = (size_t)(BK * 2);
    const size_t hstep = (size_t)HALF * K * 2;
    const unsigned ldsw = (unsigned)wid * 1024u;
    const int aoff = lds_byte(wr * 64 + fr, F8 ? fq * 16 : fq * 8), boff = lds_byte(wc * 32 + fr, F8 ? fq * 16 : fq * 8);
    constexpr int KSTEP = F8 ? 16 : 1024;
    int f8scale = 0x7F7F7F7F; asm volatile("" : "+v"(f8scale));
#define PG8_SA(b, h) (((b) * 2 + (h)) * HTB)
#define PG8_SB(b, h) ((4 + (b) * 2 + (h)) * HTB)
#define PG8_STAGE(bufoff, gbase, voff) do { _Pragma("unroll") for (int _i = 0; _i < 2; ++_i) \
        __builtin_amdgcn_global_load_lds((const unsigned*)((const char*)(gbase) + (voff)[_i]), (LAS unsigned*)(lds + (bufoff) + ldsw + _i * 8192), 16, 0, 0); } while (0)
#define PG8_LDA(dst, b, h) do { _Pragma("unroll") for (int m = 0; m < 4; ++m) _Pragma("unroll") for (int k = 0; k < 2; ++k) dst[m][k] = *(const LAS bf16x8*)(lds + PG8_SA(b, h) + aoff + m * 2048 + k * KSTEP); } while (0)
#define PG8_LDB(dst, b, h) do { _Pragma("unroll") for (int n = 0; n < 2; ++n) _Pragma("unroll") for (int k = 0; k < 2; ++k) dst[n][k] = *(const LAS bf16x8*)(lds + PG8_SB(b, h) + boff + n * 2048 + k * KSTEP); } while (0)
#define PG8_CAT(X) __builtin_shufflevector(__builtin_bit_cast(u32x4, (X)[0]), __builtin_bit_cast(u32x4, (X)[1]), 0, 1, 2, 3, 4, 5, 6, 7)
#define PG8_MMA(ai, bj, At, Bt) do { __builtin_amdgcn_s_setprio(1); \
        if constexpr (F8) { _Pragma("unroll") for (int m = 0; m < 4; ++m) _Pragma("unroll") for (int n = 0; n < 2; ++n) \
            asm volatile("v_mfma_scale_f32_16x16x128_f8f6f4 %0, %1, %2, %0, %3, %3 op_sel_hi:[0,0,0]" : "+v"(acc[ai][bj][m][n]) : "v"(__builtin_bit_cast(i32x8, PG8_CAT(Bt[n]))), "v"(__builtin_bit_cast(i32x8, PG8_CAT(At[m]))), "v"(f8scale)); } \
        else { _Pragma("unroll") for (int m = 0; m < 4; ++m) _Pragma("unroll") for (int n = 0; n < 2; ++n) _Pragma("unroll") for (int k = 0; k < 2; ++k) \
            acc[ai][bj][m][n] = __builtin_amdgcn_mfma_f32_16x16x32_bf16(Bt[n][k], At[m][k], acc[ai][bj][m][n], 0, 0, 0); } \
        __builtin_amdgcn_s_setprio(0); } while (0)
#define PG8_WAIT_V(n) asm volatile("s_waitcnt vmcnt(" #n ")" ::: "memory")
#define PG8_WAIT_L(n) asm volatile("s_waitcnt lgkmcnt(" #n ")" ::: "memory")
#define PG8_BAR __builtin_amdgcn_s_barrier()
#define PG8_SCHED __builtin_amdgcn_sched_barrier(0)
    Unit cur, nxt; int ui = 0;
    if (!S.next(0, cur)) return;
    f32x4 acc[2][2][4][2];
#pragma unroll
    for (int a = 0; a < 2; ++a)
#pragma unroll
        for (int b = 0; b < 2; ++b)
#pragma unroll
            for (int m = 0; m < 4; ++m)
#pragma unroll
                for (int n = 0; n < 2; ++n) acc[a][b][m][n] = (f32x4){0.f, 0.f, 0.f, 0.f};
    bf16x8 At[4][2], B0[2][2], B1[2][2];
    const char* cA = S.a_ptr(cur); const char* cB = S.b_ptr(cur);
    PG8_STAGE(PG8_SB(0, 0), cB, voffB); PG8_STAGE(PG8_SB(0, 1), cB + hstep, voffB); PG8_STAGE(PG8_SA(0, 0), cA, voffA); PG8_STAGE(PG8_SA(0, 1), cA + hstep, voffA);
    if (wr == 1) PG8_BAR;
    PG8_WAIT_V(2); PG8_BAR;
    PG8_STAGE(PG8_SB(1, 0), cB + kstep, voffB); PG8_STAGE(PG8_SA(1, 0), cA + kstep, voffA); PG8_STAGE(PG8_SB(1, 1), cB + hstep + kstep, voffB);
    PG8_WAIT_V(6); PG8_BAR;
    for (;;) {
        const bool has_next = S.next(ui + 1, nxt);
        const char* nA = has_next ? S.a_ptr(nxt) : cA; const char* nB = has_next ? S.b_ptr(nxt) : cB;
#pragma unroll 1
        for (int t = 0; t < nt; t += 2) {
            const bool last = (t == nt - 2);
            const char* a1 = cA + (size_t)(t + 1) * kstep;
            const char* a2 = last ? nA : cA + (size_t)(t + 2) * kstep; const char* b2 = last ? nB : cB + (size_t)(t + 2) * kstep;
            const char* a3 = a2 + kstep; const char* b3 = b2 + kstep;
            PG8_LDB(B0, 0, 0); PG8_LDB(B1, 0, 1); PG8_SCHED; PG8_LDA(At, 0, 0); PG8_STAGE(PG8_SA(1, 1), a1 + hstep, voffA);
            PG8_WAIT_V(8); PG8_WAIT_L(0); PG8_BAR; PG8_MMA(0, 0, At, B0); PG8_MMA(0, 1, At, B1); PG8_BAR; PG8_SCHED;
            PG8_LDA(At, 0, 1); PG8_STAGE(PG8_SB(0, 0), b2, voffB); PG8_STAGE(PG8_SB(0, 1), b2 + hstep, voffB); PG8_STAGE(PG8_SA(0, 0), a2, voffA);
            PG8_WAIT_V(8); PG8_WAIT_L(0); PG8_BAR; PG8_MMA(1, 0, At, B0); PG8_MMA(1, 1, At, B1); PG8_BAR; PG8_SCHED;
            PG8_LDB(B0, 1, 0); PG8_LDB(B1, 1, 1); PG8_SCHED; PG8_LDA(At, 1, 0); PG8_STAGE(PG8_SA(0, 1), a2 + hstep, voffA);
            PG8_WAIT_V(8); PG8_WAIT_L(0); PG8_BAR; PG8_MMA(0, 0, At, B0); PG8_MMA(0, 1, At, B1); PG8_BAR; PG8_SCHED;
            PG8_LDA(At, 1, 1); PG8_STAGE(PG8_SB(1, 0), b3, voffB); PG8_STAGE(PG8_SB(1, 1), b3 + hstep, voffB); PG8_STAGE(PG8_SA(1, 0), a3, voffA);
            PG8_WAIT_V(8); PG8_WAIT_L(0); PG8_BAR; PG8_MMA(1, 0, At, B0); PG8_MMA(1, 1, At, B1); PG8_BAR; PG8_SCHED;
        }
        if (wr == 0) PG8_BAR;
        if constexpr (F8) asm volatile("s_nop 15\n\ts_nop 7" ::: "memory");
        { int tz = threadIdx.x; asm volatile("" : "+v"(tz));
          const int wid2 = __builtin_amdgcn_readfirstlane(tz >> 6), lane2 = tz & 63; E(acc, cur, wid2 >> 2, wid2 & 3, lane2 & 15, lane2 >> 4); }
        if (!has_next) break;
        if (!(Epi::CHAIN && cur.kind == 0)) {
#pragma unroll
            for (int a = 0; a < 2; ++a)
#pragma unroll
                for (int b = 0; b < 2; ++b)
#pragma unroll
                    for (int m = 0; m < 4; ++m)
#pragma unroll
                        for (int n = 0; n < 2; ++n) acc[a][b][m][n] = (f32x4){0.f, 0.f, 0.f, 0.f};
        }
        cur = nxt; cA = nA; cB = nB; ++ui;
        if (wr == 1) PG8_BAR;
    }
    PG8_WAIT_V(0);
    PG8_BAR;
#undef PG8_SA
#undef PG8_SB
#undef PG8_STAGE
#undef PG8_LDA
#undef PG8_LDB
#undef PG8_MMA
#undef PG8_CAT
#undef PG8_WAIT_V
#undef PG8_WAIT_L
#undef PG8_BAR
#undef PG8_SCHED
}
}
namespace pg8 {
__device__ __forceinline__ u32x4 pack8(const f32x4 a, const f32x4 b) { u32x4 w; w.x = cvt_pk_bf16(a[0], a[1]); w.y = cvt_pk_bf16(a[2], a[3]); w.z = cvt_pk_bf16(b[0], b[1]); w.w = cvt_pk_bf16(b[2], b[3]); return w; }
__device__ __forceinline__ float sumsq4(const f32x4 a) { return (a[0] * a[0] + a[1] * a[1]) + (a[2] * a[2] + a[3] * a[3]); }
#define EPI_BAR() do { asm volatile("s_waitcnt lgkmcnt(0)" ::: "memory"); __builtin_amdgcn_s_barrier(); asm volatile("" ::: "memory"); } while (0)

struct EpiIn {
    static constexpr bool PERM = true, CHAIN = false;
    bf16_t *QA, *KA, *VA, *ZCQ, *ZCKV, *ZKR, *GATES; const float *qg, *kg;
    __device__ __forceinline__ void operator()(f32x4 (&acc)[2][2][4][2], const Unit& u, int wr, int wc, int fr, int fq) const {
        const int row0 = u.pm * BM + wr * 64 + fr, pn = u.pn;
        if (pn < 4) {
            const float* g = (pn < 2) ? qg : kg; bf16_t* dst = (pn < 2) ? QA : KA; const int head = 4 * (pn & 1) + wc;
            f32x4 gv[2][2];
#pragma unroll
            for (int bj = 0; bj < 2; ++bj)
#pragma unroll
                for (int n = 0; n < 2; ++n) gv[bj][n] = *(const f32x4*)(g + 32 * bj + 8 * fq + 4 * n);
#pragma unroll
            for (int ai = 0; ai < 2; ++ai)
#pragma unroll
                for (int m = 0; m < 4; ++m) {
                    const size_t row = (size_t)(row0 + ai * HALF + m * 16);
                    float ss = (sumsq4(acc[ai][0][m][0]) + sumsq4(acc[ai][0][m][1])) + (sumsq4(acc[ai][1][m][0]) + sumsq4(acc[ai][1][m][1]));
                    ss += __shfl_xor(ss, 16); ss += __shfl_xor(ss, 32);
                    const float rstd = rsqrtf(ss * (1.0f / 64.0f) + RMS_EPS);
#pragma unroll
                    for (int bj = 0; bj < 2; ++bj)
                        *(u32x4*)(dst + row * 512 + head * 64 + 32 * bj + 8 * fq) = pack8(acc[ai][bj][m][0] * rstd * gv[bj][0], acc[ai][bj][m][1] * rstd * gv[bj][1]);
                }
        } else if (pn >= 9) {
#pragma unroll
            for (int ai = 0; ai < 2; ++ai)
#pragma unroll
                for (int m = 0; m < 4; ++m) {
                    const size_t row = (size_t)(row0 + ai * HALF + m * 16);
#pragma unroll
                    for (int bj = 0; bj < 2; ++bj) { f32x4 a = acc[ai][bj][m][0], b = acc[ai][bj][m][1];
#pragma unroll
                        for (int j = 0; j < 4; ++j) { a[j] = sigmoidf_(a[j]); b[j] = sigmoidf_(b[j]); }
                        *(u32x4*)(GATES + row * 2048 + (pn - 9) * 256 + 128 * bj + 32 * wc + 8 * fq) = pack8(a, b); }
                }
        } else {
#pragma unroll
            for (int ai = 0; ai < 2; ++ai)
#pragma unroll
                for (int m = 0; m < 4; ++m) {
                    const size_t row = (size_t)(row0 + ai * HALF + m * 16);
#pragma unroll
                    for (int bj = 0; bj < 2; ++bj) {
                        const u32x4 w = pack8(acc[ai][bj][m][0], acc[ai][bj][m][1]); const int cc = 128 * bj + 32 * wc + 8 * fq;
                        if (pn < 6) *(u32x4*)(VA + row * 512 + (pn - 4) * 256 + cc) = w;
                        else if (pn == 6) *(u32x4*)(ZCQ + row * QLORA + cc) = w;
                        else if (pn == 8) *(u32x4*)(ZCKV + row * KVLORA + cc) = w;
                        else { if (bj == 0) *(u32x4*)(ZCQ + row * QLORA + 256 + cc) = w; else if (wc == 0) *(u32x4*)(ZKR + row * ROPED + 8 * fq) = w; }
                    }
                }
        }
    }
};

__device__ __forceinline__ void rope8(float (&v)[8], const float* rope, int s  , int fq) {
    const int pos = (fq < 2) ? (s >> 6) : (s & 63);
    const f32x4 c0 = *(const f32x4*)(rope + pos * 8), c1 = *(const f32x4*)(rope + pos * 8 + 4), s0 = *(const f32x4*)(rope + 512 + pos * 8), s1 = *(const f32x4*)(rope + 512 + pos * 8 + 4);
    const float cs[8] = {c0[0], c0[1], c0[2], c0[3], c1[0], c1[1], c1[2], c1[3]}, sn[8] = {s0[0], s0[1], s0[2], s0[3], s1[0], s1[1], s1[2], s1[3]};
#pragma unroll
    for (int i = 0; i < 8; ++i) { const float o = __shfl_xor(v[i], 16); v[i] = (fq & 1) ? (o * sn[i] + v[i] * cs[i]) : (v[i] * cs[i] - o * sn[i]); }
}

struct EpiQ {
    static constexpr bool PERM = true, CHAIN = false;
    bf16_t* QB; const float *rs, *g, *rope; LAS float* P;
    __device__ __forceinline__ void operator()(f32x4 (&acc)[2][2][4][2], const Unit& u, int wr, int wc, int fr, int fq) const {
        const int row0 = u.pm * BM + wr * 64 + fr; const bool isx = u.pm < MT_X;
#ifdef EQ_TRIVIAL
#pragma unroll
        for (int ai = 0; ai < 2; ++ai)
#pragma unroll
            for (int m = 0; m < 4; ++m) { const size_t row = (size_t)(row0 + ai * HALF + m * 16);
#pragma unroll
                for (int bj = 0; bj < 2; ++bj) *(u32x4*)(QB + row * 768 + (2 * u.pn + bj) * QKD + 32 * wc + 8 * fq) = pack8(acc[ai][bj][m][0], acc[ai][bj][m][1]); }
        return;
#endif
#pragma unroll
        for (int ai = 0; ai < 2; ++ai)
#pragma unroll
            for (int m = 0; m < 4; ++m) {
                const float r = rs[row0 + ai * HALF + m * 16]; const int rl = ai * 64 + m * 16 + fr;
#pragma unroll
                for (int bj = 0; bj < 2; ++bj) {
                    float ss = (sumsq4(acc[ai][bj][m][0]) + sumsq4(acc[ai][bj][m][1])) * (r * r); ss += __shfl_xor(ss, 16); ss += __shfl_xor(ss, 32);
                    if (fq == 0) P[((wr * 128 + rl) * 2 + bj) * 4 + wc] = ss; }
                asm volatile("" ::: "memory");
            }
        EPI_BAR();
        if (wc < 3) {
            const f32x4 g0 = *(const f32x4*)(g + 32 * wc + 8 * fq), g1 = *(const f32x4*)(g + 32 * wc + 8 * fq + 4);
#pragma unroll
            for (int ai = 0; ai < 2; ++ai)
#pragma unroll
                for (int m = 0; m < 4; ++m) {
                    const int row = row0 + ai * HALF + m * 16, rl = ai * 64 + m * 16 + fr; const float r = rs[row];
#pragma unroll
                    for (int bj = 0; bj < 2; ++bj) {
                        const f32x4 p = *(const LAS f32x4*)(P + ((wr * 128 + rl) * 2 + bj) * 4);
                        const float rstd = r * rsqrtf(((p[0] + p[1]) + p[2]) * (1.0f / 96.0f) + RMS_EPS);
                        const f32x4 a = acc[ai][bj][m][0] * rstd * g0, b = acc[ai][bj][m][1] * rstd * g1;
                        float v[8] = {a[0], a[1], a[2], a[3], b[0], b[1], b[2], b[3]};
#ifndef EQ_NOROPE
                        if (wc == 2 && isx) rope8(v, rope, row & (SEQ - 1), fq);
#endif
                        u32x4 w; w.x = cvt_pk_bf16(v[0], v[1]); w.y = cvt_pk_bf16(v[2], v[3]); w.z = cvt_pk_bf16(v[4], v[5]); w.w = cvt_pk_bf16(v[6], v[7]);
                        *(u32x4*)(QB + (size_t)row * 768 + (2 * u.pn + bj) * QKD + 32 * wc + 8 * fq) = w;
                    }
                    asm volatile("" ::: "memory");
                }
        }
    }
};

struct EpiKV {
    static constexpr bool PERM = true, CHAIN = false;
    bf16_t *KB, *VB; const bf16_t* ZKR; const float *rs, *sskr, *g, *rope; LAS float* P;
    __device__ __forceinline__ void operator()(f32x4 (&acc)[2][2][4][2], const Unit& u, int wr, int wc, int fr, int fq) const {
        const int row0 = u.pm * BM + wr * 64 + fr; const bool isx = u.pm < MT_X;
#pragma unroll
        for (int ai = 0; ai < 2; ++ai)
#pragma unroll
            for (int m = 0; m < 4; ++m) {
                const float r = rs[row0 + ai * HALF + m * 16]; const int rl = ai * 64 + m * 16 + fr;
                if (wc < 2) {
#pragma unroll
                    for (int bj = 0; bj < 2; ++bj) { float ss = (sumsq4(acc[ai][bj][m][0]) + sumsq4(acc[ai][bj][m][1])) * (r * r); ss += __shfl_xor(ss, 16); ss += __shfl_xor(ss, 32);
                        if (fq == 0) P[((wr * 128 + rl) * 2 + bj) * 4 + wc] = ss; } }
                asm volatile("" ::: "memory");
            }
        EPI_BAR();
        const int gofs = (wc < 2) ? (32 * wc + 8 * fq) : (64 + 8 * fq);
        const f32x4 g0 = *(const f32x4*)(g + gofs), g1 = *(const f32x4*)(g + gofs + 4);
#pragma unroll
        for (int ai = 0; ai < 2; ++ai)
#pragma unroll
            for (int m = 0; m < 4; ++m) {
                const int row = row0 + ai * HALF + m * 16, rl = ai * 64 + m * 16 + fr;
                const float skr = sskr[row], rr = rs[row];
                u32x4 zk = (u32x4){0u, 0u, 0u, 0u}; if (wc == 2) zk = *(const u32x4*)(ZKR + (size_t)row * ROPED + 8 * fq);
#pragma unroll
                for (int bj = 0; bj < 2; ++bj) {
                    const int head = 2 * u.pn + bj;
                    const f32x4 p = *(const LAS f32x4*)(P + ((wr * 128 + rl) * 2 + bj) * 4);
                    const float rstd = rsqrtf(((p[0] + p[1]) + skr) * (1.0f / 96.0f) + RMS_EPS);
                    if (wc < 2) {
                        *(u32x4*)(KB + (size_t)row * 768 + head * QKD + 32 * wc + 8 * fq) = pack8(acc[ai][bj][m][0] * (rr * rstd) * g0, acc[ai][bj][m][1] * (rr * rstd) * g1);
                    } else {
                        *(u32x4*)(VB + (size_t)row * 512 + head * 64 + 32 * (wc - 2) + 8 * fq) = pack8(acc[ai][bj][m][0] * rr, acc[ai][bj][m][1] * rr);
                        if (wc == 2) {
                            float v[8] = {bf_lo(zk.x) * rstd * g0[0], bf_hi(zk.x) * rstd * g0[1], bf_lo(zk.y) * rstd * g0[2], bf_hi(zk.y) * rstd * g0[3],
                                          bf_lo(zk.z) * rstd * g1[0], bf_hi(zk.z) * rstd * g1[1], bf_lo(zk.w) * rstd * g1[2], bf_hi(zk.w) * rstd * g1[3]};
                            if (isx) rope8(v, rope, row & (SEQ - 1), fq);
                            u32x4 w; w.x = cvt_pk_bf16(v[0], v[1]); w.y = cvt_pk_bf16(v[2], v[3]); w.z = cvt_pk_bf16(v[4], v[5]); w.w = cvt_pk_bf16(v[6], v[7]);
                            *(u32x4*)(KB + (size_t)row * 768 + head * QKD + 64 + 8 * fq) = w;
                        }
                    }
                }
                asm volatile("" ::: "memory");
            }
    }
};

struct EpiMerge {
    static constexpr bool PERM = true, CHAIN = true;
    const bf16_t* GATES; bf16_t* Y;
    __device__ __forceinline__ void operator()(f32x4 (&acc)[2][2][4][2], const Unit& u, int wr, int wc, int fr, int fq) const {
        const int row0 = u.pm * BM + wr * 64 + fr;
#pragma unroll
        for (int ai = 0; ai < 2; ++ai)
#pragma unroll
            for (int m = 0; m < 4; ++m) {
                const size_t row = (size_t)(row0 + ai * HALF + m * 16);
#pragma unroll
                for (int bj = 0; bj < 2; ++bj) {
                    const int col = u.pn * 256 + 128 * bj + 32 * wc + 8 * fq;
                    const u32x4 gb = *(const u32x4*)(GATES + row * 2048 + 1024 + col);
                    const f32x4 b0 = (f32x4){bf_lo(gb.x), bf_hi(gb.x), bf_lo(gb.y), bf_hi(gb.y)}, b1 = (f32x4){bf_lo(gb.z), bf_hi(gb.z), bf_lo(gb.w), bf_hi(gb.w)};
                    if (u.kind == 0) {
                        const u32x4 ga = *(const u32x4*)(GATES + row * 2048 + col);
                        const f32x4 a0 = (f32x4){bf_lo(ga.x), bf_hi(ga.x), bf_lo(ga.y), bf_hi(ga.y)}, a1 = (f32x4){bf_lo(ga.z), bf_hi(ga.z), bf_lo(ga.w), bf_hi(ga.w)};
#pragma unroll
                        for (int j = 0; j < 4; ++j) { acc[ai][bj][m][0][j] *= a0[j] * __builtin_amdgcn_rcpf(b0[j]); acc[ai][bj][m][1][j] *= a1[j] * __builtin_amdgcn_rcpf(b1[j]); }
                    } else {
                        *(u32x4*)(Y + row * 1024 + col) = pack8(acc[ai][bj][m][0] * b0, acc[ai][bj][m][1] * b1);
                    }
                }
            }
    }
};

struct EpiOut {
    static constexpr bool PERM = false, CHAIN = false;
    const float* xsrc; float* xdst; const float* csrc; float* cdst; const float* mod  ; int goff;
    __device__ __forceinline__ void operator()(f32x4 (&acc)[2][2][4][2], const Unit& u, int wr, int wc, int fr, int fq) const {
        const bool isx = u.pm < MT_X;
        const int rowt = (isx ? u.pm : u.pm - MT_X) * BM + wr * 64 + fr;
        const float* src = isx ? xsrc : csrc; float* dst = isx ? xdst : cdst;
        const float* gm = mod + (size_t)(isx ? (u.pm >> 3) : 16) * NMODC + goff;
        const int col0 = u.pn * BM + wc * 32 + 4 * fq;
        f32x4 gv[2][2];
#pragma unroll
        for (int bj = 0; bj < 2; ++bj)
#pragma unroll
            for (int n = 0; n < 2; ++n) gv[bj][n] = *(const f32x4*)(gm + col0 + bj * HALF + n * 16);
#pragma unroll
        for (int ai = 0; ai < 2; ++ai)
#pragma unroll
            for (int m = 0; m < 4; ++m) { const size_t off = (size_t)(rowt + ai * HALF + m * 16) * DM + col0;
#pragma unroll
                for (int bj = 0; bj < 2; ++bj)
#pragma unroll
                    for (int n = 0; n < 2; ++n) { const f32x4 xs = *(const f32x4*)(src + off + bj * HALF + n * 16); *(f32x4*)(dst + off + bj * HALF + n * 16) = xs + gv[bj][n] * acc[ai][bj][m][n]; }
            }
    }
};

template <bool F8> struct EpiMoe1 {
    static constexpr bool PERM = true, CHAIN = false;
    bf16_t* HM; float ascale;
    __device__ __forceinline__ void operator()(f32x4 (&acc)[2][2][4][2], const Unit& u, int wr, int wc, int fr, int fq) const {
        const int row0 = u.pm * BM + wr * 64 + fr;
#pragma unroll
        for (int ai = 0; ai < 2; ++ai)
#pragma unroll
            for (int m = 0; m < 4; ++m) { const size_t row = (size_t)(row0 + ai * HALF + m * 16);
#pragma unroll
                for (int bj = 0; bj < 2; ++bj) { f32x4 p = acc[ai][bj][m][0], q = acc[ai][bj][m][1];
                    if (F8) { p = p * ascale; q = q * ascale; }
                    const float h0 = p[0] * sigmoidf_(p[0]) * p[1], h1 = p[2] * sigmoidf_(p[2]) * p[3], h2 = q[0] * sigmoidf_(q[0]) * q[1], h3 = q[2] * sigmoidf_(q[2]) * q[3];
                    const int col = u.pn * 128 + 64 * bj + 16 * wc + 4 * fq;
                    if (F8) *(unsigned*)((unsigned char*)HM + row * DM + col) = cvt_pk4_fp8(h0 * F8_SM, h1 * F8_SM, h2 * F8_SM, h3 * F8_SM);
                    else { u32x2 w; w.x = cvt_pk_bf16(h0, h1); w.y = cvt_pk_bf16(h2, h3); *(u32x2*)(HM + row * DM + col) = w; } }
            }
    }
};
struct EpiMoe2 {
    static constexpr bool PERM = true, CHAIN = false;
    bf16_t* YS; float ascale;
    __device__ __forceinline__ void operator()(f32x4 (&acc)[2][2][4][2], const Unit& u, int wr, int wc, int fr, int fq) const {
        const int row0 = u.pm * BM + wr * 64 + fr;
#pragma unroll
        for (int ai = 0; ai < 2; ++ai)
#pragma unroll
            for (int m = 0; m < 4; ++m) { const size_t row = (size_t)(row0 + ai * HALF + m * 16);
#pragma unroll
                for (int bj = 0; bj < 2; ++bj) *(u32x4*)(YS + row * DM + u.pn * 256 + 128 * bj + 32 * wc + 8 * fq) = pack8(acc[ai][bj][m][0] * ascale, acc[ai][bj][m][1] * ascale); }
    }
};

struct SchedRect {
    const char* A; const char* B; size_t tstep; int nM, nN, G, c, nM2, pn2, npn2;
    __device__ __forceinline__ bool next(int i, Unit& u) const {
        const int L = i * G + c, mainc = nM * nN; u.kind = 0; u.e = 0;
        if (L < mainc) { rect_tile(L, nM, nN, u.pm, u.pn); return true; }
        const int Lx = L - mainc; if (Lx >= nM2 * npn2) return false;
        u.pm = nM + Lx / npn2; u.pn = pn2 + Lx % npn2; return true;
    }
    __device__ __forceinline__ const char* a_ptr(const Unit& u) const { return A + (size_t)u.pm * tstep; }
    __device__ __forceinline__ const char* b_ptr(const Unit& u) const { return B + (size_t)u.pn * tstep; }
};
struct SchedMerge {
    const char *OA, *OB, *WA, *WB; size_t tstep; int nM, nN, G, c;
    __device__ __forceinline__ bool next(int i, Unit& u) const {
        const int L = (i >> 1) * G + c; if (L >= nM * nN) return false;
        rect_tile(L, nM, nN, u.pm, u.pn); u.kind = i & 1; u.e = 0; return true;
    }
    __device__ __forceinline__ const char* a_ptr(const Unit& u) const { return (u.kind ? OB : OA) + (size_t)u.pm * tstep; }
    __device__ __forceinline__ const char* b_ptr(const Unit& u) const { return (u.kind ? WB : WA) + (size_t)u.pn * tstep; }
};
struct SchedMoe {
    const char* A; const char* W; size_t tstepA, wstride, tstepB; const LAS int* tile_e  ; int ntile, nN, G, c;
    __device__ __forceinline__ bool next(int i, Unit& u) const {
        const int L = i * G + c; if (L >= ntile * nN) return false;
        rect_tile(L, ntile, nN, u.pm, u.pn); u.kind = 0;
        u.e = __builtin_amdgcn_readfirstlane(tile_e[u.pm]); return true;
    }
    __device__ __forceinline__ const char* a_ptr(const Unit& u) const { return A + (size_t)u.pm * tstepA; }
    __device__ __forceinline__ const char* b_ptr(const Unit& u) const { return W + (size_t)u.e * wstride + (size_t)u.pn * tstepB; }
};
}
namespace att {
constexpr int NW = 8, QBLK = 32, KVBLK = 64, DV = 64;
constexpr int SHM_V = 16384, SHM_K = 16384;
constexpr int LDS_VOFF = 0, LDS_KOFF = 2 * SHM_V, LDS_WS = LDS_KOFF + 2 * SHM_K, LDS_OST = LDS_WS + NW * 64 * 4, LDS_BIAS = LDS_OST + NW * 4096, LDS_MASK = LDS_BIAS + 16 * 128 * 4, LDS_END = LDS_MASK + 64 * 64 * 4;
static_assert(LDS_END <= RING_BYTES, "attention LDS map");
template <int DQK> struct KL { static constexpr int PITCH = (DQK == 64) ? 128 : 256; };
#define KSWZ(row, colB) ((row) * KL<DQK>::PITCH + ((colB) ^ (((row) & 7) << 4)))
#define SBAR() __builtin_amdgcn_sched_barrier(0)
__device__ __forceinline__ int crow(int r, int hi) { return (r & 3) + 8 * (r >> 2) + 4 * hi; }
__device__ __forceinline__ int v_st(int k, int c) { const int kk = (k & ~0xC) | ((k & 4) << 1) | ((k & 8) >> 1); return ((kk >> 3) * 2 + (c >> 5)) * 512 + ((kk & 7) * 32 + (c & 31)) * 2; }
__device__ __forceinline__ int v_rd_base(int lane, int c) { const int hi = (lane >> 5) & 1, g = c + hi;
    return ((lane & 3) << 3) | (((lane >> 2) & 3) << 6) | (((lane >> 4) & 1) << 5) | ((g & 1) << 8) | ((g >> 1) << 11); }
constexpr int v_rd_off(int d0, int ks, int half) { return ((2 * ks + half) * 2 + d0) * 512; }
template <int OFF> __device__ __forceinline__ s16x4 tr_read(int vb) { s16x4 r; asm volatile("ds_read_b64_tr_b16 %0, %1 offset:%2" : "=&v"(r) : "v"(vb), "i"(OFF) : "memory"); return r; }

template <int D0> __device__ __forceinline__ void pv_one(f32x16& od, int vbA, int vbB, bf16x8 pa0, bf16x8 pa1, bf16x8 pa2, bf16x8 pa3) {
    const s16x4 l0 = tr_read<v_rd_off(D0, 0, 0)>(vbA), h0 = tr_read<v_rd_off(D0, 0, 1)>(vbA), l1 = tr_read<v_rd_off(D0, 1, 0)>(vbA), h1 = tr_read<v_rd_off(D0, 1, 1)>(vbA);
    const s16x4 l2 = tr_read<v_rd_off(D0, 0, 0)>(vbB), h2 = tr_read<v_rd_off(D0, 0, 1)>(vbB), l3 = tr_read<v_rd_off(D0, 1, 0)>(vbB), h3 = tr_read<v_rd_off(D0, 1, 1)>(vbB);
    asm volatile("s_waitcnt lgkmcnt(0)" ::: "memory"); SBAR();
#define PK(L, H) (bf16x8){L[0], L[1], L[2], L[3], H[0], H[1], H[2], H[3]}
    od = __builtin_amdgcn_mfma_f32_32x32x16_bf16(pa0, PK(l0, h0), od, 0, 0, 0);
    od = __builtin_amdgcn_mfma_f32_32x32x16_bf16(pa1, PK(l1, h1), od, 0, 0, 0);
    od = __builtin_amdgcn_mfma_f32_32x32x16_bf16(pa2, PK(l2, h2), od, 0, 0, 0);
    od = __builtin_amdgcn_mfma_f32_32x32x16_bf16(pa3, PK(l3, h3), od, 0, 0, 0);
#undef PK
}
__device__ __forceinline__ void pv_all(f32x16* o, int vbA, int vbB, bf16x8 pa0, bf16x8 pa1, bf16x8 pa2, bf16x8 pa3) { pv_one<0>(o[0], vbA, vbB, pa0, pa1, pa2, pa3); pv_one<1>(o[1], vbA, vbB, pa0, pa1, pa2, pa3); }

#define MX3(a, b, c) __builtin_fmaxf(__builtin_fmaxf((a), (b)), (c))
template <bool FIRST>
__device__ __forceinline__ void partialSM(f32x16& p0, f32x16& p1, float& m_reg, float& alpha, f32x16& negm, const float THR2) {
    float a = MX3(p0[0], p0[1], p1[0]), b = MX3(p0[2], p0[3], p1[1]); a = MX3(a, p1[2], p1[3]);
#pragma unroll
    for (int r = 4; r < 16; r += 4) { a = MX3(a, p0[r], p0[r + 1]); b = MX3(b, p0[r + 2], p0[r + 3]); a = MX3(a, p1[r], p1[r + 1]); b = MX3(b, p1[r + 2], p1[r + 3]); }
    float pmax = __builtin_fmaxf(a, b);
    { auto rr = __builtin_amdgcn_permlane32_swap(__float_as_uint(pmax), __float_as_uint(pmax), false, false); pmax = __builtin_fmaxf(__uint_as_float(rr[0]), __uint_as_float(rr[1])); }
    alpha = 1.f;
    if (FIRST || !__builtin_expect(__all(pmax <= THR2), 1)) {
        const float dl = FIRST ? pmax : __builtin_fmaxf(pmax, 0.f);
        m_reg += dl; alpha = FIRST ? 1.f : __builtin_amdgcn_exp2f(-dl);
#pragma unroll
        for (int r = 0; r < 16; ++r) { p0[r] -= dl; p1[r] -= dl; }
#pragma unroll
        for (int r = 0; r < 16; ++r) negm[r] = -m_reg;
    }
#pragma unroll
    for (int r = 0; r < 16; ++r) p0[r] = __builtin_amdgcn_exp2f(p0[r]);
}
__device__ __forceinline__ void finishSM(f32x16& p0, f32x16& p1, float alpha, float& l_reg, bf16x8& pa0, bf16x8& pa1, bf16x8& pa2, bf16x8& pa3) {
#pragma unroll
    for (int r = 0; r < 16; ++r) p1[r] = __builtin_amdgcn_exp2f(p1[r]);
    float ps = 0;
#pragma unroll
    for (int r = 0; r < 16; ++r) ps += p0[r];
#pragma unroll
    for (int r = 0; r < 16; ++r) ps += p1[r];
    { auto rr = __builtin_amdgcn_permlane32_swap(__float_as_uint(ps), __float_as_uint(ps), false, false); ps = __uint_as_float(rr[0]) + __uint_as_float(rr[1]); }
    l_reg = l_reg * alpha + ps;
#define PK4(P, BASE, OUT) do { unsigned a0 = cvt_pk_bf16(P[BASE + 0], P[BASE + 1]), a1 = cvt_pk_bf16(P[BASE + 2], P[BASE + 3]);   \
    unsigned b0 = cvt_pk_bf16(P[BASE + 4], P[BASE + 5]), b1 = cvt_pk_bf16(P[BASE + 6], P[BASE + 7]);                              \
    auto r0 = __builtin_amdgcn_permlane32_swap(a0, b0, false, false); auto r1 = __builtin_amdgcn_permlane32_swap(a1, b1, false, false); \
    u32x4 w = {r0[0], r1[0], r0[1], r1[1]}; OUT = *reinterpret_cast<bf16x8*>(&w); } while (0)
    PK4(p0, 0, pa0); PK4(p0, 8, pa1); PK4(p1, 0, pa2); PK4(p1, 8, pa3);
#undef PK4
}
template <int DQK> __device__ __forceinline__ void qkt(f32x16& p0, f32x16& p1, const char* Ks, int rowA, int rowB, const bf16x8* qr, const f32x16& negm, int hi) {
#pragma unroll
    for (int d0 = 0; d0 < DQK / 16; ++d0) { const int cb = (d0 * 16 + hi * 8) * 2;
        const bf16x8 b0 = *reinterpret_cast<const bf16x8*>(Ks + KSWZ(rowA, cb));
        const bf16x8 b1 = *reinterpret_cast<const bf16x8*>(Ks + KSWZ(rowB, cb));
        if (d0 == 0) { p0 = __builtin_amdgcn_mfma_f32_32x32x16_bf16(b0, qr[0], negm, 0, 0, 0); p1 = __builtin_amdgcn_mfma_f32_32x32x16_bf16(b1, qr[0], negm, 0, 0, 0); }
        else { p0 = __builtin_amdgcn_mfma_f32_32x32x16_bf16(b0, qr[d0], p0, 0, 0, 0); p1 = __builtin_amdgcn_mfma_f32_32x32x16_bf16(b1, qr[d0], p1, 0, 0, 0); } }
}

struct UnitArgs {
    const bf16_t* Q; int ldq; int qcol;
    const bf16_t* K; int ldk; int kcol;
    const bf16_t* V; int vcol;
    bf16_t* O; int ocol;
    int q0;
    int ctx0, loc0;
    int NT;
    int masked;
    int band, krow0;
    const float* bias;
    float C;
};

__device__ __forceinline__ void na_mask(f32x16& p0, f32x16& p1, const LAS float* bt, const LAS float* mk, int krA, int qrow, int qc, int kc0, int hi) {
    const int rs = min(max(qrow - 4, 0), 24);
    const int drA = ((krA >= rs) && (krA < rs + 8)) ? (krA - qrow + 7) : 15, drB = ((krA + 1 >= rs) && (krA + 1 < rs + 8)) ? (krA + 1 - qrow + 7) : 15;
    const LAS float* bA = bt + drA * 128 + (kc0 + 4 * hi - qc + 64); const LAS float* bB = bt + drB * 128 + (kc0 + 4 * hi - qc + 64);
    const LAS float* mq = mk + qc * 64 + kc0 + 4 * hi;
#pragma unroll
    for (int g = 0; g < 4; ++g) {
        const f32x4 m0 = *(const LAS f32x4*)(mq + 8 * g);
#pragma unroll
        for (int j = 0; j < 4; ++j) { p0[4 * g + j] = (p0[4 * g + j] + bA[8 * g + j]) + m0[j]; p1[4 * g + j] = (p1[4 * g + j] + bB[8 * g + j]) + m0[j]; }
    }
}
__device__ __forceinline__ void na_mask_table(char* lds) {
    LAS float* mk = (LAS float*)(lds + LDS_MASK);
    int t0 = threadIdx.x; asm volatile("" : "+v"(t0));
    for (int i = t0; i < 64 * 64; i += 512) { const int qc = i >> 6, kc = i & 63, cs = min(max(qc - 8, 0), 48); mk[i] = ((unsigned)(kc - cs) < 16u) ? 0.f : -1e30f; }
}

template <int DQK>
__device__ __forceinline__ void attn_unit(const UnitArgs& A, char* lds) {
    int tid = threadIdx.x; asm volatile("" : "+v"(tid));
    const int wid = tid >> 6, lane = tid & 63, r32 = lane & 31, hi = lane >> 5;
    char* V_lds = lds + LDS_VOFF; char* K_lds = lds + LDS_KOFF;
    float* ws = (float*)(lds + LDS_WS) + wid * 64; float* li_l = ws; float* al_l = ws + 32;
    const LAS float* bt = (const LAS float*)(lds + LDS_BIAS); const LAS float* mk = (const LAS float*)(lds + LDS_MASK);
    const float C = A.C, THR2 = 8.0f * 1.4426950408889634f;
    const bool msk = (DQK == 64) && A.masked;
    float m_reg = 0.f, l_reg = 0; f32x16 o[2] = {}; bf16x8 qr[DQK / 16]; f32x16 negm = f32x16{};
    if (msk) { for (int i = tid; i < 16 * 128; i += 512) { const int dr = i >> 7, d = (i & 127) - 64;
            ((LAS float*)(lds + LDS_BIAS))[i] = (dr == 15) ? -1e30f : ((d >= -15 && d <= 15) ? A.bias[dr * 31 + d + 15] * 1.4426950408889634f : 0.f); } }
    const int qrow = 4 * A.band + 2 * (wid >> 2) + (r32 >> 4), qc = 16 * (wid & 3) + (r32 & 15);
    const int kc0 = msk ? min(max(16 * (wid & 3) - 8, 0), 32) : 0;
    const int qtok = msk ? (A.q0 + 64 * (2 * (wid >> 2) + (r32 >> 4)) + qc) : (A.q0 + wid * QBLK + r32);
    const bf16_t* Qw = A.Q + (size_t)qtok * A.ldq + A.qcol + hi * 8;
#pragma unroll
    for (int d0 = 0; d0 < DQK / 16; ++d0) { const u32x4 w = *reinterpret_cast<const u32x4*>(Qw + d0 * 16);
        u32x4 t; t.x = cvt_pk_bf16(bf_lo(w.x) * C, bf_hi(w.x) * C); t.y = cvt_pk_bf16(bf_lo(w.y) * C, bf_hi(w.y) * C); t.z = cvt_pk_bf16(bf_lo(w.z) * C, bf_hi(w.z) * C); t.w = cvt_pk_bf16(bf_lo(w.w) * C, bf_hi(w.w) * C);
        qr[d0] = *reinterpret_cast<bf16x8*>(&t); }
    constexpr int CPR = DQK / 8;
    const int v0key = tid >> 3, vc = (tid & 7) * 8, vst0 = v_st(v0key, vc), vst1 = 8192 + vst0;
    const int k0key = tid / CPR, k0c = tid % CPR, k1id = tid + 512, k1key = k1id / CPR, k1c = k1id % CPR;
    const int vbS = (int)(uintptr_t)V_lds + v_rd_base(lane, 0);
    const int vbM = (int)(uintptr_t)V_lds + v_rd_base(lane, kc0 >> 3);
    bf16x8 sv0, sv1 = {}, sk0, sk1 = {};
#define LOCAL(t) (msk && (t) >= 4)
#define TROW(t) (((t) < 4) ? (A.ctx0 + 64 * (t)) : (A.loc0 + (msk ? 128 : 64) * ((t) - 4)))
#define K1ON(t) ((DQK == 96) ? (tid < 256) : LOCAL(t))
#define SLOAD(t) do { const int _r0 = TROW(t); sv0 = *reinterpret_cast<const bf16x8*>(A.V + (size_t)(_r0 + v0key) * 512 + A.vcol + vc); \
        sk0 = *reinterpret_cast<const bf16x8*>(A.K + (size_t)(_r0 + k0key) * A.ldk + A.kcol + k0c * 8); \
        if (K1ON(t)) sk1 = *reinterpret_cast<const bf16x8*>(A.K + (size_t)(_r0 + k1key) * A.ldk + A.kcol + k1c * 8); \
        if (LOCAL(t)) sv1 = *reinterpret_cast<const bf16x8*>(A.V + (size_t)(_r0 + 64 + v0key) * 512 + A.vcol + vc); } while (0)
#define SWRITE(b, t) do { *reinterpret_cast<bf16x8*>(V_lds + (b) * SHM_V + vst0) = sv0; *reinterpret_cast<bf16x8*>(K_lds + (b) * SHM_K + KSWZ(k0key, k0c * 16)) = sk0; \
        if (K1ON(t)) *reinterpret_cast<bf16x8*>(K_lds + (b) * SHM_K + KSWZ(k1key, k1c * 16)) = sk1; \
        if (LOCAL(t)) *reinterpret_cast<bf16x8*>(V_lds + (b) * SHM_V + vst1) = sv1; } while (0)
#define RESC(a) do { if (__any((a) < 1.f)) { if (hi == 0) al_l[r32] = (a); asm volatile("s_waitcnt lgkmcnt(0)" ::: "memory"); \
        _Pragma("unroll") for (int d = 0; d < 2; ++d) _Pragma("unroll") for (int r = 0; r < 16; ++r) o[d][r] *= al_l[crow(r, hi)]; } } while (0)
#define QKT(P0, P1, b, t) do { const int _ra = LOCAL(t) ? (kc0 + r32) : r32, _rb = LOCAL(t) ? (64 + kc0 + r32) : (32 + r32); \
        qkt<DQK>(P0, P1, K_lds + (b) * SHM_K, _ra, _rb, qr, negm, hi); if (LOCAL(t)) na_mask(P0, P1, bt, mk, A.krow0 + 2 * ((t) - 4), qrow, qc, kc0, hi); } while (0)
#define PV(b, t) do { const int _va = (LOCAL(t) ? vbM : vbS) + (b) * SHM_V, _vb = _va + (LOCAL(t) ? 8192 : 4096); pv_all(o, _va, _vb, pa0, pa1, pa2, pa3); } while (0)
    f32x16 pA0, pA1, pB0, pB1; float alA, alB; bf16x8 pa0, pa1, pa2, pa3; const int NT = A.NT;
    SLOAD(0); SWRITE(0, 0); __syncthreads();
    QKT(pA0, pA1, 0, 0); partialSM<true>(pA0, pA1, m_reg, alA, negm, THR2);
    SLOAD(1); SWRITE(1, 1); __syncthreads();
    for (int j = 1; j + 1 < NT; j += 2) {
        SBAR(); QKT(pB0, pB1, 1, j);
        finishSM(pA0, pA1, alA, l_reg, pa0, pa1, pa2, pa3); SBAR();
        SLOAD(j + 1); SBAR();
        PV(0, j - 1); partialSM<false>(pB0, pB1, m_reg, alB, negm, THR2);
        __syncthreads(); SWRITE(0, j + 1);
        RESC(alB); __syncthreads();
        SBAR(); QKT(pA0, pA1, 0, j + 1);
        finishSM(pB0, pB1, alB, l_reg, pa0, pa1, pa2, pa3); SBAR();
        SLOAD(j + 2); SBAR();
        PV(1, j); partialSM<false>(pA0, pA1, m_reg, alA, negm, THR2);
        __syncthreads(); SWRITE(1, j + 2);
        RESC(alA); __syncthreads();
    }
    SBAR(); QKT(pB0, pB1, 1, NT - 1);
    finishSM(pA0, pA1, alA, l_reg, pa0, pa1, pa2, pa3); SBAR();
    PV(0, NT - 2); partialSM<false>(pB0, pB1, m_reg, alB, negm, THR2);
    __syncthreads(); RESC(alB);
    finishSM(pB0, pB1, alB, l_reg, pa0, pa1, pa2, pa3); SBAR();
    PV(1, NT - 1);
    if (hi == 0) li_l[r32] = l_reg; asm volatile("s_waitcnt lgkmcnt(0)" ::: "memory");
    float rli[16];
#pragma unroll
    for (int r = 0; r < 16; ++r) rli[r] = __builtin_amdgcn_rcpf(li_l[crow(r, hi)]);
    bf16_t* stg = (bf16_t*)(lds + LDS_OST) + wid * 2048;
#pragma unroll
    for (int r = 0; r < 16; ++r) { const int orow = crow(r, hi);
#pragma unroll
        for (int d0 = 0; d0 < 2; ++d0) { const unsigned w = cvt_pk_bf16(o[d0][r] * rli[r], 0.f); stg[orow * 64 + d0 * 32 + r32] = (bf16_t)(w & 0xffffu); } }
    asm volatile("s_waitcnt lgkmcnt(0)" ::: "memory");
#pragma unroll
    for (int i = 0; i < 4; ++i) { const int row = i * 8 + (lane >> 3), ch = lane & 7; const u32x4 v = *(const u32x4*)(stg + row * 64 + ch * 8);
        const int otok = msk ? (A.q0 + 64 * (2 * (wid >> 2) + (row >> 4)) + 16 * (wid & 3) + (row & 15)) : (A.q0 + wid * QBLK + row);
        *(u32x4*)(A.O + (size_t)otok * 512 + A.ocol + ch * 8) = v; }
    __syncthreads();
#undef LOCAL
#undef TROW
#undef K1ON
#undef SLOAD
#undef SWRITE
#undef RESC
#undef QKT
#undef PV
}
#undef KSWZ
#undef SBAR
}
struct Frame {
    LAS unsigned char* lds;
    int tid, lane, wave, vcu, G;
};
#define CAS __attribute__((address_space(4)))
__device__ __forceinline__ const CAS char* karg() { return (const CAS char*)__builtin_amdgcn_kernarg_segment_ptr(); }
template <int I> __device__ __forceinline__ const float* in_ptr() { unsigned off = I * 8; asm volatile("" : "+s"(off)); return *(const float* const CAS*)(karg() + off); }
__device__ __forceinline__ float* out_ptr() { unsigned off = 26 * 8; asm volatile("" : "+s"(off)); return *(float* const CAS*)(karg() + off); }
__device__ __forceinline__ unsigned char* ws_ptr() { unsigned off = 27 * 8; asm volatile("" : "+s"(off)); return *(unsigned char* const CAS*)(karg() + off); }
enum { I_X = 0, I_C, I_CTX, I_CCTX, I_WADA, I_BADA, I_NMIXG, I_NFFNG, I_WIN, I_NAQG, I_NAKG, I_RPB, I_CQG, I_WUQ, I_CKVG, I_WUKV, I_QG, I_KG, I_WOA, I_WOB, I_WOUT, I_WR, I_RB, I_W1, I_W3, I_W2 };

#define LDS_WAIT() asm volatile("s_waitcnt lgkmcnt(0)" ::: "memory")

__device__ __forceinline__ int win_src_col(int np) {
    const int pn = np >> 8, cc = np & 255;
    if (pn < 4) { const int part = pn >> 1, tq = pn & 1, bj = cc >> 7, wc = (cc >> 5) & 3, i = cc & 31; return part * 512 + (4 * tq + wc) * 64 + 32 * bj + i; }
    if (pn < 6) return 1024 + (pn - 4) * 256 + cc;
    if (pn == 6) return 1536 + cc;
    if (pn == 7) return cc < 128 ? 1792 + cc : (cc < 160 ? 2176 + (cc - 128) : -1);
    if (pn == 8) return 1920 + cc;
    return 2208 + (pn - 9) * 256 + cc;
}
template <bool F8 = false>
__device__ __forceinline__ void conv_item(const float* src, size_t ld, int dcol, int dstep, const float* gain, bf16_t* WT, int K, int k0, int n0, LAS float* scr, int lane) {
    const int kr = lane >> 4;
    f32x4 v[16];
#pragma unroll
    for (int i = 0; i < 16; ++i) { v[i] = (f32x4){0.f, 0.f, 0.f, 0.f}; if (src) v[i] = __builtin_nontemporal_load((const f32x4*)(src + (size_t)(k0 + 4 * i + kr) * ld)); }
#pragma unroll
    for (int i = 0; i < 16; ++i) { const int kk = 4 * i + kr;
        if (gain) v[i] = v[i] * gain[k0 + kk];
        LAS float* s = scr + kk * 65 + dcol; s[0] = v[i][0]; s[dstep] = v[i][1]; s[2 * dstep] = v[i][2]; s[3 * dstep] = v[i][3]; }
    LDS_WAIT(); asm volatile("" ::: "memory");
    const int c = lane & 7;
#pragma unroll
    for (int j = 0; j < 8; ++j) { const int n = (lane >> 3) + 8 * j; const LAS float* s = scr + (8 * c) * 65 + n;
        if (F8) { u32x2 o; o.x = cvt_pk4_fp8(s[0 * 65] * F8_SW, s[1 * 65] * F8_SW, s[2 * 65] * F8_SW, s[3 * 65] * F8_SW); o.y = cvt_pk4_fp8(s[4 * 65] * F8_SW, s[5 * 65] * F8_SW, s[6 * 65] * F8_SW, s[7 * 65] * F8_SW);
            *(u32x2*)((unsigned char*)WT + (size_t)(n0 + n) * K + k0 + 8 * c) = o; }
        else { u32x4 o; o.x = cvt_pk_bf16(s[0 * 65], s[1 * 65]); o.y = cvt_pk_bf16(s[2 * 65], s[3 * 65]); o.z = cvt_pk_bf16(s[4 * 65], s[5 * 65]); o.w = cvt_pk_bf16(s[6 * 65], s[7 * 65]);
            *(u32x4*)(WT + (size_t)(n0 + n) * K + k0 + 8 * c) = o; } }
    LDS_WAIT(); asm volatile("" ::: "memory");
}
__device__ __forceinline__ void p0_convert(Frame& F) {
    LAS float* scr = (LAS float*)(F.lds + F.wave * 16640);
    const int gw = F.vcu * 8 + F.wave, NGW = F.G * 8, lane = F.lane, q16 = lane & 15;
    constexpr int I_IN = 16 * 68, I_UQ = 6 * 16, I_UKV = 4 * 16, I_OA = 8 * 16, I_OUT = 16 * 16, I_13 = 16 * 32 * NEXP, I_2 = 16 * 16 * NEXP;
    constexpr int PER_L = I_IN + I_UQ + I_UKV + 2 * I_OA + I_OUT + I_13 + I_2;
    unsigned char* const ws = ws_ptr();
    for (int it = gw; it < NLAYER * PER_L; it += NGW) {
        const int l = it / PER_L; int r = it - l * PER_L;
        if (r < I_IN) { const int kb = r / 68, nb = r % 68, sc = win_src_col(nb * 64 + 4 * q16);
            conv_item(sc >= 0 ? in_ptr<I_WIN>() + (size_t)l * DM * INC + sc : nullptr, INC, 4 * q16, 1, nullptr, (bf16_t*)(ws + WS_WIN) + (size_t)l * INP * DM, DM, kb * 64, nb * 64, scr, lane); continue; } r -= I_IN;
        if (r < I_UQ) { const int kb = r / 16, nb = r % 16, np = nb * 64 + 4 * q16, hh = np >> 7, dd = np & 127;
            conv_item(dd < QKD ? in_ptr<I_WUQ>() + (size_t)l * QLORA * 768 + hh * QKD + dd : nullptr, 768, 4 * q16, 1, in_ptr<I_CQG>() + l * QLORA, (bf16_t*)(ws + WS_WUQ) + (size_t)l * 1024 * QLORA, QLORA, kb * 64, nb * 64, scr, lane); continue; } r -= I_UQ;
        if (r < I_UKV) { const int kb = r / 16, nb = r % 16;
            conv_item(in_ptr<I_WUKV>() + (size_t)l * KVLORA * 1024 + nb * 64 + 4 * q16, 1024, 4 * q16, 1, in_ptr<I_CKVG>() + l * KVLORA, (bf16_t*)(ws + WS_WUKV) + (size_t)l * 1024 * KVLORA, KVLORA, kb * 64, nb * 64, scr, lane); continue; } r -= I_UKV;
        if (r < 2 * I_OA) { const int w = r / I_OA, rr = r % I_OA, kb = rr / 16, nb = rr % 16;
            conv_item((w ? in_ptr<I_WOB>() : in_ptr<I_WOA>()) + (size_t)l * 512 * DM + nb * 64 + 4 * q16, DM, 4 * q16, 1, nullptr, (bf16_t*)(ws + (w ? WS_WOB : WS_WOA)) + (size_t)l * 1024 * 512, 512, kb * 64, nb * 64, scr, lane); continue; } r -= 2 * I_OA;
        if (r < I_OUT) { const int kb = r / 16, nb = r % 16;
            conv_item(in_ptr<I_WOUT>() + (size_t)l * DM * DM + nb * 64 + 4 * q16, DM, 4 * q16, 1, nullptr, (bf16_t*)(ws + WS_WOUT) + (size_t)l * DM * DM, DM, kb * 64, nb * 64, scr, lane); continue; } r -= I_OUT;
        if (r < I_13) { const int e = r / 512, rr = r % 512, kb = rr / 32, nb = rr % 32;
            const float* base = ((q16 < 8) ? in_ptr<I_W1>() : in_ptr<I_W3>()) + ((size_t)l * NEXP + e) * DM * DM + nb * 32 + 4 * (q16 & 7);
            bf16_t* const wt = (bf16_t*)(ws + WS_W13) + ((size_t)l * NEXP) * 2048 * DM;
            if (l == NLAYER - 1) conv_item<true>(base, DM, 8 * (q16 & 7) + (q16 >> 3), 2, nullptr, (bf16_t*)((unsigned char*)wt + (size_t)e * 2048 * DM), DM, kb * 64, nb * 64, scr, lane);
            else conv_item(base, DM, 8 * (q16 & 7) + (q16 >> 3), 2, nullptr, wt + (size_t)e * 2048 * DM, DM, kb * 64, nb * 64, scr, lane);
            continue; } r -= I_13;
        { const int e = r / 256, rr = r % 256, kb = rr / 16, nb = rr % 16;
            const float* const src2 = in_ptr<I_W2>() + ((size_t)l * NEXP + e) * DM * DM + nb * 64 + 4 * q16; bf16_t* const wt = (bf16_t*)(ws + WS_W2) + ((size_t)l * NEXP) * DM * DM;
            if (l == NLAYER - 1) conv_item<true>(src2, DM, 4 * q16, 1, nullptr, (bf16_t*)((unsigned char*)wt + (size_t)e * DM * DM), DM, kb * 64, nb * 64, scr, lane);
            else conv_item(src2, DM, 4 * q16, 1, nullptr, wt + (size_t)e * DM * DM, DM, kb * 64, nb * 64, scr, lane); }
    }
}
__device__ __forceinline__ void p0_ada(Frame& F) {
    if ((int)blockIdx.x >= 2 * 96) return;
    unsigned char* const ws = ws_ptr(); const float* const cin = in_ptr<I_C>(); const float* const cctx = in_ptr<I_CCTX>(); const float* const wada = in_ptr<I_WADA>(); const float* const bada = in_ptr<I_BADA>();
    LAS float* sct = (LAS float*)F.lds;
    LAS float* red = (LAS float*)(F.lds + 1024 * 20 * 4);
    for (int idx = F.tid; idx < 17 * 1024; idx += 512) { const int r = idx >> 10, d = idx & 1023; const float v = (r < 16) ? cin[r * DM + d] : cctx[d]; sct[d * 20 + r] = v * (1.0f / (1.0f + expf(-v))); }
    __syncthreads();
    float* MOD = (float*)(ws + WS_MOD);
    for (int task = blockIdx.x; task < 2 * 96; task += F.G) {
        const int l = task / 96, cb = task % 96, col = cb * 64 + F.lane;
        const float* wa = wada + (size_t)l * DM * NMODC + col;
        float acc[17];
#pragma unroll
        for (int r = 0; r < 17; ++r) acc[r] = 0.f;
        for (int k = F.wave * 128; k < F.wave * 128 + 128; ++k) { const float wv = wa[(size_t)k * NMODC];
#pragma unroll
            for (int r = 0; r < 17; ++r) acc[r] += sct[k * 20 + r] * wv; }
#pragma unroll
        for (int r = 0; r < 17; ++r) red[(F.wave * 17 + r) * 64 + F.lane] = acc[r];
        __syncthreads();
        for (int idx = F.tid; idx < 17 * 64; idx += 512) { const int r = idx >> 6, cl = idx & 63; float s = bada[l * NMODC + cb * 64 + cl];
#pragma unroll
            for (int w = 0; w < 8; ++w) s += red[(w * 17 + r) * 64 + cl];
            MOD[((size_t)l * 17 + r) * NMODC + cb * 64 + cl] = s; }
        __syncthreads();
    }
    if (blockIdx.x == 0) { float* rope = (float*)(ws + WS_ROPE); const int pos = F.tid >> 3, i = F.tid & 7;
        const float inv = exp2f(-(float)i * 0.125f * 13.287712379549449f);
        const float ang = (float)pos * inv; const float rev = ang * 0.15915494309189535f, fr = rev - floorf(rev); rope[pos * 8 + i] = __builtin_amdgcn_cosf(fr); rope[512 + pos * 8 + i] = __builtin_amdgcn_sinf(fr); }
}

__device__ __forceinline__ void load_row(const float* xrow, int lane, f32x4 (&v)[4]) {
#pragma unroll
    for (int j = 0; j < 4; ++j) v[j] = *((const f32x4*)xrow + lane + 64 * j);
}
__device__ __forceinline__ float row_rstd(const f32x4 (&v)[4]) {
    float s = 0.f;
#pragma unroll
    for (int j = 0; j < 4; ++j) s += (v[j][0] * v[j][0] + v[j][1] * v[j][1]) + (v[j][2] * v[j][2] + v[j][3] * v[j][3]);
    return rsqrtf(wave_sum(s) * (1.0f / DM) + RMS_EPS);
}
__device__ __forceinline__ void normmod(const f32x4 (&v)[4], float rstd, const float* g, const float* sh, const float* sc, int lane, f32x4 (&h)[4]) {
#pragma unroll
    for (int j = 0; j < 4; ++j) { const f32x4 gv = *((const f32x4*)g + lane + 64 * j), shv = *((const f32x4*)sh + lane + 64 * j), scv = *((const f32x4*)sc + lane + 64 * j);
        h[j] = v[j] * rstd * gv * (scv + 1.0f) + shv; }
}
__device__ __forceinline__ void store_row_bf16(bf16_t* orow, int lane, const f32x4 (&h)[4]) {
#pragma unroll
    for (int j = 0; j < 4; ++j) { u32x2 w; w.x = cvt_pk_bf16(h[j][0], h[j][1]); w.y = cvt_pk_bf16(h[j][2], h[j][3]); *((u32x2*)orow + lane + 64 * j) = w; }
}
__device__ __forceinline__ void p0_hrows(Frame& F) {
    unsigned char* const ws = ws_ptr(); const float* const xin = in_ptr<I_X>(); const float* const cxin = in_ptr<I_CTX>(); const float* const gmix = in_ptr<I_NMIXG>();
    const int gw = F.vcu * 8 + F.wave, NGW = F.G * 8; const float* MOD = (const float*)(ws + WS_MOD); bf16_t* H = (bf16_t*)(ws + WS_H);
    for (int t = gw; t < TALL; t += NGW) {
        const float* xr = (t < TX) ? xin + (size_t)t * DM : cxin + (size_t)(t - TX) * DM;
        const float* md = MOD + (size_t)((t < TX) ? (t >> 11) : 16) * NMODC;
        f32x4 v[4], h[4]; load_row(xr, F.lane, v); const float rstd = row_rstd(v);
        normmod(v, rstd, gmix, md, md + DM, F.lane, h); store_row_bf16(H + (size_t)t * DM, F.lane, h);
    }
}
__device__ __forceinline__ void stats_phase(Frame& F, int ntok) {
    unsigned char* const ws = ws_ptr();
    const int gw = F.vcu * 8 + F.wave, NGW = F.G * 8, lane = F.lane;
    const bf16_t* ZCQ = (const bf16_t*)(ws + WS_ZCQ); const bf16_t* ZCKV = (const bf16_t*)(ws + WS_ZCKV); const bf16_t* ZKR = (const bf16_t*)(ws + WS_ZKR);
    float* RSCQ = (float*)(ws + WS_RSCQ); float* RSCKV = (float*)(ws + WS_RSCKV); float* SSKR = (float*)(ws + WS_SSKR);
    for (int t = gw; t < ntok; t += NGW) {
        float a = 0.f, b = 0.f, c = 0.f;
        if (lane < 48) { const u32x4 w = *(const u32x4*)(ZCQ + (size_t)t * QLORA + 8 * lane); a = (bf_lo(w.x) * bf_lo(w.x) + bf_hi(w.x) * bf_hi(w.x)) + (bf_lo(w.y) * bf_lo(w.y) + bf_hi(w.y) * bf_hi(w.y)) + (bf_lo(w.z) * bf_lo(w.z) + bf_hi(w.z) * bf_hi(w.z)) + (bf_lo(w.w) * bf_lo(w.w) + bf_hi(w.w) * bf_hi(w.w)); }
        if (lane < 32) { const u32x4 w = *(const u32x4*)(ZCKV + (size_t)t * KVLORA + 8 * lane); b = (bf_lo(w.x) * bf_lo(w.x) + bf_hi(w.x) * bf_hi(w.x)) + (bf_lo(w.y) * bf_lo(w.y) + bf_hi(w.y) * bf_hi(w.y)) + (bf_lo(w.z) * bf_lo(w.z) + bf_hi(w.z) * bf_hi(w.z)) + (bf_lo(w.w) * bf_lo(w.w) + bf_hi(w.w) * bf_hi(w.w)); }
        if (lane < 4) { const u32x4 w = *(const u32x4*)(ZKR + (size_t)t * ROPED + 8 * lane); c = (bf_lo(w.x) * bf_lo(w.x) + bf_hi(w.x) * bf_hi(w.x)) + (bf_lo(w.y) * bf_lo(w.y) + bf_hi(w.y) * bf_hi(w.y)) + (bf_lo(w.z) * bf_lo(w.z) + bf_hi(w.z) * bf_hi(w.z)) + (bf_lo(w.w) * bf_lo(w.w) + bf_hi(w.w) * bf_hi(w.w)); }
        a = wave_sum(a); b = wave_sum(b); c = wave_sum(c);
        if (lane == 0) { RSCQ[t] = rsqrtf(a * (1.0f / QLORA) + RMS_EPS); RSCKV[t] = rsqrtf(b * (1.0f / KVLORA) + RMS_EPS); SSKR[t] = c; }
    }
}

__device__ __forceinline__ void route_phase(Frame& F, int l, int ntok) {
    unsigned char* const ws = ws_ptr(); const float* const xcur = out_ptr();
    LAS float* h2t = (LAS float*)F.lds;
    LAS float* part = (LAS float*)(F.lds + 65536);
    LAS float* logit = (LAS float*)(F.lds + 65536 + 32768);
    const float* MOD = (const float*)(ws + WS_MOD) + (size_t)l * 17 * NMODC; const float* XC = (const float*)(ws + WS_XC);
    const float* g = in_ptr<I_NFFNG>() + l * DM; const float* wr = in_ptr<I_WR>(); const float rbias = in_ptr<I_RB>()[F.lane];
    int* TOKE = (int*)(ws + WS_TOKE); float* TOKW = (float*)(ws + WS_TOKW); int* TOKP = (int*)(ws + WS_TOKP); float* RSTD2 = (float*)(ws + WS_RSTD2);
    unsigned* cnt = (unsigned*)(ws + WS_CTL) + CW_CNT + l * 2048;
    const int lane = F.lane, w = F.wave;
    float wv[128];
#pragma unroll
    for (int i = 0; i < 128; ++i) wv[i] = wr[(w * 128 + i) * NEXP + lane];
    for (int it = blockIdx.x; it < ntok / 16; it += F.G) {
        const int T0 = it * 16;
#pragma unroll
        for (int tt = 0; tt < 2; ++tt) { const int tl = 2 * w + tt, t = T0 + tl;
            const float* xr = (t < TX) ? xcur + (size_t)t * DM : XC + (size_t)(t - TX) * DM; const float* md = MOD + (size_t)((t < TX) ? (t >> 11) : 16) * NMODC;
            f32x4 v[4], h[4]; load_row(xr, lane, v); const float rstd = row_rstd(v); if (lane == 0) RSTD2[t] = rstd;
            normmod(v, rstd, g, md + 3 * DM, md + 4 * DM, lane, h);
#pragma unroll
            for (int j = 0; j < 4; ++j) *(LAS f32x4*)(h2t + tl * DM + 4 * lane + 256 * j) = h[j];
        }
        __syncthreads();
        { float acc[16];
#pragma unroll
          for (int t = 0; t < 16; ++t) acc[t] = 0.f;
#pragma unroll
          for (int gq = 0; gq < 32; ++gq) {
#pragma unroll
              for (int hf = 0; hf < 2; ++hf) {
                  f32x4 hv[8];
#pragma unroll
                  for (int t = 0; t < 8; ++t) hv[t] = *(const LAS f32x4*)(h2t + (8 * hf + t) * DM + w * 128 + 4 * gq);
#pragma unroll
                  for (int t = 0; t < 8; ++t)
#pragma unroll
                      for (int q = 0; q < 4; ++q) acc[8 * hf + t] += hv[t][q] * wv[4 * gq + q];
              }
          }
#pragma unroll
          for (int t = 0; t < 16; ++t) part[(w * 16 + t) * 64 + lane] = acc[t]; }
        __syncthreads();
#pragma unroll
        for (int k = 0; k < 2; ++k) { const int idx = F.tid + 512 * k, t = idx >> 6, e = idx & 63; float s = 0.f;
#pragma unroll
            for (int ww = 0; ww < 8; ++ww) s += part[(ww * 16 + t) * 64 + e];
            logit[t * 64 + e] = s; }
        __syncthreads();
#pragma unroll
        for (int tt = 0; tt < 2; ++tt) { const int tl = 2 * w + tt, t = T0 + tl;
            const float sg = 1.0f / (1.0f + expf(-logit[tl * 64 + lane])); const float bs = sg + rbias;
            float m1 = -3.0e38f, m2 = -3.0e38f; int i1 = 0, i2 = 0;
#pragma unroll
            for (int j = 0; j < 8; ++j) { const float vv = __shfl(bs, (lane & ~7) + j); if (vv > m1) { m2 = m1; i2 = i1; m1 = vv; i1 = j; } else if (vv > m2) { m2 = vv; i2 = j; } }
            const float gs = m1 + m2; float best = -3.0e38f; int gsel = 0;
#pragma unroll
            for (int j = 0; j < 8; ++j) { const float vv = __shfl(gs, 8 * j); if (vv > best) { best = vv; gsel = j; } }
            const int e1 = gsel * 8 + __shfl(i1, gsel * 8), e2 = gsel * 8 + __shfl(i2, gsel * 8);
            const float s1 = __shfl(sg, e1), s2 = __shfl(sg, e2), inv = 1.0f / (s1 + s2);
            if (lane == 0) { const int p1 = (int)atomicAdd(cnt + e1 * 16, 1u), p2 = (int)atomicAdd(cnt + e2 * 16, 1u);
                TOKE[2 * t] = e1; TOKE[2 * t + 1] = e2; TOKW[2 * t] = s1 * inv; TOKW[2 * t + 1] = s2 * inv; TOKP[2 * t] = p1; TOKP[2 * t + 1] = p2; }
        }
        __syncthreads();
    }
}
__device__ __forceinline__ void expert_offsets(Frame& F, unsigned char* ws, int l, LAS int* offl, bool publish) {
    if (F.wave == 0) {
        const unsigned c = __hip_atomic_load((unsigned*)(ws + WS_CTL) + CW_CNT + l * 2048 + F.lane * 16, RLX_AGENT);
        const int pad = (int)((c + 255u) & ~255u); int incl = pad;
#pragma unroll
        for (int o = 1; o < 64; o <<= 1) { const int v = __shfl_up(incl, o); if (F.lane >= o) incl += v; }
        offl[F.lane] = incl - pad; if (F.lane == 63) offl[64] = incl;
        if (publish) { int* TILEE = (int*)(ws + WS_TILEE); for (int t = (incl - pad) >> 8; t < (incl >> 8); ++t) TILEE[t] = F.lane; if (F.lane == 63) TILEE[511] = incl >> 8; }
    }
    __syncthreads();
}
__device__ __forceinline__ void scatter_phase(Frame& F, int l, int ntok, bool f8) {
    unsigned char* const ws = ws_ptr(); const float* const xcur = out_ptr();
    LAS int* offl = (LAS int*)(F.lds + 1024);
    expert_offsets(F, ws, l, offl, blockIdx.x == 0);
    const int gw = F.vcu * 8 + F.wave, NGW = F.G * 8, lane = F.lane;
    const float* MOD = (const float*)(ws + WS_MOD) + (size_t)l * 17 * NMODC; const float* XC = (const float*)(ws + WS_XC); const float* g = in_ptr<I_NFFNG>() + l * DM;
    const int* TOKE = (const int*)(ws + WS_TOKE); const int* TOKP = (const int*)(ws + WS_TOKP); const float* RSTD2 = (const float*)(ws + WS_RSTD2); bf16_t* HS = (bf16_t*)(ws + WS_HS);
    for (int t = gw; t < ntok; t += NGW) {
        const float* xr = (t < TX) ? xcur + (size_t)t * DM : XC + (size_t)(t - TX) * DM; const float* md = MOD + (size_t)((t < TX) ? (t >> 11) : 16) * NMODC;
        f32x4 v[4], h[4]; load_row(xr, lane, v); normmod(v, RSTD2[t], g, md + 3 * DM, md + 4 * DM, lane, h);
        const int s1 = offl[TOKE[2 * t]] + TOKP[2 * t], s2 = offl[TOKE[2 * t + 1]] + TOKP[2 * t + 1];
        if (f8) {
#pragma unroll
            for (int j = 0; j < 4; ++j) { const unsigned w = cvt_pk4_fp8(h[j][0] * F8_SH, h[j][1] * F8_SH, h[j][2] * F8_SH, h[j][3] * F8_SH);
                *((unsigned*)((unsigned char*)HS + (size_t)s1 * DM) + lane + 64 * j) = w; *((unsigned*)((unsigned char*)HS + (size_t)s2 * DM) + lane + 64 * j) = w; }
        } else { store_row_bf16(HS + (size_t)s1 * DM, lane, h); store_row_bf16(HS + (size_t)s2 * DM, lane, h); }
    }
}
__device__ __forceinline__ void combine_phase(Frame& F, int l, int ntok, bool last) {
    unsigned char* const ws = ws_ptr(); float* const xcur = out_ptr();
    LAS int* offl = (LAS int*)(F.lds + 1024);
    expert_offsets(F, ws, l, offl, false);
    const int gw = F.vcu * 8 + F.wave, NGW = F.G * 8, lane = F.lane;
    const float* MOD = (const float*)(ws + WS_MOD) + (size_t)l * 17 * NMODC; float* XC = (float*)(ws + WS_XC);
    const int* TOKE = (const int*)(ws + WS_TOKE); const int* TOKP = (const int*)(ws + WS_TOKP); const float* TOKW = (const float*)(ws + WS_TOKW);
    const bf16_t* YS = (const bf16_t*)(ws + WS_YS); bf16_t* H = (bf16_t*)(ws + WS_H);
    for (int t = gw; t < ntok; t += NGW) {
        float* xr = (t < TX) ? xcur + (size_t)t * DM : XC + (size_t)(t - TX) * DM; const int bi = (t < TX) ? (t >> 11) : 16; const float* md = MOD + (size_t)bi * NMODC;
        const int s1 = offl[TOKE[2 * t]] + TOKP[2 * t], s2 = offl[TOKE[2 * t + 1]] + TOKP[2 * t + 1]; const float w1 = TOKW[2 * t], w2 = TOKW[2 * t + 1];
        f32x4 v[4]; load_row(xr, lane, v);
#pragma unroll
        for (int j = 0; j < 4; ++j) { const u32x2 a = *((const u32x2*)(YS + (size_t)s1 * DM) + lane + 64 * j), b = *((const u32x2*)(YS + (size_t)s2 * DM) + lane + 64 * j);
            const f32x4 gf = *((const f32x4*)(md + 5 * DM) + lane + 64 * j);
            const f32x4 y = (f32x4){bf_lo(a.x), bf_hi(a.x), bf_lo(a.y), bf_hi(a.y)} * w1 + (f32x4){bf_lo(b.x), bf_hi(b.x), bf_lo(b.y), bf_hi(b.y)} * w2;
            v[j] = v[j] + gf * y; *((f32x4*)xr + lane + 64 * j) = v[j]; }
        if (!last) { const float* md2 = MOD + (size_t)17 * NMODC + (size_t)bi * NMODC; f32x4 h[4]; const float rstd = row_rstd(v);
            normmod(v, rstd, in_ptr<I_NMIXG>() + (l + 1) * DM, md2, md2 + DM, lane, h); store_row_bf16(H + (size_t)t * DM, lane, h); }
    }
}
constexpr int NPHASE = 2 + 11 * NLAYER;
struct Args { const float* in[26]; float* out; unsigned char* ws; int ph_lo, ph_hi; };

__device__ __attribute__((noinline)) void grid_barrier_fn(GAS unsigned* barw, unsigned x, LAS unsigned* st) { XcdBarrier b; b.bar = (unsigned*)barw; b.x = x; b.st = (volatile LAS unsigned*)st; xcd_barrier(b); }

__global__ void __launch_bounds__(512, 2) fwd_kernel(Args args) {
    extern __shared__ __attribute__((aligned(16))) unsigned char lds_raw[];
    Frame F;
    F.lds = (LAS unsigned char*)lds_raw;
    F.tid = threadIdx.x; F.lane = F.tid & 63; F.wave = __builtin_amdgcn_readfirstlane(F.tid >> 6);
    F.G = gridDim.x; { const int bx = blockIdx.x; F.vcu = (F.G % 8 == 0) ? (bx % 8) * (F.G / 8) + bx / 8 : bx; }
    volatile LAS unsigned* MISC = (volatile LAS unsigned*)(F.lds + MISC_OFF);
    if (F.tid < 64) MISC[F.tid] = 0u;
    __syncthreads();
    const int lo = args.ph_lo, hi = args.ph_hi;
#if MK_SPLIT
#define GRID_BAR() do { } while (0)
#else
    XcdBarrier bar = xcd_barrier_post((unsigned*)(ws_ptr() + WS_CTL) + CW_BAR, MISC + 8);
#define GRID_BAR() grid_barrier_fn((GAS unsigned*)bar.bar, bar.x, (LAS unsigned*)bar.st)
#endif
#ifndef PH_MASK
#define PH_MASK 0xFFFFFFFFu
#endif
#define PHK(k) ((k) < 2 ? (k) : 2 + ((k) - 2) % 11)
#define IN(k) (((PH_MASK >> PHK(k)) & 1u) && lo <= (k) && (k) < hi)
#ifndef PH_DUP
#define PH_DUP 0u
#endif
#define REP0(k) for (int rep_ = 0; rep_ < (((PH_DUP >> (k)) & 1u) ? 2 : 1); ++rep_)
#define REPL(n) for (int rep_ = 0; rep_ < ((((PH_DUP >> (2 + (n))) & 1u) && ((n) != 5 || l == 0)) ? 2 : 1); ++rep_)
#define SEAM(k) do { if (IN(k) && IN((k) + 1)) GRID_BAR(); } while (0)
#define FRESH() Frame Fp = F; int G = F.G, c = (int)blockIdx.x; asm volatile("" : "+v"(Fp.tid), "+v"(Fp.lane)); asm volatile("" : "+s"(Fp.wave), "+s"(Fp.vcu), "+s"(Fp.G), "+s"(G), "+s"(c))

    if (IN(0)) REP0(0) { FRESH(); (void)G; (void)c; p0_convert(Fp); __syncthreads(); p0_ada(Fp); }
    SEAM(0);
    if (IN(1)) REP0(1) { FRESH(); (void)G; (void)c; p0_hrows(Fp); }
    SEAM(1);

    for (int l = 0; l < NLAYER; ++l) {
        const int base = 2 + 11 * l; const bool last = (l == NLAYER - 1);
        const int mt_act = last ? MT_X : MT_ALL;
        const int ntok = last ? TX : TALL;
        if (IN(base + 0)) REPL(0) {
            FRESH(); unsigned char* const ws = ws_ptr();
            pg8::SchedRect S{(const char*)(ws + WS_H), (const char*)((bf16_t*)(ws + WS_WIN) + (size_t)l * INP * DM), (size_t)256 * DM * 2, mt_act, 17, G, c, MT_ALL - mt_act, 2, 7};
            pg8::EpiIn E{(bf16_t*)(ws + WS_QA), (bf16_t*)(ws + WS_KA), (bf16_t*)(ws + WS_VA), (bf16_t*)(ws + WS_ZCQ), (bf16_t*)(ws + WS_ZCKV), (bf16_t*)(ws + WS_ZKR), (bf16_t*)(ws + WS_GATES),
                         in_ptr<I_NAQG>() + l * 64, in_ptr<I_NAKG>() + l * 64};
            pg8::gemm_phase(Fp.lds, DM, S, E);
        }
        SEAM(base + 0);
        if (IN(base + 1)) REPL(1) { FRESH(); (void)G; (void)c; stats_phase(Fp, TALL); }
        SEAM(base + 1);
        if (IN(base + 2)) REPL(2) {
            FRESH();
#ifndef NO_EQ
            { unsigned char* const ws = ws_ptr();
              pg8::SchedRect S{(const char*)(ws + WS_ZCQ), (const char*)((bf16_t*)(ws + WS_WUQ) + (size_t)l * 1024 * QLORA), (size_t)256 * QLORA * 2, mt_act, 4, G, c, 0, 0, 1};
              pg8::EpiQ E{(bf16_t*)(ws + WS_QB), (const float*)(ws + WS_RSCQ), in_ptr<I_QG>() + l * QKD, (const float*)(ws + WS_ROPE), (LAS float*)(Fp.lds + EPI_OFF)};
              pg8::gemm_phase(Fp.lds, QLORA, S, E); }
#endif
#ifndef NO_EKV
            { unsigned char* const ws = ws_ptr();
              pg8::SchedRect S{(const char*)(ws + WS_ZCKV), (const char*)((bf16_t*)(ws + WS_WUKV) + (size_t)l * 1024 * KVLORA), (size_t)256 * KVLORA * 2, MT_ALL, 4, G, c, 0, 0, 1};
              pg8::EpiKV E{(bf16_t*)(ws + WS_KB), (bf16_t*)(ws + WS_VB), (const bf16_t*)(ws + WS_ZKR), (const float*)(ws + WS_RSCKV), (const float*)(ws + WS_SSKR), in_ptr<I_KG>() + l * QKD, (const float*)(ws + WS_ROPE), (LAS float*)(Fp.lds + EPI_OFF)};
              pg8::gemm_phase(Fp.lds, KVLORA, S, E); }
#endif
        }
        SEAM(base + 2);
        if (IN(base + 3)) REPL(3) {
            FRESH(); (void)c;
            const float C64 = 0.125f * 1.4426950408889634f, C96 = 0.10206207261596575f * 1.4426950408889634f;
            for (int r2_ = 0; r2_ < (((PH_DUP >> 20) & 1u) ? 2 : 1); ++r2_)
            { unsigned char* const ws = ws_ptr();
              for (int u = Fp.vcu; u < 1024 + 256; u += G) {
                att::UnitArgs A; A.Q = (const bf16_t*)(ws + WS_QB); A.ldq = 768; A.K = (const bf16_t*)(ws + WS_KB); A.ldk = 768; A.V = (const bf16_t*)(ws + WS_VB); A.O = (bf16_t*)(ws + WS_OB);
                A.masked = 0; A.band = 0; A.krow0 = 0; A.bias = nullptr; A.C = C96;
                if (u < 1024) { const int bh = u >> 3, qb = u & 7, b = bh >> 3, h = bh & 7;
                    A.qcol = h * QKD; A.kcol = h * QKD; A.vcol = h * 64; A.ocol = h * 64; A.q0 = b * SEQ + qb * 256; A.ctx0 = TX + b * CTXL; A.loc0 = b * SEQ; A.NT = 36; }
                else { const int v = u - 1024; if (last || !(v & 1)) continue; const int bh = v >> 1, b = bh >> 3, h = bh & 7;
                    A.qcol = h * QKD; A.kcol = h * QKD; A.vcol = h * 64; A.ocol = h * 64; A.q0 = TX + b * CTXL; A.ctx0 = TX + b * CTXL; A.loc0 = 0; A.NT = 4; }
                att::attn_unit<96>(A, (char*)lds_raw);
              } }
            for (int r3_ = 0; r3_ < (((PH_DUP >> 21) & 1u) ? 2 : 1); ++r3_)
            { unsigned char* const ws = ws_ptr(); const float* const rpb = in_ptr<I_RPB>();
              att::na_mask_table((char*)lds_raw);
              for (int u = Fp.vcu; u < 1024 + 256; u += G) {
                att::UnitArgs A; A.Q = (const bf16_t*)(ws + WS_QA); A.ldq = 512; A.K = (const bf16_t*)(ws + WS_KA); A.ldk = 512; A.V = (const bf16_t*)(ws + WS_VA); A.O = (bf16_t*)(ws + WS_OA); A.C = C64;
                if (u < 1024) { const int bh = u >> 3, band = u & 7, b = bh >> 3, h = bh & 7;
                    A.qcol = h * 64; A.kcol = h * 64; A.vcol = h * 64; A.ocol = h * 64; A.q0 = b * SEQ + band * 256; A.ctx0 = TX + b * CTXL;
                    A.krow0 = min(max(4 * band - 4, 0), 20); A.loc0 = b * SEQ + 64 * A.krow0; A.NT = 10; A.masked = 1; A.band = band; A.bias = rpb + ((size_t)l * NHEAD + h) * 15 * 31; }
                else { const int v = u - 1024; if (last || (v & 1)) continue; const int bh = v >> 1, b = bh >> 3, h = bh & 7;
                    A.qcol = h * 64; A.kcol = h * 64; A.vcol = h * 64; A.ocol = h * 64; A.q0 = TX + b * CTXL; A.ctx0 = TX + b * CTXL; A.loc0 = 0; A.NT = 4; A.masked = 0; A.band = 0; A.krow0 = 0; A.bias = nullptr; }
                att::attn_unit<64>(A, (char*)lds_raw);
              } }
        }
        SEAM(base + 3);
        if (IN(base + 4)) REPL(4) {
            FRESH(); unsigned char* const ws = ws_ptr();
            pg8::SchedMerge S{(const char*)(ws + WS_OA), (const char*)(ws + WS_OB), (const char*)((bf16_t*)(ws + WS_WOA) + (size_t)l * 1024 * 512), (const char*)((bf16_t*)(ws + WS_WOB) + (size_t)l * 1024 * 512),
                              (size_t)256 * 512 * 2, mt_act, 4, G, c};
            pg8::EpiMerge E{(const bf16_t*)(ws + WS_GATES), (bf16_t*)(ws + WS_Y)};
            pg8::gemm_phase(Fp.lds, 512, S, E);
        }
        SEAM(base + 4);
        if (IN(base + 5)) REPL(5) {
            FRESH(); unsigned char* const ws = ws_ptr(); float* const outp = out_ptr();
            pg8::SchedRect S{(const char*)(ws + WS_Y), (const char*)((bf16_t*)(ws + WS_WOUT) + (size_t)l * DM * DM), (size_t)256 * DM * 2, mt_act, 4, G, c, 0, 0, 1};
            pg8::EpiOut E{(l == 0) ? in_ptr<I_X>() : (const float*)outp, outp, in_ptr<I_CTX>(), (float*)(ws + WS_XC), (const float*)(ws + WS_MOD) + (size_t)l * 17 * NMODC, 2 * DM};
            pg8::gemm_phase(Fp.lds, DM, S, E);
        }
        SEAM(base + 5);
        if (IN(base + 6)) REPL(6) { FRESH(); (void)G; (void)c; route_phase(Fp, l, ntok); }
        SEAM(base + 6);
        if (IN(base + 7)) REPL(7) { FRESH(); (void)G; (void)c; scatter_phase(Fp, l, ntok, last); }
        SEAM(base + 7);
        if (IN(base + 8)) REPL(8) {
            FRESH(); unsigned char* const ws = ws_ptr();
            LAS int* const tle = (LAS int*)(Fp.lds + EPI_OFF + 16384); tle[Fp.tid] = ld_i32_agent((const int*)(ws + WS_TILEE) + Fp.tid); __syncthreads();
            const int ntile = __builtin_amdgcn_readfirstlane(tle[511]);
            const char* const w13 = (const char*)((bf16_t*)(ws + WS_W13) + (size_t)l * NEXP * 2048 * DM);
#ifdef ONLY_BF16
            if (false) {} else
#endif
#ifdef ONLY_F8
            if (true)
#else
            if (last)
#endif
            { pg8::SchedMoe S{(const char*)(ws + WS_HS), w13, (size_t)256 * DM, (size_t)2048 * DM, (size_t)256 * DM, tle, ntile, 8, G, c};
                pg8::EpiMoe1<true> E{(bf16_t*)(ws + WS_HMID), 1.0f / (F8_SH * F8_SW)};
                pg8::gemm_phase<true>(Fp.lds, DM / 2, S, E); }
            else { pg8::SchedMoe S{(const char*)(ws + WS_HS), w13, (size_t)256 * DM * 2, (size_t)2048 * DM * 2, (size_t)256 * DM * 2, tle, ntile, 8, G, c};
                pg8::EpiMoe1<false> E{(bf16_t*)(ws + WS_HMID), 1.0f};
                pg8::gemm_phase(Fp.lds, DM, S, E); }
        }
        SEAM(base + 8);
        if (IN(base + 9)) REPL(9) {
            FRESH(); unsigned char* const ws = ws_ptr();
            LAS int* const tle = (LAS int*)(Fp.lds + EPI_OFF + 16384); tle[Fp.tid] = ld_i32_agent((const int*)(ws + WS_TILEE) + Fp.tid); __syncthreads();
            const int ntile = __builtin_amdgcn_readfirstlane(tle[511]);
            const char* const w2 = (const char*)((bf16_t*)(ws + WS_W2) + (size_t)l * NEXP * DM * DM);
            if (last) { pg8::SchedMoe S{(const char*)(ws + WS_HMID), w2, (size_t)256 * DM, (size_t)DM * DM, (size_t)256 * DM, tle, ntile, 4, G, c};
                pg8::EpiMoe2 E{(bf16_t*)(ws + WS_YS), 1.0f / (F8_SM * F8_SW)};
                pg8::gemm_phase<true>(Fp.lds, DM / 2, S, E); }
            else { pg8::SchedMoe S{(const char*)(ws + WS_HMID), w2, (size_t)256 * DM * 2, (size_t)DM * DM * 2, (size_t)256 * DM * 2, tle, ntile, 4, G, c};
                pg8::EpiMoe2 E{(bf16_t*)(ws + WS_YS), 1.0f};
                pg8::gemm_phase(Fp.lds, DM, S, E); }
        }
        SEAM(base + 9);
        if (IN(base + 10)) REPL(10) { FRESH(); (void)G; (void)c; combine_phase(Fp, l, ntok, last); }
        if (!last) SEAM(base + 10);
    }
#undef IN
#undef SEAM
#undef GRID_BAR
}

extern "C" void kernel_launch(void* const* d_in, const int* in_sizes, int n_in, void* d_out, int out_size, void* d_ws, size_t ws_size, hipStream_t stream) {
    static int grid = 0;
    if (grid == 0) {
        if (n_in != 26 || out_size != TX * DM || ws_size < WS_END) { fprintf(stderr, "kernel_launch: unexpected problem (n_in %d, out %d, ws %zu < %zu); nothing launched\n", n_in, out_size, ws_size, (size_t)WS_END); grid = -1; return; }
        int dev = 0, cus = 0, per_cu = 0;
        if (hipGetDevice(&dev) != hipSuccess || hipDeviceGetAttribute(&cus, hipDeviceAttributeMultiprocessorCount, dev) != hipSuccess) { grid = -1; return; }
        if (hipFuncSetAttribute((const void*)fwd_kernel, hipFuncAttributeMaxDynamicSharedMemorySize, LDS_BYTES) != hipSuccess) { fprintf(stderr, "kernel_launch: hipFuncSetAttribute failed\n"); grid = -1; return; }
        if (hipOccupancyMaxActiveBlocksPerMultiprocessor(&per_cu, (const void*)fwd_kernel, 512, LDS_BYTES) != hipSuccess || per_cu < 1) fprintf(stderr, "kernel_launch: occupancy query reports %d blocks per CU\n", per_cu);
        (void)hipGetLastError();
        grid = cus;
    }
    if (grid < 0) return;
    (void)in_sizes;
    (void)hipMemsetAsync((char*)d_ws + WS_CTL, 0, CTL_BYTES, stream);
    Args a{};
    for (int i = 0; i < 26; ++i) a.in[i] = (const float*)d_in[i];
    a.out = (float*)d_out; a.ws = (unsigned char*)d_ws;
#if MK_SPLIT
    for (int p = 0; p < NPHASE; ++p) { a.ph_lo = p; a.ph_hi = p + 1; hipLaunchKernelGGL(fwd_kernel, dim3(grid), dim3(512), LDS_BYTES, stream, a); }
#else
    a.ph_lo = 0; a.ph_hi = NPHASE;
    hipLaunchKernelGGL(fwd_kernel, dim3(grid), dim3(512), LDS_BYTES, stream, a);
#endif
    const hipError_t le = hipPeekAtLastError();
    if (le != hipSuccess) fprintf(stderr, "kernel_launch: launch failed: %s\n", hipGetErrorName(le));
}
```

```cpp
#include <hip/hip_runtime.h>
#include <hip/hip_bf16.h>
#include <cstdio>
#include <cstdint>

#ifndef MK_SPLIT
#define MK_SPLIT 0
#endif

#define LAS __attribute__((address_space(3)))
#define GAS __attribute__((address_space(1)))
typedef unsigned short bf16_t;
typedef short bf16x8 __attribute__((ext_vector_type(8)));
typedef short s16x4 __attribute__((ext_vector_type(4)));
typedef float f32x4 __attribute__((ext_vector_type(4)));
typedef float f32x2 __attribute__((ext_vector_type(2)));
typedef float f32x16 __attribute__((ext_vector_type(16)));
typedef unsigned u32x4 __attribute__((ext_vector_type(4)));
typedef unsigned u32x2 __attribute__((ext_vector_type(2)));
#define RLX_AGENT __ATOMIC_RELAXED, __HIP_MEMORY_SCOPE_AGENT

constexpr int DM = 1024, NB = 16, SEQ = 2048, TX = NB * SEQ, CTXL = 256, TC = NB * CTXL, TALL = TX + TC;
constexpr int NHEAD = 8, GRIDW = 64;
constexpr int INC = 4256, INP = 4352;
constexpr int NEXP = 64, NMODC = 6 * DM;
constexpr int QLORA = 384, KVLORA = 256, QKD = 96, ROPED = 32;
constexpr int MT_X = TX / 256, MT_ALL = TALL / 256;
constexpr int NSLOT_MAX = 2 * TALL + NEXP * 256;
constexpr float RMS_EPS = 1e-6f;
constexpr int NLAYER = 2;
constexpr float F8_SW = 64.f, F8_SH = 16.f, F8_SM = 4.f;

constexpr size_t al256(size_t x) { return (x + 255) & ~(size_t)255; }
constexpr size_t WS_CTL = 0, CTL_BYTES = 1u << 20;
constexpr size_t WS_MOD   = WS_CTL + CTL_BYTES;
constexpr size_t WS_ROPE  = WS_MOD + al256((size_t)NLAYER * 17 * NMODC * 4);
constexpr size_t WS_RSCQ  = WS_ROPE + al256(64 * 8 * 2 * 4);
constexpr size_t WS_RSCKV = WS_RSCQ + al256((size_t)TALL * 4);
constexpr size_t WS_SSKR  = WS_RSCKV + al256((size_t)TALL * 4);
constexpr size_t WS_TOKE  = WS_SSKR + al256((size_t)TALL * 4);
constexpr size_t WS_TOKW  = WS_TOKE + al256((size_t)TALL * 8);
constexpr size_t WS_TOKP  = WS_TOKW + al256((size_t)TALL * 8);
constexpr size_t WS_RSTD2 = WS_TOKP + al256((size_t)TALL * 8);
constexpr size_t WS_TILEE = WS_RSTD2 + al256((size_t)TALL * 4);
constexpr size_t WS_OFFS  = WS_TILEE + al256(512 * 4);
constexpr size_t WS_WIN   = WS_OFFS + al256(128 * 4);
constexpr size_t WS_WUQ   = WS_WIN + al256((size_t)NLAYER * INP * DM * 2);
constexpr size_t WS_WUKV  = WS_WUQ + al256((size_t)NLAYER * 1024 * QLORA * 2);
constexpr size_t WS_WOA   = WS_WUKV + al256((size_t)NLAYER * 1024 * KVLORA * 2);
constexpr size_t WS_WOB   = WS_WOA + al256((size_t)NLAYER * 1024 * 512 * 2);
constexpr size_t WS_WOUT  = WS_WOB + al256((size_t)NLAYER * 1024 * 512 * 2);
constexpr size_t WS_W13   = WS_WOUT + al256((size_t)NLAYER * 1024 * 1024 * 2);
constexpr size_t WS_W2    = WS_W13 + al256((size_t)NLAYER * NEXP * 2048 * 1024 * 2);
constexpr size_t WS_H     = WS_W2 + al256((size_t)NLAYER * NEXP * 1024 * 1024 * 2);
constexpr size_t WS_XC    = WS_H + al256((size_t)TALL * DM * 2);
constexpr size_t WS_ACT   = WS_XC + al256((size_t)TC * DM * 4);
constexpr size_t WS_QA    = WS_ACT;
constexpr size_t WS_KA    = WS_QA + al256((size_t)TALL * 512 * 2);
constexpr size_t WS_VA    = WS_KA + al256((size_t)TALL * 512 * 2);
constexpr size_t WS_ZCQ   = WS_VA + al256((size_t)TALL * 512 * 2);
constexpr size_t WS_ZCKV  = WS_ZCQ + al256((size_t)TALL * QLORA * 2);
constexpr size_t WS_ZKR   = WS_ZCKV + al256((size_t)TALL * KVLORA * 2);
constexpr size_t WS_GATES = WS_ZKR + al256((size_t)TALL * ROPED * 2);
constexpr size_t WS_QB    = WS_GATES + al256((size_t)TALL * 2048 * 2);
constexpr size_t WS_KB    = WS_QB + al256((size_t)TALL * 768 * 2);
constexpr size_t WS_VB    = WS_KB + al256((size_t)TALL * 768 * 2);
constexpr size_t WS_OA    = WS_VB + al256((size_t)TALL * 512 * 2);
constexpr size_t WS_OB    = WS_OA + al256((size_t)TALL * 512 * 2);
constexpr size_t WS_Y     = WS_OB + al256((size_t)TALL * 512 * 2);
constexpr size_t WS_MIX_END = WS_Y + al256((size_t)TALL * DM * 2);
constexpr size_t WS_HS    = WS_ACT;
constexpr size_t WS_HMID  = WS_HS + al256((size_t)NSLOT_MAX * DM * 2);
constexpr size_t WS_YS    = WS_HMID + al256((size_t)NSLOT_MAX * DM * 2);
constexpr size_t WS_MOE_END = WS_YS + al256((size_t)NSLOT_MAX * DM * 2);
constexpr size_t WS_END   = (WS_MIX_END > WS_MOE_END) ? WS_MIX_END : WS_MOE_END;

constexpr int CW_BAR = 4096;
constexpr int CW_CNT = 16384;

constexpr int RING_BYTES = 131072;
constexpr int EPI_OFF = RING_BYTES;
constexpr int MISC_OFF = RING_BYTES + 24576;
constexpr int LDS_BYTES = 160 * 1024;

__device__ __forceinline__ unsigned cvt_pk_bf16(float lo, float hi) { unsigned r; asm volatile("v_cvt_pk_bf16_f32 %0, %1, %2" : "=v"(r) : "v"(lo), "v"(hi)); return r; }
__device__ __forceinline__ unsigned cvt_pk4_fp8(float a, float b, float c, float d) {
    a = __builtin_amdgcn_fmed3f(a, -448.f, 448.f); b = __builtin_amdgcn_fmed3f(b, -448.f, 448.f); c = __builtin_amdgcn_fmed3f(c, -448.f, 448.f); d = __builtin_amdgcn_fmed3f(d, -448.f, 448.f);
    int w = 0; w = __builtin_amdgcn_cvt_pk_fp8_f32(a, b, w, false); w = __builtin_amdgcn_cvt_pk_fp8_f32(c, d, w, true); return (unsigned)w; }
__device__ __forceinline__ float bf_lo(unsigned w) { return __uint_as_float(w << 16); }
__device__ __forceinline__ float bf_hi(unsigned w) { return __uint_as_float(w & 0xffff0000u); }
__device__ __forceinline__ float wave_sum(float v) {
#pragma unroll
    for (int o = 1; o < 64; o <<= 1) v += __shfl_xor(v, o);
    return v;
}
__device__ __forceinline__ float sigmoidf_(float x) { return __builtin_amdgcn_rcpf(1.0f + __expf(-x)); }
__device__ __forceinline__ int ld_i32_agent(const int* p) { return (int)__hip_atomic_load((const unsigned*)p, RLX_AGENT); }
#define XB_TMO      128
#define XB_XCNT(j)  (256  + 64 * (j))
#define XB_XSUB(j)  (1280 + 64 * (j))
#define XB_XGEN(j)  (2304 + 64 * (j))
#define XB_TOP      3328
#define XB_TOPGEN   3392
#define XCD_BAR_WORDS 3456
#define XB_SPIN_CAP (1u << 18)

__device__ __forceinline__ unsigned xb_ld(unsigned* p)              { return __hip_atomic_load(p, __ATOMIC_RELAXED, __HIP_MEMORY_SCOPE_AGENT); }
__device__ __forceinline__ unsigned xb_add(unsigned* p, unsigned v) { return __hip_atomic_fetch_add(p, v, __ATOMIC_RELAXED, __HIP_MEMORY_SCOPE_AGENT); }
__device__ __forceinline__ unsigned xb_xcc_id() { return (unsigned)__builtin_amdgcn_s_getreg((3 << 11) | 20) & 0xFu; }
#define XB_SPIN(cond, bar) do { unsigned _sp = 0; while (cond) { __builtin_amdgcn_s_sleep(1); \
    if ((++_sp & 255u) == 0u) { if (xb_ld(&(bar)[XB_TMO])) break; if (_sp > XB_SPIN_CAP) { atomicAdd(&(bar)[XB_TMO], 1u); break; } } } } while (0)

struct XcdBarrier {
    unsigned* bar; unsigned x;
    volatile LAS unsigned* st;
};

__device__ __forceinline__ XcdBarrier xcd_barrier_post(unsigned* bar, volatile LAS unsigned* st) {
    XcdBarrier b; b.bar = bar; b.x = xb_xcc_id(); b.st = st;
    if (threadIdx.x == 0) (void)xb_add(&bar[XB_XCNT(b.x)], 1u);
    return b;
}
__device__ __forceinline__ void xcd_barrier_complete(unsigned* bar, unsigned x, unsigned& nloc, unsigned& nx) {
    const unsigned G = gridDim.x * gridDim.y * gridDim.z;
    unsigned sum, cnt, mine, sp = 0u;
    for (;;) {
        sum = 0u; cnt = 0u; mine = 0u;
#pragma unroll
        for (unsigned j = 0; j < 16; ++j) { const unsigned c = xb_ld(&bar[XB_XCNT(j)]); sum += c; cnt += (c > 0u) ? 1u : 0u; mine = (j == x) ? c : mine; }
        if (sum == G) break;
        __builtin_amdgcn_s_sleep(1);
        if ((++sp & 255u) == 0u) { if (xb_ld(&bar[XB_TMO])) break; if (sp > XB_SPIN_CAP) { atomicAdd(&bar[XB_TMO], 1u); break; } }
    }
    nloc = mine > 0u ? mine : 1u; nx = cnt > 0u ? cnt : 1u;
}

__device__ __forceinline__ void xcd_barrier(const XcdBarrier& b) {
    asm volatile("s_waitcnt vmcnt(0)" ::: "memory");
    __syncthreads();
    if (threadIdx.x == 0) {
        unsigned* bar = b.bar;
        __builtin_amdgcn_s_waitcnt(0);
        unsigned nloc = b.st[0], nx = b.st[1];
        if (nloc == 0u) { xcd_barrier_complete(bar, b.x, nloc, nx); b.st[0] = nloc; b.st[1] = nx; }
        const unsigned old = xb_add(&bar[XB_XSUB(b.x)], 1u);
        const unsigned gen = old / nloc;
        if (old + 1u == (gen + 1u) * nloc) {
            __builtin_amdgcn_fence(__ATOMIC_RELEASE, "agent");
            asm volatile("s_waitcnt vmcnt(0)" ::: "memory");
            const unsigned og = xb_add(&bar[XB_TOP], 1u);
            const unsigned tg = og / nx;
            if (og + 1u == (tg + 1u) * nx) xb_add(&bar[XB_TOPGEN], 1u);
            else XB_SPIN(xb_ld(&bar[XB_TOPGEN]) == tg, bar);
            __builtin_amdgcn_fence(__ATOMIC_ACQUIRE, "agent");
            xb_add(&bar[XB_XGEN(b.x)], 1u);
            asm volatile("s_waitcnt vmcnt(0)" ::: "memory");
        } else {
            XB_SPIN(xb_ld(&bar[XB_XGEN(b.x)]) == gen, bar);
            __builtin_amdgcn_fence(__ATOMIC_ACQUIRE, "agent");
            asm volatile("s_waitcnt vmcnt(0)" ::: "memory");
        }
    }
    __syncthreads();
}

namespace pg8 {
constexpr int BM = 256, BK = 64, HALF = 128, HTB = HALF * BK * 2  , STAGE_BYTES = 8 * HTB, NXCD = 8, WGM = 8;
__host__ __device__ __forceinline__ int lds_byte(int r, int c) { const int st = (r >> 4) * 2 + (c >> 5), rr = r & 15, cc = c & 31, ob = rr * 64 + cc * 2; return st * 1024 + (ob ^ (((ob >> 9) & 1) << 5)); }
__host__ __device__ __forceinline__ void stage_rc(int b, int& R, int& C) { const int st = b / 1024, sb = b % 1024, swz = sb ^ (((sb >> 9) & 1) << 5); R = (st >> 1) * 16 + swz / 64; C = (st & 1) * 32 + (swz % 64) / 2; }
__host__ __device__ __forceinline__ int perm32(int rho) { const int n = rho >> 4, i = rho & 15; return 8 * (i >> 2) + 4 * n + (i & 3); }

struct Unit { int pm, pn, kind, e; };

__device__ __forceinline__ void rect_tile(int wgid_in, int nM, int nN, int& pm, int& pn) {
    const int nwg = nM * nN; int wgid = wgid_in;
    { const int q = nwg / NXCD, r = nwg % NXCD, xcd = wgid % NXCD, off = wgid / NXCD; wgid = (xcd < r ? xcd * (q + 1) : r * (q + 1) + (xcd - r) * q) + off; }
    const int nig = WGM * nN, gid = wgid / nig, fm = gid * WGM, gsz = (nM - fm) < WGM ? (nM - fm) : WGM;
    pm = fm + ((wgid % nig) % gsz); pn = (wgid % nig) / gsz;
}

typedef int i32x8 __attribute__((ext_vector_type(8)));
template <bool F8 = false, class Epi, class Sched>
__device__ __forceinline__ void gemm_phase(LAS unsigned char* lds, const int K, const Sched& S, const Epi& E) {
    int tid = threadIdx.x; asm volatile("" : "+v"(tid));
    const int wid = __builtin_amdgcn_readfirstlane(tid >> 6), lane = tid & 63, wr = wid >> 2, wc = wid & 3, fr = lane & 15, fq = lane >> 4;
    const int nt = K / BK;
    unsigned voffA[2], voffB[2];
#pragma unroll
    for (int i = 0; i < 2; ++i) { int R, C; stage_rc(tid * 16 + i * 8192, R, C); const int Rb = Epi::PERM ? ((R & ~31) + perm32(R & 31)) : R;
        voffA[i] = (unsigned)(R * K + C) * 2u; voffB[i] = (unsigned)(Rb * K + C) * 2u; }
    const size_t kstep = (size_t)(BK * 2);
    const size_t hstep = (size_t)HALF * K * 2;
    const unsigned ldsw = (unsigned)wid * 1024u;
    const int aoff = lds_byte(wr * 64 + fr, F8 ? fq * 16 : fq * 8), boff = lds_byte(wc * 32 + fr, F8 ? fq * 16 : fq * 8);
    constexpr int KSTEP = F8 ? 16 : 1024;
    int f8scale = 0x7F7F7F7F; asm volatile("" : "+v"(f8scale));
#define PG8_SA(b, h) (((b) * 2 + (h)) * HTB)
#define PG8_SB(b, h) ((4 + (b) * 2 + (h)) * HTB)
#define PG8_STAGE(bufoff, gbase, voff) do { _Pragma("unroll") for (int _i = 0; _i < 2; ++_i) \
        __builtin_amdgcn_global_load_lds((const unsigned*)((const char*)(gbase) + (voff)[_i]), (LAS unsigned*)(lds + (bufoff) + ldsw + _i * 8192), 16, 0, 0); } while (0)
#define PG8_LDA(dst, b, h) do { _Pragma("unroll") for (int m = 0; m < 4; ++m) _Pragma("unroll") for (int k = 0; k < 2; ++k) dst[m][k] = *(const LAS bf16x8*)(lds + PG8_SA(b, h) + aoff + m * 2048 + k * KSTEP); } while (0)
#define PG8_LDB(dst, b, h) do { _Pragma("unroll") for (int n = 0; n < 2; ++n) _Pragma("unroll") for (int k = 0; k < 2; ++k) dst[n][k] = *(const LAS bf16x8*)(lds + PG8_SB(b, h) + boff + n * 2048 + k * KSTEP); } while (0)
#define PG8_CAT(X) __builtin_shufflevector(__builtin_bit_cast(u32x4, (X)[0]), __builtin_bit_cast(u32x4, (X)[1]), 0, 1, 2, 3, 4, 5, 6, 7)
#define PG8_MMA(ai, bj, At, Bt) do { __builtin_amdgcn_s_setprio(1); \
        if constexpr (F8) { _Pragma("unroll") for (int m = 0; m < 4; ++m) _Pragma("unroll") for (int n = 0; n < 2; ++n) \
            asm volatile("v_mfma_scale_f32_16x16x128_f8f6f4 %0, %1, %2, %0, %3, %3 op_sel_hi:[0,0,0]" : "+v"(acc[ai][bj][m][n]) : "v"(__builtin_bit_cast(i32x8, PG8_CAT(Bt[n]))), "v"(__builtin_bit_cast(i32x8, PG8_CAT(At[m]))), "v"(f8scale)); } \
        else { _Pragma("unroll") for (int m = 0; m < 4; ++m) _Pragma("unroll") for (int n = 0; n < 2; ++n) _Pragma("unroll") for (int k = 0; k < 2; ++k) \
            acc[ai][bj][m][n] = __builtin_amdgcn_mfma_f32_16x16x32_bf16(Bt[n][k], At[m][k], acc[ai][bj][m][n], 0, 0, 0); } \
        __builtin_amdgcn_s_setprio(0); } while (0)
#define PG8_WAIT_V(n) asm volatile("s_waitcnt vmcnt(" #n ")" ::: "memory")
#define PG8_WAIT_L(n) asm volatile("s_waitcnt lgkmcnt(" #n ")" ::: "memory")
#define PG8_BAR __builtin_amdgcn_s_barrier()
#define PG8_SCHED __builtin_amdgcn_sched_barrier(0)
    Unit cur, nxt; int ui = 0;
    if (!S.next(0, cur)) return;
    f32x4 acc[2][2][4][2];
#pragma unroll
    for (int a = 0; a < 2; ++a)
#pragma unroll
        for (int b = 0; b < 2; ++b)
#pragma unroll
            for (int m = 0; m < 4; ++m)
#pragma unroll
                for (int n = 0; n < 2; ++n) acc[a][b][m][n] = (f32x4){0.f, 0.f, 0.f, 0.f};
    bf16x8 At[4][2], B0[2][2], B1[2][2];
    const char* cA = S.a_ptr(cur); const char* cB = S.b_ptr(cur);
    PG8_STAGE(PG8_SB(0, 0), cB, voffB); PG8_STAGE(PG8_SB(0, 1), cB + hstep, voffB); PG8_STAGE(PG8_SA(0, 0), cA, voffA); PG8_STAGE(PG8_SA(0, 1), cA + hstep, voffA);
    if (wr == 1) PG8_BAR;
    PG8_WAIT_V(2); PG8_BAR;
    PG8_STAGE(PG8_SB(1, 0), cB + kstep, voffB); PG8_STAGE(PG8_SA(1, 0), cA + kstep, voffA); PG8_STAGE(PG8_SB(1, 1), cB + hstep + kstep, voffB);
    PG8_WAIT_V(6); PG8_BAR;
    for (;;) {
        const bool has_next = S.next(ui + 1, nxt);
        const char* nA = has_next ? S.a_ptr(nxt) : cA; const char* nB = has_next ? S.b_ptr(nxt) : cB;
#pragma unroll 1
        for (int t = 0; t < nt; t += 2) {
            const bool last = (t == nt - 2);
            const char* a1 = cA + (size_t)(t + 1) * kstep;
            const char* a2 = last ? nA : cA + (size_t)(t + 2) * kstep; const char* b2 = last ? nB : cB + (size_t)(t + 2) * kstep;
            const char* a3 = a2 + kstep; const char* b3 = b2 + kstep;
            PG8_LDB(B0, 0, 0); PG8_LDB(B1, 0, 1); PG8_SCHED; PG8_LDA(At, 0, 0); PG8_STAGE(PG8_SA(1, 1), a1 + hstep, voffA);
            PG8_WAIT_V(8); PG8_WAIT_L(0); PG8_BAR; PG8_MMA(0, 0, At, B0); PG8_MMA(0, 1, At, B1); PG8_BAR; PG8_SCHED;
            PG8_LDA(At, 0, 1); PG8_STAGE(PG8_SB(0, 0), b2, voffB); PG8_STAGE(PG8_SB(0, 1), b2 + hstep, voffB); PG8_STAGE(PG8_SA(0, 0), a2, voffA);
            PG8_WAIT_V(8); PG8_WAIT_L(0); PG8_BAR; PG8_MMA(1, 0, At, B0); PG8_MMA(1, 1, At, B1); PG8_BAR; PG8_SCHED;
            PG8_LDB(B0, 1, 0); PG8_LDB(B1, 1, 1); PG8_SCHED; PG8_LDA(At, 1, 0); PG8_STAGE(PG8_SA(0, 1), a2 + hstep, voffA);
            PG8_WAIT_V(8); PG8_WAIT_L(0); PG8_BAR; PG8_MMA(0, 0, At, B0); PG8_MMA(0, 1, At, B1); PG8_BAR; PG8_SCHED;
            PG8_LDA(At, 1, 1); PG8_STAGE(PG8_SB(1, 0), b3, voffB); PG8_STAGE(PG8_SB(1, 1), b3 + hstep, voffB); PG8_STAGE(PG8_SA(1, 0), a3, voffA);
            PG8_WAIT_V(8); PG8_WAIT_L(0); PG8_BAR; PG8_MMA(1, 0, At, B0); PG8_MMA(1, 1, At, B1); PG8_BAR; PG8_SCHED;
        }
        if (wr == 0) PG8_BAR;
        if constexpr (F8) asm volatile("s_nop 15\n\ts_nop 7" ::: "memory");
        { int tz = threadIdx.x; asm volatile("" : "+v"(tz));
          const int wid2 = __builtin_amdgcn_readfirstlane(tz >> 6), lane2 = tz & 63; E(acc, cur, wid2 >> 2, wid2 & 3, lane2 & 15, lane2 >> 4); }
        if (!has_next) break;
        if (!(Epi::CHAIN && cur.kind == 0)) {
#pragma unroll
            for (int a = 0; a < 2; ++a)
#pragma unroll
                for (int b = 0; b < 2; ++b)
#pragma unroll
                    for (int m = 0; m < 4; ++m)
#pragma unroll
                        for (int n = 0; n < 2; ++n) acc[a][b][m][n] = (f32x4){0.f, 0.f, 0.f, 0.f};
        }
        cur = nxt; cA = nA; cB = nB; ++ui;
        if (wr == 1) PG8_BAR;
    }
    PG8_WAIT_V(0);
    PG8_BAR;
#undef PG8_SA
#undef PG8_SB
#undef PG8_STAGE
#undef PG8_LDA
#undef PG8_LDB
#undef PG8_MMA
#undef PG8_CAT
#undef PG8_WAIT_V
#undef PG8_WAIT_L
#undef PG8_BAR
#undef PG8_SCHED
}
}
namespace pg8 {
__device__ __forceinline__ u32x4 pack8(const f32x4 a, const f32x4 b) { u32x4 w; w.x = cvt_pk_bf16(a[0], a[1]); w.y = cvt_pk_bf16(a[2], a[3]); w.z = cvt_pk_bf16(b[0], b[1]); w.w = cvt_pk_bf16(b[2], b[3]); return w; }
__device__ __forceinline__ float sumsq4(const f32x4 a) { return (a[0] * a[0] + a[1] * a[1]) + (a[2] * a[2] + a[3] * a[3]); }
#define EPI_BAR() do { asm volatile("s_waitcnt lgkmcnt(0)" ::: "memory"); __builtin_amdgcn_s_barrier(); asm volatile("" ::: "memory"); } while (0)

struct EpiIn {
    static constexpr bool PERM = true, CHAIN = false;
    bf16_t *QA, *KA, *VA, *ZCQ, *ZCKV, *ZKR, *GATES; const float *qg, *kg;
    __device__ __forceinline__ void operator()(f32x4 (&acc)[2][2][4][2], const Unit& u, int wr, int wc, int fr, int fq) const {
        const int row0 = u.pm * BM + wr * 64 + fr, pn = u.pn;
        if (pn < 4) {
            const float* g = (pn < 2) ? qg : kg; bf16_t* dst = (pn < 2) ? QA : KA; const int head = 4 * (pn & 1) + wc;
            f32x4 gv[2][2];
#pragma unroll
            for (int bj = 0; bj < 2; ++bj)
#pragma unroll
                for (int n = 0; n < 2; ++n) gv[bj][n] = *(const f32x4*)(g + 32 * bj + 8 * fq + 4 * n);
#pragma unroll
            for (int ai = 0; ai < 2; ++ai)
#pragma unroll
                for (int m = 0; m < 4; ++m) {
                    const size_t row = (size_t)(row0 + ai * HALF + m * 16);
                    float ss = (sumsq4(acc[ai][0][m][0]) + sumsq4(acc[ai][0][m][1])) + (sumsq4(acc[ai][1][m][0]) + sumsq4(acc[ai][1][m][1]));
                    ss += __shfl_xor(ss, 16); ss += __shfl_xor(ss, 32);
                    const float rstd = rsqrtf(ss * (1.0f / 64.0f) + RMS_EPS);
#pragma unroll
                    for (int bj = 0; bj < 2; ++bj)
                        *(u32x4*)(dst + row * 512 + head * 64 + 32 * bj + 8 * fq) = pack8(acc[ai][bj][m][0] * rstd * gv[bj][0], acc[ai][bj][m][1] * rstd * gv[bj][1]);
                }
        } else if (pn >= 9) {
#pragma unroll
            for (int ai = 0; ai < 2; ++ai)
#pragma unroll
                for (int m = 0; m < 4; ++m) {
                    const size_t row = (size_t)(row0 + ai * HALF + m * 16);
#pragma unroll
                    for (int bj = 0; bj < 2; ++bj) { f32x4 a = acc[ai][bj][m][0], b = acc[ai][bj][m][1];
#pragma unroll
                        for (int j = 0; j < 4; ++j) { a[j] = sigmoidf_(a[j]); b[j] = sigmoidf_(b[j]); }
                        *(u32x4*)(GATES + row * 2048 + (pn - 9) * 256 + 128 * bj + 32 * wc + 8 * fq) = pack8(a, b); }
                }
        } else {
#pragma unroll
            for (int ai = 0; ai < 2; ++ai)
#pragma unroll
                for (int m = 0; m < 4; ++m) {
                    const size_t row = (size_t)(row0 + ai * HALF + m * 16);
#pragma unroll
                    for (int bj = 0; bj < 2; ++bj) {
                        const u32x4 w = pack8(acc[ai][bj][m][0], acc[ai][bj][m][1]); const int cc = 128 * bj + 32 * wc + 8 * fq;
                        if (pn < 6) *(u32x4*)(VA + row * 512 + (pn - 4) * 256 + cc) = w;
                        else if (pn == 6) *(u32x4*)(ZCQ + row * QLORA + cc) = w;
                        else if (pn == 8) *(u32x4*)(ZCKV + row * KVLORA + cc) = w;
                        else { if (bj == 0) *(u32x4*)(ZCQ + row * QLORA + 256 + cc) = w; else if (wc == 0) *(u32x4*)(ZKR + row * ROPED + 8 * fq) = w; }
                    }
                }
        }
    }
};

__device__ __forceinline__ void rope8(float (&v)[8], const LAS float* rope, int s  , int fq) {
    const int pos = (fq < 2) ? (s >> 6) : (s & 63);
    const f32x4 c0 = *(const LAS f32x4*)(rope + pos * 8), c1 = *(const LAS f32x4*)(rope + pos * 8 + 4), s0 = *(const LAS f32x4*)(rope + 512 + pos * 8), s1 = *(const LAS f32x4*)(rope + 512 + pos * 8 + 4);
    const float cs[8] = {c0[0], c0[1], c0[2], c0[3], c1[0], c1[1], c1[2], c1[3]}, sn[8] = {s0[0], s0[1], s0[2], s0[3], s1[0], s1[1], s1[2], s1[3]};
#pragma unroll
    for (int i = 0; i < 8; ++i) { const float o = __shfl_xor(v[i], 16); v[i] = (fq & 1) ? (o * sn[i] + v[i] * cs[i]) : (v[i] * cs[i] - o * sn[i]); }
}

struct EpiQ {
    static constexpr bool PERM = true, CHAIN = false;
    bf16_t* QB; const float *rs, *g; const LAS float* rope; LAS float* P;
    __device__ __forceinline__ void operator()(f32x4 (&acc)[2][2][4][2], const Unit& u, int wr, int wc, int fr, int fq) const {
        const int row0 = u.pm * BM + wr * 64 + fr; const bool isx = u.pm < MT_X;
        float r8[8];
#pragma unroll
        for (int i = 0; i < 8; ++i) r8[i] = rs[row0 + (i >> 2) * HALF + (i & 3) * 16];
        const int gq = (wc < 3) ? wc : 0;
        const f32x4 g0 = *(const f32x4*)(g + 32 * gq + 8 * fq), g1 = *(const f32x4*)(g + 32 * gq + 8 * fq + 4);
#pragma unroll
        for (int ai = 0; ai < 2; ++ai)
#pragma unroll
            for (int m = 0; m < 4; ++m) {
                const float r = r8[ai * 4 + m]; const int rl = ai * 64 + m * 16 + fr;
#pragma unroll
                for (int bj = 0; bj < 2; ++bj) {
                    float ss = (sumsq4(acc[ai][bj][m][0]) + sumsq4(acc[ai][bj][m][1])) * (r * r); ss += __shfl_xor(ss, 16); ss += __shfl_xor(ss, 32);
                    if (fq == 0) P[((wr * 128 + rl) * 2 + bj) * 4 + wc] = ss; }
            }
        EPI_BAR();
        if (wc < 3) {
#pragma unroll
            for (int ai = 0; ai < 2; ++ai)
#pragma unroll
                for (int m = 0; m < 4; ++m) {
                    const int row = row0 + ai * HALF + m * 16, rl = ai * 64 + m * 16 + fr; const float r = r8[ai * 4 + m];
#pragma unroll
                    for (int bj = 0; bj < 2; ++bj) {
                        const f32x4 p = *(const LAS f32x4*)(P + ((wr * 128 + rl) * 2 + bj) * 4);
                        const float rstd = r * rsqrtf(((p[0] + p[1]) + p[2]) * (1.0f / 96.0f) + RMS_EPS);
                        const f32x4 a = acc[ai][bj][m][0] * rstd * g0, b = acc[ai][bj][m][1] * rstd * g1;
                        float v[8] = {a[0], a[1], a[2], a[3], b[0], b[1], b[2], b[3]};
                        if (wc == 2 && isx) rope8(v, rope, row & (SEQ - 1), fq);
                        u32x4 w; w.x = cvt_pk_bf16(v[0], v[1]); w.y = cvt_pk_bf16(v[2], v[3]); w.z = cvt_pk_bf16(v[4], v[5]); w.w = cvt_pk_bf16(v[6], v[7]);
                        *(u32x4*)(QB + (size_t)row * 768 + (2 * u.pn + bj) * QKD + 32 * wc + 8 * fq) = w;
                    }
                    asm volatile("" ::: "memory");
                }
        }
    }
};

struct EpiKV {
    static constexpr bool PERM = true, CHAIN = false;
    bf16_t *KB, *VB; const bf16_t* ZKR; const float *rs, *sskr, *g; const LAS float* rope; LAS float* P;
    __device__ __forceinline__ void operator()(f32x4 (&acc)[2][2][4][2], const Unit& u, int wr, int wc, int fr, int fq) const {
        const int row0 = u.pm * BM + wr * 64 + fr; const bool isx = u.pm < MT_X;
        float r8[8], k8[8]; u32x4 zk8[8];
#pragma unroll
        for (int i = 0; i < 8; ++i) { const int row = row0 + (i >> 2) * HALF + (i & 3) * 16; r8[i] = rs[row]; k8[i] = sskr[row];
            zk8[i] = (u32x4){0u, 0u, 0u, 0u}; if (wc == 2) zk8[i] = *(const u32x4*)(ZKR + (size_t)row * ROPED + 8 * fq); }
        const int gofs = (wc < 2) ? (32 * wc + 8 * fq) : (64 + 8 * fq);
        const f32x4 g0 = *(const f32x4*)(g + gofs), g1 = *(const f32x4*)(g + gofs + 4);
        if (wc < 2) {
#pragma unroll
            for (int ai = 0; ai < 2; ++ai)
#pragma unroll
                for (int m = 0; m < 4; ++m) { const float r = r8[ai * 4 + m]; const int rl = ai * 64 + m * 16 + fr;
#pragma unroll
                    for (int bj = 0; bj < 2; ++bj) { float ss = (sumsq4(acc[ai][bj][m][0]) + sumsq4(acc[ai][bj][m][1])) * (r * r); ss += __shfl_xor(ss, 16); ss += __shfl_xor(ss, 32);
                        if (fq == 0) P[((wr * 128 + rl) * 2 + bj) * 4 + wc] = ss + ((wc == 0) ? k8[ai * 4 + m] : 0.f); } }
        }
        EPI_BAR();
#pragma unroll
        for (int ai = 0; ai < 2; ++ai)
#pragma unroll
            for (int m = 0; m < 4; ++m) {
                const int row = row0 + ai * HALF + m * 16, rl = ai * 64 + m * 16 + fr;
                const float rr = r8[ai * 4 + m]; const u32x4 zk = zk8[ai * 4 + m];
#pragma unroll
                for (int bj = 0; bj < 2; ++bj) {
                    const int head = 2 * u.pn + bj;
                    const f32x4 p = *(const LAS f32x4*)(P + ((wr * 128 + rl) * 2 + bj) * 4);
                    const float rstd = rsqrtf((p[0] + p[1]) * (1.0f / 96.0f) + RMS_EPS);
                    if (wc < 2) {
                        *(u32x4*)(KB + (size_t)row * 768 + head * QKD + 32 * wc + 8 * fq) = pack8(acc[ai][bj][m][0] * (rr * rstd) * g0, acc[ai][bj][m][1] * (rr * rstd) * g1);
                    } else {
                        *(u32x4*)(VB + (size_t)row * 512 + head * 64 + 32 * (wc - 2) + 8 * fq) = pack8(acc[ai][bj][m][0] * rr, acc[ai][bj][m][1] * rr);
                        if (wc == 2) {
                            float v[8] = {bf_lo(zk.x) * rstd * g0[0], bf_hi(zk.x) * rstd * g0[1], bf_lo(zk.y) * rstd * g0[2], bf_hi(zk.y) * rstd * g0[3],
                                          bf_lo(zk.z) * rstd * g1[0], bf_hi(zk.z) * rstd * g1[1], bf_lo(zk.w) * rstd * g1[2], bf_hi(zk.w) * rstd * g1[3]};
                            if (isx) rope8(v, rope, row & (SEQ - 1), fq);
                            u32x4 w; w.x = cvt_pk_bf16(v[0], v[1]); w.y = cvt_pk_bf16(v[2], v[3]); w.z = cvt_pk_bf16(v[4], v[5]); w.w = cvt_pk_bf16(v[6], v[7]);
                            *(u32x4*)(KB + (size_t)row * 768 + head * QKD + 64 + 8 * fq) = w;
                        }
                    }
                }
                asm volatile("" ::: "memory");
            }
    }
};

struct EpiMerge {
    static constexpr bool PERM = true, CHAIN = true;
    const bf16_t* GATES; bf16_t* Y;
    __device__ __forceinline__ void operator()(f32x4 (&acc)[2][2][4][2], const Unit& u, int wr, int wc, int fr, int fq) const {
        const int row0 = u.pm * BM + wr * 64 + fr;
#pragma unroll
        for (int ai = 0; ai < 2; ++ai)
#pragma unroll
            for (int m = 0; m < 4; ++m) {
                const size_t row = (size_t)(row0 + ai * HALF + m * 16);
#pragma unroll
                for (int bj = 0; bj < 2; ++bj) {
                    const int col = u.pn * 256 + 128 * bj + 32 * wc + 8 * fq;
                    const u32x4 gb = *(const u32x4*)(GATES + row * 2048 + 1024 + col);
                    const f32x4 b0 = (f32x4){bf_lo(gb.x), bf_hi(gb.x), bf_lo(gb.y), bf_hi(gb.y)}, b1 = (f32x4){bf_lo(gb.z), bf_hi(gb.z), bf_lo(gb.w), bf_hi(gb.w)};
                    if (u.kind == 0) {
                        const u32x4 ga = *(const u32x4*)(GATES + row * 2048 + col);
                        const f32x4 a0 = (f32x4){bf_lo(ga.x), bf_hi(ga.x), bf_lo(ga.y), bf_hi(ga.y)}, a1 = (f32x4){bf_lo(ga.z), bf_hi(ga.z), bf_lo(ga.w), bf_hi(ga.w)};
#pragma unroll
                        for (int j = 0; j < 4; ++j) { acc[ai][bj][m][0][j] *= a0[j] * __builtin_amdgcn_rcpf(b0[j]); acc[ai][bj][m][1][j] *= a1[j] * __builtin_amdgcn_rcpf(b1[j]); }
                    } else {
                        *(u32x4*)(Y + row * 1024 + col) = pack8(acc[ai][bj][m][0] * b0, acc[ai][bj][m][1] * b1);
                    }
                }
            }
    }
};

struct EpiOut {
    static constexpr bool PERM = false, CHAIN = false;
    const float* xsrc; float* xdst; const float* csrc; float* cdst; const float* mod  ; int goff;
    __device__ __forceinline__ void operator()(f32x4 (&acc)[2][2][4][2], const Unit& u, int wr, int wc, int fr, int fq) const {
        const bool isx = u.pm < MT_X;
        const int rowt = (isx ? u.pm : u.pm - MT_X) * BM + wr * 64 + fr;
        const float* src = isx ? xsrc : csrc; float* dst = isx ? xdst : cdst;
        const float* gm = mod + (size_t)(isx ? (u.pm >> 3) : 16) * NMODC + goff;
        const int col0 = u.pn * BM + wc * 32 + 4 * fq;
        f32x4 gv[2][2];
#pragma unroll
        for (int bj = 0; bj < 2; ++bj)
#pragma unroll
            for (int n = 0; n < 2; ++n) gv[bj][n] = *(const f32x4*)(gm + col0 + bj * HALF + n * 16);
#pragma unroll
        for (int ai = 0; ai < 2; ++ai)
#pragma unroll
            for (int m = 0; m < 4; ++m) { const size_t off = (size_t)(rowt + ai * HALF + m * 16) * DM + col0;
#pragma unroll
                for (int bj = 0; bj < 2; ++bj)
#pragma unroll
                    for (int n = 0; n < 2; ++n) { const f32x4 xs = *(const f32x4*)(src + off + bj * HALF + n * 16); *(f32x4*)(dst + off + bj * HALF + n * 16) = xs + gv[bj][n] * acc[ai][bj][m][n]; }
            }
    }
};

template <bool F8> struct EpiMoe1 {
    static constexpr bool PERM = true, CHAIN = false;
    bf16_t* HM; float ascale;
    __device__ __forceinline__ void operator()(f32x4 (&acc)[2][2][4][2], const Unit& u, int wr, int wc, int fr, int fq) const {
        const int row0 = u.pm * BM + wr * 64 + fr;
#pragma unroll
        for (int ai = 0; ai < 2; ++ai)
#pragma unroll
            for (int m = 0; m < 4; ++m) { const size_t row = (size_t)(row0 + ai * HALF + m * 16);
#pragma unroll
                for (int bj = 0; bj < 2; ++bj) { f32x4 p = acc[ai][bj][m][0], q = acc[ai][bj][m][1];
                    if (F8) { p = p * ascale; q = q * ascale; }
                    const float h0 = p[0] * sigmoidf_(p[0]) * p[1], h1 = p[2] * sigmoidf_(p[2]) * p[3], h2 = q[0] * sigmoidf_(q[0]) * q[1], h3 = q[2] * sigmoidf_(q[2]) * q[3];
                    const int col = u.pn * 128 + 64 * bj + 16 * wc + 4 * fq;
                    if (F8) *(unsigned*)((unsigned char*)HM + row * DM + col) = cvt_pk4_fp8(h0 * F8_SM, h1 * F8_SM, h2 * F8_SM, h3 * F8_SM);
                    else { u32x2 w; w.x = cvt_pk_bf16(h0, h1); w.y = cvt_pk_bf16(h2, h3); *(u32x2*)(HM + row * DM + col) = w; } }
            }
    }
};
struct EpiMoe2 {
    static constexpr bool PERM = true, CHAIN = false;
    bf16_t* YS; float ascale;
    __device__ __forceinline__ void operator()(f32x4 (&acc)[2][2][4][2], const Unit& u, int wr, int wc, int fr, int fq) const {
        const int row0 = u.pm * BM + wr * 64 + fr;
#pragma unroll
        for (int ai = 0; ai < 2; ++ai)
#pragma unroll
            for (int m = 0; m < 4; ++m) { const size_t row = (size_t)(row0 + ai * HALF + m * 16);
#pragma unroll
                for (int bj = 0; bj < 2; ++bj) *(u32x4*)(YS + row * DM + u.pn * 256 + 128 * bj + 32 * wc + 8 * fq) = pack8(acc[ai][bj][m][0] * ascale, acc[ai][bj][m][1] * ascale); }
    }
};

struct SchedRect {
    const char* A; const char* B; size_t tstep; int nM, nN, G, c, nM2, pn2, npn2;
    __device__ __forceinline__ bool next(int i, Unit& u) const {
        const int L = i * G + c, mainc = nM * nN; u.kind = 0; u.e = 0;
        if (L < mainc) { rect_tile(L, nM, nN, u.pm, u.pn); return true; }
        const int Lx = L - mainc; if (Lx >= nM2 * npn2) return false;
        u.pm = nM + Lx / npn2; u.pn = pn2 + Lx % npn2; return true;
    }
    __device__ __forceinline__ const char* a_ptr(const Unit& u) const { return A + (size_t)u.pm * tstep; }
    __device__ __forceinline__ const char* b_ptr(const Unit& u) const { return B + (size_t)u.pn * tstep; }
};
struct SchedMerge {
    const char *OA, *OB, *WA, *WB; size_t tstep; int nM, nN, G, c;
    __device__ __forceinline__ bool next(int i, Unit& u) const {
        const int L = (i >> 1) * G + c; if (L >= nM * nN) return false;
        rect_tile(L, nM, nN, u.pm, u.pn); u.kind = i & 1; u.e = 0; return true;
    }
    __device__ __forceinline__ const char* a_ptr(const Unit& u) const { return (u.kind ? OB : OA) + (size_t)u.pm * tstep; }
    __device__ __forceinline__ const char* b_ptr(const Unit& u) const { return (u.kind ? WB : WA) + (size_t)u.pn * tstep; }
};
struct SchedMoe {
    const char* A; const char* W; size_t tstepA, wstride, tstepB; const LAS int* tile_e  ; int ntile, nN, G, c;
    __device__ __forceinline__ bool next(int i, Unit& u) const {
        const int L = i * G + c; if (L >= ntile * nN) return false;
        rect_tile(L, ntile, nN, u.pm, u.pn); u.kind = 0;
        u.e = __builtin_amdgcn_readfirstlane(tile_e[u.pm]); return true;
    }
    __device__ __forceinline__ const char* a_ptr(const Unit& u) const { return A + (size_t)u.pm * tstepA; }
    __device__ __forceinline__ const char* b_ptr(const Unit& u) const { return W + (size_t)u.e * wstride + (size_t)u.pn * tstepB; }
};
}
namespace att {
constexpr int NW = 8, QBLK = 32, KVBLK = 64, DV = 64;
constexpr int SHM_V = 16384, SHM_K = 16384;
constexpr int LDS_VOFF = 0, LDS_KOFF = 2 * SHM_V, LDS_WS = LDS_KOFF + 2 * SHM_K, LDS_OST = LDS_WS + NW * 64 * 4, LDS_BIAS = LDS_OST + NW * 4096, LDS_MASK = LDS_BIAS + 16 * 128 * 4, LDS_END = LDS_MASK + 64 * 64 * 4;
static_assert(LDS_END <= RING_BYTES, "attention LDS map");
template <int DQK> struct KL { static constexpr int PITCH = (DQK == 64) ? 128 : 256; };
#define KSWZ(row, colB) ((row) * KL<DQK>::PITCH + ((colB) ^ (((row) & 7) << 4)))
#define SBAR() __builtin_amdgcn_sched_barrier(0)
__device__ __forceinline__ int crow(int r, int hi) { return (r & 3) + 8 * (r >> 2) + 4 * hi; }
__device__ __forceinline__ int v_st(int k, int c) { const int kk = (k & ~0xC) | ((k & 4) << 1) | ((k & 8) >> 1); return ((kk >> 3) * 2 + (c >> 5)) * 512 + ((kk & 7) * 32 + (c & 31)) * 2; }
__device__ __forceinline__ int v_rd_base(int lane, int c) { const int hi = (lane >> 5) & 1, g = c + hi;
    return ((lane & 3) << 3) | (((lane >> 2) & 3) << 6) | (((lane >> 4) & 1) << 5) | ((g & 1) << 8) | ((g >> 1) << 11); }
constexpr int v_rd_off(int d0, int ks, int half) { return ((2 * ks + half) * 2 + d0) * 512; }
template <int OFF> __device__ __forceinline__ s16x4 tr_read(int vb) { s16x4 r; asm volatile("ds_read_b64_tr_b16 %0, %1 offset:%2" : "=&v"(r) : "v"(vb), "i"(OFF) : "memory"); return r; }

template <int D0> __device__ __forceinline__ void pv_one(f32x16& od, int vbA, int vbB, bf16x8 pa0, bf16x8 pa1, bf16x8 pa2, bf16x8 pa3) {
    const s16x4 l0 = tr_read<v_rd_off(D0, 0, 0)>(vbA), h0 = tr_read<v_rd_off(D0, 0, 1)>(vbA), l1 = tr_read<v_rd_off(D0, 1, 0)>(vbA), h1 = tr_read<v_rd_off(D0, 1, 1)>(vbA);
    const s16x4 l2 = tr_read<v_rd_off(D0, 0, 0)>(vbB), h2 = tr_read<v_rd_off(D0, 0, 1)>(vbB), l3 = tr_read<v_rd_off(D0, 1, 0)>(vbB), h3 = tr_read<v_rd_off(D0, 1, 1)>(vbB);
    asm volatile("s_waitcnt lgkmcnt(0)" ::: "memory"); SBAR();
#define PK(L, H) (bf16x8){L[0], L[1], L[2], L[3], H[0], H[1], H[2], H[3]}
    od = __builtin_amdgcn_mfma_f32_32x32x16_bf16(pa0, PK(l0, h0), od, 0, 0, 0);
    od = __builtin_amdgcn_mfma_f32_32x32x16_bf16(pa1, PK(l1, h1), od, 0, 0, 0);
    od = __builtin_amdgcn_mfma_f32_32x32x16_bf16(pa2, PK(l2, h2), od, 0, 0, 0);
    od = __builtin_amdgcn_mfma_f32_32x32x16_bf16(pa3, PK(l3, h3), od, 0, 0, 0);
#undef PK
}
__device__ __forceinline__ void pv_all(f32x16* o, int vbA, int vbB, bf16x8 pa0, bf16x8 pa1, bf16x8 pa2, bf16x8 pa3) { pv_one<0>(o[0], vbA, vbB, pa0, pa1, pa2, pa3); pv_one<1>(o[1], vbA, vbB, pa0, pa1, pa2, pa3); }

#define MX3(a, b, c) __builtin_fmaxf(__builtin_fmaxf((a), (b)), (c))
template <bool FIRST>
__device__ __forceinline__ void partialSM(f32x16& p0, f32x16& p1, float& m_reg, float& alpha, f32x16& negm, const float THR2) {
    float a = MX3(p0[0], p0[1], p1[0]), b = MX3(p0[2], p0[3], p1[1]); a = MX3(a, p1[2], p1[3]);
#pragma unroll
    for (int r = 4; r < 16; r += 4) { a = MX3(a, p0[r], p0[r + 1]); b = MX3(b, p0[r + 2], p0[r + 3]); a = MX3(a, p1[r], p1[r + 1]); b = MX3(b, p1[r + 2], p1[r + 3]); }
    float pmax = __builtin_fmaxf(a, b);
    { auto rr = __builtin_amdgcn_permlane32_swap(__float_as_uint(pmax), __float_as_uint(pmax), false, false); pmax = __builtin_fmaxf(__uint_as_float(rr[0]), __uint_as_float(rr[1])); }
    alpha = 1.f;
    if (FIRST || !__builtin_expect(__all(pmax <= THR2), 1)) {
        const float dl = FIRST ? pmax : __builtin_fmaxf(pmax, 0.f);
        m_reg += dl; alpha = FIRST ? 1.f : __builtin_amdgcn_exp2f(-dl);
#pragma unroll
        for (int r = 0; r < 16; ++r) { p0[r] -= dl; p1[r] -= dl; }
#pragma unroll
        for (int r = 0; r < 16; ++r) negm[r] = -m_reg;
    }
#pragma unroll
    for (int r = 0; r < 16; ++r) p0[r] = __builtin_amdgcn_exp2f(p0[r]);
}
__device__ __forceinline__ void finishSM(f32x16& p0, f32x16& p1, float alpha, float& l_reg, bf16x8& pa0, bf16x8& pa1, bf16x8& pa2, bf16x8& pa3) {
#pragma unroll
    for (int r = 0; r < 16; ++r) p1[r] = __builtin_amdgcn_exp2f(p1[r]);
    float ps = 0;
#pragma unroll
    for (int r = 0; r < 16; ++r) ps += p0[r];
#pragma unroll
    for (int r = 0; r < 16; ++r) ps += p1[r];
    { auto rr = __builtin_amdgcn_permlane32_swap(__float_as_uint(ps), __float_as_uint(ps), false, false); ps = __uint_as_float(rr[0]) + __uint_as_float(rr[1]); }
    l_reg = l_reg * alpha + ps;
#define PK4(P, BASE, OUT) do { unsigned a0 = cvt_pk_bf16(P[BASE + 0], P[BASE + 1]), a1 = cvt_pk_bf16(P[BASE + 2], P[BASE + 3]);   \
    unsigned b0 = cvt_pk_bf16(P[BASE + 4], P[BASE + 5]), b1 = cvt_pk_bf16(P[BASE + 6], P[BASE + 7]);                              \
    auto r0 = __builtin_amdgcn_permlane32_swap(a0, b0, false, false); auto r1 = __builtin_amdgcn_permlane32_swap(a1, b1, false, false); \
    u32x4 w = {r0[0], r1[0], r0[1], r1[1]}; OUT = *reinterpret_cast<bf16x8*>(&w); } while (0)
    PK4(p0, 0, pa0); PK4(p0, 8, pa1); PK4(p1, 0, pa2); PK4(p1, 8, pa3);
#undef PK4
}
template <int DQK> __device__ __forceinline__ void qkt(f32x16& p0, f32x16& p1, const char* Ks, int rowA, int rowB, const bf16x8* qr, const f32x16& negm, int hi) {
#pragma unroll
    for (int d0 = 0; d0 < DQK / 16; ++d0) { const int cb = (d0 * 16 + hi * 8) * 2;
        const bf16x8 b0 = *reinterpret_cast<const bf16x8*>(Ks + KSWZ(rowA, cb));
        const bf16x8 b1 = *reinterpret_cast<const bf16x8*>(Ks + KSWZ(rowB, cb));
        if (d0 == 0) { p0 = __builtin_amdgcn_mfma_f32_32x32x16_bf16(b0, qr[0], negm, 0, 0, 0); p1 = __builtin_amdgcn_mfma_f32_32x32x16_bf16(b1, qr[0], negm, 0, 0, 0); }
        else { p0 = __builtin_amdgcn_mfma_f32_32x32x16_bf16(b0, qr[d0], p0, 0, 0, 0); p1 = __builtin_amdgcn_mfma_f32_32x32x16_bf16(b1, qr[d0], p1, 0, 0, 0); } }
}

struct UnitArgs {
    const bf16_t* Q; int ldq; int qcol;
    const bf16_t* K; int ldk; int kcol;
    const bf16_t* V; int vcol;
    bf16_t* O; int ocol;
    int q0;
    int ctx0, loc0;
    int NT;
    int masked;
    int band, krow0;
    const float* bias;
    float C;
};

__device__ __forceinline__ void na_mask(f32x16& p0, f32x16& p1, const LAS float* bt, const LAS float* mk, int krA, int qrow, int qc, int kc0, int hi) {
    const int rs = min(max(qrow - 4, 0), 24);
    const int drA = ((krA >= rs) && (krA < rs + 8)) ? (krA - qrow + 7) : 15, drB = ((krA + 1 >= rs) && (krA + 1 < rs + 8)) ? (krA + 1 - qrow + 7) : 15;
    const LAS float* bA = bt + drA * 128 + (kc0 + 4 * hi - qc + 64); const LAS float* bB = bt + drB * 128 + (kc0 + 4 * hi - qc + 64);
    const LAS float* mq = mk + qc * 64 + kc0 + 4 * hi;
#pragma unroll
    for (int g = 0; g < 4; ++g) {
        const f32x4 m0 = *(const LAS f32x4*)(mq + 8 * g);
#pragma unroll
        for (int j = 0; j < 4; ++j) { p0[4 * g + j] = (p0[4 * g + j] + bA[8 * g + j]) + m0[j]; p1[4 * g + j] = (p1[4 * g + j] + bB[8 * g + j]) + m0[j]; }
    }
}
__device__ __forceinline__ void na_mask_table(char* lds) {
    LAS float* mk = (LAS float*)(lds + LDS_MASK);
    int t0 = threadIdx.x; asm volatile("" : "+v"(t0));
    for (int i = t0; i < 64 * 64; i += 512) { const int qc = i >> 6, kc = i & 63, cs = min(max(qc - 8, 0), 48); mk[i] = ((unsigned)(kc - cs) < 16u) ? 0.f : -1e30f; }
}

template <int DQK>
__device__ __forceinline__ void attn_unit(const UnitArgs& A, char* lds) {
    int tid = threadIdx.x; asm volatile("" : "+v"(tid));
    const int wid = tid >> 6, lane = tid & 63, r32 = lane & 31, hi = lane >> 5;
    char* V_lds = lds + LDS_VOFF; char* K_lds = lds + LDS_KOFF;
    float* ws = (float*)(lds + LDS_WS) + wid * 64; float* li_l = ws; float* al_l = ws + 32;
    const LAS float* bt = (const LAS float*)(lds + LDS_BIAS); const LAS float* mk = (const LAS float*)(lds + LDS_MASK);
    const float C = A.C, THR2 = 8.0f * 1.4426950408889634f;
    const bool msk = (DQK == 64) && A.masked;
    float m_reg = 0.f, l_reg = 0; f32x16 o[2] = {}; bf16x8 qr[DQK / 16]; f32x16 negm = f32x16{};
    if (msk) { for (int i = tid; i < 16 * 128; i += 512) { const int dr = i >> 7, d = (i & 127) - 64;
            ((LAS float*)(lds + LDS_BIAS))[i] = (dr == 15) ? -1e30f : ((d >= -15 && d <= 15) ? A.bias[dr * 31 + d + 15] * 1.4426950408889634f : 0.f); } }
    const int qrow = 4 * A.band + 2 * (wid >> 2) + (r32 >> 4), qc = 16 * (wid & 3) + (r32 & 15);
    const int kc0 = msk ? min(max(16 * (wid & 3) - 8, 0), 32) : 0;
    const int qtok = msk ? (A.q0 + 64 * (2 * (wid >> 2) + (r32 >> 4)) + qc) : (A.q0 + wid * QBLK + r32);
    const bf16_t* Qw = A.Q + (size_t)qtok * A.ldq + A.qcol + hi * 8;
#pragma unroll
    for (int d0 = 0; d0 < DQK / 16; ++d0) { const u32x4 w = *reinterpret_cast<const u32x4*>(Qw + d0 * 16);
        u32x4 t; t.x = cvt_pk_bf16(bf_lo(w.x) * C, bf_hi(w.x) * C); t.y = cvt_pk_bf16(bf_lo(w.y) * C, bf_hi(w.y) * C); t.z = cvt_pk_bf16(bf_lo(w.z) * C, bf_hi(w.z) * C); t.w = cvt_pk_bf16(bf_lo(w.w) * C, bf_hi(w.w) * C);
        qr[d0] = *reinterpret_cast<bf16x8*>(&t); }
    constexpr int CPR = DQK / 8;
    const int v0key = tid >> 3, vc = (tid & 7) * 8, vst0 = v_st(v0key, vc), vst1 = 8192 + vst0;
    const int k0key = tid / CPR, k0c = tid % CPR, k1id = tid + 512, k1key = k1id / CPR, k1c = k1id % CPR;
    const int vbS = (int)(uintptr_t)V_lds + v_rd_base(lane, 0);
    const int vbM = (int)(uintptr_t)V_lds + v_rd_base(lane, kc0 >> 3);
    bf16x8 sv0, sv1 = {}, sk0, sk1 = {};
#define LOCAL(t) (msk && (t) >= 4)
#define TROW(t) (((t) < 4) ? (A.ctx0 + 64 * (t)) : (A.loc0 + (msk ? 128 : 64) * ((t) - 4)))
#define K1ON(t) ((DQK == 96) ? (tid < 256) : LOCAL(t))
#define SLOAD(t) do { const int _r0 = TROW(t); sv0 = *reinterpret_cast<const bf16x8*>(A.V + (size_t)(_r0 + v0key) * 512 + A.vcol + vc); \
        sk0 = *reinterpret_cast<const bf16x8*>(A.K + (size_t)(_r0 + k0key) * A.ldk + A.kcol + k0c * 8); \
        if (K1ON(t)) sk1 = *reinterpret_cast<const bf16x8*>(A.K + (size_t)(_r0 + k1key) * A.ldk + A.kcol + k1c * 8); \
        if (LOCAL(t)) sv1 = *reinterpret_cast<const bf16x8*>(A.V + (size_t)(_r0 + 64 + v0key) * 512 + A.vcol + vc); } while (0)
#define SWRITE(b, t) do { *reinterpret_cast<bf16x8*>(V_lds + (b) * SHM_V + vst0) = sv0; *reinterpret_cast<bf16x8*>(K_lds + (b) * SHM_K + KSWZ(k0key, k0c * 16)) = sk0; \
        if (K1ON(t)) *reinterpret_cast<bf16x8*>(K_lds + (b) * SHM_K + KSWZ(k1key, k1c * 16)) = sk1; \
        if (LOCAL(t)) *reinterpret_cast<bf16x8*>(V_lds + (b) * SHM_V + vst1) = sv1; } while (0)
#define RESC(a) do { if (__any((a) < 1.f)) { if (hi == 0) al_l[r32] = (a); asm volatile("s_waitcnt lgkmcnt(0)" ::: "memory"); \
        _Pragma("unroll") for (int d = 0; d < 2; ++d) _Pragma("unroll") for (int r = 0; r < 16; ++r) o[d][r] *= al_l[crow(r, hi)]; } } while (0)
#define QKT(P0, P1, b, t) do { const int _ra = LOCAL(t) ? (kc0 + r32) : r32, _rb = LOCAL(t) ? (64 + kc0 + r32) : (32 + r32); \
        qkt<DQK>(P0, P1, K_lds + (b) * SHM_K, _ra, _rb, qr, negm, hi); if (LOCAL(t)) na_mask(P0, P1, bt, mk, A.krow0 + 2 * ((t) - 4), qrow, qc, kc0, hi); } while (0)
#define PV(b, t) do { const int _va = (LOCAL(t) ? vbM : vbS) + (b) * SHM_V, _vb = _va + (LOCAL(t) ? 8192 : 4096); pv_all(o, _va, _vb, pa0, pa1, pa2, pa3); } while (0)
    f32x16 pA0, pA1, pB0, pB1; float alA, alB; bf16x8 pa0, pa1, pa2, pa3; const int NT = A.NT;
    SLOAD(0); SWRITE(0, 0); __syncthreads();
    QKT(pA0, pA1, 0, 0); partialSM<true>(pA0, pA1, m_reg, alA, negm, THR2);
    SLOAD(1); SWRITE(1, 1); __syncthreads();
    for (int j = 1; j + 1 < NT; j += 2) {
        SBAR(); QKT(pB0, pB1, 1, j);
        finishSM(pA0, pA1, alA, l_reg, pa0, pa1, pa2, pa3); SBAR();
        SLOAD(j + 1); SBAR();
        PV(0, j - 1); partialSM<false>(pB0, pB1, m_reg, alB, negm, THR2);
        __syncthreads(); SWRITE(0, j + 1);
        RESC(alB); __syncthreads();
        SBAR(); QKT(pA0, pA1, 0, j + 1);
        finishSM(pB0, pB1, alB, l_reg, pa0, pa1, pa2, pa3); SBAR();
        SLOAD(j + 2); SBAR();
        PV(1, j); partialSM<false>(pA0, pA1, m_reg, alA, negm, THR2);
        __syncthreads(); SWRITE(1, j + 2);
        RESC(alA); __syncthreads();
    }
    SBAR(); QKT(pB0, pB1, 1, NT - 1);
    finishSM(pA0, pA1, alA, l_reg, pa0, pa1, pa2, pa3); SBAR();
    PV(0, NT - 2); partialSM<false>(pB0, pB1, m_reg, alB, negm, THR2);
    __syncthreads(); RESC(alB);
    finishSM(pB0, pB1, alB, l_reg, pa0, pa1, pa2, pa3); SBAR();
    PV(1, NT - 1);
    if (hi == 0) li_l[r32] = l_reg; asm volatile("s_waitcnt lgkmcnt(0)" ::: "memory");
    float rli[16];
#pragma unroll
    for (int r = 0; r < 16; ++r) rli[r] = __builtin_amdgcn_rcpf(li_l[crow(r, hi)]);
    bf16_t* stg = (bf16_t*)(lds + LDS_OST) + wid * 2048;
#pragma unroll
    for (int r = 0; r < 16; ++r) { const int orow = crow(r, hi);
#pragma unroll
        for (int d0 = 0; d0 < 2; ++d0) { const unsigned w = cvt_pk_bf16(o[d0][r] * rli[r], 0.f); stg[orow * 64 + d0 * 32 + r32] = (bf16_t)(w & 0xffffu); } }
    asm volatile("s_waitcnt lgkmcnt(0)" ::: "memory");
#pragma unroll
    for (int i = 0; i < 4; ++i) { const int row = i * 8 + (lane >> 3), ch = lane & 7; const u32x4 v = *(const u32x4*)(stg + row * 64 + ch * 8);
        const int otok = msk ? (A.q0 + 64 * (2 * (wid >> 2) + (row >> 4)) + 16 * (wid & 3) + (row & 15)) : (A.q0 + wid * QBLK + row);
        *(u32x4*)(A.O + (size_t)otok * 512 + A.ocol + ch * 8) = v; }
    __syncthreads();
#undef LOCAL
#undef TROW
#undef K1ON
#undef SLOAD
#undef SWRITE
#undef RESC
#undef QKT
#undef PV
}
#undef KSWZ
#undef SBAR
}
struct Frame {
    LAS unsigned char* lds;
    int tid, lane, wave, vcu, G;
};
#define CAS __attribute__((address_space(4)))
__device__ __forceinline__ const CAS char* karg() { return (const CAS char*)__builtin_amdgcn_kernarg_segment_ptr(); }
template <int I> __device__ __forceinline__ const float* in_ptr() { unsigned off = I * 8; asm volatile("" : "+s"(off)); return *(const float* const CAS*)(karg() + off); }
__device__ __forceinline__ float* out_ptr() { unsigned off = 26 * 8; asm volatile("" : "+s"(off)); return *(float* const CAS*)(karg() + off); }
__device__ __forceinline__ unsigned char* ws_ptr() { unsigned off = 27 * 8; asm volatile("" : "+s"(off)); return *(unsigned char* const CAS*)(karg() + off); }
enum { I_X = 0, I_C, I_CTX, I_CCTX, I_WADA, I_BADA, I_NMIXG, I_NFFNG, I_WIN, I_NAQG, I_NAKG, I_RPB, I_CQG, I_WUQ, I_CKVG, I_WUKV, I_QG, I_KG, I_WOA, I_WOB, I_WOUT, I_WR, I_RB, I_W1, I_W3, I_W2 };

#define LDS_WAIT() asm volatile("s_waitcnt lgkmcnt(0)" ::: "memory")

__device__ __forceinline__ int win_src_col(int np) {
    const int pn = np >> 8, cc = np & 255;
    if (pn < 4) { const int part = pn >> 1, tq = pn & 1, bj = cc >> 7, wc = (cc >> 5) & 3, i = cc & 31; return part * 512 + (4 * tq + wc) * 64 + 32 * bj + i; }
    if (pn < 6) return 1024 + (pn - 4) * 256 + cc;
    if (pn == 6) return 1536 + cc;
    if (pn == 7) return cc < 128 ? 1792 + cc : (cc < 160 ? 2176 + (cc - 128) : -1);
    if (pn == 8) return 1920 + cc;
    return 2208 + (pn - 9) * 256 + cc;
}
template <bool F8 = false>
__device__ __forceinline__ void conv_item(const float* src, size_t ld, int dcol, int dstep, const float* gain, bf16_t* WT, int K, int k0, int n0, LAS float* scr, int lane) {
    const int kr = lane >> 4;
    f32x4 v[16];
#pragma unroll
    for (int i = 0; i < 16; ++i) { v[i] = (f32x4){0.f, 0.f, 0.f, 0.f}; if (src) v[i] = __builtin_nontemporal_load((const f32x4*)(src + (size_t)(k0 + 4 * i + kr) * ld)); }
#pragma unroll
    for (int i = 0; i < 16; ++i) { const int kk = 4 * i + kr;
        if (gain) v[i] = v[i] * gain[k0 + kk];
        LAS float* s = scr + kk * 65 + dcol; s[0] = v[i][0]; s[dstep] = v[i][1]; s[2 * dstep] = v[i][2]; s[3 * dstep] = v[i][3]; }
    LDS_WAIT(); asm volatile("" ::: "memory");
    const int c = lane & 7;
#pragma unroll
    for (int j = 0; j < 8; ++j) { const int n = (lane >> 3) + 8 * j; const LAS float* s = scr + (8 * c) * 65 + n;
        if (F8) { u32x2 o; o.x = cvt_pk4_fp8(s[0 * 65] * F8_SW, s[1 * 65] * F8_SW, s[2 * 65] * F8_SW, s[3 * 65] * F8_SW); o.y = cvt_pk4_fp8(s[4 * 65] * F8_SW, s[5 * 65] * F8_SW, s[6 * 65] * F8_SW, s[7 * 65] * F8_SW);
            *(u32x2*)((unsigned char*)WT + (size_t)(n0 + n) * K + k0 + 8 * c) = o; }
        else { u32x4 o; o.x = cvt_pk_bf16(s[0 * 65], s[1 * 65]); o.y = cvt_pk_bf16(s[2 * 65], s[3 * 65]); o.z = cvt_pk_bf16(s[4 * 65], s[5 * 65]); o.w = cvt_pk_bf16(s[6 * 65], s[7 * 65]);
            *(u32x4*)(WT + (size_t)(n0 + n) * K + k0 + 8 * c) = o; } }
    LDS_WAIT(); asm volatile("" ::: "memory");
}
__device__ __forceinline__ void p0_convert(Frame& F) {
    LAS float* scr = (LAS float*)(F.lds + F.wave * 16640);
    const int gw = F.vcu * 8 + F.wave, NGW = F.G * 8, lane = F.lane, q16 = lane & 15;
    constexpr int I_IN = 16 * 68, I_UQ = 6 * 16, I_UKV = 4 * 16, I_OA = 8 * 16, I_OUT = 16 * 16, I_13 = 16 * 32 * NEXP, I_2 = 16 * 16 * NEXP;
    constexpr int PER_L = I_IN + I_UQ + I_UKV + 2 * I_OA + I_OUT + I_13 + I_2;
    unsigned char* const ws = ws_ptr();
    for (int it = gw; it < NLAYER * PER_L; it += NGW) {
        const int l = it / PER_L; int r = it - l * PER_L;
        if (r < I_IN) { const int kb = r / 68, nb = r % 68, sc = win_src_col(nb * 64 + 4 * q16);
            conv_item(sc >= 0 ? in_ptr<I_WIN>() + (size_t)l * DM * INC + sc : nullptr, INC, 4 * q16, 1, nullptr, (bf16_t*)(ws + WS_WIN) + (size_t)l * INP * DM, DM, kb * 64, nb * 64, scr, lane); continue; } r -= I_IN;
        if (r < I_UQ) { const int kb = r / 16, nb = r % 16, np = nb * 64 + 4 * q16, hh = np >> 7, dd = np & 127;
            conv_item(dd < QKD ? in_ptr<I_WUQ>() + (size_t)l * QLORA * 768 + hh * QKD + dd : nullptr, 768, 4 * q16, 1, in_ptr<I_CQG>() + l * QLORA, (bf16_t*)(ws + WS_WUQ) + (size_t)l * 1024 * QLORA, QLORA, kb * 64, nb * 64, scr, lane); continue; } r -= I_UQ;
        if (r < I_UKV) { const int kb = r / 16, nb = r % 16;
            conv_item(in_ptr<I_WUKV>() + (size_t)l * KVLORA * 1024 + nb * 64 + 4 * q16, 1024, 4 * q16, 1, in_ptr<I_CKVG>() + l * KVLORA, (bf16_t*)(ws + WS_WUKV) + (size_t)l * 1024 * KVLORA, KVLORA, kb * 64, nb * 64, scr, lane); continue; } r -= I_UKV;
        if (r < 2 * I_OA) { const int w = r / I_OA, rr = r % I_OA, kb = rr / 16, nb = rr % 16;
            conv_item((w ? in_ptr<I_WOB>() : in_ptr<I_WOA>()) + (size_t)l * 512 * DM + nb * 64 + 4 * q16, DM, 4 * q16, 1, nullptr, (bf16_t*)(ws + (w ? WS_WOB : WS_WOA)) + (size_t)l * 1024 * 512, 512, kb * 64, nb * 64, scr, lane); continue; } r -= 2 * I_OA;
        if (r < I_OUT) { const int kb = r / 16, nb = r % 16;
            conv_item(in_ptr<I_WOUT>() + (size_t)l * DM * DM + nb * 64 + 4 * q16, DM, 4 * q16, 1, nullptr, (bf16_t*)(ws + WS_WOUT) + (size_t)l * DM * DM, DM, kb * 64, nb * 64, scr, lane); continue; } r -= I_OUT;
        if (r < I_13) { const int e = r / 512, rr = r % 512, kb = rr / 32, nb = rr % 32;
            const float* base = ((q16 < 8) ? in_ptr<I_W1>() : in_ptr<I_W3>()) + ((size_t)l * NEXP + e) * DM * DM + nb * 32 + 4 * (q16 & 7);
            bf16_t* const wt = (bf16_t*)(ws + WS_W13) + ((size_t)l * NEXP) * 2048 * DM;
            if (l == NLAYER - 1) conv_item<true>(base, DM, 8 * (q16 & 7) + (q16 >> 3), 2, nullptr, (bf16_t*)((unsigned char*)wt + (size_t)e * 2048 * DM), DM, kb * 64, nb * 64, scr, lane);
            else conv_item(base, DM, 8 * (q16 & 7) + (q16 >> 3), 2, nullptr, wt + (size_t)e * 2048 * DM, DM, kb * 64, nb * 64, scr, lane);
            continue; } r -= I_13;
        { const int e = r / 256, rr = r % 256, kb = rr / 16, nb = rr % 16;
            const float* const src2 = in_ptr<I_W2>() + ((size_t)l * NEXP + e) * DM * DM + nb * 64 + 4 * q16; bf16_t* const wt = (bf16_t*)(ws + WS_W2) + ((size_t)l * NEXP) * DM * DM;
            if (l == NLAYER - 1) conv_item<true>(src2, DM, 4 * q16, 1, nullptr, (bf16_t*)((unsigned char*)wt + (size_t)e * DM * DM), DM, kb * 64, nb * 64, scr, lane);
            else conv_item(src2, DM, 4 * q16, 1, nullptr, wt + (size_t)e * DM * DM, DM, kb * 64, nb * 64, scr, lane); }
    }
}
__device__ __forceinline__ void p0_ada(Frame& F) {
    if ((int)blockIdx.x >= 2 * 96) return;
    unsigned char* const ws = ws_ptr(); const float* const cin = in_ptr<I_C>(); const float* const cctx = in_ptr<I_CCTX>(); const float* const wada = in_ptr<I_WADA>(); const float* const bada = in_ptr<I_BADA>();
    LAS float* sct = (LAS float*)F.lds;
    LAS float* red = (LAS float*)(F.lds + 1024 * 20 * 4);
    for (int idx = F.tid; idx < 17 * 1024; idx += 512) { const int r = idx >> 10, d = idx & 1023; const float v = (r < 16) ? cin[r * DM + d] : cctx[d]; sct[d * 20 + r] = v * (1.0f / (1.0f + expf(-v))); }
    __syncthreads();
    float* MOD = (float*)(ws + WS_MOD);
    for (int task = blockIdx.x; task < 2 * 96; task += F.G) {
        const int l = task / 96, cb = task % 96, col = cb * 64 + F.lane;
        const float* wa = wada + (size_t)l * DM * NMODC + col;
        float acc[17];
#pragma unroll
        for (int r = 0; r < 17; ++r) acc[r] = 0.f;
        for (int k = F.wave * 128; k < F.wave * 128 + 128; ++k) { const float wv = wa[(size_t)k * NMODC];
#pragma unroll
            for (int r = 0; r < 17; ++r) acc[r] += sct[k * 20 + r] * wv; }
#pragma unroll
        for (int r = 0; r < 17; ++r) red[(F.wave * 17 + r) * 64 + F.lane] = acc[r];
        __syncthreads();
        for (int idx = F.tid; idx < 17 * 64; idx += 512) { const int r = idx >> 6, cl = idx & 63; float s = bada[l * NMODC + cb * 64 + cl];
#pragma unroll
            for (int w = 0; w < 8; ++w) s += red[(w * 17 + r) * 64 + cl];
            MOD[((size_t)l * 17 + r) * NMODC + cb * 64 + cl] = s; }
        __syncthreads();
    }
    if (blockIdx.x == 0) { float* rope = (float*)(ws + WS_ROPE); const int pos = F.tid >> 3, i = F.tid & 7;
        const float inv = exp2f(-(float)i * 0.125f * 13.287712379549449f);
        const float ang = (float)pos * inv; const float rev = ang * 0.15915494309189535f, fr = rev - floorf(rev); rope[pos * 8 + i] = __builtin_amdgcn_cosf(fr); rope[512 + pos * 8 + i] = __builtin_amdgcn_sinf(fr); }
}

__device__ __forceinline__ void load_row(const float* xrow, int lane, f32x4 (&v)[4]) {
#pragma unroll
    for (int j = 0; j < 4; ++j) v[j] = *((const f32x4*)xrow + lane + 64 * j);
}
__device__ __forceinline__ float row_rstd(const f32x4 (&v)[4]) {
    float s = 0.f;
#pragma unroll
    for (int j = 0; j < 4; ++j) s += (v[j][0] * v[j][0] + v[j][1] * v[j][1]) + (v[j][2] * v[j][2] + v[j][3] * v[j][3]);
    return rsqrtf(wave_sum(s) * (1.0f / DM) + RMS_EPS);
}
__device__ __forceinline__ void normmod(const f32x4 (&v)[4], float rstd, const float* g, const float* sh, const float* sc, int lane, f32x4 (&h)[4]) {
#pragma unroll
    for (int j = 0; j < 4; ++j) { const f32x4 gv = *((const f32x4*)g + lane + 64 * j), shv = *((const f32x4*)sh + lane + 64 * j), scv = *((const f32x4*)sc + lane + 64 * j);
        h[j] = v[j] * rstd * gv * (scv + 1.0f) + shv; }
}
__device__ __forceinline__ void store_row_bf16(bf16_t* orow, int lane, const f32x4 (&h)[4]) {
#pragma unroll
    for (int j = 0; j < 4; ++j) { u32x2 w; w.x = cvt_pk_bf16(h[j][0], h[j][1]); w.y = cvt_pk_bf16(h[j][2], h[j][3]); *((u32x2*)orow + lane + 64 * j) = w; }
}
__device__ __forceinline__ void p0_hrows(Frame& F) {
    unsigned char* const ws = ws_ptr(); const float* const xin = in_ptr<I_X>(); const float* const cxin = in_ptr<I_CTX>(); const float* const gmix = in_ptr<I_NMIXG>();
    const int gw = F.vcu * 8 + F.wave, NGW = F.G * 8; const float* MOD = (const float*)(ws + WS_MOD); bf16_t* H = (bf16_t*)(ws + WS_H);
    for (int t = gw; t < TALL; t += NGW) {
        const float* xr = (t < TX) ? xin + (size_t)t * DM : cxin + (size_t)(t - TX) * DM;
        const float* md = MOD + (size_t)((t < TX) ? (t >> 11) : 16) * NMODC;
        f32x4 v[4], h[4]; load_row(xr, F.lane, v); const float rstd = row_rstd(v);
        normmod(v, rstd, gmix, md, md + DM, F.lane, h); store_row_bf16(H + (size_t)t * DM, F.lane, h);
    }
}
__device__ __forceinline__ void stats_phase(Frame& F, int ntok) {
    unsigned char* const ws = ws_ptr();
    const int gw = F.vcu * 8 + F.wave, NGW = F.G * 8, lane = F.lane;
    const bf16_t* ZCQ = (const bf16_t*)(ws + WS_ZCQ); const bf16_t* ZCKV = (const bf16_t*)(ws + WS_ZCKV); const bf16_t* ZKR = (const bf16_t*)(ws + WS_ZKR);
    float* RSCQ = (float*)(ws + WS_RSCQ); float* RSCKV = (float*)(ws + WS_RSCKV); float* SSKR = (float*)(ws + WS_SSKR);
    for (int t = gw; t < ntok; t += NGW) {
        float a = 0.f, b = 0.f, c = 0.f;
        if (lane < 48) { const u32x4 w = *(const u32x4*)(ZCQ + (size_t)t * QLORA + 8 * lane); a = (bf_lo(w.x) * bf_lo(w.x) + bf_hi(w.x) * bf_hi(w.x)) + (bf_lo(w.y) * bf_lo(w.y) + bf_hi(w.y) * bf_hi(w.y)) + (bf_lo(w.z) * bf_lo(w.z) + bf_hi(w.z) * bf_hi(w.z)) + (bf_lo(w.w) * bf_lo(w.w) + bf_hi(w.w) * bf_hi(w.w)); }
        if (lane < 32) { const u32x4 w = *(const u32x4*)(ZCKV + (size_t)t * KVLORA + 8 * lane); b = (bf_lo(w.x) * bf_lo(w.x) + bf_hi(w.x) * bf_hi(w.x)) + (bf_lo(w.y) * bf_lo(w.y) + bf_hi(w.y) * bf_hi(w.y)) + (bf_lo(w.z) * bf_lo(w.z) + bf_hi(w.z) * bf_hi(w.z)) + (bf_lo(w.w) * bf_lo(w.w) + bf_hi(w.w) * bf_hi(w.w)); }
        if (lane < 4) { const u32x4 w = *(const u32x4*)(ZKR + (size_t)t * ROPED + 8 * lane); c = (bf_lo(w.x) * bf_lo(w.x) + bf_hi(w.x) * bf_hi(w.x)) + (bf_lo(w.y) * bf_lo(w.y) + bf_hi(w.y) * bf_hi(w.y)) + (bf_lo(w.z) * bf_lo(w.z) + bf_hi(w.z) * bf_hi(w.z)) + (bf_lo(w.w) * bf_lo(w.w) + bf_hi(w.w) * bf_hi(w.w)); }
        a = wave_sum(a); b = wave_sum(b); c = wave_sum(c);
        if (lane == 0) { RSCQ[t] = rsqrtf(a * (1.0f / QLORA) + RMS_EPS); RSCKV[t] = rsqrtf(b * (1.0f / KVLORA) + RMS_EPS); SSKR[t] = c; }
    }
}

__device__ __forceinline__ void route_phase(Frame& F, int l, int ntok) {
    unsigned char* const ws = ws_ptr(); const float* const xcur = out_ptr();
    LAS float* h2t = (LAS float*)F.lds;
    LAS float* part = (LAS float*)(F.lds + 65536);
    LAS float* logit = (LAS float*)(F.lds + 65536 + 32768);
    const float* MOD = (const float*)(ws + WS_MOD) + (size_t)l * 17 * NMODC; const float* XC = (const float*)(ws + WS_XC);
    const float* g = in_ptr<I_NFFNG>() + l * DM; const float* wr = in_ptr<I_WR>(); const float rbias = in_ptr<I_RB>()[F.lane];
    int* TOKE = (int*)(ws + WS_TOKE); float* TOKW = (float*)(ws + WS_TOKW); int* TOKP = (int*)(ws + WS_TOKP); float* RSTD2 = (float*)(ws + WS_RSTD2);
    unsigned* cnt = (unsigned*)(ws + WS_CTL) + CW_CNT + l * 2048;
    const int lane = F.lane, w = F.wave;
    float wv[128];
#pragma unroll
    for (int i = 0; i < 128; ++i) wv[i] = wr[(w * 128 + i) * NEXP + lane];
    for (int it = blockIdx.x; it < ntok / 16; it += F.G) {
        const int T0 = it * 16;
#pragma unroll
        for (int tt = 0; tt < 2; ++tt) { const int tl = 2 * w + tt, t = T0 + tl;
            const float* xr = (t < TX) ? xcur + (size_t)t * DM : XC + (size_t)(t - TX) * DM; const float* md = MOD + (size_t)((t < TX) ? (t >> 11) : 16) * NMODC;
            f32x4 v[4], h[4]; load_row(xr, lane, v); const float rstd = row_rstd(v); if (lane == 0) RSTD2[t] = rstd;
            normmod(v, rstd, g, md + 3 * DM, md + 4 * DM, lane, h);
#pragma unroll
            for (int j = 0; j < 4; ++j) *(LAS f32x4*)(h2t + tl * DM + 4 * lane + 256 * j) = h[j];
        }
        __syncthreads();
        { float acc[16];
#pragma unroll
          for (int t = 0; t < 16; ++t) acc[t] = 0.f;
#pragma unroll
          for (int gq = 0; gq < 32; ++gq) {
#pragma unroll
              for (int hf = 0; hf < 2; ++hf) {
                  f32x4 hv[8];
#pragma unroll
                  for (int t = 0; t < 8; ++t) hv[t] = *(const LAS f32x4*)(h2t + (8 * hf + t) * DM + w * 128 + 4 * gq);
#pragma unroll
                  for (int t = 0; t < 8; ++t)
#pragma unroll
                      for (int q = 0; q < 4; ++q) acc[8 * hf + t] += hv[t][q] * wv[4 * gq + q];
              }
          }
#pragma unroll
          for (int t = 0; t < 16; ++t) part[(w * 16 + t) * 64 + lane] = acc[t]; }
        __syncthreads();
#pragma unroll
        for (int k = 0; k < 2; ++k) { const int idx = F.tid + 512 * k, t = idx >> 6, e = idx & 63; float s = 0.f;
#pragma unroll
            for (int ww = 0; ww < 8; ++ww) s += part[(ww * 16 + t) * 64 + e];
            logit[t * 64 + e] = s; }
        __syncthreads();
#pragma unroll
        for (int tt = 0; tt < 2; ++tt) { const int tl = 2 * w + tt, t = T0 + tl;
            const float sg = 1.0f / (1.0f + expf(-logit[tl * 64 + lane])); const float bs = sg + rbias;
            float m1 = -3.0e38f, m2 = -3.0e38f; int i1 = 0, i2 = 0;
#pragma unroll
            for (int j = 0; j < 8; ++j) { const float vv = __shfl(bs, (lane & ~7) + j); if (vv > m1) { m2 = m1; i2 = i1; m1 = vv; i1 = j; } else if (vv > m2) { m2 = vv; i2 = j; } }
            const float gs = m1 + m2; float best = -3.0e38f; int gsel = 0;
#pragma unroll
            for (int j = 0; j < 8; ++j) { const float vv = __shfl(gs, 8 * j); if (vv > best) { best = vv; gsel = j; } }
            const int e1 = gsel * 8 + __shfl(i1, gsel * 8), e2 = gsel * 8 + __shfl(i2, gsel * 8);
            const float s1 = __shfl(sg, e1), s2 = __shfl(sg, e2), inv = 1.0f / (s1 + s2);
            if (lane == 0) { const int p1 = (int)atomicAdd(cnt + e1 * 16, 1u), p2 = (int)atomicAdd(cnt + e2 * 16, 1u);
                TOKE[2 * t] = e1; TOKE[2 * t + 1] = e2; TOKW[2 * t] = s1 * inv; TOKW[2 * t + 1] = s2 * inv; TOKP[2 * t] = p1; TOKP[2 * t + 1] = p2; }
        }
        __syncthreads();
    }
}
__device__ __forceinline__ void expert_offsets(Frame& F, unsigned char* ws, int l, LAS int* offl, bool publish) {
    if (F.wave == 0) {
        const unsigned c = __hip_atomic_load((unsigned*)(ws + WS_CTL) + CW_CNT + l * 2048 + F.lane * 16, RLX_AGENT);
        const int pad = (int)((c + 255u) & ~255u); int incl = pad;
#pragma unroll
        for (int o = 1; o < 64; o <<= 1) { const int v = __shfl_up(incl, o); if (F.lane >= o) incl += v; }
        offl[F.lane] = incl - pad; if (F.lane == 63) offl[64] = incl;
        if (publish) { int* TILEE = (int*)(ws + WS_TILEE); for (int t = (incl - pad) >> 8; t < (incl >> 8); ++t) TILEE[t] = F.lane; if (F.lane == 63) TILEE[511] = incl >> 8; }
    }
    __syncthreads();
}
__device__ __forceinline__ void scatter_phase(Frame& F, int l, int ntok, bool f8) {
    unsigned char* const ws = ws_ptr(); const float* const xcur = out_ptr();
    LAS int* offl = (LAS int*)(F.lds + 1024);
    expert_offsets(F, ws, l, offl, blockIdx.x == 0);
    const int gw = F.vcu * 8 + F.wave, NGW = F.G * 8, lane = F.lane;
    const float* MOD = (const float*)(ws + WS_MOD) + (size_t)l * 17 * NMODC; const float* XC = (const float*)(ws + WS_XC); const float* g = in_ptr<I_NFFNG>() + l * DM;
    const int* TOKE = (const int*)(ws + WS_TOKE); const int* TOKP = (const int*)(ws + WS_TOKP); const float* RSTD2 = (const float*)(ws + WS_RSTD2); bf16_t* HS = (bf16_t*)(ws + WS_HS);
    for (int t = gw; t < ntok; t += NGW) {
        const float* xr = (t < TX) ? xcur + (size_t)t * DM : XC + (size_t)(t - TX) * DM; const float* md = MOD + (size_t)((t < TX) ? (t >> 11) : 16) * NMODC;
        f32x4 v[4], h[4]; load_row(xr, lane, v); normmod(v, RSTD2[t], g, md + 3 * DM, md + 4 * DM, lane, h);
        const int s1 = offl[TOKE[2 * t]] + TOKP[2 * t], s2 = offl[TOKE[2 * t + 1]] + TOKP[2 * t + 1];
        if (f8) {
#pragma unroll
            for (int j = 0; j < 4; ++j) { const unsigned w = cvt_pk4_fp8(h[j][0] * F8_SH, h[j][1] * F8_SH, h[j][2] * F8_SH, h[j][3] * F8_SH);
                *((unsigned*)((unsigned char*)HS + (size_t)s1 * DM) + lane + 64 * j) = w; *((unsigned*)((unsigned char*)HS + (size_t)s2 * DM) + lane + 64 * j) = w; }
        } else { store_row_bf16(HS + (size_t)s1 * DM, lane, h); store_row_bf16(HS + (size_t)s2 * DM, lane, h); }
    }
}
__device__ __forceinline__ void combine_phase(Frame& F, int l, int ntok, bool last) {
    unsigned char* const ws = ws_ptr(); float* const xcur = out_ptr();
    LAS int* offl = (LAS int*)(F.lds + 1024);
    expert_offsets(F, ws, l, offl, false);
    const int gw = F.vcu * 8 + F.wave, NGW = F.G * 8, lane = F.lane;
    const float* MOD = (const float*)(ws + WS_MOD) + (size_t)l * 17 * NMODC; float* XC = (float*)(ws + WS_XC);
    const int* TOKE = (const int*)(ws + WS_TOKE); const int* TOKP = (const int*)(ws + WS_TOKP); const float* TOKW = (const float*)(ws + WS_TOKW);
    const bf16_t* YS = (const bf16_t*)(ws + WS_YS); bf16_t* H = (bf16_t*)(ws + WS_H);
    for (int t = gw; t < ntok; t += NGW) {
        float* xr = (t < TX) ? xcur + (size_t)t * DM : XC + (size_t)(t - TX) * DM; const int bi = (t < TX) ? (t >> 11) : 16; const float* md = MOD + (size_t)bi * NMODC;
        const int s1 = offl[TOKE[2 * t]] + TOKP[2 * t], s2 = offl[TOKE[2 * t + 1]] + TOKP[2 * t + 1]; const float w1 = TOKW[2 * t], w2 = TOKW[2 * t + 1];
        f32x4 v[4]; load_row(xr, lane, v);
#pragma unroll
        for (int j = 0; j < 4; ++j) { const u32x2 a = *((const u32x2*)(YS + (size_t)s1 * DM) + lane + 64 * j), b = *((const u32x2*)(YS + (size_t)s2 * DM) + lane + 64 * j);
            const f32x4 gf = *((const f32x4*)(md + 5 * DM) + lane + 64 * j);
            const f32x4 y = (f32x4){bf_lo(a.x), bf_hi(a.x), bf_lo(a.y), bf_hi(a.y)} * w1 + (f32x4){bf_lo(b.x), bf_hi(b.x), bf_lo(b.y), bf_hi(b.y)} * w2;
            v[j] = v[j] + gf * y; *((f32x4*)xr + lane + 64 * j) = v[j]; }
        if (!last) { const float* md2 = MOD + (size_t)17 * NMODC + (size_t)bi * NMODC; f32x4 h[4]; const float rstd = row_rstd(v);
            normmod(v, rstd, in_ptr<I_NMIXG>() + (l + 1) * DM, md2, md2 + DM, lane, h); store_row_bf16(H + (size_t)t * DM, lane, h); }
    }
}
constexpr int NPHASE = 2 + 11 * NLAYER;
struct Args { const float* in[26]; float* out; unsigned char* ws; int ph_lo, ph_hi; };

__device__ __attribute__((noinline)) void grid_barrier_fn(GAS unsigned* barw, unsigned x, LAS unsigned* st) { XcdBarrier b; b.bar = (unsigned*)barw; b.x = x; b.st = (volatile LAS unsigned*)st; xcd_barrier(b); }

__global__ void __launch_bounds__(512, 2) fwd_kernel(Args args) {
    extern __shared__ __attribute__((aligned(16))) unsigned char lds_raw[];
    Frame F;
    F.lds = (LAS unsigned char*)lds_raw;
    F.tid = threadIdx.x; F.lane = F.tid & 63; F.wave = __builtin_amdgcn_readfirstlane(F.tid >> 6);
    F.G = gridDim.x; { const int bx = blockIdx.x; F.vcu = (F.G % 8 == 0) ? (bx % 8) * (F.G / 8) + bx / 8 : bx; }
    volatile LAS unsigned* MISC = (volatile LAS unsigned*)(F.lds + MISC_OFF);
    if (F.tid < 64) MISC[F.tid] = 0u;
    __syncthreads();
    const int lo = args.ph_lo, hi = args.ph_hi;
#if MK_SPLIT
#define GRID_BAR() do { } while (0)
#else
    XcdBarrier bar = xcd_barrier_post((unsigned*)(ws_ptr() + WS_CTL) + CW_BAR, MISC + 8);
#define GRID_BAR() grid_barrier_fn((GAS unsigned*)bar.bar, bar.x, (LAS unsigned*)bar.st)
#endif
#ifndef PH_MASK
#define PH_MASK 0xFFFFFFFFu
#endif
#define PHK(k) ((k) < 2 ? (k) : 2 + ((k) - 2) % 11)
#define IN(k) (((PH_MASK >> PHK(k)) & 1u) && lo <= (k) && (k) < hi)
#ifndef PH_DUP
#define PH_DUP 0u
#endif
#define REP0(k) for (int rep_ = 0; rep_ < (((PH_DUP >> (k)) & 1u) ? 2 : 1); ++rep_)
#define REPL(n) for (int rep_ = 0; rep_ < ((((PH_DUP >> (2 + (n))) & 1u) && ((n) != 5 || l == 0)) ? 2 : 1); ++rep_)
#define SEAM(k) do { if (IN(k) && IN((k) + 1)) GRID_BAR(); } while (0)
#define FRESH() Frame Fp = F; int G = F.G, c = (int)blockIdx.x; asm volatile("" : "+v"(Fp.tid), "+v"(Fp.lane)); asm volatile("" : "+s"(Fp.wave), "+s"(Fp.vcu), "+s"(Fp.G), "+s"(G), "+s"(c))

    if (IN(0)) REP0(0) { FRESH(); (void)G; (void)c; p0_convert(Fp); __syncthreads(); p0_ada(Fp); }
    SEAM(0);
    if (IN(1)) REP0(1) { FRESH(); (void)G; (void)c; p0_hrows(Fp); }
    SEAM(1);

    for (int l = 0; l < NLAYER; ++l) {
        const int base = 2 + 11 * l; const bool last = (l == NLAYER - 1);
        const int mt_act = last ? MT_X : MT_ALL;
        const int ntok = last ? TX : TALL;
        if (IN(base + 0)) REPL(0) {
            FRESH(); unsigned char* const ws = ws_ptr();
            pg8::SchedRect S{(const char*)(ws + WS_H), (const char*)((bf16_t*)(ws + WS_WIN) + (size_t)l * INP * DM), (size_t)256 * DM * 2, mt_act, 17, G, c, MT_ALL - mt_act, 2, 7};
            pg8::EpiIn E{(bf16_t*)(ws + WS_QA), (bf16_t*)(ws + WS_KA), (bf16_t*)(ws + WS_VA), (bf16_t*)(ws + WS_ZCQ), (bf16_t*)(ws + WS_ZCKV), (bf16_t*)(ws + WS_ZKR), (bf16_t*)(ws + WS_GATES),
                         in_ptr<I_NAQG>() + l * 64, in_ptr<I_NAKG>() + l * 64};
            pg8::gemm_phase(Fp.lds, DM, S, E);
        }
        SEAM(base + 0);
        if (IN(base + 1)) REPL(1) { FRESH(); (void)G; (void)c; stats_phase(Fp, TALL); }
        SEAM(base + 1);
        if (IN(base + 2)) REPL(2) {
            FRESH();
            LAS float* const ropeL = (LAS float*)(Fp.lds + EPI_OFF + 8192);
            { const float* const rg = (const float*)(ws_ptr() + WS_ROPE); ropeL[Fp.tid] = rg[Fp.tid]; ropeL[512 + Fp.tid] = rg[512 + Fp.tid]; __syncthreads(); }
#ifndef NO_EQ
            { unsigned char* const ws = ws_ptr();
              pg8::SchedRect S{(const char*)(ws + WS_ZCQ), (const char*)((bf16_t*)(ws + WS_WUQ) + (size_t)l * 1024 * QLORA), (size_t)256 * QLORA * 2, mt_act, 4, G, c, 0, 0, 1};
              pg8::EpiQ E{(bf16_t*)(ws + WS_QB), (const float*)(ws + WS_RSCQ), in_ptr<I_QG>() + l * QKD, ropeL, (LAS float*)(Fp.lds + EPI_OFF)};
              pg8::gemm_phase(Fp.lds, QLORA, S, E); }
#endif
#ifndef NO_EKV
            { unsigned char* const ws = ws_ptr();
              pg8::SchedRect S{(const char*)(ws + WS_ZCKV), (const char*)((bf16_t*)(ws + WS_WUKV) + (size_t)l * 1024 * KVLORA), (size_t)256 * KVLORA * 2, MT_ALL, 4, G, c, 0, 0, 1};
              pg8::EpiKV E{(bf16_t*)(ws + WS_KB), (bf16_t*)(ws + WS_VB), (const bf16_t*)(ws + WS_ZKR), (const float*)(ws + WS_RSCKV), (const float*)(ws + WS_SSKR), in_ptr<I_KG>() + l * QKD, ropeL, (LAS float*)(Fp.lds + EPI_OFF)};
              pg8::gemm_phase(Fp.lds, KVLORA, S, E); }
#endif
        }
        SEAM(base + 2);
        if (IN(base + 3)) REPL(3) {
            FRESH(); (void)c;
            const float C64 = 0.125f * 1.4426950408889634f, C96 = 0.10206207261596575f * 1.4426950408889634f;
            for (int r2_ = 0; r2_ < (((PH_DUP >> 20) & 1u) ? 2 : 1); ++r2_)
            { unsigned char* const ws = ws_ptr();
              for (int u = Fp.vcu; u < 1024 + 256; u += G) {
                att::UnitArgs A; A.Q = (const bf16_t*)(ws + WS_QB); A.ldq = 768; A.K = (const bf16_t*)(ws + WS_KB); A.ldk = 768; A.V = (const bf16_t*)(ws + WS_VB); A.O = (bf16_t*)(ws + WS_OB);
                A.masked = 0; A.band = 0; A.krow0 = 0; A.bias = nullptr; A.C = C96;
                if (u < 1024) { const int bh = u >> 3, qb = u & 7, b = bh >> 3, h = bh & 7;
                    A.qcol = h * QKD; A.kcol = h * QKD; A.vcol = h * 64; A.ocol = h * 64; A.q0 = b * SEQ + qb * 256; A.ctx0 = TX + b * CTXL; A.loc0 = b * SEQ; A.NT = 36; }
                else { const int v = u - 1024; if (last || !(v & 1)) continue; const int bh = v >> 1, b = bh >> 3, h = bh & 7;
                    A.qcol = h * QKD; A.kcol = h * QKD; A.vcol = h * 64; A.ocol = h * 64; A.q0 = TX + b * CTXL; A.ctx0 = TX + b * CTXL; A.loc0 = 0; A.NT = 4; }
                att::attn_unit<96>(A, (char*)lds_raw);
              } }
            for (int r3_ = 0; r3_ < (((PH_DUP >> 21) & 1u) ? 2 : 1); ++r3_)
            { unsigned char* const ws = ws_ptr(); const float* const rpb = in_ptr<I_RPB>();
              att::na_mask_table((char*)lds_raw);
              for (int u = Fp.vcu; u < 1024 + 256; u += G) {
                att::UnitArgs A; A.Q = (const bf16_t*)(ws + WS_QA); A.ldq = 512; A.K = (const bf16_t*)(ws + WS_KA); A.ldk = 512; A.V = (const bf16_t*)(ws + WS_VA); A.O = (bf16_t*)(ws + WS_OA); A.C = C64;
                if (u < 1024) { const int bh = u >> 3, band = u & 7, b = bh >> 3, h = bh & 7;
                    A.qcol = h * 64; A.kcol = h * 64; A.vcol = h * 64; A.ocol = h * 64; A.q0 = b * SEQ + band * 256; A.ctx0 = TX + b * CTXL;
                    A.krow0 = min(max(4 * band - 4, 0), 20); A.loc0 = b * SEQ + 64 * A.krow0; A.NT = 10; A.masked = 1; A.band = band; A.bias = rpb + ((size_t)l * NHEAD + h) * 15 * 31; }
                else { const int v = u - 1024; if (last || (v & 1)) continue; const int bh = v >> 1, b = bh >> 3, h = bh & 7;
                    A.qcol = h * 64; A.kcol = h * 64; A.vcol = h * 64; A.ocol = h * 64; A.q0 = TX + b * CTXL; A.ctx0 = TX + b * CTXL; A.loc0 = 0; A.NT = 4; A.masked = 0; A.band = 0; A.krow0 = 0; A.bias = nullptr; }
                att::attn_unit<64>(A, (char*)lds_raw);
              } }
        }
        SEAM(base + 3);
        if (IN(base + 4)) REPL(4) {
            FRESH(); unsigned char* const ws = ws_ptr();
            pg8::SchedMerge S{(const char*)(ws + WS_OA), (const char*)(ws + WS_OB), (const char*)((bf16_t*)(ws + WS_WOA) + (size_t)l * 1024 * 512), (const char*)((bf16_t*)(ws + WS_WOB) + (size_t)l * 1024 * 512),
                              (size_t)256 * 512 * 2, mt_act, 4, G, c};
            pg8::EpiMerge E{(const bf16_t*)(ws + WS_GATES), (bf16_t*)(ws + WS_Y)};
            pg8::gemm_phase(Fp.lds, 512, S, E);
        }
        SEAM(base + 4);
        if (IN(base + 5)) REPL(5) {
            FRESH(); unsigned char* const ws = ws_ptr(); float* const outp = out_ptr();
            pg8::SchedRect S{(const char*)(ws + WS_Y), (const char*)((bf16_t*)(ws + WS_WOUT) + (size_t)l * DM * DM), (size_t)256 * DM * 2, mt_act, 4, G, c, 0, 0, 1};
            pg8::EpiOut E{(l == 0) ? in_ptr<I_X>() : (const float*)outp, outp, in_ptr<I_CTX>(), (float*)(ws + WS_XC), (const float*)(ws + WS_MOD) + (size_t)l * 17 * NMODC, 2 * DM};
            pg8::gemm_phase(Fp.lds, DM, S, E);
        }
        SEAM(base + 5);
        if (IN(base + 6)) REPL(6) { FRESH(); (void)G; (void)c; route_phase(Fp, l, ntok); }
        SEAM(base + 6);
        if (IN(base + 7)) REPL(7) { FRESH(); (void)G; (void)c; scatter_phase(Fp, l, ntok, last); }
        SEAM(base + 7);
        if (IN(base + 8)) REPL(8) {
            FRESH(); unsigned char* const ws = ws_ptr();
            LAS int* const tle = (LAS int*)(Fp.lds + EPI_OFF + 16384); tle[Fp.tid] = ld_i32_agent((const int*)(ws + WS_TILEE) + Fp.tid); __syncthreads();
            const int ntile = __builtin_amdgcn_readfirstlane(tle[511]);
            const char* const w13 = (const char*)((bf16_t*)(ws + WS_W13) + (size_t)l * NEXP * 2048 * DM);
#ifdef ONLY_BF16
            if (false) {} else
#endif
#ifdef ONLY_F8
            if (true)
#else
            if (last)
#endif
            { pg8::SchedMoe S{(const char*)(ws + WS_HS), w13, (size_t)256 * DM, (size_t)2048 * DM, (size_t)256 * DM, tle, ntile, 8, G, c};
                pg8::EpiMoe1<true> E{(bf16_t*)(ws + WS_HMID), 1.0f / (F8_SH * F8_SW)};
                pg8::gemm_phase<true>(Fp.lds, DM / 2, S, E); }
            else { pg8::SchedMoe S{(const char*)(ws + WS_HS), w13, (size_t)256 * DM * 2, (size_t)2048 * DM * 2, (size_t)256 * DM * 2, tle, ntile, 8, G, c};
                pg8::EpiMoe1<false> E{(bf16_t*)(ws + WS_HMID), 1.0f};
                pg8::gemm_phase(Fp.lds, DM, S, E); }
        }
        SEAM(base + 8);
        if (IN(base + 9)) REPL(9) {
            FRESH(); unsigned char* const ws = ws_ptr();
            LAS int* const tle = (LAS int*)(Fp.lds + EPI_OFF + 16384); tle[Fp.tid] = ld_i32_agent((const int*)(ws + WS_TILEE) + Fp.tid); __syncthreads();
            const int ntile = __builtin_amdgcn_readfirstlane(tle[511]);
            const char* const w2 = (const char*)((bf16_t*)(ws + WS_W2) + (size_t)l * NEXP * DM * DM);
            if (last) { pg8::SchedMoe S{(const char*)(ws + WS_HMID), w2, (size_t)256 * DM, (size_t)DM * DM, (size_t)256 * DM, tle, ntile, 4, G, c};
                pg8::EpiMoe2 E{(bf16_t*)(ws + WS_YS), 1.0f / (F8_SM * F8_SW)};
                pg8::gemm_phase<true>(Fp.lds, DM / 2, S, E); }
            else { pg8::SchedMoe S{(const char*)(ws + WS_HMID), w2, (size_t)256 * DM * 2, (size_t)DM * DM * 2, (size_t)256 * DM * 2, tle, ntile, 4, G, c};
                pg8::EpiMoe2 E{(bf16_t*)(ws + WS_YS), 1.0f};
                pg8::gemm_phase(Fp.lds, DM, S, E); }
        }
        SEAM(base + 9);
        if (IN(base + 10)) REPL(10) { FRESH(); (void)G; (void)c; combine_phase(Fp, l, ntok, last); }
        if (!last) SEAM(base + 10);
    }
#undef IN
#undef SEAM
#undef GRID_BAR
}

extern "C" void kernel_launch(void* const* d_in, const int* in_sizes, int n_in, void* d_out, int out_size, void* d_ws, size_t ws_size, hipStream_t stream) {
    static int grid = 0;
    if (grid == 0) {
        if (n_in != 26 || out_size != TX * DM || ws_size < WS_END) { fprintf(stderr, "kernel_launch: unexpected problem (n_in %d, out %d, ws %zu < %zu); nothing launched\n", n_in, out_size, ws_size, (size_t)WS_END); grid = -1; return; }
        int dev = 0, cus = 0, per_cu = 0;
        if (hipGetDevice(&dev) != hipSuccess || hipDeviceGetAttribute(&cus, hipDeviceAttributeMultiprocessorCount, dev) != hipSuccess) { grid = -1; return; }
        if (hipFuncSetAttribute((const void*)fwd_kernel, hipFuncAttributeMaxDynamicSharedMemorySize, LDS_BYTES) != hipSuccess) { fprintf(stderr, "kernel_launch: hipFuncSetAttribute failed\n"); grid = -1; return; }
        if (hipOccupancyMaxActiveBlocksPerMultiprocessor(&per_cu, (const void*)fwd_kernel, 512, LDS_BYTES) != hipSuccess || per_cu < 1) fprintf(stderr, "kernel_launch: occupancy query reports %d blocks per CU\n", per_cu);
        (void)hipGetLastError();
        grid = cus;
    }
    if (grid < 0) return;
    (void)in_sizes;
    (void)hipMemsetAsync((char*)d_ws + WS_CTL, 0, CTL_BYTES, stream);
    Args a{};
    for (int i = 0; i < 26; ++i) a.in[i] = (const float*)d_in[i];
    a.out = (float*)d_out; a.ws = (unsigned char*)d_ws;
#if MK_SPLIT
    for (int p = 0; p < NPHASE; ++p) { a.ph_lo = p; a.ph_hi = p + 1; hipLaunchKernelGGL(fwd_kernel, dim3(grid), dim3(512), LDS_BYTES, stream, a); }
#else
    a.ph_lo = 0; a.ph_hi = NPHASE;
    hipLaunchKernelGGL(fwd_kernel, dim3(grid), dim3(512), LDS_BYTES, stream, a);
#endif
    const hipError_t le = hipPeekAtLastError();
    if (le != hipSuccess) fprintf(stderr, "kernel_launch: launch failed: %s\n", hipGetErrorName(le));
}
```

```cpp
#include <hip/hip_runtime.h>
#include <hip/hip_bf16.h>
#include <cstdio>
#include <cstdint>

#ifndef MK_SPLIT
#define MK_SPLIT 0
#endif

#define LAS __attribute__((address_space(3)))
#define GAS __attribute__((address_space(1)))
typedef unsigned short bf16_t;
typedef short bf16x8 __attribute__((ext_vector_type(8)));
typedef short s16x4 __attribute__((ext_vector_type(4)));
typedef float f32x4 __attribute__((ext_vector_type(4)));
typedef float f32x2 __attribute__((ext_vector_type(2)));
typedef float f32x16 __attribute__((ext_vector_type(16)));
typedef unsigned u32x4 __attribute__((ext_vector_type(4)));
typedef unsigned u32x2 __attribute__((ext_vector_type(2)));
#define RLX_AGENT __ATOMIC_RELAXED, __HIP_MEMORY_SCOPE_AGENT

constexpr int DM = 1024, NB = 16, SEQ = 2048, TX = NB * SEQ, CTXL = 256, TC = NB * CTXL, TALL = TX + TC;
constexpr int NHEAD = 8, GRIDW = 64;
constexpr int INC = 4256, INP = 4352;
constexpr int NEXP = 64, NMODC = 6 * DM;
constexpr int QLORA = 384, KVLORA = 256, QKD = 96, ROPED = 32;
constexpr int MT_X = TX / 256, MT_ALL = TALL / 256;
constexpr int NSLOT_MAX = 2 * TALL + NEXP * 256;
constexpr float RMS_EPS = 1e-6f;
constexpr int NLAYER = 2;
constexpr float F8_SW = 64.f, F8_SH = 16.f, F8_SM = 4.f;

constexpr size_t al256(size_t x) { return (x + 255) & ~(size_t)255; }
constexpr size_t WS_CTL = 0, CTL_BYTES = 1u << 20;
constexpr size_t WS_MOD   = WS_CTL + CTL_BYTES;
constexpr size_t WS_ROPE  = WS_MOD + al256((size_t)NLAYER * 17 * NMODC * 4);
constexpr size_t WS_RSCQ  = WS_ROPE + al256(64 * 8 * 2 * 4);
constexpr size_t WS_RSCKV = WS_RSCQ + al256((size_t)TALL * 4);
constexpr size_t WS_SSKR  = WS_RSCKV + al256((size_t)TALL * 4);
constexpr size_t WS_TOKE  = WS_SSKR + al256((size_t)TALL * 4);
constexpr size_t WS_TOKW  = WS_TOKE + al256((size_t)TALL * 8);
constexpr size_t WS_TOKP  = WS_TOKW + al256((size_t)TALL * 8);
constexpr size_t WS_RSTD2 = WS_TOKP + al256((size_t)TALL * 8);
constexpr size_t WS_TILEE = WS_RSTD2 + al256((size_t)TALL * 8);
constexpr size_t WS_OFFS  = WS_TILEE + al256(512 * 4);
constexpr size_t WS_PART6 = WS_OFFS + al256(128 * 4);
constexpr size_t WS_PART7 = WS_PART6 + al256((size_t)TALL * 4 * 4);
constexpr size_t WS_PART8 = WS_PART7 + al256((size_t)TALL * 8 * 4);
constexpr size_t WS_WIN   = WS_PART8 + al256((size_t)TALL * 4 * 4);
constexpr size_t WS_WUQ   = WS_WIN + al256((size_t)NLAYER * INP * DM * 2);
constexpr size_t WS_WUKV  = WS_WUQ + al256((size_t)NLAYER * 1024 * QLORA * 2);
constexpr size_t WS_WOA   = WS_WUKV + al256((size_t)NLAYER * 1024 * KVLORA * 2);
constexpr size_t WS_WOB   = WS_WOA + al256((size_t)NLAYER * 1024 * 512 * 2);
constexpr size_t WS_WOUT  = WS_WOB + al256((size_t)NLAYER * 1024 * 512 * 2);
constexpr size_t WS_W13   = WS_WOUT + al256((size_t)NLAYER * 1024 * 1024 * 2);
constexpr size_t WS_W2    = WS_W13 + al256((size_t)NLAYER * NEXP * 2048 * 1024 * 2);
constexpr size_t WS_H     = WS_W2 + al256((size_t)NLAYER * NEXP * 1024 * 1024 * 2);
constexpr size_t WS_XC    = WS_H + al256((size_t)TALL * DM * 2);
constexpr size_t WS_ACT   = WS_XC + al256((size_t)TC * DM * 4);
constexpr size_t WS_QA    = WS_ACT;
constexpr size_t WS_KA    = WS_QA + al256((size_t)TALL * 512 * 2);
constexpr size_t WS_VA    = WS_KA + al256((size_t)TALL * 512 * 2);
constexpr size_t WS_ZCQ   = WS_VA + al256((size_t)TALL * 512 * 2);
constexpr size_t WS_ZCKV  = WS_ZCQ + al256((size_t)TALL * QLORA * 2);
constexpr size_t WS_ZKR   = WS_ZCKV + al256((size_t)TALL * KVLORA * 2);
constexpr size_t WS_GATES = WS_ZKR + al256((size_t)TALL * ROPED * 2);
constexpr size_t WS_QB    = WS_GATES + al256((size_t)TALL * 2048 * 2);
constexpr size_t WS_KB    = WS_QB + al256((size_t)TALL * 768 * 2);
constexpr size_t WS_VB    = WS_KB + al256((size_t)TALL * 768 * 2);
constexpr size_t WS_OA    = WS_VB + al256((size_t)TALL * 512 * 2);
constexpr size_t WS_OB    = WS_OA + al256((size_t)TALL * 512 * 2);
constexpr size_t WS_Y     = WS_OB + al256((size_t)TALL * 512 * 2);
constexpr size_t WS_MIX_END = WS_Y + al256((size_t)TALL * DM * 2);
constexpr size_t WS_HS    = WS_ACT;
constexpr size_t WS_HMID  = WS_HS + al256((size_t)NSLOT_MAX * DM * 2);
constexpr size_t WS_YS    = WS_HMID + al256((size_t)NSLOT_MAX * DM * 2);
constexpr size_t WS_MOE_END = WS_YS + al256((size_t)NSLOT_MAX * DM * 2);
constexpr size_t WS_END   = (WS_MIX_END > WS_MOE_END) ? WS_MIX_END : WS_MOE_END;

constexpr int CW_BAR = 4096;
constexpr int CW_CNT = 16384;

constexpr int RING_BYTES = 131072;
constexpr int EPI_OFF = RING_BYTES;
constexpr int MISC_OFF = RING_BYTES + 24576;
constexpr int LDS_BYTES = 160 * 1024;

__device__ __forceinline__ unsigned cvt_pk_bf16(float lo, float hi) { unsigned r; asm volatile("v_cvt_pk_bf16_f32 %0, %1, %2" : "=v"(r) : "v"(lo), "v"(hi)); return r; }
__device__ __forceinline__ unsigned cvt_pk4_fp8(float a, float b, float c, float d) {
    a = __builtin_amdgcn_fmed3f(a, -448.f, 448.f); b = __builtin_amdgcn_fmed3f(b, -448.f, 448.f); c = __builtin_amdgcn_fmed3f(c, -448.f, 448.f); d = __builtin_amdgcn_fmed3f(d, -448.f, 448.f);
    int w = 0; w = __builtin_amdgcn_cvt_pk_fp8_f32(a, b, w, false); w = __builtin_amdgcn_cvt_pk_fp8_f32(c, d, w, true); return (unsigned)w; }
__device__ __forceinline__ float bf_lo(unsigned w) { return __uint_as_float(w << 16); }
__device__ __forceinline__ float bf_hi(unsigned w) { return __uint_as_float(w & 0xffff0000u); }
__device__ __forceinline__ float wave_sum(float v) {
#pragma unroll
    for (int o = 1; o < 64; o <<= 1) v += __shfl_xor(v, o);
    return v;
}
__device__ __forceinline__ float sigmoidf_(float x) { return __builtin_amdgcn_rcpf(1.0f + __expf(-x)); }
__device__ __forceinline__ int ld_i32_agent(const int* p) { return (int)__hip_atomic_load((const unsigned*)p, RLX_AGENT); }
#define XB_TMO      128
#define XB_XCNT(j)  (256  + 64 * (j))
#define XB_XSUB(j)  (1280 + 64 * (j))
#define XB_XGEN(j)  (2304 + 64 * (j))
#define XB_TOP      3328
#define XB_TOPGEN   3392
#define XCD_BAR_WORDS 3456
#define XB_SPIN_CAP (1u << 18)

__device__ __forceinline__ unsigned xb_ld(unsigned* p)              { return __hip_atomic_load(p, __ATOMIC_RELAXED, __HIP_MEMORY_SCOPE_AGENT); }
__device__ __forceinline__ unsigned xb_add(unsigned* p, unsigned v) { return __hip_atomic_fetch_add(p, v, __ATOMIC_RELAXED, __HIP_MEMORY_SCOPE_AGENT); }
__device__ __forceinline__ unsigned xb_xcc_id() { return (unsigned)__builtin_amdgcn_s_getreg((3 << 11) | 20) & 0xFu; }
#define XB_SPIN(cond, bar) do { unsigned _sp = 0; while (cond) { __builtin_amdgcn_s_sleep(1); \
    if ((++_sp & 255u) == 0u) { if (xb_ld(&(bar)[XB_TMO])) break; if (_sp > XB_SPIN_CAP) { atomicAdd(&(bar)[XB_TMO], 1u); break; } } } } while (0)

struct XcdBarrier {
    unsigned* bar; unsigned x;
    volatile LAS unsigned* st;
};

__device__ __forceinline__ XcdBarrier xcd_barrier_post(unsigned* bar, volatile LAS unsigned* st) {
    XcdBarrier b; b.bar = bar; b.x = xb_xcc_id(); b.st = st;
    if (threadIdx.x == 0) (void)xb_add(&bar[XB_XCNT(b.x)], 1u);
    return b;
}
__device__ __forceinline__ void xcd_barrier_complete(unsigned* bar, unsigned x, unsigned& nloc, unsigned& nx) {
    const unsigned G = gridDim.x * gridDim.y * gridDim.z;
    unsigned sum, cnt, mine, sp = 0u;
    for (;;) {
        sum = 0u; cnt = 0u; mine = 0u;
#pragma unroll
        for (unsigned j = 0; j < 16; ++j) { const unsigned c = xb_ld(&bar[XB_XCNT(j)]); sum += c; cnt += (c > 0u) ? 1u : 0u; mine = (j == x) ? c : mine; }
        if (sum == G) break;
        __builtin_amdgcn_s_sleep(1);
        if ((++sp & 255u) == 0u) { if (xb_ld(&bar[XB_TMO])) break; if (sp > XB_SPIN_CAP) { atomicAdd(&bar[XB_TMO], 1u); break; } }
    }
    nloc = mine > 0u ? mine : 1u; nx = cnt > 0u ? cnt : 1u;
}

__device__ __forceinline__ void xcd_barrier(const XcdBarrier& b) {
    asm volatile("s_waitcnt vmcnt(0)" ::: "memory");
    __syncthreads();
    if (threadIdx.x == 0) {
        unsigned* bar = b.bar;
        __builtin_amdgcn_s_waitcnt(0);
        unsigned nloc = b.st[0], nx = b.st[1];
        if (nloc == 0u) { xcd_barrier_complete(bar, b.x, nloc, nx); b.st[0] = nloc; b.st[1] = nx; }
        const unsigned old = xb_add(&bar[XB_XSUB(b.x)], 1u);
        const unsigned gen = old / nloc;
        if (old + 1u == (gen + 1u) * nloc) {
            __builtin_amdgcn_fence(__ATOMIC_RELEASE, "agent");
            asm volatile("s_waitcnt vmcnt(0)" ::: "memory");
            const unsigned og = xb_add(&bar[XB_TOP], 1u);
            const unsigned tg = og / nx;
            if (og + 1u == (tg + 1u) * nx) xb_add(&bar[XB_TOPGEN], 1u);
            else XB_SPIN(xb_ld(&bar[XB_TOPGEN]) == tg, bar);
            __builtin_amdgcn_fence(__ATOMIC_ACQUIRE, "agent");
            xb_add(&bar[XB_XGEN(b.x)], 1u);
            asm volatile("s_waitcnt vmcnt(0)" ::: "memory");
        } else {
            XB_SPIN(xb_ld(&bar[XB_XGEN(b.x)]) == gen, bar);
            __builtin_amdgcn_fence(__ATOMIC_ACQUIRE, "agent");
            asm volatile("s_waitcnt vmcnt(0)" ::: "memory");
        }
    }
    __syncthreads();
}

namespace pg8 {
constexpr int BM = 256, BK = 64, HALF = 128, HTB = HALF * BK * 2  , STAGE_BYTES = 8 * HTB, NXCD = 8, WGM = 8;
__host__ __device__ __forceinline__ int lds_byte(int r, int c) { const int st = (r >> 4) * 2 + (c >> 5), rr = r & 15, cc = c & 31, ob = rr * 64 + cc * 2; return st * 1024 + (ob ^ (((ob >> 9) & 1) << 5)); }
__host__ __device__ __forceinline__ void stage_rc(int b, int& R, int& C) { const int st = b / 1024, sb = b % 1024, swz = sb ^ (((sb >> 9) & 1) << 5); R = (st >> 1) * 16 + swz / 64; C = (st & 1) * 32 + (swz % 64) / 2; }
__host__ __device__ __forceinline__ int perm32(int rho) { const int n = rho >> 4, i = rho & 15; return 8 * (i >> 2) + 4 * n + (i & 3); }

struct Unit { int pm, pn, kind, e; };

__device__ __forceinline__ void rect_tile(int wgid_in, int nM, int nN, int& pm, int& pn) {
    const int nwg = nM * nN; int wgid = wgid_in;
    { const int q = nwg / NXCD, r = nwg % NXCD, xcd = wgid % NXCD, off = wgid / NXCD; wgid = (xcd < r ? xcd * (q + 1) : r * (q + 1) + (xcd - r) * q) + off; }
    const int nig = WGM * nN, gid = wgid / nig, fm = gid * WGM, gsz = (nM - fm) < WGM ? (nM - fm) : WGM;
    pm = fm + ((wgid % nig) % gsz); pn = (wgid % nig) / gsz;
}

typedef int i32x8 __attribute__((ext_vector_type(8)));
template <bool F8 = false, class Epi, class Sched>
__device__ __forceinline__ void gemm_phase(LAS unsigned char* lds, const int K, const Sched& S, const Epi& E) {
    int tid = threadIdx.x; asm volatile("" : "+v"(tid));
    const int wid = __builtin_amdgcn_readfirstlane(tid >> 6), lane = tid & 63, wr = wid >> 2, wc = wid & 3, fr = lane & 15, fq = lane >> 4;
    const int nt = K / BK;
    unsigned voffA[2], voffB[2];
#pragma unroll
    for (int i = 0; i < 2; ++i) { int R, C; stage_rc(tid * 16 + i * 8192, R, C); const int Rb = Epi::PERM ? ((R & ~31) + perm32(R & 31)) : R;
        voffA[i] = (unsigned)(R * K + C) * 2u; voffB[i] = (unsigned)(Rb * K + C) * 2u; }
    const size_t kstep = (size_t)(BK * 2);
    const size_t hstep = (size_t)HALF * K * 2;
    const unsigned ldsw = (unsigned)wid * 1024u;
    const int aoff = lds_byte(wr * 64 + fr, F8 ? fq * 16 : fq * 8), boff = lds_byte(wc * 32 + fr, F8 ? fq * 16 : fq * 8);
    constexpr int KSTEP = F8 ? 16 : 1024;
    int f8scale = 0x7F7F7F7F; asm volatile("" : "+v"(f8scale));
#define PG8_SA(b, h) (((b) * 2 + (h)) * HTB)
#define PG8_SB(b, h) ((4 + (b) * 2 + (h)) * HTB)
#define PG8_STAGE(bufoff, gbase, voff) do { _Pragma("unroll") for (int _i = 0; _i < 2; ++_i) \
        __builtin_amdgcn_global_load_lds((const unsigned*)((const char*)(gbase) + (voff)[_i]), (LAS unsigned*)(lds + (bufoff) + ldsw + _i * 8192), 16, 0, 0); } while (0)
#define PG8_LDA(dst, b, h) do { _Pragma("unroll") for (int m = 0; m < 4; ++m) _Pragma("unroll") for (int k = 0; k < 2; ++k) dst[m][k] = *(const LAS bf16x8*)(lds + PG8_SA(b, h) + aoff + m * 2048 + k * KSTEP); } while (0)
#define PG8_LDB(dst, b, h) do { _Pragma("unroll") for (int n = 0; n < 2; ++n) _Pragma("unroll") for (int k = 0; k < 2; ++k) dst[n][k] = *(const LAS bf16x8*)(lds + PG8_SB(b, h) + boff + n * 2048 + k * KSTEP); } while (0)
#define PG8_CAT(X) __builtin_shufflevector(__builtin_bit_cast(u32x4, (X)[0]), __builtin_bit_cast(u32x4, (X)[1]), 0, 1, 2, 3, 4, 5, 6, 7)
#define PG8_MMA(ai, bj, At, Bt) do { __builtin_amdgcn_s_setprio(1); \
        if constexpr (F8) { _Pragma("unroll") for (int m = 0; m < 4; ++m) _Pragma("unroll") for (int n = 0; n < 2; ++n) \
            asm volatile("v_mfma_scale_f32_16x16x128_f8f6f4 %0, %1, %2, %0, %3, %3 op_sel_hi:[0,0,0]" : "+v"(acc[ai][bj][m][n]) : "v"(__builtin_bit_cast(i32x8, PG8_CAT(Bt[n]))), "v"(__builtin_bit_cast(i32x8, PG8_CAT(At[m]))), "v"(f8scale)); } \
        else { _Pragma("unroll") for (int m = 0; m < 4; ++m) _Pragma("unroll") for (int n = 0; n < 2; ++n) _Pragma("unroll") for (int k = 0; k < 2; ++k) \
            acc[ai][bj][m][n] = __builtin_amdgcn_mfma_f32_16x16x32_bf16(Bt[n][k], At[m][k], acc[ai][bj][m][n], 0, 0, 0); } \
        __builtin_amdgcn_s_setprio(0); } while (0)
#define PG8_WAIT_V(n) asm volatile("s_waitcnt vmcnt(" #n ")" ::: "memory")
#define PG8_WAIT_L(n) asm volatile("s_waitcnt lgkmcnt(" #n ")" ::: "memory")
#define PG8_BAR __builtin_amdgcn_s_barrier()
#define PG8_SCHED __builtin_amdgcn_sched_barrier(0)
    Unit cur, nxt; int ui = 0;
    if (!S.next(0, cur)) return;
    f32x4 acc[2][2][4][2];
#pragma unroll
    for (int a = 0; a < 2; ++a)
#pragma unroll
        for (int b = 0; b < 2; ++b)
#pragma unroll
            for (int m = 0; m < 4; ++m)
#pragma unroll
                for (int n = 0; n < 2; ++n) acc[a][b][m][n] = (f32x4){0.f, 0.f, 0.f, 0.f};
    bf16x8 At[4][2], B0[2][2], B1[2][2];
    const char* cA = S.a_ptr(cur); const char* cB = S.b_ptr(cur);
    PG8_STAGE(PG8_SB(0, 0), cB, voffB); PG8_STAGE(PG8_SB(0, 1), cB + hstep, voffB); PG8_STAGE(PG8_SA(0, 0), cA, voffA); PG8_STAGE(PG8_SA(0, 1), cA + hstep, voffA);
    if (wr == 1) PG8_BAR;
    PG8_WAIT_V(2); PG8_BAR;
    PG8_STAGE(PG8_SB(1, 0), cB + kstep, voffB); PG8_STAGE(PG8_SA(1, 0), cA + kstep, voffA); PG8_STAGE(PG8_SB(1, 1), cB + hstep + kstep, voffB);
    PG8_WAIT_V(6); PG8_BAR;
    for (;;) {
        const bool has_next = S.next(ui + 1, nxt);
        const char* nA = has_next ? S.a_ptr(nxt) : cA; const char* nB = has_next ? S.b_ptr(nxt) : cB;
#pragma unroll 1
        for (int t = 0; t < nt; t += 2) {
            const bool last = (t == nt - 2);
            const char* a1 = cA + (size_t)(t + 1) * kstep;
            const char* a2 = last ? nA : cA + (size_t)(t + 2) * kstep; const char* b2 = last ? nB : cB + (size_t)(t + 2) * kstep;
            const char* a3 = a2 + kstep; const char* b3 = b2 + kstep;
            PG8_LDB(B0, 0, 0); PG8_LDB(B1, 0, 1); PG8_SCHED; PG8_LDA(At, 0, 0); PG8_STAGE(PG8_SA(1, 1), a1 + hstep, voffA);
            PG8_WAIT_V(8); PG8_WAIT_L(0); PG8_BAR; PG8_MMA(0, 0, At, B0); PG8_MMA(0, 1, At, B1); PG8_BAR; PG8_SCHED;
            PG8_LDA(At, 0, 1); PG8_STAGE(PG8_SB(0, 0), b2, voffB); PG8_STAGE(PG8_SB(0, 1), b2 + hstep, voffB); PG8_STAGE(PG8_SA(0, 0), a2, voffA);
            PG8_WAIT_V(8); PG8_WAIT_L(0); PG8_BAR; PG8_MMA(1, 0, At, B0); PG8_MMA(1, 1, At, B1); PG8_BAR; PG8_SCHED;
            PG8_LDB(B0, 1, 0); PG8_LDB(B1, 1, 1); PG8_SCHED; PG8_LDA(At, 1, 0); PG8_STAGE(PG8_SA(0, 1), a2 + hstep, voffA);
            PG8_WAIT_V(8); PG8_WAIT_L(0); PG8_BAR; PG8_MMA(0, 0, At, B0); PG8_MMA(0, 1, At, B1); PG8_BAR; PG8_SCHED;
            PG8_LDA(At, 1, 1); PG8_STAGE(PG8_SB(1, 0), b3, voffB); PG8_STAGE(PG8_SB(1, 1), b3 + hstep, voffB); PG8_STAGE(PG8_SA(1, 0), a3, voffA);
            PG8_WAIT_V(8); PG8_WAIT_L(0); PG8_BAR; PG8_MMA(1, 0, At, B0); PG8_MMA(1, 1, At, B1); PG8_BAR; PG8_SCHED;
        }
        if (wr == 0) PG8_BAR;
        if constexpr (F8) asm volatile("s_nop 15\n\ts_nop 7" ::: "memory");
        { int tz = threadIdx.x; asm volatile("" : "+v"(tz));
          const int wid2 = __builtin_amdgcn_readfirstlane(tz >> 6), lane2 = tz & 63; E(acc, cur, wid2 >> 2, wid2 & 3, lane2 & 15, lane2 >> 4); }
        if (!has_next) break;
        if (!(Epi::CHAIN && cur.kind == 0)) {
#pragma unroll
            for (int a = 0; a < 2; ++a)
#pragma unroll
                for (int b = 0; b < 2; ++b)
#pragma unroll
                    for (int m = 0; m < 4; ++m)
#pragma unroll
                        for (int n = 0; n < 2; ++n) acc[a][b][m][n] = (f32x4){0.f, 0.f, 0.f, 0.f};
        }
        cur = nxt; cA = nA; cB = nB; ++ui;
        if (wr == 1) PG8_BAR;
    }
    PG8_WAIT_V(0);
    PG8_BAR;
#undef PG8_SA
#undef PG8_SB
#undef PG8_STAGE
#undef PG8_LDA
#undef PG8_LDB
#undef PG8_MMA
#undef PG8_CAT
#undef PG8_WAIT_V
#undef PG8_WAIT_L
#undef PG8_BAR
#undef PG8_SCHED
}
}
namespace pg8 {
__device__ __forceinline__ u32x4 pack8(const f32x4 a, const f32x4 b) { u32x4 w; w.x = cvt_pk_bf16(a[0], a[1]); w.y = cvt_pk_bf16(a[2], a[3]); w.z = cvt_pk_bf16(b[0], b[1]); w.w = cvt_pk_bf16(b[2], b[3]); return w; }
__device__ __forceinline__ float sumsq4(const f32x4 a) { return (a[0] * a[0] + a[1] * a[1]) + (a[2] * a[2] + a[3] * a[3]); }
#define EPI_BAR() do { asm volatile("s_waitcnt lgkmcnt(0)" ::: "memory"); __builtin_amdgcn_s_barrier(); asm volatile("" ::: "memory"); } while (0)

struct EpiIn {
    static constexpr bool PERM = true, CHAIN = false;
    bf16_t *QA, *KA, *VA, *ZCQ, *ZCKV, *ZKR, *GATES; const float *qg, *kg; float *P6, *P7, *P8;
    __device__ __forceinline__ void operator()(f32x4 (&acc)[2][2][4][2], const Unit& u, int wr, int wc, int fr, int fq) const {
        const int row0 = u.pm * BM + wr * 64 + fr, pn = u.pn;
        if (pn < 4) {
            const float* g = (pn < 2) ? qg : kg; bf16_t* dst = (pn < 2) ? QA : KA; const int head = 4 * (pn & 1) + wc;
            f32x4 gv[2][2];
#pragma unroll
            for (int bj = 0; bj < 2; ++bj)
#pragma unroll
                for (int n = 0; n < 2; ++n) gv[bj][n] = *(const f32x4*)(g + 32 * bj + 8 * fq + 4 * n);
#pragma unroll
            for (int ai = 0; ai < 2; ++ai)
#pragma unroll
                for (int m = 0; m < 4; ++m) {
                    const size_t row = (size_t)(row0 + ai * HALF + m * 16);
                    float ss = (sumsq4(acc[ai][0][m][0]) + sumsq4(acc[ai][0][m][1])) + (sumsq4(acc[ai][1][m][0]) + sumsq4(acc[ai][1][m][1]));
                    ss += __shfl_xor(ss, 16); ss += __shfl_xor(ss, 32);
                    const float rstd = rsqrtf(ss * (1.0f / 64.0f) + RMS_EPS);
#pragma unroll
                    for (int bj = 0; bj < 2; ++bj)
                        *(u32x4*)(dst + row * 512 + head * 64 + 32 * bj + 8 * fq) = pack8(acc[ai][bj][m][0] * rstd * gv[bj][0], acc[ai][bj][m][1] * rstd * gv[bj][1]);
                }
        } else if (pn >= 9) {
#pragma unroll
            for (int ai = 0; ai < 2; ++ai)
#pragma unroll
                for (int m = 0; m < 4; ++m) {
                    const size_t row = (size_t)(row0 + ai * HALF + m * 16);
#pragma unroll
                    for (int bj = 0; bj < 2; ++bj) { f32x4 a = acc[ai][bj][m][0], b = acc[ai][bj][m][1];
#pragma unroll
                        for (int j = 0; j < 4; ++j) { a[j] = sigmoidf_(a[j]); b[j] = sigmoidf_(b[j]); }
                        *(u32x4*)(GATES + row * 2048 + (pn - 9) * 256 + 128 * bj + 32 * wc + 8 * fq) = pack8(a, b); }
                }
        } else {
#pragma unroll
            for (int ai = 0; ai < 2; ++ai)
#pragma unroll
                for (int m = 0; m < 4; ++m) {
                    const size_t row = (size_t)(row0 + ai * HALF + m * 16);
                    if (pn >= 6) {
                        float s0 = sumsq4(acc[ai][0][m][0]) + sumsq4(acc[ai][0][m][1]), s1 = sumsq4(acc[ai][1][m][0]) + sumsq4(acc[ai][1][m][1]);
                        s0 += __shfl_xor(s0, 16); s0 += __shfl_xor(s0, 32); s1 += __shfl_xor(s1, 16); s1 += __shfl_xor(s1, 32);
                        if (fq == 0) { if (pn == 6) P6[row * 4 + wc] = s0 + s1; else if (pn == 8) P8[row * 4 + wc] = s0 + s1; else { P7[row * 8 + wc] = s0; if (wc == 0) P7[row * 8 + 4] = s1; } } }
#pragma unroll
                    for (int bj = 0; bj < 2; ++bj) {
                        const u32x4 w = pack8(acc[ai][bj][m][0], acc[ai][bj][m][1]); const int cc = 128 * bj + 32 * wc + 8 * fq;
                        if (pn < 6) *(u32x4*)(VA + row * 512 + (pn - 4) * 256 + cc) = w;
                        else if (pn == 6) *(u32x4*)(ZCQ + row * QLORA + cc) = w;
                        else if (pn == 8) *(u32x4*)(ZCKV + row * KVLORA + cc) = w;
                        else { if (bj == 0) *(u32x4*)(ZCQ + row * QLORA + 256 + cc) = w; else if (wc == 0) *(u32x4*)(ZKR + row * ROPED + 8 * fq) = w; }
                    }
                }
        }
    }
};

__device__ __forceinline__ void rope8(float (&v)[8], const LAS float* rope, int s  , int fq) {
    const int pos = (fq < 2) ? (s >> 6) : (s & 63);
    const f32x4 c0 = *(const LAS f32x4*)(rope + pos * 8), c1 = *(const LAS f32x4*)(rope + pos * 8 + 4), s0 = *(const LAS f32x4*)(rope + 512 + pos * 8), s1 = *(const LAS f32x4*)(rope + 512 + pos * 8 + 4);
    const float cs[8] = {c0[0], c0[1], c0[2], c0[3], c1[0], c1[1], c1[2], c1[3]}, sn[8] = {s0[0], s0[1], s0[2], s0[3], s1[0], s1[1], s1[2], s1[3]};
#pragma unroll
    for (int i = 0; i < 8; ++i) { const float o = __shfl_xor(v[i], 16); v[i] = (fq & 1) ? (o * sn[i] + v[i] * cs[i]) : (v[i] * cs[i] - o * sn[i]); }
}

struct EpiQ {
    static constexpr bool PERM = true, CHAIN = false;
    bf16_t* QB; const float *p6, *p7, *g; const LAS float* rope; LAS float* P;
    __device__ __forceinline__ void operator()(f32x4 (&acc)[2][2][4][2], const Unit& u, int wr, int wc, int fr, int fq) const {
        const int row0 = u.pm * BM + wr * 64 + fr; const bool isx = u.pm < MT_X;
        float r8[8];
#pragma unroll
        for (int i = 0; i < 8; ++i) { const size_t row = (size_t)(row0 + (i >> 2) * HALF + (i & 3) * 16); const f32x4 a = *(const f32x4*)(p6 + row * 4), b = *(const f32x4*)(p7 + row * 8);
            r8[i] = rsqrtf((((a[0] + a[1]) + (a[2] + a[3])) + ((b[0] + b[1]) + (b[2] + b[3]))) * (1.0f / QLORA) + RMS_EPS); }
        const int gq = (wc < 3) ? wc : 0;
        const f32x4 g0 = *(const f32x4*)(g + 32 * gq + 8 * fq), g1 = *(const f32x4*)(g + 32 * gq + 8 * fq + 4);
#pragma unroll
        for (int ai = 0; ai < 2; ++ai)
#pragma unroll
            for (int m = 0; m < 4; ++m) {
                const float r = r8[ai * 4 + m]; const int rl = ai * 64 + m * 16 + fr;
#pragma unroll
                for (int bj = 0; bj < 2; ++bj) {
                    float ss = (sumsq4(acc[ai][bj][m][0]) + sumsq4(acc[ai][bj][m][1])) * (r * r); ss += __shfl_xor(ss, 16); ss += __shfl_xor(ss, 32);
                    if (fq == 0) P[((wr * 128 + rl) * 2 + bj) * 4 + wc] = ss; }
            }
        EPI_BAR();
        if (wc < 3) {
#pragma unroll
            for (int ai = 0; ai < 2; ++ai)
#pragma unroll
                for (int m = 0; m < 4; ++m) {
                    const int row = row0 + ai * HALF + m * 16, rl = ai * 64 + m * 16 + fr; const float r = r8[ai * 4 + m];
#pragma unroll
                    for (int bj = 0; bj < 2; ++bj) {
                        const f32x4 p = *(const LAS f32x4*)(P + ((wr * 128 + rl) * 2 + bj) * 4);
                        const float rstd = r * rsqrtf(((p[0] + p[1]) + p[2]) * (1.0f / 96.0f) + RMS_EPS);
                        const f32x4 a = acc[ai][bj][m][0] * rstd * g0, b = acc[ai][bj][m][1] * rstd * g1;
                        float v[8] = {a[0], a[1], a[2], a[3], b[0], b[1], b[2], b[3]};
                        if (wc == 2 && isx) rope8(v, rope, row & (SEQ - 1), fq);
                        u32x4 w; w.x = cvt_pk_bf16(v[0], v[1]); w.y = cvt_pk_bf16(v[2], v[3]); w.z = cvt_pk_bf16(v[4], v[5]); w.w = cvt_pk_bf16(v[6], v[7]);
                        *(u32x4*)(QB + (size_t)row * 768 + (2 * u.pn + bj) * QKD + 32 * wc + 8 * fq) = w;
                    }
                    asm volatile("" ::: "memory");
                }
        }
    }
};

struct EpiKV {
    static constexpr bool PERM = true, CHAIN = false;
    bf16_t *KB, *VB; const bf16_t* ZKR; const float *p7, *p8, *g; const LAS float* rope; LAS float* P;
    __device__ __forceinline__ void operator()(f32x4 (&acc)[2][2][4][2], const Unit& u, int wr, int wc, int fr, int fq) const {
        const int row0 = u.pm * BM + wr * 64 + fr; const bool isx = u.pm < MT_X;
        float r8[8], k8[8]; u32x4 zk8[8];
#pragma unroll
        for (int i = 0; i < 8; ++i) { const int row = row0 + (i >> 2) * HALF + (i & 3) * 16; const f32x4 a = *(const f32x4*)(p8 + (size_t)row * 4);
            k8[i] = p7[(size_t)row * 8 + 4]; r8[i] = rsqrtf(((a[0] + a[1]) + (a[2] + a[3])) * (1.0f / KVLORA) + RMS_EPS);
            zk8[i] = (u32x4){0u, 0u, 0u, 0u}; if (wc == 2) zk8[i] = *(const u32x4*)(ZKR + (size_t)row * ROPED + 8 * fq); }
        const int gofs = (wc < 2) ? (32 * wc + 8 * fq) : (64 + 8 * fq);
        const f32x4 g0 = *(const f32x4*)(g + gofs), g1 = *(const f32x4*)(g + gofs + 4);
        if (wc < 2) {
#pragma unroll
            for (int ai = 0; ai < 2; ++ai)
#pragma unroll
                for (int m = 0; m < 4; ++m) { const float r = r8[ai * 4 + m]; const int rl = ai * 64 + m * 16 + fr;
#pragma unroll
                    for (int bj = 0; bj < 2; ++bj) { float ss = (sumsq4(acc[ai][bj][m][0]) + sumsq4(acc[ai][bj][m][1])) * (r * r); ss += __shfl_xor(ss, 16); ss += __shfl_xor(ss, 32);
                        if (fq == 0) P[((wr * 128 + rl) * 2 + bj) * 4 + wc] = ss + ((wc == 0) ? k8[ai * 4 + m] : 0.f); } }
        }
        EPI_BAR();
#pragma unroll
        for (int ai = 0; ai < 2; ++ai)
#pragma unroll
            for (int m = 0; m < 4; ++m) {
                const int row = row0 + ai * HALF + m * 16, rl = ai * 64 + m * 16 + fr;
                const float rr = r8[ai * 4 + m]; const u32x4 zk = zk8[ai * 4 + m];
#pragma unroll
                for (int bj = 0; bj < 2; ++bj) {
                    const int head = 2 * u.pn + bj;
                    const f32x4 p = *(const LAS f32x4*)(P + ((wr * 128 + rl) * 2 + bj) * 4);
                    const float rstd = rsqrtf((p[0] + p[1]) * (1.0f / 96.0f) + RMS_EPS);
                    if (wc < 2) {
                        *(u32x4*)(KB + (size_t)row * 768 + head * QKD + 32 * wc + 8 * fq) = pack8(acc[ai][bj][m][0] * (rr * rstd) * g0, acc[ai][bj][m][1] * (rr * rstd) * g1);
                    } else {
                        *(u32x4*)(VB + (size_t)row * 512 + head * 64 + 32 * (wc - 2) + 8 * fq) = pack8(acc[ai][bj][m][0] * rr, acc[ai][bj][m][1] * rr);
                        if (wc == 2) {
                            float v[8] = {bf_lo(zk.x) * rstd * g0[0], bf_hi(zk.x) * rstd * g0[1], bf_lo(zk.y) * rstd * g0[2], bf_hi(zk.y) * rstd * g0[3],
                                          bf_lo(zk.z) * rstd * g1[0], bf_hi(zk.z) * rstd * g1[1], bf_lo(zk.w) * rstd * g1[2], bf_hi(zk.w) * rstd * g1[3]};
                            if (isx) rope8(v, rope, row & (SEQ - 1), fq);
                            u32x4 w; w.x = cvt_pk_bf16(v[0], v[1]); w.y = cvt_pk_bf16(v[2], v[3]); w.z = cvt_pk_bf16(v[4], v[5]); w.w = cvt_pk_bf16(v[6], v[7]);
                            *(u32x4*)(KB + (size_t)row * 768 + head * QKD + 64 + 8 * fq) = w;
                        }
                    }
                }
                asm volatile("" ::: "memory");
            }
    }
};

struct EpiMerge {
    static constexpr bool PERM = true, CHAIN = true;
    const bf16_t* GATES; bf16_t* Y;
    __device__ __forceinline__ void operator()(f32x4 (&acc)[2][2][4][2], const Unit& u, int wr, int wc, int fr, int fq) const {
        const int row0 = u.pm * BM + wr * 64 + fr;
#pragma unroll
        for (int ai = 0; ai < 2; ++ai)
#pragma unroll
            for (int m = 0; m < 4; ++m) {
                const size_t row = (size_t)(row0 + ai * HALF + m * 16);
#pragma unroll
                for (int bj = 0; bj < 2; ++bj) {
                    const int col = u.pn * 256 + 128 * bj + 32 * wc + 8 * fq;
                    const u32x4 gb = *(const u32x4*)(GATES + row * 2048 + 1024 + col);
                    const f32x4 b0 = (f32x4){bf_lo(gb.x), bf_hi(gb.x), bf_lo(gb.y), bf_hi(gb.y)}, b1 = (f32x4){bf_lo(gb.z), bf_hi(gb.z), bf_lo(gb.w), bf_hi(gb.w)};
                    if (u.kind == 0) {
                        const u32x4 ga = *(const u32x4*)(GATES + row * 2048 + col);
                        const f32x4 a0 = (f32x4){bf_lo(ga.x), bf_hi(ga.x), bf_lo(ga.y), bf_hi(ga.y)}, a1 = (f32x4){bf_lo(ga.z), bf_hi(ga.z), bf_lo(ga.w), bf_hi(ga.w)};
#pragma unroll
                        for (int j = 0; j < 4; ++j) { acc[ai][bj][m][0][j] *= a0[j] * __builtin_amdgcn_rcpf(b0[j]); acc[ai][bj][m][1][j] *= a1[j] * __builtin_amdgcn_rcpf(b1[j]); }
                    } else {
                        *(u32x4*)(Y + row * 1024 + col) = pack8(acc[ai][bj][m][0] * b0, acc[ai][bj][m][1] * b1);
                    }
                }
            }
    }
};

struct EpiOut {
    static constexpr bool PERM = false, CHAIN = false;
    const float* xsrc; float* xdst; const float* csrc; float* cdst; const float* mod  ; int goff;
    __device__ __forceinline__ void operator()(f32x4 (&acc)[2][2][4][2], const Unit& u, int wr, int wc, int fr, int fq) const {
        const bool isx = u.pm < MT_X;
        const int rowt = (isx ? u.pm : u.pm - MT_X) * BM + wr * 64 + fr;
        const float* src = isx ? xsrc : csrc; float* dst = isx ? xdst : cdst;
        const float* gm = mod + (size_t)(isx ? (u.pm >> 3) : 16) * NMODC + goff;
        const int col0 = u.pn * BM + wc * 32 + 4 * fq;
        f32x4 gv[2][2];
#pragma unroll
        for (int bj = 0; bj < 2; ++bj)
#pragma unroll
            for (int n = 0; n < 2; ++n) gv[bj][n] = *(const f32x4*)(gm + col0 + bj * HALF + n * 16);
#pragma unroll
        for (int ai = 0; ai < 2; ++ai)
#pragma unroll
            for (int m = 0; m < 4; ++m) { const size_t off = (size_t)(rowt + ai * HALF + m * 16) * DM + col0;
#pragma unroll
                for (int bj = 0; bj < 2; ++bj)
#pragma unroll
                    for (int n = 0; n < 2; ++n) { const f32x4 xs = *(const f32x4*)(src + off + bj * HALF + n * 16); *(f32x4*)(dst + off + bj * HALF + n * 16) = xs + gv[bj][n] * acc[ai][bj][m][n]; }
            }
    }
};

template <bool F8> struct EpiMoe1 {
    static constexpr bool PERM = true, CHAIN = false;
    bf16_t* HM; float ascale;
    __device__ __forceinline__ void operator()(f32x4 (&acc)[2][2][4][2], const Unit& u, int wr, int wc, int fr, int fq) const {
        const int row0 = u.pm * BM + wr * 64 + fr;
#pragma unroll
        for (int ai = 0; ai < 2; ++ai)
#pragma unroll
            for (int m = 0; m < 4; ++m) { const size_t row = (size_t)(row0 + ai * HALF + m * 16);
#pragma unroll
                for (int bj = 0; bj < 2; ++bj) { f32x4 p = acc[ai][bj][m][0], q = acc[ai][bj][m][1];
                    if (F8) { p = p * ascale; q = q * ascale; }
                    const float h0 = p[0] * sigmoidf_(p[0]) * p[1], h1 = p[2] * sigmoidf_(p[2]) * p[3], h2 = q[0] * sigmoidf_(q[0]) * q[1], h3 = q[2] * sigmoidf_(q[2]) * q[3];
                    const int col = u.pn * 128 + 64 * bj + 16 * wc + 4 * fq;
                    if (F8) *(unsigned*)((unsigned char*)HM + row * DM + col) = cvt_pk4_fp8(h0 * F8_SM, h1 * F8_SM, h2 * F8_SM, h3 * F8_SM);
                    else { u32x2 w; w.x = cvt_pk_bf16(h0, h1); w.y = cvt_pk_bf16(h2, h3); *(u32x2*)(HM + row * DM + col) = w; } }
            }
    }
};
struct EpiMoe2 {
    static constexpr bool PERM = true, CHAIN = false;
    bf16_t* YS; float ascale;
    __device__ __forceinline__ void operator()(f32x4 (&acc)[2][2][4][2], const Unit& u, int wr, int wc, int fr, int fq) const {
        const int row0 = u.pm * BM + wr * 64 + fr;
#pragma unroll
        for (int ai = 0; ai < 2; ++ai)
#pragma unroll
            for (int m = 0; m < 4; ++m) { const size_t row = (size_t)(row0 + ai * HALF + m * 16);
#pragma unroll
                for (int bj = 0; bj < 2; ++bj) *(u32x4*)(YS + row * DM + u.pn * 256 + 128 * bj + 32 * wc + 8 * fq) = pack8(acc[ai][bj][m][0] * ascale, acc[ai][bj][m][1] * ascale); }
    }
};

struct SchedRect {
    const char* A; const char* B; size_t tstep; int nM, nN, G, c, nM2, pn2, npn2;
    __device__ __forceinline__ bool next(int i, Unit& u) const {
        const int L = i * G + c, mainc = nM * nN; u.kind = 0; u.e = 0;
        if (L < mainc) { rect_tile(L, nM, nN, u.pm, u.pn); return true; }
        const int Lx = L - mainc; if (Lx >= nM2 * npn2) return false;
        u.pm = nM + Lx / npn2; u.pn = pn2 + Lx % npn2; return true;
    }
    __device__ __forceinline__ const char* a_ptr(const Unit& u) const { return A + (size_t)u.pm * tstep; }
    __device__ __forceinline__ const char* b_ptr(const Unit& u) const { return B + (size_t)u.pn * tstep; }
};
struct SchedMerge {
    const char *OA, *OB, *WA, *WB; size_t tstep; int nM, nN, G, c;
    __device__ __forceinline__ bool next(int i, Unit& u) const {
        const int L = (i >> 1) * G + c; if (L >= nM * nN) return false;
        rect_tile(L, nM, nN, u.pm, u.pn); u.kind = i & 1; u.e = 0; return true;
    }
    __device__ __forceinline__ const char* a_ptr(const Unit& u) const { return (u.kind ? OB : OA) + (size_t)u.pm * tstep; }
    __device__ __forceinline__ const char* b_ptr(const Unit& u) const { return (u.kind ? WB : WA) + (size_t)u.pn * tstep; }
};
struct SchedMoe {
    const char* A; const char* W; size_t tstepA, wstride, tstepB; const LAS int* tile_e  ; int ntile, nN, G, c;
    __device__ __forceinline__ bool next(int i, Unit& u) const {
        const int L = i * G + c; if (L >= ntile * nN) return false;
        rect_tile(L, ntile, nN, u.pm, u.pn); u.kind = 0;
        u.e = __builtin_amdgcn_readfirstlane(tile_e[u.pm]); return true;
    }
    __device__ __forceinline__ const char* a_ptr(const Unit& u) const { return A + (size_t)u.pm * tstepA; }
    __device__ __forceinline__ const char* b_ptr(const Unit& u) const { return W + (size_t)u.e * wstride + (size_t)u.pn * tstepB; }
};
}
namespace att {
constexpr int NW = 8, QBLK = 32, KVBLK = 64, DV = 64;
constexpr int SHM_V = 16384, SHM_K = 16384;
constexpr int LDS_VOFF = 0, LDS_KOFF = 2 * SHM_V, LDS_WS = LDS_KOFF + 2 * SHM_K, LDS_OST = LDS_WS + NW * 64 * 4, LDS_BIAS = LDS_OST + NW * 4096, LDS_MASK = LDS_BIAS + 16 * 128 * 4, LDS_END = LDS_MASK + 64 * 64 * 4;
static_assert(LDS_END <= RING_BYTES, "attention LDS map");
template <int DQK> struct KL { static constexpr int PITCH = (DQK == 64) ? 128 : 256; };
#define KSWZ(row, colB) ((row) * KL<DQK>::PITCH + ((colB) ^ (((row) & 7) << 4)))
#define SBAR() __builtin_amdgcn_sched_barrier(0)
__device__ __forceinline__ int crow(int r, int hi) { return (r & 3) + 8 * (r >> 2) + 4 * hi; }
__device__ __forceinline__ int v_st(int k, int c) { const int kk = (k & ~0xC) | ((k & 4) << 1) | ((k & 8) >> 1); return ((kk >> 3) * 2 + (c >> 5)) * 512 + ((kk & 7) * 32 + (c & 31)) * 2; }
__device__ __forceinline__ int v_rd_base(int lane, int c) { const int hi = (lane >> 5) & 1, g = c + hi;
    return ((lane & 3) << 3) | (((lane >> 2) & 3) << 6) | (((lane >> 4) & 1) << 5) | ((g & 1) << 8) | ((g >> 1) << 11); }
constexpr int v_rd_off(int d0, int ks, int half) { return ((2 * ks + half) * 2 + d0) * 512; }
template <int OFF> __device__ __forceinline__ s16x4 tr_read(int vb) { s16x4 r; asm volatile("ds_read_b64_tr_b16 %0, %1 offset:%2" : "=&v"(r) : "v"(vb), "i"(OFF) : "memory"); return r; }

template <int D0> __device__ __forceinline__ void pv_one(f32x16& od, int vbA, int vbB, bf16x8 pa0, bf16x8 pa1, bf16x8 pa2, bf16x8 pa3) {
    const s16x4 l0 = tr_read<v_rd_off(D0, 0, 0)>(vbA), h0 = tr_read<v_rd_off(D0, 0, 1)>(vbA), l1 = tr_read<v_rd_off(D0, 1, 0)>(vbA), h1 = tr_read<v_rd_off(D0, 1, 1)>(vbA);
    const s16x4 l2 = tr_read<v_rd_off(D0, 0, 0)>(vbB), h2 = tr_read<v_rd_off(D0, 0, 1)>(vbB), l3 = tr_read<v_rd_off(D0, 1, 0)>(vbB), h3 = tr_read<v_rd_off(D0, 1, 1)>(vbB);
    asm volatile("s_waitcnt lgkmcnt(0)" ::: "memory"); SBAR();
#define PK(L, H) (bf16x8){L[0], L[1], L[2], L[3], H[0], H[1], H[2], H[3]}
    od = __builtin_amdgcn_mfma_f32_32x32x16_bf16(pa0, PK(l0, h0), od, 0, 0, 0);
    od = __builtin_amdgcn_mfma_f32_32x32x16_bf16(pa1, PK(l1, h1), od, 0, 0, 0);
    od = __builtin_amdgcn_mfma_f32_32x32x16_bf16(pa2, PK(l2, h2), od, 0, 0, 0);
    od = __builtin_amdgcn_mfma_f32_32x32x16_bf16(pa3, PK(l3, h3), od, 0, 0, 0);
#undef PK
}
__device__ __forceinline__ void pv_all(f32x16* o, int vbA, int vbB, bf16x8 pa0, bf16x8 pa1, bf16x8 pa2, bf16x8 pa3) { pv_one<0>(o[0], vbA, vbB, pa0, pa1, pa2, pa3); pv_one<1>(o[1], vbA, vbB, pa0, pa1, pa2, pa3); }

#define MX3(a, b, c) __builtin_fmaxf(__builtin_fmaxf((a), (b)), (c))
template <bool FIRST>
__device__ __forceinline__ void partialSM(f32x16& p0, f32x16& p1, float& m_reg, float& alpha, f32x16& negm, const float THR2) {
    float a = MX3(p0[0], p0[1], p1[0]), b = MX3(p0[2], p0[3], p1[1]); a = MX3(a, p1[2], p1[3]);
#pragma unroll
    for (int r = 4; r < 16; r += 4) { a = MX3(a, p0[r], p0[r + 1]); b = MX3(b, p0[r + 2], p0[r + 3]); a = MX3(a, p1[r], p1[r + 1]); b = MX3(b, p1[r + 2], p1[r + 3]); }
    float pmax = __builtin_fmaxf(a, b);
    { auto rr = __builtin_amdgcn_permlane32_swap(__float_as_uint(pmax), __float_as_uint(pmax), false, false); pmax = __builtin_fmaxf(__uint_as_float(rr[0]), __uint_as_float(rr[1])); }
    alpha = 1.f;
    if (FIRST || !__builtin_expect(__all(pmax <= THR2), 1)) {
        const float dl = FIRST ? pmax : __builtin_fmaxf(pmax, 0.f);
        m_reg += dl; alpha = FIRST ? 1.f : __builtin_amdgcn_exp2f(-dl);
#pragma unroll
        for (int r = 0; r < 16; ++r) { p0[r] -= dl; p1[r] -= dl; }
#pragma unroll
        for (int r = 0; r < 16; ++r) negm[r] = -m_reg;
    }
#pragma unroll
    for (int r = 0; r < 16; ++r) p0[r] = __builtin_amdgcn_exp2f(p0[r]);
}
__device__ __forceinline__ void finishSM(f32x16& p0, f32x16& p1, float alpha, float& l_reg, bf16x8& pa0, bf16x8& pa1, bf16x8& pa2, bf16x8& pa3) {
#pragma unroll
    for (int r = 0; r < 16; ++r) p1[r] = __builtin_amdgcn_exp2f(p1[r]);
    float ps = 0;
#pragma unroll
    for (int r = 0; r < 16; ++r) ps += p0[r];
#pragma unroll
    for (int r = 0; r < 16; ++r) ps += p1[r];
    { auto rr = __builtin_amdgcn_permlane32_swap(__float_as_uint(ps), __float_as_uint(ps), false, false); ps = __uint_as_float(rr[0]) + __uint_as_float(rr[1]); }
    l_reg = l_reg * alpha + ps;
#define PK4(P, BASE, OUT) do { unsigned a0 = cvt_pk_bf16(P[BASE + 0], P[BASE + 1]), a1 = cvt_pk_bf16(P[BASE + 2], P[BASE + 3]);   \
    unsigned b0 = cvt_pk_bf16(P[BASE + 4], P[BASE + 5]), b1 = cvt_pk_bf16(P[BASE + 6], P[BASE + 7]);                              \
    auto r0 = __builtin_amdgcn_permlane32_swap(a0, b0, false, false); auto r1 = __builtin_amdgcn_permlane32_swap(a1, b1, false, false); \
    u32x4 w = {r0[0], r1[0], r0[1], r1[1]}; OUT = *reinterpret_cast<bf16x8*>(&w); } while (0)
    PK4(p0, 0, pa0); PK4(p0, 8, pa1); PK4(p1, 0, pa2); PK4(p1, 8, pa3);
#undef PK4
}
template <int DQK> __device__ __forceinline__ void qkt(f32x16& p0, f32x16& p1, const char* Ks, int rowA, int rowB, const bf16x8* qr, const f32x16& negm, int hi) {
#pragma unroll
    for (int d0 = 0; d0 < DQK / 16; ++d0) { const int cb = (d0 * 16 + hi * 8) * 2;
        const bf16x8 b0 = *reinterpret_cast<const bf16x8*>(Ks + KSWZ(rowA, cb));
        const bf16x8 b1 = *reinterpret_cast<const bf16x8*>(Ks + KSWZ(rowB, cb));
        if (d0 == 0) { p0 = __builtin_amdgcn_mfma_f32_32x32x16_bf16(b0, qr[0], negm, 0, 0, 0); p1 = __builtin_amdgcn_mfma_f32_32x32x16_bf16(b1, qr[0], negm, 0, 0, 0); }
        else { p0 = __builtin_amdgcn_mfma_f32_32x32x16_bf16(b0, qr[d0], p0, 0, 0, 0); p1 = __builtin_amdgcn_mfma_f32_32x32x16_bf16(b1, qr[d0], p1, 0, 0, 0); } }
}

struct UnitArgs {
    const bf16_t* Q; int ldq; int qcol;
    const bf16_t* K; int ldk; int kcol;
    const bf16_t* V; int vcol;
    bf16_t* O; int ocol;
    int q0;
    int ctx0, loc0;
    int NT;
    int masked;
    int band, krow0;
    const float* bias;
    float C;
};

__device__ __forceinline__ void na_mask(f32x16& p0, f32x16& p1, const LAS float* bt, const LAS float* mk, int krA, int qrow, int qc, int kc0, int hi) {
    const int rs = min(max(qrow - 4, 0), 24);
    const int drA = ((krA >= rs) && (krA < rs + 8)) ? (krA - qrow + 7) : 15, drB = ((krA + 1 >= rs) && (krA + 1 < rs + 8)) ? (krA + 1 - qrow + 7) : 15;
    const LAS float* bA = bt + drA * 128 + (kc0 + 4 * hi - qc + 64); const LAS float* bB = bt + drB * 128 + (kc0 + 4 * hi - qc + 64);
    const LAS float* mq = mk + qc * 64 + kc0 + 4 * hi;
#pragma unroll
    for (int g = 0; g < 4; ++g) {
        const f32x4 m0 = *(const LAS f32x4*)(mq + 8 * g);
#pragma unroll
        for (int j = 0; j < 4; ++j) { p0[4 * g + j] = (p0[4 * g + j] + bA[8 * g + j]) + m0[j]; p1[4 * g + j] = (p1[4 * g + j] + bB[8 * g + j]) + m0[j]; }
    }
}
__device__ __forceinline__ void na_mask_table(char* lds) {
    LAS float* mk = (LAS float*)(lds + LDS_MASK);
    int t0 = threadIdx.x; asm volatile("" : "+v"(t0));
    for (int i = t0; i < 64 * 64; i += 512) { const int qc = i >> 6, kc = i & 63, cs = min(max(qc - 8, 0), 48); mk[i] = ((unsigned)(kc - cs) < 16u) ? 0.f : -1e30f; }
}

template <int DQK>
__device__ __forceinline__ void attn_unit(const UnitArgs& A, char* lds) {
    int tid = threadIdx.x; asm volatile("" : "+v"(tid));
    const int wid = tid >> 6, lane = tid & 63, r32 = lane & 31, hi = lane >> 5;
    char* V_lds = lds + LDS_VOFF; char* K_lds = lds + LDS_KOFF;
    float* ws = (float*)(lds + LDS_WS) + wid * 64; float* li_l = ws; float* al_l = ws + 32;
    const LAS float* bt = (const LAS float*)(lds + LDS_BIAS); const LAS float* mk = (const LAS float*)(lds + LDS_MASK);
    const float C = A.C, THR2 = 8.0f * 1.4426950408889634f;
    const bool msk = (DQK == 64) && A.masked;
    float m_reg = 0.f, l_reg = 0; f32x16 o[2] = {}; bf16x8 qr[DQK / 16]; f32x16 negm = f32x16{};
    if (msk) { for (int i = tid; i < 16 * 128; i += 512) { const int dr = i >> 7, d = (i & 127) - 64;
            ((LAS float*)(lds + LDS_BIAS))[i] = (dr == 15) ? -1e30f : ((d >= -15 && d <= 15) ? A.bias[dr * 31 + d + 15] * 1.4426950408889634f : 0.f); } }
    const int qrow = 4 * A.band + 2 * (wid >> 2) + (r32 >> 4), qc = 16 * (wid & 3) + (r32 & 15);
    const int kc0 = msk ? min(max(16 * (wid & 3) - 8, 0), 32) : 0;
    const int qtok = msk ? (A.q0 + 64 * (2 * (wid >> 2) + (r32 >> 4)) + qc) : (A.q0 + wid * QBLK + r32);
    const bf16_t* Qw = A.Q + (size_t)qtok * A.ldq + A.qcol + hi * 8;
#pragma unroll
    for (int d0 = 0; d0 < DQK / 16; ++d0) { const u32x4 w = *reinterpret_cast<const u32x4*>(Qw + d0 * 16);
        u32x4 t; t.x = cvt_pk_bf16(bf_lo(w.x) * C, bf_hi(w.x) * C); t.y = cvt_pk_bf16(bf_lo(w.y) * C, bf_hi(w.y) * C); t.z = cvt_pk_bf16(bf_lo(w.z) * C, bf_hi(w.z) * C); t.w = cvt_pk_bf16(bf_lo(w.w) * C, bf_hi(w.w) * C);
        qr[d0] = *reinterpret_cast<bf16x8*>(&t); }
    constexpr int CPR = DQK / 8;
    const int v0key = tid >> 3, vc = (tid & 7) * 8, vst0 = v_st(v0key, vc), vst1 = 8192 + vst0;
    const int k0key = tid / CPR, k0c = tid % CPR, k1id = tid + 512, k1key = k1id / CPR, k1c = k1id % CPR;
    const int vbS = (int)(uintptr_t)V_lds + v_rd_base(lane, 0);
    const int vbM = (int)(uintptr_t)V_lds + v_rd_base(lane, kc0 >> 3);
    bf16x8 sv0, sv1 = {}, sk0, sk1 = {};
#define LOCAL(t) (msk && (t) >= 4)
#define TROW(t) (((t) < 4) ? (A.ctx0 + 64 * (t)) : (A.loc0 + (msk ? 128 : 64) * ((t) - 4)))
#define K1ON(t) ((DQK == 96) ? (tid < 256) : LOCAL(t))
#define SLOAD(t) do { const int _r0 = TROW(t); sv0 = *reinterpret_cast<const bf16x8*>(A.V + (size_t)(_r0 + v0key) * 512 + A.vcol + vc); \
        sk0 = *reinterpret_cast<const bf16x8*>(A.K + (size_t)(_r0 + k0key) * A.ldk + A.kcol + k0c * 8); \
        if (K1ON(t)) sk1 = *reinterpret_cast<const bf16x8*>(A.K + (size_t)(_r0 + k1key) * A.ldk + A.kcol + k1c * 8); \
        if (LOCAL(t)) sv1 = *reinterpret_cast<const bf16x8*>(A.V + (size_t)(_r0 + 64 + v0key) * 512 + A.vcol + vc); } while (0)
#define SWRITE(b, t) do { *reinterpret_cast<bf16x8*>(V_lds + (b) * SHM_V + vst0) = sv0; *reinterpret_cast<bf16x8*>(K_lds + (b) * SHM_K + KSWZ(k0key, k0c * 16)) = sk0; \
        if (K1ON(t)) *reinterpret_cast<bf16x8*>(K_lds + (b) * SHM_K + KSWZ(k1key, k1c * 16)) = sk1; \
        if (LOCAL(t)) *reinterpret_cast<bf16x8*>(V_lds + (b) * SHM_V + vst1) = sv1; } while (0)
#define RESC(a) do { if (__any((a) < 1.f)) { if (hi == 0) al_l[r32] = (a); asm volatile("s_waitcnt lgkmcnt(0)" ::: "memory"); \
        _Pragma("unroll") for (int d = 0; d < 2; ++d) _Pragma("unroll") for (int r = 0; r < 16; ++r) o[d][r] *= al_l[crow(r, hi)]; } } while (0)
#define QKT(P0, P1, b, t) do { const int _ra = LOCAL(t) ? (kc0 + r32) : r32, _rb = LOCAL(t) ? (64 + kc0 + r32) : (32 + r32); \
        qkt<DQK>(P0, P1, K_lds + (b) * SHM_K, _ra, _rb, qr, negm, hi); if (LOCAL(t)) na_mask(P0, P1, bt, mk, A.krow0 + 2 * ((t) - 4), qrow, qc, kc0, hi); } while (0)
#define PV(b, t) do { const int _va = (LOCAL(t) ? vbM : vbS) + (b) * SHM_V, _vb = _va + (LOCAL(t) ? 8192 : 4096); pv_all(o, _va, _vb, pa0, pa1, pa2, pa3); } while (0)
    f32x16 pA0, pA1, pB0, pB1; float alA, alB; bf16x8 pa0, pa1, pa2, pa3; const int NT = A.NT;
    SLOAD(0); SWRITE(0, 0); __syncthreads();
    QKT(pA0, pA1, 0, 0); partialSM<true>(pA0, pA1, m_reg, alA, negm, THR2);
    SLOAD(1); SWRITE(1, 1); __syncthreads();
    for (int j = 1; j + 1 < NT; j += 2) {
        SBAR(); QKT(pB0, pB1, 1, j);
        finishSM(pA0, pA1, alA, l_reg, pa0, pa1, pa2, pa3); SBAR();
        SLOAD(j + 1); SBAR();
        PV(0, j - 1); partialSM<false>(pB0, pB1, m_reg, alB, negm, THR2);
        __syncthreads(); SWRITE(0, j + 1);
        RESC(alB); __syncthreads();
        SBAR(); QKT(pA0, pA1, 0, j + 1);
        finishSM(pB0, pB1, alB, l_reg, pa0, pa1, pa2, pa3); SBAR();
        SLOAD(j + 2); SBAR();
        PV(1, j); partialSM<false>(pA0, pA1, m_reg, alA, negm, THR2);
        __syncthreads(); SWRITE(1, j + 2);
        RESC(alA); __syncthreads();
    }
    SBAR(); QKT(pB0, pB1, 1, NT - 1);
    finishSM(pA0, pA1, alA, l_reg, pa0, pa1, pa2, pa3); SBAR();
    PV(0, NT - 2); partialSM<false>(pB0, pB1, m_reg, alB, negm, THR2);
    __syncthreads(); RESC(alB);
    finishSM(pB0, pB1, alB, l_reg, pa0, pa1, pa2, pa3); SBAR();
    PV(1, NT - 1);
    if (hi == 0) li_l[r32] = l_reg; asm volatile("s_waitcnt lgkmcnt(0)" ::: "memory");
    float rli[16];
#pragma unroll
    for (int r = 0; r < 16; ++r) rli[r] = __builtin_amdgcn_rcpf(li_l[crow(r, hi)]);
    bf16_t* stg = (bf16_t*)(lds + LDS_OST) + wid * 2048;
#pragma unroll
    for (int r = 0; r < 16; ++r) { const int orow = crow(r, hi);
#pragma unroll
        for (int d0 = 0; d0 < 2; ++d0) { const unsigned w = cvt_pk_bf16(o[d0][r] * rli[r], 0.f); stg[orow * 64 + d0 * 32 + r32] = (bf16_t)(w & 0xffffu); } }
    asm volatile("s_waitcnt lgkmcnt(0)" ::: "memory");
#pragma unroll
    for (int i = 0; i < 4; ++i) { const int row = i * 8 + (lane >> 3), ch = lane & 7; const u32x4 v = *(const u32x4*)(stg + row * 64 + ch * 8);
        const int otok = msk ? (A.q0 + 64 * (2 * (wid >> 2) + (row >> 4)) + 16 * (wid & 3) + (row & 15)) : (A.q0 + wid * QBLK + row);
        *(u32x4*)(A.O + (size_t)otok * 512 + A.ocol + ch * 8) = v; }
    __syncthreads();
#undef LOCAL
#undef TROW
#undef K1ON
#undef SLOAD
#undef SWRITE
#undef RESC
#undef QKT
#undef PV
}
#undef KSWZ
#undef SBAR
}
struct Frame {
    LAS unsigned char* lds;
    int tid, lane, wave, vcu, G;
};
#define CAS __attribute__((address_space(4)))
__device__ __forceinline__ const CAS char* karg() { return (const CAS char*)__builtin_amdgcn_kernarg_segment_ptr(); }
template <int I> __device__ __forceinline__ const float* in_ptr() { unsigned off = I * 8; asm volatile("" : "+s"(off)); return *(const float* const CAS*)(karg() + off); }
__device__ __forceinline__ float* out_ptr() { unsigned off = 26 * 8; asm volatile("" : "+s"(off)); return *(float* const CAS*)(karg() + off); }
__device__ __forceinline__ unsigned char* ws_ptr() { unsigned off = 27 * 8; asm volatile("" : "+s"(off)); return *(unsigned char* const CAS*)(karg() + off); }
enum { I_X = 0, I_C, I_CTX, I_CCTX, I_WADA, I_BADA, I_NMIXG, I_NFFNG, I_WIN, I_NAQG, I_NAKG, I_RPB, I_CQG, I_WUQ, I_CKVG, I_WUKV, I_QG, I_KG, I_WOA, I_WOB, I_WOUT, I_WR, I_RB, I_W1, I_W3, I_W2 };

#define LDS_WAIT() asm volatile("s_waitcnt lgkmcnt(0)" ::: "memory")

__device__ __forceinline__ int win_src_col(int np) {
    const int pn = np >> 8, cc = np & 255;
    if (pn < 4) { const int part = pn >> 1, tq = pn & 1, bj = cc >> 7, wc = (cc >> 5) & 3, i = cc & 31; return part * 512 + (4 * tq + wc) * 64 + 32 * bj + i; }
    if (pn < 6) return 1024 + (pn - 4) * 256 + cc;
    if (pn == 6) return 1536 + cc;
    if (pn == 7) return cc < 128 ? 1792 + cc : (cc < 160 ? 2176 + (cc - 128) : -1);
    if (pn == 8) return 1920 + cc;
    return 2208 + (pn - 9) * 256 + cc;
}
template <bool F8 = false>
__device__ __forceinline__ void conv_item(const float* src, size_t ld, int dcol, int dstep, const float* gain, bf16_t* WT, int K, int k0, int n0, LAS float* scr, int lane) {
    const int kr = lane >> 4;
    f32x4 v[16];
#pragma unroll
    for (int i = 0; i < 16; ++i) { v[i] = (f32x4){0.f, 0.f, 0.f, 0.f}; if (src) v[i] = __builtin_nontemporal_load((const f32x4*)(src + (size_t)(k0 + 4 * i + kr) * ld)); }
#pragma unroll
    for (int i = 0; i < 16; ++i) { const int kk = 4 * i + kr;
        if (gain) v[i] = v[i] * gain[k0 + kk];
        LAS float* s = scr + kk * 65 + dcol; s[0] = v[i][0]; s[dstep] = v[i][1]; s[2 * dstep] = v[i][2]; s[3 * dstep] = v[i][3]; }
    LDS_WAIT(); asm volatile("" ::: "memory");
    const int c = lane & 7;
#pragma unroll
    for (int j = 0; j < 8; ++j) { const int n = (lane >> 3) + 8 * j; const LAS float* s = scr + (8 * c) * 65 + n;
        if (F8) { u32x2 o; o.x = cvt_pk4_fp8(s[0 * 65] * F8_SW, s[1 * 65] * F8_SW, s[2 * 65] * F8_SW, s[3 * 65] * F8_SW); o.y = cvt_pk4_fp8(s[4 * 65] * F8_SW, s[5 * 65] * F8_SW, s[6 * 65] * F8_SW, s[7 * 65] * F8_SW);
            *(u32x2*)((unsigned char*)WT + (size_t)(n0 + n) * K + k0 + 8 * c) = o; }
        else { u32x4 o; o.x = cvt_pk_bf16(s[0 * 65], s[1 * 65]); o.y = cvt_pk_bf16(s[2 * 65], s[3 * 65]); o.z = cvt_pk_bf16(s[4 * 65], s[5 * 65]); o.w = cvt_pk_bf16(s[6 * 65], s[7 * 65]);
            *(u32x4*)(WT + (size_t)(n0 + n) * K + k0 + 8 * c) = o; } }
    LDS_WAIT(); asm volatile("" ::: "memory");
}
__device__ __forceinline__ void p0_convert(Frame& F) {
    LAS float* scr = (LAS float*)(F.lds + F.wave * 16640);
    const int gw = F.vcu * 8 + F.wave, NGW = F.G * 8, lane = F.lane, q16 = lane & 15;
    constexpr int I_IN = 16 * 68, I_UQ = 6 * 16, I_UKV = 4 * 16, I_OA = 8 * 16, I_OUT = 16 * 16, I_13 = 16 * 32 * NEXP, I_2 = 16 * 16 * NEXP;
    constexpr int PER_L = I_IN + I_UQ + I_UKV + 2 * I_OA + I_OUT + I_13 + I_2;
    unsigned char* const ws = ws_ptr();
    for (int it = gw; it < NLAYER * PER_L; it += NGW) {
        const int l = it / PER_L; int r = it - l * PER_L;
        if (r < I_IN) { const int kb = r / 68, nb = r % 68, sc = win_src_col(nb * 64 + 4 * q16);
            conv_item(sc >= 0 ? in_ptr<I_WIN>() + (size_t)l * DM * INC + sc : nullptr, INC, 4 * q16, 1, nullptr, (bf16_t*)(ws + WS_WIN) + (size_t)l * INP * DM, DM, kb * 64, nb * 64, scr, lane); continue; } r -= I_IN;
        if (r < I_UQ) { const int kb = r / 16, nb = r % 16, np = nb * 64 + 4 * q16, hh = np >> 7, dd = np & 127;
            conv_item(dd < QKD ? in_ptr<I_WUQ>() + (size_t)l * QLORA * 768 + hh * QKD + dd : nullptr, 768, 4 * q16, 1, in_ptr<I_CQG>() + l * QLORA, (bf16_t*)(ws + WS_WUQ) + (size_t)l * 1024 * QLORA, QLORA, kb * 64, nb * 64, scr, lane); continue; } r -= I_UQ;
        if (r < I_UKV) { const int kb = r / 16, nb = r % 16;
            conv_item(in_ptr<I_WUKV>() + (size_t)l * KVLORA * 1024 + nb * 64 + 4 * q16, 1024, 4 * q16, 1, in_ptr<I_CKVG>() + l * KVLORA, (bf16_t*)(ws + WS_WUKV) + (size_t)l * 1024 * KVLORA, KVLORA, kb * 64, nb * 64, scr, lane); continue; } r -= I_UKV;
        if (r < 2 * I_OA) { const int w = r / I_OA, rr = r % I_OA, kb = rr / 16, nb = rr % 16;
            conv_item((w ? in_ptr<I_WOB>() : in_ptr<I_WOA>()) + (size_t)l * 512 * DM + nb * 64 + 4 * q16, DM, 4 * q16, 1, nullptr, (bf16_t*)(ws + (w ? WS_WOB : WS_WOA)) + (size_t)l * 1024 * 512, 512, kb * 64, nb * 64, scr, lane); continue; } r -= 2 * I_OA;
        if (r < I_OUT) { const int kb = r / 16, nb = r % 16;
            conv_item(in_ptr<I_WOUT>() + (size_t)l * DM * DM + nb * 64 + 4 * q16, DM, 4 * q16, 1, nullptr, (bf16_t*)(ws + WS_WOUT) + (size_t)l * DM * DM, DM, kb * 64, nb * 64, scr, lane); continue; } r -= I_OUT;
        if (r < I_13) { const int e = r / 512, rr = r % 512, kb = rr / 32, nb = rr % 32;
            const float* base = ((q16 < 8) ? in_ptr<I_W1>() : in_ptr<I_W3>()) + ((size_t)l * NEXP + e) * DM * DM + nb * 32 + 4 * (q16 & 7);
            bf16_t* const wt = (bf16_t*)(ws + WS_W13) + ((size_t)l * NEXP) * 2048 * DM;
            if (l == NLAYER - 1) { if ((kb ^ (e >> 2)) & 1) continue;
                const int k0 = (kb & ~1) * 64;
                conv_item<true>(base, DM, 8 * (q16 & 7) + (q16 >> 3), 2, nullptr, (bf16_t*)((unsigned char*)wt + (size_t)e * 2048 * DM), DM, k0, nb * 64, scr, lane);
                conv_item<true>(base, DM, 8 * (q16 & 7) + (q16 >> 3), 2, nullptr, (bf16_t*)((unsigned char*)wt + (size_t)e * 2048 * DM), DM, k0 + 64, nb * 64, scr, lane); }
            else conv_item(base, DM, 8 * (q16 & 7) + (q16 >> 3), 2, nullptr, wt + (size_t)e * 2048 * DM, DM, kb * 64, nb * 64, scr, lane);
            continue; } r -= I_13;
        { const int e = r / 256, rr = r % 256, kb = rr / 16, nb = rr % 16;
            const float* const src2 = in_ptr<I_W2>() + ((size_t)l * NEXP + e) * DM * DM + nb * 64 + 4 * q16; bf16_t* const wt = (bf16_t*)(ws + WS_W2) + ((size_t)l * NEXP) * DM * DM;
            if (l == NLAYER - 1) { if ((kb ^ (e >> 3)) & 1) continue; const int k0 = (kb & ~1) * 64;
                conv_item<true>(src2, DM, 4 * q16, 1, nullptr, (bf16_t*)((unsigned char*)wt + (size_t)e * DM * DM), DM, k0, nb * 64, scr, lane);
                conv_item<true>(src2, DM, 4 * q16, 1, nullptr, (bf16_t*)((unsigned char*)wt + (size_t)e * DM * DM), DM, k0 + 64, nb * 64, scr, lane); }
            else conv_item(src2, DM, 4 * q16, 1, nullptr, wt + (size_t)e * DM * DM, DM, kb * 64, nb * 64, scr, lane); }
    }
}
__device__ __forceinline__ void p0_ada(Frame& F) {
    if ((int)blockIdx.x >= 2 * 96) return;
    unsigned char* const ws = ws_ptr(); const float* const cin = in_ptr<I_C>(); const float* const cctx = in_ptr<I_CCTX>(); const float* const wada = in_ptr<I_WADA>(); const float* const bada = in_ptr<I_BADA>();
    LAS float* sct = (LAS float*)F.lds;
    LAS float* red = (LAS float*)(F.lds + 1024 * 20 * 4);
    for (int idx = F.tid; idx < 17 * 1024; idx += 512) { const int r = idx >> 10, d = idx & 1023; const float v = (r < 16) ? cin[r * DM + d] : cctx[d]; sct[d * 20 + r] = v * (1.0f / (1.0f + expf(-v))); }
    __syncthreads();
    float* MOD = (float*)(ws + WS_MOD);
    for (int task = blockIdx.x; task < 2 * 96; task += F.G) {
        const int l = task / 96, cb = task % 96, col = cb * 64 + F.lane;
        const float* wa = wada + (size_t)l * DM * NMODC + col;
        float acc[17];
#pragma unroll
        for (int r = 0; r < 17; ++r) acc[r] = 0.f;
        for (int k = F.wave * 128; k < F.wave * 128 + 128; ++k) { const float wv = wa[(size_t)k * NMODC];
#pragma unroll
            for (int r = 0; r < 17; ++r) acc[r] += sct[k * 20 + r] * wv; }
#pragma unroll
        for (int r = 0; r < 17; ++r) red[(F.wave * 17 + r) * 64 + F.lane] = acc[r];
        __syncthreads();
        for (int idx = F.tid; idx < 17 * 64; idx += 512) { const int r = idx >> 6, cl = idx & 63; float s = bada[l * NMODC + cb * 64 + cl];
#pragma unroll
            for (int w = 0; w < 8; ++w) s += red[(w * 17 + r) * 64 + cl];
            MOD[((size_t)l * 17 + r) * NMODC + cb * 64 + cl] = s; }
        __syncthreads();
    }
    if (blockIdx.x == 0) { float* rope = (float*)(ws + WS_ROPE); const int pos = F.tid >> 3, i = F.tid & 7;
        const float inv = exp2f(-(float)i * 0.125f * 13.287712379549449f);
        const float ang = (float)pos * inv; const float rev = ang * 0.15915494309189535f, fr = rev - floorf(rev); rope[pos * 8 + i] = __builtin_amdgcn_cosf(fr); rope[512 + pos * 8 + i] = __builtin_amdgcn_sinf(fr); }
}

__device__ __forceinline__ void load_row(const float* xrow, int lane, f32x4 (&v)[4]) {
#pragma unroll
    for (int j = 0; j < 4; ++j) v[j] = *((const f32x4*)xrow + lane + 64 * j);
}
__device__ __forceinline__ float row_rstd(const f32x4 (&v)[4]) {
    float s = 0.f;
#pragma unroll
    for (int j = 0; j < 4; ++j) s += (v[j][0] * v[j][0] + v[j][1] * v[j][1]) + (v[j][2] * v[j][2] + v[j][3] * v[j][3]);
    return rsqrtf(wave_sum(s) * (1.0f / DM) + RMS_EPS);
}
__device__ __forceinline__ void normmod(const f32x4 (&v)[4], float rstd, const float* g, const float* sh, const float* sc, int lane, f32x4 (&h)[4]) {
#pragma unroll
    for (int j = 0; j < 4; ++j) { const f32x4 gv = *((const f32x4*)g + lane + 64 * j), shv = *((const f32x4*)sh + lane + 64 * j), scv = *((const f32x4*)sc + lane + 64 * j);
        h[j] = v[j] * rstd * gv * (scv + 1.0f) + shv; }
}
__device__ __forceinline__ void store_row_bf16(bf16_t* orow, int lane, const f32x4 (&h)[4]) {
#pragma unroll
    for (int j = 0; j < 4; ++j) { u32x2 w; w.x = cvt_pk_bf16(h[j][0], h[j][1]); w.y = cvt_pk_bf16(h[j][2], h[j][3]); *((u32x2*)orow + lane + 64 * j) = w; }
}
__device__ __forceinline__ void p0_hrows(Frame& F) {
    unsigned char* const ws = ws_ptr(); const float* const xin = in_ptr<I_X>(); const float* const cxin = in_ptr<I_CTX>(); const float* const gmix = in_ptr<I_NMIXG>();
    const int gw = F.vcu * 8 + F.wave, NGW = F.G * 8; const float* MOD = (const float*)(ws + WS_MOD); bf16_t* H = (bf16_t*)(ws + WS_H);
    for (int t = gw; t < TALL; t += NGW) {
        const float* xr = (t < TX) ? xin + (size_t)t * DM : cxin + (size_t)(t - TX) * DM;
        const float* md = MOD + (size_t)((t < TX) ? (t >> 11) : 16) * NMODC;
        f32x4 v[4], h[4]; load_row(xr, F.lane, v); const float rstd = row_rstd(v);
        normmod(v, rstd, gmix, md, md + DM, F.lane, h); store_row_bf16(H + (size_t)t * DM, F.lane, h);
    }
}
__device__ __forceinline__ void stats_phase(Frame& F, int ntok) {
    unsigned char* const ws = ws_ptr();
    const int gw = F.vcu * 8 + F.wave, NGW = F.G * 8, lane = F.lane;
    const bf16_t* ZCQ = (const bf16_t*)(ws + WS_ZCQ); const bf16_t* ZCKV = (const bf16_t*)(ws + WS_ZCKV); const bf16_t* ZKR = (const bf16_t*)(ws + WS_ZKR);
    float* RSCQ = (float*)(ws + WS_RSCQ); float* RSCKV = (float*)(ws + WS_RSCKV); float* SSKR = (float*)(ws + WS_SSKR);
    for (int t = gw; t < ntok; t += NGW) {
        float a = 0.f, b = 0.f, c = 0.f;
        if (lane < 48) { const u32x4 w = *(const u32x4*)(ZCQ + (size_t)t * QLORA + 8 * lane); a = (bf_lo(w.x) * bf_lo(w.x) + bf_hi(w.x) * bf_hi(w.x)) + (bf_lo(w.y) * bf_lo(w.y) + bf_hi(w.y) * bf_hi(w.y)) + (bf_lo(w.z) * bf_lo(w.z) + bf_hi(w.z) * bf_hi(w.z)) + (bf_lo(w.w) * bf_lo(w.w) + bf_hi(w.w) * bf_hi(w.w)); }
        if (lane < 32) { const u32x4 w = *(const u32x4*)(ZCKV + (size_t)t * KVLORA + 8 * lane); b = (bf_lo(w.x) * bf_lo(w.x) + bf_hi(w.x) * bf_hi(w.x)) + (bf_lo(w.y) * bf_lo(w.y) + bf_hi(w.y) * bf_hi(w.y)) + (bf_lo(w.z) * bf_lo(w.z) + bf_hi(w.z) * bf_hi(w.z)) + (bf_lo(w.w) * bf_lo(w.w) + bf_hi(w.w) * bf_hi(w.w)); }
        if (lane < 4) { const u32x4 w = *(const u32x4*)(ZKR + (size_t)t * ROPED + 8 * lane); c = (bf_lo(w.x) * bf_lo(w.x) + bf_hi(w.x) * bf_hi(w.x)) + (bf_lo(w.y) * bf_lo(w.y) + bf_hi(w.y) * bf_hi(w.y)) + (bf_lo(w.z) * bf_lo(w.z) + bf_hi(w.z) * bf_hi(w.z)) + (bf_lo(w.w) * bf_lo(w.w) + bf_hi(w.w) * bf_hi(w.w)); }
        a = wave_sum(a); b = wave_sum(b); c = wave_sum(c);
        if (lane == 0) { RSCQ[t] = rsqrtf(a * (1.0f / QLORA) + RMS_EPS); RSCKV[t] = rsqrtf(b * (1.0f / KVLORA) + RMS_EPS); SSKR[t] = c; }
    }
}

__device__ __forceinline__ void route_phase(Frame& F, int l, int ntok) {
    unsigned char* const ws = ws_ptr(); const float* const xcur = out_ptr();
    constexpr int HP = DM + 4;
    LAS float* h2t = (LAS float*)F.lds;
    LAS float* part = (LAS float*)(F.lds + 66560);
    LAS float* logit = (LAS float*)(F.lds + 66560 + 32768);
    const float* MOD = (const float*)(ws + WS_MOD) + (size_t)l * 17 * NMODC; const float* XC = (const float*)(ws + WS_XC);
    const float* g = in_ptr<I_NFFNG>() + l * DM; const float* wr = in_ptr<I_WR>(); const float rbias = in_ptr<I_RB>()[F.lane];
    int* TOKE = (int*)(ws + WS_TOKE); float* TOKW = (float*)(ws + WS_TOKW); int* TOKP = (int*)(ws + WS_TOKP); float* RSTD2 = (float*)(ws + WS_RSTD2);
    unsigned* cnt = (unsigned*)(ws + WS_CTL) + CW_CNT + l * 2048;
    const int lane = F.lane, w = F.wave;
    float wv[32][4];
#pragma unroll
    for (int s_ = 0; s_ < 32; ++s_)
#pragma unroll
        for (int j = 0; j < 4; ++j) wv[s_][j] = wr[(w * 128 + 4 * s_ + (lane >> 4)) * NEXP + 16 * j + (lane & 15)];
    for (int it = blockIdx.x; it < ntok / 16; it += F.G) {
        const int T0 = it * 16;
#pragma unroll
        for (int tt = 0; tt < 2; ++tt) { const int tl = 2 * w + tt, t = T0 + tl;
            const float* xr = (t < TX) ? xcur + (size_t)t * DM : XC + (size_t)(t - TX) * DM; const float* md = MOD + (size_t)((t < TX) ? (t >> 11) : 16) * NMODC;
            f32x4 v[4], h[4]; load_row(xr, lane, v); const float rstd = row_rstd(v); if (lane == 0) RSTD2[(t >> 4) * 32 + (t & 15)] = rstd;
            normmod(v, rstd, g, md + 3 * DM, md + 4 * DM, lane, h);
#pragma unroll
            for (int j = 0; j < 4; ++j) *(LAS f32x4*)(h2t + tl * HP + 4 * lane + 256 * j) = h[j];
        }
        __syncthreads();
        { f32x4 acc[4];
#pragma unroll
          for (int j = 0; j < 4; ++j) acc[j] = (f32x4){0.f, 0.f, 0.f, 0.f};
          const LAS float* ha = h2t + (lane & 15) * HP + w * 128 + (lane >> 4);
#pragma unroll
          for (int s_ = 0; s_ < 32; ++s_) { const float a = ha[4 * s_];
#pragma unroll
              for (int j = 0; j < 4; ++j) acc[j] = __builtin_amdgcn_mfma_f32_16x16x4f32(a, wv[s_][j], acc[j], 0, 0, 0); }
#pragma unroll
          for (int j = 0; j < 4; ++j)
#pragma unroll
              for (int q = 0; q < 4; ++q) part[(w * 16 + 4 * (lane >> 4) + q) * 64 + 16 * j + (lane & 15)] = acc[j][q]; }
        __syncthreads();
#pragma unroll
        for (int k = 0; k < 2; ++k) { const int idx = F.tid + 512 * k, t = idx >> 6, e = idx & 63; float s = 0.f;
#pragma unroll
            for (int ww = 0; ww < 8; ++ww) s += part[(ww * 16 + t) * 64 + e];
            logit[t * 64 + e] = s; }
        __syncthreads();
#pragma unroll
        for (int tt = 0; tt < 2; ++tt) { const int tl = 2 * w + tt, t = T0 + tl;
            const float sg = 1.0f / (1.0f + expf(-logit[tl * 64 + lane])); const float bs = sg + rbias;
            float m1 = -3.0e38f, m2 = -3.0e38f; int i1 = 0, i2 = 0;
#pragma unroll
            for (int j = 0; j < 8; ++j) { const float vv = __shfl(bs, (lane & ~7) + j); if (vv > m1) { m2 = m1; i2 = i1; m1 = vv; i1 = j; } else if (vv > m2) { m2 = vv; i2 = j; } }
            const float gs = m1 + m2; float best = -3.0e38f; int gsel = 0;
#pragma unroll
            for (int j = 0; j < 8; ++j) { const float vv = __shfl(gs, 8 * j); if (vv > best) { best = vv; gsel = j; } }
            const int e1 = gsel * 8 + __shfl(i1, gsel * 8), e2 = gsel * 8 + __shfl(i2, gsel * 8);
            const float s1 = __shfl(sg, e1), s2 = __shfl(sg, e2), inv = 1.0f / (s1 + s2);
            if (lane == 0) { const int p1 = (int)atomicAdd(cnt + e1 * 16, 1u), p2 = (int)atomicAdd(cnt + e2 * 16, 1u);
                TOKE[2 * t] = e1; TOKE[2 * t + 1] = e2; TOKW[2 * t] = s1 * inv; TOKW[2 * t + 1] = s2 * inv; TOKP[2 * t] = p1; TOKP[2 * t + 1] = p2; }
        }
        __syncthreads();
    }
}
__device__ __forceinline__ void expert_offsets(Frame& F, unsigned char* ws, int l, LAS int* offl, bool publish) {
    if (F.wave == 0) {
        const unsigned c = __hip_atomic_load((unsigned*)(ws + WS_CTL) + CW_CNT + l * 2048 + F.lane * 16, RLX_AGENT);
        const int pad = (int)((c + 255u) & ~255u); int incl = pad;
#pragma unroll
        for (int o = 1; o < 64; o <<= 1) { const int v = __shfl_up(incl, o); if (F.lane >= o) incl += v; }
        offl[F.lane] = incl - pad; if (F.lane == 63) offl[64] = incl;
        if (publish) { int* TILEE = (int*)(ws + WS_TILEE); for (int t = (incl - pad) >> 8; t < (incl >> 8); ++t) TILEE[t] = F.lane; if (F.lane == 63) TILEE[511] = incl >> 8; }
    }
    __syncthreads();
}
__device__ __forceinline__ void scatter_phase(Frame& F, int l, int ntok, bool f8) {
    unsigned char* const ws = ws_ptr(); const float* const xcur = out_ptr();
    LAS int* offl = (LAS int*)(F.lds + 1024);
    expert_offsets(F, ws, l, offl, blockIdx.x == 0);
    const int gw = F.vcu * 8 + F.wave, NGW = F.G * 8, lane = F.lane;
    const float* MOD = (const float*)(ws + WS_MOD) + (size_t)l * 17 * NMODC; const float* XC = (const float*)(ws + WS_XC); const float* g = in_ptr<I_NFFNG>() + l * DM;
    const int* TOKE = (const int*)(ws + WS_TOKE); const int* TOKP = (const int*)(ws + WS_TOKP); const float* RSTD2 = (const float*)(ws + WS_RSTD2); bf16_t* HS = (bf16_t*)(ws + WS_HS);
    for (int t = gw; t < ntok; t += NGW) {
        const float* xr = (t < TX) ? xcur + (size_t)t * DM : XC + (size_t)(t - TX) * DM; const float* md = MOD + (size_t)((t < TX) ? (t >> 11) : 16) * NMODC;
        f32x4 v[4], h[4]; load_row(xr, lane, v); normmod(v, RSTD2[(t >> 4) * 32 + (t & 15)], g, md + 3 * DM, md + 4 * DM, lane, h);
        const int s1 = offl[TOKE[2 * t]] + TOKP[2 * t], s2 = offl[TOKE[2 * t + 1]] + TOKP[2 * t + 1];
        if (f8) {
#pragma unroll
            for (int j = 0; j < 4; ++j) { const unsigned w = cvt_pk4_fp8(h[j][0] * F8_SH, h[j][1] * F8_SH, h[j][2] * F8_SH, h[j][3] * F8_SH);
                *((unsigned*)((unsigned char*)HS + (size_t)s1 * DM) + lane + 64 * j) = w; *((unsigned*)((unsigned char*)HS + (size_t)s2 * DM) + lane + 64 * j) = w; }
        } else { store_row_bf16(HS + (size_t)s1 * DM, lane, h); store_row_bf16(HS + (size_t)s2 * DM, lane, h); }
    }
}
__device__ __forceinline__ void combine_phase(Frame& F, int l, int ntok, bool last) {
    unsigned char* const ws = ws_ptr(); float* const xcur = out_ptr();
    LAS int* offl = (LAS int*)(F.lds + 1024);
    expert_offsets(F, ws, l, offl, false);
    const int gw = F.vcu * 8 + F.wave, NGW = F.G * 8, lane = F.lane;
    const float* MOD = (const float*)(ws + WS_MOD) + (size_t)l * 17 * NMODC; float* XC = (float*)(ws + WS_XC);
    const int* TOKE = (const int*)(ws + WS_TOKE); const int* TOKP = (const int*)(ws + WS_TOKP); const float* TOKW = (const float*)(ws + WS_TOKW);
    const bf16_t* YS = (const bf16_t*)(ws + WS_YS); bf16_t* H = (bf16_t*)(ws + WS_H);
    for (int t = gw; t < ntok; t += NGW) {
        float* xr = (t < TX) ? xcur + (size_t)t * DM : XC + (size_t)(t - TX) * DM; const int bi = (t < TX) ? (t >> 11) : 16; const float* md = MOD + (size_t)bi * NMODC;
        const int s1 = offl[TOKE[2 * t]] + TOKP[2 * t], s2 = offl[TOKE[2 * t + 1]] + TOKP[2 * t + 1]; const float w1 = TOKW[2 * t], w2 = TOKW[2 * t + 1];
        f32x4 v[4]; load_row(xr, lane, v);
#pragma unroll
        for (int j = 0; j < 4; ++j) { const u32x2 a = *((const u32x2*)(YS + (size_t)s1 * DM) + lane + 64 * j), b = *((const u32x2*)(YS + (size_t)s2 * DM) + lane + 64 * j);
            const f32x4 gf = *((const f32x4*)(md + 5 * DM) + lane + 64 * j);
            const f32x4 y = (f32x4){bf_lo(a.x), bf_hi(a.x), bf_lo(a.y), bf_hi(a.y)} * w1 + (f32x4){bf_lo(b.x), bf_hi(b.x), bf_lo(b.y), bf_hi(b.y)} * w2;
            v[j] = v[j] + gf * y; *((f32x4*)xr + lane + 64 * j) = v[j]; }
        if (!last) { const float* md2 = MOD + (size_t)17 * NMODC + (size_t)bi * NMODC; f32x4 h[4]; const float rstd = row_rstd(v);
            normmod(v, rstd, in_ptr<I_NMIXG>() + (l + 1) * DM, md2, md2 + DM, lane, h); store_row_bf16(H + (size_t)t * DM, lane, h); }
    }
}
constexpr int NPHASE = 2 + 11 * NLAYER;
struct Args { const float* in[26]; float* out; unsigned char* ws; int ph_lo, ph_hi; };

__device__ __attribute__((noinline)) void grid_barrier_fn(GAS unsigned* barw, unsigned x, LAS unsigned* st) { XcdBarrier b; b.bar = (unsigned*)barw; b.x = x; b.st = (volatile LAS unsigned*)st; xcd_barrier(b); }

__global__ void __launch_bounds__(512, 2) fwd_kernel(Args args) {
    extern __shared__ __attribute__((aligned(16))) unsigned char lds_raw[];
    Frame F;
    F.lds = (LAS unsigned char*)lds_raw;
    F.tid = threadIdx.x; F.lane = F.tid & 63; F.wave = __builtin_amdgcn_readfirstlane(F.tid >> 6);
    F.G = gridDim.x; { const int bx = blockIdx.x; F.vcu = (F.G % 8 == 0) ? (bx % 8) * (F.G / 8) + bx / 8 : bx; }
    volatile LAS unsigned* MISC = (volatile LAS unsigned*)(F.lds + MISC_OFF);
    if (F.tid < 64) MISC[F.tid] = 0u;
    __syncthreads();
    const int lo = args.ph_lo, hi = args.ph_hi;
#if MK_SPLIT
#define GRID_BAR() do { } while (0)
#else
    XcdBarrier bar = xcd_barrier_post((unsigned*)(ws_ptr() + WS_CTL) + CW_BAR, MISC + 8);
#define GRID_BAR() grid_barrier_fn((GAS unsigned*)bar.bar, bar.x, (LAS unsigned*)bar.st)
#endif
#ifndef PH_MASK
#define PH_MASK 0xFFFFFFFFu
#endif
#define PHK(k) ((k) < 2 ? (k) : 2 + ((k) - 2) % 11)
#define IN(k) (((PH_MASK >> PHK(k)) & 1u) && lo <= (k) && (k) < hi)
#ifndef PH_DUP
#define PH_DUP 0u
#endif
#define REP0(k) for (int rep_ = 0; rep_ < (((PH_DUP >> (k)) & 1u) ? 2 : 1); ++rep_)
#define REPL(n) for (int rep_ = 0; rep_ < ((((PH_DUP >> (2 + (n))) & 1u) && ((n) != 5 || l == 0)) ? 2 : 1); ++rep_)
#define SEAM(k) do { if (IN(k) && IN((k) + 1)) GRID_BAR(); } while (0)
#define FRESH() Frame Fp = F; int G = F.G, c = (int)blockIdx.x; asm volatile("" : "+v"(Fp.tid), "+v"(Fp.lane)); asm volatile("" : "+s"(Fp.wave), "+s"(Fp.vcu), "+s"(Fp.G), "+s"(G), "+s"(c))

    if (IN(0)) REP0(0) { FRESH(); (void)G; (void)c; p0_convert(Fp); __syncthreads(); p0_ada(Fp); }
    SEAM(0);
    if (IN(1)) REP0(1) { FRESH(); (void)G; (void)c; p0_hrows(Fp); }
    SEAM(1);

    for (int l = 0; l < NLAYER; ++l) {
        const int base = 2 + 11 * l; const bool last = (l == NLAYER - 1);
        const int mt_act = last ? MT_X : MT_ALL;
        const int ntok = last ? TX : TALL;
        if (IN(base + 0)) REPL(0) {
            FRESH(); unsigned char* const ws = ws_ptr();
            pg8::SchedRect S{(const char*)(ws + WS_H), (const char*)((bf16_t*)(ws + WS_WIN) + (size_t)l * INP * DM), (size_t)256 * DM * 2, mt_act, 17, G, c, MT_ALL - mt_act, 2, 7};
            pg8::EpiIn E{(bf16_t*)(ws + WS_QA), (bf16_t*)(ws + WS_KA), (bf16_t*)(ws + WS_VA), (bf16_t*)(ws + WS_ZCQ), (bf16_t*)(ws + WS_ZCKV), (bf16_t*)(ws + WS_ZKR), (bf16_t*)(ws + WS_GATES),
                         in_ptr<I_NAQG>() + l * 64, in_ptr<I_NAKG>() + l * 64, (float*)(ws + WS_PART6), (float*)(ws + WS_PART7), (float*)(ws + WS_PART8)};
            pg8::gemm_phase(Fp.lds, DM, S, E);
        }
        SEAM(base + 0);
        if (IN(base + 2)) REPL(2) {
            FRESH();
            LAS float* const ropeL = (LAS float*)(Fp.lds + EPI_OFF + 8192);
            { const float* const rg = (const float*)(ws_ptr() + WS_ROPE); ropeL[Fp.tid] = rg[Fp.tid]; ropeL[512 + Fp.tid] = rg[512 + Fp.tid]; __syncthreads(); }
#ifndef NO_EQ
            { unsigned char* const ws = ws_ptr();
              pg8::SchedRect S{(const char*)(ws + WS_ZCQ), (const char*)((bf16_t*)(ws + WS_WUQ) + (size_t)l * 1024 * QLORA), (size_t)256 * QLORA * 2, mt_act, 4, G, c, 0, 0, 1};
              pg8::EpiQ E{(bf16_t*)(ws + WS_QB), (const float*)(ws + WS_PART6), (const float*)(ws + WS_PART7), in_ptr<I_QG>() + l * QKD, ropeL, (LAS float*)(Fp.lds + EPI_OFF)};
              pg8::gemm_phase(Fp.lds, QLORA, S, E); }
#endif
#ifndef NO_EKV
            { unsigned char* const ws = ws_ptr();
              pg8::SchedRect S{(const char*)(ws + WS_ZCKV), (const char*)((bf16_t*)(ws + WS_WUKV) + (size_t)l * 1024 * KVLORA), (size_t)256 * KVLORA * 2, MT_ALL, 4, G, c, 0, 0, 1};
              pg8::EpiKV E{(bf16_t*)(ws + WS_KB), (bf16_t*)(ws + WS_VB), (const bf16_t*)(ws + WS_ZKR), (const float*)(ws + WS_PART7), (const float*)(ws + WS_PART8), in_ptr<I_KG>() + l * QKD, ropeL, (LAS float*)(Fp.lds + EPI_OFF)};
              pg8::gemm_phase(Fp.lds, KVLORA, S, E); }
#endif
        }
        SEAM(base + 2);
        if (IN(base + 3)) REPL(3) {
            FRESH(); (void)c;
            const float C64 = 0.125f * 1.4426950408889634f, C96 = 0.10206207261596575f * 1.4426950408889634f;
            for (int r2_ = 0; r2_ < (((PH_DUP >> 20) & 1u) ? 2 : 1); ++r2_)
            { unsigned char* const ws = ws_ptr();
              for (int u = Fp.vcu; u < 1024 + 256; u += G) {
                att::UnitArgs A; A.Q = (const bf16_t*)(ws + WS_QB); A.ldq = 768; A.K = (const bf16_t*)(ws + WS_KB); A.ldk = 768; A.V = (const bf16_t*)(ws + WS_VB); A.O = (bf16_t*)(ws + WS_OB);
                A.masked = 0; A.band = 0; A.krow0 = 0; A.bias = nullptr; A.C = C96;
                if (u < 1024) { const int bh = u >> 3, qb = u & 7, b = bh >> 3, h = bh & 7;
                    A.qcol = h * QKD; A.kcol = h * QKD; A.vcol = h * 64; A.ocol = h * 64; A.q0 = b * SEQ + qb * 256; A.ctx0 = TX + b * CTXL; A.loc0 = b * SEQ; A.NT = 36; }
                else { const int v = u - 1024; if (last || !(v & 1)) continue; const int bh = v >> 1, b = bh >> 3, h = bh & 7;
                    A.qcol = h * QKD; A.kcol = h * QKD; A.vcol = h * 64; A.ocol = h * 64; A.q0 = TX + b * CTXL; A.ctx0 = TX + b * CTXL; A.loc0 = 0; A.NT = 4; }
                att::attn_unit<96>(A, (char*)lds_raw);
              } }
            for (int r3_ = 0; r3_ < (((PH_DUP >> 21) & 1u) ? 2 : 1); ++r3_)
            { unsigned char* const ws = ws_ptr(); const float* const rpb = in_ptr<I_RPB>();
              att::na_mask_table((char*)lds_raw);
              for (int u = Fp.vcu; u < 1024 + 256; u += G) {
                att::UnitArgs A; A.Q = (const bf16_t*)(ws + WS_QA); A.ldq = 512; A.K = (const bf16_t*)(ws + WS_KA); A.ldk = 512; A.V = (const bf16_t*)(ws + WS_VA); A.O = (bf16_t*)(ws + WS_OA); A.C = C64;
                if (u < 1024) { const int bh = u >> 3, band = u & 7, b = bh >> 3, h = bh & 7;
                    A.qcol = h * 64; A.kcol = h * 64; A.vcol = h * 64; A.ocol = h * 64; A.q0 = b * SEQ + band * 256; A.ctx0 = TX + b * CTXL;
                    A.krow0 = min(max(4 * band - 4, 0), 20); A.loc0 = b * SEQ + 64 * A.krow0; A.NT = 10; A.masked = 1; A.band = band; A.bias = rpb + ((size_t)l * NHEAD + h) * 15 * 31; }
                else { const int v = u - 1024; if (last || (v & 1)) continue; const int bh = v >> 1, b = bh >> 3, h = bh & 7;
                    A.qcol = h * 64; A.kcol = h * 64; A.vcol = h * 64; A.ocol = h * 64; A.q0 = TX + b * CTXL; A.ctx0 = TX + b * CTXL; A.loc0 = 0; A.NT = 4; A.masked = 0; A.band = 0; A.krow0 = 0; A.bias = nullptr; }
                att::attn_unit<64>(A, (char*)lds_raw);
              } }
        }
        SEAM(base + 3);
        if (IN(base + 4)) REPL(4) {
            FRESH(); unsigned char* const ws = ws_ptr();
            pg8::SchedMerge S{(const char*)(ws + WS_OA), (const char*)(ws + WS_OB), (const char*)((bf16_t*)(ws + WS_WOA) + (size_t)l * 1024 * 512), (const char*)((bf16_t*)(ws + WS_WOB) + (size_t)l * 1024 * 512),
                              (size_t)256 * 512 * 2, mt_act, 4, G, c};
            pg8::EpiMerge E{(const bf16_t*)(ws + WS_GATES), (bf16_t*)(ws + WS_Y)};
            pg8::gemm_phase(Fp.lds, 512, S, E);
        }
        SEAM(base + 4);
        if (IN(base + 5)) REPL(5) {
            FRESH(); unsigned char* const ws = ws_ptr(); float* const outp = out_ptr();
            pg8::SchedRect S{(const char*)(ws + WS_Y), (const char*)((bf16_t*)(ws + WS_WOUT) + (size_t)l * DM * DM), (size_t)256 * DM * 2, mt_act, 4, G, c, 0, 0, 1};
            pg8::EpiOut E{(l == 0) ? in_ptr<I_X>() : (const float*)outp, outp, in_ptr<I_CTX>(), (float*)(ws + WS_XC), (const float*)(ws + WS_MOD) + (size_t)l * 17 * NMODC, 2 * DM};
            pg8::gemm_phase(Fp.lds, DM, S, E);
        }
        SEAM(base + 5);
        if (IN(base + 6)) REPL(6) { FRESH(); (void)G; (void)c; route_phase(Fp, l, ntok); }
        SEAM(base + 6);
        if (IN(base + 7)) REPL(7) { FRESH(); (void)G; (void)c; scatter_phase(Fp, l, ntok, last); }
        SEAM(base + 7);
        if (IN(base + 8)) REPL(8) {
            FRESH(); unsigned char* const ws = ws_ptr();
            LAS int* const tle = (LAS int*)(Fp.lds + EPI_OFF + 16384); tle[Fp.tid] = ld_i32_agent((const int*)(ws + WS_TILEE) + Fp.tid); __syncthreads();
            const int ntile = __builtin_amdgcn_readfirstlane(tle[511]);
            const char* const w13 = (const char*)((bf16_t*)(ws + WS_W13) + (size_t)l * NEXP * 2048 * DM);
#ifdef ONLY_BF16
            if (false) {} else
#endif
#ifdef ONLY_F8
            if (true)
#else
            if (last)
#endif
            { pg8::SchedMoe S{(const char*)(ws + WS_HS), w13, (size_t)256 * DM, (size_t)2048 * DM, (size_t)256 * DM, tle, ntile, 8, G, c};
                pg8::EpiMoe1<true> E{(bf16_t*)(ws + WS_HMID), 1.0f / (F8_SH * F8_SW)};
                pg8::gemm_phase<true>(Fp.lds, DM / 2, S, E); }
            else { pg8::SchedMoe S{(const char*)(ws + WS_HS), w13, (size_t)256 * DM * 2, (size_t)2048 * DM * 2, (size_t)256 * DM * 2, tle, ntile, 8, G, c};
                pg8::EpiMoe1<false> E{(bf16_t*)(ws + WS_HMID), 1.0f};
                pg8::gemm_phase(Fp.lds, DM, S, E); }
        }
        SEAM(base + 8);
        if (IN(base + 9)) REPL(9) {
            FRESH(); unsigned char* const ws = ws_ptr();
            LAS int* const tle = (LAS int*)(Fp.lds + EPI_OFF + 16384); tle[Fp.tid] = ld_i32_agent((const int*)(ws + WS_TILEE) + Fp.tid); __syncthreads();
            const int ntile = __builtin_amdgcn_readfirstlane(tle[511]);
            const char* const w2 = (const char*)((bf16_t*)(ws + WS_W2) + (size_t)l * NEXP * DM * DM);
            if (last) { pg8::SchedMoe S{(const char*)(ws + WS_HMID), w2, (size_t)256 * DM, (size_t)DM * DM, (size_t)256 * DM, tle, ntile, 4, G, c};
                pg8::EpiMoe2 E{(bf16_t*)(ws + WS_YS), 1.0f / (F8_SM * F8_SW)};
                pg8::gemm_phase<true>(Fp.lds, DM / 2, S, E); }
            else { pg8::SchedMoe S{(const char*)(ws + WS_HMID), w2, (size_t)256 * DM * 2, (size_t)DM * DM * 2, (size_t)256 * DM * 2, tle, ntile, 4, G, c};
                pg8::EpiMoe2 E{(bf16_t*)(ws + WS_YS), 1.0f};
                pg8::gemm_phase(Fp.lds, DM, S, E); }
        }
        SEAM(base + 9);
        if (IN(base + 10)) REPL(10) { FRESH(); (void)G; (void)c; combine_phase(Fp, l, ntok, last); }
        if (!last) SEAM(base + 10);
    }
#undef IN
#undef SEAM
#undef GRID_BAR
}

extern "C" void kernel_launch(void* const* d_in, const int* in_sizes, int n_in, void* d_out, int out_size, void* d_ws, size_t ws_size, hipStream_t stream) {
    static int grid = 0;
    if (grid == 0) {
        if (n_in != 26 || out_size != TX * DM || ws_size < WS_END) { fprintf(stderr, "kernel_launch: unexpected problem (n_in %d, out %d, ws %zu < %zu); nothing launched\n", n_in, out_size, ws_size, (size_t)WS_END); grid = -1; return; }
        int dev = 0, cus = 0, per_cu = 0;
        if (hipGetDevice(&dev) != hipSuccess || hipDeviceGetAttribute(&cus, hipDeviceAttributeMultiprocessorCount, dev) != hipSuccess) { grid = -1; return; }
        if (hipFuncSetAttribute((const void*)fwd_kernel, hipFuncAttributeMaxDynamicSharedMemorySize, LDS_BYTES) != hipSuccess) { fprintf(stderr, "kernel_launch: hipFuncSetAttribute failed\n"); grid = -1; return; }
        if (hipOccupancyMaxActiveBlocksPerMultiprocessor(&per_cu, (const void*)fwd_kernel, 512, LDS_BYTES) != hipSuccess || per_cu < 1) fprintf(stderr, "kernel_launch: occupancy query reports %d blocks per CU\n", per_cu);
        (void)hipGetLastError();
        grid = cus;
    }
    if (grid < 0) return;
    (void)in_sizes;
    (void)hipMemsetAsync((char*)d_ws + WS_CTL, 0, CTL_BYTES, stream);
    Args a{};
    for (int i = 0; i < 26; ++i) a.in[i] = (const float*)d_in[i];
    a.out = (float*)d_out; a.ws = (unsigned char*)d_ws;
#if MK_SPLIT
    for (int p = 0; p < NPHASE; ++p) { a.ph_lo = p; a.ph_hi = p + 1; hipLaunchKernelGGL(fwd_kernel, dim3(grid), dim3(512), LDS_BYTES, stream, a); }
#else
    a.ph_lo = 0; a.ph_hi = NPHASE;
    hipLaunchKernelGGL(fwd_kernel, dim3(grid), dim3(512), LDS_BYTES, stream, a);
#endif
    const hipError_t le = hipPeekAtLastError();
    if (le != hipSuccess) fprintf(stderr, "kernel_launch: launch failed: %s\n", hipGetErrorName(le));
}
```

```cpp
#include <hip/hip_runtime.h>
#include <hip/hip_bf16.h>
#include <cstdio>
#include <cstdint>

#ifndef MK_SPLIT
#define MK_SPLIT 0
#endif

#define LAS __attribute__((address_space(3)))
#define GAS __attribute__((address_space(1)))
typedef unsigned short bf16_t;
typedef short bf16x8 __attribute__((ext_vector_type(8)));
typedef short s16x4 __attribute__((ext_vector_type(4)));
typedef float f32x4 __attribute__((ext_vector_type(4)));
typedef float f32x2 __attribute__((ext_vector_type(2)));
typedef float f32x16 __attribute__((ext_vector_type(16)));
typedef unsigned u32x4 __attribute__((ext_vector_type(4)));
typedef unsigned u32x2 __attribute__((ext_vector_type(2)));
#define RLX_AGENT __ATOMIC_RELAXED, __HIP_MEMORY_SCOPE_AGENT

constexpr int DM = 1024, NB = 16, SEQ = 2048, TX = NB * SEQ, CTXL = 256, TC = NB * CTXL, TALL = TX + TC;
constexpr int NHEAD = 8, GRIDW = 64;
constexpr int INC = 4256, INP = 4352;
constexpr int NEXP = 64, NMODC = 6 * DM;
constexpr int QLORA = 384, KVLORA = 256, QKD = 96, ROPED = 32;
constexpr int MT_X = TX / 256, MT_ALL = TALL / 256;
constexpr int NSLOT_MAX = 2 * TALL + NEXP * 256;
constexpr float RMS_EPS = 1e-6f;
constexpr int NLAYER = 2;
constexpr float F8_SW = 64.f, F8_SH = 16.f, F8_SM = 4.f;
#ifndef F8_FROM
#define F8_FROM 0
#endif
#define F8LAYER(l) ((l) >= F8_FROM)

constexpr size_t al256(size_t x) { return (x + 255) & ~(size_t)255; }
constexpr size_t WS_CTL = 0, CTL_BYTES = 1u << 20;
constexpr size_t WS_MOD   = WS_CTL + CTL_BYTES;
constexpr size_t WS_ROPE  = WS_MOD + al256((size_t)NLAYER * 17 * NMODC * 4);
constexpr size_t WS_RSCQ  = WS_ROPE + al256(64 * 8 * 2 * 4);
constexpr size_t WS_RSCKV = WS_RSCQ + al256((size_t)TALL * 4);
constexpr size_t WS_SSKR  = WS_RSCKV + al256((size_t)TALL * 4);
constexpr size_t WS_TOKE  = WS_SSKR + al256((size_t)TALL * 4);
constexpr size_t WS_TOKW  = WS_TOKE + al256((size_t)TALL * 8);
constexpr size_t WS_TOKP  = WS_TOKW + al256((size_t)TALL * 8);
constexpr size_t WS_RSTD2 = WS_TOKP + al256((size_t)TALL * 8);
constexpr size_t WS_TILEE = WS_RSTD2 + al256((size_t)TALL * 8);
constexpr size_t WS_OFFS  = WS_TILEE + al256(512 * 4);
constexpr size_t WS_PART6 = WS_OFFS + al256(128 * 4);
constexpr size_t WS_PART7 = WS_PART6 + al256((size_t)TALL * 4 * 4);
constexpr size_t WS_PART8 = WS_PART7 + al256((size_t)TALL * 8 * 4);
constexpr size_t WS_WIN   = WS_PART8 + al256((size_t)TALL * 4 * 4);
constexpr size_t WS_WUQ   = WS_WIN + al256((size_t)NLAYER * INP * DM * 2);
constexpr size_t WS_WUKV  = WS_WUQ + al256((size_t)NLAYER * 1024 * QLORA * 2);
constexpr size_t WS_WOA   = WS_WUKV + al256((size_t)NLAYER * 1024 * KVLORA * 2);
constexpr size_t WS_WOB   = WS_WOA + al256((size_t)NLAYER * 1024 * 512 * 2);
constexpr size_t WS_WOUT  = WS_WOB + al256((size_t)NLAYER * 1024 * 512 * 2);
constexpr size_t WS_W13   = WS_WOUT + al256((size_t)NLAYER * 1024 * 1024 * 2);
constexpr size_t WS_W2    = WS_W13 + al256((size_t)NLAYER * NEXP * 2048 * 1024 * 2);
constexpr size_t WS_H     = WS_W2 + al256((size_t)NLAYER * NEXP * 1024 * 1024 * 2);
constexpr size_t WS_XC    = WS_H + al256((size_t)TALL * DM * 2);
constexpr size_t WS_ACT   = WS_XC + al256((size_t)TC * DM * 4);
constexpr size_t WS_QA    = WS_ACT;
constexpr size_t WS_KA    = WS_QA + al256((size_t)TALL * 512 * 2);
constexpr size_t WS_VA    = WS_KA + al256((size_t)TALL * 512 * 2);
constexpr size_t WS_ZCQ   = WS_VA + al256((size_t)TALL * 512 * 2);
constexpr size_t WS_ZCKV  = WS_ZCQ + al256((size_t)TALL * QLORA * 2);
constexpr size_t WS_ZKR   = WS_ZCKV + al256((size_t)TALL * KVLORA * 2);
constexpr size_t WS_GATES = WS_ZKR + al256((size_t)TALL * ROPED * 2);
constexpr size_t WS_QB    = WS_GATES + al256((size_t)TALL * 2048 * 2);
constexpr size_t WS_KB    = WS_QB + al256((size_t)TALL * 768 * 2);
constexpr size_t WS_VB    = WS_KB + al256((size_t)TALL * 768 * 2);
constexpr size_t WS_OA    = WS_VB + al256((size_t)TALL * 512 * 2);
constexpr size_t WS_OB    = WS_OA + al256((size_t)TALL * 512 * 2);
constexpr size_t WS_Y     = WS_OB + al256((size_t)TALL * 512 * 2);
constexpr size_t WS_MIX_END = WS_Y + al256((size_t)TALL * DM * 2);
constexpr size_t WS_HS    = WS_ACT;
constexpr size_t WS_HMID  = WS_HS + al256((size_t)NSLOT_MAX * DM * 2);
constexpr size_t WS_YS    = WS_HMID + al256((size_t)NSLOT_MAX * DM * 2);
constexpr size_t WS_MOE_END = WS_YS + al256((size_t)NSLOT_MAX * DM * 2);
constexpr size_t WS_END   = (WS_MIX_END > WS_MOE_END) ? WS_MIX_END : WS_MOE_END;

constexpr int CW_BAR = 4096;
constexpr int CW_CNT = 16384;

constexpr int RING_BYTES = 131072;
constexpr int EPI_OFF = RING_BYTES;
constexpr int MISC_OFF = RING_BYTES + 24576;
constexpr int LDS_BYTES = 160 * 1024;

__device__ __forceinline__ unsigned cvt_pk_bf16(float lo, float hi) { unsigned r; asm volatile("v_cvt_pk_bf16_f32 %0, %1, %2" : "=v"(r) : "v"(lo), "v"(hi)); return r; }
__device__ __forceinline__ unsigned cvt_pk4_fp8(float a, float b, float c, float d) {
    a = __builtin_amdgcn_fmed3f(a, -448.f, 448.f); b = __builtin_amdgcn_fmed3f(b, -448.f, 448.f); c = __builtin_amdgcn_fmed3f(c, -448.f, 448.f); d = __builtin_amdgcn_fmed3f(d, -448.f, 448.f);
    int w = 0; w = __builtin_amdgcn_cvt_pk_fp8_f32(a, b, w, false); w = __builtin_amdgcn_cvt_pk_fp8_f32(c, d, w, true); return (unsigned)w; }
__device__ __forceinline__ float bf_lo(unsigned w) { return __uint_as_float(w << 16); }
__device__ __forceinline__ float bf_hi(unsigned w) { return __uint_as_float(w & 0xffff0000u); }
__device__ __forceinline__ float wave_sum(float v) {
#pragma unroll
    for (int o = 1; o < 64; o <<= 1) v += __shfl_xor(v, o);
    return v;
}
__device__ __forceinline__ float sigmoidf_(float x) { return __builtin_amdgcn_rcpf(1.0f + __expf(-x)); }
__device__ __forceinline__ int ld_i32_agent(const int* p) { return (int)__hip_atomic_load((const unsigned*)p, RLX_AGENT); }
#define XB_TMO      128
#define XB_XCNT(j)  (256  + 64 * (j))
#define XB_XSUB(j)  (1280 + 64 * (j))
#define XB_XGEN(j)  (2304 + 64 * (j))
#define XB_TOP      3328
#define XB_TOPGEN   3392
#define XCD_BAR_WORDS 3456
#define XB_SPIN_CAP (1u << 18)

__device__ __forceinline__ unsigned xb_ld(unsigned* p)              { return __hip_atomic_load(p, __ATOMIC_RELAXED, __HIP_MEMORY_SCOPE_AGENT); }
__device__ __forceinline__ unsigned xb_add(unsigned* p, unsigned v) { return __hip_atomic_fetch_add(p, v, __ATOMIC_RELAXED, __HIP_MEMORY_SCOPE_AGENT); }
__device__ __forceinline__ unsigned xb_xcc_id() { return (unsigned)__builtin_amdgcn_s_getreg((3 << 11) | 20) & 0xFu; }
#define XB_SPIN(cond, bar) do { unsigned _sp = 0; while (cond) { __builtin_amdgcn_s_sleep(1); \
    if ((++_sp & 255u) == 0u) { if (xb_ld(&(bar)[XB_TMO])) break; if (_sp > XB_SPIN_CAP) { atomicAdd(&(bar)[XB_TMO], 1u); break; } } } } while (0)

struct XcdBarrier {
    unsigned* bar; unsigned x;
    volatile LAS unsigned* st;
};

__device__ __forceinline__ XcdBarrier xcd_barrier_post(unsigned* bar, volatile LAS unsigned* st) {
    XcdBarrier b; b.bar = bar; b.x = xb_xcc_id(); b.st = st;
    if (threadIdx.x == 0) (void)xb_add(&bar[XB_XCNT(b.x)], 1u);
    return b;
}
__device__ __forceinline__ void xcd_barrier_complete(unsigned* bar, unsigned x, unsigned& nloc, unsigned& nx) {
    const unsigned G = gridDim.x * gridDim.y * gridDim.z;
    unsigned sum, cnt, mine, sp = 0u;
    for (;;) {
        sum = 0u; cnt = 0u; mine = 0u;
#pragma unroll
        for (unsigned j = 0; j < 16; ++j) { const unsigned c = xb_ld(&bar[XB_XCNT(j)]); sum += c; cnt += (c > 0u) ? 1u : 0u; mine = (j == x) ? c : mine; }
        if (sum == G) break;
        __builtin_amdgcn_s_sleep(1);
        if ((++sp & 255u) == 0u) { if (xb_ld(&bar[XB_TMO])) break; if (sp > XB_SPIN_CAP) { atomicAdd(&bar[XB_TMO], 1u); break; } }
    }
    nloc = mine > 0u ? mine : 1u; nx = cnt > 0u ? cnt : 1u;
}

__device__ __forceinline__ void xcd_barrier(const XcdBarrier& b) {
    asm volatile("s_waitcnt vmcnt(0)" ::: "memory");
    __syncthreads();
    if (threadIdx.x == 0) {
        unsigned* bar = b.bar;
        __builtin_amdgcn_s_waitcnt(0);
        unsigned nloc = b.st[0], nx = b.st[1];
        if (nloc == 0u) { xcd_barrier_complete(bar, b.x, nloc, nx); b.st[0] = nloc; b.st[1] = nx; }
        const unsigned old = xb_add(&bar[XB_XSUB(b.x)], 1u);
        const unsigned gen = old / nloc;
        if (old + 1u == (gen + 1u) * nloc) {
            __builtin_amdgcn_fence(__ATOMIC_RELEASE, "agent");
            asm volatile("s_waitcnt vmcnt(0)" ::: "memory");
            const unsigned og = xb_add(&bar[XB_TOP], 1u);
            const unsigned tg = og / nx;
            if (og + 1u == (tg + 1u) * nx) xb_add(&bar[XB_TOPGEN], 1u);
            else XB_SPIN(xb_ld(&bar[XB_TOPGEN]) == tg, bar);
            __builtin_amdgcn_fence(__ATOMIC_ACQUIRE, "agent");
            xb_add(&bar[XB_XGEN(b.x)], 1u);
            asm volatile("s_waitcnt vmcnt(0)" ::: "memory");
        } else {
            XB_SPIN(xb_ld(&bar[XB_XGEN(b.x)]) == gen, bar);
            __builtin_amdgcn_fence(__ATOMIC_ACQUIRE, "agent");
            asm volatile("s_waitcnt vmcnt(0)" ::: "memory");
        }
    }
    __syncthreads();
}

namespace pg8 {
constexpr int BM = 256, BK = 64, HALF = 128, HTB = HALF * BK * 2  , STAGE_BYTES = 8 * HTB, NXCD = 8, WGM = 8;
__host__ __device__ __forceinline__ int lds_byte(int r, int c) { const int st = (r >> 4) * 2 + (c >> 5), rr = r & 15, cc = c & 31, ob = rr * 64 + cc * 2; return st * 1024 + (ob ^ (((ob >> 9) & 1) << 5)); }
__host__ __device__ __forceinline__ void stage_rc(int b, int& R, int& C) { const int st = b / 1024, sb = b % 1024, swz = sb ^ (((sb >> 9) & 1) << 5); R = (st >> 1) * 16 + swz / 64; C = (st & 1) * 32 + (swz % 64) / 2; }
__host__ __device__ __forceinline__ int perm32(int rho) { const int n = rho >> 4, i = rho & 15; return 8 * (i >> 2) + 4 * n + (i & 3); }

struct Unit { int pm, pn, kind, e; };

__device__ __forceinline__ void rect_tile(int wgid_in, int nM, int nN, int& pm, int& pn) {
    const int nwg = nM * nN; int wgid = wgid_in;
    { const int q = nwg / NXCD, r = nwg % NXCD, xcd = wgid % NXCD, off = wgid / NXCD; wgid = (xcd < r ? xcd * (q + 1) : r * (q + 1) + (xcd - r) * q) + off; }
    const int nig = WGM * nN, gid = wgid / nig, fm = gid * WGM, gsz = (nM - fm) < WGM ? (nM - fm) : WGM;
    pm = fm + ((wgid % nig) % gsz); pn = (wgid % nig) / gsz;
}

typedef int i32x8 __attribute__((ext_vector_type(8)));
template <bool F8 = false, class Epi, class Sched>
__device__ __forceinline__ void gemm_phase(LAS unsigned char* lds, const int K, const Sched& S, const Epi& E) {
    int tid = threadIdx.x; asm volatile("" : "+v"(tid));
    const int wid = __builtin_amdgcn_readfirstlane(tid >> 6), lane = tid & 63, wr = wid >> 2, wc = wid & 3, fr = lane & 15, fq = lane >> 4;
    const int nt = K / BK;
    unsigned voffA[2], voffB[2];
#pragma unroll
    for (int i = 0; i < 2; ++i) { int R, C; stage_rc(tid * 16 + i * 8192, R, C); const int Rb = Epi::PERM ? ((R & ~31) + perm32(R & 31)) : R;
        voffA[i] = (unsigned)(R * K + C) * 2u; voffB[i] = (unsigned)(Rb * K + C) * 2u; }
    const size_t kstep = (size_t)(BK * 2);
    const size_t hstep = (size_t)HALF * K * 2;
    const unsigned ldsw = (unsigned)wid * 1024u;
    const int aoff = lds_byte(wr * 64 + fr, F8 ? fq * 16 : fq * 8), boff = lds_byte(wc * 32 + fr, F8 ? fq * 16 : fq * 8);
    constexpr int KSTEP = F8 ? 16 : 1024;
    int f8scale = 0x7F7F7F7F; asm volatile("" : "+v"(f8scale));
#define PG8_SA(b, h) (((b) * 2 + (h)) * HTB)
#define PG8_SB(b, h) ((4 + (b) * 2 + (h)) * HTB)
#define PG8_STAGE(bufoff, gbase, voff) do { _Pragma("unroll") for (int _i = 0; _i < 2; ++_i) \
        __builtin_amdgcn_global_load_lds((const unsigned*)((const char*)(gbase) + (voff)[_i]), (LAS unsigned*)(lds + (bufoff) + ldsw + _i * 8192), 16, 0, 0); } while (0)
#define PG8_LDA(dst, b, h) do { _Pragma("unroll") for (int m = 0; m < 4; ++m) _Pragma("unroll") for (int k = 0; k < 2; ++k) dst[m][k] = *(const LAS bf16x8*)(lds + PG8_SA(b, h) + aoff + m * 2048 + k * KSTEP); } while (0)
#define PG8_LDB(dst, b, h) do { _Pragma("unroll") for (int n = 0; n < 2; ++n) _Pragma("unroll") for (int k = 0; k < 2; ++k) dst[n][k] = *(const LAS bf16x8*)(lds + PG8_SB(b, h) + boff + n * 2048 + k * KSTEP); } while (0)
#define PG8_CAT(X) __builtin_shufflevector(__builtin_bit_cast(u32x4, (X)[0]), __builtin_bit_cast(u32x4, (X)[1]), 0, 1, 2, 3, 4, 5, 6, 7)
#define PG8_MMA(ai, bj, At, Bt) do { __builtin_amdgcn_s_setprio(1); \
        if constexpr (F8) { _Pragma("unroll") for (int m = 0; m < 4; ++m) _Pragma("unroll") for (int n = 0; n < 2; ++n) \
            asm volatile("v_mfma_scale_f32_16x16x128_f8f6f4 %0, %1, %2, %0, %3, %3 op_sel_hi:[0,0,0]" : "+v"(acc[ai][bj][m][n]) : "v"(__builtin_bit_cast(i32x8, PG8_CAT(Bt[n]))), "v"(__builtin_bit_cast(i32x8, PG8_CAT(At[m]))), "v"(f8scale)); } \
        else { _Pragma("unroll") for (int m = 0; m < 4; ++m) _Pragma("unroll") for (int n = 0; n < 2; ++n) _Pragma("unroll") for (int k = 0; k < 2; ++k) \
            acc[ai][bj][m][n] = __builtin_amdgcn_mfma_f32_16x16x32_bf16(Bt[n][k], At[m][k], acc[ai][bj][m][n], 0, 0, 0); } \
        __builtin_amdgcn_s_setprio(0); } while (0)
#define PG8_WAIT_V(n) asm volatile("s_waitcnt vmcnt(" #n ")" ::: "memory")
#define PG8_WAIT_L(n) asm volatile("s_waitcnt lgkmcnt(" #n ")" ::: "memory")
#define PG8_BAR __builtin_amdgcn_s_barrier()
#define PG8_SCHED __builtin_amdgcn_sched_barrier(0)
    Unit cur, nxt; int ui = 0;
    if (!S.next(0, cur)) return;
    f32x4 acc[2][2][4][2];
#pragma unroll
    for (int a = 0; a < 2; ++a)
#pragma unroll
        for (int b = 0; b < 2; ++b)
#pragma unroll
            for (int m = 0; m < 4; ++m)
#pragma unroll
                for (int n = 0; n < 2; ++n) acc[a][b][m][n] = (f32x4){0.f, 0.f, 0.f, 0.f};
    bf16x8 At[4][2], B0[2][2], B1[2][2];
    const char* cA = S.a_ptr(cur); const char* cB = S.b_ptr(cur);
    PG8_STAGE(PG8_SB(0, 0), cB, voffB); PG8_STAGE(PG8_SB(0, 1), cB + hstep, voffB); PG8_STAGE(PG8_SA(0, 0), cA, voffA); PG8_STAGE(PG8_SA(0, 1), cA + hstep, voffA);
    if (wr == 1) PG8_BAR;
    PG8_WAIT_V(2); PG8_BAR;
    PG8_STAGE(PG8_SB(1, 0), cB + kstep, voffB); PG8_STAGE(PG8_SA(1, 0), cA + kstep, voffA); PG8_STAGE(PG8_SB(1, 1), cB + hstep + kstep, voffB);
    PG8_WAIT_V(6); PG8_BAR;
    for (;;) {
        const bool has_next = S.next(ui + 1, nxt);
        const char* nA = has_next ? S.a_ptr(nxt) : cA; const char* nB = has_next ? S.b_ptr(nxt) : cB;
#pragma unroll 1
        for (int t = 0; t < nt; t += 2) {
            const bool last = (t == nt - 2);
            const char* a1 = cA + (size_t)(t + 1) * kstep;
            const char* a2 = last ? nA : cA + (size_t)(t + 2) * kstep; const char* b2 = last ? nB : cB + (size_t)(t + 2) * kstep;
            const char* a3 = a2 + kstep; const char* b3 = b2 + kstep;
            PG8_LDB(B0, 0, 0); PG8_LDB(B1, 0, 1); PG8_SCHED; PG8_LDA(At, 0, 0); PG8_STAGE(PG8_SA(1, 1), a1 + hstep, voffA);
            PG8_WAIT_V(8); PG8_WAIT_L(0); PG8_BAR; PG8_MMA(0, 0, At, B0); PG8_MMA(0, 1, At, B1); PG8_BAR; PG8_SCHED;
            PG8_LDA(At, 0, 1); PG8_STAGE(PG8_SB(0, 0), b2, voffB); PG8_STAGE(PG8_SB(0, 1), b2 + hstep, voffB); PG8_STAGE(PG8_SA(0, 0), a2, voffA);
            PG8_WAIT_V(8); PG8_WAIT_L(0); PG8_BAR; PG8_MMA(1, 0, At, B0); PG8_MMA(1, 1, At, B1); PG8_BAR; PG8_SCHED;
            PG8_LDB(B0, 1, 0); PG8_LDB(B1, 1, 1); PG8_SCHED; PG8_LDA(At, 1, 0); PG8_STAGE(PG8_SA(0, 1), a2 + hstep, voffA);
            PG8_WAIT_V(8); PG8_WAIT_L(0); PG8_BAR; PG8_MMA(0, 0, At, B0); PG8_MMA(0, 1, At, B1); PG8_BAR; PG8_SCHED;
            PG8_LDA(At, 1, 1); PG8_STAGE(PG8_SB(1, 0), b3, voffB); PG8_STAGE(PG8_SB(1, 1), b3 + hstep, voffB); PG8_STAGE(PG8_SA(1, 0), a3, voffA);
            PG8_WAIT_V(8); PG8_WAIT_L(0); PG8_BAR; PG8_MMA(1, 0, At, B0); PG8_MMA(1, 1, At, B1); PG8_BAR; PG8_SCHED;
        }
        if (wr == 0) PG8_BAR;
        if constexpr (F8) asm volatile("s_nop 15\n\ts_nop 7" ::: "memory");
        { int tz = threadIdx.x; asm volatile("" : "+v"(tz));
          const int wid2 = __builtin_amdgcn_readfirstlane(tz >> 6), lane2 = tz & 63; E(acc, cur, wid2 >> 2, wid2 & 3, lane2 & 15, lane2 >> 4); }
        if (!has_next) break;
        if (!(Epi::CHAIN && cur.kind == 0)) {
#pragma unroll
            for (int a = 0; a < 2; ++a)
#pragma unroll
                for (int b = 0; b < 2; ++b)
#pragma unroll
                    for (int m = 0; m < 4; ++m)
#pragma unroll
                        for (int n = 0; n < 2; ++n) acc[a][b][m][n] = (f32x4){0.f, 0.f, 0.f, 0.f};
        }
        cur = nxt; cA = nA; cB = nB; ++ui;
        if (wr == 1) PG8_BAR;
    }
    PG8_WAIT_V(0);
    PG8_BAR;
#undef PG8_SA
#undef PG8_SB
#undef PG8_STAGE
#undef PG8_LDA
#undef PG8_LDB
#undef PG8_MMA
#undef PG8_CAT
#undef PG8_WAIT_V
#undef PG8_WAIT_L
#undef PG8_BAR
#undef PG8_SCHED
}
}
namespace pg8 {
__device__ __forceinline__ u32x4 pack8(const f32x4 a, const f32x4 b) { u32x4 w; w.x = cvt_pk_bf16(a[0], a[1]); w.y = cvt_pk_bf16(a[2], a[3]); w.z = cvt_pk_bf16(b[0], b[1]); w.w = cvt_pk_bf16(b[2], b[3]); return w; }
__device__ __forceinline__ float sumsq4(const f32x4 a) { return (a[0] * a[0] + a[1] * a[1]) + (a[2] * a[2] + a[3] * a[3]); }
#define EPI_BAR() do { asm volatile("s_waitcnt lgkmcnt(0)" ::: "memory"); __builtin_amdgcn_s_barrier(); asm volatile("" ::: "memory"); } while (0)

struct EpiIn {
    static constexpr bool PERM = true, CHAIN = false;
    bf16_t *QA, *KA, *VA, *ZCQ, *ZCKV, *ZKR, *GATES; const float *qg, *kg; float *P6, *P7, *P8;
    __device__ __forceinline__ void operator()(f32x4 (&acc)[2][2][4][2], const Unit& u, int wr, int wc, int fr, int fq) const {
        const int row0 = u.pm * BM + wr * 64 + fr, pn = u.pn;
        if (pn < 4) {
            const float* g = (pn < 2) ? qg : kg; bf16_t* dst = (pn < 2) ? QA : KA; const int head = 4 * (pn & 1) + wc;
            f32x4 gv[2][2];
#pragma unroll
            for (int bj = 0; bj < 2; ++bj)
#pragma unroll
                for (int n = 0; n < 2; ++n) gv[bj][n] = *(const f32x4*)(g + 32 * bj + 8 * fq + 4 * n);
#pragma unroll
            for (int ai = 0; ai < 2; ++ai)
#pragma unroll
                for (int m = 0; m < 4; ++m) {
                    const size_t row = (size_t)(row0 + ai * HALF + m * 16);
                    float ss = (sumsq4(acc[ai][0][m][0]) + sumsq4(acc[ai][0][m][1])) + (sumsq4(acc[ai][1][m][0]) + sumsq4(acc[ai][1][m][1]));
                    ss += __shfl_xor(ss, 16); ss += __shfl_xor(ss, 32);
                    const float rstd = rsqrtf(ss * (1.0f / 64.0f) + RMS_EPS);
#pragma unroll
                    for (int bj = 0; bj < 2; ++bj)
                        *(u32x4*)(dst + row * 512 + head * 64 + 32 * bj + 8 * fq) = pack8(acc[ai][bj][m][0] * rstd * gv[bj][0], acc[ai][bj][m][1] * rstd * gv[bj][1]);
                }
        } else if (pn >= 9) {
#pragma unroll
            for (int ai = 0; ai < 2; ++ai)
#pragma unroll
                for (int m = 0; m < 4; ++m) {
                    const size_t row = (size_t)(row0 + ai * HALF + m * 16);
#pragma unroll
                    for (int bj = 0; bj < 2; ++bj) { f32x4 a = acc[ai][bj][m][0], b = acc[ai][bj][m][1];
#pragma unroll
                        for (int j = 0; j < 4; ++j) { a[j] = sigmoidf_(a[j]); b[j] = sigmoidf_(b[j]); }
                        *(u32x4*)(GATES + row * 2048 + (pn - 9) * 256 + 128 * bj + 32 * wc + 8 * fq) = pack8(a, b); }
                }
        } else {
#pragma unroll
            for (int ai = 0; ai < 2; ++ai)
#pragma unroll
                for (int m = 0; m < 4; ++m) {
                    const size_t row = (size_t)(row0 + ai * HALF + m * 16);
                    if (pn >= 6) {
                        float s0 = sumsq4(acc[ai][0][m][0]) + sumsq4(acc[ai][0][m][1]), s1 = sumsq4(acc[ai][1][m][0]) + sumsq4(acc[ai][1][m][1]);
                        s0 += __shfl_xor(s0, 16); s0 += __shfl_xor(s0, 32); s1 += __shfl_xor(s1, 16); s1 += __shfl_xor(s1, 32);
                        if (fq == 0) { if (pn == 6) P6[row * 4 + wc] = s0 + s1; else if (pn == 8) P8[row * 4 + wc] = s0 + s1; else { P7[row * 8 + wc] = s0; if (wc == 0) P7[row * 8 + 4] = s1; } } }
#pragma unroll
                    for (int bj = 0; bj < 2; ++bj) {
                        const u32x4 w = pack8(acc[ai][bj][m][0], acc[ai][bj][m][1]); const int cc = 128 * bj + 32 * wc + 8 * fq;
                        if (pn < 6) *(u32x4*)(VA + row * 512 + (pn - 4) * 256 + cc) = w;
                        else if (pn == 6) *(u32x4*)(ZCQ + row * QLORA + cc) = w;
                        else if (pn == 8) *(u32x4*)(ZCKV + row * KVLORA + cc) = w;
                        else { if (bj == 0) *(u32x4*)(ZCQ + row * QLORA + 256 + cc) = w; else if (wc == 0) *(u32x4*)(ZKR + row * ROPED + 8 * fq) = w; }
                    }
                }
        }
    }
};

__device__ __forceinline__ void rope8(float (&v)[8], const LAS float* rope, int s  , int fq) {
    const int pos = (fq < 2) ? (s >> 6) : (s & 63);
    const f32x4 c0 = *(const LAS f32x4*)(rope + pos * 8), c1 = *(const LAS f32x4*)(rope + pos * 8 + 4), s0 = *(const LAS f32x4*)(rope + 512 + pos * 8), s1 = *(const LAS f32x4*)(rope + 512 + pos * 8 + 4);
    const float cs[8] = {c0[0], c0[1], c0[2], c0[3], c1[0], c1[1], c1[2], c1[3]}, sn[8] = {s0[0], s0[1], s0[2], s0[3], s1[0], s1[1], s1[2], s1[3]};
#pragma unroll
    for (int i = 0; i < 8; ++i) { const float o = __shfl_xor(v[i], 16); v[i] = (fq & 1) ? (o * sn[i] + v[i] * cs[i]) : (v[i] * cs[i] - o * sn[i]); }
}

struct EpiQ {
    static constexpr bool PERM = true, CHAIN = false;
    bf16_t* QB; const float *p6, *p7, *g; const LAS float* rope; LAS float* P;
    __device__ __forceinline__ void operator()(f32x4 (&acc)[2][2][4][2], const Unit& u, int wr, int wc, int fr, int fq) const {
        const int row0 = u.pm * BM + wr * 64 + fr; const bool isx = u.pm < MT_X;
        float r8[8];
#pragma unroll
        for (int i = 0; i < 8; ++i) { const size_t row = (size_t)(row0 + (i >> 2) * HALF + (i & 3) * 16); const f32x4 a = *(const f32x4*)(p6 + row * 4), b = *(const f32x4*)(p7 + row * 8);
            r8[i] = rsqrtf((((a[0] + a[1]) + (a[2] + a[3])) + ((b[0] + b[1]) + (b[2] + b[3]))) * (1.0f / QLORA) + RMS_EPS); }
        const int gq = (wc < 3) ? wc : 0;
        const f32x4 g0 = *(const f32x4*)(g + 32 * gq + 8 * fq), g1 = *(const f32x4*)(g + 32 * gq + 8 * fq + 4);
#pragma unroll
        for (int ai = 0; ai < 2; ++ai)
#pragma unroll
            for (int m = 0; m < 4; ++m) {
                const float r = r8[ai * 4 + m]; const int rl = ai * 64 + m * 16 + fr;
#pragma unroll
                for (int bj = 0; bj < 2; ++bj) {
                    float ss = (sumsq4(acc[ai][bj][m][0]) + sumsq4(acc[ai][bj][m][1])) * (r * r); ss += __shfl_xor(ss, 16); ss += __shfl_xor(ss, 32);
                    if (fq == 0) P[((wr * 128 + rl) * 2 + bj) * 4 + wc] = ss; }
            }
        EPI_BAR();
        if (wc < 3) {
#pragma unroll
            for (int ai = 0; ai < 2; ++ai)
#pragma unroll
                for (int m = 0; m < 4; ++m) {
                    const int row = row0 + ai * HALF + m * 16, rl = ai * 64 + m * 16 + fr; const float r = r8[ai * 4 + m];
#pragma unroll
                    for (int bj = 0; bj < 2; ++bj) {
                        const f32x4 p = *(const LAS f32x4*)(P + ((wr * 128 + rl) * 2 + bj) * 4);
                        const float rstd = r * rsqrtf(((p[0] + p[1]) + p[2]) * (1.0f / 96.0f) + RMS_EPS);
                        const f32x4 a = acc[ai][bj][m][0] * rstd * g0, b = acc[ai][bj][m][1] * rstd * g1;
                        float v[8] = {a[0], a[1], a[2], a[3], b[0], b[1], b[2], b[3]};
                        if (wc == 2 && isx) rope8(v, rope, row & (SEQ - 1), fq);
                        u32x4 w; w.x = cvt_pk_bf16(v[0], v[1]); w.y = cvt_pk_bf16(v[2], v[3]); w.z = cvt_pk_bf16(v[4], v[5]); w.w = cvt_pk_bf16(v[6], v[7]);
                        *(u32x4*)(QB + (size_t)row * 768 + (2 * u.pn + bj) * QKD + 32 * wc + 8 * fq) = w;
                    }
                    asm volatile("" ::: "memory");
                }
        }
    }
};

struct EpiKV {
    static constexpr bool PERM = true, CHAIN = false;
    bf16_t *KB, *VB; const bf16_t* ZKR; const float *p7, *p8, *g; const LAS float* rope; LAS float* P;
    __device__ __forceinline__ void operator()(f32x4 (&acc)[2][2][4][2], const Unit& u, int wr, int wc, int fr, int fq) const {
        const int row0 = u.pm * BM + wr * 64 + fr; const bool isx = u.pm < MT_X;
        float r8[8], k8[8]; u32x4 zk8[8];
#pragma unroll
        for (int i = 0; i < 8; ++i) { const int row = row0 + (i >> 2) * HALF + (i & 3) * 16; const f32x4 a = *(const f32x4*)(p8 + (size_t)row * 4);
            k8[i] = p7[(size_t)row * 8 + 4]; r8[i] = rsqrtf(((a[0] + a[1]) + (a[2] + a[3])) * (1.0f / KVLORA) + RMS_EPS);
            zk8[i] = (u32x4){0u, 0u, 0u, 0u}; if (wc == 2) zk8[i] = *(const u32x4*)(ZKR + (size_t)row * ROPED + 8 * fq); }
        const int gofs = (wc < 2) ? (32 * wc + 8 * fq) : (64 + 8 * fq);
        const f32x4 g0 = *(const f32x4*)(g + gofs), g1 = *(const f32x4*)(g + gofs + 4);
        if (wc < 2) {
#pragma unroll
            for (int ai = 0; ai < 2; ++ai)
#pragma unroll
                for (int m = 0; m < 4; ++m) { const float r = r8[ai * 4 + m]; const int rl = ai * 64 + m * 16 + fr;
#pragma unroll
                    for (int bj = 0; bj < 2; ++bj) { float ss = (sumsq4(acc[ai][bj][m][0]) + sumsq4(acc[ai][bj][m][1])) * (r * r); ss += __shfl_xor(ss, 16); ss += __shfl_xor(ss, 32);
                        if (fq == 0) P[((wr * 128 + rl) * 2 + bj) * 4 + wc] = ss + ((wc == 0) ? k8[ai * 4 + m] : 0.f); } }
        }
        EPI_BAR();
#pragma unroll
        for (int ai = 0; ai < 2; ++ai)
#pragma unroll
            for (int m = 0; m < 4; ++m) {
                const int row = row0 + ai * HALF + m * 16, rl = ai * 64 + m * 16 + fr;
                const float rr = r8[ai * 4 + m]; const u32x4 zk = zk8[ai * 4 + m];
#pragma unroll
                for (int bj = 0; bj < 2; ++bj) {
                    const int head = 2 * u.pn + bj;
                    const f32x4 p = *(const LAS f32x4*)(P + ((wr * 128 + rl) * 2 + bj) * 4);
                    const float rstd = rsqrtf((p[0] + p[1]) * (1.0f / 96.0f) + RMS_EPS);
                    if (wc < 2) {
                        *(u32x4*)(KB + (size_t)row * 768 + head * QKD + 32 * wc + 8 * fq) = pack8(acc[ai][bj][m][0] * (rr * rstd) * g0, acc[ai][bj][m][1] * (rr * rstd) * g1);
                    } else {
                        *(u32x4*)(VB + (size_t)row * 512 + head * 64 + 32 * (wc - 2) + 8 * fq) = pack8(acc[ai][bj][m][0] * rr, acc[ai][bj][m][1] * rr);
                        if (wc == 2) {
                            float v[8] = {bf_lo(zk.x) * rstd * g0[0], bf_hi(zk.x) * rstd * g0[1], bf_lo(zk.y) * rstd * g0[2], bf_hi(zk.y) * rstd * g0[3],
                                          bf_lo(zk.z) * rstd * g1[0], bf_hi(zk.z) * rstd * g1[1], bf_lo(zk.w) * rstd * g1[2], bf_hi(zk.w) * rstd * g1[3]};
                            if (isx) rope8(v, rope, row & (SEQ - 1), fq);
                            u32x4 w; w.x = cvt_pk_bf16(v[0], v[1]); w.y = cvt_pk_bf16(v[2], v[3]); w.z = cvt_pk_bf16(v[4], v[5]); w.w = cvt_pk_bf16(v[6], v[7]);
                            *(u32x4*)(KB + (size_t)row * 768 + head * QKD + 64 + 8 * fq) = w;
                        }
                    }
                }
                asm volatile("" ::: "memory");
            }
    }
};

struct EpiMerge {
    static constexpr bool PERM = true, CHAIN = true;
    const bf16_t* GATES; bf16_t* Y;
    __device__ __forceinline__ void operator()(f32x4 (&acc)[2][2][4][2], const Unit& u, int wr, int wc, int fr, int fq) const {
        const int row0 = u.pm * BM + wr * 64 + fr;
#pragma unroll
        for (int ai = 0; ai < 2; ++ai)
#pragma unroll
            for (int m = 0; m < 4; ++m) {
                const size_t row = (size_t)(row0 + ai * HALF + m * 16);
#pragma unroll
                for (int bj = 0; bj < 2; ++bj) {
                    const int col = u.pn * 256 + 128 * bj + 32 * wc + 8 * fq;
                    const u32x4 gb = *(const u32x4*)(GATES + row * 2048 + 1024 + col);
                    const f32x4 b0 = (f32x4){bf_lo(gb.x), bf_hi(gb.x), bf_lo(gb.y), bf_hi(gb.y)}, b1 = (f32x4){bf_lo(gb.z), bf_hi(gb.z), bf_lo(gb.w), bf_hi(gb.w)};
                    if (u.kind == 0) {
                        const u32x4 ga = *(const u32x4*)(GATES + row * 2048 + col);
                        const f32x4 a0 = (f32x4){bf_lo(ga.x), bf_hi(ga.x), bf_lo(ga.y), bf_hi(ga.y)}, a1 = (f32x4){bf_lo(ga.z), bf_hi(ga.z), bf_lo(ga.w), bf_hi(ga.w)};
#pragma unroll
                        for (int j = 0; j < 4; ++j) { acc[ai][bj][m][0][j] *= a0[j] * __builtin_amdgcn_rcpf(b0[j]); acc[ai][bj][m][1][j] *= a1[j] * __builtin_amdgcn_rcpf(b1[j]); }
                    } else {
                        *(u32x4*)(Y + row * 1024 + col) = pack8(acc[ai][bj][m][0] * b0, acc[ai][bj][m][1] * b1);
                    }
                }
            }
    }
};

struct EpiOut {
    static constexpr bool PERM = false, CHAIN = false;
    const float* xsrc; float* xdst; const float* csrc; float* cdst; const float* mod  ; int goff;
    __device__ __forceinline__ void operator()(f32x4 (&acc)[2][2][4][2], const Unit& u, int wr, int wc, int fr, int fq) const {
        const bool isx = u.pm < MT_X;
        const int rowt = (isx ? u.pm : u.pm - MT_X) * BM + wr * 64 + fr;
        const float* src = isx ? xsrc : csrc; float* dst = isx ? xdst : cdst;
        const float* gm = mod + (size_t)(isx ? (u.pm >> 3) : 16) * NMODC + goff;
        const int col0 = u.pn * BM + wc * 32 + 4 * fq;
        f32x4 gv[2][2];
#pragma unroll
        for (int bj = 0; bj < 2; ++bj)
#pragma unroll
            for (int n = 0; n < 2; ++n) gv[bj][n] = *(const f32x4*)(gm + col0 + bj * HALF + n * 16);
#pragma unroll
        for (int ai = 0; ai < 2; ++ai)
#pragma unroll
            for (int m = 0; m < 4; ++m) { const size_t off = (size_t)(rowt + ai * HALF + m * 16) * DM + col0;
#pragma unroll
                for (int bj = 0; bj < 2; ++bj)
#pragma unroll
                    for (int n = 0; n < 2; ++n) { const f32x4 xs = *(const f32x4*)(src + off + bj * HALF + n * 16); *(f32x4*)(dst + off + bj * HALF + n * 16) = xs + gv[bj][n] * acc[ai][bj][m][n]; }
            }
    }
};

template <bool F8> struct EpiMoe1 {
    static constexpr bool PERM = true, CHAIN = false;
    bf16_t* HM; float ascale;
    __device__ __forceinline__ void operator()(f32x4 (&acc)[2][2][4][2], const Unit& u, int wr, int wc, int fr, int fq) const {
        const int row0 = u.pm * BM + wr * 64 + fr;
#pragma unroll
        for (int ai = 0; ai < 2; ++ai)
#pragma unroll
            for (int m = 0; m < 4; ++m) { const size_t row = (size_t)(row0 + ai * HALF + m * 16);
#pragma unroll
                for (int bj = 0; bj < 2; ++bj) { f32x4 p = acc[ai][bj][m][0], q = acc[ai][bj][m][1];
                    if (F8) { p = p * ascale; q = q * ascale; }
                    const float h0 = p[0] * sigmoidf_(p[0]) * p[1], h1 = p[2] * sigmoidf_(p[2]) * p[3], h2 = q[0] * sigmoidf_(q[0]) * q[1], h3 = q[2] * sigmoidf_(q[2]) * q[3];
                    const int col = u.pn * 128 + 64 * bj + 16 * wc + 4 * fq;
                    if (F8) *(unsigned*)((unsigned char*)HM + row * DM + col) = cvt_pk4_fp8(h0 * F8_SM, h1 * F8_SM, h2 * F8_SM, h3 * F8_SM);
                    else { u32x2 w; w.x = cvt_pk_bf16(h0, h1); w.y = cvt_pk_bf16(h2, h3); *(u32x2*)(HM + row * DM + col) = w; } }
            }
    }
};
struct EpiMoe2 {
    static constexpr bool PERM = true, CHAIN = false;
    bf16_t* YS; float ascale;
    __device__ __forceinline__ void operator()(f32x4 (&acc)[2][2][4][2], const Unit& u, int wr, int wc, int fr, int fq) const {
        const int row0 = u.pm * BM + wr * 64 + fr;
#pragma unroll
        for (int ai = 0; ai < 2; ++ai)
#pragma unroll
            for (int m = 0; m < 4; ++m) { const size_t row = (size_t)(row0 + ai * HALF + m * 16);
#pragma unroll
                for (int bj = 0; bj < 2; ++bj) *(u32x4*)(YS + row * DM + u.pn * 256 + 128 * bj + 32 * wc + 8 * fq) = pack8(acc[ai][bj][m][0] * ascale, acc[ai][bj][m][1] * ascale); }
    }
};

struct SchedRect {
    const char* A; const char* B; size_t tstep; int nM, nN, G, c, nM2, pn2, npn2;
    __device__ __forceinline__ bool next(int i, Unit& u) const {
        const int L = i * G + c, mainc = nM * nN; u.kind = 0; u.e = 0;
        if (L < mainc) { rect_tile(L, nM, nN, u.pm, u.pn); return true; }
        const int Lx = L - mainc; if (Lx >= nM2 * npn2) return false;
        u.pm = nM + Lx / npn2; u.pn = pn2 + Lx % npn2; return true;
    }
    __device__ __forceinline__ const char* a_ptr(const Unit& u) const { return A + (size_t)u.pm * tstep; }
    __device__ __forceinline__ const char* b_ptr(const Unit& u) const { return B + (size_t)u.pn * tstep; }
};
struct SchedMerge {
    const char *OA, *OB, *WA, *WB; size_t tstep; int nM, nN, G, c;
    __device__ __forceinline__ bool next(int i, Unit& u) const {
        const int L = (i >> 1) * G + c; if (L >= nM * nN) return false;
        rect_tile(L, nM, nN, u.pm, u.pn); u.kind = i & 1; u.e = 0; return true;
    }
    __device__ __forceinline__ const char* a_ptr(const Unit& u) const { return (u.kind ? OB : OA) + (size_t)u.pm * tstep; }
    __device__ __forceinline__ const char* b_ptr(const Unit& u) const { return (u.kind ? WB : WA) + (size_t)u.pn * tstep; }
};
struct SchedMoe {
    const char* A; const char* W; size_t tstepA, wstride, tstepB; const LAS int* tile_e  ; int ntile, nN, G, c;
    __device__ __forceinline__ bool next(int i, Unit& u) const {
        const int L = i * G + c; if (L >= ntile * nN) return false;
        rect_tile(L, ntile, nN, u.pm, u.pn); u.kind = 0;
        u.e = __builtin_amdgcn_readfirstlane(tile_e[u.pm]); return true;
    }
    __device__ __forceinline__ const char* a_ptr(const Unit& u) const { return A + (size_t)u.pm * tstepA; }
    __device__ __forceinline__ const char* b_ptr(const Unit& u) const { return W + (size_t)u.e * wstride + (size_t)u.pn * tstepB; }
};
}
namespace att {
constexpr int NW = 8, QBLK = 32, KVBLK = 64, DV = 64;
constexpr int SHM_V = 16384, SHM_K = 16384;
constexpr int LDS_VOFF = 0, LDS_KOFF = 2 * SHM_V, LDS_WS = LDS_KOFF + 2 * SHM_K, LDS_OST = LDS_WS + NW * 64 * 4, LDS_BIAS = LDS_OST + NW * 4096, LDS_MASK = LDS_BIAS + 16 * 128 * 4, LDS_END = LDS_MASK + 64 * 64 * 4;
static_assert(LDS_END <= RING_BYTES, "attention LDS map");
template <int DQK> struct KL { static constexpr int PITCH = (DQK == 64) ? 128 : 256; };
#define KSWZ(row, colB) ((row) * KL<DQK>::PITCH + ((colB) ^ (((row) & 7) << 4)))
#define SBAR() __builtin_amdgcn_sched_barrier(0)
__device__ __forceinline__ int crow(int r, int hi) { return (r & 3) + 8 * (r >> 2) + 4 * hi; }
__device__ __forceinline__ int v_st(int k, int c) { const int kk = (k & ~0xC) | ((k & 4) << 1) | ((k & 8) >> 1); return ((kk >> 3) * 2 + (c >> 5)) * 512 + ((kk & 7) * 32 + (c & 31)) * 2; }
__device__ __forceinline__ int v_rd_base(int lane, int c) { const int hi = (lane >> 5) & 1, g = c + hi;
    return ((lane & 3) << 3) | (((lane >> 2) & 3) << 6) | (((lane >> 4) & 1) << 5) | ((g & 1) << 8) | ((g >> 1) << 11); }
constexpr int v_rd_off(int d0, int ks, int half) { return ((2 * ks + half) * 2 + d0) * 512; }
template <int OFF> __device__ __forceinline__ s16x4 tr_read(int vb) { s16x4 r; asm volatile("ds_read_b64_tr_b16 %0, %1 offset:%2" : "=&v"(r) : "v"(vb), "i"(OFF) : "memory"); return r; }

template <int D0> __device__ __forceinline__ void pv_one(f32x16& od, int vbA, int vbB, bf16x8 pa0, bf16x8 pa1, bf16x8 pa2, bf16x8 pa3) {
    const s16x4 l0 = tr_read<v_rd_off(D0, 0, 0)>(vbA), h0 = tr_read<v_rd_off(D0, 0, 1)>(vbA), l1 = tr_read<v_rd_off(D0, 1, 0)>(vbA), h1 = tr_read<v_rd_off(D0, 1, 1)>(vbA);
    const s16x4 l2 = tr_read<v_rd_off(D0, 0, 0)>(vbB), h2 = tr_read<v_rd_off(D0, 0, 1)>(vbB), l3 = tr_read<v_rd_off(D0, 1, 0)>(vbB), h3 = tr_read<v_rd_off(D0, 1, 1)>(vbB);
    asm volatile("s_waitcnt lgkmcnt(0)" ::: "memory"); SBAR();
#define PK(L, H) (bf16x8){L[0], L[1], L[2], L[3], H[0], H[1], H[2], H[3]}
    od = __builtin_amdgcn_mfma_f32_32x32x16_bf16(pa0, PK(l0, h0), od, 0, 0, 0);
    od = __builtin_amdgcn_mfma_f32_32x32x16_bf16(pa1, PK(l1, h1), od, 0, 0, 0);
    od = __builtin_amdgcn_mfma_f32_32x32x16_bf16(pa2, PK(l2, h2), od, 0, 0, 0);
    od = __builtin_amdgcn_mfma_f32_32x32x16_bf16(pa3, PK(l3, h3), od, 0, 0, 0);
#undef PK
}
__device__ __forceinline__ void pv_all(f32x16* o, int vbA, int vbB, bf16x8 pa0, bf16x8 pa1, bf16x8 pa2, bf16x8 pa3) { pv_one<0>(o[0], vbA, vbB, pa0, pa1, pa2, pa3); pv_one<1>(o[1], vbA, vbB, pa0, pa1, pa2, pa3); }

#define MX3(a, b, c) __builtin_fmaxf(__builtin_fmaxf((a), (b)), (c))
template <bool FIRST>
__device__ __forceinline__ void partialSM(f32x16& p0, f32x16& p1, float& m_reg, float& alpha, f32x16& negm, const float THR2) {
    float a = MX3(p0[0], p0[1], p1[0]), b = MX3(p0[2], p0[3], p1[1]); a = MX3(a, p1[2], p1[3]);
#pragma unroll
    for (int r = 4; r < 16; r += 4) { a = MX3(a, p0[r], p0[r + 1]); b = MX3(b, p0[r + 2], p0[r + 3]); a = MX3(a, p1[r], p1[r + 1]); b = MX3(b, p1[r + 2], p1[r + 3]); }
    float pmax = __builtin_fmaxf(a, b);
    { auto rr = __builtin_amdgcn_permlane32_swap(__float_as_uint(pmax), __float_as_uint(pmax), false, false); pmax = __builtin_fmaxf(__uint_as_float(rr[0]), __uint_as_float(rr[1])); }
    alpha = 1.f;
    if (FIRST || !__builtin_expect(__all(pmax <= THR2), 1)) {
        const float dl = FIRST ? pmax : __builtin_fmaxf(pmax, 0.f);
        m_reg += dl; alpha = FIRST ? 1.f : __builtin_amdgcn_exp2f(-dl);
#pragma unroll
        for (int r = 0; r < 16; ++r) { p0[r] -= dl; p1[r] -= dl; }
#pragma unroll
        for (int r = 0; r < 16; ++r) negm[r] = -m_reg;
    }
#pragma unroll
    for (int r = 0; r < 16; ++r) p0[r] = __builtin_amdgcn_exp2f(p0[r]);
}
__device__ __forceinline__ void finishSM(f32x16& p0, f32x16& p1, float alpha, float& l_reg, bf16x8& pa0, bf16x8& pa1, bf16x8& pa2, bf16x8& pa3) {
#pragma unroll
    for (int r = 0; r < 16; ++r) p1[r] = __builtin_amdgcn_exp2f(p1[r]);
    float ps = 0;
#pragma unroll
    for (int r = 0; r < 16; ++r) ps += p0[r];
#pragma unroll
    for (int r = 0; r < 16; ++r) ps += p1[r];
    { auto rr = __builtin_amdgcn_permlane32_swap(__float_as_uint(ps), __float_as_uint(ps), false, false); ps = __uint_as_float(rr[0]) + __uint_as_float(rr[1]); }
    l_reg = l_reg * alpha + ps;
#define PK4(P, BASE, OUT) do { unsigned a0 = cvt_pk_bf16(P[BASE + 0], P[BASE + 1]), a1 = cvt_pk_bf16(P[BASE + 2], P[BASE + 3]);   \
    unsigned b0 = cvt_pk_bf16(P[BASE + 4], P[BASE + 5]), b1 = cvt_pk_bf16(P[BASE + 6], P[BASE + 7]);                              \
    auto r0 = __builtin_amdgcn_permlane32_swap(a0, b0, false, false); auto r1 = __builtin_amdgcn_permlane32_swap(a1, b1, false, false); \
    u32x4 w = {r0[0], r1[0], r0[1], r1[1]}; OUT = *reinterpret_cast<bf16x8*>(&w); } while (0)
    PK4(p0, 0, pa0); PK4(p0, 8, pa1); PK4(p1, 0, pa2); PK4(p1, 8, pa3);
#undef PK4
}
template <int DQK> __device__ __forceinline__ void qkt(f32x16& p0, f32x16& p1, const char* Ks, int rowA, int rowB, const bf16x8* qr, const f32x16& negm, int hi) {
#pragma unroll
    for (int d0 = 0; d0 < DQK / 16; ++d0) { const int cb = (d0 * 16 + hi * 8) * 2;
        const bf16x8 b0 = *reinterpret_cast<const bf16x8*>(Ks + KSWZ(rowA, cb));
        const bf16x8 b1 = *reinterpret_cast<const bf16x8*>(Ks + KSWZ(rowB, cb));
        if (d0 == 0) { p0 = __builtin_amdgcn_mfma_f32_32x32x16_bf16(b0, qr[0], negm, 0, 0, 0); p1 = __builtin_amdgcn_mfma_f32_32x32x16_bf16(b1, qr[0], negm, 0, 0, 0); }
        else { p0 = __builtin_amdgcn_mfma_f32_32x32x16_bf16(b0, qr[d0], p0, 0, 0, 0); p1 = __builtin_amdgcn_mfma_f32_32x32x16_bf16(b1, qr[d0], p1, 0, 0, 0); } }
}

struct UnitArgs {
    const bf16_t* Q; int ldq; int qcol;
    const bf16_t* K; int ldk; int kcol;
    const bf16_t* V; int vcol;
    bf16_t* O; int ocol;
    int q0;
    int ctx0, loc0;
    int NT;
    int masked;
    int band, krow0;
    const float* bias;
    float C;
};

__device__ __forceinline__ void na_mask(f32x16& p0, f32x16& p1, const LAS float* bt, const LAS float* mk, int krA, int qrow, int qc, int kc0, int hi) {
    const int rs = min(max(qrow - 4, 0), 24);
    const int drA = ((krA >= rs) && (krA < rs + 8)) ? (krA - qrow + 7) : 15, drB = ((krA + 1 >= rs) && (krA + 1 < rs + 8)) ? (krA + 1 - qrow + 7) : 15;
    const LAS float* bA = bt + drA * 128 + (kc0 + 4 * hi - qc + 64); const LAS float* bB = bt + drB * 128 + (kc0 + 4 * hi - qc + 64);
    const LAS float* mq = mk + qc * 64 + kc0 + 4 * hi;
#pragma unroll
    for (int g = 0; g < 4; ++g) {
        const f32x4 m0 = *(const LAS f32x4*)(mq + 8 * g);
#pragma unroll
        for (int j = 0; j < 4; ++j) { p0[4 * g + j] = (p0[4 * g + j] + bA[8 * g + j]) + m0[j]; p1[4 * g + j] = (p1[4 * g + j] + bB[8 * g + j]) + m0[j]; }
    }
}
__device__ __forceinline__ void na_mask_table(char* lds) {
    LAS float* mk = (LAS float*)(lds + LDS_MASK);
    int t0 = threadIdx.x; asm volatile("" : "+v"(t0));
    for (int i = t0; i < 64 * 64; i += 512) { const int qc = i >> 6, kc = i & 63, cs = min(max(qc - 8, 0), 48); mk[i] = ((unsigned)(kc - cs) < 16u) ? 0.f : -1e30f; }
}

template <int DQK>
__device__ __forceinline__ void attn_unit(const UnitArgs& A, char* lds) {
    int tid = threadIdx.x; asm volatile("" : "+v"(tid));
    const int wid = tid >> 6, lane = tid & 63, r32 = lane & 31, hi = lane >> 5;
    char* V_lds = lds + LDS_VOFF; char* K_lds = lds + LDS_KOFF;
    float* ws = (float*)(lds + LDS_WS) + wid * 64; float* li_l = ws; float* al_l = ws + 32;
    const LAS float* bt = (const LAS float*)(lds + LDS_BIAS); const LAS float* mk = (const LAS float*)(lds + LDS_MASK);
    const float C = A.C, THR2 = 8.0f * 1.4426950408889634f;
    const bool msk = (DQK == 64) && A.masked;
    float m_reg = 0.f, l_reg = 0; f32x16 o[2] = {}; bf16x8 qr[DQK / 16]; f32x16 negm = f32x16{};
    if (msk) { for (int i = tid; i < 16 * 128; i += 512) { const int dr = i >> 7, d = (i & 127) - 64;
            ((LAS float*)(lds + LDS_BIAS))[i] = (dr == 15) ? -1e30f : ((d >= -15 && d <= 15) ? A.bias[dr * 31 + d + 15] * 1.4426950408889634f : 0.f); } }
    const int qrow = 4 * A.band + 2 * (wid >> 2) + (r32 >> 4), qc = 16 * (wid & 3) + (r32 & 15);
    const int kc0 = msk ? min(max(16 * (wid & 3) - 8, 0), 32) : 0;
    const int qtok = msk ? (A.q0 + 64 * (2 * (wid >> 2) + (r32 >> 4)) + qc) : (A.q0 + wid * QBLK + r32);
    const bf16_t* Qw = A.Q + (size_t)qtok * A.ldq + A.qcol + hi * 8;
#pragma unroll
    for (int d0 = 0; d0 < DQK / 16; ++d0) { const u32x4 w = *reinterpret_cast<const u32x4*>(Qw + d0 * 16);
        u32x4 t; t.x = cvt_pk_bf16(bf_lo(w.x) * C, bf_hi(w.x) * C); t.y = cvt_pk_bf16(bf_lo(w.y) * C, bf_hi(w.y) * C); t.z = cvt_pk_bf16(bf_lo(w.z) * C, bf_hi(w.z) * C); t.w = cvt_pk_bf16(bf_lo(w.w) * C, bf_hi(w.w) * C);
        qr[d0] = *reinterpret_cast<bf16x8*>(&t); }
    constexpr int CPR = DQK / 8;
    const int v0key = tid >> 3, vc = (tid & 7) * 8, vst0 = v_st(v0key, vc), vst1 = 8192 + vst0;
    const int k0key = tid / CPR, k0c = tid % CPR, k1id = tid + 512, k1key = k1id / CPR, k1c = k1id % CPR;
    const int vbS = (int)(uintptr_t)V_lds + v_rd_base(lane, 0);
    const int vbM = (int)(uintptr_t)V_lds + v_rd_base(lane, kc0 >> 3);
    bf16x8 sv0, sv1 = {}, sk0, sk1 = {};
#define LOCAL(t) (msk && (t) >= 4)
#define TROW(t) (((t) < 4) ? (A.ctx0 + 64 * (t)) : (A.loc0 + (msk ? 128 : 64) * ((t) - 4)))
#define K1ON(t) ((DQK == 96) ? (tid < 256) : LOCAL(t))
#define SLOAD(t) do { const int _r0 = TROW(t); sv0 = *reinterpret_cast<const bf16x8*>(A.V + (size_t)(_r0 + v0key) * 512 + A.vcol + vc); \
        sk0 = *reinterpret_cast<const bf16x8*>(A.K + (size_t)(_r0 + k0key) * A.ldk + A.kcol + k0c * 8); \
        if (K1ON(t)) sk1 = *reinterpret_cast<const bf16x8*>(A.K + (size_t)(_r0 + k1key) * A.ldk + A.kcol + k1c * 8); \
        if (LOCAL(t)) sv1 = *reinterpret_cast<const bf16x8*>(A.V + (size_t)(_r0 + 64 + v0key) * 512 + A.vcol + vc); } while (0)
#define SWRITE(b, t) do { *reinterpret_cast<bf16x8*>(V_lds + (b) * SHM_V + vst0) = sv0; *reinterpret_cast<bf16x8*>(K_lds + (b) * SHM_K + KSWZ(k0key, k0c * 16)) = sk0; \
        if (K1ON(t)) *reinterpret_cast<bf16x8*>(K_lds + (b) * SHM_K + KSWZ(k1key, k1c * 16)) = sk1; \
        if (LOCAL(t)) *reinterpret_cast<bf16x8*>(V_lds + (b) * SHM_V + vst1) = sv1; } while (0)
#define RESC(a) do { if (__any((a) < 1.f)) { if (hi == 0) al_l[r32] = (a); asm volatile("s_waitcnt lgkmcnt(0)" ::: "memory"); \
        _Pragma("unroll") for (int d = 0; d < 2; ++d) _Pragma("unroll") for (int r = 0; r < 16; ++r) o[d][r] *= al_l[crow(r, hi)]; } } while (0)
#define QKT(P0, P1, b, t) do { const int _ra = LOCAL(t) ? (kc0 + r32) : r32, _rb = LOCAL(t) ? (64 + kc0 + r32) : (32 + r32); \
        qkt<DQK>(P0, P1, K_lds + (b) * SHM_K, _ra, _rb, qr, negm, hi); if (LOCAL(t)) na_mask(P0, P1, bt, mk, A.krow0 + 2 * ((t) - 4), qrow, qc, kc0, hi); } while (0)
#define PV(b, t) do { const int _va = (LOCAL(t) ? vbM : vbS) + (b) * SHM_V, _vb = _va + (LOCAL(t) ? 8192 : 4096); pv_all(o, _va, _vb, pa0, pa1, pa2, pa3); } while (0)
    f32x16 pA0, pA1, pB0, pB1; float alA, alB; bf16x8 pa0, pa1, pa2, pa3; const int NT = A.NT;
    SLOAD(0); SWRITE(0, 0); __syncthreads();
    QKT(pA0, pA1, 0, 0); partialSM<true>(pA0, pA1, m_reg, alA, negm, THR2);
    SLOAD(1); SWRITE(1, 1); __syncthreads();
    for (int j = 1; j + 1 < NT; j += 2) {
        SBAR(); QKT(pB0, pB1, 1, j);
        finishSM(pA0, pA1, alA, l_reg, pa0, pa1, pa2, pa3); SBAR();
        SLOAD(j + 1); SBAR();
        PV(0, j - 1); partialSM<false>(pB0, pB1, m_reg, alB, negm, THR2);
        __syncthreads(); SWRITE(0, j + 1);
        RESC(alB); __syncthreads();
        SBAR(); QKT(pA0, pA1, 0, j + 1);
        finishSM(pB0, pB1, alB, l_reg, pa0, pa1, pa2, pa3); SBAR();
        SLOAD(j + 2); SBAR();
        PV(1, j); partialSM<false>(pA0, pA1, m_reg, alA, negm, THR2);
        __syncthreads(); SWRITE(1, j + 2);
        RESC(alA); __syncthreads();
    }
    SBAR(); QKT(pB0, pB1, 1, NT - 1);
    finishSM(pA0, pA1, alA, l_reg, pa0, pa1, pa2, pa3); SBAR();
    PV(0, NT - 2); partialSM<false>(pB0, pB1, m_reg, alB, negm, THR2);
    __syncthreads(); RESC(alB);
    finishSM(pB0, pB1, alB, l_reg, pa0, pa1, pa2, pa3); SBAR();
    PV(1, NT - 1);
    if (hi == 0) li_l[r32] = l_reg; asm volatile("s_waitcnt lgkmcnt(0)" ::: "memory");
    float rli[16];
#pragma unroll
    for (int r = 0; r < 16; ++r) rli[r] = __builtin_amdgcn_rcpf(li_l[crow(r, hi)]);
    bf16_t* stg = (bf16_t*)(lds + LDS_OST) + wid * 2048;
#pragma unroll
    for (int r = 0; r < 16; ++r) { const int orow = crow(r, hi);
#pragma unroll
        for (int d0 = 0; d0 < 2; ++d0) { const unsigned w = cvt_pk_bf16(o[d0][r] * rli[r], 0.f); stg[orow * 64 + d0 * 32 + r32] = (bf16_t)(w & 0xffffu); } }
    asm volatile("s_waitcnt lgkmcnt(0)" ::: "memory");
#pragma unroll
    for (int i = 0; i < 4; ++i) { const int row = i * 8 + (lane >> 3), ch = lane & 7; const u32x4 v = *(const u32x4*)(stg + row * 64 + ch * 8);
        const int otok = msk ? (A.q0 + 64 * (2 * (wid >> 2) + (row >> 4)) + 16 * (wid & 3) + (row & 15)) : (A.q0 + wid * QBLK + row);
        *(u32x4*)(A.O + (size_t)otok * 512 + A.ocol + ch * 8) = v; }
    __syncthreads();
#undef LOCAL
#undef TROW
#undef K1ON
#undef SLOAD
#undef SWRITE
#undef RESC
#undef QKT
#undef PV
}
#undef KSWZ
#undef SBAR
}
struct Frame {
    LAS unsigned char* lds;
    int tid, lane, wave, vcu, G;
};
#define CAS __attribute__((address_space(4)))
__device__ __forceinline__ const CAS char* karg() { return (const CAS char*)__builtin_amdgcn_kernarg_segment_ptr(); }
template <int I> __device__ __forceinline__ const float* in_ptr() { unsigned off = I * 8; asm volatile("" : "+s"(off)); return *(const float* const CAS*)(karg() + off); }
__device__ __forceinline__ float* out_ptr() { unsigned off = 26 * 8; asm volatile("" : "+s"(off)); return *(float* const CAS*)(karg() + off); }
__device__ __forceinline__ unsigned char* ws_ptr() { unsigned off = 27 * 8; asm volatile("" : "+s"(off)); return *(unsigned char* const CAS*)(karg() + off); }
enum { I_X = 0, I_C, I_CTX, I_CCTX, I_WADA, I_BADA, I_NMIXG, I_NFFNG, I_WIN, I_NAQG, I_NAKG, I_RPB, I_CQG, I_WUQ, I_CKVG, I_WUKV, I_QG, I_KG, I_WOA, I_WOB, I_WOUT, I_WR, I_RB, I_W1, I_W3, I_W2 };

#define LDS_WAIT() asm volatile("s_waitcnt lgkmcnt(0)" ::: "memory")

__device__ __forceinline__ int win_src_col(int np) {
    const int pn = np >> 8, cc = np & 255;
    if (pn < 4) { const int part = pn >> 1, tq = pn & 1, bj = cc >> 7, wc = (cc >> 5) & 3, i = cc & 31; return part * 512 + (4 * tq + wc) * 64 + 32 * bj + i; }
    if (pn < 6) return 1024 + (pn - 4) * 256 + cc;
    if (pn == 6) return 1536 + cc;
    if (pn == 7) return cc < 128 ? 1792 + cc : (cc < 160 ? 2176 + (cc - 128) : -1);
    if (pn == 8) return 1920 + cc;
    return 2208 + (pn - 9) * 256 + cc;
}
template <bool F8 = false>
__device__ __forceinline__ void conv_item(const float* src, size_t ld, int dcol, int dstep, const float* gain, bf16_t* WT, int K, int k0, int n0, LAS float* scr, int lane) {
    const int kr = lane >> 4;
    f32x4 v[16];
#pragma unroll
    for (int i = 0; i < 16; ++i) { v[i] = (f32x4){0.f, 0.f, 0.f, 0.f}; if (src) v[i] = __builtin_nontemporal_load((const f32x4*)(src + (size_t)(k0 + 4 * i + kr) * ld)); }
#pragma unroll
    for (int i = 0; i < 16; ++i) { const int kk = 4 * i + kr;
        if (gain) v[i] = v[i] * gain[k0 + kk];
        LAS float* s = scr + kk * 65 + dcol; s[0] = v[i][0]; s[dstep] = v[i][1]; s[2 * dstep] = v[i][2]; s[3 * dstep] = v[i][3]; }
    LDS_WAIT(); asm volatile("" ::: "memory");
    const int c = lane & 7;
#pragma unroll
    for (int j = 0; j < 8; ++j) { const int n = (lane >> 3) + 8 * j; const LAS float* s = scr + (8 * c) * 65 + n;
        if (F8) { u32x2 o; o.x = cvt_pk4_fp8(s[0 * 65] * F8_SW, s[1 * 65] * F8_SW, s[2 * 65] * F8_SW, s[3 * 65] * F8_SW); o.y = cvt_pk4_fp8(s[4 * 65] * F8_SW, s[5 * 65] * F8_SW, s[6 * 65] * F8_SW, s[7 * 65] * F8_SW);
            *(u32x2*)((unsigned char*)WT + (size_t)(n0 + n) * K + k0 + 8 * c) = o; }
        else { u32x4 o; o.x = cvt_pk_bf16(s[0 * 65], s[1 * 65]); o.y = cvt_pk_bf16(s[2 * 65], s[3 * 65]); o.z = cvt_pk_bf16(s[4 * 65], s[5 * 65]); o.w = cvt_pk_bf16(s[6 * 65], s[7 * 65]);
            *(u32x4*)(WT + (size_t)(n0 + n) * K + k0 + 8 * c) = o; } }
    LDS_WAIT(); asm volatile("" ::: "memory");
}
__device__ __forceinline__ void p0_convert(Frame& F) {
    LAS float* scr = (LAS float*)(F.lds + F.wave * 16640);
    const int gw = F.vcu * 8 + F.wave, NGW = F.G * 8, lane = F.lane, q16 = lane & 15;
    constexpr int I_IN = 16 * 68, I_UQ = 6 * 16, I_UKV = 4 * 16, I_OA = 8 * 16, I_OUT = 16 * 16, I_13 = 16 * 32 * NEXP, I_2 = 16 * 16 * NEXP;
    constexpr int PER_L = I_IN + I_UQ + I_UKV + 2 * I_OA + I_OUT + I_13 + I_2;
    unsigned char* const ws = ws_ptr();
    for (int it = gw; it < NLAYER * PER_L; it += NGW) {
        const int l = it / PER_L; int r = it - l * PER_L;
        if (r < I_IN) { const int kb = r / 68, nb = r % 68, sc = win_src_col(nb * 64 + 4 * q16);
            conv_item(sc >= 0 ? in_ptr<I_WIN>() + (size_t)l * DM * INC + sc : nullptr, INC, 4 * q16, 1, nullptr, (bf16_t*)(ws + WS_WIN) + (size_t)l * INP * DM, DM, kb * 64, nb * 64, scr, lane); continue; } r -= I_IN;
        if (r < I_UQ) { const int kb = r / 16, nb = r % 16, np = nb * 64 + 4 * q16, hh = np >> 7, dd = np & 127;
            conv_item(dd < QKD ? in_ptr<I_WUQ>() + (size_t)l * QLORA * 768 + hh * QKD + dd : nullptr, 768, 4 * q16, 1, in_ptr<I_CQG>() + l * QLORA, (bf16_t*)(ws + WS_WUQ) + (size_t)l * 1024 * QLORA, QLORA, kb * 64, nb * 64, scr, lane); continue; } r -= I_UQ;
        if (r < I_UKV) { const int kb = r / 16, nb = r % 16;
            conv_item(in_ptr<I_WUKV>() + (size_t)l * KVLORA * 1024 + nb * 64 + 4 * q16, 1024, 4 * q16, 1, in_ptr<I_CKVG>() + l * KVLORA, (bf16_t*)(ws + WS_WUKV) + (size_t)l * 1024 * KVLORA, KVLORA, kb * 64, nb * 64, scr, lane); continue; } r -= I_UKV;
        if (r < 2 * I_OA) { const int w = r / I_OA, rr = r % I_OA, kb = rr / 16, nb = rr % 16;
            conv_item((w ? in_ptr<I_WOB>() : in_ptr<I_WOA>()) + (size_t)l * 512 * DM + nb * 64 + 4 * q16, DM, 4 * q16, 1, nullptr, (bf16_t*)(ws + (w ? WS_WOB : WS_WOA)) + (size_t)l * 1024 * 512, 512, kb * 64, nb * 64, scr, lane); continue; } r -= 2 * I_OA;
        if (r < I_OUT) { const int kb = r / 16, nb = r % 16;
            conv_item(in_ptr<I_WOUT>() + (size_t)l * DM * DM + nb * 64 + 4 * q16, DM, 4 * q16, 1, nullptr, (bf16_t*)(ws + WS_WOUT) + (size_t)l * DM * DM, DM, kb * 64, nb * 64, scr, lane); continue; } r -= I_OUT;
        if (r < I_13) { const int e = r / 512, rr = r % 512, kb = rr / 32, nb = rr % 32;
            const float* base = ((q16 < 8) ? in_ptr<I_W1>() : in_ptr<I_W3>()) + ((size_t)l * NEXP + e) * DM * DM + nb * 32 + 4 * (q16 & 7);
            bf16_t* const wt = (bf16_t*)(ws + WS_W13) + ((size_t)l * NEXP) * 2048 * DM;
            if (F8LAYER(l)) { if ((kb ^ (e >> 2)) & 1) continue;
                const int k0 = (kb & ~1) * 64;
                conv_item<true>(base, DM, 8 * (q16 & 7) + (q16 >> 3), 2, nullptr, (bf16_t*)((unsigned char*)wt + (size_t)e * 2048 * DM), DM, k0, nb * 64, scr, lane);
                conv_item<true>(base, DM, 8 * (q16 & 7) + (q16 >> 3), 2, nullptr, (bf16_t*)((unsigned char*)wt + (size_t)e * 2048 * DM), DM, k0 + 64, nb * 64, scr, lane); }
            else conv_item(base, DM, 8 * (q16 & 7) + (q16 >> 3), 2, nullptr, wt + (size_t)e * 2048 * DM, DM, kb * 64, nb * 64, scr, lane);
            continue; } r -= I_13;
        { const int e = r / 256, rr = r % 256, kb = rr / 16, nb = rr % 16;
            const float* const src2 = in_ptr<I_W2>() + ((size_t)l * NEXP + e) * DM * DM + nb * 64 + 4 * q16; bf16_t* const wt = (bf16_t*)(ws + WS_W2) + ((size_t)l * NEXP) * DM * DM;
            if (F8LAYER(l)) { if ((kb ^ (e >> 3)) & 1) continue; const int k0 = (kb & ~1) * 64;
                conv_item<true>(src2, DM, 4 * q16, 1, nullptr, (bf16_t*)((unsigned char*)wt + (size_t)e * DM * DM), DM, k0, nb * 64, scr, lane);
                conv_item<true>(src2, DM, 4 * q16, 1, nullptr, (bf16_t*)((unsigned char*)wt + (size_t)e * DM * DM), DM, k0 + 64, nb * 64, scr, lane); }
            else conv_item(src2, DM, 4 * q16, 1, nullptr, wt + (size_t)e * DM * DM, DM, kb * 64, nb * 64, scr, lane); }
    }
}
__device__ __forceinline__ void p0_ada(Frame& F) {
    if ((int)blockIdx.x >= 2 * 96) return;
    unsigned char* const ws = ws_ptr(); const float* const cin = in_ptr<I_C>(); const float* const cctx = in_ptr<I_CCTX>(); const float* const wada = in_ptr<I_WADA>(); const float* const bada = in_ptr<I_BADA>();
    LAS float* sct = (LAS float*)F.lds;
    LAS float* red = (LAS float*)(F.lds + 1024 * 20 * 4);
    for (int idx = F.tid; idx < 17 * 1024; idx += 512) { const int r = idx >> 10, d = idx & 1023; const float v = (r < 16) ? cin[r * DM + d] : cctx[d]; sct[d * 20 + r] = v * (1.0f / (1.0f + expf(-v))); }
    __syncthreads();
    float* MOD = (float*)(ws + WS_MOD);
    for (int task = blockIdx.x; task < 2 * 96; task += F.G) {
        const int l = task / 96, cb = task % 96, col = cb * 64 + F.lane;
        const float* wa = wada + (size_t)l * DM * NMODC + col;
        float acc[17];
#pragma unroll
        for (int r = 0; r < 17; ++r) acc[r] = 0.f;
        for (int k = F.wave * 128; k < F.wave * 128 + 128; ++k) { const float wv = wa[(size_t)k * NMODC];
#pragma unroll
            for (int r = 0; r < 17; ++r) acc[r] += sct[k * 20 + r] * wv; }
#pragma unroll
        for (int r = 0; r < 17; ++r) red[(F.wave * 17 + r) * 64 + F.lane] = acc[r];
        __syncthreads();
        for (int idx = F.tid; idx < 17 * 64; idx += 512) { const int r = idx >> 6, cl = idx & 63; float s = bada[l * NMODC + cb * 64 + cl];
#pragma unroll
            for (int w = 0; w < 8; ++w) s += red[(w * 17 + r) * 64 + cl];
            MOD[((size_t)l * 17 + r) * NMODC + cb * 64 + cl] = s; }
        __syncthreads();
    }
    if (blockIdx.x == 0) { float* rope = (float*)(ws + WS_ROPE); const int pos = F.tid >> 3, i = F.tid & 7;
        const float inv = exp2f(-(float)i * 0.125f * 13.287712379549449f);
        const float ang = (float)pos * inv; const float rev = ang * 0.15915494309189535f, fr = rev - floorf(rev); rope[pos * 8 + i] = __builtin_amdgcn_cosf(fr); rope[512 + pos * 8 + i] = __builtin_amdgcn_sinf(fr); }
}

__device__ __forceinline__ void load_row(const float* xrow, int lane, f32x4 (&v)[4]) {
#pragma unroll
    for (int j = 0; j < 4; ++j) v[j] = *((const f32x4*)xrow + lane + 64 * j);
}
__device__ __forceinline__ float row_rstd(const f32x4 (&v)[4]) {
    float s = 0.f;
#pragma unroll
    for (int j = 0; j < 4; ++j) s += (v[j][0] * v[j][0] + v[j][1] * v[j][1]) + (v[j][2] * v[j][2] + v[j][3] * v[j][3]);
    return rsqrtf(wave_sum(s) * (1.0f / DM) + RMS_EPS);
}
__device__ __forceinline__ void normmod(const f32x4 (&v)[4], float rstd, const float* g, const float* sh, const float* sc, int lane, f32x4 (&h)[4]) {
#pragma unroll
    for (int j = 0; j < 4; ++j) { const f32x4 gv = *((const f32x4*)g + lane + 64 * j), shv = *((const f32x4*)sh + lane + 64 * j), scv = *((const f32x4*)sc + lane + 64 * j);
        h[j] = v[j] * rstd * gv * (scv + 1.0f) + shv; }
}
__device__ __forceinline__ void store_row_bf16(bf16_t* orow, int lane, const f32x4 (&h)[4]) {
#pragma unroll
    for (int j = 0; j < 4; ++j) { u32x2 w; w.x = cvt_pk_bf16(h[j][0], h[j][1]); w.y = cvt_pk_bf16(h[j][2], h[j][3]); *((u32x2*)orow + lane + 64 * j) = w; }
}
__device__ __forceinline__ void p0_hrows(Frame& F) {
    unsigned char* const ws = ws_ptr(); const float* const xin = in_ptr<I_X>(); const float* const cxin = in_ptr<I_CTX>(); const float* const gmix = in_ptr<I_NMIXG>();
    const int gw = F.vcu * 8 + F.wave, NGW = F.G * 8; const float* MOD = (const float*)(ws + WS_MOD); bf16_t* H = (bf16_t*)(ws + WS_H);
    for (int t = gw; t < TALL; t += NGW) {
        const float* xr = (t < TX) ? xin + (size_t)t * DM : cxin + (size_t)(t - TX) * DM;
        const float* md = MOD + (size_t)((t < TX) ? (t >> 11) : 16) * NMODC;
        f32x4 v[4], h[4]; load_row(xr, F.lane, v); const float rstd = row_rstd(v);
        normmod(v, rstd, gmix, md, md + DM, F.lane, h); store_row_bf16(H + (size_t)t * DM, F.lane, h);
    }
}
__device__ __forceinline__ void stats_phase(Frame& F, int ntok) {
    unsigned char* const ws = ws_ptr();
    const int gw = F.vcu * 8 + F.wave, NGW = F.G * 8, lane = F.lane;
    const bf16_t* ZCQ = (const bf16_t*)(ws + WS_ZCQ); const bf16_t* ZCKV = (const bf16_t*)(ws + WS_ZCKV); const bf16_t* ZKR = (const bf16_t*)(ws + WS_ZKR);
    float* RSCQ = (float*)(ws + WS_RSCQ); float* RSCKV = (float*)(ws + WS_RSCKV); float* SSKR = (float*)(ws + WS_SSKR);
    for (int t = gw; t < ntok; t += NGW) {
        float a = 0.f, b = 0.f, c = 0.f;
        if (lane < 48) { const u32x4 w = *(const u32x4*)(ZCQ + (size_t)t * QLORA + 8 * lane); a = (bf_lo(w.x) * bf_lo(w.x) + bf_hi(w.x) * bf_hi(w.x)) + (bf_lo(w.y) * bf_lo(w.y) + bf_hi(w.y) * bf_hi(w.y)) + (bf_lo(w.z) * bf_lo(w.z) + bf_hi(w.z) * bf_hi(w.z)) + (bf_lo(w.w) * bf_lo(w.w) + bf_hi(w.w) * bf_hi(w.w)); }
        if (lane < 32) { const u32x4 w = *(const u32x4*)(ZCKV + (size_t)t * KVLORA + 8 * lane); b = (bf_lo(w.x) * bf_lo(w.x) + bf_hi(w.x) * bf_hi(w.x)) + (bf_lo(w.y) * bf_lo(w.y) + bf_hi(w.y) * bf_hi(w.y)) + (bf_lo(w.z) * bf_lo(w.z) + bf_hi(w.z) * bf_hi(w.z)) + (bf_lo(w.w) * bf_lo(w.w) + bf_hi(w.w) * bf_hi(w.w)); }
        if (lane < 4) { const u32x4 w = *(const u32x4*)(ZKR + (size_t)t * ROPED + 8 * lane); c = (bf_lo(w.x) * bf_lo(w.x) + bf_hi(w.x) * bf_hi(w.x)) + (bf_lo(w.y) * bf_lo(w.y) + bf_hi(w.y) * bf_hi(w.y)) + (bf_lo(w.z) * bf_lo(w.z) + bf_hi(w.z) * bf_hi(w.z)) + (bf_lo(w.w) * bf_lo(w.w) + bf_hi(w.w) * bf_hi(w.w)); }
        a = wave_sum(a); b = wave_sum(b); c = wave_sum(c);
        if (lane == 0) { RSCQ[t] = rsqrtf(a * (1.0f / QLORA) + RMS_EPS); RSCKV[t] = rsqrtf(b * (1.0f / KVLORA) + RMS_EPS); SSKR[t] = c; }
    }
}

__device__ __forceinline__ void route_phase(Frame& F, int l, int ntok) {
    unsigned char* const ws = ws_ptr(); const float* const xcur = out_ptr();
    constexpr int HP = DM + 4;
    LAS float* h2t = (LAS float*)F.lds;
    LAS float* part = (LAS float*)(F.lds + 66560);
    LAS float* logit = (LAS float*)(F.lds + 66560 + 32768);
    const float* MOD = (const float*)(ws + WS_MOD) + (size_t)l * 17 * NMODC; const float* XC = (const float*)(ws + WS_XC);
    const float* g = in_ptr<I_NFFNG>() + l * DM; const float* wr = in_ptr<I_WR>(); const float rbias = in_ptr<I_RB>()[F.lane];
    int* TOKE = (int*)(ws + WS_TOKE); float* TOKW = (float*)(ws + WS_TOKW); int* TOKP = (int*)(ws + WS_TOKP); float* RSTD2 = (float*)(ws + WS_RSTD2);
    unsigned* cnt = (unsigned*)(ws + WS_CTL) + CW_CNT + l * 2048;
    const int lane = F.lane, w = F.wave;
    float wv[32][4];
#pragma unroll
    for (int s_ = 0; s_ < 32; ++s_)
#pragma unroll
        for (int j = 0; j < 4; ++j) wv[s_][j] = wr[(w * 128 + 4 * s_ + (lane >> 4)) * NEXP + 16 * j + (lane & 15)];
    for (int it = blockIdx.x; it < ntok / 16; it += F.G) {
        const int T0 = it * 16;
#pragma unroll
        for (int tt = 0; tt < 2; ++tt) { const int tl = 2 * w + tt, t = T0 + tl;
            const float* xr = (t < TX) ? xcur + (size_t)t * DM : XC + (size_t)(t - TX) * DM; const float* md = MOD + (size_t)((t < TX) ? (t >> 11) : 16) * NMODC;
            f32x4 v[4], h[4]; load_row(xr, lane, v); const float rstd = row_rstd(v); if (lane == 0) RSTD2[(t >> 4) * 32 + (t & 15)] = rstd;
            normmod(v, rstd, g, md + 3 * DM, md + 4 * DM, lane, h);
#pragma unroll
            for (int j = 0; j < 4; ++j) *(LAS f32x4*)(h2t + tl * HP + 4 * lane + 256 * j) = h[j];
        }
        __syncthreads();
        { f32x4 acc[4];
#pragma unroll
          for (int j = 0; j < 4; ++j) acc[j] = (f32x4){0.f, 0.f, 0.f, 0.f};
          const LAS float* ha = h2t + (lane & 15) * HP + w * 128 + (lane >> 4);
#pragma unroll
          for (int s_ = 0; s_ < 32; ++s_) { const float a = ha[4 * s_];
#pragma unroll
              for (int j = 0; j < 4; ++j) acc[j] = __builtin_amdgcn_mfma_f32_16x16x4f32(a, wv[s_][j], acc[j], 0, 0, 0); }
#pragma unroll
          for (int j = 0; j < 4; ++j)
#pragma unroll
              for (int q = 0; q < 4; ++q) part[(w * 16 + 4 * (lane >> 4) + q) * 64 + 16 * j + (lane & 15)] = acc[j][q]; }
        __syncthreads();
#pragma unroll
        for (int k = 0; k < 2; ++k) { const int idx = F.tid + 512 * k, t = idx >> 6, e = idx & 63; float s = 0.f;
#pragma unroll
            for (int ww = 0; ww < 8; ++ww) s += part[(ww * 16 + t) * 64 + e];
            logit[t * 64 + e] = s; }
        __syncthreads();
#pragma unroll
        for (int tt = 0; tt < 2; ++tt) { const int tl = 2 * w + tt, t = T0 + tl;
            const float sg = 1.0f / (1.0f + expf(-logit[tl * 64 + lane])); const float bs = sg + rbias;
            float m1 = -3.0e38f, m2 = -3.0e38f; int i1 = 0, i2 = 0;
#pragma unroll
            for (int j = 0; j < 8; ++j) { const float vv = __shfl(bs, (lane & ~7) + j); if (vv > m1) { m2 = m1; i2 = i1; m1 = vv; i1 = j; } else if (vv > m2) { m2 = vv; i2 = j; } }
            const float gs = m1 + m2; float best = -3.0e38f; int gsel = 0;
#pragma unroll
            for (int j = 0; j < 8; ++j) { const float vv = __shfl(gs, 8 * j); if (vv > best) { best = vv; gsel = j; } }
            const int e1 = gsel * 8 + __shfl(i1, gsel * 8), e2 = gsel * 8 + __shfl(i2, gsel * 8);
            const float s1 = __shfl(sg, e1), s2 = __shfl(sg, e2), inv = 1.0f / (s1 + s2);
            if (lane == 0) { const int p1 = (int)atomicAdd(cnt + e1 * 16, 1u), p2 = (int)atomicAdd(cnt + e2 * 16, 1u);
                TOKE[2 * t] = e1; TOKE[2 * t + 1] = e2; TOKW[2 * t] = s1 * inv; TOKW[2 * t + 1] = s2 * inv; TOKP[2 * t] = p1; TOKP[2 * t + 1] = p2; }
        }
        __syncthreads();
    }
}
__device__ __forceinline__ void expert_offsets(Frame& F, unsigned char* ws, int l, LAS int* offl, bool publish) {
    if (F.wave == 0) {
        const unsigned c = __hip_atomic_load((unsigned*)(ws + WS_CTL) + CW_CNT + l * 2048 + F.lane * 16, RLX_AGENT);
        const int pad = (int)((c + 255u) & ~255u); int incl = pad;
#pragma unroll
        for (int o = 1; o < 64; o <<= 1) { const int v = __shfl_up(incl, o); if (F.lane >= o) incl += v; }
        offl[F.lane] = incl - pad; if (F.lane == 63) offl[64] = incl;
        if (publish) { int* TILEE = (int*)(ws + WS_TILEE); for (int t = (incl - pad) >> 8; t < (incl >> 8); ++t) TILEE[t] = F.lane; if (F.lane == 63) TILEE[511] = incl >> 8; }
    }
    __syncthreads();
}
__device__ __forceinline__ void scatter_phase(Frame& F, int l, int ntok, bool f8) {
    unsigned char* const ws = ws_ptr(); const float* const xcur = out_ptr();
    LAS int* offl = (LAS int*)(F.lds + 1024);
    expert_offsets(F, ws, l, offl, blockIdx.x == 0);
    const int gw = F.vcu * 8 + F.wave, NGW = F.G * 8, lane = F.lane;
    const float* MOD = (const float*)(ws + WS_MOD) + (size_t)l * 17 * NMODC; const float* XC = (const float*)(ws + WS_XC); const float* g = in_ptr<I_NFFNG>() + l * DM;
    const int* TOKE = (const int*)(ws + WS_TOKE); const int* TOKP = (const int*)(ws + WS_TOKP); const float* RSTD2 = (const float*)(ws + WS_RSTD2); bf16_t* HS = (bf16_t*)(ws + WS_HS);
    for (int t = gw; t < ntok; t += NGW) {
        const float* xr = (t < TX) ? xcur + (size_t)t * DM : XC + (size_t)(t - TX) * DM; const float* md = MOD + (size_t)((t < TX) ? (t >> 11) : 16) * NMODC;
        f32x4 v[4], h[4]; load_row(xr, lane, v); normmod(v, RSTD2[(t >> 4) * 32 + (t & 15)], g, md + 3 * DM, md + 4 * DM, lane, h);
        const int s1 = offl[TOKE[2 * t]] + TOKP[2 * t], s2 = offl[TOKE[2 * t + 1]] + TOKP[2 * t + 1];
        if (f8) {
#pragma unroll
            for (int j = 0; j < 4; ++j) { const unsigned w = cvt_pk4_fp8(h[j][0] * F8_SH, h[j][1] * F8_SH, h[j][2] * F8_SH, h[j][3] * F8_SH);
                *((unsigned*)((unsigned char*)HS + (size_t)s1 * DM) + lane + 64 * j) = w; *((unsigned*)((unsigned char*)HS + (size_t)s2 * DM) + lane + 64 * j) = w; }
        } else { store_row_bf16(HS + (size_t)s1 * DM, lane, h); store_row_bf16(HS + (size_t)s2 * DM, lane, h); }
    }
}
__device__ __forceinline__ void combine_phase(Frame& F, int l, int ntok, bool last) {
    unsigned char* const ws = ws_ptr(); float* const xcur = out_ptr();
    LAS int* offl = (LAS int*)(F.lds + 1024);
    expert_offsets(F, ws, l, offl, false);
    const int gw = F.vcu * 8 + F.wave, NGW = F.G * 8, lane = F.lane;
    const float* MOD = (const float*)(ws + WS_MOD) + (size_t)l * 17 * NMODC; float* XC = (float*)(ws + WS_XC);
    const int* TOKE = (const int*)(ws + WS_TOKE); const int* TOKP = (const int*)(ws + WS_TOKP); const float* TOKW = (const float*)(ws + WS_TOKW);
    const bf16_t* YS = (const bf16_t*)(ws + WS_YS); bf16_t* H = (bf16_t*)(ws + WS_H);
    for (int t = gw; t < ntok; t += NGW) {
        float* xr = (t < TX) ? xcur + (size_t)t * DM : XC + (size_t)(t - TX) * DM; const int bi = (t < TX) ? (t >> 11) : 16; const float* md = MOD + (size_t)bi * NMODC;
        const int s1 = offl[TOKE[2 * t]] + TOKP[2 * t], s2 = offl[TOKE[2 * t + 1]] + TOKP[2 * t + 1]; const float w1 = TOKW[2 * t], w2 = TOKW[2 * t + 1];
        f32x4 v[4]; load_row(xr, lane, v);
#pragma unroll
        for (int j = 0; j < 4; ++j) { const u32x2 a = *((const u32x2*)(YS + (size_t)s1 * DM) + lane + 64 * j), b = *((const u32x2*)(YS + (size_t)s2 * DM) + lane + 64 * j);
            const f32x4 gf = *((const f32x4*)(md + 5 * DM) + lane + 64 * j);
            const f32x4 y = (f32x4){bf_lo(a.x), bf_hi(a.x), bf_lo(a.y), bf_hi(a.y)} * w1 + (f32x4){bf_lo(b.x), bf_hi(b.x), bf_lo(b.y), bf_hi(b.y)} * w2;
            v[j] = v[j] + gf * y; *((f32x4*)xr + lane + 64 * j) = v[j]; }
        if (!last) { const float* md2 = MOD + (size_t)17 * NMODC + (size_t)bi * NMODC; f32x4 h[4]; const float rstd = row_rstd(v);
            normmod(v, rstd, in_ptr<I_NMIXG>() + (l + 1) * DM, md2, md2 + DM, lane, h); store_row_bf16(H + (size_t)t * DM, lane, h); }
    }
}
constexpr int NPHASE = 2 + 11 * NLAYER;
struct Args { const float* in[26]; float* out; unsigned char* ws; int ph_lo, ph_hi; };

__device__ __attribute__((noinline)) void grid_barrier_fn(GAS unsigned* barw, unsigned x, LAS unsigned* st) { XcdBarrier b; b.bar = (unsigned*)barw; b.x = x; b.st = (volatile LAS unsigned*)st; xcd_barrier(b); }

__global__ void __launch_bounds__(512, 2) fwd_kernel(Args args) {
    extern __shared__ __attribute__((aligned(16))) unsigned char lds_raw[];
    Frame F;
    F.lds = (LAS unsigned char*)lds_raw;
    F.tid = threadIdx.x; F.lane = F.tid & 63; F.wave = __builtin_amdgcn_readfirstlane(F.tid >> 6);
    F.G = gridDim.x; { const int bx = blockIdx.x; F.vcu = (F.G % 8 == 0) ? (bx % 8) * (F.G / 8) + bx / 8 : bx; }
    volatile LAS unsigned* MISC = (volatile LAS unsigned*)(F.lds + MISC_OFF);
    if (F.tid < 64) MISC[F.tid] = 0u;
    __syncthreads();
    const int lo = args.ph_lo, hi = args.ph_hi;
#if MK_SPLIT
#define GRID_BAR() do { } while (0)
#else
    XcdBarrier bar = xcd_barrier_post((unsigned*)(ws_ptr() + WS_CTL) + CW_BAR, MISC + 8);
#define GRID_BAR() grid_barrier_fn((GAS unsigned*)bar.bar, bar.x, (LAS unsigned*)bar.st)
#endif
#ifndef PH_MASK
#define PH_MASK 0xFFFFFFFFu
#endif
#define PHK(k) ((k) < 2 ? (k) : 2 + ((k) - 2) % 11)
#define IN(k) (((PH_MASK >> PHK(k)) & 1u) && lo <= (k) && (k) < hi)
#ifndef PH_DUP
#define PH_DUP 0u
#endif
#define REP0(k) for (int rep_ = 0; rep_ < (((PH_DUP >> (k)) & 1u) ? 2 : 1); ++rep_)
#define REPL(n) for (int rep_ = 0; rep_ < ((((PH_DUP >> (2 + (n))) & 1u) && ((n) != 5 || l == 0)) ? 2 : 1); ++rep_)
#define SEAM(k) do { if (IN(k) && IN((k) + 1)) GRID_BAR(); } while (0)
#define FRESH() Frame Fp = F; int G = F.G, c = (int)blockIdx.x; asm volatile("" : "+v"(Fp.tid), "+v"(Fp.lane)); asm volatile("" : "+s"(Fp.wave), "+s"(Fp.vcu), "+s"(Fp.G), "+s"(G), "+s"(c))

    if (IN(0)) REP0(0) { FRESH(); (void)G; (void)c; p0_convert(Fp); __syncthreads(); p0_ada(Fp); }
    SEAM(0);
    if (IN(1)) REP0(1) { FRESH(); (void)G; (void)c; p0_hrows(Fp); }
    SEAM(1);

    for (int l = 0; l < NLAYER; ++l) {
        const int base = 2 + 11 * l; const bool last = (l == NLAYER - 1);
        const int mt_act = last ? MT_X : MT_ALL;
        const int ntok = last ? TX : TALL;
        if (IN(base + 0)) REPL(0) {
            FRESH(); unsigned char* const ws = ws_ptr();
            pg8::SchedRect S{(const char*)(ws + WS_H), (const char*)((bf16_t*)(ws + WS_WIN) + (size_t)l * INP * DM), (size_t)256 * DM * 2, mt_act, 17, G, c, MT_ALL - mt_act, 2, 7};
            pg8::EpiIn E{(bf16_t*)(ws + WS_QA), (bf16_t*)(ws + WS_KA), (bf16_t*)(ws + WS_VA), (bf16_t*)(ws + WS_ZCQ), (bf16_t*)(ws + WS_ZCKV), (bf16_t*)(ws + WS_ZKR), (bf16_t*)(ws + WS_GATES),
                         in_ptr<I_NAQG>() + l * 64, in_ptr<I_NAKG>() + l * 64, (float*)(ws + WS_PART6), (float*)(ws + WS_PART7), (float*)(ws + WS_PART8)};
            pg8::gemm_phase(Fp.lds, DM, S, E);
        }
        SEAM(base + 0);
        if (IN(base + 2)) REPL(2) {
            FRESH();
            LAS float* const ropeL = (LAS float*)(Fp.lds + EPI_OFF + 8192);
            { const float* const rg = (const float*)(ws_ptr() + WS_ROPE); ropeL[Fp.tid] = rg[Fp.tid]; ropeL[512 + Fp.tid] = rg[512 + Fp.tid]; __syncthreads(); }
#ifndef NO_EQ
            { unsigned char* const ws = ws_ptr();
              pg8::SchedRect S{(const char*)(ws + WS_ZCQ), (const char*)((bf16_t*)(ws + WS_WUQ) + (size_t)l * 1024 * QLORA), (size_t)256 * QLORA * 2, mt_act, 4, G, c, 0, 0, 1};
              pg8::EpiQ E{(bf16_t*)(ws + WS_QB), (const float*)(ws + WS_PART6), (const float*)(ws + WS_PART7), in_ptr<I_QG>() + l * QKD, ropeL, (LAS float*)(Fp.lds + EPI_OFF)};
              pg8::gemm_phase(Fp.lds, QLORA, S, E); }
#endif
#ifndef NO_EKV
            { unsigned char* const ws = ws_ptr();
              pg8::SchedRect S{(const char*)(ws + WS_ZCKV), (const char*)((bf16_t*)(ws + WS_WUKV) + (size_t)l * 1024 * KVLORA), (size_t)256 * KVLORA * 2, MT_ALL, 4, G, c, 0, 0, 1};
              pg8::EpiKV E{(bf16_t*)(ws + WS_KB), (bf16_t*)(ws + WS_VB), (const bf16_t*)(ws + WS_ZKR), (const float*)(ws + WS_PART7), (const float*)(ws + WS_PART8), in_ptr<I_KG>() + l * QKD, ropeL, (LAS float*)(Fp.lds + EPI_OFF)};
              pg8::gemm_phase(Fp.lds, KVLORA, S, E); }
#endif
        }
        SEAM(base + 2);
        if (IN(base + 3)) REPL(3) {
            FRESH(); (void)c;
            const float C64 = 0.125f * 1.4426950408889634f, C96 = 0.10206207261596575f * 1.4426950408889634f;
            for (int r2_ = 0; r2_ < (((PH_DUP >> 20) & 1u) ? 2 : 1); ++r2_)
            { unsigned char* const ws = ws_ptr();
              for (int u = Fp.vcu; u < 1024 + 256; u += G) {
                att::UnitArgs A; A.Q = (const bf16_t*)(ws + WS_QB); A.ldq = 768; A.K = (const bf16_t*)(ws + WS_KB); A.ldk = 768; A.V = (const bf16_t*)(ws + WS_VB); A.O = (bf16_t*)(ws + WS_OB);
                A.masked = 0; A.band = 0; A.krow0 = 0; A.bias = nullptr; A.C = C96;
                if (u < 1024) { const int bh = u >> 3, qb = u & 7, b = bh >> 3, h = bh & 7;
                    A.qcol = h * QKD; A.kcol = h * QKD; A.vcol = h * 64; A.ocol = h * 64; A.q0 = b * SEQ + qb * 256; A.ctx0 = TX + b * CTXL; A.loc0 = b * SEQ; A.NT = 36; }
                else { const int v = u - 1024; if (last || !(v & 1)) continue; const int bh = v >> 1, b = bh >> 3, h = bh & 7;
                    A.qcol = h * QKD; A.kcol = h * QKD; A.vcol = h * 64; A.ocol = h * 64; A.q0 = TX + b * CTXL; A.ctx0 = TX + b * CTXL; A.loc0 = 0; A.NT = 4; }
                att::attn_unit<96>(A, (char*)lds_raw);
              } }
            for (int r3_ = 0; r3_ < (((PH_DUP >> 21) & 1u) ? 2 : 1); ++r3_)
            { unsigned char* const ws = ws_ptr(); const float* const rpb = in_ptr<I_RPB>();
              att::na_mask_table((char*)lds_raw);
              for (int u = Fp.vcu; u < 1024 + 256; u += G) {
                att::UnitArgs A; A.Q = (const bf16_t*)(ws + WS_QA); A.ldq = 512; A.K = (const bf16_t*)(ws + WS_KA); A.ldk = 512; A.V = (const bf16_t*)(ws + WS_VA); A.O = (bf16_t*)(ws + WS_OA); A.C = C64;
                if (u < 1024) { const int bh = u >> 3, band = u & 7, b = bh >> 3, h = bh & 7;
                    A.qcol = h * 64; A.kcol = h * 64; A.vcol = h * 64; A.ocol = h * 64; A.q0 = b * SEQ + band * 256; A.ctx0 = TX + b * CTXL;
                    A.krow0 = min(max(4 * band - 4, 0), 20); A.loc0 = b * SEQ + 64 * A.krow0; A.NT = 10; A.masked = 1; A.band = band; A.bias = rpb + ((size_t)l * NHEAD + h) * 15 * 31; }
                else { const int v = u - 1024; if (last || (v & 1)) continue; const int bh = v >> 1, b = bh >> 3, h = bh & 7;
                    A.qcol = h * 64; A.kcol = h * 64; A.vcol = h * 64; A.ocol = h * 64; A.q0 = TX + b * CTXL; A.ctx0 = TX + b * CTXL; A.loc0 = 0; A.NT = 4; A.masked = 0; A.band = 0; A.krow0 = 0; A.bias = nullptr; }
                att::attn_unit<64>(A, (char*)lds_raw);
              } }
        }
        SEAM(base + 3);
        if (IN(base + 4)) REPL(4) {
            FRESH(); unsigned char* const ws = ws_ptr();
            pg8::SchedMerge S{(const char*)(ws + WS_OA), (const char*)(ws + WS_OB), (const char*)((bf16_t*)(ws + WS_WOA) + (size_t)l * 1024 * 512), (const char*)((bf16_t*)(ws + WS_WOB) + (size_t)l * 1024 * 512),
                              (size_t)256 * 512 * 2, mt_act, 4, G, c};
            pg8::EpiMerge E{(const bf16_t*)(ws + WS_GATES), (bf16_t*)(ws + WS_Y)};
            pg8::gemm_phase(Fp.lds, 512, S, E);
        }
        SEAM(base + 4);
        if (IN(base + 5)) REPL(5) {
            FRESH(); unsigned char* const ws = ws_ptr(); float* const outp = out_ptr();
            pg8::SchedRect S{(const char*)(ws + WS_Y), (const char*)((bf16_t*)(ws + WS_WOUT) + (size_t)l * DM * DM), (size_t)256 * DM * 2, mt_act, 4, G, c, 0, 0, 1};
            pg8::EpiOut E{(l == 0) ? in_ptr<I_X>() : (const float*)outp, outp, in_ptr<I_CTX>(), (float*)(ws + WS_XC), (const float*)(ws + WS_MOD) + (size_t)l * 17 * NMODC, 2 * DM};
            pg8::gemm_phase(Fp.lds, DM, S, E);
        }
        SEAM(base + 5);
        if (IN(base + 6)) REPL(6) { FRESH(); (void)G; (void)c; route_phase(Fp, l, ntok); }
        SEAM(base + 6);
        if (IN(base + 7)) REPL(7) { FRESH(); (void)G; (void)c; scatter_phase(Fp, l, ntok, F8LAYER(l)); }
        SEAM(base + 7);
        if (IN(base + 8)) REPL(8) {
            FRESH(); unsigned char* const ws = ws_ptr();
            LAS int* const tle = (LAS int*)(Fp.lds + EPI_OFF + 16384); tle[Fp.tid] = ld_i32_agent((const int*)(ws + WS_TILEE) + Fp.tid); __syncthreads();
            const int ntile = __builtin_amdgcn_readfirstlane(tle[511]);
            const char* const w13 = (const char*)((bf16_t*)(ws + WS_W13) + (size_t)l * NEXP * 2048 * DM);
#ifdef ONLY_BF16
            if (false) {} else
#endif
#ifdef ONLY_F8
            if (true)
#else
            if (F8LAYER(l))
#endif
            { pg8::SchedMoe S{(const char*)(ws + WS_HS), w13, (size_t)256 * DM, (size_t)2048 * DM, (size_t)256 * DM, tle, ntile, 8, G, c};
                pg8::EpiMoe1<true> E{(bf16_t*)(ws + WS_HMID), 1.0f / (F8_SH * F8_SW)};
                pg8::gemm_phase<true>(Fp.lds, DM / 2, S, E); }
            else { pg8::SchedMoe S{(const char*)(ws + WS_HS), w13, (size_t)256 * DM * 2, (size_t)2048 * DM * 2, (size_t)256 * DM * 2, tle, ntile, 8, G, c};
                pg8::EpiMoe1<false> E{(bf16_t*)(ws + WS_HMID), 1.0f};
                pg8::gemm_phase(Fp.lds, DM, S, E); }
        }
        SEAM(base + 8);
        if (IN(base + 9)) REPL(9) {
            FRESH(); unsigned char* const ws = ws_ptr();
            LAS int* const tle = (LAS int*)(Fp.lds + EPI_OFF + 16384); tle[Fp.tid] = ld_i32_agent((const int*)(ws + WS_TILEE) + Fp.tid); __syncthreads();
            const int ntile = __builtin_amdgcn_readfirstlane(tle[511]);
            const char* const w2 = (const char*)((bf16_t*)(ws + WS_W2) + (size_t)l * NEXP * DM * DM);
            if (F8LAYER(l)) { pg8::SchedMoe S{(const char*)(ws + WS_HMID), w2, (size_t)256 * DM, (size_t)DM * DM, (size_t)256 * DM, tle, ntile, 4, G, c};
                pg8::EpiMoe2 E{(bf16_t*)(ws + WS_YS), 1.0f / (F8_SM * F8_SW)};
                pg8::gemm_phase<true>(Fp.lds, DM / 2, S, E); }
            else { pg8::SchedMoe S{(const char*)(ws + WS_HMID), w2, (size_t)256 * DM * 2, (size_t)DM * DM * 2, (size_t)256 * DM * 2, tle, ntile, 4, G, c};
                pg8::EpiMoe2 E{(bf16_t*)(ws + WS_YS), 1.0f};
                pg8::gemm_phase(Fp.lds, DM, S, E); }
        }
        SEAM(base + 9);
        if (IN(base + 10)) REPL(10) { FRESH(); (void)G; (void)c; combine_phase(Fp, l, ntok, last); }
        if (!last) SEAM(base + 10);
    }
#undef IN
#undef SEAM
#undef GRID_BAR
}

extern "C" void kernel_launch(void* const* d_in, const int* in_sizes, int n_in, void* d_out, int out_size, void* d_ws, size_t ws_size, hipStream_t stream) {
    static int grid = 0;
    if (grid == 0) {
        if (n_in != 26 || out_size != TX * DM || ws_size < WS_END) { fprintf(stderr, "kernel_launch: unexpected problem (n_in %d, out %d, ws %zu < %zu); nothing launched\n", n_in, out_size, ws_size, (size_t)WS_END); grid = -1; return; }
        int dev = 0, cus = 0, per_cu = 0;
        if (hipGetDevice(&dev) != hipSuccess || hipDeviceGetAttribute(&cus, hipDeviceAttributeMultiprocessorCount, dev) != hipSuccess) { grid = -1; return; }
        if (hipFuncSetAttribute((const void*)fwd_kernel, hipFuncAttributeMaxDynamicSharedMemorySize, LDS_BYTES) != hipSuccess) { fprintf(stderr, "kernel_launch: hipFuncSetAttribute failed\n"); grid = -1; return; }
        if (hipOccupancyMaxActiveBlocksPerMultiprocessor(&per_cu, (const void*)fwd_kernel, 512, LDS_BYTES) != hipSuccess || per_cu < 1) fprintf(stderr, "kernel_launch: occupancy query reports %d blocks per CU\n", per_cu);
        (void)hipGetLastError();
        grid = cus;
    }
    if (grid < 0) return;
    (void)in_sizes;
    (void)hipMemsetAsync((char*)d_ws + WS_CTL, 0, CTL_BYTES, stream);
    Args a{};
    for (int i = 0; i < 26; ++i) a.in[i] = (const float*)d_in[i];
    a.out = (float*)d_out; a.ws = (unsigned char*)d_ws;
#if MK_SPLIT
    for (int p = 0; p < NPHASE; ++p) { a.ph_lo = p; a.ph_hi = p + 1; hipLaunchKernelGGL(fwd_kernel, dim3(grid), dim3(512), LDS_BYTES, stream, a); }
#else
    a.ph_lo = 0; a.ph_hi = NPHASE;
    hipLaunchKernelGGL(fwd_kernel, dim3(grid), dim3(512), LDS_BYTES, stream, a);
#endif
    const hipError_t le = hipPeekAtLastError();
    if (le != hipSuccess) fprintf(stderr, "kernel_launch: launch failed: %s\n", hipGetErrorName(le));
}
```

```cpp
#include <hip/hip_runtime.h>
#include <hip/hip_bf16.h>
#include <cstdio>
#include <cstdint>

#ifndef MK_SPLIT
#define MK_SPLIT 0
#endif

#define LAS __attribute__((address_space(3)))
#define GAS __attribute__((address_space(1)))
typedef unsigned short bf16_t;
typedef short bf16x8 __attribute__((ext_vector_type(8)));
typedef short s16x4 __attribute__((ext_vector_type(4)));
typedef float f32x4 __attribute__((ext_vector_type(4)));
typedef float f32x2 __attribute__((ext_vector_type(2)));
typedef float f32x16 __attribute__((ext_vector_type(16)));
typedef unsigned u32x4 __attribute__((ext_vector_type(4)));
typedef unsigned u32x2 __attribute__((ext_vector_type(2)));
#define RLX_AGENT __ATOMIC_RELAXED, __HIP_MEMORY_SCOPE_AGENT

constexpr int DM = 1024, NB = 16, SEQ = 2048, TX = NB * SEQ, CTXL = 256, TC = NB * CTXL, TALL = TX + TC;
constexpr int NHEAD = 8, GRIDW = 64;
constexpr int INC = 4256, INP = 4352;
constexpr int NEXP = 64, NMODC = 6 * DM;
constexpr int QLORA = 384, KVLORA = 256, QKD = 96, ROPED = 32;
constexpr int MT_X = TX / 256, MT_ALL = TALL / 256;
constexpr int NSLOT_MAX = 2 * TALL + NEXP * 256;
constexpr float RMS_EPS = 1e-6f;
constexpr int NLAYER = 2;
constexpr float F8_SW = 64.f, F8_SH = 16.f, F8_SM = 4.f;
#ifndef F8_FROM
#define F8_FROM 0
#endif
#define F8LAYER(l) ((l) >= F8_FROM)
#ifndef C2_F8
#define C2_F8 1
#endif
constexpr float F8_SY = 32.f;
#ifndef GATES_F8
#define GATES_F8 1
#endif
constexpr float F8_SG = 256.f;
#ifndef A2_F8
#define A2_F8 1
#endif

constexpr size_t al256(size_t x) { return (x + 255) & ~(size_t)255; }
constexpr size_t WS_CTL = 0, CTL_BYTES = 1u << 20;
constexpr size_t WS_MOD   = WS_CTL + CTL_BYTES;
constexpr size_t WS_ROPE  = WS_MOD + al256((size_t)NLAYER * 17 * NMODC * 4);
constexpr size_t WS_RSCQ  = WS_ROPE + al256(64 * 8 * 2 * 4);
constexpr size_t WS_RSCKV = WS_RSCQ + al256((size_t)TALL * 4);
constexpr size_t WS_SSKR  = WS_RSCKV + al256((size_t)TALL * 4);
constexpr size_t WS_TOKE  = WS_SSKR + al256((size_t)TALL * 4);
constexpr size_t WS_TOKW  = WS_TOKE + al256((size_t)TALL * 8);
constexpr size_t WS_TOKP  = WS_TOKW + al256((size_t)TALL * 8);
constexpr size_t WS_RSTD2 = WS_TOKP + al256((size_t)TALL * 8);
constexpr size_t WS_TILEE = WS_RSTD2 + al256((size_t)TALL * 8);
constexpr size_t WS_OFFS  = WS_TILEE + al256(512 * 4);
constexpr size_t WS_PART6 = WS_OFFS + al256(128 * 4);
constexpr size_t WS_PART7 = WS_PART6 + al256((size_t)TALL * 4 * 4);
constexpr size_t WS_PART8 = WS_PART7 + al256((size_t)TALL * 8 * 4);
constexpr size_t WS_WIN   = WS_PART8 + al256((size_t)TALL * 4 * 4);
constexpr size_t WS_WUQ   = WS_WIN + al256((size_t)NLAYER * INP * DM * 2);
constexpr size_t WS_WUKV  = WS_WUQ + al256((size_t)NLAYER * 1024 * QLORA * 2);
constexpr size_t WS_WOA   = WS_WUKV + al256((size_t)NLAYER * 1024 * KVLORA * 2);
constexpr size_t WS_WOB   = WS_WOA + al256((size_t)NLAYER * 1024 * 512 * 2);
constexpr size_t WS_WOUT  = WS_WOB + al256((size_t)NLAYER * 1024 * 512 * 2);
constexpr size_t WS_W13   = WS_WOUT + al256((size_t)NLAYER * 1024 * 1024 * 2);
constexpr size_t WS_W2    = WS_W13 + al256((size_t)NLAYER * NEXP * 2048 * 1024 * 2);
constexpr size_t WS_H     = WS_W2 + al256((size_t)NLAYER * NEXP * 1024 * 1024 * 2);
constexpr size_t WS_XC    = WS_H + al256((size_t)TALL * DM * 2);
constexpr size_t WS_ACT   = WS_XC + al256((size_t)TC * DM * 4);
constexpr size_t WS_QA    = WS_ACT;
constexpr size_t WS_KA    = WS_QA + al256((size_t)TALL * 512 * 2);
constexpr size_t WS_VA    = WS_KA + al256((size_t)TALL * 512 * 2);
constexpr size_t WS_ZCQ   = WS_VA + al256((size_t)TALL * 512 * 2);
constexpr size_t WS_ZCKV  = WS_ZCQ + al256((size_t)TALL * QLORA * 2);
constexpr size_t WS_ZKR   = WS_ZCKV + al256((size_t)TALL * KVLORA * 2);
constexpr size_t WS_GATES = WS_ZKR + al256((size_t)TALL * ROPED * 2);
constexpr size_t WS_QB    = WS_GATES + al256((size_t)TALL * 2048 * 2);
constexpr size_t WS_KB    = WS_QB + al256((size_t)TALL * 768 * 2);
constexpr size_t WS_VB    = WS_KB + al256((size_t)TALL * 768 * 2);
constexpr size_t WS_OA    = WS_VB + al256((size_t)TALL * 512 * 2);
constexpr size_t WS_OB    = WS_OA + al256((size_t)TALL * 512 * 2);
constexpr size_t WS_Y     = WS_OB + al256((size_t)TALL * 512 * 2);
constexpr size_t WS_MIX_END = WS_Y + al256((size_t)TALL * DM * 2);
constexpr size_t WS_HS    = WS_ACT;
constexpr size_t WS_HMID  = WS_HS + al256((size_t)NSLOT_MAX * DM * 2);
constexpr size_t WS_YS    = WS_HMID + al256((size_t)NSLOT_MAX * DM * 2);
constexpr size_t WS_MOE_END = WS_YS + al256((size_t)NSLOT_MAX * DM * 2);
constexpr size_t WS_END   = (WS_MIX_END > WS_MOE_END) ? WS_MIX_END : WS_MOE_END;

constexpr int CW_BAR = 4096;
constexpr int CW_CNT = 16384;

constexpr int RING_BYTES = 131072;
constexpr int EPI_OFF = RING_BYTES;
constexpr int MISC_OFF = RING_BYTES + 24576;
constexpr int LDS_BYTES = 160 * 1024;

__device__ __forceinline__ unsigned cvt_pk_bf16(float lo, float hi) { unsigned r; asm volatile("v_cvt_pk_bf16_f32 %0, %1, %2" : "=v"(r) : "v"(lo), "v"(hi)); return r; }
__device__ __forceinline__ unsigned cvt_pk4_fp8(float a, float b, float c, float d) {
    a = __builtin_amdgcn_fmed3f(a, -448.f, 448.f); b = __builtin_amdgcn_fmed3f(b, -448.f, 448.f); c = __builtin_amdgcn_fmed3f(c, -448.f, 448.f); d = __builtin_amdgcn_fmed3f(d, -448.f, 448.f);
    int w = 0; w = __builtin_amdgcn_cvt_pk_fp8_f32(a, b, w, false); w = __builtin_amdgcn_cvt_pk_fp8_f32(c, d, w, true); return (unsigned)w; }
__device__ __forceinline__ f32x4 fp8x4_f32(unsigned w) {
    const f32x2 lo = __builtin_amdgcn_cvt_pk_f32_fp8((int)w, false), hi = __builtin_amdgcn_cvt_pk_f32_fp8((int)w, true); return (f32x4){lo[0], lo[1], hi[0], hi[1]}; }
__device__ __forceinline__ float bf_lo(unsigned w) { return __uint_as_float(w << 16); }
__device__ __forceinline__ float bf_hi(unsigned w) { return __uint_as_float(w & 0xffff0000u); }
__device__ __forceinline__ float wave_sum(float v) {
#pragma unroll
    for (int o = 1; o < 64; o <<= 1) v += __shfl_xor(v, o);
    return v;
}
__device__ __forceinline__ float sigmoidf_(float x) { return __builtin_amdgcn_rcpf(1.0f + __expf(-x)); }
__device__ __forceinline__ int ld_i32_agent(const int* p) { return (int)__hip_atomic_load((const unsigned*)p, RLX_AGENT); }
#define XB_TMO      128
#define XB_XCNT(j)  (256  + 64 * (j))
#define XB_XSUB(j)  (1280 + 64 * (j))
#define XB_XGEN(j)  (2304 + 64 * (j))
#define XB_TOP      3328
#define XB_TOPGEN   3392
#define XCD_BAR_WORDS 3456
#define XB_SPIN_CAP (1u << 18)

__device__ __forceinline__ unsigned xb_ld(unsigned* p)              { return __hip_atomic_load(p, __ATOMIC_RELAXED, __HIP_MEMORY_SCOPE_AGENT); }
__device__ __forceinline__ unsigned xb_add(unsigned* p, unsigned v) { return __hip_atomic_fetch_add(p, v, __ATOMIC_RELAXED, __HIP_MEMORY_SCOPE_AGENT); }
__device__ __forceinline__ unsigned xb_xcc_id() { return (unsigned)__builtin_amdgcn_s_getreg((3 << 11) | 20) & 0xFu; }
#define XB_SPIN(cond, bar) do { unsigned _sp = 0; while (cond) { __builtin_amdgcn_s_sleep(1); \
    if ((++_sp & 255u) == 0u) { if (xb_ld(&(bar)[XB_TMO])) break; if (_sp > XB_SPIN_CAP) { atomicAdd(&(bar)[XB_TMO], 1u); break; } } } } while (0)

struct XcdBarrier {
    unsigned* bar; unsigned x;
    volatile LAS unsigned* st;
};

__device__ __forceinline__ XcdBarrier xcd_barrier_post(unsigned* bar, volatile LAS unsigned* st) {
    XcdBarrier b; b.bar = bar; b.x = xb_xcc_id(); b.st = st;
    if (threadIdx.x == 0) (void)xb_add(&bar[XB_XCNT(b.x)], 1u);
    return b;
}
__device__ __forceinline__ void xcd_barrier_complete(unsigned* bar, unsigned x, unsigned& nloc, unsigned& nx) {
    const unsigned G = gridDim.x * gridDim.y * gridDim.z;
    unsigned sum, cnt, mine, sp = 0u;
    for (;;) {
        sum = 0u; cnt = 0u; mine = 0u;
#pragma unroll
        for (unsigned j = 0; j < 16; ++j) { const unsigned c = xb_ld(&bar[XB_XCNT(j)]); sum += c; cnt += (c > 0u) ? 1u : 0u; mine = (j == x) ? c : mine; }
        if (sum == G) break;
        __builtin_amdgcn_s_sleep(1);
        if ((++sp & 255u) == 0u) { if (xb_ld(&bar[XB_TMO])) break; if (sp > XB_SPIN_CAP) { atomicAdd(&bar[XB_TMO], 1u); break; } }
    }
    nloc = mine > 0u ? mine : 1u; nx = cnt > 0u ? cnt : 1u;
}

__device__ __forceinline__ void xcd_barrier(const XcdBarrier& b) {
    asm volatile("s_waitcnt vmcnt(0)" ::: "memory");
    __syncthreads();
    if (threadIdx.x == 0) {
        unsigned* bar = b.bar;
        __builtin_amdgcn_s_waitcnt(0);
        unsigned nloc = b.st[0], nx = b.st[1];
        if (nloc == 0u) { xcd_barrier_complete(bar, b.x, nloc, nx); b.st[0] = nloc; b.st[1] = nx; }
        const unsigned old = xb_add(&bar[XB_XSUB(b.x)], 1u);
        const unsigned gen = old / nloc;
        if (old + 1u == (gen + 1u) * nloc) {
            __builtin_amdgcn_fence(__ATOMIC_RELEASE, "agent");
            asm volatile("s_waitcnt vmcnt(0)" ::: "memory");
            const unsigned og = xb_add(&bar[XB_TOP], 1u);
            const unsigned tg = og / nx;
            if (og + 1u == (tg + 1u) * nx) xb_add(&bar[XB_TOPGEN], 1u);
            else XB_SPIN(xb_ld(&bar[XB_TOPGEN]) == tg, bar);
            __builtin_amdgcn_fence(__ATOMIC_ACQUIRE, "agent");
            xb_add(&bar[XB_XGEN(b.x)], 1u);
            asm volatile("s_waitcnt vmcnt(0)" ::: "memory");
        } else {
            XB_SPIN(xb_ld(&bar[XB_XGEN(b.x)]) == gen, bar);
            __builtin_amdgcn_fence(__ATOMIC_ACQUIRE, "agent");
            asm volatile("s_waitcnt vmcnt(0)" ::: "memory");
        }
    }
    __syncthreads();
}

namespace pg8 {
constexpr int BM = 256, BK = 64, HALF = 128, HTB = HALF * BK * 2  , STAGE_BYTES = 8 * HTB, NXCD = 8, WGM = 8;
__host__ __device__ __forceinline__ int lds_byte(int r, int c) { const int st = (r >> 4) * 2 + (c >> 5), rr = r & 15, cc = c & 31, ob = rr * 64 + cc * 2; return st * 1024 + (ob ^ (((ob >> 9) & 1) << 5)); }
__host__ __device__ __forceinline__ void stage_rc(int b, int& R, int& C) { const int st = b / 1024, sb = b % 1024, swz = sb ^ (((sb >> 9) & 1) << 5); R = (st >> 1) * 16 + swz / 64; C = (st & 1) * 32 + (swz % 64) / 2; }
__host__ __device__ __forceinline__ int perm32(int rho) { const int n = rho >> 4, i = rho & 15; return 8 * (i >> 2) + 4 * n + (i & 3); }

struct Unit { int pm, pn, kind, e; };

__device__ __forceinline__ void rect_tile(int wgid_in, int nM, int nN, int& pm, int& pn) {
    const int nwg = nM * nN; int wgid = wgid_in;
    { const int q = nwg / NXCD, r = nwg % NXCD, xcd = wgid % NXCD, off = wgid / NXCD; wgid = (xcd < r ? xcd * (q + 1) : r * (q + 1) + (xcd - r) * q) + off; }
    const int nig = WGM * nN, gid = wgid / nig, fm = gid * WGM, gsz = (nM - fm) < WGM ? (nM - fm) : WGM;
    pm = fm + ((wgid % nig) % gsz); pn = (wgid % nig) / gsz;
}

typedef int i32x8 __attribute__((ext_vector_type(8)));
template <bool F8 = false, class Epi, class Sched>
__device__ __forceinline__ void gemm_phase(LAS unsigned char* lds, const int K, const Sched& S, const Epi& E) {
    int tid = threadIdx.x; asm volatile("" : "+v"(tid));
    const int wid = __builtin_amdgcn_readfirstlane(tid >> 6), lane = tid & 63, wr = wid >> 2, wc = wid & 3, fr = lane & 15, fq = lane >> 4;
    const int nt = K / BK;
    unsigned voffA[2], voffB[2];
#pragma unroll
    for (int i = 0; i < 2; ++i) { int R, C; stage_rc(tid * 16 + i * 8192, R, C); const int Rb = Epi::PERM ? ((R & ~31) + perm32(R & 31)) : R;
        voffA[i] = (unsigned)(R * K + C) * 2u; voffB[i] = (unsigned)(Rb * K + C) * 2u; }
    const size_t kstep = (size_t)(BK * 2);
    const size_t hstep = (size_t)HALF * K * 2;
    const unsigned ldsw = (unsigned)wid * 1024u;
    const int aoff = lds_byte(wr * 64 + fr, F8 ? fq * 16 : fq * 8), boff = lds_byte(wc * 32 + fr, F8 ? fq * 16 : fq * 8);
    constexpr int KSTEP = F8 ? 16 : 1024;
    int f8scale = 0x7F7F7F7F; asm volatile("" : "+v"(f8scale));
#define PG8_SA(b, h) (((b) * 2 + (h)) * HTB)
#define PG8_SB(b, h) ((4 + (b) * 2 + (h)) * HTB)
#define PG8_STAGE(bufoff, gbase, voff) do { _Pragma("unroll") for (int _i = 0; _i < 2; ++_i) \
        __builtin_amdgcn_global_load_lds((const unsigned*)((const char*)(gbase) + (voff)[_i]), (LAS unsigned*)(lds + (bufoff) + ldsw + _i * 8192), 16, 0, 0); } while (0)
#define PG8_LDA(dst, b, h) do { _Pragma("unroll") for (int m = 0; m < 4; ++m) _Pragma("unroll") for (int k = 0; k < 2; ++k) dst[m][k] = *(const LAS bf16x8*)(lds + PG8_SA(b, h) + aoff + m * 2048 + k * KSTEP); } while (0)
#define PG8_LDB(dst, b, h) do { _Pragma("unroll") for (int n = 0; n < 2; ++n) _Pragma("unroll") for (int k = 0; k < 2; ++k) dst[n][k] = *(const LAS bf16x8*)(lds + PG8_SB(b, h) + boff + n * 2048 + k * KSTEP); } while (0)
#define PG8_CAT(X) __builtin_shufflevector(__builtin_bit_cast(u32x4, (X)[0]), __builtin_bit_cast(u32x4, (X)[1]), 0, 1, 2, 3, 4, 5, 6, 7)
#define PG8_MMA(ai, bj, At, Bt) do { __builtin_amdgcn_s_setprio(1); \
        if constexpr (F8) { _Pragma("unroll") for (int m = 0; m < 4; ++m) _Pragma("unroll") for (int n = 0; n < 2; ++n) \
            asm volatile("v_mfma_scale_f32_16x16x128_f8f6f4 %0, %1, %2, %0, %3, %3 op_sel_hi:[0,0,0]" : "+v"(acc[ai][bj][m][n]) : "v"(__builtin_bit_cast(i32x8, PG8_CAT(Bt[n]))), "v"(__builtin_bit_cast(i32x8, PG8_CAT(At[m]))), "v"(f8scale)); } \
        else { _Pragma("unroll") for (int m = 0; m < 4; ++m) _Pragma("unroll") for (int n = 0; n < 2; ++n) _Pragma("unroll") for (int k = 0; k < 2; ++k) \
            acc[ai][bj][m][n] = __builtin_amdgcn_mfma_f32_16x16x32_bf16(Bt[n][k], At[m][k], acc[ai][bj][m][n], 0, 0, 0); } \
        __builtin_amdgcn_s_setprio(0); } while (0)
#define PG8_WAIT_V(n) asm volatile("s_waitcnt vmcnt(" #n ")" ::: "memory")
#define PG8_WAIT_L(n) asm volatile("s_waitcnt lgkmcnt(" #n ")" ::: "memory")
#define PG8_BAR __builtin_amdgcn_s_barrier()
#define PG8_SCHED __builtin_amdgcn_sched_barrier(0)
    Unit cur, nxt; int ui = 0;
    if (!S.next(0, cur)) return;
    f32x4 acc[2][2][4][2];
#pragma unroll
    for (int a = 0; a < 2; ++a)
#pragma unroll
        for (int b = 0; b < 2; ++b)
#pragma unroll
            for (int m = 0; m < 4; ++m)
#pragma unroll
                for (int n = 0; n < 2; ++n) acc[a][b][m][n] = (f32x4){0.f, 0.f, 0.f, 0.f};
    bf16x8 At[4][2], B0[2][2], B1[2][2];
    const char* cA = S.a_ptr(cur); const char* cB = S.b_ptr(cur);
    PG8_STAGE(PG8_SB(0, 0), cB, voffB); PG8_STAGE(PG8_SB(0, 1), cB + hstep, voffB); PG8_STAGE(PG8_SA(0, 0), cA, voffA); PG8_STAGE(PG8_SA(0, 1), cA + hstep, voffA);
    if (wr == 1) PG8_BAR;
    PG8_WAIT_V(2); PG8_BAR;
    PG8_STAGE(PG8_SB(1, 0), cB + kstep, voffB); PG8_STAGE(PG8_SA(1, 0), cA + kstep, voffA); PG8_STAGE(PG8_SB(1, 1), cB + hstep + kstep, voffB);
    PG8_WAIT_V(6); PG8_BAR;
    for (;;) {
        const bool has_next = S.next(ui + 1, nxt);
        const char* nA = has_next ? S.a_ptr(nxt) : cA; const char* nB = has_next ? S.b_ptr(nxt) : cB;
#pragma unroll 1
        for (int t = 0; t < nt; t += 2) {
            const bool last = (t == nt - 2);
            const char* a1 = cA + (size_t)(t + 1) * kstep;
            const char* a2 = last ? nA : cA + (size_t)(t + 2) * kstep; const char* b2 = last ? nB : cB + (size_t)(t + 2) * kstep;
            const char* a3 = a2 + kstep; const char* b3 = b2 + kstep;
            PG8_LDB(B0, 0, 0); PG8_LDB(B1, 0, 1); PG8_SCHED; PG8_LDA(At, 0, 0); PG8_STAGE(PG8_SA(1, 1), a1 + hstep, voffA);
            PG8_WAIT_V(8); PG8_WAIT_L(0); PG8_BAR; PG8_MMA(0, 0, At, B0); PG8_MMA(0, 1, At, B1); PG8_BAR; PG8_SCHED;
            PG8_LDA(At, 0, 1); PG8_STAGE(PG8_SB(0, 0), b2, voffB); PG8_STAGE(PG8_SB(0, 1), b2 + hstep, voffB); PG8_STAGE(PG8_SA(0, 0), a2, voffA);
            PG8_WAIT_V(8); PG8_WAIT_L(0); PG8_BAR; PG8_MMA(1, 0, At, B0); PG8_MMA(1, 1, At, B1); PG8_BAR; PG8_SCHED;
            PG8_LDB(B0, 1, 0); PG8_LDB(B1, 1, 1); PG8_SCHED; PG8_LDA(At, 1, 0); PG8_STAGE(PG8_SA(0, 1), a2 + hstep, voffA);
            PG8_WAIT_V(8); PG8_WAIT_L(0); PG8_BAR; PG8_MMA(0, 0, At, B0); PG8_MMA(0, 1, At, B1); PG8_BAR; PG8_SCHED;
            PG8_LDA(At, 1, 1); PG8_STAGE(PG8_SB(1, 0), b3, voffB); PG8_STAGE(PG8_SB(1, 1), b3 + hstep, voffB); PG8_STAGE(PG8_SA(1, 0), a3, voffA);
            PG8_WAIT_V(8); PG8_WAIT_L(0); PG8_BAR; PG8_MMA(1, 0, At, B0); PG8_MMA(1, 1, At, B1); PG8_BAR; PG8_SCHED;
        }
        if (wr == 0) PG8_BAR;
        if constexpr (F8) asm volatile("s_nop 15\n\ts_nop 7" ::: "memory");
        { int tz = threadIdx.x; asm volatile("" : "+v"(tz));
          const int wid2 = __builtin_amdgcn_readfirstlane(tz >> 6), lane2 = tz & 63; E(acc, cur, wid2 >> 2, wid2 & 3, lane2 & 15, lane2 >> 4); }
        if (!has_next) break;
        if (!(Epi::CHAIN && cur.kind == 0)) {
#pragma unroll
            for (int a = 0; a < 2; ++a)
#pragma unroll
                for (int b = 0; b < 2; ++b)
#pragma unroll
                    for (int m = 0; m < 4; ++m)
#pragma unroll
                        for (int n = 0; n < 2; ++n) acc[a][b][m][n] = (f32x4){0.f, 0.f, 0.f, 0.f};
        }
        cur = nxt; cA = nA; cB = nB; ++ui;
        if (wr == 1) PG8_BAR;
    }
    PG8_WAIT_V(0);
    PG8_BAR;
#undef PG8_SA
#undef PG8_SB
#undef PG8_STAGE
#undef PG8_LDA
#undef PG8_LDB
#undef PG8_MMA
#undef PG8_CAT
#undef PG8_WAIT_V
#undef PG8_WAIT_L
#undef PG8_BAR
#undef PG8_SCHED
}
}
namespace pg8 {
__device__ __forceinline__ u32x4 pack8(const f32x4 a, const f32x4 b) { u32x4 w; w.x = cvt_pk_bf16(a[0], a[1]); w.y = cvt_pk_bf16(a[2], a[3]); w.z = cvt_pk_bf16(b[0], b[1]); w.w = cvt_pk_bf16(b[2], b[3]); return w; }
__device__ __forceinline__ float sumsq4(const f32x4 a) { return (a[0] * a[0] + a[1] * a[1]) + (a[2] * a[2] + a[3] * a[3]); }
#define EPI_BAR() do { asm volatile("s_waitcnt lgkmcnt(0)" ::: "memory"); __builtin_amdgcn_s_barrier(); asm volatile("" ::: "memory"); } while (0)

struct EpiIn {
    static constexpr bool PERM = true, CHAIN = false;
    bf16_t *QA, *KA, *VA, *ZCQ, *ZCKV, *ZKR, *GATES; const float *qg, *kg; float *P6, *P7, *P8; float asc;
    __device__ __forceinline__ void operator()(f32x4 (&acc)[2][2][4][2], const Unit& u, int wr, int wc, int fr, int fq) const {
        const int row0 = u.pm * BM + wr * 64 + fr, pn = u.pn;
        if (asc != 1.0f) {
#pragma unroll
            for (int ai = 0; ai < 2; ++ai)
#pragma unroll
                for (int bj = 0; bj < 2; ++bj)
#pragma unroll
                    for (int m = 0; m < 4; ++m) { acc[ai][bj][m][0] = acc[ai][bj][m][0] * asc; acc[ai][bj][m][1] = acc[ai][bj][m][1] * asc; } }
        if (pn < 4) {
            const float* g = (pn < 2) ? qg : kg; bf16_t* dst = (pn < 2) ? QA : KA; const int head = 4 * (pn & 1) + wc;
            f32x4 gv[2][2];
#pragma unroll
            for (int bj = 0; bj < 2; ++bj)
#pragma unroll
                for (int n = 0; n < 2; ++n) gv[bj][n] = *(const f32x4*)(g + 32 * bj + 8 * fq + 4 * n);
#pragma unroll
            for (int ai = 0; ai < 2; ++ai)
#pragma unroll
                for (int m = 0; m < 4; ++m) {
                    const size_t row = (size_t)(row0 + ai * HALF + m * 16);
                    float ss = (sumsq4(acc[ai][0][m][0]) + sumsq4(acc[ai][0][m][1])) + (sumsq4(acc[ai][1][m][0]) + sumsq4(acc[ai][1][m][1]));
                    ss += __shfl_xor(ss, 16); ss += __shfl_xor(ss, 32);
                    const float rstd = rsqrtf(ss * (1.0f / 64.0f) + RMS_EPS);
#pragma unroll
                    for (int bj = 0; bj < 2; ++bj)
                        *(u32x4*)(dst + row * 512 + head * 64 + 32 * bj + 8 * fq) = pack8(acc[ai][bj][m][0] * rstd * gv[bj][0], acc[ai][bj][m][1] * rstd * gv[bj][1]);
                }
        } else if (pn >= 9) {
#pragma unroll
            for (int ai = 0; ai < 2; ++ai)
#pragma unroll
                for (int m = 0; m < 4; ++m) {
                    const size_t row = (size_t)(row0 + ai * HALF + m * 16);
#pragma unroll
                    for (int bj = 0; bj < 2; ++bj) { f32x4 a = acc[ai][bj][m][0], b = acc[ai][bj][m][1];
#pragma unroll
                        for (int j = 0; j < 4; ++j) { a[j] = sigmoidf_(a[j]); b[j] = sigmoidf_(b[j]); }
#if GATES_F8
                        { u32x2 w; w.x = cvt_pk4_fp8(a[0] * F8_SG, a[1] * F8_SG, a[2] * F8_SG, a[3] * F8_SG); w.y = cvt_pk4_fp8(b[0] * F8_SG, b[1] * F8_SG, b[2] * F8_SG, b[3] * F8_SG);
                          *(u32x2*)((unsigned char*)GATES + row * 2048 + (pn - 9) * 256 + 128 * bj + 32 * wc + 8 * fq) = w; } }
#else
                        *(u32x4*)(GATES + row * 2048 + (pn - 9) * 256 + 128 * bj + 32 * wc + 8 * fq) = pack8(a, b); }
#endif
                }
        } else {
#pragma unroll
            for (int ai = 0; ai < 2; ++ai)
#pragma unroll
                for (int m = 0; m < 4; ++m) {
                    const size_t row = (size_t)(row0 + ai * HALF + m * 16);
                    if (pn >= 6) {
                        float s0 = sumsq4(acc[ai][0][m][0]) + sumsq4(acc[ai][0][m][1]), s1 = sumsq4(acc[ai][1][m][0]) + sumsq4(acc[ai][1][m][1]);
                        s0 += __shfl_xor(s0, 16); s0 += __shfl_xor(s0, 32); s1 += __shfl_xor(s1, 16); s1 += __shfl_xor(s1, 32);
                        if (fq == 0) { if (pn == 6) P6[row * 4 + wc] = s0 + s1; else if (pn == 8) P8[row * 4 + wc] = s0 + s1; else { P7[row * 8 + wc] = s0; if (wc == 0) P7[row * 8 + 4] = s1; } } }
#pragma unroll
                    for (int bj = 0; bj < 2; ++bj) {
                        const u32x4 w = pack8(acc[ai][bj][m][0], acc[ai][bj][m][1]); const int cc = 128 * bj + 32 * wc + 8 * fq;
                        if (pn < 6) *(u32x4*)(VA + row * 512 + (pn - 4) * 256 + cc) = w;
                        else if (pn == 6) *(u32x4*)(ZCQ + row * QLORA + cc) = w;
                        else if (pn == 8) *(u32x4*)(ZCKV + row * KVLORA + cc) = w;
                        else { if (bj == 0) *(u32x4*)(ZCQ + row * QLORA + 256 + cc) = w; else if (wc == 0) *(u32x4*)(ZKR + row * ROPED + 8 * fq) = w; }
                    }
                }
        }
    }
};

__device__ __forceinline__ void rope8(float (&v)[8], const LAS float* rope, int s  , int fq) {
    const int pos = (fq < 2) ? (s >> 6) : (s & 63);
    const f32x4 c0 = *(const LAS f32x4*)(rope + pos * 8), c1 = *(const LAS f32x4*)(rope + pos * 8 + 4), s0 = *(const LAS f32x4*)(rope + 512 + pos * 8), s1 = *(const LAS f32x4*)(rope + 512 + pos * 8 + 4);
    const float cs[8] = {c0[0], c0[1], c0[2], c0[3], c1[0], c1[1], c1[2], c1[3]}, sn[8] = {s0[0], s0[1], s0[2], s0[3], s1[0], s1[1], s1[2], s1[3]};
#pragma unroll
    for (int i = 0; i < 8; ++i) { const float o = __shfl_xor(v[i], 16); v[i] = (fq & 1) ? (o * sn[i] + v[i] * cs[i]) : (v[i] * cs[i] - o * sn[i]); }
}

struct EpiQ {
    static constexpr bool PERM = true, CHAIN = false;
    bf16_t* QB; const float *p6, *p7, *g; const LAS float* rope; LAS float* P;
    __device__ __forceinline__ void operator()(f32x4 (&acc)[2][2][4][2], const Unit& u, int wr, int wc, int fr, int fq) const {
        const int row0 = u.pm * BM + wr * 64 + fr; const bool isx = u.pm < MT_X;
        float r8[8];
#pragma unroll
        for (int i = 0; i < 8; ++i) { const size_t row = (size_t)(row0 + (i >> 2) * HALF + (i & 3) * 16); const f32x4 a = *(const f32x4*)(p6 + row * 4), b = *(const f32x4*)(p7 + row * 8);
            r8[i] = rsqrtf((((a[0] + a[1]) + (a[2] + a[3])) + ((b[0] + b[1]) + (b[2] + b[3]))) * (1.0f / QLORA) + RMS_EPS); }
        const int gq = (wc < 3) ? wc : 0;
        const f32x4 g0 = *(const f32x4*)(g + 32 * gq + 8 * fq), g1 = *(const f32x4*)(g + 32 * gq + 8 * fq + 4);
#pragma unroll
        for (int ai = 0; ai < 2; ++ai)
#pragma unroll
            for (int m = 0; m < 4; ++m) {
                const float r = r8[ai * 4 + m]; const int rl = ai * 64 + m * 16 + fr;
#pragma unroll
                for (int bj = 0; bj < 2; ++bj) {
                    float ss = (sumsq4(acc[ai][bj][m][0]) + sumsq4(acc[ai][bj][m][1])) * (r * r); ss += __shfl_xor(ss, 16); ss += __shfl_xor(ss, 32);
                    if (fq == 0) P[((wr * 128 + rl) * 2 + bj) * 4 + wc] = ss; }
            }
        EPI_BAR();
        if (wc < 3) {
#pragma unroll
            for (int ai = 0; ai < 2; ++ai)
#pragma unroll
                for (int m = 0; m < 4; ++m) {
                    const int row = row0 + ai * HALF + m * 16, rl = ai * 64 + m * 16 + fr; const float r = r8[ai * 4 + m];
#pragma unroll
                    for (int bj = 0; bj < 2; ++bj) {
                        const f32x4 p = *(const LAS f32x4*)(P + ((wr * 128 + rl) * 2 + bj) * 4);
                        const float rstd = r * rsqrtf(((p[0] + p[1]) + p[2]) * (1.0f / 96.0f) + RMS_EPS);
                        const f32x4 a = acc[ai][bj][m][0] * rstd * g0, b = acc[ai][bj][m][1] * rstd * g1;
                        float v[8] = {a[0], a[1], a[2], a[3], b[0], b[1], b[2], b[3]};
                        if (wc == 2 && isx) rope8(v, rope, row & (SEQ - 1), fq);
                        u32x4 w; w.x = cvt_pk_bf16(v[0], v[1]); w.y = cvt_pk_bf16(v[2], v[3]); w.z = cvt_pk_bf16(v[4], v[5]); w.w = cvt_pk_bf16(v[6], v[7]);
                        *(u32x4*)(QB + (size_t)row * 768 + (2 * u.pn + bj) * QKD + 32 * wc + 8 * fq) = w;
                    }
                    asm volatile("" ::: "memory");
                }
        }
    }
};

struct EpiKV {
    static constexpr bool PERM = true, CHAIN = false;
    bf16_t *KB, *VB; const bf16_t* ZKR; const float *p7, *p8, *g; const LAS float* rope; LAS float* P;
    __device__ __forceinline__ void operator()(f32x4 (&acc)[2][2][4][2], const Unit& u, int wr, int wc, int fr, int fq) const {
        const int row0 = u.pm * BM + wr * 64 + fr; const bool isx = u.pm < MT_X;
        float r8[8], k8[8]; u32x4 zk8[8];
#pragma unroll
        for (int i = 0; i < 8; ++i) { const int row = row0 + (i >> 2) * HALF + (i & 3) * 16; const f32x4 a = *(const f32x4*)(p8 + (size_t)row * 4);
            k8[i] = p7[(size_t)row * 8 + 4]; r8[i] = rsqrtf(((a[0] + a[1]) + (a[2] + a[3])) * (1.0f / KVLORA) + RMS_EPS);
            zk8[i] = (u32x4){0u, 0u, 0u, 0u}; if (wc == 2) zk8[i] = *(const u32x4*)(ZKR + (size_t)row * ROPED + 8 * fq); }
        const int gofs = (wc < 2) ? (32 * wc + 8 * fq) : (64 + 8 * fq);
        const f32x4 g0 = *(const f32x4*)(g + gofs), g1 = *(const f32x4*)(g + gofs + 4);
        if (wc < 2) {
#pragma unroll
            for (int ai = 0; ai < 2; ++ai)
#pragma unroll
                for (int m = 0; m < 4; ++m) { const float r = r8[ai * 4 + m]; const int rl = ai * 64 + m * 16 + fr;
#pragma unroll
                    for (int bj = 0; bj < 2; ++bj) { float ss = (sumsq4(acc[ai][bj][m][0]) + sumsq4(acc[ai][bj][m][1])) * (r * r); ss += __shfl_xor(ss, 16); ss += __shfl_xor(ss, 32);
                        if (fq == 0) P[((wr * 128 + rl) * 2 + bj) * 4 + wc] = ss + ((wc == 0) ? k8[ai * 4 + m] : 0.f); } }
        }
        EPI_BAR();
#pragma unroll
        for (int ai = 0; ai < 2; ++ai)
#pragma unroll
            for (int m = 0; m < 4; ++m) {
                const int row = row0 + ai * HALF + m * 16, rl = ai * 64 + m * 16 + fr;
                const float rr = r8[ai * 4 + m]; const u32x4 zk = zk8[ai * 4 + m];
#pragma unroll
                for (int bj = 0; bj < 2; ++bj) {
                    const int head = 2 * u.pn + bj;
                    const f32x4 p = *(const LAS f32x4*)(P + ((wr * 128 + rl) * 2 + bj) * 4);
                    const float rstd = rsqrtf((p[0] + p[1]) * (1.0f / 96.0f) + RMS_EPS);
                    if (wc < 2) {
                        *(u32x4*)(KB + (size_t)row * 768 + head * QKD + 32 * wc + 8 * fq) = pack8(acc[ai][bj][m][0] * (rr * rstd) * g0, acc[ai][bj][m][1] * (rr * rstd) * g1);
                    } else {
                        *(u32x4*)(VB + (size_t)row * 512 + head * 64 + 32 * (wc - 2) + 8 * fq) = pack8(acc[ai][bj][m][0] * rr, acc[ai][bj][m][1] * rr);
                        if (wc == 2) {
                            float v[8] = {bf_lo(zk.x) * rstd * g0[0], bf_hi(zk.x) * rstd * g0[1], bf_lo(zk.y) * rstd * g0[2], bf_hi(zk.y) * rstd * g0[3],
                                          bf_lo(zk.z) * rstd * g1[0], bf_hi(zk.z) * rstd * g1[1], bf_lo(zk.w) * rstd * g1[2], bf_hi(zk.w) * rstd * g1[3]};
                            if (isx) rope8(v, rope, row & (SEQ - 1), fq);
                            u32x4 w; w.x = cvt_pk_bf16(v[0], v[1]); w.y = cvt_pk_bf16(v[2], v[3]); w.z = cvt_pk_bf16(v[4], v[5]); w.w = cvt_pk_bf16(v[6], v[7]);
                            *(u32x4*)(KB + (size_t)row * 768 + head * QKD + 64 + 8 * fq) = w;
                        }
                    }
                }
                asm volatile("" ::: "memory");
            }
    }
};

struct EpiMerge {
    static constexpr bool PERM = true, CHAIN = true;
    const bf16_t* GATES; bf16_t* Y;
    __device__ __forceinline__ void operator()(f32x4 (&acc)[2][2][4][2], const Unit& u, int wr, int wc, int fr, int fq) const {
        const int row0 = u.pm * BM + wr * 64 + fr;
#pragma unroll
        for (int ai = 0; ai < 2; ++ai)
#pragma unroll
            for (int m = 0; m < 4; ++m) {
                const size_t row = (size_t)(row0 + ai * HALF + m * 16);
#pragma unroll
                for (int bj = 0; bj < 2; ++bj) {
                    const int col = u.pn * 256 + 128 * bj + 32 * wc + 8 * fq;
#if GATES_F8
                    const u32x2 gb = *(const u32x2*)((const unsigned char*)GATES + row * 2048 + 1024 + col);
                    const f32x4 b0 = fp8x4_f32(gb.x) * (1.0f / F8_SG), b1 = fp8x4_f32(gb.y) * (1.0f / F8_SG);
#else
                    const u32x4 gb = *(const u32x4*)(GATES + row * 2048 + 1024 + col);
                    const f32x4 b0 = (f32x4){bf_lo(gb.x), bf_hi(gb.x), bf_lo(gb.y), bf_hi(gb.y)}, b1 = (f32x4){bf_lo(gb.z), bf_hi(gb.z), bf_lo(gb.w), bf_hi(gb.w)};
#endif
                    if (u.kind == 0) {
#if GATES_F8
                        const u32x2 ga = *(const u32x2*)((const unsigned char*)GATES + row * 2048 + col);
                        const f32x4 a0 = fp8x4_f32(ga.x) * (1.0f / F8_SG), a1 = fp8x4_f32(ga.y) * (1.0f / F8_SG);
#else
                        const u32x4 ga = *(const u32x4*)(GATES + row * 2048 + col);
                        const f32x4 a0 = (f32x4){bf_lo(ga.x), bf_hi(ga.x), bf_lo(ga.y), bf_hi(ga.y)}, a1 = (f32x4){bf_lo(ga.z), bf_hi(ga.z), bf_lo(ga.w), bf_hi(ga.w)};
#endif
#pragma unroll
                        for (int j = 0; j < 4; ++j) { acc[ai][bj][m][0][j] *= a0[j] * __builtin_amdgcn_rcpf(b0[j]); acc[ai][bj][m][1][j] *= a1[j] * __builtin_amdgcn_rcpf(b1[j]); }
                    } else {
#if C2_F8
                        { const f32x4 y0 = acc[ai][bj][m][0] * b0 * F8_SY, y1 = acc[ai][bj][m][1] * b1 * F8_SY; u32x2 w; w.x = cvt_pk4_fp8(y0[0], y0[1], y0[2], y0[3]); w.y = cvt_pk4_fp8(y1[0], y1[1], y1[2], y1[3]);
                          *(u32x2*)((unsigned char*)Y + row * 1024 + col) = w; }
#else
                        *(u32x4*)(Y + row * 1024 + col) = pack8(acc[ai][bj][m][0] * b0, acc[ai][bj][m][1] * b1);
#endif
                    }
                }
            }
    }
};

struct EpiOut {
    static constexpr bool PERM = false, CHAIN = false;
    const float* xsrc; float* xdst; const float* csrc; float* cdst; const float* mod  ; int goff; float asc;
    __device__ __forceinline__ void operator()(f32x4 (&acc)[2][2][4][2], const Unit& u, int wr, int wc, int fr, int fq) const {
        const bool isx = u.pm < MT_X;
        const int rowt = (isx ? u.pm : u.pm - MT_X) * BM + wr * 64 + fr;
        const float* src = isx ? xsrc : csrc; float* dst = isx ? xdst : cdst;
        const float* gm = mod + (size_t)(isx ? (u.pm >> 3) : 16) * NMODC + goff;
        const int col0 = u.pn * BM + wc * 32 + 4 * fq;
        f32x4 gv[2][2];
#pragma unroll
        for (int bj = 0; bj < 2; ++bj)
#pragma unroll
            for (int n = 0; n < 2; ++n) gv[bj][n] = *(const f32x4*)(gm + col0 + bj * HALF + n * 16) * asc;
#pragma unroll
        for (int ai = 0; ai < 2; ++ai)
#pragma unroll
            for (int m = 0; m < 4; ++m) { const size_t off = (size_t)(rowt + ai * HALF + m * 16) * DM + col0;
#pragma unroll
                for (int bj = 0; bj < 2; ++bj)
#pragma unroll
                    for (int n = 0; n < 2; ++n) { const f32x4 xs = *(const f32x4*)(src + off + bj * HALF + n * 16); *(f32x4*)(dst + off + bj * HALF + n * 16) = xs + gv[bj][n] * acc[ai][bj][m][n]; }
            }
    }
};

template <bool F8> struct EpiMoe1 {
    static constexpr bool PERM = true, CHAIN = false;
    bf16_t* HM; float ascale;
    __device__ __forceinline__ void operator()(f32x4 (&acc)[2][2][4][2], const Unit& u, int wr, int wc, int fr, int fq) const {
        const int row0 = u.pm * BM + wr * 64 + fr;
#pragma unroll
        for (int ai = 0; ai < 2; ++ai)
#pragma unroll
            for (int m = 0; m < 4; ++m) { const size_t row = (size_t)(row0 + ai * HALF + m * 16);
#pragma unroll
                for (int bj = 0; bj < 2; ++bj) { f32x4 p = acc[ai][bj][m][0], q = acc[ai][bj][m][1];
                    if (F8) { p = p * ascale; q = q * ascale; }
                    const float h0 = p[0] * sigmoidf_(p[0]) * p[1], h1 = p[2] * sigmoidf_(p[2]) * p[3], h2 = q[0] * sigmoidf_(q[0]) * q[1], h3 = q[2] * sigmoidf_(q[2]) * q[3];
                    const int col = u.pn * 128 + 64 * bj + 16 * wc + 4 * fq;
                    if (F8) *(unsigned*)((unsigned char*)HM + row * DM + col) = cvt_pk4_fp8(h0 * F8_SM, h1 * F8_SM, h2 * F8_SM, h3 * F8_SM);
                    else { u32x2 w; w.x = cvt_pk_bf16(h0, h1); w.y = cvt_pk_bf16(h2, h3); *(u32x2*)(HM + row * DM + col) = w; } }
            }
    }
};
struct EpiMoe2 {
    static constexpr bool PERM = true, CHAIN = false;
    bf16_t* YS; float ascale;
    __device__ __forceinline__ void operator()(f32x4 (&acc)[2][2][4][2], const Unit& u, int wr, int wc, int fr, int fq) const {
        const int row0 = u.pm * BM + wr * 64 + fr;
#pragma unroll
        for (int ai = 0; ai < 2; ++ai)
#pragma unroll
            for (int m = 0; m < 4; ++m) { const size_t row = (size_t)(row0 + ai * HALF + m * 16);
#pragma unroll
                for (int bj = 0; bj < 2; ++bj) *(u32x4*)(YS + row * DM + u.pn * 256 + 128 * bj + 32 * wc + 8 * fq) = pack8(acc[ai][bj][m][0] * ascale, acc[ai][bj][m][1] * ascale); }
    }
};

struct SchedRect {
    const char* A; const char* B; size_t tstep; int nM, nN, G, c, nM2, pn2, npn2;
    __device__ __forceinline__ bool next(int i, Unit& u) const {
        const int L = i * G + c, mainc = nM * nN; u.kind = 0; u.e = 0;
        if (L < mainc) { rect_tile(L, nM, nN, u.pm, u.pn); return true; }
        const int Lx = L - mainc; if (Lx >= nM2 * npn2) return false;
        u.pm = nM + Lx / npn2; u.pn = pn2 + Lx % npn2; return true;
    }
    __device__ __forceinline__ const char* a_ptr(const Unit& u) const { return A + (size_t)u.pm * tstep; }
    __device__ __forceinline__ const char* b_ptr(const Unit& u) const { return B + (size_t)u.pn * tstep; }
};
struct SchedMerge {
    const char *OA, *OB, *WA, *WB; size_t tstep; int nM, nN, G, c;
    __device__ __forceinline__ bool next(int i, Unit& u) const {
        const int L = (i >> 1) * G + c; if (L >= nM * nN) return false;
        rect_tile(L, nM, nN, u.pm, u.pn); u.kind = i & 1; u.e = 0; return true;
    }
    __device__ __forceinline__ const char* a_ptr(const Unit& u) const { return (u.kind ? OB : OA) + (size_t)u.pm * tstep; }
    __device__ __forceinline__ const char* b_ptr(const Unit& u) const { return (u.kind ? WB : WA) + (size_t)u.pn * tstep; }
};
struct SchedMoe {
    const char* A; const char* W; size_t tstepA, wstride, tstepB; const LAS int* tile_e  ; int ntile, nN, G, c;
    __device__ __forceinline__ bool next(int i, Unit& u) const {
        const int L = i * G + c; if (L >= ntile * nN) return false;
        rect_tile(L, ntile, nN, u.pm, u.pn); u.kind = 0;
        u.e = __builtin_amdgcn_readfirstlane(tile_e[u.pm]); return true;
    }
    __device__ __forceinline__ const char* a_ptr(const Unit& u) const { return A + (size_t)u.pm * tstepA; }
    __device__ __forceinline__ const char* b_ptr(const Unit& u) const { return W + (size_t)u.e * wstride + (size_t)u.pn * tstepB; }
};
}
namespace att {
constexpr int NW = 8, QBLK = 32, KVBLK = 64, DV = 64;
constexpr int SHM_V = 16384, SHM_K = 16384;
constexpr int LDS_VOFF = 0, LDS_KOFF = 2 * SHM_V, LDS_WS = LDS_KOFF + 2 * SHM_K, LDS_OST = LDS_WS + NW * 64 * 4, LDS_BIAS = LDS_OST + NW * 4096, LDS_MASK = LDS_BIAS + 16 * 128 * 4, LDS_END = LDS_MASK + 64 * 64 * 4;
static_assert(LDS_END <= RING_BYTES, "attention LDS map");
template <int DQK> struct KL { static constexpr int PITCH = (DQK == 64) ? 128 : 256; };
#define KSWZ(row, colB) ((row) * KL<DQK>::PITCH + ((colB) ^ (((row) & 7) << 4)))
#define SBAR() __builtin_amdgcn_sched_barrier(0)
__device__ __forceinline__ int crow(int r, int hi) { return (r & 3) + 8 * (r >> 2) + 4 * hi; }
__device__ __forceinline__ int v_st(int k, int c) { const int kk = (k & ~0xC) | ((k & 4) << 1) | ((k & 8) >> 1); return ((kk >> 3) * 2 + (c >> 5)) * 512 + ((kk & 7) * 32 + (c & 31)) * 2; }
__device__ __forceinline__ int v_rd_base(int lane, int c) { const int hi = (lane >> 5) & 1, g = c + hi;
    return ((lane & 3) << 3) | (((lane >> 2) & 3) << 6) | (((lane >> 4) & 1) << 5) | ((g & 1) << 8) | ((g >> 1) << 11); }
constexpr int v_rd_off(int d0, int ks, int half) { return ((2 * ks + half) * 2 + d0) * 512; }
template <int OFF> __device__ __forceinline__ s16x4 tr_read(int vb) { s16x4 r; asm volatile("ds_read_b64_tr_b16 %0, %1 offset:%2" : "=&v"(r) : "v"(vb), "i"(OFF) : "memory"); return r; }

template <int D0> __device__ __forceinline__ void pv_one(f32x16& od, int vbA, int vbB, bf16x8 pa0, bf16x8 pa1, bf16x8 pa2, bf16x8 pa3) {
    const s16x4 l0 = tr_read<v_rd_off(D0, 0, 0)>(vbA), h0 = tr_read<v_rd_off(D0, 0, 1)>(vbA), l1 = tr_read<v_rd_off(D0, 1, 0)>(vbA), h1 = tr_read<v_rd_off(D0, 1, 1)>(vbA);
    const s16x4 l2 = tr_read<v_rd_off(D0, 0, 0)>(vbB), h2 = tr_read<v_rd_off(D0, 0, 1)>(vbB), l3 = tr_read<v_rd_off(D0, 1, 0)>(vbB), h3 = tr_read<v_rd_off(D0, 1, 1)>(vbB);
    asm volatile("s_waitcnt lgkmcnt(0)" ::: "memory"); SBAR();
#define PK(L, H) (bf16x8){L[0], L[1], L[2], L[3], H[0], H[1], H[2], H[3]}
    od = __builtin_amdgcn_mfma_f32_32x32x16_bf16(pa0, PK(l0, h0), od, 0, 0, 0);
    od = __builtin_amdgcn_mfma_f32_32x32x16_bf16(pa1, PK(l1, h1), od, 0, 0, 0);
    od = __builtin_amdgcn_mfma_f32_32x32x16_bf16(pa2, PK(l2, h2), od, 0, 0, 0);
    od = __builtin_amdgcn_mfma_f32_32x32x16_bf16(pa3, PK(l3, h3), od, 0, 0, 0);
#undef PK
}
__device__ __forceinline__ void pv_all(f32x16* o, int vbA, int vbB, bf16x8 pa0, bf16x8 pa1, bf16x8 pa2, bf16x8 pa3) { pv_one<0>(o[0], vbA, vbB, pa0, pa1, pa2, pa3); pv_one<1>(o[1], vbA, vbB, pa0, pa1, pa2, pa3); }

#define MX3(a, b, c) __builtin_fmaxf(__builtin_fmaxf((a), (b)), (c))
template <bool FIRST>
__device__ __forceinline__ void partialSM(f32x16& p0, f32x16& p1, float& m_reg, float& alpha, f32x16& negm, const float THR2) {
    float a = MX3(p0[0], p0[1], p1[0]), b = MX3(p0[2], p0[3], p1[1]); a = MX3(a, p1[2], p1[3]);
#pragma unroll
    for (int r = 4; r < 16; r += 4) { a = MX3(a, p0[r], p0[r + 1]); b = MX3(b, p0[r + 2], p0[r + 3]); a = MX3(a, p1[r], p1[r + 1]); b = MX3(b, p1[r + 2], p1[r + 3]); }
    float pmax = __builtin_fmaxf(a, b);
    { auto rr = __builtin_amdgcn_permlane32_swap(__float_as_uint(pmax), __float_as_uint(pmax), false, false); pmax = __builtin_fmaxf(__uint_as_float(rr[0]), __uint_as_float(rr[1])); }
    alpha = 1.f;
    if (FIRST || !__builtin_expect(__all(pmax <= THR2), 1)) {
        const float dl = FIRST ? pmax : __builtin_fmaxf(pmax, 0.f);
        m_reg += dl; alpha = FIRST ? 1.f : __builtin_amdgcn_exp2f(-dl);
#pragma unroll
        for (int r = 0; r < 16; ++r) { p0[r] -= dl; p1[r] -= dl; }
#pragma unroll
        for (int r = 0; r < 16; ++r) negm[r] = -m_reg;
    }
#pragma unroll
    for (int r = 0; r < 16; ++r) p0[r] = __builtin_amdgcn_exp2f(p0[r]);
}
__device__ __forceinline__ void finishSM(f32x16& p0, f32x16& p1, float alpha, float& l_reg, bf16x8& pa0, bf16x8& pa1, bf16x8& pa2, bf16x8& pa3) {
#pragma unroll
    for (int r = 0; r < 16; ++r) p1[r] = __builtin_amdgcn_exp2f(p1[r]);
    float ps = 0;
#pragma unroll
    for (int r = 0; r < 16; ++r) ps += p0[r];
#pragma unroll
    for (int r = 0; r < 16; ++r) ps += p1[r];
    { auto rr = __builtin_amdgcn_permlane32_swap(__float_as_uint(ps), __float_as_uint(ps), false, false); ps = __uint_as_float(rr[0]) + __uint_as_float(rr[1]); }
    l_reg = l_reg * alpha + ps;
#define PK4(P, BASE, OUT) do { unsigned a0 = cvt_pk_bf16(P[BASE + 0], P[BASE + 1]), a1 = cvt_pk_bf16(P[BASE + 2], P[BASE + 3]);   \
    unsigned b0 = cvt_pk_bf16(P[BASE + 4], P[BASE + 5]), b1 = cvt_pk_bf16(P[BASE + 6], P[BASE + 7]);                              \
    auto r0 = __builtin_amdgcn_permlane32_swap(a0, b0, false, false); auto r1 = __builtin_amdgcn_permlane32_swap(a1, b1, false, false); \
    u32x4 w = {r0[0], r1[0], r0[1], r1[1]}; OUT = *reinterpret_cast<bf16x8*>(&w); } while (0)
    PK4(p0, 0, pa0); PK4(p0, 8, pa1); PK4(p1, 0, pa2); PK4(p1, 8, pa3);
#undef PK4
}
template <int DQK> __device__ __forceinline__ void qkt(f32x16& p0, f32x16& p1, const char* Ks, int rowA, int rowB, const bf16x8* qr, const f32x16& negm, int hi) {
#pragma unroll
    for (int d0 = 0; d0 < DQK / 16; ++d0) { const int cb = (d0 * 16 + hi * 8) * 2;
        const bf16x8 b0 = *reinterpret_cast<const bf16x8*>(Ks + KSWZ(rowA, cb));
        const bf16x8 b1 = *reinterpret_cast<const bf16x8*>(Ks + KSWZ(rowB, cb));
        if (d0 == 0) { p0 = __builtin_amdgcn_mfma_f32_32x32x16_bf16(b0, qr[0], negm, 0, 0, 0); p1 = __builtin_amdgcn_mfma_f32_32x32x16_bf16(b1, qr[0], negm, 0, 0, 0); }
        else { p0 = __builtin_amdgcn_mfma_f32_32x32x16_bf16(b0, qr[d0], p0, 0, 0, 0); p1 = __builtin_amdgcn_mfma_f32_32x32x16_bf16(b1, qr[d0], p1, 0, 0, 0); } }
}

struct UnitArgs {
    const bf16_t* Q; int ldq; int qcol;
    const bf16_t* K; int ldk; int kcol;
    const bf16_t* V; int vcol;
    bf16_t* O; int ocol;
    int q0;
    int ctx0, loc0;
    int NT;
    int masked;
    int band, krow0;
    const float* bias;
    float C;
};

__device__ __forceinline__ void na_mask(f32x16& p0, f32x16& p1, const LAS float* bt, const LAS float* mk, int krA, int qrow, int qc, int kc0, int hi) {
    const int rs = min(max(qrow - 4, 0), 24);
    const int drA = ((krA >= rs) && (krA < rs + 8)) ? (krA - qrow + 7) : 15, drB = ((krA + 1 >= rs) && (krA + 1 < rs + 8)) ? (krA + 1 - qrow + 7) : 15;
    const LAS float* bA = bt + drA * 128 + (kc0 + 4 * hi - qc + 64); const LAS float* bB = bt + drB * 128 + (kc0 + 4 * hi - qc + 64);
    const LAS float* mq = mk + qc * 64 + kc0 + 4 * hi;
#pragma unroll
    for (int g = 0; g < 4; ++g) {
        const f32x4 m0 = *(const LAS f32x4*)(mq + 8 * g);
#pragma unroll
        for (int j = 0; j < 4; ++j) { p0[4 * g + j] = (p0[4 * g + j] + bA[8 * g + j]) + m0[j]; p1[4 * g + j] = (p1[4 * g + j] + bB[8 * g + j]) + m0[j]; }
    }
}
__device__ __forceinline__ void na_mask_table(char* lds) {
    LAS float* mk = (LAS float*)(lds + LDS_MASK);
    int t0 = threadIdx.x; asm volatile("" : "+v"(t0));
    for (int i = t0; i < 64 * 64; i += 512) { const int qc = i >> 6, kc = i & 63, cs = min(max(qc - 8, 0), 48); mk[i] = ((unsigned)(kc - cs) < 16u) ? 0.f : -1e30f; }
}

template <int DQK>
__device__ __forceinline__ void attn_unit(const UnitArgs& A, char* lds) {
    int tid = threadIdx.x; asm volatile("" : "+v"(tid));
    const int wid = tid >> 6, lane = tid & 63, r32 = lane & 31, hi = lane >> 5;
    char* V_lds = lds + LDS_VOFF; char* K_lds = lds + LDS_KOFF;
    float* ws = (float*)(lds + LDS_WS) + wid * 64; float* li_l = ws; float* al_l = ws + 32;
    const LAS float* bt = (const LAS float*)(lds + LDS_BIAS); const LAS float* mk = (const LAS float*)(lds + LDS_MASK);
    const float C = A.C, THR2 = 8.0f * 1.4426950408889634f;
    const bool msk = (DQK == 64) && A.masked;
    float m_reg = 0.f, l_reg = 0; f32x16 o[2] = {}; bf16x8 qr[DQK / 16]; f32x16 negm = f32x16{};
    if (msk) { for (int i = tid; i < 16 * 128; i += 512) { const int dr = i >> 7, d = (i & 127) - 64;
            ((LAS float*)(lds + LDS_BIAS))[i] = (dr == 15) ? -1e30f : ((d >= -15 && d <= 15) ? A.bias[dr * 31 + d + 15] * 1.4426950408889634f : 0.f); } }
    const int qrow = 4 * A.band + 2 * (wid >> 2) + (r32 >> 4), qc = 16 * (wid & 3) + (r32 & 15);
    const int kc0 = msk ? min(max(16 * (wid & 3) - 8, 0), 32) : 0;
    const int qtok = msk ? (A.q0 + 64 * (2 * (wid >> 2) + (r32 >> 4)) + qc) : (A.q0 + wid * QBLK + r32);
    const bf16_t* Qw = A.Q + (size_t)qtok * A.ldq + A.qcol + hi * 8;
#pragma unroll
    for (int d0 = 0; d0 < DQK / 16; ++d0) { const u32x4 w = *reinterpret_cast<const u32x4*>(Qw + d0 * 16);
        u32x4 t; t.x = cvt_pk_bf16(bf_lo(w.x) * C, bf_hi(w.x) * C); t.y = cvt_pk_bf16(bf_lo(w.y) * C, bf_hi(w.y) * C); t.z = cvt_pk_bf16(bf_lo(w.z) * C, bf_hi(w.z) * C); t.w = cvt_pk_bf16(bf_lo(w.w) * C, bf_hi(w.w) * C);
        qr[d0] = *reinterpret_cast<bf16x8*>(&t); }
    constexpr int CPR = DQK / 8;
    const int v0key = tid >> 3, vc = (tid & 7) * 8, vst0 = v_st(v0key, vc), vst1 = 8192 + vst0;
    const int k0key = tid / CPR, k0c = tid % CPR, k1id = tid + 512, k1key = k1id / CPR, k1c = k1id % CPR;
    const int vbS = (int)(uintptr_t)V_lds + v_rd_base(lane, 0);
    const int vbM = (int)(uintptr_t)V_lds + v_rd_base(lane, kc0 >> 3);
    bf16x8 sv0, sv1 = {}, sk0, sk1 = {};
#define LOCAL(t) (msk && (t) >= 4)
#define TROW(t) (((t) < 4) ? (A.ctx0 + 64 * (t)) : (A.loc0 + (msk ? 128 : 64) * ((t) - 4)))
#define K1ON(t) ((DQK == 96) ? (tid < 256) : LOCAL(t))
#define SLOAD(t) do { const int _r0 = TROW(t); sv0 = *reinterpret_cast<const bf16x8*>(A.V + (size_t)(_r0 + v0key) * 512 + A.vcol + vc); \
        sk0 = *reinterpret_cast<const bf16x8*>(A.K + (size_t)(_r0 + k0key) * A.ldk + A.kcol + k0c * 8); \
        if (K1ON(t)) sk1 = *reinterpret_cast<const bf16x8*>(A.K + (size_t)(_r0 + k1key) * A.ldk + A.kcol + k1c * 8); \
        if (LOCAL(t)) sv1 = *reinterpret_cast<const bf16x8*>(A.V + (size_t)(_r0 + 64 + v0key) * 512 + A.vcol + vc); } while (0)
#define SWRITE(b, t) do { *reinterpret_cast<bf16x8*>(V_lds + (b) * SHM_V + vst0) = sv0; *reinterpret_cast<bf16x8*>(K_lds + (b) * SHM_K + KSWZ(k0key, k0c * 16)) = sk0; \
        if (K1ON(t)) *reinterpret_cast<bf16x8*>(K_lds + (b) * SHM_K + KSWZ(k1key, k1c * 16)) = sk1; \
        if (LOCAL(t)) *reinterpret_cast<bf16x8*>(V_lds + (b) * SHM_V + vst1) = sv1; } while (0)
#define RESC(a) do { if (__any((a) < 1.f)) { if (hi == 0) al_l[r32] = (a); asm volatile("s_waitcnt lgkmcnt(0)" ::: "memory"); \
        _Pragma("unroll") for (int d = 0; d < 2; ++d) _Pragma("unroll") for (int r = 0; r < 16; ++r) o[d][r] *= al_l[crow(r, hi)]; } } while (0)
#define QKT(P0, P1, b, t) do { const int _ra = LOCAL(t) ? (kc0 + r32) : r32, _rb = LOCAL(t) ? (64 + kc0 + r32) : (32 + r32); \
        qkt<DQK>(P0, P1, K_lds + (b) * SHM_K, _ra, _rb, qr, negm, hi); if (LOCAL(t)) na_mask(P0, P1, bt, mk, A.krow0 + 2 * ((t) - 4), qrow, qc, kc0, hi); } while (0)
#define PV(b, t) do { const int _va = (LOCAL(t) ? vbM : vbS) + (b) * SHM_V, _vb = _va + (LOCAL(t) ? 8192 : 4096); pv_all(o, _va, _vb, pa0, pa1, pa2, pa3); } while (0)
    f32x16 pA0, pA1, pB0, pB1; float alA, alB; bf16x8 pa0, pa1, pa2, pa3; const int NT = A.NT;
    SLOAD(0); SWRITE(0, 0); __syncthreads();
    QKT(pA0, pA1, 0, 0); partialSM<true>(pA0, pA1, m_reg, alA, negm, THR2);
    SLOAD(1); SWRITE(1, 1); __syncthreads();
    for (int j = 1; j + 1 < NT; j += 2) {
        SBAR(); QKT(pB0, pB1, 1, j);
        finishSM(pA0, pA1, alA, l_reg, pa0, pa1, pa2, pa3); SBAR();
        SLOAD(j + 1); SBAR();
        PV(0, j - 1); partialSM<false>(pB0, pB1, m_reg, alB, negm, THR2);
        __syncthreads(); SWRITE(0, j + 1);
        RESC(alB); __syncthreads();
        SBAR(); QKT(pA0, pA1, 0, j + 1);
        finishSM(pB0, pB1, alB, l_reg, pa0, pa1, pa2, pa3); SBAR();
        SLOAD(j + 2); SBAR();
        PV(1, j); partialSM<false>(pA0, pA1, m_reg, alA, negm, THR2);
        __syncthreads(); SWRITE(1, j + 2);
        RESC(alA); __syncthreads();
    }
    SBAR(); QKT(pB0, pB1, 1, NT - 1);
    finishSM(pA0, pA1, alA, l_reg, pa0, pa1, pa2, pa3); SBAR();
    PV(0, NT - 2); partialSM<false>(pB0, pB1, m_reg, alB, negm, THR2);
    __syncthreads(); RESC(alB);
    finishSM(pB0, pB1, alB, l_reg, pa0, pa1, pa2, pa3); SBAR();
    PV(1, NT - 1);
    if (hi == 0) li_l[r32] = l_reg; asm volatile("s_waitcnt lgkmcnt(0)" ::: "memory");
    float rli[16];
#pragma unroll
    for (int r = 0; r < 16; ++r) rli[r] = __builtin_amdgcn_rcpf(li_l[crow(r, hi)]);
    bf16_t* stg = (bf16_t*)(lds + LDS_OST) + wid * 2048;
#pragma unroll
    for (int r = 0; r < 16; ++r) { const int orow = crow(r, hi);
#pragma unroll
        for (int d0 = 0; d0 < 2; ++d0) { const unsigned w = cvt_pk_bf16(o[d0][r] * rli[r], 0.f); stg[orow * 64 + d0 * 32 + r32] = (bf16_t)(w & 0xffffu); } }
    asm volatile("s_waitcnt lgkmcnt(0)" ::: "memory");
#pragma unroll
    for (int i = 0; i < 4; ++i) { const int row = i * 8 + (lane >> 3), ch = lane & 7; const u32x4 v = *(const u32x4*)(stg + row * 64 + ch * 8);
        const int otok = msk ? (A.q0 + 64 * (2 * (wid >> 2) + (row >> 4)) + 16 * (wid & 3) + (row & 15)) : (A.q0 + wid * QBLK + row);
        *(u32x4*)(A.O + (size_t)otok * 512 + A.ocol + ch * 8) = v; }
    __syncthreads();
#undef LOCAL
#undef TROW
#undef K1ON
#undef SLOAD
#undef SWRITE
#undef RESC
#undef QKT
#undef PV
}
#undef KSWZ
#undef SBAR
}
struct Frame {
    LAS unsigned char* lds;
    int tid, lane, wave, vcu, G;
};
#define CAS __attribute__((address_space(4)))
__device__ __forceinline__ const CAS char* karg() { return (const CAS char*)__builtin_amdgcn_kernarg_segment_ptr(); }
template <int I> __device__ __forceinline__ const float* in_ptr() { unsigned off = I * 8; asm volatile("" : "+s"(off)); return *(const float* const CAS*)(karg() + off); }
__device__ __forceinline__ float* out_ptr() { unsigned off = 26 * 8; asm volatile("" : "+s"(off)); return *(float* const CAS*)(karg() + off); }
__device__ __forceinline__ unsigned char* ws_ptr() { unsigned off = 27 * 8; asm volatile("" : "+s"(off)); return *(unsigned char* const CAS*)(karg() + off); }
enum { I_X = 0, I_C, I_CTX, I_CCTX, I_WADA, I_BADA, I_NMIXG, I_NFFNG, I_WIN, I_NAQG, I_NAKG, I_RPB, I_CQG, I_WUQ, I_CKVG, I_WUKV, I_QG, I_KG, I_WOA, I_WOB, I_WOUT, I_WR, I_RB, I_W1, I_W3, I_W2 };

#define LDS_WAIT() asm volatile("s_waitcnt lgkmcnt(0)" ::: "memory")

__device__ __forceinline__ int win_src_col(int np) {
    const int pn = np >> 8, cc = np & 255;
    if (pn < 4) { const int part = pn >> 1, tq = pn & 1, bj = cc >> 7, wc = (cc >> 5) & 3, i = cc & 31; return part * 512 + (4 * tq + wc) * 64 + 32 * bj + i; }
    if (pn < 6) return 1024 + (pn - 4) * 256 + cc;
    if (pn == 6) return 1536 + cc;
    if (pn == 7) return cc < 128 ? 1792 + cc : (cc < 160 ? 2176 + (cc - 128) : -1);
    if (pn == 8) return 1920 + cc;
    return 2208 + (pn - 9) * 256 + cc;
}
template <bool F8 = false>
__device__ __forceinline__ void conv_item(const float* src, size_t ld, int dcol, int dstep, const float* gain, bf16_t* WT, int K, int k0, int n0, LAS float* scr, int lane) {
    const int kr = lane >> 4;
    f32x4 v[16];
#pragma unroll
    for (int i = 0; i < 16; ++i) { v[i] = (f32x4){0.f, 0.f, 0.f, 0.f}; if (src) v[i] = __builtin_nontemporal_load((const f32x4*)(src + (size_t)(k0 + 4 * i + kr) * ld)); }
#pragma unroll
    for (int i = 0; i < 16; ++i) { const int kk = 4 * i + kr;
        if (gain) v[i] = v[i] * gain[k0 + kk];
        LAS float* s = scr + kk * 65 + dcol; s[0] = v[i][0]; s[dstep] = v[i][1]; s[2 * dstep] = v[i][2]; s[3 * dstep] = v[i][3]; }
    LDS_WAIT(); asm volatile("" ::: "memory");
    const int c = lane & 7;
#pragma unroll
    for (int j = 0; j < 8; ++j) { const int n = (lane >> 3) + 8 * j; const LAS float* s = scr + (8 * c) * 65 + n;
        if (F8) { u32x2 o; o.x = cvt_pk4_fp8(s[0 * 65] * F8_SW, s[1 * 65] * F8_SW, s[2 * 65] * F8_SW, s[3 * 65] * F8_SW); o.y = cvt_pk4_fp8(s[4 * 65] * F8_SW, s[5 * 65] * F8_SW, s[6 * 65] * F8_SW, s[7 * 65] * F8_SW);
            *(u32x2*)((unsigned char*)WT + (size_t)(n0 + n) * K + k0 + 8 * c) = o; }
        else { u32x4 o; o.x = cvt_pk_bf16(s[0 * 65], s[1 * 65]); o.y = cvt_pk_bf16(s[2 * 65], s[3 * 65]); o.z = cvt_pk_bf16(s[4 * 65], s[5 * 65]); o.w = cvt_pk_bf16(s[6 * 65], s[7 * 65]);
            *(u32x4*)(WT + (size_t)(n0 + n) * K + k0 + 8 * c) = o; } }
    LDS_WAIT(); asm volatile("" ::: "memory");
}
__device__ __forceinline__ void p0_convert(Frame& F) {
    LAS float* scr = (LAS float*)(F.lds + F.wave * 16640);
    const int gw = F.vcu * 8 + F.wave, NGW = F.G * 8, lane = F.lane, q16 = lane & 15;
    constexpr int I_IN = 16 * 68, I_UQ = 6 * 16, I_UKV = 4 * 16, I_OA = 8 * 16, I_OUT = 16 * 16, I_13 = 16 * 32 * NEXP, I_2 = 16 * 16 * NEXP;
    constexpr int PER_L = I_IN + I_UQ + I_UKV + 2 * I_OA + I_OUT + I_13 + I_2;
    unsigned char* const ws = ws_ptr();
    for (int it = gw; it < NLAYER * PER_L; it += NGW) {
        const int l = it / PER_L; int r = it - l * PER_L;
        if (r < I_IN) { const int kb = r / 68, nb = r % 68, sc = win_src_col(nb * 64 + 4 * q16);
#if A2_F8
            if ((kb ^ nb) & 1) continue;
            { const float* const sp = sc >= 0 ? in_ptr<I_WIN>() + (size_t)l * DM * INC + sc : nullptr; bf16_t* const wt8 = (bf16_t*)(ws + WS_WIN + (size_t)l * INP * DM); const int k0 = (kb & ~1) * 64;
              conv_item<true>(sp, INC, 4 * q16, 1, nullptr, wt8, DM, k0, nb * 64, scr, lane); conv_item<true>(sp, INC, 4 * q16, 1, nullptr, wt8, DM, k0 + 64, nb * 64, scr, lane); }
#else
            conv_item(sc >= 0 ? in_ptr<I_WIN>() + (size_t)l * DM * INC + sc : nullptr, INC, 4 * q16, 1, nullptr, (bf16_t*)(ws + WS_WIN) + (size_t)l * INP * DM, DM, kb * 64, nb * 64, scr, lane);
#endif
            continue; } r -= I_IN;
        if (r < I_UQ) { const int kb = r / 16, nb = r % 16, np = nb * 64 + 4 * q16, hh = np >> 7, dd = np & 127;
            conv_item(dd < QKD ? in_ptr<I_WUQ>() + (size_t)l * QLORA * 768 + hh * QKD + dd : nullptr, 768, 4 * q16, 1, in_ptr<I_CQG>() + l * QLORA, (bf16_t*)(ws + WS_WUQ) + (size_t)l * 1024 * QLORA, QLORA, kb * 64, nb * 64, scr, lane); continue; } r -= I_UQ;
        if (r < I_UKV) { const int kb = r / 16, nb = r % 16;
            conv_item(in_ptr<I_WUKV>() + (size_t)l * KVLORA * 1024 + nb * 64 + 4 * q16, 1024, 4 * q16, 1, in_ptr<I_CKVG>() + l * KVLORA, (bf16_t*)(ws + WS_WUKV) + (size_t)l * 1024 * KVLORA, KVLORA, kb * 64, nb * 64, scr, lane); continue; } r -= I_UKV;
        if (r < 2 * I_OA) { const int w = r / I_OA, rr = r % I_OA, kb = rr / 16, nb = rr % 16;
            conv_item((w ? in_ptr<I_WOB>() : in_ptr<I_WOA>()) + (size_t)l * 512 * DM + nb * 64 + 4 * q16, DM, 4 * q16, 1, nullptr, (bf16_t*)(ws + (w ? WS_WOB : WS_WOA)) + (size_t)l * 1024 * 512, 512, kb * 64, nb * 64, scr, lane); continue; } r -= 2 * I_OA;
        if (r < I_OUT) { const int kb = r / 16, nb = r % 16;
#if C2_F8
            if ((kb ^ nb) & 1) continue;
            { const float* const sp = in_ptr<I_WOUT>() + (size_t)l * DM * DM + nb * 64 + 4 * q16; bf16_t* const wt8 = (bf16_t*)(ws + WS_WOUT + (size_t)l * DM * DM); const int k0 = (kb & ~1) * 64;
              conv_item<true>(sp, DM, 4 * q16, 1, nullptr, wt8, DM, k0, nb * 64, scr, lane); conv_item<true>(sp, DM, 4 * q16, 1, nullptr, wt8, DM, k0 + 64, nb * 64, scr, lane); }
#else
            conv_item(in_ptr<I_WOUT>() + (size_t)l * DM * DM + nb * 64 + 4 * q16, DM, 4 * q16, 1, nullptr, (bf16_t*)(ws + WS_WOUT) + (size_t)l * DM * DM, DM, kb * 64, nb * 64, scr, lane);
#endif
            continue; } r -= I_OUT;
        if (r < I_13) { const int e = r / 512, rr = r % 512, kb = rr / 32, nb = rr % 32;
            const float* base = ((q16 < 8) ? in_ptr<I_W1>() : in_ptr<I_W3>()) + ((size_t)l * NEXP + e) * DM * DM + nb * 32 + 4 * (q16 & 7);
            bf16_t* const wt = (bf16_t*)(ws + WS_W13) + ((size_t)l * NEXP) * 2048 * DM;
            if (F8LAYER(l)) { if ((kb ^ (e >> 2)) & 1) continue;
                const int k0 = (kb & ~1) * 64;
                conv_item<true>(base, DM, 8 * (q16 & 7) + (q16 >> 3), 2, nullptr, (bf16_t*)((unsigned char*)wt + (size_t)e * 2048 * DM), DM, k0, nb * 64, scr, lane);
                conv_item<true>(base, DM, 8 * (q16 & 7) + (q16 >> 3), 2, nullptr, (bf16_t*)((unsigned char*)wt + (size_t)e * 2048 * DM), DM, k0 + 64, nb * 64, scr, lane); }
            else conv_item(base, DM, 8 * (q16 & 7) + (q16 >> 3), 2, nullptr, wt + (size_t)e * 2048 * DM, DM, kb * 64, nb * 64, scr, lane);
            continue; } r -= I_13;
        { const int e = r / 256, rr = r % 256, kb = rr / 16, nb = rr % 16;
            const float* const src2 = in_ptr<I_W2>() + ((size_t)l * NEXP + e) * DM * DM + nb * 64 + 4 * q16; bf16_t* const wt = (bf16_t*)(ws + WS_W2) + ((size_t)l * NEXP) * DM * DM;
            if (F8LAYER(l)) { if ((kb ^ (e >> 3)) & 1) continue; const int k0 = (kb & ~1) * 64;
                conv_item<true>(src2, DM, 4 * q16, 1, nullptr, (bf16_t*)((unsigned char*)wt + (size_t)e * DM * DM), DM, k0, nb * 64, scr, lane);
                conv_item<true>(src2, DM, 4 * q16, 1, nullptr, (bf16_t*)((unsigned char*)wt + (size_t)e * DM * DM), DM, k0 + 64, nb * 64, scr, lane); }
            else conv_item(src2, DM, 4 * q16, 1, nullptr, wt + (size_t)e * DM * DM, DM, kb * 64, nb * 64, scr, lane); }
    }
}
__device__ __forceinline__ void p0_ada(Frame& F) {
    if ((int)blockIdx.x >= 2 * 96) return;
    unsigned char* const ws = ws_ptr(); const float* const cin = in_ptr<I_C>(); const float* const cctx = in_ptr<I_CCTX>(); const float* const wada = in_ptr<I_WADA>(); const float* const bada = in_ptr<I_BADA>();
    LAS float* sct = (LAS float*)F.lds;
    LAS float* red = (LAS float*)(F.lds + 1024 * 20 * 4);
    for (int idx = F.tid; idx < 17 * 1024; idx += 512) { const int r = idx >> 10, d = idx & 1023; const float v = (r < 16) ? cin[r * DM + d] : cctx[d]; sct[d * 20 + r] = v * (1.0f / (1.0f + expf(-v))); }
    __syncthreads();
    float* MOD = (float*)(ws + WS_MOD);
    for (int task = blockIdx.x; task < 2 * 96; task += F.G) {
        const int l = task / 96, cb = task % 96, col = cb * 64 + F.lane;
        const float* wa = wada + (size_t)l * DM * NMODC + col;
        float acc[17];
#pragma unroll
        for (int r = 0; r < 17; ++r) acc[r] = 0.f;
        for (int k = F.wave * 128; k < F.wave * 128 + 128; ++k) { const float wv = wa[(size_t)k * NMODC];
#pragma unroll
            for (int r = 0; r < 17; ++r) acc[r] += sct[k * 20 + r] * wv; }
#pragma unroll
        for (int r = 0; r < 17; ++r) red[(F.wave * 17 + r) * 64 + F.lane] = acc[r];
        __syncthreads();
        for (int idx = F.tid; idx < 17 * 64; idx += 512) { const int r = idx >> 6, cl = idx & 63; float s = bada[l * NMODC + cb * 64 + cl];
#pragma unroll
            for (int w = 0; w < 8; ++w) s += red[(w * 17 + r) * 64 + cl];
            MOD[((size_t)l * 17 + r) * NMODC + cb * 64 + cl] = s; }
        __syncthreads();
    }
    if (blockIdx.x == 0) { float* rope = (float*)(ws + WS_ROPE); const int pos = F.tid >> 3, i = F.tid & 7;
        const float inv = exp2f(-(float)i * 0.125f * 13.287712379549449f);
        const float ang = (float)pos * inv; const float rev = ang * 0.15915494309189535f, fr = rev - floorf(rev); rope[pos * 8 + i] = __builtin_amdgcn_cosf(fr); rope[512 + pos * 8 + i] = __builtin_amdgcn_sinf(fr); }
}

__device__ __forceinline__ void load_row(const float* xrow, int lane, f32x4 (&v)[4]) {
#pragma unroll
    for (int j = 0; j < 4; ++j) v[j] = *((const f32x4*)xrow + lane + 64 * j);
}
__device__ __forceinline__ float row_rstd(const f32x4 (&v)[4]) {
    float s = 0.f;
#pragma unroll
    for (int j = 0; j < 4; ++j) s += (v[j][0] * v[j][0] + v[j][1] * v[j][1]) + (v[j][2] * v[j][2] + v[j][3] * v[j][3]);
    return rsqrtf(wave_sum(s) * (1.0f / DM) + RMS_EPS);
}
__device__ __forceinline__ void normmod(const f32x4 (&v)[4], float rstd, const float* g, const float* sh, const float* sc, int lane, f32x4 (&h)[4]) {
#pragma unroll
    for (int j = 0; j < 4; ++j) { const f32x4 gv = *((const f32x4*)g + lane + 64 * j), shv = *((const f32x4*)sh + lane + 64 * j), scv = *((const f32x4*)sc + lane + 64 * j);
        h[j] = v[j] * rstd * gv * (scv + 1.0f) + shv; }
}
__device__ __forceinline__ void store_row_h(unsigned char* Hb, int t, int lane, const f32x4 (&h)[4]) {
#if A2_F8
#pragma unroll
    for (int j = 0; j < 4; ++j) *((unsigned*)(Hb + (size_t)t * DM) + lane + 64 * j) = cvt_pk4_fp8(h[j][0] * F8_SH, h[j][1] * F8_SH, h[j][2] * F8_SH, h[j][3] * F8_SH);
#else
#pragma unroll
    for (int j = 0; j < 4; ++j) { u32x2 w; w.x = cvt_pk_bf16(h[j][0], h[j][1]); w.y = cvt_pk_bf16(h[j][2], h[j][3]); *((u32x2*)((bf16_t*)Hb + (size_t)t * DM) + lane + 64 * j) = w; }
#endif
}
__device__ __forceinline__ void store_row_bf16(bf16_t* orow, int lane, const f32x4 (&h)[4]) {
#pragma unroll
    for (int j = 0; j < 4; ++j) { u32x2 w; w.x = cvt_pk_bf16(h[j][0], h[j][1]); w.y = cvt_pk_bf16(h[j][2], h[j][3]); *((u32x2*)orow + lane + 64 * j) = w; }
}
__device__ __forceinline__ void p0_hrows(Frame& F) {
    unsigned char* const ws = ws_ptr(); const float* const xin = in_ptr<I_X>(); const float* const cxin = in_ptr<I_CTX>(); const float* const gmix = in_ptr<I_NMIXG>();
    const int gw = F.vcu * 8 + F.wave, NGW = F.G * 8; const float* MOD = (const float*)(ws + WS_MOD); bf16_t* H = (bf16_t*)(ws + WS_H);
    for (int t = gw; t < TALL; t += NGW) {
        const float* xr = (t < TX) ? xin + (size_t)t * DM : cxin + (size_t)(t - TX) * DM;
        const float* md = MOD + (size_t)((t < TX) ? (t >> 11) : 16) * NMODC;
        f32x4 v[4], h[4]; load_row(xr, F.lane, v); const float rstd = row_rstd(v);
        normmod(v, rstd, gmix, md, md + DM, F.lane, h); store_row_h((unsigned char*)H, t, F.lane, h);
    }
}
__device__ __forceinline__ void stats_phase(Frame& F, int ntok) {
    unsigned char* const ws = ws_ptr();
    const int gw = F.vcu * 8 + F.wave, NGW = F.G * 8, lane = F.lane;
    const bf16_t* ZCQ = (const bf16_t*)(ws + WS_ZCQ); const bf16_t* ZCKV = (const bf16_t*)(ws + WS_ZCKV); const bf16_t* ZKR = (const bf16_t*)(ws + WS_ZKR);
    float* RSCQ = (float*)(ws + WS_RSCQ); float* RSCKV = (float*)(ws + WS_RSCKV); float* SSKR = (float*)(ws + WS_SSKR);
    for (int t = gw; t < ntok; t += NGW) {
        float a = 0.f, b = 0.f, c = 0.f;
        if (lane < 48) { const u32x4 w = *(const u32x4*)(ZCQ + (size_t)t * QLORA + 8 * lane); a = (bf_lo(w.x) * bf_lo(w.x) + bf_hi(w.x) * bf_hi(w.x)) + (bf_lo(w.y) * bf_lo(w.y) + bf_hi(w.y) * bf_hi(w.y)) + (bf_lo(w.z) * bf_lo(w.z) + bf_hi(w.z) * bf_hi(w.z)) + (bf_lo(w.w) * bf_lo(w.w) + bf_hi(w.w) * bf_hi(w.w)); }
        if (lane < 32) { const u32x4 w = *(const u32x4*)(ZCKV + (size_t)t * KVLORA + 8 * lane); b = (bf_lo(w.x) * bf_lo(w.x) + bf_hi(w.x) * bf_hi(w.x)) + (bf_lo(w.y) * bf_lo(w.y) + bf_hi(w.y) * bf_hi(w.y)) + (bf_lo(w.z) * bf_lo(w.z) + bf_hi(w.z) * bf_hi(w.z)) + (bf_lo(w.w) * bf_lo(w.w) + bf_hi(w.w) * bf_hi(w.w)); }
        if (lane < 4) { const u32x4 w = *(const u32x4*)(ZKR + (size_t)t * ROPED + 8 * lane); c = (bf_lo(w.x) * bf_lo(w.x) + bf_hi(w.x) * bf_hi(w.x)) + (bf_lo(w.y) * bf_lo(w.y) + bf_hi(w.y) * bf_hi(w.y)) + (bf_lo(w.z) * bf_lo(w.z) + bf_hi(w.z) * bf_hi(w.z)) + (bf_lo(w.w) * bf_lo(w.w) + bf_hi(w.w) * bf_hi(w.w)); }
        a = wave_sum(a); b = wave_sum(b); c = wave_sum(c);
        if (lane == 0) { RSCQ[t] = rsqrtf(a * (1.0f / QLORA) + RMS_EPS); RSCKV[t] = rsqrtf(b * (1.0f / KVLORA) + RMS_EPS); SSKR[t] = c; }
    }
}

__device__ __forceinline__ void route_phase(Frame& F, int l, int ntok) {
    unsigned char* const ws = ws_ptr(); const float* const xcur = out_ptr();
    constexpr int HP = DM + 4;
    LAS float* h2t = (LAS float*)F.lds;
    LAS float* part = (LAS float*)(F.lds + 66560);
    LAS float* logit = (LAS float*)(F.lds + 66560 + 32768);
    const float* MOD = (const float*)(ws + WS_MOD) + (size_t)l * 17 * NMODC; const float* XC = (const float*)(ws + WS_XC);
    const float* g = in_ptr<I_NFFNG>() + l * DM; const float* wr = in_ptr<I_WR>(); const float rbias = in_ptr<I_RB>()[F.lane];
    int* TOKE = (int*)(ws + WS_TOKE); float* TOKW = (float*)(ws + WS_TOKW); int* TOKP = (int*)(ws + WS_TOKP); float* RSTD2 = (float*)(ws + WS_RSTD2);
    unsigned* cnt = (unsigned*)(ws + WS_CTL) + CW_CNT + l * 2048;
    const int lane = F.lane, w = F.wave;
    float wv[32][4];
#pragma unroll
    for (int s_ = 0; s_ < 32; ++s_)
#pragma unroll
        for (int j = 0; j < 4; ++j) wv[s_][j] = wr[(w * 128 + 4 * s_ + (lane >> 4)) * NEXP + 16 * j + (lane & 15)];
    for (int it = blockIdx.x; it < ntok / 16; it += F.G) {
        const int T0 = it * 16;
#pragma unroll
        for (int tt = 0; tt < 2; ++tt) { const int tl = 2 * w + tt, t = T0 + tl;
            const float* xr = (t < TX) ? xcur + (size_t)t * DM : XC + (size_t)(t - TX) * DM; const float* md = MOD + (size_t)((t < TX) ? (t >> 11) : 16) * NMODC;
            f32x4 v[4], h[4]; load_row(xr, lane, v); const float rstd = row_rstd(v); if (lane == 0) RSTD2[(t >> 4) * 32 + (t & 15)] = rstd;
            normmod(v, rstd, g, md + 3 * DM, md + 4 * DM, lane, h);
#pragma unroll
            for (int j = 0; j < 4; ++j) *(LAS f32x4*)(h2t + tl * HP + 4 * lane + 256 * j) = h[j];
        }
        __syncthreads();
        { f32x4 acc[4];
#pragma unroll
          for (int j = 0; j < 4; ++j) acc[j] = (f32x4){0.f, 0.f, 0.f, 0.f};
          const LAS float* ha = h2t + (lane & 15) * HP + w * 128 + (lane >> 4);
#pragma unroll
          for (int s_ = 0; s_ < 32; ++s_) { const float a = ha[4 * s_];
#pragma unroll
              for (int j = 0; j < 4; ++j) acc[j] = __builtin_amdgcn_mfma_f32_16x16x4f32(a, wv[s_][j], acc[j], 0, 0, 0); }
#pragma unroll
          for (int j = 0; j < 4; ++j)
#pragma unroll
              for (int q = 0; q < 4; ++q) part[(w * 16 + 4 * (lane >> 4) + q) * 64 + 16 * j + (lane & 15)] = acc[j][q]; }
        __syncthreads();
#pragma unroll
        for (int k = 0; k < 2; ++k) { const int idx = F.tid + 512 * k, t = idx >> 6, e = idx & 63; float s = 0.f;
#pragma unroll
            for (int ww = 0; ww < 8; ++ww) s += part[(ww * 16 + t) * 64 + e];
            logit[t * 64 + e] = s; }
        __syncthreads();
#pragma unroll
        for (int tt = 0; tt < 2; ++tt) { const int tl = 2 * w + tt, t = T0 + tl;
            const float sg = 1.0f / (1.0f + expf(-logit[tl * 64 + lane])); const float bs = sg + rbias;
            float m1 = -3.0e38f, m2 = -3.0e38f; int i1 = 0, i2 = 0;
#pragma unroll
            for (int j = 0; j < 8; ++j) { const float vv = __shfl(bs, (lane & ~7) + j); if (vv > m1) { m2 = m1; i2 = i1; m1 = vv; i1 = j; } else if (vv > m2) { m2 = vv; i2 = j; } }
            const float gs = m1 + m2; float best = -3.0e38f; int gsel = 0;
#pragma unroll
            for (int j = 0; j < 8; ++j) { const float vv = __shfl(gs, 8 * j); if (vv > best) { best = vv; gsel = j; } }
            const int e1 = gsel * 8 + __shfl(i1, gsel * 8), e2 = gsel * 8 + __shfl(i2, gsel * 8);
            const float s1 = __shfl(sg, e1), s2 = __shfl(sg, e2), inv = 1.0f / (s1 + s2);
            if (lane == 0) { const int p1 = (int)atomicAdd(cnt + e1 * 16, 1u), p2 = (int)atomicAdd(cnt + e2 * 16, 1u);
                TOKE[2 * t] = e1; TOKE[2 * t + 1] = e2; TOKW[2 * t] = s1 * inv; TOKW[2 * t + 1] = s2 * inv; TOKP[2 * t] = p1; TOKP[2 * t + 1] = p2; }
        }
        __syncthreads();
    }
}
__device__ __forceinline__ void expert_offsets(Frame& F, unsigned char* ws, int l, LAS int* offl, bool publish) {
    if (F.wave == 0) {
        const unsigned c = __hip_atomic_load((unsigned*)(ws + WS_CTL) + CW_CNT + l * 2048 + F.lane * 16, RLX_AGENT);
        const int pad = (int)((c + 255u) & ~255u); int incl = pad;
#pragma unroll
        for (int o = 1; o < 64; o <<= 1) { const int v = __shfl_up(incl, o); if (F.lane >= o) incl += v; }
        offl[F.lane] = incl - pad; if (F.lane == 63) offl[64] = incl;
        if (publish) { int* TILEE = (int*)(ws + WS_TILEE); for (int t = (incl - pad) >> 8; t < (incl >> 8); ++t) TILEE[t] = F.lane; if (F.lane == 63) TILEE[511] = incl >> 8; }
    }
    __syncthreads();
}
__device__ __forceinline__ void scatter_phase(Frame& F, int l, int ntok, bool f8) {
    unsigned char* const ws = ws_ptr(); const float* const xcur = out_ptr();
    LAS int* offl = (LAS int*)(F.lds + 1024);
    expert_offsets(F, ws, l, offl, blockIdx.x == 0);
    const int gw = F.vcu * 8 + F.wave, NGW = F.G * 8, lane = F.lane;
    const float* MOD = (const float*)(ws + WS_MOD) + (size_t)l * 17 * NMODC; const float* XC = (const float*)(ws + WS_XC); const float* g = in_ptr<I_NFFNG>() + l * DM;
    const int* TOKE = (const int*)(ws + WS_TOKE); const int* TOKP = (const int*)(ws + WS_TOKP); const float* RSTD2 = (const float*)(ws + WS_RSTD2); bf16_t* HS = (bf16_t*)(ws + WS_HS);
    for (int t = gw; t < ntok; t += NGW) {
        const float* xr = (t < TX) ? xcur + (size_t)t * DM : XC + (size_t)(t - TX) * DM; const float* md = MOD + (size_t)((t < TX) ? (t >> 11) : 16) * NMODC;
        f32x4 v[4], h[4]; load_row(xr, lane, v); normmod(v, RSTD2[(t >> 4) * 32 + (t & 15)], g, md + 3 * DM, md + 4 * DM, lane, h);
        const int s1 = offl[TOKE[2 * t]] + TOKP[2 * t], s2 = offl[TOKE[2 * t + 1]] + TOKP[2 * t + 1];
        if (f8) {
#pragma unroll
            for (int j = 0; j < 4; ++j) { const unsigned w = cvt_pk4_fp8(h[j][0] * F8_SH, h[j][1] * F8_SH, h[j][2] * F8_SH, h[j][3] * F8_SH);
                *((unsigned*)((unsigned char*)HS + (size_t)s1 * DM) + lane + 64 * j) = w; *((unsigned*)((unsigned char*)HS + (size_t)s2 * DM) + lane + 64 * j) = w; }
        } else { store_row_bf16(HS + (size_t)s1 * DM, lane, h); store_row_bf16(HS + (size_t)s2 * DM, lane, h); }
    }
}
__device__ __forceinline__ void combine_phase(Frame& F, int l, int ntok, bool last) {
    unsigned char* const ws = ws_ptr(); float* const xcur = out_ptr();
    LAS int* offl = (LAS int*)(F.lds + 1024);
    expert_offsets(F, ws, l, offl, false);
    const int gw = F.vcu * 8 + F.wave, NGW = F.G * 8, lane = F.lane;
    const float* MOD = (const float*)(ws + WS_MOD) + (size_t)l * 17 * NMODC; float* XC = (float*)(ws + WS_XC);
    const int* TOKE = (const int*)(ws + WS_TOKE); const int* TOKP = (const int*)(ws + WS_TOKP); const float* TOKW = (const float*)(ws + WS_TOKW);
    const bf16_t* YS = (const bf16_t*)(ws + WS_YS); bf16_t* H = (bf16_t*)(ws + WS_H);
    for (int t = gw; t < ntok; t += NGW) {
        float* xr = (t < TX) ? xcur + (size_t)t * DM : XC + (size_t)(t - TX) * DM; const int bi = (t < TX) ? (t >> 11) : 16; const float* md = MOD + (size_t)bi * NMODC;
        const int s1 = offl[TOKE[2 * t]] + TOKP[2 * t], s2 = offl[TOKE[2 * t + 1]] + TOKP[2 * t + 1]; const float w1 = TOKW[2 * t], w2 = TOKW[2 * t + 1];
        f32x4 v[4]; load_row(xr, lane, v);
#pragma unroll
        for (int j = 0; j < 4; ++j) { const u32x2 a = *((const u32x2*)(YS + (size_t)s1 * DM) + lane + 64 * j), b = *((const u32x2*)(YS + (size_t)s2 * DM) + lane + 64 * j);
            const f32x4 gf = *((const f32x4*)(md + 5 * DM) + lane + 64 * j);
            const f32x4 y = (f32x4){bf_lo(a.x), bf_hi(a.x), bf_lo(a.y), bf_hi(a.y)} * w1 + (f32x4){bf_lo(b.x), bf_hi(b.x), bf_lo(b.y), bf_hi(b.y)} * w2;
            v[j] = v[j] + gf * y; *((f32x4*)xr + lane + 64 * j) = v[j]; }
        if (!last) { const float* md2 = MOD + (size_t)17 * NMODC + (size_t)bi * NMODC; f32x4 h[4]; const float rstd = row_rstd(v);
            normmod(v, rstd, in_ptr<I_NMIXG>() + (l + 1) * DM, md2, md2 + DM, lane, h); store_row_h((unsigned char*)H, t, lane, h); }
    }
}
constexpr int NPHASE = 2 + 11 * NLAYER;
struct Args { const float* in[26]; float* out; unsigned char* ws; int ph_lo, ph_hi; };

__device__ __attribute__((noinline)) void grid_barrier_fn(GAS unsigned* barw, unsigned x, LAS unsigned* st) { XcdBarrier b; b.bar = (unsigned*)barw; b.x = x; b.st = (volatile LAS unsigned*)st; xcd_barrier(b); }

__global__ void __launch_bounds__(512, 2) fwd_kernel(Args args) {
    extern __shared__ __attribute__((aligned(16))) unsigned char lds_raw[];
    Frame F;
    F.lds = (LAS unsigned char*)lds_raw;
    F.tid = threadIdx.x; F.lane = F.tid & 63; F.wave = __builtin_amdgcn_readfirstlane(F.tid >> 6);
    F.G = gridDim.x; { const int bx = blockIdx.x; F.vcu = (F.G % 8 == 0) ? (bx % 8) * (F.G / 8) + bx / 8 : bx; }
    volatile LAS unsigned* MISC = (volatile LAS unsigned*)(F.lds + MISC_OFF);
    if (F.tid < 64) MISC[F.tid] = 0u;
    __syncthreads();
    const int lo = args.ph_lo, hi = args.ph_hi;
#if MK_SPLIT
#define GRID_BAR() do { } while (0)
#else
    XcdBarrier bar = xcd_barrier_post((unsigned*)(ws_ptr() + WS_CTL) + CW_BAR, MISC + 8);
#define GRID_BAR() grid_barrier_fn((GAS unsigned*)bar.bar, bar.x, (LAS unsigned*)bar.st)
#endif
#ifndef PH_MASK
#define PH_MASK 0xFFFFFFFFu
#endif
#define PHK(k) ((k) < 2 ? (k) : 2 + ((k) - 2) % 11)
#define IN(k) (((PH_MASK >> PHK(k)) & 1u) && lo <= (k) && (k) < hi)
#ifndef PH_DUP
#define PH_DUP 0u
#endif
#define REP0(k) for (int rep_ = 0; rep_ < (((PH_DUP >> (k)) & 1u) ? 2 : 1); ++rep_)
#define REPL(n) for (int rep_ = 0; rep_ < ((((PH_DUP >> (2 + (n))) & 1u) && ((n) != 5 || l == 0)) ? 2 : 1); ++rep_)
#ifdef BAR_DUP
#define SEAM(k) do { if (IN(k) && IN((k) + 1)) { for (int b_ = 0; b_ < 1 + BAR_DUP; ++b_) GRID_BAR(); } } while (0)
#else
#define SEAM(k) do { if (IN(k) && IN((k) + 1)) GRID_BAR(); } while (0)
#endif
#define FRESH() Frame Fp = F; int G = F.G, c = (int)blockIdx.x; asm volatile("" : "+v"(Fp.tid), "+v"(Fp.lane)); asm volatile("" : "+s"(Fp.wave), "+s"(Fp.vcu), "+s"(Fp.G), "+s"(G), "+s"(c))

    if (IN(0)) REP0(0) { FRESH(); (void)G; (void)c; p0_convert(Fp); __syncthreads(); p0_ada(Fp); }
    SEAM(0);
    if (IN(1)) REP0(1) { FRESH(); (void)G; (void)c; p0_hrows(Fp); }
    SEAM(1);

    for (int l = 0; l < NLAYER; ++l) {
        const int base = 2 + 11 * l; const bool last = (l == NLAYER - 1);
        const int mt_act = last ? MT_X : MT_ALL;
        const int ntok = last ? TX : TALL;
        if (IN(base + 0)) REPL(0) {
            FRESH(); unsigned char* const ws = ws_ptr();
#if A2_F8
            pg8::SchedRect S{(const char*)(ws + WS_H), (const char*)(ws + WS_WIN + (size_t)l * INP * DM), (size_t)256 * DM, mt_act, 17, G, c, MT_ALL - mt_act, 2, 7};
            pg8::EpiIn E{(bf16_t*)(ws + WS_QA), (bf16_t*)(ws + WS_KA), (bf16_t*)(ws + WS_VA), (bf16_t*)(ws + WS_ZCQ), (bf16_t*)(ws + WS_ZCKV), (bf16_t*)(ws + WS_ZKR), (bf16_t*)(ws + WS_GATES),
                         in_ptr<I_NAQG>() + l * 64, in_ptr<I_NAKG>() + l * 64, (float*)(ws + WS_PART6), (float*)(ws + WS_PART7), (float*)(ws + WS_PART8), 1.0f / (F8_SH * F8_SW)};
            pg8::gemm_phase<true>(Fp.lds, DM / 2, S, E);
#else
            pg8::SchedRect S{(const char*)(ws + WS_H), (const char*)((bf16_t*)(ws + WS_WIN) + (size_t)l * INP * DM), (size_t)256 * DM * 2, mt_act, 17, G, c, MT_ALL - mt_act, 2, 7};
            pg8::EpiIn E{(bf16_t*)(ws + WS_QA), (bf16_t*)(ws + WS_KA), (bf16_t*)(ws + WS_VA), (bf16_t*)(ws + WS_ZCQ), (bf16_t*)(ws + WS_ZCKV), (bf16_t*)(ws + WS_ZKR), (bf16_t*)(ws + WS_GATES),
                         in_ptr<I_NAQG>() + l * 64, in_ptr<I_NAKG>() + l * 64, (float*)(ws + WS_PART6), (float*)(ws + WS_PART7), (float*)(ws + WS_PART8), 1.0f};
            pg8::gemm_phase(Fp.lds, DM, S, E);
#endif
        }
        SEAM(base + 0);
        if (IN(base + 2)) REPL(2) {
            FRESH();
            LAS float* const ropeL = (LAS float*)(Fp.lds + EPI_OFF + 8192);
            { const float* const rg = (const float*)(ws_ptr() + WS_ROPE); ropeL[Fp.tid] = rg[Fp.tid]; ropeL[512 + Fp.tid] = rg[512 + Fp.tid]; __syncthreads(); }
#ifndef NO_EQ
            { unsigned char* const ws = ws_ptr();
              pg8::SchedRect S{(const char*)(ws + WS_ZCQ), (const char*)((bf16_t*)(ws + WS_WUQ) + (size_t)l * 1024 * QLORA), (size_t)256 * QLORA * 2, mt_act, 4, G, c, 0, 0, 1};
              pg8::EpiQ E{(bf16_t*)(ws + WS_QB), (const float*)(ws + WS_PART6), (const float*)(ws + WS_PART7), in_ptr<I_QG>() + l * QKD, ropeL, (LAS float*)(Fp.lds + EPI_OFF)};
              pg8::gemm_phase(Fp.lds, QLORA, S, E); }
#endif
#ifndef NO_EKV
            { unsigned char* const ws = ws_ptr();
              pg8::SchedRect S{(const char*)(ws + WS_ZCKV), (const char*)((bf16_t*)(ws + WS_WUKV) + (size_t)l * 1024 * KVLORA), (size_t)256 * KVLORA * 2, MT_ALL, 4, G, c, 0, 0, 1};
              pg8::EpiKV E{(bf16_t*)(ws + WS_KB), (bf16_t*)(ws + WS_VB), (const bf16_t*)(ws + WS_ZKR), (const float*)(ws + WS_PART7), (const float*)(ws + WS_PART8), in_ptr<I_KG>() + l * QKD, ropeL, (LAS float*)(Fp.lds + EPI_OFF)};
              pg8::gemm_phase(Fp.lds, KVLORA, S, E); }
#endif
        }
        SEAM(base + 2);
        if (IN(base + 3)) REPL(3) {
            FRESH(); (void)c;
            const float C64 = 0.125f * 1.4426950408889634f, C96 = 0.10206207261596575f * 1.4426950408889634f;
            for (int r2_ = 0; r2_ < (((PH_DUP >> 20) & 1u) ? 2 : 1); ++r2_)
            { unsigned char* const ws = ws_ptr();
              for (int u = Fp.vcu; u < 1024 + 256; u += G) {
                att::UnitArgs A; A.Q = (const bf16_t*)(ws + WS_QB); A.ldq = 768; A.K = (const bf16_t*)(ws + WS_KB); A.ldk = 768; A.V = (const bf16_t*)(ws + WS_VB); A.O = (bf16_t*)(ws + WS_OB);
                A.masked = 0; A.band = 0; A.krow0 = 0; A.bias = nullptr; A.C = C96;
                if (u < 1024) { const int bh = u >> 3, qb = u & 7, b = bh >> 3, h = bh & 7;
                    A.qcol = h * QKD; A.kcol = h * QKD; A.vcol = h * 64; A.ocol = h * 64; A.q0 = b * SEQ + qb * 256; A.ctx0 = TX + b * CTXL; A.loc0 = b * SEQ; A.NT = 36; }
                else { const int v = u - 1024; if (last || !(v & 1)) continue; const int bh = v >> 1, b = bh >> 3, h = bh & 7;
                    A.qcol = h * QKD; A.kcol = h * QKD; A.vcol = h * 64; A.ocol = h * 64; A.q0 = TX + b * CTXL; A.ctx0 = TX + b * CTXL; A.loc0 = 0; A.NT = 4; }
                att::attn_unit<96>(A, (char*)lds_raw);
              } }
            for (int r3_ = 0; r3_ < (((PH_DUP >> 21) & 1u) ? 2 : 1); ++r3_)
            { unsigned char* const ws = ws_ptr(); const float* const rpb = in_ptr<I_RPB>();
              att::na_mask_table((char*)lds_raw);
              for (int u = Fp.vcu; u < 1024 + 256; u += G) {
                att::UnitArgs A; A.Q = (const bf16_t*)(ws + WS_QA); A.ldq = 512; A.K = (const bf16_t*)(ws + WS_KA); A.ldk = 512; A.V = (const bf16_t*)(ws + WS_VA); A.O = (bf16_t*)(ws + WS_OA); A.C = C64;
                if (u < 1024) { const int bh = u >> 3, band = u & 7, b = bh >> 3, h = bh & 7;
                    A.qcol = h * 64; A.kcol = h * 64; A.vcol = h * 64; A.ocol = h * 64; A.q0 = b * SEQ + band * 256; A.ctx0 = TX + b * CTXL;
                    A.krow0 = min(max(4 * band - 4, 0), 20); A.loc0 = b * SEQ + 64 * A.krow0; A.NT = 10; A.masked = 1; A.band = band; A.bias = rpb + ((size_t)l * NHEAD + h) * 15 * 31; }
                else { const int v = u - 1024; if (last || (v & 1)) continue; const int bh = v >> 1, b = bh >> 3, h = bh & 7;
                    A.qcol = h * 64; A.kcol = h * 64; A.vcol = h * 64; A.ocol = h * 64; A.q0 = TX + b * CTXL; A.ctx0 = TX + b * CTXL; A.loc0 = 0; A.NT = 4; A.masked = 0; A.band = 0; A.krow0 = 0; A.bias = nullptr; }
                att::attn_unit<64>(A, (char*)lds_raw);
              } }
        }
        SEAM(base + 3);
        if (IN(base + 4)) REPL(4) {
            FRESH(); unsigned char* const ws = ws_ptr();
            pg8::SchedMerge S{(const char*)(ws + WS_OA), (const char*)(ws + WS_OB), (const char*)((bf16_t*)(ws + WS_WOA) + (size_t)l * 1024 * 512), (const char*)((bf16_t*)(ws + WS_WOB) + (size_t)l * 1024 * 512),
                              (size_t)256 * 512 * 2, mt_act, 4, G, c};
            pg8::EpiMerge E{(const bf16_t*)(ws + WS_GATES), (bf16_t*)(ws + WS_Y)};
            pg8::gemm_phase(Fp.lds, 512, S, E);
        }
        SEAM(base + 4);
        if (IN(base + 5)) REPL(5) {
            FRESH(); unsigned char* const ws = ws_ptr(); float* const outp = out_ptr();
#if C2_F8
            pg8::SchedRect S{(const char*)(ws + WS_Y), (const char*)(ws + WS_WOUT + (size_t)l * DM * DM), (size_t)256 * DM, mt_act, 4, G, c, 0, 0, 1};
            pg8::EpiOut E{(l == 0) ? in_ptr<I_X>() : (const float*)outp, outp, in_ptr<I_CTX>(), (float*)(ws + WS_XC), (const float*)(ws + WS_MOD) + (size_t)l * 17 * NMODC, 2 * DM, 1.0f / (F8_SY * F8_SW)};
            pg8::gemm_phase<true>(Fp.lds, DM / 2, S, E);
#else
            pg8::SchedRect S{(const char*)(ws + WS_Y), (const char*)((bf16_t*)(ws + WS_WOUT) + (size_t)l * DM * DM), (size_t)256 * DM * 2, mt_act, 4, G, c, 0, 0, 1};
            pg8::EpiOut E{(l == 0) ? in_ptr<I_X>() : (const float*)outp, outp, in_ptr<I_CTX>(), (float*)(ws + WS_XC), (const float*)(ws + WS_MOD) + (size_t)l * 17 * NMODC, 2 * DM, 1.0f};
            pg8::gemm_phase(Fp.lds, DM, S, E);
#endif
        }
        SEAM(base + 5);
        if (IN(base + 6)) REPL(6) { FRESH(); (void)G; (void)c; route_phase(Fp, l, ntok); }
        SEAM(base + 6);
        if (IN(base + 7)) REPL(7) { FRESH(); (void)G; (void)c; scatter_phase(Fp, l, ntok, F8LAYER(l)); }
        SEAM(base + 7);
        if (IN(base + 8)) REPL(8) {
            FRESH(); unsigned char* const ws = ws_ptr();
            LAS int* const tle = (LAS int*)(Fp.lds + EPI_OFF + 16384); tle[Fp.tid] = ld_i32_agent((const int*)(ws + WS_TILEE) + Fp.tid); __syncthreads();
            const int ntile = __builtin_amdgcn_readfirstlane(tle[511]);
            const char* const w13 = (const char*)((bf16_t*)(ws + WS_W13) + (size_t)l * NEXP * 2048 * DM);
#ifdef ONLY_BF16
            if (false) {} else
#endif
#ifdef ONLY_F8
            if (true)
#else
            if (F8LAYER(l))
#endif
            { pg8::SchedMoe S{(const char*)(ws + WS_HS), w13, (size_t)256 * DM, (size_t)2048 * DM, (size_t)256 * DM, tle, ntile, 8, G, c};
                pg8::EpiMoe1<true> E{(bf16_t*)(ws + WS_HMID), 1.0f / (F8_SH * F8_SW)};
                pg8::gemm_phase<true>(Fp.lds, DM / 2, S, E); }
            else { pg8::SchedMoe S{(const char*)(ws + WS_HS), w13, (size_t)256 * DM * 2, (size_t)2048 * DM * 2, (size_t)256 * DM * 2, tle, ntile, 8, G, c};
                pg8::EpiMoe1<false> E{(bf16_t*)(ws + WS_HMID), 1.0f};
                pg8::gemm_phase(Fp.lds, DM, S, E); }
        }
        SEAM(base + 8);
        if (IN(base + 9)) REPL(9) {
            FRESH(); unsigned char* const ws = ws_ptr();
            LAS int* const tle = (LAS int*)(Fp.lds + EPI_OFF + 16384); tle[Fp.tid] = ld_i32_agent((const int*)(ws + WS_TILEE) + Fp.tid); __syncthreads();
            const int ntile = __builtin_amdgcn_readfirstlane(tle[511]);
            const char* const w2 = (const char*)((bf16_t*)(ws + WS_W2) + (size_t)l * NEXP * DM * DM);
            if (F8LAYER(l)) { pg8::SchedMoe S{(const char*)(ws + WS_HMID), w2, (size_t)256 * DM, (size_t)DM * DM, (size_t)256 * DM, tle, ntile, 4, G, c};
                pg8::EpiMoe2 E{(bf16_t*)(ws + WS_YS), 1.0f / (F8_SM * F8_SW)};
                pg8::gemm_phase<true>(Fp.lds, DM / 2, S, E); }
            else { pg8::SchedMoe S{(const char*)(ws + WS_HMID), w2, (size_t)256 * DM * 2, (size_t)DM * DM * 2, (size_t)256 * DM * 2, tle, ntile, 4, G, c};
                pg8::EpiMoe2 E{(bf16_t*)(ws + WS_YS), 1.0f};
                pg8::gemm_phase(Fp.lds, DM, S, E); }
        }
        SEAM(base + 9);
        if (IN(base + 10)) REPL(10) { FRESH(); (void)G; (void)c; combine_phase(Fp, l, ntok, last); }
        if (!last) SEAM(base + 10);
    }
#undef IN
#undef SEAM
#undef GRID_BAR
}

extern "C" void kernel_launch(void* const* d_in, const int* in_sizes, int n_in, void* d_out, int out_size, void* d_ws, size_t ws_size, hipStream_t stream) {
    static int grid = 0;
    if (grid == 0) {
        if (n_in != 26 || out_size != TX * DM || ws_size < WS_END) { fprintf(stderr, "kernel_launch: unexpected problem (n_in %d, out %d, ws %zu < %zu); nothing launched\n", n_in, out_size, ws_size, (size_t)WS_END); grid = -1; return; }
        int dev = 0, cus = 0, per_cu = 0;
        if (hipGetDevice(&dev) != hipSuccess || hipDeviceGetAttribute(&cus, hipDeviceAttributeMultiprocessorCount, dev) != hipSuccess) { grid = -1; return; }
        if (hipFuncSetAttribute((const void*)fwd_kernel, hipFuncAttributeMaxDynamicSharedMemorySize, LDS_BYTES) != hipSuccess) { fprintf(stderr, "kernel_launch: hipFuncSetAttribute failed\n"); grid = -1; return; }
        if (hipOccupancyMaxActiveBlocksPerMultiprocessor(&per_cu, (const void*)fwd_kernel, 512, LDS_BYTES) != hipSuccess || per_cu < 1) fprintf(stderr, "kernel_launch: occupancy query reports %d blocks per CU\n", per_cu);
        (void)hipGetLastError();
        grid = cus;
    }
    if (grid < 0) return;
    (void)in_sizes;
    (void)hipMemsetAsync((char*)d_ws + WS_CTL, 0, CTL_BYTES, stream);
    Args a{};
    for (int i = 0; i < 26; ++i) a.in[i] = (const float*)d_in[i];
    a.out = (float*)d_out; a.ws = (unsigned char*)d_ws;
#if MK_SPLIT
    for (int p = 0; p < NPHASE; ++p) { a.ph_lo = p; a.ph_hi = p + 1; hipLaunchKernelGGL(fwd_kernel, dim3(grid), dim3(512), LDS_BYTES, stream, a); }
#else
    a.ph_lo = 0; a.ph_hi = NPHASE;
    hipLaunchKernelGGL(fwd_kernel, dim3(grid), dim3(512), LDS_BYTES, stream, a);
#endif
    const hipError_t le = hipPeekAtLastError();
    if (le != hipSuccess) fprintf(stderr, "kernel_launch: launch failed: %s\n", hipGetErrorName(le));
}
```

```cpp
#include <hip/hip_runtime.h>
#include <hip/hip_bf16.h>
#include <cstdio>
#include <cstdint>

#ifndef MK_SPLIT
#define MK_SPLIT 0
#endif

#define LAS __attribute__((address_space(3)))
#define GAS __attribute__((address_space(1)))
typedef unsigned short bf16_t;
typedef short bf16x8 __attribute__((ext_vector_type(8)));
typedef short s16x4 __attribute__((ext_vector_type(4)));
typedef float f32x4 __attribute__((ext_vector_type(4)));
typedef float f32x2 __attribute__((ext_vector_type(2)));
typedef float f32x16 __attribute__((ext_vector_type(16)));
typedef unsigned u32x4 __attribute__((ext_vector_type(4)));
typedef unsigned u32x2 __attribute__((ext_vector_type(2)));
#define RLX_AGENT __ATOMIC_RELAXED, __HIP_MEMORY_SCOPE_AGENT

constexpr int DM = 1024, NB = 16, SEQ = 2048, TX = NB * SEQ, CTXL = 256, TC = NB * CTXL, TALL = TX + TC;
constexpr int NHEAD = 8, GRIDW = 64;
constexpr int INC = 4256, INP = 4352;
constexpr int NEXP = 64, NMODC = 6 * DM;
constexpr int QLORA = 384, KVLORA = 256, QKD = 96, ROPED = 32;
constexpr int MT_X = TX / 256, MT_ALL = TALL / 256;
constexpr int NSLOT_MAX = 2 * TALL + NEXP * 256;
constexpr float RMS_EPS = 1e-6f;
constexpr int NLAYER = 2;
constexpr float F8_SW = 64.f, F8_SH = 16.f, F8_SM = 4.f;
#ifndef F8_FROM
#define F8_FROM 0
#endif
#define F8LAYER(l) ((l) >= F8_FROM)
#ifndef C2_F8
#define C2_F8 1
#endif
constexpr float F8_SY = 32.f;
#ifndef MRG_F8
#define MRG_F8 1
#endif
constexpr float F8_SO = 32.f;
#ifndef HEAD_PAIR
#define HEAD_PAIR MRG_F8
#endif
#ifndef GATES_F8
#define GATES_F8 1
#endif
constexpr float F8_SG = 256.f;
#ifndef A2_F8
#define A2_F8 1
#endif

constexpr size_t al256(size_t x) { return (x + 255) & ~(size_t)255; }
constexpr size_t WS_CTL = 0, CTL_BYTES = 1u << 20;
constexpr size_t WS_MOD   = WS_CTL + CTL_BYTES;
constexpr size_t WS_ROPE  = WS_MOD + al256((size_t)NLAYER * 17 * NMODC * 4);
constexpr size_t WS_RSCQ  = WS_ROPE + al256(64 * 8 * 2 * 4);
constexpr size_t WS_RSCKV = WS_RSCQ + al256((size_t)TALL * 4);
constexpr size_t WS_SSKR  = WS_RSCKV + al256((size_t)TALL * 4);
constexpr size_t WS_TOKE  = WS_SSKR + al256((size_t)TALL * 4);
constexpr size_t WS_TOKW  = WS_TOKE + al256((size_t)TALL * 8);
constexpr size_t WS_TOKP  = WS_TOKW + al256((size_t)TALL * 8);
constexpr size_t WS_RSTD2 = WS_TOKP + al256((size_t)TALL * 8);
constexpr size_t WS_TILEE = WS_RSTD2 + al256((size_t)TALL * 8);
constexpr size_t WS_OFFS  = WS_TILEE + al256(512 * 4);
constexpr size_t WS_PART6 = WS_OFFS + al256(128 * 4);
constexpr size_t WS_PART7 = WS_PART6 + al256((size_t)TALL * 4 * 4);
constexpr size_t WS_PART8 = WS_PART7 + al256((size_t)TALL * 8 * 4);
constexpr size_t WS_WIN   = WS_PART8 + al256((size_t)TALL * 4 * 4);
constexpr size_t WS_WUQ   = WS_WIN + al256((size_t)NLAYER * INP * DM * 2);
constexpr size_t WS_WUKV  = WS_WUQ + al256((size_t)NLAYER * 1024 * QLORA * 2);
constexpr size_t WS_WOA   = WS_WUKV + al256((size_t)NLAYER * 1024 * KVLORA * 2);
constexpr size_t WS_WOB   = WS_WOA + al256((size_t)NLAYER * 1024 * 512 * 2);
constexpr size_t WS_WOUT  = WS_WOB + al256((size_t)NLAYER * 1024 * 512 * 2);
constexpr size_t WS_W13   = WS_WOUT + al256((size_t)NLAYER * 1024 * 1024 * 2);
constexpr size_t WS_W2    = WS_W13 + al256((size_t)NLAYER * NEXP * 2048 * 1024 * 2);
constexpr size_t WS_H     = WS_W2 + al256((size_t)NLAYER * NEXP * 1024 * 1024 * 2);
constexpr size_t WS_XC    = WS_H + al256((size_t)TALL * DM * 2);
constexpr size_t WS_ACT   = WS_XC + al256((size_t)TC * DM * 4);
constexpr size_t WS_QA    = WS_ACT;
constexpr size_t WS_KA    = WS_QA + al256((size_t)TALL * 512 * 2);
constexpr size_t WS_VA    = WS_KA + al256((size_t)TALL * 512 * 2);
constexpr size_t WS_ZCQ   = WS_VA + al256((size_t)TALL * 512 * 2);
constexpr size_t WS_ZCKV  = WS_ZCQ + al256((size_t)TALL * QLORA * 2);
constexpr size_t WS_ZKR   = WS_ZCKV + al256((size_t)TALL * KVLORA * 2);
constexpr size_t WS_GATES = WS_ZKR + al256((size_t)TALL * ROPED * 2);
constexpr size_t WS_QB    = WS_GATES + al256((size_t)TALL * 2048 * 2);
constexpr size_t WS_KB    = WS_QB + al256((size_t)TALL * 768 * 2);
constexpr size_t WS_VB    = WS_KB + al256((size_t)TALL * 768 * 2);
constexpr size_t WS_OA    = WS_VB + al256((size_t)TALL * 512 * 2);
constexpr size_t WS_OB    = WS_OA + al256((size_t)TALL * 512 * 2);
constexpr size_t WS_Y     = WS_OB + al256((size_t)TALL * 512 * 2);
constexpr size_t WS_MIX_END = WS_Y + al256((size_t)TALL * DM * 2);
constexpr size_t WS_HS    = WS_ACT;
constexpr size_t WS_HMID  = WS_HS + al256((size_t)NSLOT_MAX * DM * 2);
constexpr size_t WS_YS    = WS_HMID + al256((size_t)NSLOT_MAX * DM * 2);
constexpr size_t WS_MOE_END = WS_YS + al256((size_t)NSLOT_MAX * DM * 2);
constexpr size_t WS_END0  = (WS_MIX_END > WS_MOE_END) ? WS_MIX_END : WS_MOE_END;
#ifndef XRES_BF16
#define XRES_BF16 1
#endif
constexpr size_t WS_XB    = WS_END0;
constexpr size_t WS_END   = WS_XB + al256((size_t)TALL * DM * 2);

constexpr int CW_BAR = 4096;
constexpr int CW_CNT = 16384;

constexpr int RING_BYTES = 131072;
constexpr int EPI_OFF = RING_BYTES;
constexpr int MISC_OFF = RING_BYTES + 24576;
constexpr int LDS_BYTES = 160 * 1024;

__device__ __forceinline__ unsigned cvt_pk_bf16(float lo, float hi) { unsigned r; asm volatile("v_cvt_pk_bf16_f32 %0, %1, %2" : "=v"(r) : "v"(lo), "v"(hi)); return r; }
__device__ __forceinline__ unsigned cvt_pk4_fp8(float a, float b, float c, float d) {
    a = __builtin_amdgcn_fmed3f(a, -448.f, 448.f); b = __builtin_amdgcn_fmed3f(b, -448.f, 448.f); c = __builtin_amdgcn_fmed3f(c, -448.f, 448.f); d = __builtin_amdgcn_fmed3f(d, -448.f, 448.f);
    int w = 0; w = __builtin_amdgcn_cvt_pk_fp8_f32(a, b, w, false); w = __builtin_amdgcn_cvt_pk_fp8_f32(c, d, w, true); return (unsigned)w; }
__device__ __forceinline__ f32x4 fp8x4_f32(unsigned w) {
    const f32x2 lo = __builtin_amdgcn_cvt_pk_f32_fp8((int)w, false), hi = __builtin_amdgcn_cvt_pk_f32_fp8((int)w, true); return (f32x4){lo[0], lo[1], hi[0], hi[1]}; }
__device__ __forceinline__ float bf_lo(unsigned w) { return __uint_as_float(w << 16); }
__device__ __forceinline__ float bf_hi(unsigned w) { return __uint_as_float(w & 0xffff0000u); }
__device__ __forceinline__ float wave_sum(float v) {
#pragma unroll
    for (int o = 1; o < 64; o <<= 1) v += __shfl_xor(v, o);
    return v;
}
__device__ __forceinline__ float sigmoidf_(float x) { return __builtin_amdgcn_rcpf(1.0f + __expf(-x)); }
__device__ __forceinline__ int ld_i32_agent(const int* p) { return (int)__hip_atomic_load((const unsigned*)p, RLX_AGENT); }
#define XB_TMO      128
#define XB_XCNT(j)  (256  + 64 * (j))
#define XB_XSUB(j)  (1280 + 64 * (j))
#define XB_XGEN(j)  (2304 + 64 * (j))
#define XB_TOP      3328
#define XB_TOPGEN   3392
#define XCD_BAR_WORDS 3456
#define XB_SPIN_CAP (1u << 18)

__device__ __forceinline__ unsigned xb_ld(unsigned* p)              { return __hip_atomic_load(p, __ATOMIC_RELAXED, __HIP_MEMORY_SCOPE_AGENT); }
__device__ __forceinline__ unsigned xb_add(unsigned* p, unsigned v) { return __hip_atomic_fetch_add(p, v, __ATOMIC_RELAXED, __HIP_MEMORY_SCOPE_AGENT); }
__device__ __forceinline__ unsigned xb_xcc_id() { return (unsigned)__builtin_amdgcn_s_getreg((3 << 11) | 20) & 0xFu; }
#define XB_SPIN(cond, bar) do { unsigned _sp = 0; while (cond) { __builtin_amdgcn_s_sleep(1); \
    if ((++_sp & 255u) == 0u) { if (xb_ld(&(bar)[XB_TMO])) break; if (_sp > XB_SPIN_CAP) { atomicAdd(&(bar)[XB_TMO], 1u); break; } } } } while (0)

struct XcdBarrier {
    unsigned* bar; unsigned x;
    volatile LAS unsigned* st;
};

__device__ __forceinline__ XcdBarrier xcd_barrier_post(unsigned* bar, volatile LAS unsigned* st) {
    XcdBarrier b; b.bar = bar; b.x = xb_xcc_id(); b.st = st;
    if (threadIdx.x == 0) (void)xb_add(&bar[XB_XCNT(b.x)], 1u);
    return b;
}
__device__ __forceinline__ void xcd_barrier_complete(unsigned* bar, unsigned x, unsigned& nloc, unsigned& nx) {
    const unsigned G = gridDim.x * gridDim.y * gridDim.z;
    unsigned sum, cnt, mine, sp = 0u;
    for (;;) {
        sum = 0u; cnt = 0u; mine = 0u;
#pragma unroll
        for (unsigned j = 0; j < 16; ++j) { const unsigned c = xb_ld(&bar[XB_XCNT(j)]); sum += c; cnt += (c > 0u) ? 1u : 0u; mine = (j == x) ? c : mine; }
        if (sum == G) break;
        __builtin_amdgcn_s_sleep(1);
        if ((++sp & 255u) == 0u) { if (xb_ld(&bar[XB_TMO])) break; if (sp > XB_SPIN_CAP) { atomicAdd(&bar[XB_TMO], 1u); break; } }
    }
    nloc = mine > 0u ? mine : 1u; nx = cnt > 0u ? cnt : 1u;
}

__device__ __forceinline__ void xcd_barrier(const XcdBarrier& b) {
    asm volatile("s_waitcnt vmcnt(0)" ::: "memory");
    __syncthreads();
    if (threadIdx.x == 0) {
        unsigned* bar = b.bar;
        __builtin_amdgcn_s_waitcnt(0);
        unsigned nloc = b.st[0], nx = b.st[1];
        if (nloc == 0u) { xcd_barrier_complete(bar, b.x, nloc, nx); b.st[0] = nloc; b.st[1] = nx; }
        const unsigned old = xb_add(&bar[XB_XSUB(b.x)], 1u);
        const unsigned gen = old / nloc;
        if (old + 1u == (gen + 1u) * nloc) {
            __builtin_amdgcn_fence(__ATOMIC_RELEASE, "agent");
            asm volatile("s_waitcnt vmcnt(0)" ::: "memory");
            const unsigned og = xb_add(&bar[XB_TOP], 1u);
            const unsigned tg = og / nx;
            if (og + 1u == (tg + 1u) * nx) xb_add(&bar[XB_TOPGEN], 1u);
            else XB_SPIN(xb_ld(&bar[XB_TOPGEN]) == tg, bar);
            __builtin_amdgcn_fence(__ATOMIC_ACQUIRE, "agent");
            xb_add(&bar[XB_XGEN(b.x)], 1u);
            asm volatile("s_waitcnt vmcnt(0)" ::: "memory");
        } else {
            XB_SPIN(xb_ld(&bar[XB_XGEN(b.x)]) == gen, bar);
            __builtin_amdgcn_fence(__ATOMIC_ACQUIRE, "agent");
            asm volatile("s_waitcnt vmcnt(0)" ::: "memory");
        }
    }
    __syncthreads();
}

namespace pg8 {
constexpr int BM = 256, BK = 64, HALF = 128, HTB = HALF * BK * 2  , STAGE_BYTES = 8 * HTB, NXCD = 8, WGM = 8;
__host__ __device__ __forceinline__ int lds_byte(int r, int c) { const int st = (r >> 4) * 2 + (c >> 5), rr = r & 15, cc = c & 31, ob = rr * 64 + cc * 2; return st * 1024 + (ob ^ (((ob >> 9) & 1) << 5)); }
__host__ __device__ __forceinline__ void stage_rc(int b, int& R, int& C) { const int st = b / 1024, sb = b % 1024, swz = sb ^ (((sb >> 9) & 1) << 5); R = (st >> 1) * 16 + swz / 64; C = (st & 1) * 32 + (swz % 64) / 2; }
__host__ __device__ __forceinline__ int perm32(int rho) { const int n = rho >> 4, i = rho & 15; return 8 * (i >> 2) + 4 * n + (i & 3); }

struct Unit { int pm, pn, kind, e; };

__device__ __forceinline__ void rect_tile(int wgid_in, int nM, int nN, int& pm, int& pn) {
    const int nwg = nM * nN; int wgid = wgid_in;
    { const int q = nwg / NXCD, r = nwg % NXCD, xcd = wgid % NXCD, off = wgid / NXCD; wgid = (xcd < r ? xcd * (q + 1) : r * (q + 1) + (xcd - r) * q) + off; }
    const int nig = WGM * nN, gid = wgid / nig, fm = gid * WGM, gsz = (nM - fm) < WGM ? (nM - fm) : WGM;
    pm = fm + ((wgid % nig) % gsz); pn = (wgid % nig) / gsz;
}

typedef int i32x8 __attribute__((ext_vector_type(8)));
template <bool F8 = false, class Epi, class Sched>
__device__ __forceinline__ void gemm_phase(LAS unsigned char* lds, const int K, const Sched& S, const Epi& E) {
    int tid = threadIdx.x; asm volatile("" : "+v"(tid));
    const int wid = __builtin_amdgcn_readfirstlane(tid >> 6), lane = tid & 63, wr = wid >> 2, wc = wid & 3, fr = lane & 15, fq = lane >> 4;
    const int nt = K / BK;
    unsigned voffA[2], voffB[2];
#pragma unroll
    for (int i = 0; i < 2; ++i) { int R, C; stage_rc(tid * 16 + i * 8192, R, C); const int Rb = Epi::PERM ? ((R & ~31) + perm32(R & 31)) : R;
        voffA[i] = (unsigned)(R * K + C) * 2u; voffB[i] = (unsigned)(Rb * K + C) * 2u; }
    const size_t kstep = (size_t)(BK * 2);
    const size_t hstep = (size_t)HALF * K * 2;
    const unsigned ldsw = (unsigned)wid * 1024u;
    const int aoff = lds_byte(wr * 64 + fr, F8 ? fq * 16 : fq * 8), boff = lds_byte(wc * 32 + fr, F8 ? fq * 16 : fq * 8);
    constexpr int KSTEP = F8 ? 16 : 1024;
    int f8scale = 0x7F7F7F7F; asm volatile("" : "+v"(f8scale));
#define PG8_SA(b, h) (((b) * 2 + (h)) * HTB)
#define PG8_SB(b, h) ((4 + (b) * 2 + (h)) * HTB)
#define PG8_STAGE(bufoff, gbase, voff) do { _Pragma("unroll") for (int _i = 0; _i < 2; ++_i) \
        __builtin_amdgcn_global_load_lds((const unsigned*)((const char*)(gbase) + (voff)[_i]), (LAS unsigned*)(lds + (bufoff) + ldsw + _i * 8192), 16, 0, 0); } while (0)
#define PG8_LDA(dst, b, h) do { _Pragma("unroll") for (int m = 0; m < 4; ++m) _Pragma("unroll") for (int k = 0; k < 2; ++k) dst[m][k] = *(const LAS bf16x8*)(lds + PG8_SA(b, h) + aoff + m * 2048 + k * KSTEP); } while (0)
#define PG8_LDB(dst, b, h) do { _Pragma("unroll") for (int n = 0; n < 2; ++n) _Pragma("unroll") for (int k = 0; k < 2; ++k) dst[n][k] = *(const LAS bf16x8*)(lds + PG8_SB(b, h) + boff + n * 2048 + k * KSTEP); } while (0)
#define PG8_CAT(X) __builtin_shufflevector(__builtin_bit_cast(u32x4, (X)[0]), __builtin_bit_cast(u32x4, (X)[1]), 0, 1, 2, 3, 4, 5, 6, 7)
#define PG8_MMA(ai, bj, At, Bt) do { __builtin_amdgcn_s_setprio(1); \
        if constexpr (F8) { _Pragma("unroll") for (int m = 0; m < 4; ++m) _Pragma("unroll") for (int n = 0; n < 2; ++n) \
            asm volatile("v_mfma_scale_f32_16x16x128_f8f6f4 %0, %1, %2, %0, %3, %3 op_sel_hi:[0,0,0]" : "+v"(acc[ai][bj][m][n]) : "v"(__builtin_bit_cast(i32x8, PG8_CAT(Bt[n]))), "v"(__builtin_bit_cast(i32x8, PG8_CAT(At[m]))), "v"(f8scale)); } \
        else { _Pragma("unroll") for (int m = 0; m < 4; ++m) _Pragma("unroll") for (int n = 0; n < 2; ++n) _Pragma("unroll") for (int k = 0; k < 2; ++k) \
            acc[ai][bj][m][n] = __builtin_amdgcn_mfma_f32_16x16x32_bf16(Bt[n][k], At[m][k], acc[ai][bj][m][n], 0, 0, 0); } \
        __builtin_amdgcn_s_setprio(0); } while (0)
#define PG8_WAIT_V(n) asm volatile("s_waitcnt vmcnt(" #n ")" ::: "memory")
#define PG8_WAIT_L(n) asm volatile("s_waitcnt lgkmcnt(" #n ")" ::: "memory")
#define PG8_BAR __builtin_amdgcn_s_barrier()
#define PG8_SCHED __builtin_amdgcn_sched_barrier(0)
    Unit cur, nxt; int ui = 0;
    if (!S.next(0, cur)) return;
    f32x4 acc[2][2][4][2];
#pragma unroll
    for (int a = 0; a < 2; ++a)
#pragma unroll
        for (int b = 0; b < 2; ++b)
#pragma unroll
            for (int m = 0; m < 4; ++m)
#pragma unroll
                for (int n = 0; n < 2; ++n) acc[a][b][m][n] = (f32x4){0.f, 0.f, 0.f, 0.f};
    bf16x8 At[4][2], B0[2][2], B1[2][2];
    const char* cA = S.a_ptr(cur); const char* cB = S.b_ptr(cur);
    PG8_STAGE(PG8_SB(0, 0), cB, voffB); PG8_STAGE(PG8_SB(0, 1), cB + hstep, voffB); PG8_STAGE(PG8_SA(0, 0), cA, voffA); PG8_STAGE(PG8_SA(0, 1), cA + hstep, voffA);
    if (wr == 1) PG8_BAR;
    PG8_WAIT_V(2); PG8_BAR;
    PG8_STAGE(PG8_SB(1, 0), cB + kstep, voffB); PG8_STAGE(PG8_SA(1, 0), cA + kstep, voffA); PG8_STAGE(PG8_SB(1, 1), cB + hstep + kstep, voffB);
    PG8_WAIT_V(6); PG8_BAR;
    for (;;) {
        const bool has_next = S.next(ui + 1, nxt);
        const char* nA = has_next ? S.a_ptr(nxt) : cA; const char* nB = has_next ? S.b_ptr(nxt) : cB;
#pragma unroll 1
        for (int t = 0; t < nt; t += 2) {
            const bool last = (t == nt - 2);
            const char* a1 = cA + (size_t)(t + 1) * kstep;
            const char* a2 = last ? nA : cA + (size_t)(t + 2) * kstep; const char* b2 = last ? nB : cB + (size_t)(t + 2) * kstep;
            const char* a3 = a2 + kstep; const char* b3 = b2 + kstep;
            PG8_LDB(B0, 0, 0); PG8_LDB(B1, 0, 1); PG8_SCHED; PG8_LDA(At, 0, 0); PG8_STAGE(PG8_SA(1, 1), a1 + hstep, voffA);
            PG8_WAIT_V(8); PG8_WAIT_L(0); PG8_BAR; PG8_MMA(0, 0, At, B0); PG8_MMA(0, 1, At, B1); PG8_BAR; PG8_SCHED;
            PG8_LDA(At, 0, 1); PG8_STAGE(PG8_SB(0, 0), b2, voffB); PG8_STAGE(PG8_SB(0, 1), b2 + hstep, voffB); PG8_STAGE(PG8_SA(0, 0), a2, voffA);
            PG8_WAIT_V(8); PG8_WAIT_L(0); PG8_BAR; PG8_MMA(1, 0, At, B0); PG8_MMA(1, 1, At, B1); PG8_BAR; PG8_SCHED;
            PG8_LDB(B0, 1, 0); PG8_LDB(B1, 1, 1); PG8_SCHED; PG8_LDA(At, 1, 0); PG8_STAGE(PG8_SA(0, 1), a2 + hstep, voffA);
            PG8_WAIT_V(8); PG8_WAIT_L(0); PG8_BAR; PG8_MMA(0, 0, At, B0); PG8_MMA(0, 1, At, B1); PG8_BAR; PG8_SCHED;
            PG8_LDA(At, 1, 1); PG8_STAGE(PG8_SB(1, 0), b3, voffB); PG8_STAGE(PG8_SB(1, 1), b3 + hstep, voffB); PG8_STAGE(PG8_SA(1, 0), a3, voffA);
            PG8_WAIT_V(8); PG8_WAIT_L(0); PG8_BAR; PG8_MMA(1, 0, At, B0); PG8_MMA(1, 1, At, B1); PG8_BAR; PG8_SCHED;
        }
        if (wr == 0) PG8_BAR;
        if constexpr (F8) asm volatile("s_nop 15\n\ts_nop 7" ::: "memory");
        { int tz = threadIdx.x; asm volatile("" : "+v"(tz));
          const int wid2 = __builtin_amdgcn_readfirstlane(tz >> 6), lane2 = tz & 63; E(acc, cur, wid2 >> 2, wid2 & 3, lane2 & 15, lane2 >> 4); }
        if (!has_next) break;
        if (!(Epi::CHAIN && cur.kind == 0)) {
#pragma unroll
            for (int a = 0; a < 2; ++a)
#pragma unroll
                for (int b = 0; b < 2; ++b)
#pragma unroll
                    for (int m = 0; m < 4; ++m)
#pragma unroll
                        for (int n = 0; n < 2; ++n) acc[a][b][m][n] = (f32x4){0.f, 0.f, 0.f, 0.f};
        }
        cur = nxt; cA = nA; cB = nB; ++ui;
        if (wr == 1) PG8_BAR;
    }
    PG8_WAIT_V(0);
    PG8_BAR;
#undef PG8_SA
#undef PG8_SB
#undef PG8_STAGE
#undef PG8_LDA
#undef PG8_LDB
#undef PG8_MMA
#undef PG8_CAT
#undef PG8_WAIT_V
#undef PG8_WAIT_L
#undef PG8_BAR
#undef PG8_SCHED
}
}
namespace pg8 {
__device__ __forceinline__ u32x4 pack8(const f32x4 a, const f32x4 b) { u32x4 w; w.x = cvt_pk_bf16(a[0], a[1]); w.y = cvt_pk_bf16(a[2], a[3]); w.z = cvt_pk_bf16(b[0], b[1]); w.w = cvt_pk_bf16(b[2], b[3]); return w; }
__device__ __forceinline__ float sumsq4(const f32x4 a) { return (a[0] * a[0] + a[1] * a[1]) + (a[2] * a[2] + a[3] * a[3]); }
#define EPI_BAR() do { asm volatile("s_waitcnt lgkmcnt(0)" ::: "memory"); __builtin_amdgcn_s_barrier(); asm volatile("" ::: "memory"); } while (0)

struct EpiIn {
    static constexpr bool PERM = true, CHAIN = false;
    bf16_t *QA, *KA, *VA, *ZCQ, *ZCKV, *ZKR, *GATES; const float *qg, *kg; float *P6, *P7, *P8; float asc;
    __device__ __forceinline__ void operator()(f32x4 (&acc)[2][2][4][2], const Unit& u, int wr, int wc, int fr, int fq) const {
        const int row0 = u.pm * BM + wr * 64 + fr, pn = u.pn;
        if (asc != 1.0f) {
#pragma unroll
            for (int ai = 0; ai < 2; ++ai)
#pragma unroll
                for (int bj = 0; bj < 2; ++bj)
#pragma unroll
                    for (int m = 0; m < 4; ++m) { acc[ai][bj][m][0] = acc[ai][bj][m][0] * asc; acc[ai][bj][m][1] = acc[ai][bj][m][1] * asc; } }
        if (pn < 4) {
            const float* g = (pn < 2) ? qg : kg; bf16_t* dst = (pn < 2) ? QA : KA; const int head = 4 * (pn & 1) + wc;
            f32x4 gv[2][2];
#pragma unroll
            for (int bj = 0; bj < 2; ++bj)
#pragma unroll
                for (int n = 0; n < 2; ++n) gv[bj][n] = *(const f32x4*)(g + 32 * bj + 8 * fq + 4 * n);
#pragma unroll
            for (int ai = 0; ai < 2; ++ai)
#pragma unroll
                for (int m = 0; m < 4; ++m) {
                    const size_t row = (size_t)(row0 + ai * HALF + m * 16);
                    float ss = (sumsq4(acc[ai][0][m][0]) + sumsq4(acc[ai][0][m][1])) + (sumsq4(acc[ai][1][m][0]) + sumsq4(acc[ai][1][m][1]));
                    ss += __shfl_xor(ss, 16); ss += __shfl_xor(ss, 32);
                    const float rstd = rsqrtf(ss * (1.0f / 64.0f) + RMS_EPS);
#pragma unroll
                    for (int bj = 0; bj < 2; ++bj)
                        *(u32x4*)(dst + row * 512 + head * 64 + 32 * bj + 8 * fq) = pack8(acc[ai][bj][m][0] * rstd * gv[bj][0], acc[ai][bj][m][1] * rstd * gv[bj][1]);
                }
        } else if (pn >= 9) {
#pragma unroll
            for (int ai = 0; ai < 2; ++ai)
#pragma unroll
                for (int m = 0; m < 4; ++m) {
                    const size_t row = (size_t)(row0 + ai * HALF + m * 16);
#pragma unroll
                    for (int bj = 0; bj < 2; ++bj) { f32x4 a = acc[ai][bj][m][0], b = acc[ai][bj][m][1];
#pragma unroll
                        for (int j = 0; j < 4; ++j) { a[j] = sigmoidf_(a[j]); b[j] = sigmoidf_(b[j]); }
#if GATES_F8
                        { u32x2 w; w.x = cvt_pk4_fp8(a[0] * F8_SG, a[1] * F8_SG, a[2] * F8_SG, a[3] * F8_SG); w.y = cvt_pk4_fp8(b[0] * F8_SG, b[1] * F8_SG, b[2] * F8_SG, b[3] * F8_SG);
                          *(u32x2*)((unsigned char*)GATES + row * 2048 + (pn - 9) * 256 + 128 * bj + 32 * wc + 8 * fq) = w; } }
#else
                        *(u32x4*)(GATES + row * 2048 + (pn - 9) * 256 + 128 * bj + 32 * wc + 8 * fq) = pack8(a, b); }
#endif
                }
        } else {
#pragma unroll
            for (int ai = 0; ai < 2; ++ai)
#pragma unroll
                for (int m = 0; m < 4; ++m) {
                    const size_t row = (size_t)(row0 + ai * HALF + m * 16);
                    if (pn >= 6) {
                        float s0 = sumsq4(acc[ai][0][m][0]) + sumsq4(acc[ai][0][m][1]), s1 = sumsq4(acc[ai][1][m][0]) + sumsq4(acc[ai][1][m][1]);
                        s0 += __shfl_xor(s0, 16); s0 += __shfl_xor(s0, 32); s1 += __shfl_xor(s1, 16); s1 += __shfl_xor(s1, 32);
                        if (fq == 0) { if (pn == 6) P6[row * 4 + wc] = s0 + s1; else if (pn == 8) P8[row * 4 + wc] = s0 + s1; else { P7[row * 8 + wc] = s0; if (wc == 0) P7[row * 8 + 4] = s1; } } }
#pragma unroll
                    for (int bj = 0; bj < 2; ++bj) {
                        const u32x4 w = pack8(acc[ai][bj][m][0], acc[ai][bj][m][1]); const int cc = 128 * bj + 32 * wc + 8 * fq;
                        if (pn < 6) *(u32x4*)(VA + row * 512 + (pn - 4) * 256 + cc) = w;
                        else if (pn == 6) *(u32x4*)(ZCQ + row * QLORA + cc) = w;
                        else if (pn == 8) *(u32x4*)(ZCKV + row * KVLORA + cc) = w;
                        else { if (bj == 0) *(u32x4*)(ZCQ + row * QLORA + 256 + cc) = w; else if (wc == 0) *(u32x4*)(ZKR + row * ROPED + 8 * fq) = w; }
                    }
                }
        }
    }
};

__device__ __forceinline__ void rope8(float (&v)[8], const LAS float* rope, int s  , int fq) {
    const int pos = (fq < 2) ? (s >> 6) : (s & 63);
    const f32x4 c0 = *(const LAS f32x4*)(rope + pos * 8), c1 = *(const LAS f32x4*)(rope + pos * 8 + 4), s0 = *(const LAS f32x4*)(rope + 512 + pos * 8), s1 = *(const LAS f32x4*)(rope + 512 + pos * 8 + 4);
    const float cs[8] = {c0[0], c0[1], c0[2], c0[3], c1[0], c1[1], c1[2], c1[3]}, sn[8] = {s0[0], s0[1], s0[2], s0[3], s1[0], s1[1], s1[2], s1[3]};
#pragma unroll
    for (int i = 0; i < 8; ++i) { const float o = __shfl_xor(v[i], 16); v[i] = (fq & 1) ? (o * sn[i] + v[i] * cs[i]) : (v[i] * cs[i] - o * sn[i]); }
}

struct EpiQ {
    static constexpr bool PERM = true, CHAIN = false;
    bf16_t* QB; const float *p6, *p7, *g; const LAS float* rope; LAS float* P;
    __device__ __forceinline__ void operator()(f32x4 (&acc)[2][2][4][2], const Unit& u, int wr, int wc, int fr, int fq) const {
        const int row0 = u.pm * BM + wr * 64 + fr; const bool isx = u.pm < MT_X;
        float r8[8];
#pragma unroll
        for (int i = 0; i < 8; ++i) { const size_t row = (size_t)(row0 + (i >> 2) * HALF + (i & 3) * 16); const f32x4 a = *(const f32x4*)(p6 + row * 4), b = *(const f32x4*)(p7 + row * 8);
            r8[i] = rsqrtf((((a[0] + a[1]) + (a[2] + a[3])) + ((b[0] + b[1]) + (b[2] + b[3]))) * (1.0f / QLORA) + RMS_EPS); }
        const int gq = (wc < 3) ? wc : 0;
        const f32x4 g0 = *(const f32x4*)(g + 32 * gq + 8 * fq), g1 = *(const f32x4*)(g + 32 * gq + 8 * fq + 4);
#pragma unroll
        for (int ai = 0; ai < 2; ++ai)
#pragma unroll
            for (int m = 0; m < 4; ++m) {
                const float r = r8[ai * 4 + m]; const int rl = ai * 64 + m * 16 + fr;
#pragma unroll
                for (int bj = 0; bj < 2; ++bj) {
                    float ss = (sumsq4(acc[ai][bj][m][0]) + sumsq4(acc[ai][bj][m][1])) * (r * r); ss += __shfl_xor(ss, 16); ss += __shfl_xor(ss, 32);
                    if (fq == 0) P[((wr * 128 + rl) * 2 + bj) * 4 + wc] = ss; }
            }
        EPI_BAR();
        if (wc < 3) {
#pragma unroll
            for (int ai = 0; ai < 2; ++ai)
#pragma unroll
                for (int m = 0; m < 4; ++m) {
                    const int row = row0 + ai * HALF + m * 16, rl = ai * 64 + m * 16 + fr; const float r = r8[ai * 4 + m];
#pragma unroll
                    for (int bj = 0; bj < 2; ++bj) {
                        const f32x4 p = *(const LAS f32x4*)(P + ((wr * 128 + rl) * 2 + bj) * 4);
                        const float rstd = r * rsqrtf(((p[0] + p[1]) + p[2]) * (1.0f / 96.0f) + RMS_EPS);
                        const f32x4 a = acc[ai][bj][m][0] * rstd * g0, b = acc[ai][bj][m][1] * rstd * g1;
                        float v[8] = {a[0], a[1], a[2], a[3], b[0], b[1], b[2], b[3]};
                        if (wc == 2 && isx) rope8(v, rope, row & (SEQ - 1), fq);
                        u32x4 w; w.x = cvt_pk_bf16(v[0], v[1]); w.y = cvt_pk_bf16(v[2], v[3]); w.z = cvt_pk_bf16(v[4], v[5]); w.w = cvt_pk_bf16(v[6], v[7]);
                        *(u32x4*)(QB + (size_t)row * 768 + (2 * u.pn + bj) * QKD + 32 * wc + 8 * fq) = w;
                    }
                    asm volatile("" ::: "memory");
                }
        }
    }
};

struct EpiKV {
    static constexpr bool PERM = true, CHAIN = false;
    bf16_t *KB, *VB; const bf16_t* ZKR; const float *p7, *p8, *g; const LAS float* rope; LAS float* P;
    __device__ __forceinline__ void operator()(f32x4 (&acc)[2][2][4][2], const Unit& u, int wr, int wc, int fr, int fq) const {
        const int row0 = u.pm * BM + wr * 64 + fr; const bool isx = u.pm < MT_X;
        float r8[8], k8[8]; u32x4 zk8[8];
#pragma unroll
        for (int i = 0; i < 8; ++i) { const int row = row0 + (i >> 2) * HALF + (i & 3) * 16; const f32x4 a = *(const f32x4*)(p8 + (size_t)row * 4);
            k8[i] = p7[(size_t)row * 8 + 4]; r8[i] = rsqrtf(((a[0] + a[1]) + (a[2] + a[3])) * (1.0f / KVLORA) + RMS_EPS);
            zk8[i] = (u32x4){0u, 0u, 0u, 0u}; if (wc == 2) zk8[i] = *(const u32x4*)(ZKR + (size_t)row * ROPED + 8 * fq); }
        const int gofs = (wc < 2) ? (32 * wc + 8 * fq) : (64 + 8 * fq);
        const f32x4 g0 = *(const f32x4*)(g + gofs), g1 = *(const f32x4*)(g + gofs + 4);
        if (wc < 2) {
#pragma unroll
            for (int ai = 0; ai < 2; ++ai)
#pragma unroll
                for (int m = 0; m < 4; ++m) { const float r = r8[ai * 4 + m]; const int rl = ai * 64 + m * 16 + fr;
#pragma unroll
                    for (int bj = 0; bj < 2; ++bj) { float ss = (sumsq4(acc[ai][bj][m][0]) + sumsq4(acc[ai][bj][m][1])) * (r * r); ss += __shfl_xor(ss, 16); ss += __shfl_xor(ss, 32);
                        if (fq == 0) P[((wr * 128 + rl) * 2 + bj) * 4 + wc] = ss + ((wc == 0) ? k8[ai * 4 + m] : 0.f); } }
        }
        EPI_BAR();
#pragma unroll
        for (int ai = 0; ai < 2; ++ai)
#pragma unroll
            for (int m = 0; m < 4; ++m) {
                const int row = row0 + ai * HALF + m * 16, rl = ai * 64 + m * 16 + fr;
                const float rr = r8[ai * 4 + m]; const u32x4 zk = zk8[ai * 4 + m];
#pragma unroll
                for (int bj = 0; bj < 2; ++bj) {
                    const int head = 2 * u.pn + bj;
                    const f32x4 p = *(const LAS f32x4*)(P + ((wr * 128 + rl) * 2 + bj) * 4);
                    const float rstd = rsqrtf((p[0] + p[1]) * (1.0f / 96.0f) + RMS_EPS);
                    if (wc < 2) {
                        *(u32x4*)(KB + (size_t)row * 768 + head * QKD + 32 * wc + 8 * fq) = pack8(acc[ai][bj][m][0] * (rr * rstd) * g0, acc[ai][bj][m][1] * (rr * rstd) * g1);
                    } else {
                        *(u32x4*)(VB + (size_t)row * 512 + head * 64 + 32 * (wc - 2) + 8 * fq) = pack8(acc[ai][bj][m][0] * rr, acc[ai][bj][m][1] * rr);
                        if (wc == 2) {
                            float v[8] = {bf_lo(zk.x) * rstd * g0[0], bf_hi(zk.x) * rstd * g0[1], bf_lo(zk.y) * rstd * g0[2], bf_hi(zk.y) * rstd * g0[3],
                                          bf_lo(zk.z) * rstd * g1[0], bf_hi(zk.z) * rstd * g1[1], bf_lo(zk.w) * rstd * g1[2], bf_hi(zk.w) * rstd * g1[3]};
                            if (isx) rope8(v, rope, row & (SEQ - 1), fq);
                            u32x4 w; w.x = cvt_pk_bf16(v[0], v[1]); w.y = cvt_pk_bf16(v[2], v[3]); w.z = cvt_pk_bf16(v[4], v[5]); w.w = cvt_pk_bf16(v[6], v[7]);
                            *(u32x4*)(KB + (size_t)row * 768 + head * QKD + 64 + 8 * fq) = w;
                        }
                    }
                }
                asm volatile("" ::: "memory");
            }
    }
};

struct EpiMerge {
    static constexpr bool PERM = true, CHAIN = true;
    const bf16_t* GATES; bf16_t* Y; float asc;
    __device__ __forceinline__ void operator()(f32x4 (&acc)[2][2][4][2], const Unit& u, int wr, int wc, int fr, int fq) const {
        const int row0 = u.pm * BM + wr * 64 + fr;
#pragma unroll
        for (int ai = 0; ai < 2; ++ai)
#pragma unroll
            for (int m = 0; m < 4; ++m) {
                const size_t row = (size_t)(row0 + ai * HALF + m * 16);
#pragma unroll
                for (int bj = 0; bj < 2; ++bj) {
                    const int col = u.pn * 256 + 128 * bj + 32 * wc + 8 * fq;
#if GATES_F8
                    const u32x2 gb = *(const u32x2*)((const unsigned char*)GATES + row * 2048 + 1024 + col);
                    const f32x4 b0 = fp8x4_f32(gb.x) * (1.0f / F8_SG), b1 = fp8x4_f32(gb.y) * (1.0f / F8_SG);
#else
                    const u32x4 gb = *(const u32x4*)(GATES + row * 2048 + 1024 + col);
                    const f32x4 b0 = (f32x4){bf_lo(gb.x), bf_hi(gb.x), bf_lo(gb.y), bf_hi(gb.y)}, b1 = (f32x4){bf_lo(gb.z), bf_hi(gb.z), bf_lo(gb.w), bf_hi(gb.w)};
#endif
                    if (u.kind == 0) {
#if GATES_F8
                        const u32x2 ga = *(const u32x2*)((const unsigned char*)GATES + row * 2048 + col);
                        const f32x4 a0 = fp8x4_f32(ga.x) * (1.0f / F8_SG), a1 = fp8x4_f32(ga.y) * (1.0f / F8_SG);
#else
                        const u32x4 ga = *(const u32x4*)(GATES + row * 2048 + col);
                        const f32x4 a0 = (f32x4){bf_lo(ga.x), bf_hi(ga.x), bf_lo(ga.y), bf_hi(ga.y)}, a1 = (f32x4){bf_lo(ga.z), bf_hi(ga.z), bf_lo(ga.w), bf_hi(ga.w)};
#endif
#pragma unroll
                        for (int j = 0; j < 4; ++j) { acc[ai][bj][m][0][j] *= a0[j] * __builtin_amdgcn_rcpf(b0[j]); acc[ai][bj][m][1][j] *= a1[j] * __builtin_amdgcn_rcpf(b1[j]); }
                    } else {
#if C2_F8
                        { const f32x4 y0 = acc[ai][bj][m][0] * b0 * (F8_SY * asc), y1 = acc[ai][bj][m][1] * b1 * (F8_SY * asc); u32x2 w; w.x = cvt_pk4_fp8(y0[0], y0[1], y0[2], y0[3]); w.y = cvt_pk4_fp8(y1[0], y1[1], y1[2], y1[3]);
                          *(u32x2*)((unsigned char*)Y + row * 1024 + col) = w; }
#else
                        *(u32x4*)(Y + row * 1024 + col) = pack8(acc[ai][bj][m][0] * b0 * asc, acc[ai][bj][m][1] * b1 * asc);
#endif
                    }
                }
            }
    }
};

struct EpiOut {
    static constexpr bool PERM = false, CHAIN = false;
    const float* xsrc; float* xdst; const float* csrc; float* cdst; const float* mod  ; int goff; float asc;
    __device__ __forceinline__ void operator()(f32x4 (&acc)[2][2][4][2], const Unit& u, int wr, int wc, int fr, int fq) const {
        const bool isx = u.pm < MT_X;
        const int rowt = (isx ? u.pm : u.pm - MT_X) * BM + wr * 64 + fr;
        const float* src = isx ? xsrc : csrc; float* dst = isx ? xdst : cdst;
        const float* gm = mod + (size_t)(isx ? (u.pm >> 3) : 16) * NMODC + goff;
        const int col0 = u.pn * BM + wc * 32 + 4 * fq;
        f32x4 gv[2][2];
#pragma unroll
        for (int bj = 0; bj < 2; ++bj)
#pragma unroll
            for (int n = 0; n < 2; ++n) gv[bj][n] = *(const f32x4*)(gm + col0 + bj * HALF + n * 16) * asc;
#pragma unroll
        for (int ai = 0; ai < 2; ++ai)
#pragma unroll
            for (int m = 0; m < 4; ++m) { const size_t off = (size_t)(rowt + ai * HALF + m * 16) * DM + col0;
#if XRES_BF16
                bf16_t* const xb = (bf16_t*)cdst + (size_t)(u.pm * BM + wr * 64 + fr + ai * HALF + m * 16) * DM + col0; (void)dst; const bool src_xb = (xsrc == nullptr);
#pragma unroll
                for (int bj = 0; bj < 2; ++bj)
#pragma unroll
                    for (int n = 0; n < 2; ++n) { f32x4 xs;
                        if (src_xb) { const u32x2 w = *(const u32x2*)(xb + bj * HALF + n * 16); xs = (f32x4){bf_lo(w.x), bf_hi(w.x), bf_lo(w.y), bf_hi(w.y)}; }
                        else xs = *(const f32x4*)(src + off + bj * HALF + n * 16);
                        const f32x4 r = xs + gv[bj][n] * acc[ai][bj][m][n]; u32x2 o; o.x = cvt_pk_bf16(r[0], r[1]); o.y = cvt_pk_bf16(r[2], r[3]); *(u32x2*)(xb + bj * HALF + n * 16) = o; }
#else
#pragma unroll
                for (int bj = 0; bj < 2; ++bj)
#pragma unroll
                    for (int n = 0; n < 2; ++n) { const f32x4 xs = *(const f32x4*)(src + off + bj * HALF + n * 16); *(f32x4*)(dst + off + bj * HALF + n * 16) = xs + gv[bj][n] * acc[ai][bj][m][n]; }
#endif
            }
    }
};

template <bool F8> struct EpiMoe1 {
    static constexpr bool PERM = true, CHAIN = false;
    bf16_t* HM; float ascale;
    __device__ __forceinline__ void operator()(f32x4 (&acc)[2][2][4][2], const Unit& u, int wr, int wc, int fr, int fq) const {
        const int row0 = u.pm * BM + wr * 64 + fr;
#pragma unroll
        for (int ai = 0; ai < 2; ++ai)
#pragma unroll
            for (int m = 0; m < 4; ++m) { const size_t row = (size_t)(row0 + ai * HALF + m * 16);
#pragma unroll
                for (int bj = 0; bj < 2; ++bj) { f32x4 p = acc[ai][bj][m][0], q = acc[ai][bj][m][1];
                    if (F8) { p = p * ascale; q = q * ascale; }
                    const float h0 = p[0] * sigmoidf_(p[0]) * p[1], h1 = p[2] * sigmoidf_(p[2]) * p[3], h2 = q[0] * sigmoidf_(q[0]) * q[1], h3 = q[2] * sigmoidf_(q[2]) * q[3];
                    const int col = u.pn * 128 + 64 * bj + 16 * wc + 4 * fq;
                    if (F8) *(unsigned*)((unsigned char*)HM + row * DM + col) = cvt_pk4_fp8(h0 * F8_SM, h1 * F8_SM, h2 * F8_SM, h3 * F8_SM);
                    else { u32x2 w; w.x = cvt_pk_bf16(h0, h1); w.y = cvt_pk_bf16(h2, h3); *(u32x2*)(HM + row * DM + col) = w; } }
            }
    }
};
struct EpiMoe2 {
    static constexpr bool PERM = true, CHAIN = false;
    bf16_t* YS; float ascale;
    __device__ __forceinline__ void operator()(f32x4 (&acc)[2][2][4][2], const Unit& u, int wr, int wc, int fr, int fq) const {
        const int row0 = u.pm * BM + wr * 64 + fr;
#pragma unroll
        for (int ai = 0; ai < 2; ++ai)
#pragma unroll
            for (int m = 0; m < 4; ++m) { const size_t row = (size_t)(row0 + ai * HALF + m * 16);
#pragma unroll
                for (int bj = 0; bj < 2; ++bj) *(u32x4*)(YS + row * DM + u.pn * 256 + 128 * bj + 32 * wc + 8 * fq) = pack8(acc[ai][bj][m][0] * ascale, acc[ai][bj][m][1] * ascale); }
    }
};

struct SchedRect {
    const char* A; const char* B; size_t tstep; int nM, nN, G, c, nM2, pn2, npn2;
    __device__ __forceinline__ bool next(int i, Unit& u) const {
        const int L = i * G + c, mainc = nM * nN; u.kind = 0; u.e = 0;
        if (L < mainc) { rect_tile(L, nM, nN, u.pm, u.pn); return true; }
        const int Lx = L - mainc; if (Lx >= nM2 * npn2) return false;
        u.pm = nM + Lx / npn2; u.pn = pn2 + Lx % npn2; return true;
    }
    __device__ __forceinline__ const char* a_ptr(const Unit& u) const { return A + (size_t)u.pm * tstep; }
    __device__ __forceinline__ const char* b_ptr(const Unit& u) const { return B + (size_t)u.pn * tstep; }
};
struct SchedMerge {
    const char *OA, *OB, *WA, *WB; size_t tstep; int nM, nN, G, c;
    __device__ __forceinline__ bool next(int i, Unit& u) const {
        const int L = (i >> 1) * G + c; if (L >= nM * nN) return false;
        rect_tile(L, nM, nN, u.pm, u.pn); u.kind = i & 1; u.e = 0; return true;
    }
    __device__ __forceinline__ const char* a_ptr(const Unit& u) const { return (u.kind ? OB : OA) + (size_t)u.pm * tstep; }
    __device__ __forceinline__ const char* b_ptr(const Unit& u) const { return (u.kind ? WB : WA) + (size_t)u.pn * tstep; }
};
struct SchedMoe {
    const char* A; const char* W; size_t tstepA, wstride, tstepB; const LAS int* tile_e  ; int ntile, nN, G, c;
    __device__ __forceinline__ bool next(int i, Unit& u) const {
        const int L = i * G + c; if (L >= ntile * nN) return false;
        rect_tile(L, ntile, nN, u.pm, u.pn); u.kind = 0;
        u.e = __builtin_amdgcn_readfirstlane(tile_e[u.pm]); return true;
    }
    __device__ __forceinline__ const char* a_ptr(const Unit& u) const { return A + (size_t)u.pm * tstepA; }
    __device__ __forceinline__ const char* b_ptr(const Unit& u) const { return W + (size_t)u.e * wstride + (size_t)u.pn * tstepB; }
};
}
namespace att {
constexpr int NW = 8, QBLK = 32, KVBLK = 64, DV = 64;
constexpr int SHM_V = 16384, SHM_K = 16384;
constexpr int LDS_VOFF = 0, LDS_KOFF = 2 * SHM_V, LDS_WS = LDS_KOFF + 2 * SHM_K, LDS_OST = LDS_WS + NW * 64 * 4, LDS_BIAS = LDS_OST + NW * 4096, LDS_MASK = LDS_BIAS + 16 * 128 * 4, LDS_END = LDS_MASK + 64 * 64 * 4;
static_assert(LDS_END <= RING_BYTES, "attention LDS map");
template <int DQK> struct KL { static constexpr int PITCH = (DQK == 64) ? 128 : 256; };
#define KSWZ(row, colB) ((row) * KL<DQK>::PITCH + ((colB) ^ (((row) & 7) << 4)))
#define SBAR() __builtin_amdgcn_sched_barrier(0)
__device__ __forceinline__ int crow(int r, int hi) { return (r & 3) + 8 * (r >> 2) + 4 * hi; }
__device__ __forceinline__ int v_st(int k, int c) { const int kk = (k & ~0xC) | ((k & 4) << 1) | ((k & 8) >> 1); return ((kk >> 3) * 2 + (c >> 5)) * 512 + ((kk & 7) * 32 + (c & 31)) * 2; }
__device__ __forceinline__ int v_rd_base(int lane, int c) { const int hi = (lane >> 5) & 1, g = c + hi;
    return ((lane & 3) << 3) | (((lane >> 2) & 3) << 6) | (((lane >> 4) & 1) << 5) | ((g & 1) << 8) | ((g >> 1) << 11); }
constexpr int v_rd_off(int d0, int ks, int half) { return ((2 * ks + half) * 2 + d0) * 512; }
template <int OFF> __device__ __forceinline__ s16x4 tr_read(int vb) { s16x4 r; asm volatile("ds_read_b64_tr_b16 %0, %1 offset:%2" : "=&v"(r) : "v"(vb), "i"(OFF) : "memory"); return r; }

template <int D0> __device__ __forceinline__ void pv_one(f32x16& od, int vbA, int vbB, bf16x8 pa0, bf16x8 pa1, bf16x8 pa2, bf16x8 pa3) {
    const s16x4 l0 = tr_read<v_rd_off(D0, 0, 0)>(vbA), h0 = tr_read<v_rd_off(D0, 0, 1)>(vbA), l1 = tr_read<v_rd_off(D0, 1, 0)>(vbA), h1 = tr_read<v_rd_off(D0, 1, 1)>(vbA);
    const s16x4 l2 = tr_read<v_rd_off(D0, 0, 0)>(vbB), h2 = tr_read<v_rd_off(D0, 0, 1)>(vbB), l3 = tr_read<v_rd_off(D0, 1, 0)>(vbB), h3 = tr_read<v_rd_off(D0, 1, 1)>(vbB);
    asm volatile("s_waitcnt lgkmcnt(0)" ::: "memory"); SBAR();
#define PK(L, H) (bf16x8){L[0], L[1], L[2], L[3], H[0], H[1], H[2], H[3]}
    od = __builtin_amdgcn_mfma_f32_32x32x16_bf16(pa0, PK(l0, h0), od, 0, 0, 0);
    od = __builtin_amdgcn_mfma_f32_32x32x16_bf16(pa1, PK(l1, h1), od, 0, 0, 0);
    od = __builtin_amdgcn_mfma_f32_32x32x16_bf16(pa2, PK(l2, h2), od, 0, 0, 0);
    od = __builtin_amdgcn_mfma_f32_32x32x16_bf16(pa3, PK(l3, h3), od, 0, 0, 0);
#undef PK
}
__device__ __forceinline__ void pv_all(f32x16* o, int vbA, int vbB, bf16x8 pa0, bf16x8 pa1, bf16x8 pa2, bf16x8 pa3) { pv_one<0>(o[0], vbA, vbB, pa0, pa1, pa2, pa3); pv_one<1>(o[1], vbA, vbB, pa0, pa1, pa2, pa3); }

#define MX3(a, b, c) __builtin_fmaxf(__builtin_fmaxf((a), (b)), (c))
template <bool FIRST>
__device__ __forceinline__ void partialSM(f32x16& p0, f32x16& p1, float& m_reg, float& alpha, f32x16& negm, const float THR2) {
    float a = MX3(p0[0], p0[1], p1[0]), b = MX3(p0[2], p0[3], p1[1]); a = MX3(a, p1[2], p1[3]);
#pragma unroll
    for (int r = 4; r < 16; r += 4) { a = MX3(a, p0[r], p0[r + 1]); b = MX3(b, p0[r + 2], p0[r + 3]); a = MX3(a, p1[r], p1[r + 1]); b = MX3(b, p1[r + 2], p1[r + 3]); }
    float pmax = __builtin_fmaxf(a, b);
    { auto rr = __builtin_amdgcn_permlane32_swap(__float_as_uint(pmax), __float_as_uint(pmax), false, false); pmax = __builtin_fmaxf(__uint_as_float(rr[0]), __uint_as_float(rr[1])); }
    alpha = 1.f;
    if (FIRST || !__builtin_expect(__all(pmax <= THR2), 1)) {
        const float dl = FIRST ? pmax : __builtin_fmaxf(pmax, 0.f);
        m_reg += dl; alpha = FIRST ? 1.f : __builtin_amdgcn_exp2f(-dl);
#pragma unroll
        for (int r = 0; r < 16; ++r) { p0[r] -= dl; p1[r] -= dl; }
#pragma unroll
        for (int r = 0; r < 16; ++r) negm[r] = -m_reg;
    }
#pragma unroll
    for (int r = 0; r < 16; ++r) p0[r] = __builtin_amdgcn_exp2f(p0[r]);
}
__device__ __forceinline__ void finishSM(f32x16& p0, f32x16& p1, float alpha, float& l_reg, bf16x8& pa0, bf16x8& pa1, bf16x8& pa2, bf16x8& pa3) {
#pragma unroll
    for (int r = 0; r < 16; ++r) p1[r] = __builtin_amdgcn_exp2f(p1[r]);
    float ps = 0;
#pragma unroll
    for (int r = 0; r < 16; ++r) ps += p0[r];
#pragma unroll
    for (int r = 0; r < 16; ++r) ps += p1[r];
    { auto rr = __builtin_amdgcn_permlane32_swap(__float_as_uint(ps), __float_as_uint(ps), false, false); ps = __uint_as_float(rr[0]) + __uint_as_float(rr[1]); }
    l_reg = l_reg * alpha + ps;
#define PK4(P, BASE, OUT) do { unsigned a0 = cvt_pk_bf16(P[BASE + 0], P[BASE + 1]), a1 = cvt_pk_bf16(P[BASE + 2], P[BASE + 3]);   \
    unsigned b0 = cvt_pk_bf16(P[BASE + 4], P[BASE + 5]), b1 = cvt_pk_bf16(P[BASE + 6], P[BASE + 7]);                              \
    auto r0 = __builtin_amdgcn_permlane32_swap(a0, b0, false, false); auto r1 = __builtin_amdgcn_permlane32_swap(a1, b1, false, false); \
    u32x4 w = {r0[0], r1[0], r0[1], r1[1]}; OUT = *reinterpret_cast<bf16x8*>(&w); } while (0)
    PK4(p0, 0, pa0); PK4(p0, 8, pa1); PK4(p1, 0, pa2); PK4(p1, 8, pa3);
#undef PK4
}
template <int DQK> __device__ __forceinline__ void qkt(f32x16& p0, f32x16& p1, const char* Ks, int rowA, int rowB, const bf16x8* qr, const f32x16& negm, int hi) {
#pragma unroll
    for (int d0 = 0; d0 < DQK / 16; ++d0) { const int cb = (d0 * 16 + hi * 8) * 2;
        const bf16x8 b0 = *reinterpret_cast<const bf16x8*>(Ks + KSWZ(rowA, cb));
        const bf16x8 b1 = *reinterpret_cast<const bf16x8*>(Ks + KSWZ(rowB, cb));
        if (d0 == 0) { p0 = __builtin_amdgcn_mfma_f32_32x32x16_bf16(b0, qr[0], negm, 0, 0, 0); p1 = __builtin_amdgcn_mfma_f32_32x32x16_bf16(b1, qr[0], negm, 0, 0, 0); }
        else { p0 = __builtin_amdgcn_mfma_f32_32x32x16_bf16(b0, qr[d0], p0, 0, 0, 0); p1 = __builtin_amdgcn_mfma_f32_32x32x16_bf16(b1, qr[d0], p1, 0, 0, 0); } }
}

struct UnitArgs {
    const bf16_t* Q; int ldq; int qcol;
    const bf16_t* K; int ldk; int kcol;
    const bf16_t* V; int vcol;
    bf16_t* O; int ocol;
    int q0;
    int ctx0, loc0;
    int NT;
    int masked;
    int band, krow0;
    const float* bias;
    float C;
};

__device__ __forceinline__ void na_mask(f32x16& p0, f32x16& p1, const LAS float* bt, const LAS float* mk, int krA, int qrow, int qc, int kc0, int hi) {
    const int rs = min(max(qrow - 4, 0), 24);
    const int drA = ((krA >= rs) && (krA < rs + 8)) ? (krA - qrow + 7) : 15, drB = ((krA + 1 >= rs) && (krA + 1 < rs + 8)) ? (krA + 1 - qrow + 7) : 15;
    const LAS float* bA = bt + drA * 128 + (kc0 + 4 * hi - qc + 64); const LAS float* bB = bt + drB * 128 + (kc0 + 4 * hi - qc + 64);
    const LAS float* mq = mk + qc * 64 + kc0 + 4 * hi;
#pragma unroll
    for (int g = 0; g < 4; ++g) {
        const f32x4 m0 = *(const LAS f32x4*)(mq + 8 * g);
#pragma unroll
        for (int j = 0; j < 4; ++j) { p0[4 * g + j] = (p0[4 * g + j] + bA[8 * g + j]) + m0[j]; p1[4 * g + j] = (p1[4 * g + j] + bB[8 * g + j]) + m0[j]; }
    }
}
__device__ __forceinline__ void na_mask_table(char* lds) {
    LAS float* mk = (LAS float*)(lds + LDS_MASK);
    int t0 = threadIdx.x; asm volatile("" : "+v"(t0));
    for (int i = t0; i < 64 * 64; i += 512) { const int qc = i >> 6, kc = i & 63, cs = min(max(qc - 8, 0), 48); mk[i] = ((unsigned)(kc - cs) < 16u) ? 0.f : -1e30f; }
}

template <int DQK>
__device__ __forceinline__ void attn_unit(const UnitArgs& A, char* lds) {
    int tid = threadIdx.x; asm volatile("" : "+v"(tid));
    const int wid = tid >> 6, lane = tid & 63, r32 = lane & 31, hi = lane >> 5;
    char* V_lds = lds + LDS_VOFF; char* K_lds = lds + LDS_KOFF;
    float* ws = (float*)(lds + LDS_WS) + wid * 64; float* li_l = ws; float* al_l = ws + 32;
    const LAS float* bt = (const LAS float*)(lds + LDS_BIAS); const LAS float* mk = (const LAS float*)(lds + LDS_MASK);
    const float C = A.C, THR2 = 8.0f * 1.4426950408889634f;
    const bool msk = (DQK == 64) && A.masked;
    float m_reg = 0.f, l_reg = 0; f32x16 o[2] = {}; bf16x8 qr[DQK / 16]; f32x16 negm = f32x16{};
    if (msk) { for (int i = tid; i < 16 * 128; i += 512) { const int dr = i >> 7, d = (i & 127) - 64;
            ((LAS float*)(lds + LDS_BIAS))[i] = (dr == 15) ? -1e30f : ((d >= -15 && d <= 15) ? A.bias[dr * 31 + d + 15] * 1.4426950408889634f : 0.f); } }
    const int qrow = 4 * A.band + 2 * (wid >> 2) + (r32 >> 4), qc = 16 * (wid & 3) + (r32 & 15);
    const int kc0 = msk ? min(max(16 * (wid & 3) - 8, 0), 32) : 0;
    const int qtok = msk ? (A.q0 + 64 * (2 * (wid >> 2) + (r32 >> 4)) + qc) : (A.q0 + wid * QBLK + r32);
    const bf16_t* Qw = A.Q + (size_t)qtok * A.ldq + A.qcol + hi * 8;
#pragma unroll
    for (int d0 = 0; d0 < DQK / 16; ++d0) { const u32x4 w = *reinterpret_cast<const u32x4*>(Qw + d0 * 16);
        u32x4 t; t.x = cvt_pk_bf16(bf_lo(w.x) * C, bf_hi(w.x) * C); t.y = cvt_pk_bf16(bf_lo(w.y) * C, bf_hi(w.y) * C); t.z = cvt_pk_bf16(bf_lo(w.z) * C, bf_hi(w.z) * C); t.w = cvt_pk_bf16(bf_lo(w.w) * C, bf_hi(w.w) * C);
        qr[d0] = *reinterpret_cast<bf16x8*>(&t); }
    constexpr int CPR = DQK / 8;
    const int v0key = tid >> 3, vc = (tid & 7) * 8, vst0 = v_st(v0key, vc), vst1 = 8192 + vst0;
    const int k0key = tid / CPR, k0c = tid % CPR, k1id = tid + 512, k1key = k1id / CPR, k1c = k1id % CPR;
    const int vbS = (int)(uintptr_t)V_lds + v_rd_base(lane, 0);
    const int vbM = (int)(uintptr_t)V_lds + v_rd_base(lane, kc0 >> 3);
    bf16x8 sv0, sv1 = {}, sk0, sk1 = {};
#define LOCAL(t) (msk && (t) >= 4)
#define TROW(t) (((t) < 4) ? (A.ctx0 + 64 * (t)) : (A.loc0 + (msk ? 128 : 64) * ((t) - 4)))
#define K1ON(t) ((DQK == 96) ? (tid < 256) : LOCAL(t))
#define SLOAD(t) do { const int _r0 = TROW(t); sv0 = *reinterpret_cast<const bf16x8*>(A.V + (size_t)(_r0 + v0key) * 512 + A.vcol + vc); \
        sk0 = *reinterpret_cast<const bf16x8*>(A.K + (size_t)(_r0 + k0key) * A.ldk + A.kcol + k0c * 8); \
        if (K1ON(t)) sk1 = *reinterpret_cast<const bf16x8*>(A.K + (size_t)(_r0 + k1key) * A.ldk + A.kcol + k1c * 8); \
        if (LOCAL(t)) sv1 = *reinterpret_cast<const bf16x8*>(A.V + (size_t)(_r0 + 64 + v0key) * 512 + A.vcol + vc); } while (0)
#define SWRITE(b, t) do { *reinterpret_cast<bf16x8*>(V_lds + (b) * SHM_V + vst0) = sv0; *reinterpret_cast<bf16x8*>(K_lds + (b) * SHM_K + KSWZ(k0key, k0c * 16)) = sk0; \
        if (K1ON(t)) *reinterpret_cast<bf16x8*>(K_lds + (b) * SHM_K + KSWZ(k1key, k1c * 16)) = sk1; \
        if (LOCAL(t)) *reinterpret_cast<bf16x8*>(V_lds + (b) * SHM_V + vst1) = sv1; } while (0)
#define RESC(a) do { if (__any((a) < 1.f)) { if (hi == 0) al_l[r32] = (a); asm volatile("s_waitcnt lgkmcnt(0)" ::: "memory"); \
        _Pragma("unroll") for (int d = 0; d < 2; ++d) _Pragma("unroll") for (int r = 0; r < 16; ++r) o[d][r] *= al_l[crow(r, hi)]; } } while (0)
#define QKT(P0, P1, b, t) do { const int _ra = LOCAL(t) ? (kc0 + r32) : r32, _rb = LOCAL(t) ? (64 + kc0 + r32) : (32 + r32); \
        qkt<DQK>(P0, P1, K_lds + (b) * SHM_K, _ra, _rb, qr, negm, hi); if (LOCAL(t)) na_mask(P0, P1, bt, mk, A.krow0 + 2 * ((t) - 4), qrow, qc, kc0, hi); } while (0)
#define PV(b, t) do { const int _va = (LOCAL(t) ? vbM : vbS) + (b) * SHM_V, _vb = _va + (LOCAL(t) ? 8192 : 4096); pv_all(o, _va, _vb, pa0, pa1, pa2, pa3); } while (0)
    f32x16 pA0, pA1, pB0, pB1; float alA, alB; bf16x8 pa0, pa1, pa2, pa3; const int NT = A.NT;
    SLOAD(0); SWRITE(0, 0); __syncthreads();
    QKT(pA0, pA1, 0, 0); partialSM<true>(pA0, pA1, m_reg, alA, negm, THR2);
    SLOAD(1); SWRITE(1, 1); __syncthreads();
    for (int j = 1; j + 1 < NT; j += 2) {
        SBAR(); QKT(pB0, pB1, 1, j);
        finishSM(pA0, pA1, alA, l_reg, pa0, pa1, pa2, pa3); SBAR();
        SLOAD(j + 1); SBAR();
        PV(0, j - 1); partialSM<false>(pB0, pB1, m_reg, alB, negm, THR2);
        __syncthreads(); SWRITE(0, j + 1);
        RESC(alB); __syncthreads();
        SBAR(); QKT(pA0, pA1, 0, j + 1);
        finishSM(pB0, pB1, alB, l_reg, pa0, pa1, pa2, pa3); SBAR();
        SLOAD(j + 2); SBAR();
        PV(1, j); partialSM<false>(pA0, pA1, m_reg, alA, negm, THR2);
        __syncthreads(); SWRITE(1, j + 2);
        RESC(alA); __syncthreads();
    }
    SBAR(); QKT(pB0, pB1, 1, NT - 1);
    finishSM(pA0, pA1, alA, l_reg, pa0, pa1, pa2, pa3); SBAR();
    PV(0, NT - 2); partialSM<false>(pB0, pB1, m_reg, alB, negm, THR2);
    __syncthreads(); RESC(alB);
    finishSM(pB0, pB1, alB, l_reg, pa0, pa1, pa2, pa3); SBAR();
    PV(1, NT - 1);
    if (hi == 0) li_l[r32] = l_reg; asm volatile("s_waitcnt lgkmcnt(0)" ::: "memory");
    float rli[16];
#pragma unroll
    for (int r = 0; r < 16; ++r) rli[r] = __builtin_amdgcn_rcpf(li_l[crow(r, hi)]);
    bf16_t* stg = (bf16_t*)(lds + LDS_OST) + wid * 2048;
#pragma unroll
    for (int r = 0; r < 16; ++r) { const int orow = crow(r, hi);
#pragma unroll
        for (int d0 = 0; d0 < 2; ++d0) { const unsigned w = cvt_pk_bf16(o[d0][r] * rli[r], 0.f); stg[orow * 64 + d0 * 32 + r32] = (bf16_t)(w & 0xffffu); } }
    asm volatile("s_waitcnt lgkmcnt(0)" ::: "memory");
#pragma unroll
    for (int i = 0; i < 4; ++i) { const int row = i * 8 + (lane >> 3), ch = lane & 7; const u32x4 v = *(const u32x4*)(stg + row * 64 + ch * 8);
        const int otok = msk ? (A.q0 + 64 * (2 * (wid >> 2) + (row >> 4)) + 16 * (wid & 3) + (row & 15)) : (A.q0 + wid * QBLK + row);
#if MRG_F8
        { u32x2 o8; o8.x = cvt_pk4_fp8(bf_lo(v.x) * F8_SO, bf_hi(v.x) * F8_SO, bf_lo(v.y) * F8_SO, bf_hi(v.y) * F8_SO); o8.y = cvt_pk4_fp8(bf_lo(v.z) * F8_SO, bf_hi(v.z) * F8_SO, bf_lo(v.w) * F8_SO, bf_hi(v.w) * F8_SO);
          *(u32x2*)((unsigned char*)A.O + (size_t)otok * 512 + A.ocol + ch * 8) = o8; } }
#else
        *(u32x4*)(A.O + (size_t)otok * 512 + A.ocol + ch * 8) = v; }
#endif
    __syncthreads();
#undef LOCAL
#undef TROW
#undef K1ON
#undef SLOAD
#undef SWRITE
#undef RESC
#undef QKT
#undef PV
}
#undef KSWZ
#undef SBAR
}
struct Frame {
    LAS unsigned char* lds;
    int tid, lane, wave, vcu, G;
};
#define CAS __attribute__((address_space(4)))
__device__ __forceinline__ const CAS char* karg() { return (const CAS char*)__builtin_amdgcn_kernarg_segment_ptr(); }
template <int I> __device__ __forceinline__ const float* in_ptr() { unsigned off = I * 8; asm volatile("" : "+s"(off)); return *(const float* const CAS*)(karg() + off); }
__device__ __forceinline__ float* out_ptr() { unsigned off = 26 * 8; asm volatile("" : "+s"(off)); return *(float* const CAS*)(karg() + off); }
__device__ __forceinline__ unsigned char* ws_ptr() { unsigned off = 27 * 8; asm volatile("" : "+s"(off)); return *(unsigned char* const CAS*)(karg() + off); }
enum { I_X = 0, I_C, I_CTX, I_CCTX, I_WADA, I_BADA, I_NMIXG, I_NFFNG, I_WIN, I_NAQG, I_NAKG, I_RPB, I_CQG, I_WUQ, I_CKVG, I_WUKV, I_QG, I_KG, I_WOA, I_WOB, I_WOUT, I_WR, I_RB, I_W1, I_W3, I_W2 };

#define LDS_WAIT() asm volatile("s_waitcnt lgkmcnt(0)" ::: "memory")

__device__ __forceinline__ int win_src_col(int np) {
    const int pn = np >> 8, cc = np & 255;
    if (pn < 4) { const int part = pn >> 1, tq = pn & 1, bj = cc >> 7, wc = (cc >> 5) & 3, i = cc & 31; return part * 512 + (4 * tq + wc) * 64 + 32 * bj + i; }
    if (pn < 6) return 1024 + (pn - 4) * 256 + cc;
    if (pn == 6) return 1536 + cc;
    if (pn == 7) return cc < 128 ? 1792 + cc : (cc < 160 ? 2176 + (cc - 128) : -1);
    if (pn == 8) return 1920 + cc;
    return 2208 + (pn - 9) * 256 + cc;
}
template <bool F8 = false>
__device__ __forceinline__ void conv_item(const float* src, size_t ld, int dcol, int dstep, const float* gain, bf16_t* WT, int K, int k0, int n0, LAS float* scr, int lane) {
    const int kr = lane >> 4;
    f32x4 v[16];
#pragma unroll
    for (int i = 0; i < 16; ++i) { v[i] = (f32x4){0.f, 0.f, 0.f, 0.f}; if (src) v[i] = __builtin_nontemporal_load((const f32x4*)(src + (size_t)(k0 + 4 * i + kr) * ld)); }
#pragma unroll
    for (int i = 0; i < 16; ++i) { const int kk = 4 * i + kr;
        if (gain) v[i] = v[i] * gain[k0 + kk];
        LAS float* s = scr + kk * 65 + dcol; s[0] = v[i][0]; s[dstep] = v[i][1]; s[2 * dstep] = v[i][2]; s[3 * dstep] = v[i][3]; }
    LDS_WAIT(); asm volatile("" ::: "memory");
    const int c = lane & 7;
#pragma unroll
    for (int j = 0; j < 8; ++j) { const int n = (lane >> 3) + 8 * j; const LAS float* s = scr + (8 * c) * 65 + n;
        if (F8) { u32x2 o; o.x = cvt_pk4_fp8(s[0 * 65] * F8_SW, s[1 * 65] * F8_SW, s[2 * 65] * F8_SW, s[3 * 65] * F8_SW); o.y = cvt_pk4_fp8(s[4 * 65] * F8_SW, s[5 * 65] * F8_SW, s[6 * 65] * F8_SW, s[7 * 65] * F8_SW);
            *(u32x2*)((unsigned char*)WT + (size_t)(n0 + n) * K + k0 + 8 * c) = o; }
        else { u32x4 o; o.x = cvt_pk_bf16(s[0 * 65], s[1 * 65]); o.y = cvt_pk_bf16(s[2 * 65], s[3 * 65]); o.z = cvt_pk_bf16(s[4 * 65], s[5 * 65]); o.w = cvt_pk_bf16(s[6 * 65], s[7 * 65]);
            *(u32x4*)(WT + (size_t)(n0 + n) * K + k0 + 8 * c) = o; } }
    LDS_WAIT(); asm volatile("" ::: "memory");
}
__device__ __forceinline__ void p0_convert(Frame& F) {
    LAS float* scr = (LAS float*)(F.lds + F.wave * 16640);
    const int gw = F.vcu * 8 + F.wave, NGW = F.G * 8, lane = F.lane, q16 = lane & 15;
    constexpr int I_IN = 16 * 68, I_UQ = 6 * 16, I_UKV = 4 * 16, I_OA = 8 * 16, I_OUT = 16 * 16, I_13 = 16 * 32 * NEXP, I_2 = 16 * 16 * NEXP;
    constexpr int PER_L = I_IN + I_UQ + I_UKV + 2 * I_OA + I_OUT + I_13 + I_2;
    unsigned char* const ws = ws_ptr();
    for (int it = gw; it < NLAYER * PER_L; it += NGW) {
        const int l = it / PER_L; int r = it - l * PER_L;
        if (r < I_IN) { const int kb = r / 68, nb = r % 68, sc = win_src_col(nb * 64 + 4 * q16);
#if A2_F8
            if ((kb ^ nb) & 1) continue;
            { const float* const sp = sc >= 0 ? in_ptr<I_WIN>() + (size_t)l * DM * INC + sc : nullptr; bf16_t* const wt8 = (bf16_t*)(ws + WS_WIN + (size_t)l * INP * DM); const int k0 = (kb & ~1) * 64;
              conv_item<true>(sp, INC, 4 * q16, 1, nullptr, wt8, DM, k0, nb * 64, scr, lane); conv_item<true>(sp, INC, 4 * q16, 1, nullptr, wt8, DM, k0 + 64, nb * 64, scr, lane); }
#else
            conv_item(sc >= 0 ? in_ptr<I_WIN>() + (size_t)l * DM * INC + sc : nullptr, INC, 4 * q16, 1, nullptr, (bf16_t*)(ws + WS_WIN) + (size_t)l * INP * DM, DM, kb * 64, nb * 64, scr, lane);
#endif
            continue; } r -= I_IN;
        if (r < I_UQ) { const int kb = r / 16, nb = r % 16, np = nb * 64 + 4 * q16, hh = np >> 7, dd = np & 127;
            conv_item(dd < QKD ? in_ptr<I_WUQ>() + (size_t)l * QLORA * 768 + hh * QKD + dd : nullptr, 768, 4 * q16, 1, in_ptr<I_CQG>() + l * QLORA, (bf16_t*)(ws + WS_WUQ) + (size_t)l * 1024 * QLORA, QLORA, kb * 64, nb * 64, scr, lane); continue; } r -= I_UQ;
        if (r < I_UKV) { const int kb = r / 16, nb = r % 16;
            conv_item(in_ptr<I_WUKV>() + (size_t)l * KVLORA * 1024 + nb * 64 + 4 * q16, 1024, 4 * q16, 1, in_ptr<I_CKVG>() + l * KVLORA, (bf16_t*)(ws + WS_WUKV) + (size_t)l * 1024 * KVLORA, KVLORA, kb * 64, nb * 64, scr, lane); continue; } r -= I_UKV;
        if (r < 2 * I_OA) { const int w = r / I_OA, rr = r % I_OA, kb = rr / 16, nb = rr % 16;
#if MRG_F8
            if ((kb ^ nb) & 1) continue;
            { const float* const sp = (w ? in_ptr<I_WOB>() : in_ptr<I_WOA>()) + (size_t)l * 512 * DM + nb * 64 + 4 * q16; bf16_t* const wt8 = (bf16_t*)(ws + (w ? WS_WOB : WS_WOA) + (size_t)l * 1024 * 512); const int k0 = (kb & ~1) * 64;
              conv_item<true>(sp, DM, 4 * q16, 1, nullptr, wt8, 512, k0, nb * 64, scr, lane); conv_item<true>(sp, DM, 4 * q16, 1, nullptr, wt8, 512, k0 + 64, nb * 64, scr, lane); }
#else
            conv_item((w ? in_ptr<I_WOB>() : in_ptr<I_WOA>()) + (size_t)l * 512 * DM + nb * 64 + 4 * q16, DM, 4 * q16, 1, nullptr, (bf16_t*)(ws + (w ? WS_WOB : WS_WOA)) + (size_t)l * 1024 * 512, 512, kb * 64, nb * 64, scr, lane);
#endif
            continue; } r -= 2 * I_OA;
        if (r < I_OUT) { const int kb = r / 16, nb = r % 16;
#if C2_F8
            if ((kb ^ nb) & 1) continue;
            { const float* const sp = in_ptr<I_WOUT>() + (size_t)l * DM * DM + nb * 64 + 4 * q16; bf16_t* const wt8 = (bf16_t*)(ws + WS_WOUT + (size_t)l * DM * DM); const int k0 = (kb & ~1) * 64;
              conv_item<true>(sp, DM, 4 * q16, 1, nullptr, wt8, DM, k0, nb * 64, scr, lane); conv_item<true>(sp, DM, 4 * q16, 1, nullptr, wt8, DM, k0 + 64, nb * 64, scr, lane); }
#else
            conv_item(in_ptr<I_WOUT>() + (size_t)l * DM * DM + nb * 64 + 4 * q16, DM, 4 * q16, 1, nullptr, (bf16_t*)(ws + WS_WOUT) + (size_t)l * DM * DM, DM, kb * 64, nb * 64, scr, lane);
#endif
            continue; } r -= I_OUT;
        if (r < I_13) { const int e = r / 512, rr = r % 512, kb = rr / 32, nb = rr % 32;
            const float* base = ((q16 < 8) ? in_ptr<I_W1>() : in_ptr<I_W3>()) + ((size_t)l * NEXP + e) * DM * DM + nb * 32 + 4 * (q16 & 7);
            bf16_t* const wt = (bf16_t*)(ws + WS_W13) + ((size_t)l * NEXP) * 2048 * DM;
            if (F8LAYER(l)) { if ((kb ^ (e >> 2)) & 1) continue;
                const int k0 = (kb & ~1) * 64;
                conv_item<true>(base, DM, 8 * (q16 & 7) + (q16 >> 3), 2, nullptr, (bf16_t*)((unsigned char*)wt + (size_t)e * 2048 * DM), DM, k0, nb * 64, scr, lane);
                conv_item<true>(base, DM, 8 * (q16 & 7) + (q16 >> 3), 2, nullptr, (bf16_t*)((unsigned char*)wt + (size_t)e * 2048 * DM), DM, k0 + 64, nb * 64, scr, lane); }
            else conv_item(base, DM, 8 * (q16 & 7) + (q16 >> 3), 2, nullptr, wt + (size_t)e * 2048 * DM, DM, kb * 64, nb * 64, scr, lane);
            continue; } r -= I_13;
        { const int e = r / 256, rr = r % 256, kb = rr / 16, nb = rr % 16;
            const float* const src2 = in_ptr<I_W2>() + ((size_t)l * NEXP + e) * DM * DM + nb * 64 + 4 * q16; bf16_t* const wt = (bf16_t*)(ws + WS_W2) + ((size_t)l * NEXP) * DM * DM;
            if (F8LAYER(l)) { if ((kb ^ (e >> 3)) & 1) continue; const int k0 = (kb & ~1) * 64;
                conv_item<true>(src2, DM, 4 * q16, 1, nullptr, (bf16_t*)((unsigned char*)wt + (size_t)e * DM * DM), DM, k0, nb * 64, scr, lane);
                conv_item<true>(src2, DM, 4 * q16, 1, nullptr, (bf16_t*)((unsigned char*)wt + (size_t)e * DM * DM), DM, k0 + 64, nb * 64, scr, lane); }
            else conv_item(src2, DM, 4 * q16, 1, nullptr, wt + (size_t)e * DM * DM, DM, kb * 64, nb * 64, scr, lane); }
    }
}
__device__ __forceinline__ void p0_ada(Frame& F) {
    if ((int)blockIdx.x >= 2 * 96) return;
    unsigned char* const ws = ws_ptr(); const float* const cin = in_ptr<I_C>(); const float* const cctx = in_ptr<I_CCTX>(); const float* const wada = in_ptr<I_WADA>(); const float* const bada = in_ptr<I_BADA>();
    LAS float* sct = (LAS float*)F.lds;
    LAS float* red = (LAS float*)(F.lds + 1024 * 20 * 4);
    for (int idx = F.tid; idx < 17 * 1024; idx += 512) { const int r = idx >> 10, d = idx & 1023; const float v = (r < 16) ? cin[r * DM + d] : cctx[d]; sct[d * 20 + r] = v * (1.0f / (1.0f + expf(-v))); }
    __syncthreads();
    float* MOD = (float*)(ws + WS_MOD);
    for (int task = blockIdx.x; task < 2 * 96; task += F.G) {
        const int l = task / 96, cb = task % 96, col = cb * 64 + F.lane;
        const float* wa = wada + (size_t)l * DM * NMODC + col;
        float acc[17];
#pragma unroll
        for (int r = 0; r < 17; ++r) acc[r] = 0.f;
        for (int k = F.wave * 128; k < F.wave * 128 + 128; ++k) { const float wv = wa[(size_t)k * NMODC];
#pragma unroll
            for (int r = 0; r < 17; ++r) acc[r] += sct[k * 20 + r] * wv; }
#pragma unroll
        for (int r = 0; r < 17; ++r) red[(F.wave * 17 + r) * 64 + F.lane] = acc[r];
        __syncthreads();
        for (int idx = F.tid; idx < 17 * 64; idx += 512) { const int r = idx >> 6, cl = idx & 63; float s = bada[l * NMODC + cb * 64 + cl];
#pragma unroll
            for (int w = 0; w < 8; ++w) s += red[(w * 17 + r) * 64 + cl];
            MOD[((size_t)l * 17 + r) * NMODC + cb * 64 + cl] = s; }
        __syncthreads();
    }
    if (blockIdx.x == 0) { float* rope = (float*)(ws + WS_ROPE); const int pos = F.tid >> 3, i = F.tid & 7;
        const float inv = exp2f(-(float)i * 0.125f * 13.287712379549449f);
        const float ang = (float)pos * inv; const float rev = ang * 0.15915494309189535f, fr = rev - floorf(rev); rope[pos * 8 + i] = __builtin_amdgcn_cosf(fr); rope[512 + pos * 8 + i] = __builtin_amdgcn_sinf(fr); }
}

__device__ __forceinline__ void load_row(const float* xrow, int lane, f32x4 (&v)[4]) {
#pragma unroll
    for (int j = 0; j < 4; ++j) v[j] = *((const f32x4*)xrow + lane + 64 * j);
}
__device__ __forceinline__ void load_xrow(const unsigned char* ws, const float* xcur, int t, int lane, f32x4 (&v)[4]) {
#if XRES_BF16
    const u32x2* r = (const u32x2*)((const bf16_t*)(ws + WS_XB) + (size_t)t * DM);
#pragma unroll
    for (int j = 0; j < 4; ++j) { const u32x2 w = r[lane + 64 * j]; v[j] = (f32x4){bf_lo(w.x), bf_hi(w.x), bf_lo(w.y), bf_hi(w.y)}; }
#else
    load_row((t < TX) ? xcur + (size_t)t * DM : (const float*)(ws + WS_XC) + (size_t)(t - TX) * DM, lane, v);
#endif
}
__device__ __forceinline__ float row_rstd(const f32x4 (&v)[4]) {
    float s = 0.f;
#pragma unroll
    for (int j = 0; j < 4; ++j) s += (v[j][0] * v[j][0] + v[j][1] * v[j][1]) + (v[j][2] * v[j][2] + v[j][3] * v[j][3]);
    return rsqrtf(wave_sum(s) * (1.0f / DM) + RMS_EPS);
}
__device__ __forceinline__ void normmod(const f32x4 (&v)[4], float rstd, const float* g, const float* sh, const float* sc, int lane, f32x4 (&h)[4]) {
#pragma unroll
    for (int j = 0; j < 4; ++j) { const f32x4 gv = *((const f32x4*)g + lane + 64 * j), shv = *((const f32x4*)sh + lane + 64 * j), scv = *((const f32x4*)sc + lane + 64 * j);
        h[j] = v[j] * rstd * gv * (scv + 1.0f) + shv; }
}
__device__ __forceinline__ void store_row_h(unsigned char* Hb, int t, int lane, const f32x4 (&h)[4]) {
#if A2_F8
#pragma unroll
    for (int j = 0; j < 4; ++j) *((unsigned*)(Hb + (size_t)t * DM) + lane + 64 * j) = cvt_pk4_fp8(h[j][0] * F8_SH, h[j][1] * F8_SH, h[j][2] * F8_SH, h[j][3] * F8_SH);
#else
#pragma unroll
    for (int j = 0; j < 4; ++j) { u32x2 w; w.x = cvt_pk_bf16(h[j][0], h[j][1]); w.y = cvt_pk_bf16(h[j][2], h[j][3]); *((u32x2*)((bf16_t*)Hb + (size_t)t * DM) + lane + 64 * j) = w; }
#endif
}
__device__ __forceinline__ void store_row_bf16(bf16_t* orow, int lane, const f32x4 (&h)[4]) {
#pragma unroll
    for (int j = 0; j < 4; ++j) { u32x2 w; w.x = cvt_pk_bf16(h[j][0], h[j][1]); w.y = cvt_pk_bf16(h[j][2], h[j][3]); *((u32x2*)orow + lane + 64 * j) = w; }
}
__device__ __forceinline__ void p0_hrows(Frame& F) {
    unsigned char* const ws = ws_ptr(); const float* const xin = in_ptr<I_X>(); const float* const cxin = in_ptr<I_CTX>(); const float* const gmix = in_ptr<I_NMIXG>();
    const int gw = F.vcu * 8 + F.wave, NGW = F.G * 8; const float* MOD = (const float*)(ws + WS_MOD); bf16_t* H = (bf16_t*)(ws + WS_H);
    for (int t = gw; t < TALL; t += NGW) {
        const float* xr = (t < TX) ? xin + (size_t)t * DM : cxin + (size_t)(t - TX) * DM;
        const float* md = MOD + (size_t)((t < TX) ? (t >> 11) : 16) * NMODC;
        f32x4 v[4], h[4]; load_row(xr, F.lane, v); const float rstd = row_rstd(v);
        normmod(v, rstd, gmix, md, md + DM, F.lane, h); store_row_h((unsigned char*)H, t, F.lane, h);
    }
}
__device__ __forceinline__ void stats_phase(Frame& F, int ntok) {
    unsigned char* const ws = ws_ptr();
    const int gw = F.vcu * 8 + F.wave, NGW = F.G * 8, lane = F.lane;
    const bf16_t* ZCQ = (const bf16_t*)(ws + WS_ZCQ); const bf16_t* ZCKV = (const bf16_t*)(ws + WS_ZCKV); const bf16_t* ZKR = (const bf16_t*)(ws + WS_ZKR);
    float* RSCQ = (float*)(ws + WS_RSCQ); float* RSCKV = (float*)(ws + WS_RSCKV); float* SSKR = (float*)(ws + WS_SSKR);
    for (int t = gw; t < ntok; t += NGW) {
        float a = 0.f, b = 0.f, c = 0.f;
        if (lane < 48) { const u32x4 w = *(const u32x4*)(ZCQ + (size_t)t * QLORA + 8 * lane); a = (bf_lo(w.x) * bf_lo(w.x) + bf_hi(w.x) * bf_hi(w.x)) + (bf_lo(w.y) * bf_lo(w.y) + bf_hi(w.y) * bf_hi(w.y)) + (bf_lo(w.z) * bf_lo(w.z) + bf_hi(w.z) * bf_hi(w.z)) + (bf_lo(w.w) * bf_lo(w.w) + bf_hi(w.w) * bf_hi(w.w)); }
        if (lane < 32) { const u32x4 w = *(const u32x4*)(ZCKV + (size_t)t * KVLORA + 8 * lane); b = (bf_lo(w.x) * bf_lo(w.x) + bf_hi(w.x) * bf_hi(w.x)) + (bf_lo(w.y) * bf_lo(w.y) + bf_hi(w.y) * bf_hi(w.y)) + (bf_lo(w.z) * bf_lo(w.z) + bf_hi(w.z) * bf_hi(w.z)) + (bf_lo(w.w) * bf_lo(w.w) + bf_hi(w.w) * bf_hi(w.w)); }
        if (lane < 4) { const u32x4 w = *(const u32x4*)(ZKR + (size_t)t * ROPED + 8 * lane); c = (bf_lo(w.x) * bf_lo(w.x) + bf_hi(w.x) * bf_hi(w.x)) + (bf_lo(w.y) * bf_lo(w.y) + bf_hi(w.y) * bf_hi(w.y)) + (bf_lo(w.z) * bf_lo(w.z) + bf_hi(w.z) * bf_hi(w.z)) + (bf_lo(w.w) * bf_lo(w.w) + bf_hi(w.w) * bf_hi(w.w)); }
        a = wave_sum(a); b = wave_sum(b); c = wave_sum(c);
        if (lane == 0) { RSCQ[t] = rsqrtf(a * (1.0f / QLORA) + RMS_EPS); RSCKV[t] = rsqrtf(b * (1.0f / KVLORA) + RMS_EPS); SSKR[t] = c; }
    }
}

__device__ __forceinline__ void route_phase(Frame& F, int l, int ntok) {
    unsigned char* const ws = ws_ptr(); const float* const xcur = out_ptr();
    constexpr int HP = DM + 4;
    LAS float* h2t = (LAS float*)F.lds;
    LAS float* part = (LAS float*)(F.lds + 66560);
    LAS float* logit = (LAS float*)(F.lds + 66560 + 32768);
    const float* MOD = (const float*)(ws + WS_MOD) + (size_t)l * 17 * NMODC;
    const float* g = in_ptr<I_NFFNG>() + l * DM; const float* wr = in_ptr<I_WR>(); const float rbias = in_ptr<I_RB>()[F.lane];
    int* TOKE = (int*)(ws + WS_TOKE); float* TOKW = (float*)(ws + WS_TOKW); int* TOKP = (int*)(ws + WS_TOKP); float* RSTD2 = (float*)(ws + WS_RSTD2);
    unsigned* cnt = (unsigned*)(ws + WS_CTL) + CW_CNT + l * 2048;
    const int lane = F.lane, w = F.wave;
    float wv[32][4];
#pragma unroll
    for (int s_ = 0; s_ < 32; ++s_)
#pragma unroll
        for (int j = 0; j < 4; ++j) wv[s_][j] = wr[(w * 128 + 4 * s_ + (lane >> 4)) * NEXP + 16 * j + (lane & 15)];
    for (int it = blockIdx.x; it < ntok / 16; it += F.G) {
        const int T0 = it * 16;
#pragma unroll
        for (int tt = 0; tt < 2; ++tt) { const int tl = 2 * w + tt, t = T0 + tl;
            const float* md = MOD + (size_t)((t < TX) ? (t >> 11) : 16) * NMODC;
            f32x4 v[4], h[4]; load_xrow(ws, xcur, t, lane, v); const float rstd = row_rstd(v); if (lane == 0) RSTD2[(t >> 4) * 32 + (t & 15)] = rstd;
            normmod(v, rstd, g, md + 3 * DM, md + 4 * DM, lane, h);
#pragma unroll
            for (int j = 0; j < 4; ++j) *(LAS f32x4*)(h2t + tl * HP + 4 * lane + 256 * j) = h[j];
        }
        __syncthreads();
        { f32x4 acc[4];
#pragma unroll
          for (int j = 0; j < 4; ++j) acc[j] = (f32x4){0.f, 0.f, 0.f, 0.f};
          const LAS float* ha = h2t + (lane & 15) * HP + w * 128 + (lane >> 4);
#pragma unroll
          for (int s_ = 0; s_ < 32; ++s_) { const float a = ha[4 * s_];
#pragma unroll
              for (int j = 0; j < 4; ++j) acc[j] = __builtin_amdgcn_mfma_f32_16x16x4f32(a, wv[s_][j], acc[j], 0, 0, 0); }
#pragma unroll
          for (int j = 0; j < 4; ++j)
#pragma unroll
              for (int q = 0; q < 4; ++q) part[(w * 16 + 4 * (lane >> 4) + q) * 64 + 16 * j + (lane & 15)] = acc[j][q]; }
        __syncthreads();
#pragma unroll
        for (int k = 0; k < 2; ++k) { const int idx = F.tid + 512 * k, t = idx >> 6, e = idx & 63; float s = 0.f;
#pragma unroll
            for (int ww = 0; ww < 8; ++ww) s += part[(ww * 16 + t) * 64 + e];
            logit[t * 64 + e] = s; }
        __syncthreads();
#pragma unroll
        for (int tt = 0; tt < 2; ++tt) { const int tl = 2 * w + tt, t = T0 + tl;
            const float sg = 1.0f / (1.0f + expf(-logit[tl * 64 + lane])); const float bs = sg + rbias;
            float m1 = -3.0e38f, m2 = -3.0e38f; int i1 = 0, i2 = 0;
#pragma unroll
            for (int j = 0; j < 8; ++j) { const float vv = __shfl(bs, (lane & ~7) + j); if (vv > m1) { m2 = m1; i2 = i1; m1 = vv; i1 = j; } else if (vv > m2) { m2 = vv; i2 = j; } }
            const float gs = m1 + m2; float best = -3.0e38f; int gsel = 0;
#pragma unroll
            for (int j = 0; j < 8; ++j) { const float vv = __shfl(gs, 8 * j); if (vv > best) { best = vv; gsel = j; } }
            const int e1 = gsel * 8 + __shfl(i1, gsel * 8), e2 = gsel * 8 + __shfl(i2, gsel * 8);
            const float s1 = __shfl(sg, e1), s2 = __shfl(sg, e2), inv = 1.0f / (s1 + s2);
            if (lane == 0) { const int p1 = (int)atomicAdd(cnt + e1 * 16, 1u), p2 = (int)atomicAdd(cnt + e2 * 16, 1u);
                TOKE[2 * t] = e1; TOKE[2 * t + 1] = e2; TOKW[2 * t] = s1 * inv; TOKW[2 * t + 1] = s2 * inv; TOKP[2 * t] = p1; TOKP[2 * t + 1] = p2; }
        }
        __syncthreads();
    }
}
__device__ __forceinline__ void expert_offsets(Frame& F, unsigned char* ws, int l, LAS int* offl, bool publish) {
    if (F.wave == 0) {
        const unsigned c = __hip_atomic_load((unsigned*)(ws + WS_CTL) + CW_CNT + l * 2048 + F.lane * 16, RLX_AGENT);
        const int pad = (int)((c + 255u) & ~255u); int incl = pad;
#pragma unroll
        for (int o = 1; o < 64; o <<= 1) { const int v = __shfl_up(incl, o); if (F.lane >= o) incl += v; }
        offl[F.lane] = incl - pad; if (F.lane == 63) offl[64] = incl;
        if (publish) { int* TILEE = (int*)(ws + WS_TILEE); for (int t = (incl - pad) >> 8; t < (incl >> 8); ++t) TILEE[t] = F.lane; if (F.lane == 63) TILEE[511] = incl >> 8; }
    }
    __syncthreads();
}
__device__ __forceinline__ void scatter_phase(Frame& F, int l, int ntok, bool f8) {
    unsigned char* const ws = ws_ptr(); const float* const xcur = out_ptr();
    LAS int* offl = (LAS int*)(F.lds + 1024);
    expert_offsets(F, ws, l, offl, blockIdx.x == 0);
    const int gw = F.vcu * 8 + F.wave, NGW = F.G * 8, lane = F.lane;
    const float* MOD = (const float*)(ws + WS_MOD) + (size_t)l * 17 * NMODC; const float* g = in_ptr<I_NFFNG>() + l * DM;
    const int* TOKE = (const int*)(ws + WS_TOKE); const int* TOKP = (const int*)(ws + WS_TOKP); const float* RSTD2 = (const float*)(ws + WS_RSTD2); bf16_t* HS = (bf16_t*)(ws + WS_HS);
    for (int t = gw; t < ntok; t += NGW) {
        const float* md = MOD + (size_t)((t < TX) ? (t >> 11) : 16) * NMODC;
        f32x4 v[4], h[4]; load_xrow(ws, xcur, t, lane, v); normmod(v, RSTD2[(t >> 4) * 32 + (t & 15)], g, md + 3 * DM, md + 4 * DM, lane, h);
        const int s1 = offl[TOKE[2 * t]] + TOKP[2 * t], s2 = offl[TOKE[2 * t + 1]] + TOKP[2 * t + 1];
        if (f8) {
#pragma unroll
            for (int j = 0; j < 4; ++j) { const unsigned w = cvt_pk4_fp8(h[j][0] * F8_SH, h[j][1] * F8_SH, h[j][2] * F8_SH, h[j][3] * F8_SH);
                *((unsigned*)((unsigned char*)HS + (size_t)s1 * DM) + lane + 64 * j) = w; *((unsigned*)((unsigned char*)HS + (size_t)s2 * DM) + lane + 64 * j) = w; }
        } else { store_row_bf16(HS + (size_t)s1 * DM, lane, h); store_row_bf16(HS + (size_t)s2 * DM, lane, h); }
    }
}
__device__ __forceinline__ void combine_phase(Frame& F, int l, int ntok, bool last) {
    unsigned char* const ws = ws_ptr(); float* const xcur = out_ptr();
    LAS int* offl = (LAS int*)(F.lds + 1024);
    expert_offsets(F, ws, l, offl, false);
    const int gw = F.vcu * 8 + F.wave, NGW = F.G * 8, lane = F.lane;
    const float* MOD = (const float*)(ws + WS_MOD) + (size_t)l * 17 * NMODC; float* XC = (float*)(ws + WS_XC);
    const int* TOKE = (const int*)(ws + WS_TOKE); const int* TOKP = (const int*)(ws + WS_TOKP); const float* TOKW = (const float*)(ws + WS_TOKW);
    const bf16_t* YS = (const bf16_t*)(ws + WS_YS); bf16_t* H = (bf16_t*)(ws + WS_H);
    for (int t = gw; t < ntok; t += NGW) {
        float* xr = (t < TX) ? xcur + (size_t)t * DM : XC + (size_t)(t - TX) * DM; const int bi = (t < TX) ? (t >> 11) : 16; const float* md = MOD + (size_t)bi * NMODC;
        const int s1 = offl[TOKE[2 * t]] + TOKP[2 * t], s2 = offl[TOKE[2 * t + 1]] + TOKP[2 * t + 1]; const float w1 = TOKW[2 * t], w2 = TOKW[2 * t + 1];
        f32x4 v[4]; load_xrow(ws, xcur, t, lane, v);
#pragma unroll
        for (int j = 0; j < 4; ++j) { const u32x2 a = *((const u32x2*)(YS + (size_t)s1 * DM) + lane + 64 * j), b = *((const u32x2*)(YS + (size_t)s2 * DM) + lane + 64 * j);
            const f32x4 gf = *((const f32x4*)(md + 5 * DM) + lane + 64 * j);
            const f32x4 y = (f32x4){bf_lo(a.x), bf_hi(a.x), bf_lo(a.y), bf_hi(a.y)} * w1 + (f32x4){bf_lo(b.x), bf_hi(b.x), bf_lo(b.y), bf_hi(b.y)} * w2;
            v[j] = v[j] + gf * y;
#if XRES_BF16
            if (last) *((f32x4*)xr + lane + 64 * j) = v[j];
            else { u32x2 w; w.x = cvt_pk_bf16(v[j][0], v[j][1]); w.y = cvt_pk_bf16(v[j][2], v[j][3]); *((u32x2*)((bf16_t*)(ws + WS_XB) + (size_t)t * DM) + lane + 64 * j) = w; }
#else
            *((f32x4*)xr + lane + 64 * j) = v[j];
#endif
        }
        if (!last) { const float* md2 = MOD + (size_t)17 * NMODC + (size_t)bi * NMODC; f32x4 h[4]; const float rstd = row_rstd(v);
            normmod(v, rstd, in_ptr<I_NMIXG>() + (l + 1) * DM, md2, md2 + DM, lane, h); store_row_h((unsigned char*)H, t, lane, h); }
    }
}
constexpr int NPHASE = 2 + 11 * NLAYER;
struct Args { const float* in[26]; float* out; unsigned char* ws; int ph_lo, ph_hi; };

__device__ __attribute__((noinline)) void grid_barrier_fn(GAS unsigned* barw, unsigned x, LAS unsigned* st) { XcdBarrier b; b.bar = (unsigned*)barw; b.x = x; b.st = (volatile LAS unsigned*)st; xcd_barrier(b); }

__global__ void __launch_bounds__(512, 2) fwd_kernel(Args args) {
    extern __shared__ __attribute__((aligned(16))) unsigned char lds_raw[];
    Frame F;
    F.lds = (LAS unsigned char*)lds_raw;
    F.tid = threadIdx.x; F.lane = F.tid & 63; F.wave = __builtin_amdgcn_readfirstlane(F.tid >> 6);
    F.G = gridDim.x; { const int bx = blockIdx.x; F.vcu = (F.G % 8 == 0) ? (bx % 8) * (F.G / 8) + bx / 8 : bx; }
    volatile LAS unsigned* MISC = (volatile LAS unsigned*)(F.lds + MISC_OFF);
    if (F.tid < 64) MISC[F.tid] = 0u;
    __syncthreads();
    const int lo = args.ph_lo, hi = args.ph_hi;
#if MK_SPLIT
#define GRID_BAR() do { } while (0)
#else
    XcdBarrier bar = xcd_barrier_post((unsigned*)(ws_ptr() + WS_CTL) + CW_BAR, MISC + 8);
#define GRID_BAR() grid_barrier_fn((GAS unsigned*)bar.bar, bar.x, (LAS unsigned*)bar.st)
#endif
#ifndef PH_MASK
#define PH_MASK 0xFFFFFFFFu
#endif
#define PHK(k) ((k) < 2 ? (k) : 2 + ((k) - 2) % 11)
#define IN(k) (((PH_MASK >> PHK(k)) & 1u) && lo <= (k) && (k) < hi)
#ifndef PH_DUP
#define PH_DUP 0u
#endif
#define REP0(k) for (int rep_ = 0; rep_ < (((PH_DUP >> (k)) & 1u) ? 2 : 1); ++rep_)
#define REPL(n) for (int rep_ = 0; rep_ < ((((PH_DUP >> (2 + (n))) & 1u) && ((n) != 5 || l == 0)) ? 2 : 1); ++rep_)
#ifdef BAR_DUP
#define SEAM(k) do { if (IN(k) && IN((k) + 1)) { for (int b_ = 0; b_ < 1 + BAR_DUP; ++b_) GRID_BAR(); } } while (0)
#else
#define SEAM(k) do { if (IN(k) && IN((k) + 1)) GRID_BAR(); } while (0)
#endif
#define FRESH() Frame Fp = F; int G = F.G, c = (int)blockIdx.x; asm volatile("" : "+v"(Fp.tid), "+v"(Fp.lane)); asm volatile("" : "+s"(Fp.wave), "+s"(Fp.vcu), "+s"(Fp.G), "+s"(G), "+s"(c))

    if (IN(0)) REP0(0) { FRESH(); (void)G; (void)c; p0_convert(Fp); __syncthreads(); p0_ada(Fp); }
    SEAM(0);
    if (IN(1)) REP0(1) { FRESH(); (void)G; (void)c; p0_hrows(Fp); }
    SEAM(1);

    for (int l = 0; l < NLAYER; ++l) {
        const int base = 2 + 11 * l; const bool last = (l == NLAYER - 1);
        const int mt_act = last ? MT_X : MT_ALL;
        const int ntok = last ? TX : TALL;
        if (IN(base + 0)) REPL(0) {
            FRESH(); unsigned char* const ws = ws_ptr();
#if A2_F8
            pg8::SchedRect S{(const char*)(ws + WS_H), (const char*)(ws + WS_WIN + (size_t)l * INP * DM), (size_t)256 * DM, mt_act, 17, G, c, MT_ALL - mt_act, 2, 7};
            pg8::EpiIn E{(bf16_t*)(ws + WS_QA), (bf16_t*)(ws + WS_KA), (bf16_t*)(ws + WS_VA), (bf16_t*)(ws + WS_ZCQ), (bf16_t*)(ws + WS_ZCKV), (bf16_t*)(ws + WS_ZKR), (bf16_t*)(ws + WS_GATES),
                         in_ptr<I_NAQG>() + l * 64, in_ptr<I_NAKG>() + l * 64, (float*)(ws + WS_PART6), (float*)(ws + WS_PART7), (float*)(ws + WS_PART8), 1.0f / (F8_SH * F8_SW)};
            pg8::gemm_phase<true>(Fp.lds, DM / 2, S, E);
#else
            pg8::SchedRect S{(const char*)(ws + WS_H), (const char*)((bf16_t*)(ws + WS_WIN) + (size_t)l * INP * DM), (size_t)256 * DM * 2, mt_act, 17, G, c, MT_ALL - mt_act, 2, 7};
            pg8::EpiIn E{(bf16_t*)(ws + WS_QA), (bf16_t*)(ws + WS_KA), (bf16_t*)(ws + WS_VA), (bf16_t*)(ws + WS_ZCQ), (bf16_t*)(ws + WS_ZCKV), (bf16_t*)(ws + WS_ZKR), (bf16_t*)(ws + WS_GATES),
                         in_ptr<I_NAQG>() + l * 64, in_ptr<I_NAKG>() + l * 64, (float*)(ws + WS_PART6), (float*)(ws + WS_PART7), (float*)(ws + WS_PART8), 1.0f};
            pg8::gemm_phase(Fp.lds, DM, S, E);
#endif
        }
        SEAM(base + 0);
        if (IN(base + 2)) REPL(2) {
            FRESH();
            LAS float* const ropeL = (LAS float*)(Fp.lds + EPI_OFF + 8192);
            { const float* const rg = (const float*)(ws_ptr() + WS_ROPE); ropeL[Fp.tid] = rg[Fp.tid]; ropeL[512 + Fp.tid] = rg[512 + Fp.tid]; __syncthreads(); }
#ifndef NO_EQ
            { unsigned char* const ws = ws_ptr();
              pg8::SchedRect S{(const char*)(ws + WS_ZCQ), (const char*)((bf16_t*)(ws + WS_WUQ) + (size_t)l * 1024 * QLORA), (size_t)256 * QLORA * 2, mt_act, 4, G, c, 0, 0, 1};
              pg8::EpiQ E{(bf16_t*)(ws + WS_QB), (const float*)(ws + WS_PART6), (const float*)(ws + WS_PART7), in_ptr<I_QG>() + l * QKD, ropeL, (LAS float*)(Fp.lds + EPI_OFF)};
              pg8::gemm_phase(Fp.lds, QLORA, S, E); }
#endif
#ifndef NO_EKV
            { unsigned char* const ws = ws_ptr();
              pg8::SchedRect S{(const char*)(ws + WS_ZCKV), (const char*)((bf16_t*)(ws + WS_WUKV) + (size_t)l * 1024 * KVLORA), (size_t)256 * KVLORA * 2, MT_ALL, 4, G, c, 0, 0, 1};
              pg8::EpiKV E{(bf16_t*)(ws + WS_KB), (bf16_t*)(ws + WS_VB), (const bf16_t*)(ws + WS_ZKR), (const float*)(ws + WS_PART7), (const float*)(ws + WS_PART8), in_ptr<I_KG>() + l * QKD, ropeL, (LAS float*)(Fp.lds + EPI_OFF)};
              pg8::gemm_phase(Fp.lds, KVLORA, S, E); }
#endif
        }
        SEAM(base + 2);
        if (IN(base + 3)) REPL(3) {
            FRESH(); (void)c;
            const float C64 = 0.125f * 1.4426950408889634f, C96 = 0.10206207261596575f * 1.4426950408889634f;
            for (int r2_ = 0; r2_ < (((PH_DUP >> 20) & 1u) ? 2 : 1); ++r2_)
            { unsigned char* const ws = ws_ptr();
#if HEAD_PAIR
              for (int w_ = 2 * Fp.vcu; w_ < 2 * (512 + 128); w_ = (w_ & 1) ? w_ + 2 * G - 1 : w_ + 1) { const int u = w_ >> 1, hp = w_ & 1;
#else
              for (int u = Fp.vcu; u < 1024 + 256; u += G) {
#endif
                att::UnitArgs A; A.Q = (const bf16_t*)(ws + WS_QB); A.ldq = 768; A.K = (const bf16_t*)(ws + WS_KB); A.ldk = 768; A.V = (const bf16_t*)(ws + WS_VB); A.O = (bf16_t*)(ws + WS_OB);
                A.masked = 0; A.band = 0; A.krow0 = 0; A.bias = nullptr; A.C = C96;
#if HEAD_PAIR
                if (u < 512) { const int bh = 2 * (u >> 3) + hp, qb = u & 7, b = bh >> 3, h = bh & 7;
                    A.qcol = h * QKD; A.kcol = h * QKD; A.vcol = h * 64; A.ocol = h * 64; A.q0 = b * SEQ + qb * 256; A.ctx0 = TX + b * CTXL; A.loc0 = b * SEQ; A.NT = 36; }
                else { const int v = u - 512; if (last || !(v & 1)) continue; const int bh = 2 * (v >> 1) + hp, b = bh >> 3, h = bh & 7;
#else
                if (u < 1024) { const int bh = u >> 3, qb = u & 7, b = bh >> 3, h = bh & 7;
                    A.qcol = h * QKD; A.kcol = h * QKD; A.vcol = h * 64; A.ocol = h * 64; A.q0 = b * SEQ + qb * 256; A.ctx0 = TX + b * CTXL; A.loc0 = b * SEQ; A.NT = 36; }
                else { const int v = u - 1024; if (last || !(v & 1)) continue; const int bh = v >> 1, b = bh >> 3, h = bh & 7;
#endif
                    A.qcol = h * QKD; A.kcol = h * QKD; A.vcol = h * 64; A.ocol = h * 64; A.q0 = TX + b * CTXL; A.ctx0 = TX + b * CTXL; A.loc0 = 0; A.NT = 4; }
                att::attn_unit<96>(A, (char*)lds_raw);
              } }
            for (int r3_ = 0; r3_ < (((PH_DUP >> 21) & 1u) ? 2 : 1); ++r3_)
            { unsigned char* const ws = ws_ptr(); const float* const rpb = in_ptr<I_RPB>();
              att::na_mask_table((char*)lds_raw);
#if HEAD_PAIR
              for (int w_ = 2 * Fp.vcu; w_ < 2 * (512 + 128); w_ = (w_ & 1) ? w_ + 2 * G - 1 : w_ + 1) { const int u = w_ >> 1, hp = w_ & 1;
#else
              for (int u = Fp.vcu; u < 1024 + 256; u += G) {
#endif
                att::UnitArgs A; A.Q = (const bf16_t*)(ws + WS_QA); A.ldq = 512; A.K = (const bf16_t*)(ws + WS_KA); A.ldk = 512; A.V = (const bf16_t*)(ws + WS_VA); A.O = (bf16_t*)(ws + WS_OA); A.C = C64;
#if HEAD_PAIR
                if (u < 512) { const int bh = 2 * (u >> 3) + hp, band = u & 7, b = bh >> 3, h = bh & 7;
#else
                if (u < 1024) { const int bh = u >> 3, band = u & 7, b = bh >> 3, h = bh & 7;
#endif
                    A.qcol = h * 64; A.kcol = h * 64; A.vcol = h * 64; A.ocol = h * 64; A.q0 = b * SEQ + band * 256; A.ctx0 = TX + b * CTXL;
                    A.krow0 = min(max(4 * band - 4, 0), 20); A.loc0 = b * SEQ + 64 * A.krow0; A.NT = 10; A.masked = 1; A.band = band; A.bias = rpb + ((size_t)l * NHEAD + h) * 15 * 31; }
#if HEAD_PAIR
                else { const int v = u - 512; if (last || (v & 1)) continue; const int bh = 2 * (v >> 1) + hp, b = bh >> 3, h = bh & 7;
#else
                else { const int v = u - 1024; if (last || (v & 1)) continue; const int bh = v >> 1, b = bh >> 3, h = bh & 7;
#endif
                    A.qcol = h * 64; A.kcol = h * 64; A.vcol = h * 64; A.ocol = h * 64; A.q0 = TX + b * CTXL; A.ctx0 = TX + b * CTXL; A.loc0 = 0; A.NT = 4; A.masked = 0; A.band = 0; A.krow0 = 0; A.bias = nullptr; }
                att::attn_unit<64>(A, (char*)lds_raw);
              } }
        }
        SEAM(base + 3);
        if (IN(base + 4)) REPL(4) {
            FRESH(); unsigned char* const ws = ws_ptr();
#if MRG_F8
            pg8::SchedMerge S{(const char*)(ws + WS_OA), (const char*)(ws + WS_OB), (const char*)(ws + WS_WOA + (size_t)l * 1024 * 512), (const char*)(ws + WS_WOB + (size_t)l * 1024 * 512),
                              (size_t)256 * 512, mt_act, 4, G, c};
            pg8::EpiMerge E{(const bf16_t*)(ws + WS_GATES), (bf16_t*)(ws + WS_Y), 1.0f / (F8_SO * F8_SW)};
            pg8::gemm_phase<true>(Fp.lds, 256, S, E);
#else
            pg8::SchedMerge S{(const char*)(ws + WS_OA), (const char*)(ws + WS_OB), (const char*)((bf16_t*)(ws + WS_WOA) + (size_t)l * 1024 * 512), (const char*)((bf16_t*)(ws + WS_WOB) + (size_t)l * 1024 * 512),
                              (size_t)256 * 512 * 2, mt_act, 4, G, c};
            pg8::EpiMerge E{(const bf16_t*)(ws + WS_GATES), (bf16_t*)(ws + WS_Y), 1.0f};
            pg8::gemm_phase(Fp.lds, 512, S, E);
#endif
        }
        SEAM(base + 4);
        if (IN(base + 5)) REPL(5) {
            FRESH(); unsigned char* const ws = ws_ptr(); float* const outp = out_ptr();
#if C2_F8
            pg8::SchedRect S{(const char*)(ws + WS_Y), (const char*)(ws + WS_WOUT + (size_t)l * DM * DM), (size_t)256 * DM, mt_act, 4, G, c, 0, 0, 1};
            #if XRES_BF16
            pg8::EpiOut E{(l == 0) ? in_ptr<I_X>() : (const float*)nullptr, outp, in_ptr<I_CTX>(), (float*)(ws + WS_XB), (const float*)(ws + WS_MOD) + (size_t)l * 17 * NMODC, 2 * DM, 1.0f / (F8_SY * F8_SW)};
#else
            pg8::EpiOut E{(l == 0) ? in_ptr<I_X>() : (const float*)outp, outp, in_ptr<I_CTX>(), (float*)(ws + WS_XC), (const float*)(ws + WS_MOD) + (size_t)l * 17 * NMODC, 2 * DM, 1.0f / (F8_SY * F8_SW)};
#endif
            pg8::gemm_phase<true>(Fp.lds, DM / 2, S, E);
#else
            pg8::SchedRect S{(const char*)(ws + WS_Y), (const char*)((bf16_t*)(ws + WS_WOUT) + (size_t)l * DM * DM), (size_t)256 * DM * 2, mt_act, 4, G, c, 0, 0, 1};
            #if XRES_BF16
            pg8::EpiOut E{(l == 0) ? in_ptr<I_X>() : (const float*)nullptr, outp, in_ptr<I_CTX>(), (float*)(ws + WS_XB), (const float*)(ws + WS_MOD) + (size_t)l * 17 * NMODC, 2 * DM, 1.0f};
#else
            pg8::EpiOut E{(l == 0) ? in_ptr<I_X>() : (const float*)outp, outp, in_ptr<I_CTX>(), (float*)(ws + WS_XC), (const float*)(ws + WS_MOD) + (size_t)l * 17 * NMODC, 2 * DM, 1.0f};
#endif
            pg8::gemm_phase(Fp.lds, DM, S, E);
#endif
        }
        SEAM(base + 5);
        if (IN(base + 6)) REPL(6) { FRESH(); (void)G; (void)c; route_phase(Fp, l, ntok); }
        SEAM(base + 6);
        if (IN(base + 7)) REPL(7) { FRESH(); (void)G; (void)c; scatter_phase(Fp, l, ntok, F8LAYER(l)); }
        SEAM(base + 7);
        if (IN(base + 8)) REPL(8) {
            FRESH(); unsigned char* const ws = ws_ptr();
            LAS int* const tle = (LAS int*)(Fp.lds + EPI_OFF + 16384); tle[Fp.tid] = ld_i32_agent((const int*)(ws + WS_TILEE) + Fp.tid); __syncthreads();
            const int ntile = __builtin_amdgcn_readfirstlane(tle[511]);
            const char* const w13 = (const char*)((bf16_t*)(ws + WS_W13) + (size_t)l * NEXP * 2048 * DM);
#ifdef ONLY_BF16
            if (false) {} else
#endif
#ifdef ONLY_F8
            if (true)
#else
            if (F8LAYER(l))
#endif
            { pg8::SchedMoe S{(const char*)(ws + WS_HS), w13, (size_t)256 * DM, (size_t)2048 * DM, (size_t)256 * DM, tle, ntile, 8, G, c};
                pg8::EpiMoe1<true> E{(bf16_t*)(ws + WS_HMID), 1.0f / (F8_SH * F8_SW)};
                pg8::gemm_phase<true>(Fp.lds, DM / 2, S, E); }
            else { pg8::SchedMoe S{(const char*)(ws + WS_HS), w13, (size_t)256 * DM * 2, (size_t)2048 * DM * 2, (size_t)256 * DM * 2, tle, ntile, 8, G, c};
                pg8::EpiMoe1<false> E{(bf16_t*)(ws + WS_HMID), 1.0f};
                pg8::gemm_phase(Fp.lds, DM, S, E); }
        }
        SEAM(base + 8);
        if (IN(base + 9)) REPL(9) {
            FRESH(); unsigned char* const ws = ws_ptr();
            LAS int* const tle = (LAS int*)(Fp.lds + EPI_OFF + 16384); tle[Fp.tid] = ld_i32_agent((const int*)(ws + WS_TILEE) + Fp.tid); __syncthreads();
            const int ntile = __builtin_amdgcn_readfirstlane(tle[511]);
            const char* const w2 = (const char*)((bf16_t*)(ws + WS_W2) + (size_t)l * NEXP * DM * DM);
            if (F8LAYER(l)) { pg8::SchedMoe S{(const char*)(ws + WS_HMID), w2, (size_t)256 * DM, (size_t)DM * DM, (size_t)256 * DM, tle, ntile, 4, G, c};
                pg8::EpiMoe2 E{(bf16_t*)(ws + WS_YS), 1.0f / (F8_SM * F8_SW)};
                pg8::gemm_phase<true>(Fp.lds, DM / 2, S, E); }
            else { pg8::SchedMoe S{(const char*)(ws + WS_HMID), w2, (size_t)256 * DM * 2, (size_t)DM * DM * 2, (size_t)256 * DM * 2, tle, ntile, 4, G, c};
                pg8::EpiMoe2 E{(bf16_t*)(ws + WS_YS), 1.0f};
                pg8::gemm_phase(Fp.lds, DM, S, E); }
        }
        SEAM(base + 9);
        if (IN(base + 10)) REPL(10) { FRESH(); (void)G; (void)c; combine_phase(Fp, l, ntok, last); }
        if (!last) SEAM(base + 10);
    }
#undef IN
#undef SEAM
#undef GRID_BAR
}

extern "C" void kernel_launch(void* const* d_in, const int* in_sizes, int n_in, void* d_out, int out_size, void* d_ws, size_t ws_size, hipStream_t stream) {
    static int grid = 0;
    if (grid == 0) {
        if (n_in != 26 || out_size != TX * DM || ws_size < WS_END) { fprintf(stderr, "kernel_launch: unexpected problem (n_in %d, out %d, ws %zu < %zu); nothing launched\n", n_in, out_size, ws_size, (size_t)WS_END); grid = -1; return; }
        int dev = 0, cus = 0, per_cu = 0;
        if (hipGetDevice(&dev) != hipSuccess || hipDeviceGetAttribute(&cus, hipDeviceAttributeMultiprocessorCount, dev) != hipSuccess) { grid = -1; return; }
        if (hipFuncSetAttribute((const void*)fwd_kernel, hipFuncAttributeMaxDynamicSharedMemorySize, LDS_BYTES) != hipSuccess) { fprintf(stderr, "kernel_launch: hipFuncSetAttribute failed\n"); grid = -1; return; }
        if (hipOccupancyMaxActiveBlocksPerMultiprocessor(&per_cu, (const void*)fwd_kernel, 512, LDS_BYTES) != hipSuccess || per_cu < 1) fprintf(stderr, "kernel_launch: occupancy query reports %d blocks per CU\n", per_cu);
        (void)hipGetLastError();
        grid = cus;
    }
    if (grid < 0) return;
    (void)in_sizes;
    (void)hipMemsetAsync((char*)d_ws + WS_CTL, 0, CTL_BYTES, stream);
    Args a{};
    for (int i = 0; i < 26; ++i) a.in[i] = (const float*)d_in[i];
    a.out = (float*)d_out; a.ws = (unsigned char*)d_ws;
#if MK_SPLIT
    for (int p = 0; p < NPHASE; ++p) { a.ph_lo = p; a.ph_hi = p + 1; hipLaunchKernelGGL(fwd_kernel, dim3(grid), dim3(512), LDS_BYTES, stream, a); }
#else
    a.ph_lo = 0; a.ph_hi = NPHASE;
    hipLaunchKernelGGL(fwd_kernel, dim3(grid), dim3(512), LDS_BYTES, stream, a);
#endif
    const hipError_t le = hipPeekAtLastError();
    if (le != hipSuccess) fprintf(stderr, "kernel_launch: launch failed: %s\n", hipGetErrorName(le));
}
```

```cpp
#include <hip/hip_runtime.h>
#include <hip/hip_bf16.h>
#include <cstdio>
#include <cstdint>

#ifndef MK_SPLIT
#define MK_SPLIT 0
#endif

#define LAS __attribute__((address_space(3)))
#define GAS __attribute__((address_space(1)))
typedef unsigned short bf16_t;
typedef short bf16x8 __attribute__((ext_vector_type(8)));
typedef short s16x4 __attribute__((ext_vector_type(4)));
typedef float f32x4 __attribute__((ext_vector_type(4)));
typedef float f32x2 __attribute__((ext_vector_type(2)));
typedef float f32x16 __attribute__((ext_vector_type(16)));
typedef unsigned u32x4 __attribute__((ext_vector_type(4)));
typedef unsigned u32x2 __attribute__((ext_vector_type(2)));
#define RLX_AGENT __ATOMIC_RELAXED, __HIP_MEMORY_SCOPE_AGENT

constexpr int DM = 1024, NB = 16, SEQ = 2048, TX = NB * SEQ, CTXL = 256, TC = NB * CTXL, TALL = TX + TC;
constexpr int NHEAD = 8, GRIDW = 64;
constexpr int INC = 4256, INP = 4352;
constexpr int NEXP = 64, NMODC = 6 * DM;
constexpr int QLORA = 384, KVLORA = 256, QKD = 96, ROPED = 32;
constexpr int MT_X = TX / 256, MT_ALL = TALL / 256;
constexpr int NSLOT_MAX = 2 * TALL + NEXP * 256;
constexpr float RMS_EPS = 1e-6f;
constexpr int NLAYER = 2;
constexpr float F8_SW = 64.f, F8_SH = 16.f, F8_SM = 4.f;
#ifndef F8_FROM
#define F8_FROM 0
#endif
#define F8LAYER(l) ((l) >= F8_FROM)
#ifndef C2_F8
#define C2_F8 1
#endif
constexpr float F8_SY = 32.f;
#ifndef MRG_F8
#define MRG_F8 1
#endif
constexpr float F8_SO = 32.f;
#ifndef HEAD_PAIR
#define HEAD_PAIR MRG_F8
#endif
#ifndef YS_F8
#define YS_F8 1
#endif
constexpr float F8_SYS = 32.f;
#ifndef GATES_F8
#define GATES_F8 1
#endif
constexpr float F8_SG = 256.f;
#ifndef A2_F8
#define A2_F8 1
#endif

constexpr size_t al256(size_t x) { return (x + 255) & ~(size_t)255; }
constexpr size_t WS_CTL = 0, CTL_BYTES = 1u << 20;
constexpr size_t WS_MOD   = WS_CTL + CTL_BYTES;
constexpr size_t WS_ROPE  = WS_MOD + al256((size_t)NLAYER * 17 * NMODC * 4);
constexpr size_t WS_RSCQ  = WS_ROPE + al256(64 * 8 * 2 * 4);
constexpr size_t WS_RSCKV = WS_RSCQ + al256((size_t)TALL * 4);
constexpr size_t WS_SSKR  = WS_RSCKV + al256((size_t)TALL * 4);
constexpr size_t WS_TOKE  = WS_SSKR + al256((size_t)TALL * 4);
constexpr size_t WS_TOKW  = WS_TOKE + al256((size_t)TALL * 8);
constexpr size_t WS_TOKP  = WS_TOKW + al256((size_t)TALL * 8);
constexpr size_t WS_RSTD2 = WS_TOKP + al256((size_t)TALL * 8);
constexpr size_t WS_TILEE = WS_RSTD2 + al256((size_t)TALL * 8);
constexpr size_t WS_OFFS  = WS_TILEE + al256(512 * 4);
constexpr size_t WS_PART6 = WS_OFFS + al256(128 * 4);
constexpr size_t WS_PART7 = WS_PART6 + al256((size_t)TALL * 4 * 4);
constexpr size_t WS_PART8 = WS_PART7 + al256((size_t)TALL * 8 * 4);
constexpr size_t WS_WIN   = WS_PART8 + al256((size_t)TALL * 4 * 4);
constexpr size_t WS_WUQ   = WS_WIN + al256((size_t)NLAYER * INP * DM * 2);
constexpr size_t WS_WUKV  = WS_WUQ + al256((size_t)NLAYER * 1024 * QLORA * 2);
constexpr size_t WS_WOA   = WS_WUKV + al256((size_t)NLAYER * 1024 * KVLORA * 2);
constexpr size_t WS_WOB   = WS_WOA + al256((size_t)NLAYER * 1024 * 512 * 2);
constexpr size_t WS_WOUT  = WS_WOB + al256((size_t)NLAYER * 1024 * 512 * 2);
constexpr size_t WS_W13   = WS_WOUT + al256((size_t)NLAYER * 1024 * 1024 * 2);
constexpr size_t WS_W2    = WS_W13 + al256((size_t)NLAYER * NEXP * 2048 * 1024 * 2);
constexpr size_t WS_H     = WS_W2 + al256((size_t)NLAYER * NEXP * 1024 * 1024 * 2);
constexpr size_t WS_XC    = WS_H + al256((size_t)TALL * DM * 2);
constexpr size_t WS_ACT   = WS_XC + al256((size_t)TC * DM * 4);
constexpr size_t WS_QA    = WS_ACT;
constexpr size_t WS_KA    = WS_QA + al256((size_t)TALL * 512 * 2);
constexpr size_t WS_VA    = WS_KA + al256((size_t)TALL * 512 * 2);
constexpr size_t WS_ZCQ   = WS_VA + al256((size_t)TALL * 512 * 2);
constexpr size_t WS_ZCKV  = WS_ZCQ + al256((size_t)TALL * QLORA * 2);
constexpr size_t WS_ZKR   = WS_ZCKV + al256((size_t)TALL * KVLORA * 2);
constexpr size_t WS_GATES = WS_ZKR + al256((size_t)TALL * ROPED * 2);
constexpr size_t WS_QB    = WS_GATES + al256((size_t)TALL * 2048 * 2);
constexpr size_t WS_KB    = WS_QB + al256((size_t)TALL * 768 * 2);
constexpr size_t WS_VB    = WS_KB + al256((size_t)TALL * 768 * 2);
constexpr size_t WS_OA    = WS_VB + al256((size_t)TALL * 512 * 2);
constexpr size_t WS_OB    = WS_OA + al256((size_t)TALL * 512 * 2);
constexpr size_t WS_Y     = WS_OB + al256((size_t)TALL * 512 * 2);
constexpr size_t WS_MIX_END = WS_Y + al256((size_t)TALL * DM * 2);
constexpr size_t WS_HS    = WS_ACT;
constexpr size_t WS_HMID  = WS_HS + al256((size_t)NSLOT_MAX * DM * 2);
constexpr size_t WS_YS    = WS_HMID + al256((size_t)NSLOT_MAX * DM * 2);
constexpr size_t WS_MOE_END = WS_YS + al256((size_t)NSLOT_MAX * DM * 2);
constexpr size_t WS_END0  = (WS_MIX_END > WS_MOE_END) ? WS_MIX_END : WS_MOE_END;
#ifndef XRES_BF16
#define XRES_BF16 1
#endif
constexpr size_t WS_XB    = WS_END0;
constexpr size_t WS_END   = WS_XB + al256((size_t)TALL * DM * 2);

constexpr int CW_BAR = 4096;
constexpr int CW_CNT = 16384;

constexpr int RING_BYTES = 131072;
constexpr int EPI_OFF = RING_BYTES;
constexpr int MISC_OFF = RING_BYTES + 24576;
constexpr int LDS_BYTES = 160 * 1024;

__device__ __forceinline__ unsigned cvt_pk_bf16(float lo, float hi) { unsigned r; asm volatile("v_cvt_pk_bf16_f32 %0, %1, %2" : "=v"(r) : "v"(lo), "v"(hi)); return r; }
__device__ __forceinline__ unsigned cvt_pk4_fp8(float a, float b, float c, float d) {
    a = __builtin_amdgcn_fmed3f(a, -448.f, 448.f); b = __builtin_amdgcn_fmed3f(b, -448.f, 448.f); c = __builtin_amdgcn_fmed3f(c, -448.f, 448.f); d = __builtin_amdgcn_fmed3f(d, -448.f, 448.f);
    int w = 0; w = __builtin_amdgcn_cvt_pk_fp8_f32(a, b, w, false); w = __builtin_amdgcn_cvt_pk_fp8_f32(c, d, w, true); return (unsigned)w; }
__device__ __forceinline__ f32x4 fp8x4_f32(unsigned w) {
    const f32x2 lo = __builtin_amdgcn_cvt_pk_f32_fp8((int)w, false), hi = __builtin_amdgcn_cvt_pk_f32_fp8((int)w, true); return (f32x4){lo[0], lo[1], hi[0], hi[1]}; }
__device__ __forceinline__ float bf_lo(unsigned w) { return __uint_as_float(w << 16); }
__device__ __forceinline__ float bf_hi(unsigned w) { return __uint_as_float(w & 0xffff0000u); }
__device__ __forceinline__ float wave_sum(float v) {
#pragma unroll
    for (int o = 1; o < 64; o <<= 1) v += __shfl_xor(v, o);
    return v;
}
__device__ __forceinline__ float sigmoidf_(float x) { return __builtin_amdgcn_rcpf(1.0f + __expf(-x)); }
__device__ __forceinline__ int ld_i32_agent(const int* p) { return (int)__hip_atomic_load((const unsigned*)p, RLX_AGENT); }
#define XB_TMO      128
#define XB_XCNT(j)  (256  + 64 * (j))
#define XB_XSUB(j)  (1280 + 64 * (j))
#define XB_XGEN(j)  (2304 + 64 * (j))
#define XB_TOP      3328
#define XB_TOPGEN   3392
#define XCD_BAR_WORDS 3456
#define XB_SPIN_CAP (1u << 18)

__device__ __forceinline__ unsigned xb_ld(unsigned* p)              { return __hip_atomic_load(p, __ATOMIC_RELAXED, __HIP_MEMORY_SCOPE_AGENT); }
__device__ __forceinline__ unsigned xb_add(unsigned* p, unsigned v) { return __hip_atomic_fetch_add(p, v, __ATOMIC_RELAXED, __HIP_MEMORY_SCOPE_AGENT); }
__device__ __forceinline__ unsigned xb_xcc_id() { return (unsigned)__builtin_amdgcn_s_getreg((3 << 11) | 20) & 0xFu; }
#define XB_SPIN(cond, bar) do { unsigned _sp = 0; while (cond) { __builtin_amdgcn_s_sleep(1); \
    if ((++_sp & 255u) == 0u) { if (xb_ld(&(bar)[XB_TMO])) break; if (_sp > XB_SPIN_CAP) { atomicAdd(&(bar)[XB_TMO], 1u); break; } } } } while (0)

struct XcdBarrier {
    unsigned* bar; unsigned x;
    volatile LAS unsigned* st;
};

__device__ __forceinline__ XcdBarrier xcd_barrier_post(unsigned* bar, volatile LAS unsigned* st) {
    XcdBarrier b; b.bar = bar; b.x = xb_xcc_id(); b.st = st;
    if (threadIdx.x == 0) (void)xb_add(&bar[XB_XCNT(b.x)], 1u);
    return b;
}
__device__ __forceinline__ void xcd_barrier_complete(unsigned* bar, unsigned x, unsigned& nloc, unsigned& nx) {
    const unsigned G = gridDim.x * gridDim.y * gridDim.z;
    unsigned sum, cnt, mine, sp = 0u;
    for (;;) {
        sum = 0u; cnt = 0u; mine = 0u;
#pragma unroll
        for (unsigned j = 0; j < 16; ++j) { const unsigned c = xb_ld(&bar[XB_XCNT(j)]); sum += c; cnt += (c > 0u) ? 1u : 0u; mine = (j == x) ? c : mine; }
        if (sum == G) break;
        __builtin_amdgcn_s_sleep(1);
        if ((++sp & 255u) == 0u) { if (xb_ld(&bar[XB_TMO])) break; if (sp > XB_SPIN_CAP) { atomicAdd(&bar[XB_TMO], 1u); break; } }
    }
    nloc = mine > 0u ? mine : 1u; nx = cnt > 0u ? cnt : 1u;
}

__device__ __forceinline__ void xcd_barrier(const XcdBarrier& b) {
    asm volatile("s_waitcnt vmcnt(0)" ::: "memory");
    __syncthreads();
    if (threadIdx.x == 0) {
        unsigned* bar = b.bar;
        __builtin_amdgcn_s_waitcnt(0);
        unsigned nloc = b.st[0], nx = b.st[1];
        if (nloc == 0u) { xcd_barrier_complete(bar, b.x, nloc, nx); b.st[0] = nloc; b.st[1] = nx; }
        const unsigned old = xb_add(&bar[XB_XSUB(b.x)], 1u);
        const unsigned gen = old / nloc;
        if (old + 1u == (gen + 1u) * nloc) {
            __builtin_amdgcn_fence(__ATOMIC_RELEASE, "agent");
            asm volatile("s_waitcnt vmcnt(0)" ::: "memory");
            const unsigned og = xb_add(&bar[XB_TOP], 1u);
            const unsigned tg = og / nx;
            if (og + 1u == (tg + 1u) * nx) xb_add(&bar[XB_TOPGEN], 1u);
            else XB_SPIN(xb_ld(&bar[XB_TOPGEN]) == tg, bar);
            __builtin_amdgcn_fence(__ATOMIC_ACQUIRE, "agent");
            xb_add(&bar[XB_XGEN(b.x)], 1u);
            asm volatile("s_waitcnt vmcnt(0)" ::: "memory");
        } else {
            XB_SPIN(xb_ld(&bar[XB_XGEN(b.x)]) == gen, bar);
            __builtin_amdgcn_fence(__ATOMIC_ACQUIRE, "agent");
            asm volatile("s_waitcnt vmcnt(0)" ::: "memory");
        }
    }
    __syncthreads();
}

namespace pg8 {
constexpr int BM = 256, BK = 64, HALF = 128, HTB = HALF * BK * 2  , STAGE_BYTES = 8 * HTB, NXCD = 8, WGM = 8;
__host__ __device__ __forceinline__ int lds_byte(int r, int c) { const int st = (r >> 4) * 2 + (c >> 5), rr = r & 15, cc = c & 31, ob = rr * 64 + cc * 2; return st * 1024 + (ob ^ (((ob >> 9) & 1) << 5)); }
__host__ __device__ __forceinline__ void stage_rc(int b, int& R, int& C) { const int st = b / 1024, sb = b % 1024, swz = sb ^ (((sb >> 9) & 1) << 5); R = (st >> 1) * 16 + swz / 64; C = (st & 1) * 32 + (swz % 64) / 2; }
__host__ __device__ __forceinline__ int perm32(int rho) { const int n = rho >> 4, i = rho & 15; return 8 * (i >> 2) + 4 * n + (i & 3); }

struct Unit { int pm, pn, kind, e; };

__device__ __forceinline__ void rect_tile(int wgid_in, int nM, int nN, int& pm, int& pn) {
    const int nwg = nM * nN; int wgid = wgid_in;
    { const int q = nwg / NXCD, r = nwg % NXCD, xcd = wgid % NXCD, off = wgid / NXCD; wgid = (xcd < r ? xcd * (q + 1) : r * (q + 1) + (xcd - r) * q) + off; }
    const int nig = WGM * nN, gid = wgid / nig, fm = gid * WGM, gsz = (nM - fm) < WGM ? (nM - fm) : WGM;
    pm = fm + ((wgid % nig) % gsz); pn = (wgid % nig) / gsz;
}

typedef int i32x8 __attribute__((ext_vector_type(8)));
template <bool F8 = false, class Epi, class Sched>
__device__ __forceinline__ void gemm_phase(LAS unsigned char* lds, const int K, const Sched& S, const Epi& E) {
    int tid = threadIdx.x; asm volatile("" : "+v"(tid));
    const int wid = __builtin_amdgcn_readfirstlane(tid >> 6), lane = tid & 63, wr = wid >> 2, wc = wid & 3, fr = lane & 15, fq = lane >> 4;
    const int nt = K / BK;
    unsigned voffA[2], voffB[2];
#pragma unroll
    for (int i = 0; i < 2; ++i) { int R, C; stage_rc(tid * 16 + i * 8192, R, C); const int Rb = Epi::PERM ? ((R & ~31) + perm32(R & 31)) : R;
        voffA[i] = (unsigned)(R * K + C) * 2u; voffB[i] = (unsigned)(Rb * K + C) * 2u; }
    const size_t kstep = (size_t)(BK * 2);
    const size_t hstep = (size_t)HALF * K * 2;
    const unsigned ldsw = (unsigned)wid * 1024u;
    const int aoff = lds_byte(wr * 64 + fr, F8 ? fq * 16 : fq * 8), boff = lds_byte(wc * 32 + fr, F8 ? fq * 16 : fq * 8);
    constexpr int KSTEP = F8 ? 16 : 1024;
    int f8scale = 0x7F7F7F7F; asm volatile("" : "+v"(f8scale));
#define PG8_SA(b, h) (((b) * 2 + (h)) * HTB)
#define PG8_SB(b, h) ((4 + (b) * 2 + (h)) * HTB)
#define PG8_STAGE(bufoff, gbase, voff) do { _Pragma("unroll") for (int _i = 0; _i < 2; ++_i) \
        __builtin_amdgcn_global_load_lds((const unsigned*)((const char*)(gbase) + (voff)[_i]), (LAS unsigned*)(lds + (bufoff) + ldsw + _i * 8192), 16, 0, 0); } while (0)
#define PG8_LDA(dst, b, h) do { _Pragma("unroll") for (int m = 0; m < 4; ++m) _Pragma("unroll") for (int k = 0; k < 2; ++k) dst[m][k] = *(const LAS bf16x8*)(lds + PG8_SA(b, h) + aoff + m * 2048 + k * KSTEP); } while (0)
#define PG8_LDB(dst, b, h) do { _Pragma("unroll") for (int n = 0; n < 2; ++n) _Pragma("unroll") for (int k = 0; k < 2; ++k) dst[n][k] = *(const LAS bf16x8*)(lds + PG8_SB(b, h) + boff + n * 2048 + k * KSTEP); } while (0)
#define PG8_CAT(X) __builtin_shufflevector(__builtin_bit_cast(u32x4, (X)[0]), __builtin_bit_cast(u32x4, (X)[1]), 0, 1, 2, 3, 4, 5, 6, 7)
#define PG8_MMA(ai, bj, At, Bt) do { __builtin_amdgcn_s_setprio(1); \
        if constexpr (F8) { _Pragma("unroll") for (int m = 0; m < 4; ++m) _Pragma("unroll") for (int n = 0; n < 2; ++n) \
            asm volatile("v_mfma_scale_f32_16x16x128_f8f6f4 %0, %1, %2, %0, %3, %3 op_sel_hi:[0,0,0]" : "+v"(acc[ai][bj][m][n]) : "v"(__builtin_bit_cast(i32x8, PG8_CAT(Bt[n]))), "v"(__builtin_bit_cast(i32x8, PG8_CAT(At[m]))), "v"(f8scale)); } \
        else { _Pragma("unroll") for (int m = 0; m < 4; ++m) _Pragma("unroll") for (int n = 0; n < 2; ++n) _Pragma("unroll") for (int k = 0; k < 2; ++k) \
            acc[ai][bj][m][n] = __builtin_amdgcn_mfma_f32_16x16x32_bf16(Bt[n][k], At[m][k], acc[ai][bj][m][n], 0, 0, 0); } \
        __builtin_amdgcn_s_setprio(0); } while (0)
#define PG8_WAIT_V(n) asm volatile("s_waitcnt vmcnt(" #n ")" ::: "memory")
#define PG8_WAIT_L(n) asm volatile("s_waitcnt lgkmcnt(" #n ")" ::: "memory")
#define PG8_BAR __builtin_amdgcn_s_barrier()
#define PG8_SCHED __builtin_amdgcn_sched_barrier(0)
    Unit cur, nxt; int ui = 0;
    if (!S.next(0, cur)) return;
    f32x4 acc[2][2][4][2];
#pragma unroll
    for (int a = 0; a < 2; ++a)
#pragma unroll
        for (int b = 0; b < 2; ++b)
#pragma unroll
            for (int m = 0; m < 4; ++m)
#pragma unroll
                for (int n = 0; n < 2; ++n) acc[a][b][m][n] = (f32x4){0.f, 0.f, 0.f, 0.f};
    bf16x8 At[4][2], B0[2][2], B1[2][2];
    const char* cA = S.a_ptr(cur); const char* cB = S.b_ptr(cur);
    PG8_STAGE(PG8_SB(0, 0), cB, voffB); PG8_STAGE(PG8_SB(0, 1), cB + hstep, voffB); PG8_STAGE(PG8_SA(0, 0), cA, voffA); PG8_STAGE(PG8_SA(0, 1), cA + hstep, voffA);
    if (wr == 1) PG8_BAR;
    PG8_WAIT_V(2); PG8_BAR;
    PG8_STAGE(PG8_SB(1, 0), cB + kstep, voffB); PG8_STAGE(PG8_SA(1, 0), cA + kstep, voffA); PG8_STAGE(PG8_SB(1, 1), cB + hstep + kstep, voffB);
    PG8_WAIT_V(6); PG8_BAR;
    for (;;) {
        const bool has_next = S.next(ui + 1, nxt);
        const char* nA = has_next ? S.a_ptr(nxt) : cA; const char* nB = has_next ? S.b_ptr(nxt) : cB;
#pragma unroll 1
        for (int t = 0; t < nt; t += 2) {
            const bool last = (t == nt - 2);
            const char* a1 = cA + (size_t)(t + 1) * kstep;
            const char* a2 = last ? nA : cA + (size_t)(t + 2) * kstep; const char* b2 = last ? nB : cB + (size_t)(t + 2) * kstep;
            const char* a3 = a2 + kstep; const char* b3 = b2 + kstep;
            PG8_LDB(B0, 0, 0); PG8_LDB(B1, 0, 1); PG8_SCHED; PG8_LDA(At, 0, 0); PG8_STAGE(PG8_SA(1, 1), a1 + hstep, voffA);
            PG8_WAIT_V(8); PG8_WAIT_L(0); PG8_BAR; PG8_MMA(0, 0, At, B0); PG8_MMA(0, 1, At, B1); PG8_BAR; PG8_SCHED;
            PG8_LDA(At, 0, 1); PG8_STAGE(PG8_SB(0, 0), b2, voffB); PG8_STAGE(PG8_SB(0, 1), b2 + hstep, voffB); PG8_STAGE(PG8_SA(0, 0), a2, voffA);
            PG8_WAIT_V(8); PG8_WAIT_L(0); PG8_BAR; PG8_MMA(1, 0, At, B0); PG8_MMA(1, 1, At, B1); PG8_BAR; PG8_SCHED;
            PG8_LDB(B0, 1, 0); PG8_LDB(B1, 1, 1); PG8_SCHED; PG8_LDA(At, 1, 0); PG8_STAGE(PG8_SA(0, 1), a2 + hstep, voffA);
            PG8_WAIT_V(8); PG8_WAIT_L(0); PG8_BAR; PG8_MMA(0, 0, At, B0); PG8_MMA(0, 1, At, B1); PG8_BAR; PG8_SCHED;
            PG8_LDA(At, 1, 1); PG8_STAGE(PG8_SB(1, 0), b3, voffB); PG8_STAGE(PG8_SB(1, 1), b3 + hstep, voffB); PG8_STAGE(PG8_SA(1, 0), a3, voffA);
            PG8_WAIT_V(8); PG8_WAIT_L(0); PG8_BAR; PG8_MMA(1, 0, At, B0); PG8_MMA(1, 1, At, B1); PG8_BAR; PG8_SCHED;
        }
        if (wr == 0) PG8_BAR;
        if constexpr (F8) asm volatile("s_nop 15\n\ts_nop 7" ::: "memory");
        { int tz = threadIdx.x; asm volatile("" : "+v"(tz));
          const int wid2 = __builtin_amdgcn_readfirstlane(tz >> 6), lane2 = tz & 63; E(acc, cur, wid2 >> 2, wid2 & 3, lane2 & 15, lane2 >> 4); }
        if (!has_next) break;
        if (!(Epi::CHAIN && cur.kind == 0)) {
#pragma unroll
            for (int a = 0; a < 2; ++a)
#pragma unroll
                for (int b = 0; b < 2; ++b)
#pragma unroll
                    for (int m = 0; m < 4; ++m)
#pragma unroll
                        for (int n = 0; n < 2; ++n) acc[a][b][m][n] = (f32x4){0.f, 0.f, 0.f, 0.f};
        }
        cur = nxt; cA = nA; cB = nB; ++ui;
        if (wr == 1) PG8_BAR;
    }
    PG8_WAIT_V(0);
    PG8_BAR;
#undef PG8_SA
#undef PG8_SB
#undef PG8_STAGE
#undef PG8_LDA
#undef PG8_LDB
#undef PG8_MMA
#undef PG8_CAT
#undef PG8_WAIT_V
#undef PG8_WAIT_L
#undef PG8_BAR
#undef PG8_SCHED
}
}
namespace pg8 {
__device__ __forceinline__ u32x4 pack8(const f32x4 a, const f32x4 b) { u32x4 w; w.x = cvt_pk_bf16(a[0], a[1]); w.y = cvt_pk_bf16(a[2], a[3]); w.z = cvt_pk_bf16(b[0], b[1]); w.w = cvt_pk_bf16(b[2], b[3]); return w; }
__device__ __forceinline__ float sumsq4(const f32x4 a) { return (a[0] * a[0] + a[1] * a[1]) + (a[2] * a[2] + a[3] * a[3]); }
#define EPI_BAR() do { asm volatile("s_waitcnt lgkmcnt(0)" ::: "memory"); __builtin_amdgcn_s_barrier(); asm volatile("" ::: "memory"); } while (0)

struct EpiIn {
    static constexpr bool PERM = true, CHAIN = false;
    bf16_t *QA, *KA, *VA, *ZCQ, *ZCKV, *ZKR, *GATES; const float *qg, *kg; float *P6, *P7, *P8; float asc;
    __device__ __forceinline__ void operator()(f32x4 (&acc)[2][2][4][2], const Unit& u, int wr, int wc, int fr, int fq) const {
        const int row0 = u.pm * BM + wr * 64 + fr, pn = u.pn;
        if (asc != 1.0f) {
#pragma unroll
            for (int ai = 0; ai < 2; ++ai)
#pragma unroll
                for (int bj = 0; bj < 2; ++bj)
#pragma unroll
                    for (int m = 0; m < 4; ++m) { acc[ai][bj][m][0] = acc[ai][bj][m][0] * asc; acc[ai][bj][m][1] = acc[ai][bj][m][1] * asc; } }
        if (pn < 4) {
            const float* g = (pn < 2) ? qg : kg; bf16_t* dst = (pn < 2) ? QA : KA; const int head = 4 * (pn & 1) + wc;
            f32x4 gv[2][2];
#pragma unroll
            for (int bj = 0; bj < 2; ++bj)
#pragma unroll
                for (int n = 0; n < 2; ++n) gv[bj][n] = *(const f32x4*)(g + 32 * bj + 8 * fq + 4 * n);
#pragma unroll
            for (int ai = 0; ai < 2; ++ai)
#pragma unroll
                for (int m = 0; m < 4; ++m) {
                    const size_t row = (size_t)(row0 + ai * HALF + m * 16);
                    float ss = (sumsq4(acc[ai][0][m][0]) + sumsq4(acc[ai][0][m][1])) + (sumsq4(acc[ai][1][m][0]) + sumsq4(acc[ai][1][m][1]));
                    ss += __shfl_xor(ss, 16); ss += __shfl_xor(ss, 32);
                    const float rstd = rsqrtf(ss * (1.0f / 64.0f) + RMS_EPS);
#pragma unroll
                    for (int bj = 0; bj < 2; ++bj)
                        *(u32x4*)(dst + row * 512 + head * 64 + 32 * bj + 8 * fq) = pack8(acc[ai][bj][m][0] * rstd * gv[bj][0], acc[ai][bj][m][1] * rstd * gv[bj][1]);
                }
        } else if (pn >= 9) {
#pragma unroll
            for (int ai = 0; ai < 2; ++ai)
#pragma unroll
                for (int m = 0; m < 4; ++m) {
                    const size_t row = (size_t)(row0 + ai * HALF + m * 16);
#pragma unroll
                    for (int bj = 0; bj < 2; ++bj) { f32x4 a = acc[ai][bj][m][0], b = acc[ai][bj][m][1];
#pragma unroll
                        for (int j = 0; j < 4; ++j) { a[j] = sigmoidf_(a[j]); b[j] = sigmoidf_(b[j]); }
#if GATES_F8
                        { u32x2 w; w.x = cvt_pk4_fp8(a[0] * F8_SG, a[1] * F8_SG, a[2] * F8_SG, a[3] * F8_SG); w.y = cvt_pk4_fp8(b[0] * F8_SG, b[1] * F8_SG, b[2] * F8_SG, b[3] * F8_SG);
                          *(u32x2*)((unsigned char*)GATES + row * 2048 + (pn - 9) * 256 + 128 * bj + 32 * wc + 8 * fq) = w; } }
#else
                        *(u32x4*)(GATES + row * 2048 + (pn - 9) * 256 + 128 * bj + 32 * wc + 8 * fq) = pack8(a, b); }
#endif
                }
        } else {
#pragma unroll
            for (int ai = 0; ai < 2; ++ai)
#pragma unroll
                for (int m = 0; m < 4; ++m) {
                    const size_t row = (size_t)(row0 + ai * HALF + m * 16);
                    if (pn >= 6) {
                        float s0 = sumsq4(acc[ai][0][m][0]) + sumsq4(acc[ai][0][m][1]), s1 = sumsq4(acc[ai][1][m][0]) + sumsq4(acc[ai][1][m][1]);
                        s0 += __shfl_xor(s0, 16); s0 += __shfl_xor(s0, 32); s1 += __shfl_xor(s1, 16); s1 += __shfl_xor(s1, 32);
                        if (fq == 0) { if (pn == 6) P6[row * 4 + wc] = s0 + s1; else if (pn == 8) P8[row * 4 + wc] = s0 + s1; else { P7[row * 8 + wc] = s0; if (wc == 0) P7[row * 8 + 4] = s1; } } }
#pragma unroll
                    for (int bj = 0; bj < 2; ++bj) {
                        const u32x4 w = pack8(acc[ai][bj][m][0], acc[ai][bj][m][1]); const int cc = 128 * bj + 32 * wc + 8 * fq;
                        if (pn < 6) *(u32x4*)(VA + row * 512 + (pn - 4) * 256 + cc) = w;
                        else if (pn == 6) *(u32x4*)(ZCQ + row * QLORA + cc) = w;
                        else if (pn == 8) *(u32x4*)(ZCKV + row * KVLORA + cc) = w;
                        else { if (bj == 0) *(u32x4*)(ZCQ + row * QLORA + 256 + cc) = w; else if (wc == 0) *(u32x4*)(ZKR + row * ROPED + 8 * fq) = w; }
                    }
                }
        }
    }
};

__device__ __forceinline__ void rope8(float (&v)[8], const LAS float* rope, int s  , int fq) {
    const int pos = (fq < 2) ? (s >> 6) : (s & 63);
    const f32x4 c0 = *(const LAS f32x4*)(rope + pos * 8), c1 = *(const LAS f32x4*)(rope + pos * 8 + 4), s0 = *(const LAS f32x4*)(rope + 512 + pos * 8), s1 = *(const LAS f32x4*)(rope + 512 + pos * 8 + 4);
    const float cs[8] = {c0[0], c0[1], c0[2], c0[3], c1[0], c1[1], c1[2], c1[3]}, sn[8] = {s0[0], s0[1], s0[2], s0[3], s1[0], s1[1], s1[2], s1[3]};
#pragma unroll
    for (int i = 0; i < 8; ++i) { const float o = __shfl_xor(v[i], 16); v[i] = (fq & 1) ? (o * sn[i] + v[i] * cs[i]) : (v[i] * cs[i] - o * sn[i]); }
}

struct EpiQ {
    static constexpr bool PERM = true, CHAIN = false;
    bf16_t* QB; const float *p6, *p7, *g; const LAS float* rope; LAS float* P;
    __device__ __forceinline__ void operator()(f32x4 (&acc)[2][2][4][2], const Unit& u, int wr, int wc, int fr, int fq) const {
        const int row0 = u.pm * BM + wr * 64 + fr; const bool isx = u.pm < MT_X;
        float r8[8];
#pragma unroll
        for (int i = 0; i < 8; ++i) { const size_t row = (size_t)(row0 + (i >> 2) * HALF + (i & 3) * 16); const f32x4 a = *(const f32x4*)(p6 + row * 4), b = *(const f32x4*)(p7 + row * 8);
            r8[i] = rsqrtf((((a[0] + a[1]) + (a[2] + a[3])) + ((b[0] + b[1]) + (b[2] + b[3]))) * (1.0f / QLORA) + RMS_EPS); }
        const int gq = (wc < 3) ? wc : 0;
        const f32x4 g0 = *(const f32x4*)(g + 32 * gq + 8 * fq), g1 = *(const f32x4*)(g + 32 * gq + 8 * fq + 4);
#pragma unroll
        for (int ai = 0; ai < 2; ++ai)
#pragma unroll
            for (int m = 0; m < 4; ++m) {
                const float r = r8[ai * 4 + m]; const int rl = ai * 64 + m * 16 + fr;
#pragma unroll
                for (int bj = 0; bj < 2; ++bj) {
                    float ss = (sumsq4(acc[ai][bj][m][0]) + sumsq4(acc[ai][bj][m][1])) * (r * r); ss += __shfl_xor(ss, 16); ss += __shfl_xor(ss, 32);
                    if (fq == 0) P[((wr * 128 + rl) * 2 + bj) * 4 + wc] = ss; }
            }
        EPI_BAR();
        if (wc < 3) {
#pragma unroll
            for (int ai = 0; ai < 2; ++ai)
#pragma unroll
                for (int m = 0; m < 4; ++m) {
                    const int row = row0 + ai * HALF + m * 16, rl = ai * 64 + m * 16 + fr; const float r = r8[ai * 4 + m];
#pragma unroll
                    for (int bj = 0; bj < 2; ++bj) {
                        const f32x4 p = *(const LAS f32x4*)(P + ((wr * 128 + rl) * 2 + bj) * 4);
                        const float rstd = r * rsqrtf(((p[0] + p[1]) + p[2]) * (1.0f / 96.0f) + RMS_EPS);
                        const f32x4 a = acc[ai][bj][m][0] * rstd * g0, b = acc[ai][bj][m][1] * rstd * g1;
                        float v[8] = {a[0], a[1], a[2], a[3], b[0], b[1], b[2], b[3]};
                        if (wc == 2 && isx) rope8(v, rope, row & (SEQ - 1), fq);
                        u32x4 w; w.x = cvt_pk_bf16(v[0], v[1]); w.y = cvt_pk_bf16(v[2], v[3]); w.z = cvt_pk_bf16(v[4], v[5]); w.w = cvt_pk_bf16(v[6], v[7]);
                        *(u32x4*)(QB + (size_t)row * 768 + (2 * u.pn + bj) * QKD + 32 * wc + 8 * fq) = w;
                    }
                    asm volatile("" ::: "memory");
                }
        }
    }
};

struct EpiKV {
    static constexpr bool PERM = true, CHAIN = false;
    bf16_t *KB, *VB; const bf16_t* ZKR; const float *p7, *p8, *g; const LAS float* rope; LAS float* P;
    __device__ __forceinline__ void operator()(f32x4 (&acc)[2][2][4][2], const Unit& u, int wr, int wc, int fr, int fq) const {
        const int row0 = u.pm * BM + wr * 64 + fr; const bool isx = u.pm < MT_X;
        float r8[8], k8[8]; u32x4 zk8[8];
#pragma unroll
        for (int i = 0; i < 8; ++i) { const int row = row0 + (i >> 2) * HALF + (i & 3) * 16; const f32x4 a = *(const f32x4*)(p8 + (size_t)row * 4);
            k8[i] = p7[(size_t)row * 8 + 4]; r8[i] = rsqrtf(((a[0] + a[1]) + (a[2] + a[3])) * (1.0f / KVLORA) + RMS_EPS);
            zk8[i] = (u32x4){0u, 0u, 0u, 0u}; if (wc == 2) zk8[i] = *(const u32x4*)(ZKR + (size_t)row * ROPED + 8 * fq); }
        const int gofs = (wc < 2) ? (32 * wc + 8 * fq) : (64 + 8 * fq);
        const f32x4 g0 = *(const f32x4*)(g + gofs), g1 = *(const f32x4*)(g + gofs + 4);
        if (wc < 2) {
#pragma unroll
            for (int ai = 0; ai < 2; ++ai)
#pragma unroll
                for (int m = 0; m < 4; ++m) { const float r = r8[ai * 4 + m]; const int rl = ai * 64 + m * 16 + fr;
#pragma unroll
                    for (int bj = 0; bj < 2; ++bj) { float ss = (sumsq4(acc[ai][bj][m][0]) + sumsq4(acc[ai][bj][m][1])) * (r * r); ss += __shfl_xor(ss, 16); ss += __shfl_xor(ss, 32);
                        if (fq == 0) P[((wr * 128 + rl) * 2 + bj) * 4 + wc] = ss + ((wc == 0) ? k8[ai * 4 + m] : 0.f); } }
        }
        EPI_BAR();
#pragma unroll
        for (int ai = 0; ai < 2; ++ai)
#pragma unroll
            for (int m = 0; m < 4; ++m) {
                const int row = row0 + ai * HALF + m * 16, rl = ai * 64 + m * 16 + fr;
                const float rr = r8[ai * 4 + m]; const u32x4 zk = zk8[ai * 4 + m];
#pragma unroll
                for (int bj = 0; bj < 2; ++bj) {
                    const int head = 2 * u.pn + bj;
                    const f32x4 p = *(const LAS f32x4*)(P + ((wr * 128 + rl) * 2 + bj) * 4);
                    const float rstd = rsqrtf((p[0] + p[1]) * (1.0f / 96.0f) + RMS_EPS);
                    if (wc < 2) {
                        *(u32x4*)(KB + (size_t)row * 768 + head * QKD + 32 * wc + 8 * fq) = pack8(acc[ai][bj][m][0] * (rr * rstd) * g0, acc[ai][bj][m][1] * (rr * rstd) * g1);
                    } else {
                        *(u32x4*)(VB + (size_t)row * 512 + head * 64 + 32 * (wc - 2) + 8 * fq) = pack8(acc[ai][bj][m][0] * rr, acc[ai][bj][m][1] * rr);
                        if (wc == 2) {
                            float v[8] = {bf_lo(zk.x) * rstd * g0[0], bf_hi(zk.x) * rstd * g0[1], bf_lo(zk.y) * rstd * g0[2], bf_hi(zk.y) * rstd * g0[3],
                                          bf_lo(zk.z) * rstd * g1[0], bf_hi(zk.z) * rstd * g1[1], bf_lo(zk.w) * rstd * g1[2], bf_hi(zk.w) * rstd * g1[3]};
                            if (isx) rope8(v, rope, row & (SEQ - 1), fq);
                            u32x4 w; w.x = cvt_pk_bf16(v[0], v[1]); w.y = cvt_pk_bf16(v[2], v[3]); w.z = cvt_pk_bf16(v[4], v[5]); w.w = cvt_pk_bf16(v[6], v[7]);
                            *(u32x4*)(KB + (size_t)row * 768 + head * QKD + 64 + 8 * fq) = w;
                        }
                    }
                }
                asm volatile("" ::: "memory");
            }
    }
};

struct EpiMerge {
    static constexpr bool PERM = true, CHAIN = true;
    const bf16_t* GATES; bf16_t* Y; float asc;
    __device__ __forceinline__ void operator()(f32x4 (&acc)[2][2][4][2], const Unit& u, int wr, int wc, int fr, int fq) const {
        const int row0 = u.pm * BM + wr * 64 + fr;
#pragma unroll
        for (int ai = 0; ai < 2; ++ai)
#pragma unroll
            for (int m = 0; m < 4; ++m) {
                const size_t row = (size_t)(row0 + ai * HALF + m * 16);
#pragma unroll
                for (int bj = 0; bj < 2; ++bj) {
                    const int col = u.pn * 256 + 128 * bj + 32 * wc + 8 * fq;
#if GATES_F8
                    const u32x2 gb = *(const u32x2*)((const unsigned char*)GATES + row * 2048 + 1024 + col);
                    const f32x4 b0 = fp8x4_f32(gb.x) * (1.0f / F8_SG), b1 = fp8x4_f32(gb.y) * (1.0f / F8_SG);
#else
                    const u32x4 gb = *(const u32x4*)(GATES + row * 2048 + 1024 + col);
                    const f32x4 b0 = (f32x4){bf_lo(gb.x), bf_hi(gb.x), bf_lo(gb.y), bf_hi(gb.y)}, b1 = (f32x4){bf_lo(gb.z), bf_hi(gb.z), bf_lo(gb.w), bf_hi(gb.w)};
#endif
                    if (u.kind == 0) {
#if GATES_F8
                        const u32x2 ga = *(const u32x2*)((const unsigned char*)GATES + row * 2048 + col);
                        const f32x4 a0 = fp8x4_f32(ga.x) * (1.0f / F8_SG), a1 = fp8x4_f32(ga.y) * (1.0f / F8_SG);
#else
                        const u32x4 ga = *(const u32x4*)(GATES + row * 2048 + col);
                        const f32x4 a0 = (f32x4){bf_lo(ga.x), bf_hi(ga.x), bf_lo(ga.y), bf_hi(ga.y)}, a1 = (f32x4){bf_lo(ga.z), bf_hi(ga.z), bf_lo(ga.w), bf_hi(ga.w)};
#endif
#pragma unroll
                        for (int j = 0; j < 4; ++j) { acc[ai][bj][m][0][j] *= a0[j] * __builtin_amdgcn_rcpf(b0[j]); acc[ai][bj][m][1][j] *= a1[j] * __builtin_amdgcn_rcpf(b1[j]); }
                    } else {
#if C2_F8
                        { const f32x4 y0 = acc[ai][bj][m][0] * b0 * (F8_SY * asc), y1 = acc[ai][bj][m][1] * b1 * (F8_SY * asc); u32x2 w; w.x = cvt_pk4_fp8(y0[0], y0[1], y0[2], y0[3]); w.y = cvt_pk4_fp8(y1[0], y1[1], y1[2], y1[3]);
                          *(u32x2*)((unsigned char*)Y + row * 1024 + col) = w; }
#else
                        *(u32x4*)(Y + row * 1024 + col) = pack8(acc[ai][bj][m][0] * b0 * asc, acc[ai][bj][m][1] * b1 * asc);
#endif
                    }
                }
            }
    }
};

struct EpiOut {
    static constexpr bool PERM = false, CHAIN = false;
    const float* xsrc; float* xdst; const float* csrc; float* cdst; const float* mod  ; int goff; float asc;
    __device__ __forceinline__ void operator()(f32x4 (&acc)[2][2][4][2], const Unit& u, int wr, int wc, int fr, int fq) const {
        const bool isx = u.pm < MT_X;
        const int rowt = (isx ? u.pm : u.pm - MT_X) * BM + wr * 64 + fr;
        const float* src = isx ? xsrc : csrc; float* dst = isx ? xdst : cdst;
        const float* gm = mod + (size_t)(isx ? (u.pm >> 3) : 16) * NMODC + goff;
        const int col0 = u.pn * BM + wc * 32 + 4 * fq;
        f32x4 gv[2][2];
#pragma unroll
        for (int bj = 0; bj < 2; ++bj)
#pragma unroll
            for (int n = 0; n < 2; ++n) gv[bj][n] = *(const f32x4*)(gm + col0 + bj * HALF + n * 16) * asc;
#pragma unroll
        for (int ai = 0; ai < 2; ++ai)
#pragma unroll
            for (int m = 0; m < 4; ++m) { const size_t off = (size_t)(rowt + ai * HALF + m * 16) * DM + col0;
#if XRES_BF16
                bf16_t* const xb = (bf16_t*)cdst + (size_t)(u.pm * BM + wr * 64 + fr + ai * HALF + m * 16) * DM + col0; (void)dst; const bool src_xb = (xsrc == nullptr);
#pragma unroll
                for (int bj = 0; bj < 2; ++bj)
#pragma unroll
                    for (int n = 0; n < 2; ++n) { f32x4 xs;
                        if (src_xb) { const u32x2 w = *(const u32x2*)(xb + bj * HALF + n * 16); xs = (f32x4){bf_lo(w.x), bf_hi(w.x), bf_lo(w.y), bf_hi(w.y)}; }
                        else xs = *(const f32x4*)(src + off + bj * HALF + n * 16);
                        const f32x4 r = xs + gv[bj][n] * acc[ai][bj][m][n]; u32x2 o; o.x = cvt_pk_bf16(r[0], r[1]); o.y = cvt_pk_bf16(r[2], r[3]); *(u32x2*)(xb + bj * HALF + n * 16) = o; }
#else
#pragma unroll
                for (int bj = 0; bj < 2; ++bj)
#pragma unroll
                    for (int n = 0; n < 2; ++n) { const f32x4 xs = *(const f32x4*)(src + off + bj * HALF + n * 16); *(f32x4*)(dst + off + bj * HALF + n * 16) = xs + gv[bj][n] * acc[ai][bj][m][n]; }
#endif
            }
    }
};

template <bool F8> struct EpiMoe1 {
    static constexpr bool PERM = true, CHAIN = false;
    bf16_t* HM; float ascale;
    __device__ __forceinline__ void operator()(f32x4 (&acc)[2][2][4][2], const Unit& u, int wr, int wc, int fr, int fq) const {
        const int row0 = u.pm * BM + wr * 64 + fr;
#pragma unroll
        for (int ai = 0; ai < 2; ++ai)
#pragma unroll
            for (int m = 0; m < 4; ++m) { const size_t row = (size_t)(row0 + ai * HALF + m * 16);
#pragma unroll
                for (int bj = 0; bj < 2; ++bj) { f32x4 p = acc[ai][bj][m][0], q = acc[ai][bj][m][1];
                    if (F8) { p = p * ascale; q = q * ascale; }
                    const float h0 = p[0] * sigmoidf_(p[0]) * p[1], h1 = p[2] * sigmoidf_(p[2]) * p[3], h2 = q[0] * sigmoidf_(q[0]) * q[1], h3 = q[2] * sigmoidf_(q[2]) * q[3];
                    const int col = u.pn * 128 + 64 * bj + 16 * wc + 4 * fq;
                    if (F8) *(unsigned*)((unsigned char*)HM + row * DM + col) = cvt_pk4_fp8(h0 * F8_SM, h1 * F8_SM, h2 * F8_SM, h3 * F8_SM);
                    else { u32x2 w; w.x = cvt_pk_bf16(h0, h1); w.y = cvt_pk_bf16(h2, h3); *(u32x2*)(HM + row * DM + col) = w; } }
            }
    }
};
struct EpiMoe2 {
    static constexpr bool PERM = true, CHAIN = false;
    bf16_t* YS; float ascale;
    __device__ __forceinline__ void operator()(f32x4 (&acc)[2][2][4][2], const Unit& u, int wr, int wc, int fr, int fq) const {
        const int row0 = u.pm * BM + wr * 64 + fr;
#pragma unroll
        for (int ai = 0; ai < 2; ++ai)
#pragma unroll
            for (int m = 0; m < 4; ++m) { const size_t row = (size_t)(row0 + ai * HALF + m * 16);
#pragma unroll
#if YS_F8
                for (int bj = 0; bj < 2; ++bj) { const f32x4 y0 = acc[ai][bj][m][0] * (ascale * F8_SYS), y1 = acc[ai][bj][m][1] * (ascale * F8_SYS); u32x2 w; w.x = cvt_pk4_fp8(y0[0], y0[1], y0[2], y0[3]); w.y = cvt_pk4_fp8(y1[0], y1[1], y1[2], y1[3]);
                    *(u32x2*)((unsigned char*)YS + row * DM + u.pn * 256 + 128 * bj + 32 * wc + 8 * fq) = w; } }
#else
                for (int bj = 0; bj < 2; ++bj) *(u32x4*)(YS + row * DM + u.pn * 256 + 128 * bj + 32 * wc + 8 * fq) = pack8(acc[ai][bj][m][0] * ascale, acc[ai][bj][m][1] * ascale); }
#endif
    }
};

struct SchedRect {
    const char* A; const char* B; size_t tstep; int nM, nN, G, c, nM2, pn2, npn2;
    __device__ __forceinline__ bool next(int i, Unit& u) const {
        const int L = i * G + c, mainc = nM * nN; u.kind = 0; u.e = 0;
        if (L < mainc) { rect_tile(L, nM, nN, u.pm, u.pn); return true; }
        const int Lx = L - mainc; if (Lx >= nM2 * npn2) return false;
        u.pm = nM + Lx / npn2; u.pn = pn2 + Lx % npn2; return true;
    }
    __device__ __forceinline__ const char* a_ptr(const Unit& u) const { return A + (size_t)u.pm * tstep; }
    __device__ __forceinline__ const char* b_ptr(const Unit& u) const { return B + (size_t)u.pn * tstep; }
};
struct SchedMerge {
    const char *OA, *OB, *WA, *WB; size_t tstep; int nM, nN, G, c;
    __device__ __forceinline__ bool next(int i, Unit& u) const {
        const int L = (i >> 1) * G + c; if (L >= nM * nN) return false;
        rect_tile(L, nM, nN, u.pm, u.pn); u.kind = i & 1; u.e = 0; return true;
    }
    __device__ __forceinline__ const char* a_ptr(const Unit& u) const { return (u.kind ? OB : OA) + (size_t)u.pm * tstep; }
    __device__ __forceinline__ const char* b_ptr(const Unit& u) const { return (u.kind ? WB : WA) + (size_t)u.pn * tstep; }
};
struct SchedMoe {
    const char* A; const char* W; size_t tstepA, wstride, tstepB; const LAS int* tile_e  ; int ntile, nN, G, c;
    __device__ __forceinline__ bool next(int i, Unit& u) const {
        const int L = i * G + c; if (L >= ntile * nN) return false;
        rect_tile(L, ntile, nN, u.pm, u.pn); u.kind = 0;
        u.e = __builtin_amdgcn_readfirstlane(tile_e[u.pm]); return true;
    }
    __device__ __forceinline__ const char* a_ptr(const Unit& u) const { return A + (size_t)u.pm * tstepA; }
    __device__ __forceinline__ const char* b_ptr(const Unit& u) const { return W + (size_t)u.e * wstride + (size_t)u.pn * tstepB; }
};
}
namespace att {
constexpr int NW = 8, QBLK = 32, KVBLK = 64, DV = 64;
constexpr int SHM_V = 16384, SHM_K = 16384;
constexpr int LDS_VOFF = 0, LDS_KOFF = 2 * SHM_V, LDS_WS = LDS_KOFF + 2 * SHM_K, LDS_OST = LDS_WS + NW * 64 * 4, LDS_BIAS = LDS_OST + NW * 4096, LDS_MASK = LDS_BIAS + 16 * 128 * 4, LDS_END = LDS_MASK + 64 * 64 * 4;
static_assert(LDS_END <= RING_BYTES, "attention LDS map");
template <int DQK> struct KL { static constexpr int PITCH = (DQK == 64) ? 128 : 256; };
#define KSWZ(row, colB) ((row) * KL<DQK>::PITCH + ((colB) ^ (((row) & ((DQK == 96) ? 15 : 7)) << 4)))
#define SBAR() __builtin_amdgcn_sched_barrier(0)
__device__ __forceinline__ int crow(int r, int hi) { return (r & 3) + 8 * (r >> 2) + 4 * hi; }
__device__ __forceinline__ int v_st(int k, int c) { const int kk = (k & ~0xC) | ((k & 4) << 1) | ((k & 8) >> 1); return ((kk >> 3) * 2 + (c >> 5)) * 512 + ((kk & 7) * 32 + (c & 31)) * 2; }
__device__ __forceinline__ int v_rd_base(int lane, int c) { const int hi = (lane >> 5) & 1, g = c + hi;
    return ((lane & 3) << 3) | (((lane >> 2) & 3) << 6) | (((lane >> 4) & 1) << 5) | ((g & 1) << 8) | ((g >> 1) << 11); }
constexpr int v_rd_off(int d0, int ks, int half) { return ((2 * ks + half) * 2 + d0) * 512; }
template <int OFF> __device__ __forceinline__ s16x4 tr_read(int vb) { s16x4 r; asm volatile("ds_read_b64_tr_b16 %0, %1 offset:%2" : "=&v"(r) : "v"(vb), "i"(OFF) : "memory"); return r; }

template <int D0> __device__ __forceinline__ void pv_one(f32x16& od, int vbA, int vbB, bf16x8 pa0, bf16x8 pa1, bf16x8 pa2, bf16x8 pa3) {
    const s16x4 l0 = tr_read<v_rd_off(D0, 0, 0)>(vbA), h0 = tr_read<v_rd_off(D0, 0, 1)>(vbA), l1 = tr_read<v_rd_off(D0, 1, 0)>(vbA), h1 = tr_read<v_rd_off(D0, 1, 1)>(vbA);
    const s16x4 l2 = tr_read<v_rd_off(D0, 0, 0)>(vbB), h2 = tr_read<v_rd_off(D0, 0, 1)>(vbB), l3 = tr_read<v_rd_off(D0, 1, 0)>(vbB), h3 = tr_read<v_rd_off(D0, 1, 1)>(vbB);
    asm volatile("s_waitcnt lgkmcnt(0)" ::: "memory"); SBAR();
#define PK(L, H) (bf16x8){L[0], L[1], L[2], L[3], H[0], H[1], H[2], H[3]}
    od = __builtin_amdgcn_mfma_f32_32x32x16_bf16(pa0, PK(l0, h0), od, 0, 0, 0);
    od = __builtin_amdgcn_mfma_f32_32x32x16_bf16(pa1, PK(l1, h1), od, 0, 0, 0);
    od = __builtin_amdgcn_mfma_f32_32x32x16_bf16(pa2, PK(l2, h2), od, 0, 0, 0);
    od = __builtin_amdgcn_mfma_f32_32x32x16_bf16(pa3, PK(l3, h3), od, 0, 0, 0);
#undef PK
}
__device__ __forceinline__ void pv_all(f32x16* o, int vbA, int vbB, bf16x8 pa0, bf16x8 pa1, bf16x8 pa2, bf16x8 pa3) { pv_one<0>(o[0], vbA, vbB, pa0, pa1, pa2, pa3); pv_one<1>(o[1], vbA, vbB, pa0, pa1, pa2, pa3); }

#define MX3(a, b, c) __builtin_fmaxf(__builtin_fmaxf((a), (b)), (c))
template <bool FIRST>
__device__ __forceinline__ void partialSM(f32x16& p0, f32x16& p1, float& m_reg, float& alpha, f32x16& negm, const float THR2) {
    float a = MX3(p0[0], p0[1], p1[0]), b = MX3(p0[2], p0[3], p1[1]); a = MX3(a, p1[2], p1[3]);
#pragma unroll
    for (int r = 4; r < 16; r += 4) { a = MX3(a, p0[r], p0[r + 1]); b = MX3(b, p0[r + 2], p0[r + 3]); a = MX3(a, p1[r], p1[r + 1]); b = MX3(b, p1[r + 2], p1[r + 3]); }
    float pmax = __builtin_fmaxf(a, b);
    { auto rr = __builtin_amdgcn_permlane32_swap(__float_as_uint(pmax), __float_as_uint(pmax), false, false); pmax = __builtin_fmaxf(__uint_as_float(rr[0]), __uint_as_float(rr[1])); }
    alpha = 1.f;
    if (FIRST || !__builtin_expect(__all(pmax <= THR2), 1)) {
        const float dl = FIRST ? pmax : __builtin_fmaxf(pmax, 0.f);
        m_reg += dl; alpha = FIRST ? 1.f : __builtin_amdgcn_exp2f(-dl);
#pragma unroll
        for (int r = 0; r < 16; ++r) { p0[r] -= dl; p1[r] -= dl; }
#pragma unroll
        for (int r = 0; r < 16; ++r) negm[r] = -m_reg;
    }
#pragma unroll
    for (int r = 0; r < 16; ++r) p0[r] = __builtin_amdgcn_exp2f(p0[r]);
}
__device__ __forceinline__ void finishSM(f32x16& p0, f32x16& p1, float alpha, float& l_reg, bf16x8& pa0, bf16x8& pa1, bf16x8& pa2, bf16x8& pa3) {
#pragma unroll
    for (int r = 0; r < 16; ++r) p1[r] = __builtin_amdgcn_exp2f(p1[r]);
    float ps = 0;
#pragma unroll
    for (int r = 0; r < 16; ++r) ps += p0[r];
#pragma unroll
    for (int r = 0; r < 16; ++r) ps += p1[r];
    { auto rr = __builtin_amdgcn_permlane32_swap(__float_as_uint(ps), __float_as_uint(ps), false, false); ps = __uint_as_float(rr[0]) + __uint_as_float(rr[1]); }
    l_reg = l_reg * alpha + ps;
#define PK4(P, BASE, OUT) do { unsigned a0 = cvt_pk_bf16(P[BASE + 0], P[BASE + 1]), a1 = cvt_pk_bf16(P[BASE + 2], P[BASE + 3]);   \
    unsigned b0 = cvt_pk_bf16(P[BASE + 4], P[BASE + 5]), b1 = cvt_pk_bf16(P[BASE + 6], P[BASE + 7]);                              \
    auto r0 = __builtin_amdgcn_permlane32_swap(a0, b0, false, false); auto r1 = __builtin_amdgcn_permlane32_swap(a1, b1, false, false); \
    u32x4 w = {r0[0], r1[0], r0[1], r1[1]}; OUT = *reinterpret_cast<bf16x8*>(&w); } while (0)
    PK4(p0, 0, pa0); PK4(p0, 8, pa1); PK4(p1, 0, pa2); PK4(p1, 8, pa3);
#undef PK4
}
template <int DQK> __device__ __forceinline__ void qkt(f32x16& p0, f32x16& p1, const char* Ks, int rowA, int rowB, const bf16x8* qr, const f32x16& negm, int hi) {
#pragma unroll
    for (int d0 = 0; d0 < DQK / 16; ++d0) { const int cb = (d0 * 16 + hi * 8) * 2;
        const bf16x8 b0 = *reinterpret_cast<const bf16x8*>(Ks + KSWZ(rowA, cb));
        const bf16x8 b1 = *reinterpret_cast<const bf16x8*>(Ks + KSWZ(rowB, cb));
        if (d0 == 0) { p0 = __builtin_amdgcn_mfma_f32_32x32x16_bf16(b0, qr[0], negm, 0, 0, 0); p1 = __builtin_amdgcn_mfma_f32_32x32x16_bf16(b1, qr[0], negm, 0, 0, 0); }
        else { p0 = __builtin_amdgcn_mfma_f32_32x32x16_bf16(b0, qr[d0], p0, 0, 0, 0); p1 = __builtin_amdgcn_mfma_f32_32x32x16_bf16(b1, qr[d0], p1, 0, 0, 0); } }
}

struct UnitArgs {
    const bf16_t* Q; int ldq; int qcol;
    const bf16_t* K; int ldk; int kcol;
    const bf16_t* V; int vcol;
    bf16_t* O; int ocol;
    int q0;
    int ctx0, loc0;
    int NT;
    int masked;
    int band, krow0;
    const float* bias;
    float C;
};

__device__ __forceinline__ void na_mask(f32x16& p0, f32x16& p1, const LAS float* bt, const LAS float* mk, int krA, int qrow, int qc, int kc0, int hi) {
    const int rs = min(max(qrow - 4, 0), 24);
    const int drA = ((krA >= rs) && (krA < rs + 8)) ? (krA - qrow + 7) : 15, drB = ((krA + 1 >= rs) && (krA + 1 < rs + 8)) ? (krA + 1 - qrow + 7) : 15;
    const LAS float* bA = bt + drA * 128 + (kc0 + 4 * hi - qc + 64); const LAS float* bB = bt + drB * 128 + (kc0 + 4 * hi - qc + 64);
    const LAS float* mq = mk + qc * 64 + kc0 + 4 * hi;
#pragma unroll
    for (int g = 0; g < 4; ++g) {
        const f32x4 m0 = *(const LAS f32x4*)(mq + 8 * g);
#pragma unroll
        for (int j = 0; j < 4; ++j) { p0[4 * g + j] = (p0[4 * g + j] + bA[8 * g + j]) + m0[j]; p1[4 * g + j] = (p1[4 * g + j] + bB[8 * g + j]) + m0[j]; }
    }
}
__device__ __forceinline__ void na_mask_table(char* lds) {
    LAS float* mk = (LAS float*)(lds + LDS_MASK);
    int t0 = threadIdx.x; asm volatile("" : "+v"(t0));
    for (int i = t0; i < 64 * 64; i += 512) { const int qc = i >> 6, kc = i & 63, cs = min(max(qc - 8, 0), 48); mk[i] = ((unsigned)(kc - cs) < 16u) ? 0.f : -1e30f; }
}

template <int DQK>
__device__ __forceinline__ void attn_unit(const UnitArgs& A, char* lds) {
    int tid = threadIdx.x; asm volatile("" : "+v"(tid));
    const int wid = tid >> 6, lane = tid & 63, r32 = lane & 31, hi = lane >> 5;
    char* V_lds = lds + LDS_VOFF; char* K_lds = lds + LDS_KOFF;
    float* ws = (float*)(lds + LDS_WS) + wid * 64; float* li_l = ws; float* al_l = ws + 32;
    const LAS float* bt = (const LAS float*)(lds + LDS_BIAS); const LAS float* mk = (const LAS float*)(lds + LDS_MASK);
    const float C = A.C, THR2 = 8.0f * 1.4426950408889634f;
    const bool msk = (DQK == 64) && A.masked;
    float m_reg = 0.f, l_reg = 0; f32x16 o[2] = {}; bf16x8 qr[DQK / 16]; f32x16 negm = f32x16{};
    if (msk) { for (int i = tid; i < 16 * 128; i += 512) { const int dr = i >> 7, d = (i & 127) - 64;
            ((LAS float*)(lds + LDS_BIAS))[i] = (dr == 15) ? -1e30f : ((d >= -15 && d <= 15) ? A.bias[dr * 31 + d + 15] * 1.4426950408889634f : 0.f); } }
    const int qrow = 4 * A.band + 2 * (wid >> 2) + (r32 >> 4), qc = 16 * (wid & 3) + (r32 & 15);
    const int kc0 = msk ? min(max(16 * (wid & 3) - 8, 0), 32) : 0;
    const int qtok = msk ? (A.q0 + 64 * (2 * (wid >> 2) + (r32 >> 4)) + qc) : (A.q0 + wid * QBLK + r32);
    const bf16_t* Qw = A.Q + (size_t)qtok * A.ldq + A.qcol + hi * 8;
#pragma unroll
    for (int d0 = 0; d0 < DQK / 16; ++d0) { const u32x4 w = *reinterpret_cast<const u32x4*>(Qw + d0 * 16);
        u32x4 t; t.x = cvt_pk_bf16(bf_lo(w.x) * C, bf_hi(w.x) * C); t.y = cvt_pk_bf16(bf_lo(w.y) * C, bf_hi(w.y) * C); t.z = cvt_pk_bf16(bf_lo(w.z) * C, bf_hi(w.z) * C); t.w = cvt_pk_bf16(bf_lo(w.w) * C, bf_hi(w.w) * C);
        qr[d0] = *reinterpret_cast<bf16x8*>(&t); }
    constexpr int CPR = DQK / 8;
    const int v0key = tid >> 3, vc = (tid & 7) * 8, vst0 = v_st(v0key, vc), vst1 = 8192 + vst0;
    const int k0key = tid / CPR, k0c = tid % CPR, k1id = tid + 512, k1key = k1id / CPR, k1c = k1id % CPR;
    const int vbS = (int)(uintptr_t)V_lds + v_rd_base(lane, 0);
    const int vbM = (int)(uintptr_t)V_lds + v_rd_base(lane, kc0 >> 3);
    bf16x8 sv0, sv1 = {}, sk0, sk1 = {};
#define LOCAL(t) (msk && (t) >= 4)
#define TROW(t) (((t) < 4) ? (A.ctx0 + 64 * (t)) : (A.loc0 + (msk ? 128 : 64) * ((t) - 4)))
#define K1ON(t) ((DQK == 96) ? (tid < 256) : LOCAL(t))
#define SLOAD(t) do { const int _r0 = TROW(t); sv0 = *reinterpret_cast<const bf16x8*>(A.V + (size_t)(_r0 + v0key) * 512 + A.vcol + vc); \
        sk0 = *reinterpret_cast<const bf16x8*>(A.K + (size_t)(_r0 + k0key) * A.ldk + A.kcol + k0c * 8); \
        if (K1ON(t)) sk1 = *reinterpret_cast<const bf16x8*>(A.K + (size_t)(_r0 + k1key) * A.ldk + A.kcol + k1c * 8); \
        if (LOCAL(t)) sv1 = *reinterpret_cast<const bf16x8*>(A.V + (size_t)(_r0 + 64 + v0key) * 512 + A.vcol + vc); } while (0)
#define SWRITE(b, t) do { *reinterpret_cast<bf16x8*>(V_lds + (b) * SHM_V + vst0) = sv0; *reinterpret_cast<bf16x8*>(K_lds + (b) * SHM_K + KSWZ(k0key, k0c * 16)) = sk0; \
        if (K1ON(t)) *reinterpret_cast<bf16x8*>(K_lds + (b) * SHM_K + KSWZ(k1key, k1c * 16)) = sk1; \
        if (LOCAL(t)) *reinterpret_cast<bf16x8*>(V_lds + (b) * SHM_V + vst1) = sv1; } while (0)
#define RESC(a) do { if (__any((a) < 1.f)) { if (hi == 0) al_l[r32] = (a); asm volatile("s_waitcnt lgkmcnt(0)" ::: "memory"); \
        _Pragma("unroll") for (int d = 0; d < 2; ++d) _Pragma("unroll") for (int r = 0; r < 16; ++r) o[d][r] *= al_l[crow(r, hi)]; } } while (0)
#define QKT(P0, P1, b, t) do { const int _ra = LOCAL(t) ? (kc0 + r32) : r32, _rb = LOCAL(t) ? (64 + kc0 + r32) : (32 + r32); \
        qkt<DQK>(P0, P1, K_lds + (b) * SHM_K, _ra, _rb, qr, negm, hi); if (LOCAL(t)) na_mask(P0, P1, bt, mk, A.krow0 + 2 * ((t) - 4), qrow, qc, kc0, hi); } while (0)
#define PV(b, t) do { const int _va = (LOCAL(t) ? vbM : vbS) + (b) * SHM_V, _vb = _va + (LOCAL(t) ? 8192 : 4096); pv_all(o, _va, _vb, pa0, pa1, pa2, pa3); } while (0)
    f32x16 pA0, pA1, pB0, pB1; float alA, alB; bf16x8 pa0, pa1, pa2, pa3; const int NT = A.NT;
    SLOAD(0); SWRITE(0, 0); __syncthreads();
    QKT(pA0, pA1, 0, 0); partialSM<true>(pA0, pA1, m_reg, alA, negm, THR2);
    SLOAD(1); SWRITE(1, 1); __syncthreads();
    for (int j = 1; j + 1 < NT; j += 2) {
        SBAR(); QKT(pB0, pB1, 1, j);
        finishSM(pA0, pA1, alA, l_reg, pa0, pa1, pa2, pa3); SBAR();
        SLOAD(j + 1); SBAR();
        PV(0, j - 1); partialSM<false>(pB0, pB1, m_reg, alB, negm, THR2);
        __syncthreads(); SWRITE(0, j + 1);
        RESC(alB); __syncthreads();
        SBAR(); QKT(pA0, pA1, 0, j + 1);
        finishSM(pB0, pB1, alB, l_reg, pa0, pa1, pa2, pa3); SBAR();
        SLOAD(j + 2); SBAR();
        PV(1, j); partialSM<false>(pA0, pA1, m_reg, alA, negm, THR2);
        __syncthreads(); SWRITE(1, j + 2);
        RESC(alA); __syncthreads();
    }
    SBAR(); QKT(pB0, pB1, 1, NT - 1);
    finishSM(pA0, pA1, alA, l_reg, pa0, pa1, pa2, pa3); SBAR();
    PV(0, NT - 2); partialSM<false>(pB0, pB1, m_reg, alB, negm, THR2);
    __syncthreads(); RESC(alB);
    finishSM(pB0, pB1, alB, l_reg, pa0, pa1, pa2, pa3); SBAR();
    PV(1, NT - 1);
    if (hi == 0) li_l[r32] = l_reg; asm volatile("s_waitcnt lgkmcnt(0)" ::: "memory");
    float rli[16];
#pragma unroll
    for (int r = 0; r < 16; ++r) rli[r] = __builtin_amdgcn_rcpf(li_l[crow(r, hi)]);
    bf16_t* stg = (bf16_t*)(lds + LDS_OST) + wid * 2048;
#pragma unroll
    for (int r = 0; r < 16; ++r) { const int orow = crow(r, hi);
#pragma unroll
        for (int d0 = 0; d0 < 2; ++d0) { const unsigned w = cvt_pk_bf16(o[d0][r] * rli[r], 0.f); stg[orow * 64 + d0 * 32 + r32] = (bf16_t)(w & 0xffffu); } }
    asm volatile("s_waitcnt lgkmcnt(0)" ::: "memory");
#pragma unroll
    for (int i = 0; i < 4; ++i) { const int row = i * 8 + (lane >> 3), ch = lane & 7; const u32x4 v = *(const u32x4*)(stg + row * 64 + ch * 8);
        const int otok = msk ? (A.q0 + 64 * (2 * (wid >> 2) + (row >> 4)) + 16 * (wid & 3) + (row & 15)) : (A.q0 + wid * QBLK + row);
#if MRG_F8
        { u32x2 o8; o8.x = cvt_pk4_fp8(bf_lo(v.x) * F8_SO, bf_hi(v.x) * F8_SO, bf_lo(v.y) * F8_SO, bf_hi(v.y) * F8_SO); o8.y = cvt_pk4_fp8(bf_lo(v.z) * F8_SO, bf_hi(v.z) * F8_SO, bf_lo(v.w) * F8_SO, bf_hi(v.w) * F8_SO);
          *(u32x2*)((unsigned char*)A.O + (size_t)otok * 512 + A.ocol + ch * 8) = o8; } }
#else
        *(u32x4*)(A.O + (size_t)otok * 512 + A.ocol + ch * 8) = v; }
#endif
    __syncthreads();
#undef LOCAL
#undef TROW
#undef K1ON
#undef SLOAD
#undef SWRITE
#undef RESC
#undef QKT
#undef PV
}

constexpr int ML_K = 0, ML_V = 3 * 16384, ML_WS = ML_V + 4 * 8192, ML_OST = ML_WS + NW * 64 * 4, ML_END = ML_OST + NW * 4096;
static_assert(ML_END <= RING_BYTES, "latent attention LDS map");
#define MLBAR() asm volatile("s_waitcnt lgkmcnt(0)\n\ts_barrier" ::: "memory")
__device__ __forceinline__ void mla_unit(const UnitArgs& A, char* lds) {
    constexpr int DQK = 96;
    int tid = threadIdx.x; asm volatile("" : "+v"(tid));
    const int wid = __builtin_amdgcn_readfirstlane(tid >> 6), lane = tid & 63, r32 = lane & 31, hi = lane >> 5, grp = wid >> 2;
    char* V_lds = lds + ML_V; char* K_lds = lds + ML_K;
    float* ws = (float*)(lds + ML_WS) + wid * 64; float* li_l = ws; float* al_l = ws + 32;
    const float C = A.C, THR2 = 8.0f * 1.4426950408889634f;
    float m_reg = 0.f, l_reg = 0; f32x16 o[2] = {}; bf16x8 qr[DQK / 16]; f32x16 negm = f32x16{};
    const bf16_t* Qw = A.Q + (size_t)(A.q0 + wid * QBLK + r32) * A.ldq + A.qcol + hi * 8;
#pragma unroll
    for (int d0 = 0; d0 < DQK / 16; ++d0) { const u32x4 w = *reinterpret_cast<const u32x4*>(Qw + d0 * 16);
        u32x4 t; t.x = cvt_pk_bf16(bf_lo(w.x) * C, bf_hi(w.x) * C); t.y = cvt_pk_bf16(bf_lo(w.y) * C, bf_hi(w.y) * C); t.z = cvt_pk_bf16(bf_lo(w.z) * C, bf_hi(w.z) * C); t.w = cvt_pk_bf16(bf_lo(w.w) * C, bf_hi(w.w) * C);
        qr[d0] = *reinterpret_cast<bf16x8*>(&t); }
    unsigned voffK[2], voffV;
#pragma unroll
    for (int i = 0; i < 2; ++i) { const int R = 4 * (2 * wid + i) + (lane >> 4), pos = lane & 15; int c = pos ^ (R & 15); c = (c >= 12) ? c - 4 : c; voffK[i] = (unsigned)(R * A.ldk + A.kcol + c * 8) * 2u; }
    { const int kk = 8 * wid + ((lane & 31) >> 2), k = (kk & ~0xC) | ((kk & 4) << 1) | ((kk & 8) >> 1), c = 32 * (lane >> 5) + 8 * (lane & 3); voffV = (unsigned)(k * 512 + A.vcol + c) * 2u; }
    const int vbS = (int)(uintptr_t)V_lds + v_rd_base(lane, 0);
#define TROW(t) (((t) < 4) ? (A.ctx0 + 64 * (t)) : (A.loc0 + 64 * ((t) - 4)))
#define KB3(t) ((t) - 3 * (((t) * 43) >> 7))
#define DMA(t) do { const int _r0 = TROW(t); const char* const _gk = (const char*)(A.K + (size_t)_r0 * A.ldk); const char* const _gv = (const char*)(A.V + (size_t)_r0 * 512); \
        LAS unsigned char* const _lk = (LAS unsigned char*)(K_lds) + KB3(t) * 16384 + wid * 2048; LAS unsigned char* const _lv = (LAS unsigned char*)(V_lds) + ((t) & 3) * 8192 + wid * 1024; \
        __builtin_amdgcn_global_load_lds((const unsigned*)(_gk + voffK[0]), (LAS unsigned*)(_lk), 16, 0, 0); \
        __builtin_amdgcn_global_load_lds((const unsigned*)(_gk + voffK[1]), (LAS unsigned*)(_lk + 1024), 16, 0, 0); \
        __builtin_amdgcn_global_load_lds((const unsigned*)(_gv + voffV), (LAS unsigned*)(_lv), 16, 0, 0); } while (0)
    f32x16 p0, p1; bf16x8 pa0, pa1, pa2, pa3; const int NT = A.NT;
#define VSEG(j, FIRST) do { float _al; \
        partialSM<FIRST>(p0, p1, m_reg, _al, negm, THR2); finishSM(p0, p1, _al, l_reg, pa0, pa1, pa2, pa3); \
        if (!(FIRST)) { if (__any(_al < 1.f)) { if (hi == 0) al_l[r32] = _al; asm volatile("s_waitcnt lgkmcnt(0)" ::: "memory"); \
            _Pragma("unroll") for (int d = 0; d < 2; ++d) _Pragma("unroll") for (int r = 0; r < 16; ++r) o[d][r] *= al_l[crow(r, hi)]; } } } while (0)
#define PK(L, H) (bf16x8){L[0], L[1], L[2], L[3], H[0], H[1], H[2], H[3]}
#define RD128(dst, addr, OFF) asm volatile("ds_read_b128 %0, %1 offset:%2" : "=&v"(dst) : "v"(addr), "i"(OFF) : "memory")
#define WAIT2(N, x, y) asm volatile("s_waitcnt lgkmcnt(" #N ")" : "+v"(x), "+v"(y) :: "memory")
#define WAIT4(N, x, y, z, w) asm volatile("s_waitcnt lgkmcnt(" #N ")" : "+v"(x), "+v"(y), "+v"(z), "+v"(w) :: "memory")
#define MF(A_, B_, C_) __builtin_amdgcn_mfma_f32_32x32x16_bf16(A_, B_, C_, 0, 0, 0)
#define MSEG(j, SCORE) do { const int _va = vbS + ((j) & 3) * 8192, _vb = _va + 4096; \
        s16x4 a0 = tr_read<v_rd_off(0, 0, 0)>(_va), a1 = tr_read<v_rd_off(0, 0, 1)>(_va), a2 = tr_read<v_rd_off(0, 1, 0)>(_va), a3 = tr_read<v_rd_off(0, 1, 1)>(_va); \
        s16x4 a4 = tr_read<v_rd_off(0, 0, 0)>(_vb), a5 = tr_read<v_rd_off(0, 0, 1)>(_vb), a6 = tr_read<v_rd_off(0, 1, 0)>(_vb), a7 = tr_read<v_rd_off(0, 1, 1)>(_vb); \
        s16x4 c0, c1, c2, c3, c4, c5, c6, c7; \
        if (SCORE) { const int _kb = kls + KB3((j) + 1) * 16384; bf16x8 k0a, k0b, k1a, k1b, k2a, k2b, k3a, k3b, k4a, k4b, k5a, k5b; \
            RD128(k0a, _kb + ka0, 0); RD128(k0b, _kb + ka0, 8192); RD128(k1a, _kb + ka1, 0); RD128(k1b, _kb + ka1, 8192); RD128(k2a, _kb + ka2, 0); RD128(k2b, _kb + ka2, 8192); \
            WAIT2(4, k0a, k0b); p0 = MF(k0a, qr[0], negm); p1 = MF(k0b, qr[0], negm); \
            RD128(k3a, _kb + ka3, 0); RD128(k3b, _kb + ka3, 8192); WAIT2(4, k1a, k1b); p0 = MF(k1a, qr[1], p0); p1 = MF(k1b, qr[1], p1); \
            RD128(k4a, _kb + ka4, 0); RD128(k4b, _kb + ka4, 8192); WAIT2(4, k2a, k2b); p0 = MF(k2a, qr[2], p0); p1 = MF(k2b, qr[2], p1); \
            RD128(k5a, _kb + ka5, 0); RD128(k5b, _kb + ka5, 8192); WAIT2(4, k3a, k3b); p0 = MF(k3a, qr[3], p0); p1 = MF(k3b, qr[3], p1); \
            c0 = tr_read<v_rd_off(1, 0, 0)>(_va); c1 = tr_read<v_rd_off(1, 0, 1)>(_va); c2 = tr_read<v_rd_off(1, 1, 0)>(_va); c3 = tr_read<v_rd_off(1, 1, 1)>(_va); \
            WAIT2(6, k4a, k4b); p0 = MF(k4a, qr[4], p0); p1 = MF(k4b, qr[4], p1); \
            c4 = tr_read<v_rd_off(1, 0, 0)>(_vb); c5 = tr_read<v_rd_off(1, 0, 1)>(_vb); c6 = tr_read<v_rd_off(1, 1, 0)>(_vb); c7 = tr_read<v_rd_off(1, 1, 1)>(_vb); \
            WAIT2(8, k5a, k5b); p0 = MF(k5a, qr[5], p0); p1 = MF(k5b, qr[5], p1); \
        } else { \
            c0 = tr_read<v_rd_off(1, 0, 0)>(_va); c1 = tr_read<v_rd_off(1, 0, 1)>(_va); c2 = tr_read<v_rd_off(1, 1, 0)>(_va); c3 = tr_read<v_rd_off(1, 1, 1)>(_va); \
            c4 = tr_read<v_rd_off(1, 0, 0)>(_vb); c5 = tr_read<v_rd_off(1, 0, 1)>(_vb); c6 = tr_read<v_rd_off(1, 1, 0)>(_vb); c7 = tr_read<v_rd_off(1, 1, 1)>(_vb); } \
        WAIT4(8, a0, a1, a2, a3); WAIT4(8, a4, a5, a6, a7); \
        o[0] = MF(pa0, PK(a0, a1), o[0]); o[0] = MF(pa1, PK(a2, a3), o[0]); o[0] = MF(pa2, PK(a4, a5), o[0]); o[0] = MF(pa3, PK(a6, a7), o[0]); \
        WAIT4(4, c0, c1, c2, c3); o[1] = MF(pa0, PK(c0, c1), o[1]); o[1] = MF(pa1, PK(c2, c3), o[1]); \
        WAIT4(0, c4, c5, c6, c7); o[1] = MF(pa2, PK(c4, c5), o[1]); o[1] = MF(pa3, PK(c6, c7), o[1]); \
        if ((j) + 3 < NT) { DMA((j) + 3); asm volatile("s_waitcnt vmcnt(3)" ::: "memory"); } else asm volatile("s_waitcnt vmcnt(0)" ::: "memory"); } while (0)
    const int kls = (int)(uintptr_t)K_lds;
    const int ka0 = KSWZ(r32, 0 * 32 + hi * 16), ka1 = KSWZ(r32, 1 * 32 + hi * 16), ka2 = KSWZ(r32, 2 * 32 + hi * 16), ka3 = KSWZ(r32, 3 * 32 + hi * 16), ka4 = KSWZ(r32, 4 * 32 + hi * 16), ka5 = KSWZ(r32, 5 * 32 + hi * 16);
    DMA(0); DMA(1); DMA(2); asm volatile("s_waitcnt vmcnt(3)" ::: "memory");
    MLBAR();
    if (grp == 1) MLBAR();
    qkt<DQK>(p0, p1, K_lds + KB3(0) * 16384, r32, 32 + r32, qr, negm, hi); MLBAR();
    VSEG(0, true); MLBAR(); MSEG(0, true); MLBAR();
    for (int j = 1; j + 1 < NT; ++j) { VSEG(j, false); MLBAR(); MSEG(j, true); MLBAR(); }
    VSEG(NT - 1, false); MLBAR(); MSEG(NT - 1, false); MLBAR();
    if (grp == 0) MLBAR();
#undef VSEG
#undef MSEG
#undef PK
#undef RD128
#undef WAIT2
#undef WAIT4
#undef MF
    if (hi == 0) li_l[r32] = l_reg; asm volatile("s_waitcnt lgkmcnt(0)" ::: "memory");
    float rli[16];
#pragma unroll
    for (int r = 0; r < 16; ++r) rli[r] = __builtin_amdgcn_rcpf(li_l[crow(r, hi)]);
    bf16_t* stg = (bf16_t*)(lds + ML_OST) + wid * 2048;
#pragma unroll
    for (int r = 0; r < 16; ++r) { const int orow = crow(r, hi);
#pragma unroll
        for (int d0 = 0; d0 < 2; ++d0) { const unsigned w = cvt_pk_bf16(o[d0][r] * rli[r], 0.f); stg[orow * 64 + d0 * 32 + r32] = (bf16_t)(w & 0xffffu); } }
    asm volatile("s_waitcnt lgkmcnt(0)" ::: "memory");
#pragma unroll
    for (int i = 0; i < 4; ++i) { const int row = i * 8 + (lane >> 3), ch = lane & 7; const u32x4 v = *(const u32x4*)(stg + row * 64 + ch * 8); const int otok = A.q0 + wid * QBLK + row;
#if MRG_F8
        { u32x2 o8; o8.x = cvt_pk4_fp8(bf_lo(v.x) * F8_SO, bf_hi(v.x) * F8_SO, bf_lo(v.y) * F8_SO, bf_hi(v.y) * F8_SO); o8.y = cvt_pk4_fp8(bf_lo(v.z) * F8_SO, bf_hi(v.z) * F8_SO, bf_lo(v.w) * F8_SO, bf_hi(v.w) * F8_SO);
          *(u32x2*)((unsigned char*)A.O + (size_t)otok * 512 + A.ocol + ch * 8) = o8; } }
#else
        *(u32x4*)(A.O + (size_t)otok * 512 + A.ocol + ch * 8) = v; }
#endif
    MLBAR();
#undef TROW
#undef KB3
#undef DMA
}
#undef MLBAR
#undef KSWZ
#undef SBAR
}
struct Frame {
    LAS unsigned char* lds;
    int tid, lane, wave, vcu, G;
};
#define CAS __attribute__((address_space(4)))
__device__ __forceinline__ const CAS char* karg() { return (const CAS char*)__builtin_amdgcn_kernarg_segment_ptr(); }
template <int I> __device__ __forceinline__ const float* in_ptr() { unsigned off = I * 8; asm volatile("" : "+s"(off)); return *(const float* const CAS*)(karg() + off); }
__device__ __forceinline__ float* out_ptr() { unsigned off = 26 * 8; asm volatile("" : "+s"(off)); return *(float* const CAS*)(karg() + off); }
__device__ __forceinline__ unsigned char* ws_ptr() { unsigned off = 27 * 8; asm volatile("" : "+s"(off)); return *(unsigned char* const CAS*)(karg() + off); }
enum { I_X = 0, I_C, I_CTX, I_CCTX, I_WADA, I_BADA, I_NMIXG, I_NFFNG, I_WIN, I_NAQG, I_NAKG, I_RPB, I_CQG, I_WUQ, I_CKVG, I_WUKV, I_QG, I_KG, I_WOA, I_WOB, I_WOUT, I_WR, I_RB, I_W1, I_W3, I_W2 };

#define LDS_WAIT() asm volatile("s_waitcnt lgkmcnt(0)" ::: "memory")

__device__ __forceinline__ int win_src_col(int np) {
    const int pn = np >> 8, cc = np & 255;
    if (pn < 4) { const int part = pn >> 1, tq = pn & 1, bj = cc >> 7, wc = (cc >> 5) & 3, i = cc & 31; return part * 512 + (4 * tq + wc) * 64 + 32 * bj + i; }
    if (pn < 6) return 1024 + (pn - 4) * 256 + cc;
    if (pn == 6) return 1536 + cc;
    if (pn == 7) return cc < 128 ? 1792 + cc : (cc < 160 ? 2176 + (cc - 128) : -1);
    if (pn == 8) return 1920 + cc;
    return 2208 + (pn - 9) * 256 + cc;
}
template <bool F8 = false>
__device__ __forceinline__ void conv_item(const float* src, size_t ld, int dcol, int dstep, const float* gain, bf16_t* WT, int K, int k0, int n0, LAS float* scr, int lane) {
    const int kr = lane >> 4;
    f32x4 v[16];
#pragma unroll
    for (int i = 0; i < 16; ++i) { v[i] = (f32x4){0.f, 0.f, 0.f, 0.f}; if (src) v[i] = __builtin_nontemporal_load((const f32x4*)(src + (size_t)(k0 + 4 * i + kr) * ld)); }
#pragma unroll
    for (int i = 0; i < 16; ++i) { const int kk = 4 * i + kr;
        if (gain) v[i] = v[i] * gain[k0 + kk];
        LAS float* s = scr + kk * 65 + dcol; s[0] = v[i][0]; s[dstep] = v[i][1]; s[2 * dstep] = v[i][2]; s[3 * dstep] = v[i][3]; }
    LDS_WAIT(); asm volatile("" ::: "memory");
    const int c = lane & 7;
#pragma unroll
    for (int j = 0; j < 8; ++j) { const int n = (lane >> 3) + 8 * j; const LAS float* s = scr + (8 * c) * 65 + n;
        if (F8) { u32x2 o; o.x = cvt_pk4_fp8(s[0 * 65] * F8_SW, s[1 * 65] * F8_SW, s[2 * 65] * F8_SW, s[3 * 65] * F8_SW); o.y = cvt_pk4_fp8(s[4 * 65] * F8_SW, s[5 * 65] * F8_SW, s[6 * 65] * F8_SW, s[7 * 65] * F8_SW);
            *(u32x2*)((unsigned char*)WT + (size_t)(n0 + n) * K + k0 + 8 * c) = o; }
        else { u32x4 o; o.x = cvt_pk_bf16(s[0 * 65], s[1 * 65]); o.y = cvt_pk_bf16(s[2 * 65], s[3 * 65]); o.z = cvt_pk_bf16(s[4 * 65], s[5 * 65]); o.w = cvt_pk_bf16(s[6 * 65], s[7 * 65]);
            *(u32x4*)(WT + (size_t)(n0 + n) * K + k0 + 8 * c) = o; } }
    LDS_WAIT(); asm volatile("" ::: "memory");
}
__device__ __forceinline__ void p0_convert(Frame& F) {
    LAS float* scr = (LAS float*)(F.lds + F.wave * 16640);
    const int gw = F.vcu * 8 + F.wave, NGW = F.G * 8, lane = F.lane, q16 = lane & 15;
    constexpr int I_IN = 16 * 68, I_UQ = 6 * 16, I_UKV = 4 * 16, I_OA = 8 * 16, I_OUT = 16 * 16, I_13 = 16 * 32 * NEXP, I_2 = 16 * 16 * NEXP;
    constexpr int PER_L = I_IN + I_UQ + I_UKV + 2 * I_OA + I_OUT + I_13 + I_2;
    unsigned char* const ws = ws_ptr();
    for (int it = gw; it < NLAYER * PER_L; it += NGW) {
        const int l = it / PER_L; int r = it - l * PER_L;
        if (r < I_IN) { const int kb = r / 68, nb = r % 68, sc = win_src_col(nb * 64 + 4 * q16);
#if A2_F8
            if ((kb ^ nb) & 1) continue;
            { const float* const sp = sc >= 0 ? in_ptr<I_WIN>() + (size_t)l * DM * INC + sc : nullptr; bf16_t* const wt8 = (bf16_t*)(ws + WS_WIN + (size_t)l * INP * DM); const int k0 = (kb & ~1) * 64;
              conv_item<true>(sp, INC, 4 * q16, 1, nullptr, wt8, DM, k0, nb * 64, scr, lane); conv_item<true>(sp, INC, 4 * q16, 1, nullptr, wt8, DM, k0 + 64, nb * 64, scr, lane); }
#else
            conv_item(sc >= 0 ? in_ptr<I_WIN>() + (size_t)l * DM * INC + sc : nullptr, INC, 4 * q16, 1, nullptr, (bf16_t*)(ws + WS_WIN) + (size_t)l * INP * DM, DM, kb * 64, nb * 64, scr, lane);
#endif
            continue; } r -= I_IN;
        if (r < I_UQ) { const int kb = r / 16, nb = r % 16, np = nb * 64 + 4 * q16, hh = np >> 7, dd = np & 127;
            conv_item(dd < QKD ? in_ptr<I_WUQ>() + (size_t)l * QLORA * 768 + hh * QKD + dd : nullptr, 768, 4 * q16, 1, in_ptr<I_CQG>() + l * QLORA, (bf16_t*)(ws + WS_WUQ) + (size_t)l * 1024 * QLORA, QLORA, kb * 64, nb * 64, scr, lane); continue; } r -= I_UQ;
        if (r < I_UKV) { const int kb = r / 16, nb = r % 16;
            conv_item(in_ptr<I_WUKV>() + (size_t)l * KVLORA * 1024 + nb * 64 + 4 * q16, 1024, 4 * q16, 1, in_ptr<I_CKVG>() + l * KVLORA, (bf16_t*)(ws + WS_WUKV) + (size_t)l * 1024 * KVLORA, KVLORA, kb * 64, nb * 64, scr, lane); continue; } r -= I_UKV;
        if (r < 2 * I_OA) { const int w = r / I_OA, rr = r % I_OA, kb = rr / 16, nb = rr % 16;
#if MRG_F8
            if ((kb ^ nb) & 1) continue;
            { const float* const sp = (w ? in_ptr<I_WOB>() : in_ptr<I_WOA>()) + (size_t)l * 512 * DM + nb * 64 + 4 * q16; bf16_t* const wt8 = (bf16_t*)(ws + (w ? WS_WOB : WS_WOA) + (size_t)l * 1024 * 512); const int k0 = (kb & ~1) * 64;
              conv_item<true>(sp, DM, 4 * q16, 1, nullptr, wt8, 512, k0, nb * 64, scr, lane); conv_item<true>(sp, DM, 4 * q16, 1, nullptr, wt8, 512, k0 + 64, nb * 64, scr, lane); }
#else
            conv_item((w ? in_ptr<I_WOB>() : in_ptr<I_WOA>()) + (size_t)l * 512 * DM + nb * 64 + 4 * q16, DM, 4 * q16, 1, nullptr, (bf16_t*)(ws + (w ? WS_WOB : WS_WOA)) + (size_t)l * 1024 * 512, 512, kb * 64, nb * 64, scr, lane);
#endif
            continue; } r -= 2 * I_OA;
        if (r < I_OUT) { const int kb = r / 16, nb = r % 16;
#if C2_F8
            if ((kb ^ nb) & 1) continue;
            { const float* const sp = in_ptr<I_WOUT>() + (size_t)l * DM * DM + nb * 64 + 4 * q16; bf16_t* const wt8 = (bf16_t*)(ws + WS_WOUT + (size_t)l * DM * DM); const int k0 = (kb & ~1) * 64;
              conv_item<true>(sp, DM, 4 * q16, 1, nullptr, wt8, DM, k0, nb * 64, scr, lane); conv_item<true>(sp, DM, 4 * q16, 1, nullptr, wt8, DM, k0 + 64, nb * 64, scr, lane); }
#else
            conv_item(in_ptr<I_WOUT>() + (size_t)l * DM * DM + nb * 64 + 4 * q16, DM, 4 * q16, 1, nullptr, (bf16_t*)(ws + WS_WOUT) + (size_t)l * DM * DM, DM, kb * 64, nb * 64, scr, lane);
#endif
            continue; } r -= I_OUT;
        if (r < I_13) { const int e = r / 512, rr = r % 512, kb = rr / 32, nb = rr % 32;
            const float* base = ((q16 < 8) ? in_ptr<I_W1>() : in_ptr<I_W3>()) + ((size_t)l * NEXP + e) * DM * DM + nb * 32 + 4 * (q16 & 7);
            bf16_t* const wt = (bf16_t*)(ws + WS_W13) + ((size_t)l * NEXP) * 2048 * DM;
            if (F8LAYER(l)) { if ((kb ^ (e >> 2)) & 1) continue;
                const int k0 = (kb & ~1) * 64;
                conv_item<true>(base, DM, 8 * (q16 & 7) + (q16 >> 3), 2, nullptr, (bf16_t*)((unsigned char*)wt + (size_t)e * 2048 * DM), DM, k0, nb * 64, scr, lane);
                conv_item<true>(base, DM, 8 * (q16 & 7) + (q16 >> 3), 2, nullptr, (bf16_t*)((unsigned char*)wt + (size_t)e * 2048 * DM), DM, k0 + 64, nb * 64, scr, lane); }
            else conv_item(base, DM, 8 * (q16 & 7) + (q16 >> 3), 2, nullptr, wt + (size_t)e * 2048 * DM, DM, kb * 64, nb * 64, scr, lane);
            continue; } r -= I_13;
        { const int e = r / 256, rr = r % 256, kb = rr / 16, nb = rr % 16;
            const float* const src2 = in_ptr<I_W2>() + ((size_t)l * NEXP + e) * DM * DM + nb * 64 + 4 * q16; bf16_t* const wt = (bf16_t*)(ws + WS_W2) + ((size_t)l * NEXP) * DM * DM;
            if (F8LAYER(l)) { if ((kb ^ (e >> 3)) & 1) continue; const int k0 = (kb & ~1) * 64;
                conv_item<true>(src2, DM, 4 * q16, 1, nullptr, (bf16_t*)((unsigned char*)wt + (size_t)e * DM * DM), DM, k0, nb * 64, scr, lane);
                conv_item<true>(src2, DM, 4 * q16, 1, nullptr, (bf16_t*)((unsigned char*)wt + (size_t)e * DM * DM), DM, k0 + 64, nb * 64, scr, lane); }
            else conv_item(src2, DM, 4 * q16, 1, nullptr, wt + (size_t)e * DM * DM, DM, kb * 64, nb * 64, scr, lane); }
    }
}
__device__ __forceinline__ void p0_ada(Frame& F) {
    if ((int)blockIdx.x >= 2 * 96) return;
    unsigned char* const ws = ws_ptr(); const float* const cin = in_ptr<I_C>(); const float* const cctx = in_ptr<I_CCTX>(); const float* const wada = in_ptr<I_WADA>(); const float* const bada = in_ptr<I_BADA>();
    LAS float* sct = (LAS float*)F.lds;
    LAS float* red = (LAS float*)(F.lds + 1024 * 20 * 4);
    for (int idx = F.tid; idx < 17 * 1024; idx += 512) { const int r = idx >> 10, d = idx & 1023; const float v = (r < 16) ? cin[r * DM + d] : cctx[d]; sct[d * 20 + r] = v * (1.0f / (1.0f + expf(-v))); }
    __syncthreads();
    float* MOD = (float*)(ws + WS_MOD);
    for (int task = blockIdx.x; task < 2 * 96; task += F.G) {
        const int l = task / 96, cb = task % 96, col = cb * 64 + F.lane;
        const float* wa = wada + (size_t)l * DM * NMODC + col;
        float acc[17];
#pragma unroll
        for (int r = 0; r < 17; ++r) acc[r] = 0.f;
        for (int k = F.wave * 128; k < F.wave * 128 + 128; ++k) { const float wv = wa[(size_t)k * NMODC];
#pragma unroll
            for (int r = 0; r < 17; ++r) acc[r] += sct[k * 20 + r] * wv; }
#pragma unroll
        for (int r = 0; r < 17; ++r) red[(F.wave * 17 + r) * 64 + F.lane] = acc[r];
        __syncthreads();
        for (int idx = F.tid; idx < 17 * 64; idx += 512) { const int r = idx >> 6, cl = idx & 63; float s = bada[l * NMODC + cb * 64 + cl];
#pragma unroll
            for (int w = 0; w < 8; ++w) s += red[(w * 17 + r) * 64 + cl];
            MOD[((size_t)l * 17 + r) * NMODC + cb * 64 + cl] = s; }
        __syncthreads();
    }
    if (blockIdx.x == 0) { float* rope = (float*)(ws + WS_ROPE); const int pos = F.tid >> 3, i = F.tid & 7;
        const float inv = exp2f(-(float)i * 0.125f * 13.287712379549449f);
        const float ang = (float)pos * inv; const float rev = ang * 0.15915494309189535f, fr = rev - floorf(rev); rope[pos * 8 + i] = __builtin_amdgcn_cosf(fr); rope[512 + pos * 8 + i] = __builtin_amdgcn_sinf(fr); }
}

__device__ __forceinline__ void load_row(const float* xrow, int lane, f32x4 (&v)[4]) {
#pragma unroll
    for (int j = 0; j < 4; ++j) v[j] = *((const f32x4*)xrow + lane + 64 * j);
}
__device__ __forceinline__ void load_xrow(const unsigned char* ws, const float* xcur, int t, int lane, f32x4 (&v)[4]) {
#if XRES_BF16
    const u32x2* r = (const u32x2*)((const bf16_t*)(ws + WS_XB) + (size_t)t * DM);
#pragma unroll
    for (int j = 0; j < 4; ++j) { const u32x2 w = r[lane + 64 * j]; v[j] = (f32x4){bf_lo(w.x), bf_hi(w.x), bf_lo(w.y), bf_hi(w.y)}; }
#else
    load_row((t < TX) ? xcur + (size_t)t * DM : (const float*)(ws + WS_XC) + (size_t)(t - TX) * DM, lane, v);
#endif
}
__device__ __forceinline__ float row_rstd(const f32x4 (&v)[4]) {
    float s = 0.f;
#pragma unroll
    for (int j = 0; j < 4; ++j) s += (v[j][0] * v[j][0] + v[j][1] * v[j][1]) + (v[j][2] * v[j][2] + v[j][3] * v[j][3]);
    return rsqrtf(wave_sum(s) * (1.0f / DM) + RMS_EPS);
}
__device__ __forceinline__ void normmod(const f32x4 (&v)[4], float rstd, const float* g, const float* sh, const float* sc, int lane, f32x4 (&h)[4]) {
#pragma unroll
    for (int j = 0; j < 4; ++j) { const f32x4 gv = *((const f32x4*)g + lane + 64 * j), shv = *((const f32x4*)sh + lane + 64 * j), scv = *((const f32x4*)sc + lane + 64 * j);
        h[j] = v[j] * rstd * gv * (scv + 1.0f) + shv; }
}
__device__ __forceinline__ void store_row_h(unsigned char* Hb, int t, int lane, const f32x4 (&h)[4]) {
#if A2_F8
#pragma unroll
    for (int j = 0; j < 4; ++j) *((unsigned*)(Hb + (size_t)t * DM) + lane + 64 * j) = cvt_pk4_fp8(h[j][0] * F8_SH, h[j][1] * F8_SH, h[j][2] * F8_SH, h[j][3] * F8_SH);
#else
#pragma unroll
    for (int j = 0; j < 4; ++j) { u32x2 w; w.x = cvt_pk_bf16(h[j][0], h[j][1]); w.y = cvt_pk_bf16(h[j][2], h[j][3]); *((u32x2*)((bf16_t*)Hb + (size_t)t * DM) + lane + 64 * j) = w; }
#endif
}
__device__ __forceinline__ void store_row_bf16(bf16_t* orow, int lane, const f32x4 (&h)[4]) {
#pragma unroll
    for (int j = 0; j < 4; ++j) { u32x2 w; w.x = cvt_pk_bf16(h[j][0], h[j][1]); w.y = cvt_pk_bf16(h[j][2], h[j][3]); *((u32x2*)orow + lane + 64 * j) = w; }
}
__device__ __forceinline__ void p0_hrows(Frame& F) {
    unsigned char* const ws = ws_ptr(); const float* const xin = in_ptr<I_X>(); const float* const cxin = in_ptr<I_CTX>(); const float* const gmix = in_ptr<I_NMIXG>();
    const int gw = F.vcu * 8 + F.wave, NGW = F.G * 8; const float* MOD = (const float*)(ws + WS_MOD); bf16_t* H = (bf16_t*)(ws + WS_H);
    for (int t = gw; t < TALL; t += NGW) {
        const float* xr = (t < TX) ? xin + (size_t)t * DM : cxin + (size_t)(t - TX) * DM;
        const float* md = MOD + (size_t)((t < TX) ? (t >> 11) : 16) * NMODC;
        f32x4 v[4], h[4]; load_row(xr, F.lane, v); const float rstd = row_rstd(v);
        normmod(v, rstd, gmix, md, md + DM, F.lane, h); store_row_h((unsigned char*)H, t, F.lane, h);
    }
}
__device__ __forceinline__ void stats_phase(Frame& F, int ntok) {
    unsigned char* const ws = ws_ptr();
    const int gw = F.vcu * 8 + F.wave, NGW = F.G * 8, lane = F.lane;
    const bf16_t* ZCQ = (const bf16_t*)(ws + WS_ZCQ); const bf16_t* ZCKV = (const bf16_t*)(ws + WS_ZCKV); const bf16_t* ZKR = (const bf16_t*)(ws + WS_ZKR);
    float* RSCQ = (float*)(ws + WS_RSCQ); float* RSCKV = (float*)(ws + WS_RSCKV); float* SSKR = (float*)(ws + WS_SSKR);
    for (int t = gw; t < ntok; t += NGW) {
        float a = 0.f, b = 0.f, c = 0.f;
        if (lane < 48) { const u32x4 w = *(const u32x4*)(ZCQ + (size_t)t * QLORA + 8 * lane); a = (bf_lo(w.x) * bf_lo(w.x) + bf_hi(w.x) * bf_hi(w.x)) + (bf_lo(w.y) * bf_lo(w.y) + bf_hi(w.y) * bf_hi(w.y)) + (bf_lo(w.z) * bf_lo(w.z) + bf_hi(w.z) * bf_hi(w.z)) + (bf_lo(w.w) * bf_lo(w.w) + bf_hi(w.w) * bf_hi(w.w)); }
        if (lane < 32) { const u32x4 w = *(const u32x4*)(ZCKV + (size_t)t * KVLORA + 8 * lane); b = (bf_lo(w.x) * bf_lo(w.x) + bf_hi(w.x) * bf_hi(w.x)) + (bf_lo(w.y) * bf_lo(w.y) + bf_hi(w.y) * bf_hi(w.y)) + (bf_lo(w.z) * bf_lo(w.z) + bf_hi(w.z) * bf_hi(w.z)) + (bf_lo(w.w) * bf_lo(w.w) + bf_hi(w.w) * bf_hi(w.w)); }
        if (lane < 4) { const u32x4 w = *(const u32x4*)(ZKR + (size_t)t * ROPED + 8 * lane); c = (bf_lo(w.x) * bf_lo(w.x) + bf_hi(w.x) * bf_hi(w.x)) + (bf_lo(w.y) * bf_lo(w.y) + bf_hi(w.y) * bf_hi(w.y)) + (bf_lo(w.z) * bf_lo(w.z) + bf_hi(w.z) * bf_hi(w.z)) + (bf_lo(w.w) * bf_lo(w.w) + bf_hi(w.w) * bf_hi(w.w)); }
        a = wave_sum(a); b = wave_sum(b); c = wave_sum(c);
        if (lane == 0) { RSCQ[t] = rsqrtf(a * (1.0f / QLORA) + RMS_EPS); RSCKV[t] = rsqrtf(b * (1.0f / KVLORA) + RMS_EPS); SSKR[t] = c; }
    }
}

__device__ __forceinline__ void route_phase(Frame& F, int l, int ntok) {
    unsigned char* const ws = ws_ptr(); const float* const xcur = out_ptr();
    constexpr int HP = DM + 4;
    LAS float* h2t = (LAS float*)F.lds;
    LAS float* part = (LAS float*)(F.lds + 66560);
    LAS float* logit = (LAS float*)(F.lds + 66560 + 32768);
    const float* MOD = (const float*)(ws + WS_MOD) + (size_t)l * 17 * NMODC;
    const float* g = in_ptr<I_NFFNG>() + l * DM; const float* wr = in_ptr<I_WR>(); const float rbias = in_ptr<I_RB>()[F.lane];
    int* TOKE = (int*)(ws + WS_TOKE); float* TOKW = (float*)(ws + WS_TOKW); int* TOKP = (int*)(ws + WS_TOKP); float* RSTD2 = (float*)(ws + WS_RSTD2);
    unsigned* cnt = (unsigned*)(ws + WS_CTL) + CW_CNT + l * 2048;
    const int lane = F.lane, w = F.wave;
    float wv[32][4];
#pragma unroll
    for (int s_ = 0; s_ < 32; ++s_)
#pragma unroll
        for (int j = 0; j < 4; ++j) wv[s_][j] = wr[(w * 128 + 4 * s_ + (lane >> 4)) * NEXP + 16 * j + (lane & 15)];
    for (int it = blockIdx.x; it < ntok / 16; it += F.G) {
        const int T0 = it * 16;
#pragma unroll
        for (int tt = 0; tt < 2; ++tt) { const int tl = 2 * w + tt, t = T0 + tl;
            const float* md = MOD + (size_t)((t < TX) ? (t >> 11) : 16) * NMODC;
            f32x4 v[4], h[4]; load_xrow(ws, xcur, t, lane, v); const float rstd = row_rstd(v); if (lane == 0) RSTD2[(t >> 4) * 32 + (t & 15)] = rstd;
            normmod(v, rstd, g, md + 3 * DM, md + 4 * DM, lane, h);
#pragma unroll
            for (int j = 0; j < 4; ++j) *(LAS f32x4*)(h2t + tl * HP + 4 * lane + 256 * j) = h[j];
        }
        __syncthreads();
        { f32x4 acc[4];
#pragma unroll
          for (int j = 0; j < 4; ++j) acc[j] = (f32x4){0.f, 0.f, 0.f, 0.f};
          const LAS float* ha = h2t + (lane & 15) * HP + w * 128 + (lane >> 4);
#pragma unroll
          for (int s_ = 0; s_ < 32; ++s_) { const float a = ha[4 * s_];
#pragma unroll
              for (int j = 0; j < 4; ++j) acc[j] = __builtin_amdgcn_mfma_f32_16x16x4f32(a, wv[s_][j], acc[j], 0, 0, 0); }
#pragma unroll
          for (int j = 0; j < 4; ++j)
#pragma unroll
              for (int q = 0; q < 4; ++q) part[(w * 16 + 4 * (lane >> 4) + q) * 64 + 16 * j + (lane & 15)] = acc[j][q]; }
        __syncthreads();
#pragma unroll
        for (int k = 0; k < 2; ++k) { const int idx = F.tid + 512 * k, t = idx >> 6, e = idx & 63; float s = 0.f;
#pragma unroll
            for (int ww = 0; ww < 8; ++ww) s += part[(ww * 16 + t) * 64 + e];
            logit[t * 64 + e] = s; }
        __syncthreads();
#pragma unroll
        for (int tt = 0; tt < 2; ++tt) { const int tl = 2 * w + tt, t = T0 + tl;
            const float sg = 1.0f / (1.0f + expf(-logit[tl * 64 + lane])); const float bs = sg + rbias;
            float m1 = -3.0e38f, m2 = -3.0e38f; int i1 = 0, i2 = 0;
#pragma unroll
            for (int j = 0; j < 8; ++j) { const float vv = __shfl(bs, (lane & ~7) + j); if (vv > m1) { m2 = m1; i2 = i1; m1 = vv; i1 = j; } else if (vv > m2) { m2 = vv; i2 = j; } }
            const float gs = m1 + m2; float best = -3.0e38f; int gsel = 0;
#pragma unroll
            for (int j = 0; j < 8; ++j) { const float vv = __shfl(gs, 8 * j); if (vv > best) { best = vv; gsel = j; } }
            const int e1 = gsel * 8 + __shfl(i1, gsel * 8), e2 = gsel * 8 + __shfl(i2, gsel * 8);
            const float s1 = __shfl(sg, e1), s2 = __shfl(sg, e2), inv = 1.0f / (s1 + s2);
            if (lane == 0) { const int p1 = (int)atomicAdd(cnt + e1 * 16, 1u), p2 = (int)atomicAdd(cnt + e2 * 16, 1u);
                TOKE[2 * t] = e1; TOKE[2 * t + 1] = e2; TOKW[2 * t] = s1 * inv; TOKW[2 * t + 1] = s2 * inv; TOKP[2 * t] = p1; TOKP[2 * t + 1] = p2; }
        }
        __syncthreads();
    }
}
__device__ __forceinline__ void expert_offsets(Frame& F, unsigned char* ws, int l, LAS int* offl, bool publish) {
    if (F.wave == 0) {
        const unsigned c = __hip_atomic_load((unsigned*)(ws + WS_CTL) + CW_CNT + l * 2048 + F.lane * 16, RLX_AGENT);
        const int pad = (int)((c + 255u) & ~255u); int incl = pad;
#pragma unroll
        for (int o = 1; o < 64; o <<= 1) { const int v = __shfl_up(incl, o); if (F.lane >= o) incl += v; }
        offl[F.lane] = incl - pad; if (F.lane == 63) offl[64] = incl;
        if (publish) { int* TILEE = (int*)(ws + WS_TILEE); for (int t = (incl - pad) >> 8; t < (incl >> 8); ++t) TILEE[t] = F.lane; if (F.lane == 63) TILEE[511] = incl >> 8; }
    }
    __syncthreads();
}
__device__ __forceinline__ void scatter_phase(Frame& F, int l, int ntok, bool f8) {
    unsigned char* const ws = ws_ptr(); const float* const xcur = out_ptr();
    LAS int* offl = (LAS int*)(F.lds + 1024);
    expert_offsets(F, ws, l, offl, blockIdx.x == 0);
    const int gw = F.vcu * 8 + F.wave, NGW = F.G * 8, lane = F.lane;
    const float* MOD = (const float*)(ws + WS_MOD) + (size_t)l * 17 * NMODC; const float* g = in_ptr<I_NFFNG>() + l * DM;
    const int* TOKE = (const int*)(ws + WS_TOKE); const int* TOKP = (const int*)(ws + WS_TOKP); const float* RSTD2 = (const float*)(ws + WS_RSTD2); bf16_t* HS = (bf16_t*)(ws + WS_HS);
    for (int t = gw; t < ntok; t += NGW) {
        const float* md = MOD + (size_t)((t < TX) ? (t >> 11) : 16) * NMODC;
        f32x4 v[4], h[4]; load_xrow(ws, xcur, t, lane, v); normmod(v, RSTD2[(t >> 4) * 32 + (t & 15)], g, md + 3 * DM, md + 4 * DM, lane, h);
        const int s1 = offl[TOKE[2 * t]] + TOKP[2 * t], s2 = offl[TOKE[2 * t + 1]] + TOKP[2 * t + 1];
        if (f8) {
#pragma unroll
            for (int j = 0; j < 4; ++j) { const unsigned w = cvt_pk4_fp8(h[j][0] * F8_SH, h[j][1] * F8_SH, h[j][2] * F8_SH, h[j][3] * F8_SH);
                *((unsigned*)((unsigned char*)HS + (size_t)s1 * DM) + lane + 64 * j) = w; *((unsigned*)((unsigned char*)HS + (size_t)s2 * DM) + lane + 64 * j) = w; }
        } else { store_row_bf16(HS + (size_t)s1 * DM, lane, h); store_row_bf16(HS + (size_t)s2 * DM, lane, h); }
    }
}
__device__ __forceinline__ void combine_phase(Frame& F, int l, int ntok, bool last) {
    unsigned char* const ws = ws_ptr(); float* const xcur = out_ptr();
    LAS int* offl = (LAS int*)(F.lds + 1024);
    expert_offsets(F, ws, l, offl, false);
    const int gw = F.vcu * 8 + F.wave, NGW = F.G * 8, lane = F.lane;
    const float* MOD = (const float*)(ws + WS_MOD) + (size_t)l * 17 * NMODC; float* XC = (float*)(ws + WS_XC);
    const int* TOKE = (const int*)(ws + WS_TOKE); const int* TOKP = (const int*)(ws + WS_TOKP); const float* TOKW = (const float*)(ws + WS_TOKW);
    const bf16_t* YS = (const bf16_t*)(ws + WS_YS); bf16_t* H = (bf16_t*)(ws + WS_H);
    for (int t = gw; t < ntok; t += NGW) {
        float* xr = (t < TX) ? xcur + (size_t)t * DM : XC + (size_t)(t - TX) * DM; const int bi = (t < TX) ? (t >> 11) : 16; const float* md = MOD + (size_t)bi * NMODC;
        const int s1 = offl[TOKE[2 * t]] + TOKP[2 * t], s2 = offl[TOKE[2 * t + 1]] + TOKP[2 * t + 1]; const float w1 = TOKW[2 * t], w2 = TOKW[2 * t + 1];
        f32x4 v[4]; load_xrow(ws, xcur, t, lane, v);
#pragma unroll
        for (int j = 0; j < 4; ++j) {
            const f32x4 gf = *((const f32x4*)(md + 5 * DM) + lane + 64 * j);
#if YS_F8
            const unsigned a = *((const unsigned*)((const unsigned char*)YS + (size_t)s1 * DM) + lane + 64 * j), b = *((const unsigned*)((const unsigned char*)YS + (size_t)s2 * DM) + lane + 64 * j);
            const f32x4 y = fp8x4_f32(a) * (w1 * (1.0f / F8_SYS)) + fp8x4_f32(b) * (w2 * (1.0f / F8_SYS));
#else
            const u32x2 a = *((const u32x2*)(YS + (size_t)s1 * DM) + lane + 64 * j), b = *((const u32x2*)(YS + (size_t)s2 * DM) + lane + 64 * j);
            const f32x4 y = (f32x4){bf_lo(a.x), bf_hi(a.x), bf_lo(a.y), bf_hi(a.y)} * w1 + (f32x4){bf_lo(b.x), bf_hi(b.x), bf_lo(b.y), bf_hi(b.y)} * w2;
#endif
            v[j] = v[j] + gf * y;
#if XRES_BF16
            if (last) *((f32x4*)xr + lane + 64 * j) = v[j];
            else { u32x2 w; w.x = cvt_pk_bf16(v[j][0], v[j][1]); w.y = cvt_pk_bf16(v[j][2], v[j][3]); *((u32x2*)((bf16_t*)(ws + WS_XB) + (size_t)t * DM) + lane + 64 * j) = w; }
#else
            *((f32x4*)xr + lane + 64 * j) = v[j];
#endif
        }
        if (!last) { const float* md2 = MOD + (size_t)17 * NMODC + (size_t)bi * NMODC; f32x4 h[4]; const float rstd = row_rstd(v);
            normmod(v, rstd, in_ptr<I_NMIXG>() + (l + 1) * DM, md2, md2 + DM, lane, h); store_row_h((unsigned char*)H, t, lane, h); }
    }
}
constexpr int NPHASE = 2 + 11 * NLAYER;
struct Args { const float* in[26]; float* out; unsigned char* ws; int ph_lo, ph_hi; };

__device__ __attribute__((noinline)) void grid_barrier_fn(GAS unsigned* barw, unsigned x, LAS unsigned* st) { XcdBarrier b; b.bar = (unsigned*)barw; b.x = x; b.st = (volatile LAS unsigned*)st; xcd_barrier(b); }

__global__ void __launch_bounds__(512, 2) fwd_kernel(Args args) {
    extern __shared__ __attribute__((aligned(16))) unsigned char lds_raw[];
    Frame F;
    F.lds = (LAS unsigned char*)lds_raw;
    F.tid = threadIdx.x; F.lane = F.tid & 63; F.wave = __builtin_amdgcn_readfirstlane(F.tid >> 6);
    F.G = gridDim.x; { const int bx = blockIdx.x; F.vcu = (F.G % 8 == 0) ? (bx % 8) * (F.G / 8) + bx / 8 : bx; }
    volatile LAS unsigned* MISC = (volatile LAS unsigned*)(F.lds + MISC_OFF);
    if (F.tid < 64) MISC[F.tid] = 0u;
    __syncthreads();
    const int lo = args.ph_lo, hi = args.ph_hi;
#if MK_SPLIT
#define GRID_BAR() do { } while (0)
#else
    XcdBarrier bar = xcd_barrier_post((unsigned*)(ws_ptr() + WS_CTL) + CW_BAR, MISC + 8);
#define GRID_BAR() grid_barrier_fn((GAS unsigned*)bar.bar, bar.x, (LAS unsigned*)bar.st)
#endif
#ifndef PH_MASK
#define PH_MASK 0xFFFFFFFFu
#endif
#define PHK(k) ((k) < 2 ? (k) : 2 + ((k) - 2) % 11)
#define IN(k) (((PH_MASK >> PHK(k)) & 1u) && lo <= (k) && (k) < hi)
#ifndef PH_DUP
#define PH_DUP 0u
#endif
#define REP0(k) for (int rep_ = 0; rep_ < (((PH_DUP >> (k)) & 1u) ? 2 : 1); ++rep_)
#define REPL(n) for (int rep_ = 0; rep_ < ((((PH_DUP >> (2 + (n))) & 1u) && ((n) != 5 || l == 0)) ? 2 : 1); ++rep_)
#ifdef BAR_DUP
#define SEAM(k) do { if (IN(k) && IN((k) + 1)) { for (int b_ = 0; b_ < 1 + BAR_DUP; ++b_) GRID_BAR(); } } while (0)
#else
#define SEAM(k) do { if (IN(k) && IN((k) + 1)) GRID_BAR(); } while (0)
#endif
#define FRESH() Frame Fp = F; int G = F.G, c = (int)blockIdx.x; asm volatile("" : "+v"(Fp.tid), "+v"(Fp.lane)); asm volatile("" : "+s"(Fp.wave), "+s"(Fp.vcu), "+s"(Fp.G), "+s"(G), "+s"(c))

    if (IN(0)) REP0(0) { FRESH(); (void)G; (void)c; p0_convert(Fp); __syncthreads(); p0_ada(Fp); }
    SEAM(0);
    if (IN(1)) REP0(1) { FRESH(); (void)G; (void)c; p0_hrows(Fp); }
    SEAM(1);

    for (int l = 0; l < NLAYER; ++l) {
        const int base = 2 + 11 * l; const bool last = (l == NLAYER - 1);
        const int mt_act = last ? MT_X : MT_ALL;
        const int ntok = last ? TX : TALL;
        if (IN(base + 0)) REPL(0) {
            FRESH(); unsigned char* const ws = ws_ptr();
#if A2_F8
            pg8::SchedRect S{(const char*)(ws + WS_H), (const char*)(ws + WS_WIN + (size_t)l * INP * DM), (size_t)256 * DM, mt_act, 17, G, c, MT_ALL - mt_act, 2, 7};
            pg8::EpiIn E{(bf16_t*)(ws + WS_QA), (bf16_t*)(ws + WS_KA), (bf16_t*)(ws + WS_VA), (bf16_t*)(ws + WS_ZCQ), (bf16_t*)(ws + WS_ZCKV), (bf16_t*)(ws + WS_ZKR), (bf16_t*)(ws + WS_GATES),
                         in_ptr<I_NAQG>() + l * 64, in_ptr<I_NAKG>() + l * 64, (float*)(ws + WS_PART6), (float*)(ws + WS_PART7), (float*)(ws + WS_PART8), 1.0f / (F8_SH * F8_SW)};
            pg8::gemm_phase<true>(Fp.lds, DM / 2, S, E);
#else
            pg8::SchedRect S{(const char*)(ws + WS_H), (const char*)((bf16_t*)(ws + WS_WIN) + (size_t)l * INP * DM), (size_t)256 * DM * 2, mt_act, 17, G, c, MT_ALL - mt_act, 2, 7};
            pg8::EpiIn E{(bf16_t*)(ws + WS_QA), (bf16_t*)(ws + WS_KA), (bf16_t*)(ws + WS_VA), (bf16_t*)(ws + WS_ZCQ), (bf16_t*)(ws + WS_ZCKV), (bf16_t*)(ws + WS_ZKR), (bf16_t*)(ws + WS_GATES),
                         in_ptr<I_NAQG>() + l * 64, in_ptr<I_NAKG>() + l * 64, (float*)(ws + WS_PART6), (float*)(ws + WS_PART7), (float*)(ws + WS_PART8), 1.0f};
            pg8::gemm_phase(Fp.lds, DM, S, E);
#endif
        }
        SEAM(base + 0);
        if (IN(base + 2)) REPL(2) {
            FRESH();
            LAS float* const ropeL = (LAS float*)(Fp.lds + EPI_OFF + 8192);
            { const float* const rg = (const float*)(ws_ptr() + WS_ROPE); ropeL[Fp.tid] = rg[Fp.tid]; ropeL[512 + Fp.tid] = rg[512 + Fp.tid]; __syncthreads(); }
#ifndef NO_EQ
            { unsigned char* const ws = ws_ptr();
              pg8::SchedRect S{(const char*)(ws + WS_ZCQ), (const char*)((bf16_t*)(ws + WS_WUQ) + (size_t)l * 1024 * QLORA), (size_t)256 * QLORA * 2, mt_act, 4, G, c, 0, 0, 1};
              pg8::EpiQ E{(bf16_t*)(ws + WS_QB), (const float*)(ws + WS_PART6), (const float*)(ws + WS_PART7), in_ptr<I_QG>() + l * QKD, ropeL, (LAS float*)(Fp.lds + EPI_OFF)};
              pg8::gemm_phase(Fp.lds, QLORA, S, E); }
#endif
#ifndef NO_EKV
            { unsigned char* const ws = ws_ptr();
              pg8::SchedRect S{(const char*)(ws + WS_ZCKV), (const char*)((bf16_t*)(ws + WS_WUKV) + (size_t)l * 1024 * KVLORA), (size_t)256 * KVLORA * 2, MT_ALL, 4, G, c, 0, 0, 1};
              pg8::EpiKV E{(bf16_t*)(ws + WS_KB), (bf16_t*)(ws + WS_VB), (const bf16_t*)(ws + WS_ZKR), (const float*)(ws + WS_PART7), (const float*)(ws + WS_PART8), in_ptr<I_KG>() + l * QKD, ropeL, (LAS float*)(Fp.lds + EPI_OFF)};
              pg8::gemm_phase(Fp.lds, KVLORA, S, E); }
#endif
        }
        SEAM(base + 2);
        if (IN(base + 3)) REPL(3) {
            FRESH(); (void)c;
            const float C64 = 0.125f * 1.4426950408889634f, C96 = 0.10206207261596575f * 1.4426950408889634f;
            for (int r2_ = 0; r2_ < (((PH_DUP >> 20) & 1u) ? 2 : 1); ++r2_)
            { unsigned char* const ws = ws_ptr();
#if HEAD_PAIR
              for (int w_ = 2 * Fp.vcu; w_ < 2 * (512 + 128); w_ = (w_ & 1) ? w_ + 2 * G - 1 : w_ + 1) { const int u = w_ >> 1, hp = w_ & 1;
#else
              for (int u = Fp.vcu; u < 1024 + 256; u += G) {
#endif
                att::UnitArgs A; A.Q = (const bf16_t*)(ws + WS_QB); A.ldq = 768; A.K = (const bf16_t*)(ws + WS_KB); A.ldk = 768; A.V = (const bf16_t*)(ws + WS_VB); A.O = (bf16_t*)(ws + WS_OB);
                A.masked = 0; A.band = 0; A.krow0 = 0; A.bias = nullptr; A.C = C96;
#if HEAD_PAIR
                if (u < 512) { const int bh = 2 * (u >> 3) + hp, qb = u & 7, b = bh >> 3, h = bh & 7;
                    A.qcol = h * QKD; A.kcol = h * QKD; A.vcol = h * 64; A.ocol = h * 64; A.q0 = b * SEQ + qb * 256; A.ctx0 = TX + b * CTXL; A.loc0 = b * SEQ; A.NT = 36; }
                else { const int v = u - 512; if (last || !(v & 1)) continue; const int bh = 2 * (v >> 1) + hp, b = bh >> 3, h = bh & 7;
#else
                if (u < 1024) { const int bh = u >> 3, qb = u & 7, b = bh >> 3, h = bh & 7;
                    A.qcol = h * QKD; A.kcol = h * QKD; A.vcol = h * 64; A.ocol = h * 64; A.q0 = b * SEQ + qb * 256; A.ctx0 = TX + b * CTXL; A.loc0 = b * SEQ; A.NT = 36; }
                else { const int v = u - 1024; if (last || !(v & 1)) continue; const int bh = v >> 1, b = bh >> 3, h = bh & 7;
#endif
                    A.qcol = h * QKD; A.kcol = h * QKD; A.vcol = h * 64; A.ocol = h * 64; A.q0 = TX + b * CTXL; A.ctx0 = TX + b * CTXL; A.loc0 = 0; A.NT = 4; }
                att::mla_unit(A, (char*)lds_raw);
              } }
            for (int r3_ = 0; r3_ < (((PH_DUP >> 21) & 1u) ? 2 : 1); ++r3_)
            { unsigned char* const ws = ws_ptr(); const float* const rpb = in_ptr<I_RPB>();
              att::na_mask_table((char*)lds_raw);
#if HEAD_PAIR
              for (int w_ = 2 * Fp.vcu; w_ < 2 * (512 + 128); w_ = (w_ & 1) ? w_ + 2 * G - 1 : w_ + 1) { const int u = w_ >> 1, hp = w_ & 1;
#else
              for (int u = Fp.vcu; u < 1024 + 256; u += G) {
#endif
                att::UnitArgs A; A.Q = (const bf16_t*)(ws + WS_QA); A.ldq = 512; A.K = (const bf16_t*)(ws + WS_KA); A.ldk = 512; A.V = (const bf16_t*)(ws + WS_VA); A.O = (bf16_t*)(ws + WS_OA); A.C = C64;
#if HEAD_PAIR
                if (u < 512) { const int bh = 2 * (u >> 3) + hp, band = u & 7, b = bh >> 3, h = bh & 7;
#else
                if (u < 1024) { const int bh = u >> 3, band = u & 7, b = bh >> 3, h = bh & 7;
#endif
                    A.qcol = h * 64; A.kcol = h * 64; A.vcol = h * 64; A.ocol = h * 64; A.q0 = b * SEQ + band * 256; A.ctx0 = TX + b * CTXL;
                    A.krow0 = min(max(4 * band - 4, 0), 20); A.loc0 = b * SEQ + 64 * A.krow0; A.NT = 10; A.masked = 1; A.band = band; A.bias = rpb + ((size_t)l * NHEAD + h) * 15 * 31; }
#if HEAD_PAIR
                else { const int v = u - 512; if (last || (v & 1)) continue; const int bh = 2 * (v >> 1) + hp, b = bh >> 3, h = bh & 7;
#else
                else { const int v = u - 1024; if (last || (v & 1)) continue; const int bh = v >> 1, b = bh >> 3, h = bh & 7;
#endif
                    A.qcol = h * 64; A.kcol = h * 64; A.vcol = h * 64; A.ocol = h * 64; A.q0 = TX + b * CTXL; A.ctx0 = TX + b * CTXL; A.loc0 = 0; A.NT = 4; A.masked = 0; A.band = 0; A.krow0 = 0; A.bias = nullptr; }
                att::attn_unit<64>(A, (char*)lds_raw);
              } }
        }
        SEAM(base + 3);
        if (IN(base + 4)) REPL(4) {
            FRESH(); unsigned char* const ws = ws_ptr();
#if MRG_F8
            pg8::SchedMerge S{(const char*)(ws + WS_OA), (const char*)(ws + WS_OB), (const char*)(ws + WS_WOA + (size_t)l * 1024 * 512), (const char*)(ws + WS_WOB + (size_t)l * 1024 * 512),
                              (size_t)256 * 512, mt_act, 4, G, c};
            pg8::EpiMerge E{(const bf16_t*)(ws + WS_GATES), (bf16_t*)(ws + WS_Y), 1.0f / (F8_SO * F8_SW)};
            pg8::gemm_phase<true>(Fp.lds, 256, S, E);
#else
            pg8::SchedMerge S{(const char*)(ws + WS_OA), (const char*)(ws + WS_OB), (const char*)((bf16_t*)(ws + WS_WOA) + (size_t)l * 1024 * 512), (const char*)((bf16_t*)(ws + WS_WOB) + (size_t)l * 1024 * 512),
                              (size_t)256 * 512 * 2, mt_act, 4, G, c};
            pg8::EpiMerge E{(const bf16_t*)(ws + WS_GATES), (bf16_t*)(ws + WS_Y), 1.0f};
            pg8::gemm_phase(Fp.lds, 512, S, E);
#endif
        }
        SEAM(base + 4);
        if (IN(base + 5)) REPL(5) {
            FRESH(); unsigned char* const ws = ws_ptr(); float* const outp = out_ptr();
#if C2_F8
            pg8::SchedRect S{(const char*)(ws + WS_Y), (const char*)(ws + WS_WOUT + (size_t)l * DM * DM), (size_t)256 * DM, mt_act, 4, G, c, 0, 0, 1};
            #if XRES_BF16
            pg8::EpiOut E{(l == 0) ? in_ptr<I_X>() : (const float*)nullptr, outp, in_ptr<I_CTX>(), (float*)(ws + WS_XB), (const float*)(ws + WS_MOD) + (size_t)l * 17 * NMODC, 2 * DM, 1.0f / (F8_SY * F8_SW)};
#else
            pg8::EpiOut E{(l == 0) ? in_ptr<I_X>() : (const float*)outp, outp, in_ptr<I_CTX>(), (float*)(ws + WS_XC), (const float*)(ws + WS_MOD) + (size_t)l * 17 * NMODC, 2 * DM, 1.0f / (F8_SY * F8_SW)};
#endif
            pg8::gemm_phase<true>(Fp.lds, DM / 2, S, E);
#else
            pg8::SchedRect S{(const char*)(ws + WS_Y), (const char*)((bf16_t*)(ws + WS_WOUT) + (size_t)l * DM * DM), (size_t)256 * DM * 2, mt_act, 4, G, c, 0, 0, 1};
            #if XRES_BF16
            pg8::EpiOut E{(l == 0) ? in_ptr<I_X>() : (const float*)nullptr, outp, in_ptr<I_CTX>(), (float*)(ws + WS_XB), (const float*)(ws + WS_MOD) + (size_t)l * 17 * NMODC, 2 * DM, 1.0f};
#else
            pg8::EpiOut E{(l == 0) ? in_ptr<I_X>() : (const float*)outp, outp, in_ptr<I_CTX>(), (float*)(ws + WS_XC), (const float*)(ws + WS_MOD) + (size_t)l * 17 * NMODC, 2 * DM, 1.0f};
#endif
            pg8::gemm_phase(Fp.lds, DM, S, E);
#endif
        }
        SEAM(base + 5);
        if (IN(base + 6)) REPL(6) { FRESH(); (void)G; (void)c; route_phase(Fp, l, ntok); }
        SEAM(base + 6);
        if (IN(base + 7)) REPL(7) { FRESH(); (void)G; (void)c; scatter_phase(Fp, l, ntok, F8LAYER(l)); }
        SEAM(base + 7);
        if (IN(base + 8)) REPL(8) {
            FRESH(); unsigned char* const ws = ws_ptr();
            LAS int* const tle = (LAS int*)(Fp.lds + EPI_OFF + 16384); tle[Fp.tid] = ld_i32_agent((const int*)(ws + WS_TILEE) + Fp.tid); __syncthreads();
            const int ntile = __builtin_amdgcn_readfirstlane(tle[511]);
            const char* const w13 = (const char*)((bf16_t*)(ws + WS_W13) + (size_t)l * NEXP * 2048 * DM);
#ifdef ONLY_BF16
            if (false) {} else
#endif
#ifdef ONLY_F8
            if (true)
#else
            if (F8LAYER(l))
#endif
            { pg8::SchedMoe S{(const char*)(ws + WS_HS), w13, (size_t)256 * DM, (size_t)2048 * DM, (size_t)256 * DM, tle, ntile, 8, G, c};
                pg8::EpiMoe1<true> E{(bf16_t*)(ws + WS_HMID), 1.0f / (F8_SH * F8_SW)};
                pg8::gemm_phase<true>(Fp.lds, DM / 2, S, E); }
            else { pg8::SchedMoe S{(const char*)(ws + WS_HS), w13, (size_t)256 * DM * 2, (size_t)2048 * DM * 2, (size_t)256 * DM * 2, tle, ntile, 8, G, c};
                pg8::EpiMoe1<false> E{(bf16_t*)(ws + WS_HMID), 1.0f};
                pg8::gemm_phase(Fp.lds, DM, S, E); }
        }
        SEAM(base + 8);
        if (IN(base + 9)) REPL(9) {
            FRESH(); unsigned char* const ws = ws_ptr();
            LAS int* const tle = (LAS int*)(Fp.lds + EPI_OFF + 16384); tle[Fp.tid] = ld_i32_agent((const int*)(ws + WS_TILEE) + Fp.tid); __syncthreads();
            const int ntile = __builtin_amdgcn_readfirstlane(tle[511]);
            const char* const w2 = (const char*)((bf16_t*)(ws + WS_W2) + (size_t)l * NEXP * DM * DM);
            if (F8LAYER(l)) { pg8::SchedMoe S{(const char*)(ws + WS_HMID), w2, (size_t)256 * DM, (size_t)DM * DM, (size_t)256 * DM, tle, ntile, 4, G, c};
                pg8::EpiMoe2 E{(bf16_t*)(ws + WS_YS), 1.0f / (F8_SM * F8_SW)};
                pg8::gemm_phase<true>(Fp.lds, DM / 2, S, E); }
            else { pg8::SchedMoe S{(const char*)(ws + WS_HMID), w2, (size_t)256 * DM * 2, (size_t)DM * DM * 2, (size_t)256 * DM * 2, tle, ntile, 4, G, c};
                pg8::EpiMoe2 E{(bf16_t*)(ws + WS_YS), 1.0f};
                pg8::gemm_phase(Fp.lds, DM, S, E); }
        }
        SEAM(base + 9);
        if (IN(base + 10)) REPL(10) { FRESH(); (void)G; (void)c; combine_phase(Fp, l, ntok, last); }
        if (!last) SEAM(base + 10);
    }
#undef IN
#undef SEAM
#undef GRID_BAR
}

extern "C" void kernel_launch(void* const* d_in, const int* in_sizes, int n_in, void* d_out, int out_size, void* d_ws, size_t ws_size, hipStream_t stream) {
    static int grid = 0;
    if (grid == 0) {
        if (n_in != 26 || out_size != TX * DM || ws_size < WS_END) { fprintf(stderr, "kernel_launch: unexpected problem (n_in %d, out %d, ws %zu < %zu); nothing launched\n", n_in, out_size, ws_size, (size_t)WS_END); grid = -1; return; }
        int dev = 0, cus = 0, per_cu = 0;
        if (hipGetDevice(&dev) != hipSuccess || hipDeviceGetAttribute(&cus, hipDeviceAttributeMultiprocessorCount, dev) != hipSuccess) { grid = -1; return; }
        if (hipFuncSetAttribute((const void*)fwd_kernel, hipFuncAttributeMaxDynamicSharedMemorySize, LDS_BYTES) != hipSuccess) { fprintf(stderr, "kernel_launch: hipFuncSetAttribute failed\n"); grid = -1; return; }
        if (hipOccupancyMaxActiveBlocksPerMultiprocessor(&per_cu, (const void*)fwd_kernel, 512, LDS_BYTES) != hipSuccess || per_cu < 1) fprintf(stderr, "kernel_launch: occupancy query reports %d blocks per CU\n", per_cu);
        (void)hipGetLastError();
        grid = cus;
    }
    if (grid < 0) return;
    (void)in_sizes;
    (void)hipMemsetAsync((char*)d_ws + WS_CTL, 0, CTL_BYTES, stream);
    Args a{};
    for (int i = 0; i < 26; ++i) a.in[i] = (const float*)d_in[i];
    a.out = (float*)d_out; a.ws = (unsigned char*)d_ws;
#if MK_SPLIT
    for (int p = 0; p < NPHASE; ++p) { a.ph_lo = p; a.ph_hi = p + 1; hipLaunchKernelGGL(fwd_kernel, dim3(grid), dim3(512), LDS_BYTES, stream, a); }
#else
    a.ph_lo = 0; a.ph_hi = NPHASE;
    hipLaunchKernelGGL(fwd_kernel, dim3(grid), dim3(512), LDS_BYTES, stream, a);
#endif
    const hipError_t le = hipPeekAtLastError();
    if (le != hipSuccess) fprintf(stderr, "kernel_launch: launch failed: %s\n", hipGetErrorName(le));
}
```

```cpp
#include <hip/hip_runtime.h>
#include <hip/hip_bf16.h>
#include <cstdio>
#include <cstdint>

#ifndef MK_SPLIT
#define MK_SPLIT 0
#endif

#define LAS __attribute__((address_space(3)))
#define GAS __attribute__((address_space(1)))
typedef unsigned short bf16_t;
typedef short bf16x8 __attribute__((ext_vector_type(8)));
typedef short s16x4 __attribute__((ext_vector_type(4)));
typedef float f32x4 __attribute__((ext_vector_type(4)));
typedef float f32x2 __attribute__((ext_vector_type(2)));
typedef float f32x16 __attribute__((ext_vector_type(16)));
typedef unsigned u32x4 __attribute__((ext_vector_type(4)));
typedef unsigned u32x2 __attribute__((ext_vector_type(2)));
#define RLX_AGENT __ATOMIC_RELAXED, __HIP_MEMORY_SCOPE_AGENT

constexpr int DM = 1024, NB = 16, SEQ = 2048, TX = NB * SEQ, CTXL = 256, TC = NB * CTXL, TALL = TX + TC;
constexpr int NHEAD = 8, GRIDW = 64;
constexpr int INC = 4256, INP = 4352;
constexpr int NEXP = 64, NMODC = 6 * DM;
constexpr int QLORA = 384, KVLORA = 256, QKD = 96, ROPED = 32;
constexpr int MT_X = TX / 256, MT_ALL = TALL / 256;
constexpr int NSLOT_MAX = 2 * TALL + NEXP * 256;
constexpr float RMS_EPS = 1e-6f;
constexpr int NLAYER = 2;
constexpr float F8_SW = 64.f, F8_SH = 16.f, F8_SM = 4.f;
#ifndef F8_FROM
#define F8_FROM 0
#endif
#define F8LAYER(l) ((l) >= F8_FROM)
#ifndef C2_F8
#define C2_F8 1
#endif
constexpr float F8_SY = 32.f;
#ifndef MRG_F8
#define MRG_F8 1
#endif
constexpr float F8_SO = 32.f;
#ifndef HEAD_PAIR
#define HEAD_PAIR MRG_F8
#endif
#ifndef YS_F8
#define YS_F8 1
#endif
constexpr float F8_SYS = 32.f;
#ifndef GATES_F8
#define GATES_F8 1
#endif
constexpr float F8_SG = 256.f;
#ifndef A2_F8
#define A2_F8 1
#endif

constexpr size_t al256(size_t x) { return (x + 255) & ~(size_t)255; }
constexpr size_t WS_CTL = 0, CTL_BYTES = 1u << 20;
constexpr size_t WS_MOD   = WS_CTL + CTL_BYTES;
constexpr size_t WS_ROPE  = WS_MOD + al256((size_t)NLAYER * 17 * NMODC * 4);
constexpr size_t WS_RSCQ  = WS_ROPE + al256(64 * 8 * 2 * 4);
constexpr size_t WS_RSCKV = WS_RSCQ + al256((size_t)TALL * 4);
constexpr size_t WS_SSKR  = WS_RSCKV + al256((size_t)TALL * 4);
constexpr size_t WS_TOKE  = WS_SSKR + al256((size_t)TALL * 4);
constexpr size_t WS_TOKW  = WS_TOKE + al256((size_t)TALL * 8);
constexpr size_t WS_TOKP  = WS_TOKW + al256((size_t)TALL * 8);
constexpr size_t WS_RSTD2 = WS_TOKP + al256((size_t)TALL * 8);
constexpr size_t WS_TILEE = WS_RSTD2 + al256((size_t)TALL * 8);
constexpr size_t WS_OFFS  = WS_TILEE + al256(512 * 4);
constexpr size_t WS_PART6 = WS_OFFS + al256(128 * 4);
constexpr size_t WS_PART7 = WS_PART6 + al256((size_t)TALL * 4 * 4);
constexpr size_t WS_PART8 = WS_PART7 + al256((size_t)TALL * 8 * 4);
constexpr size_t WS_WIN   = WS_PART8 + al256((size_t)TALL * 4 * 4);
constexpr size_t WS_WUQ   = WS_WIN + al256((size_t)NLAYER * INP * DM * 2);
constexpr size_t WS_WUKV  = WS_WUQ + al256((size_t)NLAYER * 1024 * QLORA * 2);
constexpr size_t WS_WOA   = WS_WUKV + al256((size_t)NLAYER * 1024 * KVLORA * 2);
constexpr size_t WS_WOB   = WS_WOA + al256((size_t)NLAYER * 1024 * 512 * 2);
constexpr size_t WS_WOUT  = WS_WOB + al256((size_t)NLAYER * 1024 * 512 * 2);
constexpr size_t WS_W13   = WS_WOUT + al256((size_t)NLAYER * 1024 * 1024 * 2);
constexpr size_t WS_W2    = WS_W13 + al256((size_t)NLAYER * NEXP * 2048 * 1024 * 2);
constexpr size_t WS_H     = WS_W2 + al256((size_t)NLAYER * NEXP * 1024 * 1024 * 2);
constexpr size_t WS_XC    = WS_H + al256((size_t)TALL * DM * 2);
constexpr size_t WS_ACT   = WS_XC + al256((size_t)TC * DM * 4);
constexpr size_t WS_QA    = WS_ACT;
constexpr size_t WS_KA    = WS_QA + al256((size_t)TALL * 512 * 2);
constexpr size_t WS_VA    = WS_KA + al256((size_t)TALL * 512 * 2);
constexpr size_t WS_ZCQ   = WS_VA + al256((size_t)TALL * 512 * 2);
constexpr size_t WS_ZCKV  = WS_ZCQ + al256((size_t)TALL * QLORA * 2);
constexpr size_t WS_ZKR   = WS_ZCKV + al256((size_t)TALL * KVLORA * 2);
constexpr size_t WS_GATES = WS_ZKR + al256((size_t)TALL * ROPED * 2);
constexpr size_t WS_QB    = WS_GATES + al256((size_t)TALL * 2048 * 2);
constexpr size_t WS_KB    = WS_QB + al256((size_t)TALL * 768 * 2);
constexpr size_t WS_VB    = WS_KB + al256((size_t)TALL * 768 * 2);
constexpr size_t WS_OA    = WS_VB + al256((size_t)TALL * 512 * 2);
constexpr size_t WS_OB    = WS_OA + al256((size_t)TALL * 512 * 2);
constexpr size_t WS_Y     = WS_OB + al256((size_t)TALL * 512 * 2);
constexpr size_t WS_MIX_END = WS_Y + al256((size_t)TALL * DM * 2);
constexpr size_t WS_HS    = WS_ACT;
constexpr size_t WS_HMID  = WS_HS + al256((size_t)NSLOT_MAX * DM * 2);
constexpr size_t WS_YS    = WS_HMID + al256((size_t)NSLOT_MAX * DM * 2);
constexpr size_t WS_MOE_END = WS_YS + al256((size_t)NSLOT_MAX * DM * 2);
constexpr size_t WS_END0  = (WS_MIX_END > WS_MOE_END) ? WS_MIX_END : WS_MOE_END;
#ifndef XRES_BF16
#define XRES_BF16 1
#endif
constexpr size_t WS_XB    = WS_END0;
constexpr size_t WS_WRF   = WS_XB + al256((size_t)TALL * DM * 2);
constexpr size_t WS_RBP   = WS_WRF + al256((size_t)NLAYER * 17 * 8 * 4 * 4 * 2 * 64 * 16);
constexpr size_t WS_END   = WS_RBP + al256((size_t)NLAYER * 17 * 8 * 64 * 4);

constexpr int CW_BAR = 4096;
constexpr int CW_CNT = 16384;

constexpr int RING_BYTES = 131072;
constexpr int EPI_OFF = RING_BYTES;
constexpr int MISC_OFF = RING_BYTES + 24576;
constexpr int LDS_BYTES = 160 * 1024;

__device__ __forceinline__ unsigned cvt_pk_bf16(float lo, float hi) { unsigned r; asm volatile("v_cvt_pk_bf16_f32 %0, %1, %2" : "=v"(r) : "v"(lo), "v"(hi)); return r; }
__device__ __forceinline__ unsigned cvt_pk4_fp8(float a, float b, float c, float d) {
    a = __builtin_amdgcn_fmed3f(a, -448.f, 448.f); b = __builtin_amdgcn_fmed3f(b, -448.f, 448.f); c = __builtin_amdgcn_fmed3f(c, -448.f, 448.f); d = __builtin_amdgcn_fmed3f(d, -448.f, 448.f);
    int w = 0; w = __builtin_amdgcn_cvt_pk_fp8_f32(a, b, w, false); w = __builtin_amdgcn_cvt_pk_fp8_f32(c, d, w, true); return (unsigned)w; }
__device__ __forceinline__ f32x4 fp8x4_f32(unsigned w) {
    const f32x2 lo = __builtin_amdgcn_cvt_pk_f32_fp8((int)w, false), hi = __builtin_amdgcn_cvt_pk_f32_fp8((int)w, true); return (f32x4){lo[0], lo[1], hi[0], hi[1]}; }
__device__ __forceinline__ float bf_lo(unsigned w) { return __uint_as_float(w << 16); }
__device__ __forceinline__ float bf_hi(unsigned w) { return __uint_as_float(w & 0xffff0000u); }
__device__ __forceinline__ float wave_sum(float v) {
#pragma unroll
    for (int o = 1; o < 64; o <<= 1) v += __shfl_xor(v, o);
    return v;
}
__device__ __forceinline__ float sigmoidf_(float x) { return __builtin_amdgcn_rcpf(1.0f + __expf(-x)); }
__device__ __forceinline__ int ld_i32_agent(const int* p) { return (int)__hip_atomic_load((const unsigned*)p, RLX_AGENT); }
#define XB_TMO      128
#define XB_XCNT(j)  (256  + 64 * (j))
#define XB_XSUB(j)  (1280 + 64 * (j))
#define XB_XGEN(j)  (2304 + 64 * (j))
#define XB_TOP      3328
#define XB_TOPGEN   3392
#define XCD_BAR_WORDS 3456
#define XB_SPIN_CAP (1u << 18)

__device__ __forceinline__ unsigned xb_ld(unsigned* p)              { return __hip_atomic_load(p, __ATOMIC_RELAXED, __HIP_MEMORY_SCOPE_AGENT); }
__device__ __forceinline__ unsigned xb_add(unsigned* p, unsigned v) { return __hip_atomic_fetch_add(p, v, __ATOMIC_RELAXED, __HIP_MEMORY_SCOPE_AGENT); }
__device__ __forceinline__ unsigned xb_xcc_id() { return (unsigned)__builtin_amdgcn_s_getreg((3 << 11) | 20) & 0xFu; }
#define XB_SPIN(cond, bar) do { unsigned _sp = 0; while (cond) { __builtin_amdgcn_s_sleep(1); \
    if ((++_sp & 255u) == 0u) { if (xb_ld(&(bar)[XB_TMO])) break; if (_sp > XB_SPIN_CAP) { atomicAdd(&(bar)[XB_TMO], 1u); break; } } } } while (0)

struct XcdBarrier {
    unsigned* bar; unsigned x;
    volatile LAS unsigned* st;
};

__device__ __forceinline__ XcdBarrier xcd_barrier_post(unsigned* bar, volatile LAS unsigned* st) {
    XcdBarrier b; b.bar = bar; b.x = xb_xcc_id(); b.st = st;
    if (threadIdx.x == 0) (void)xb_add(&bar[XB_XCNT(b.x)], 1u);
    return b;
}
__device__ __forceinline__ void xcd_barrier_complete(unsigned* bar, unsigned x, unsigned& nloc, unsigned& nx) {
    const unsigned G = gridDim.x * gridDim.y * gridDim.z;
    unsigned sum, cnt, mine, sp = 0u;
    for (;;) {
        sum = 0u; cnt = 0u; mine = 0u;
#pragma unroll
        for (unsigned j = 0; j < 16; ++j) { const unsigned c = xb_ld(&bar[XB_XCNT(j)]); sum += c; cnt += (c > 0u) ? 1u : 0u; mine = (j == x) ? c : mine; }
        if (sum == G) break;
        __builtin_amdgcn_s_sleep(1);
        if ((++sp & 255u) == 0u) { if (xb_ld(&bar[XB_TMO])) break; if (sp > XB_SPIN_CAP) { atomicAdd(&bar[XB_TMO], 1u); break; } }
    }
    nloc = mine > 0u ? mine : 1u; nx = cnt > 0u ? cnt : 1u;
}

__device__ __forceinline__ void xcd_barrier(const XcdBarrier& b) {
    asm volatile("s_waitcnt vmcnt(0)" ::: "memory");
    __syncthreads();
    if (threadIdx.x == 0) {
        unsigned* bar = b.bar;
        __builtin_amdgcn_s_waitcnt(0);
        unsigned nloc = b.st[0], nx = b.st[1];
        if (nloc == 0u) { xcd_barrier_complete(bar, b.x, nloc, nx); b.st[0] = nloc; b.st[1] = nx; }
        const unsigned old = xb_add(&bar[XB_XSUB(b.x)], 1u);
        const unsigned gen = old / nloc;
        if (old + 1u == (gen + 1u) * nloc) {
            __builtin_amdgcn_fence(__ATOMIC_RELEASE, "agent");
            asm volatile("s_waitcnt vmcnt(0)" ::: "memory");
            const unsigned og = xb_add(&bar[XB_TOP], 1u);
            const unsigned tg = og / nx;
            if (og + 1u == (tg + 1u) * nx) xb_add(&bar[XB_TOPGEN], 1u);
            else XB_SPIN(xb_ld(&bar[XB_TOPGEN]) == tg, bar);
            __builtin_amdgcn_fence(__ATOMIC_ACQUIRE, "agent");
            xb_add(&bar[XB_XGEN(b.x)], 1u);
            asm volatile("s_waitcnt vmcnt(0)" ::: "memory");
        } else {
            XB_SPIN(xb_ld(&bar[XB_XGEN(b.x)]) == gen, bar);
            __builtin_amdgcn_fence(__ATOMIC_ACQUIRE, "agent");
            asm volatile("s_waitcnt vmcnt(0)" ::: "memory");
        }
    }
    __syncthreads();
}

namespace pg8 {
constexpr int BM = 256, BK = 64, HALF = 128, HTB = HALF * BK * 2  , STAGE_BYTES = 8 * HTB, NXCD = 8, WGM = 8;
__host__ __device__ __forceinline__ int lds_byte(int r, int c) { const int st = (r >> 4) * 2 + (c >> 5), rr = r & 15, cc = c & 31, ob = rr * 64 + cc * 2; return st * 1024 + (ob ^ (((ob >> 9) & 1) << 5)); }
__host__ __device__ __forceinline__ void stage_rc(int b, int& R, int& C) { const int st = b / 1024, sb = b % 1024, swz = sb ^ (((sb >> 9) & 1) << 5); R = (st >> 1) * 16 + swz / 64; C = (st & 1) * 32 + (swz % 64) / 2; }
__host__ __device__ __forceinline__ int perm32(int rho) { const int n = rho >> 4, i = rho & 15; return 8 * (i >> 2) + 4 * n + (i & 3); }

struct Unit { int pm, pn, kind, e; };

__device__ __forceinline__ void rect_tile(int wgid_in, int nM, int nN, int& pm, int& pn) {
    const int nwg = nM * nN; int wgid = wgid_in;
    { const int q = nwg / NXCD, r = nwg % NXCD, xcd = wgid % NXCD, off = wgid / NXCD; wgid = (xcd < r ? xcd * (q + 1) : r * (q + 1) + (xcd - r) * q) + off; }
    const int nig = WGM * nN, gid = wgid / nig, fm = gid * WGM, gsz = (nM - fm) < WGM ? (nM - fm) : WGM;
    pm = fm + ((wgid % nig) % gsz); pn = (wgid % nig) / gsz;
}

typedef int i32x8 __attribute__((ext_vector_type(8)));
template <bool F8 = false, class Epi, class Sched>
__device__ __forceinline__ void gemm_phase(LAS unsigned char* lds, const int K, const Sched& S, const Epi& E) {
    int tid = threadIdx.x; asm volatile("" : "+v"(tid));
    const int wid = __builtin_amdgcn_readfirstlane(tid >> 6), lane = tid & 63, wr = wid >> 2, wc = wid & 3, fr = lane & 15, fq = lane >> 4;
    const int nt = K / BK;
    unsigned voffA[2], voffB[2];
#pragma unroll
    for (int i = 0; i < 2; ++i) { int R, C; stage_rc(tid * 16 + i * 8192, R, C); const int Rb = Epi::PERM ? ((R & ~31) + perm32(R & 31)) : R;
        voffA[i] = (unsigned)(R * K + C) * 2u; voffB[i] = (unsigned)(Rb * K + C) * 2u; }
    const size_t kstep = (size_t)(BK * 2);
    const size_t hstep = (size_t)HALF * K * 2;
    const unsigned ldsw = (unsigned)wid * 1024u;
    const int aoff = lds_byte(wr * 64 + fr, F8 ? fq * 16 : fq * 8), boff = lds_byte(wc * 32 + fr, F8 ? fq * 16 : fq * 8);
    constexpr int KSTEP = F8 ? 16 : 1024;
    int f8scale = 0x7F7F7F7F; asm volatile("" : "+v"(f8scale));
#define PG8_SA(b, h) (((b) * 2 + (h)) * HTB)
#define PG8_SB(b, h) ((4 + (b) * 2 + (h)) * HTB)
#define PG8_STAGE(bufoff, gbase, voff) do { _Pragma("unroll") for (int _i = 0; _i < 2; ++_i) \
        __builtin_amdgcn_global_load_lds((const unsigned*)((const char*)(gbase) + (voff)[_i]), (LAS unsigned*)(lds + (bufoff) + ldsw + _i * 8192), 16, 0, 0); } while (0)
#define PG8_LDA(dst, b, h) do { _Pragma("unroll") for (int m = 0; m < 4; ++m) _Pragma("unroll") for (int k = 0; k < 2; ++k) dst[m][k] = *(const LAS bf16x8*)(lds + PG8_SA(b, h) + aoff + m * 2048 + k * KSTEP); } while (0)
#define PG8_LDB(dst, b, h) do { _Pragma("unroll") for (int n = 0; n < 2; ++n) _Pragma("unroll") for (int k = 0; k < 2; ++k) dst[n][k] = *(const LAS bf16x8*)(lds + PG8_SB(b, h) + boff + n * 2048 + k * KSTEP); } while (0)
#define PG8_CAT(X) __builtin_shufflevector(__builtin_bit_cast(u32x4, (X)[0]), __builtin_bit_cast(u32x4, (X)[1]), 0, 1, 2, 3, 4, 5, 6, 7)
#define PG8_MMA(ai, bj, At, Bt) do { __builtin_amdgcn_s_setprio(1); \
        if constexpr (F8) { _Pragma("unroll") for (int m = 0; m < 4; ++m) _Pragma("unroll") for (int n = 0; n < 2; ++n) \
            asm volatile("v_mfma_scale_f32_16x16x128_f8f6f4 %0, %1, %2, %0, %3, %3 op_sel_hi:[0,0,0]" : "+v"(acc[ai][bj][m][n]) : "v"(__builtin_bit_cast(i32x8, PG8_CAT(Bt[n]))), "v"(__builtin_bit_cast(i32x8, PG8_CAT(At[m]))), "v"(f8scale)); } \
        else { _Pragma("unroll") for (int m = 0; m < 4; ++m) _Pragma("unroll") for (int n = 0; n < 2; ++n) _Pragma("unroll") for (int k = 0; k < 2; ++k) \
            acc[ai][bj][m][n] = __builtin_amdgcn_mfma_f32_16x16x32_bf16(Bt[n][k], At[m][k], acc[ai][bj][m][n], 0, 0, 0); } \
        __builtin_amdgcn_s_setprio(0); } while (0)
#define PG8_WAIT_V(n) asm volatile("s_waitcnt vmcnt(" #n ")" ::: "memory")
#define PG8_WAIT_L(n) asm volatile("s_waitcnt lgkmcnt(" #n ")" ::: "memory")
#define PG8_BAR __builtin_amdgcn_s_barrier()
#define PG8_SCHED __builtin_amdgcn_sched_barrier(0)
    Unit cur, nxt; int ui = 0;
    if (!S.next(0, cur)) return;
    f32x4 acc[2][2][4][2];
#pragma unroll
    for (int a = 0; a < 2; ++a)
#pragma unroll
        for (int b = 0; b < 2; ++b)
#pragma unroll
            for (int m = 0; m < 4; ++m)
#pragma unroll
                for (int n = 0; n < 2; ++n) acc[a][b][m][n] = (f32x4){0.f, 0.f, 0.f, 0.f};
    bf16x8 At[4][2], B0[2][2], B1[2][2];
    const char* cA = S.a_ptr(cur); const char* cB = S.b_ptr(cur);
    PG8_STAGE(PG8_SB(0, 0), cB, voffB); PG8_STAGE(PG8_SB(0, 1), cB + hstep, voffB); PG8_STAGE(PG8_SA(0, 0), cA, voffA); PG8_STAGE(PG8_SA(0, 1), cA + hstep, voffA);
    if (wr == 1) PG8_BAR;
    PG8_WAIT_V(2); PG8_BAR;
    PG8_STAGE(PG8_SB(1, 0), cB + kstep, voffB); PG8_STAGE(PG8_SA(1, 0), cA + kstep, voffA); PG8_STAGE(PG8_SB(1, 1), cB + hstep + kstep, voffB);
    PG8_WAIT_V(6); PG8_BAR;
    for (;;) {
        const bool has_next = S.next(ui + 1, nxt);
        const char* nA = has_next ? S.a_ptr(nxt) : cA; const char* nB = has_next ? S.b_ptr(nxt) : cB;
#pragma unroll 1
        for (int t = 0; t < nt; t += 2) {
            const bool last = (t == nt - 2);
            const char* a1 = cA + (size_t)(t + 1) * kstep;
            const char* a2 = last ? nA : cA + (size_t)(t + 2) * kstep; const char* b2 = last ? nB : cB + (size_t)(t + 2) * kstep;
            const char* a3 = a2 + kstep; const char* b3 = b2 + kstep;
            PG8_LDB(B0, 0, 0); PG8_LDB(B1, 0, 1); PG8_SCHED; PG8_LDA(At, 0, 0); PG8_STAGE(PG8_SA(1, 1), a1 + hstep, voffA);
            PG8_WAIT_V(8); PG8_WAIT_L(0); PG8_BAR; PG8_MMA(0, 0, At, B0); PG8_MMA(0, 1, At, B1); PG8_BAR; PG8_SCHED;
            PG8_LDA(At, 0, 1); PG8_STAGE(PG8_SB(0, 0), b2, voffB); PG8_STAGE(PG8_SB(0, 1), b2 + hstep, voffB); PG8_STAGE(PG8_SA(0, 0), a2, voffA);
            PG8_WAIT_V(8); PG8_WAIT_L(0); PG8_BAR; PG8_MMA(1, 0, At, B0); PG8_MMA(1, 1, At, B1); PG8_BAR; PG8_SCHED;
            PG8_LDB(B0, 1, 0); PG8_LDB(B1, 1, 1); PG8_SCHED; PG8_LDA(At, 1, 0); PG8_STAGE(PG8_SA(0, 1), a2 + hstep, voffA);
            PG8_WAIT_V(8); PG8_WAIT_L(0); PG8_BAR; PG8_MMA(0, 0, At, B0); PG8_MMA(0, 1, At, B1); PG8_BAR; PG8_SCHED;
            PG8_LDA(At, 1, 1); PG8_STAGE(PG8_SB(1, 0), b3, voffB); PG8_STAGE(PG8_SB(1, 1), b3 + hstep, voffB); PG8_STAGE(PG8_SA(1, 0), a3, voffA);
            PG8_WAIT_V(8); PG8_WAIT_L(0); PG8_BAR; PG8_MMA(1, 0, At, B0); PG8_MMA(1, 1, At, B1); PG8_BAR; PG8_SCHED;
        }
        if (wr == 0) PG8_BAR;
        if constexpr (F8) asm volatile("s_nop 15\n\ts_nop 7" ::: "memory");
        { int tz = threadIdx.x; asm volatile("" : "+v"(tz));
          const int wid2 = __builtin_amdgcn_readfirstlane(tz >> 6), lane2 = tz & 63; E(acc, cur, wid2 >> 2, wid2 & 3, lane2 & 15, lane2 >> 4); }
        if (!has_next) break;
        if (!(Epi::CHAIN && cur.kind == 0)) {
#pragma unroll
            for (int a = 0; a < 2; ++a)
#pragma unroll
                for (int b = 0; b < 2; ++b)
#pragma unroll
                    for (int m = 0; m < 4; ++m)
#pragma unroll
                        for (int n = 0; n < 2; ++n) acc[a][b][m][n] = (f32x4){0.f, 0.f, 0.f, 0.f};
        }
        cur = nxt; cA = nA; cB = nB; ++ui;
        if (wr == 1) PG8_BAR;
    }
    PG8_WAIT_V(0);
    PG8_BAR;
#undef PG8_SA
#undef PG8_SB
#undef PG8_STAGE
#undef PG8_LDA
#undef PG8_LDB
#undef PG8_MMA
#undef PG8_CAT
#undef PG8_WAIT_V
#undef PG8_WAIT_L
#undef PG8_BAR
#undef PG8_SCHED
}
}
namespace pg8 {
__device__ __forceinline__ u32x4 pack8(const f32x4 a, const f32x4 b) { u32x4 w; w.x = cvt_pk_bf16(a[0], a[1]); w.y = cvt_pk_bf16(a[2], a[3]); w.z = cvt_pk_bf16(b[0], b[1]); w.w = cvt_pk_bf16(b[2], b[3]); return w; }
__device__ __forceinline__ float sumsq4(const f32x4 a) { return (a[0] * a[0] + a[1] * a[1]) + (a[2] * a[2] + a[3] * a[3]); }
#define EPI_BAR() do { asm volatile("s_waitcnt lgkmcnt(0)" ::: "memory"); __builtin_amdgcn_s_barrier(); asm volatile("" ::: "memory"); } while (0)

struct EpiIn {
    static constexpr bool PERM = true, CHAIN = false;
    bf16_t *QA, *KA, *VA, *ZCQ, *ZCKV, *ZKR, *GATES; const float *qg, *kg; float *P6, *P7, *P8; float asc;
    __device__ __forceinline__ void operator()(f32x4 (&acc)[2][2][4][2], const Unit& u, int wr, int wc, int fr, int fq) const {
        const int row0 = u.pm * BM + wr * 64 + fr, pn = u.pn;
        if (asc != 1.0f) {
#pragma unroll
            for (int ai = 0; ai < 2; ++ai)
#pragma unroll
                for (int bj = 0; bj < 2; ++bj)
#pragma unroll
                    for (int m = 0; m < 4; ++m) { acc[ai][bj][m][0] = acc[ai][bj][m][0] * asc; acc[ai][bj][m][1] = acc[ai][bj][m][1] * asc; } }
        if (pn < 4) {
            const float* g = (pn < 2) ? qg : kg; bf16_t* dst = (pn < 2) ? QA : KA; const int head = 4 * (pn & 1) + wc;
            f32x4 gv[2][2];
#pragma unroll
            for (int bj = 0; bj < 2; ++bj)
#pragma unroll
                for (int n = 0; n < 2; ++n) gv[bj][n] = *(const f32x4*)(g + 32 * bj + 8 * fq + 4 * n);
#pragma unroll
            for (int ai = 0; ai < 2; ++ai)
#pragma unroll
                for (int m = 0; m < 4; ++m) {
                    const size_t row = (size_t)(row0 + ai * HALF + m * 16);
                    float ss = (sumsq4(acc[ai][0][m][0]) + sumsq4(acc[ai][0][m][1])) + (sumsq4(acc[ai][1][m][0]) + sumsq4(acc[ai][1][m][1]));
                    ss += __shfl_xor(ss, 16); ss += __shfl_xor(ss, 32);
                    const float rstd = rsqrtf(ss * (1.0f / 64.0f) + RMS_EPS);
#pragma unroll
                    for (int bj = 0; bj < 2; ++bj)
                        *(u32x4*)(dst + row * 512 + head * 64 + 32 * bj + 8 * fq) = pack8(acc[ai][bj][m][0] * rstd * gv[bj][0], acc[ai][bj][m][1] * rstd * gv[bj][1]);
                }
        } else if (pn >= 9) {
#pragma unroll
            for (int ai = 0; ai < 2; ++ai)
#pragma unroll
                for (int m = 0; m < 4; ++m) {
                    const size_t row = (size_t)(row0 + ai * HALF + m * 16);
#pragma unroll
                    for (int bj = 0; bj < 2; ++bj) { f32x4 a = acc[ai][bj][m][0], b = acc[ai][bj][m][1];
#pragma unroll
                        for (int j = 0; j < 4; ++j) { a[j] = sigmoidf_(a[j]); b[j] = sigmoidf_(b[j]); }
#if GATES_F8
                        { u32x2 w; w.x = cvt_pk4_fp8(a[0] * F8_SG, a[1] * F8_SG, a[2] * F8_SG, a[3] * F8_SG); w.y = cvt_pk4_fp8(b[0] * F8_SG, b[1] * F8_SG, b[2] * F8_SG, b[3] * F8_SG);
                          *(u32x2*)((unsigned char*)GATES + row * 2048 + (pn - 9) * 256 + 128 * bj + 32 * wc + 8 * fq) = w; } }
#else
                        *(u32x4*)(GATES + row * 2048 + (pn - 9) * 256 + 128 * bj + 32 * wc + 8 * fq) = pack8(a, b); }
#endif
                }
        } else {
#pragma unroll
            for (int ai = 0; ai < 2; ++ai)
#pragma unroll
                for (int m = 0; m < 4; ++m) {
                    const size_t row = (size_t)(row0 + ai * HALF + m * 16);
                    if (pn >= 6) {
                        float s0 = sumsq4(acc[ai][0][m][0]) + sumsq4(acc[ai][0][m][1]), s1 = sumsq4(acc[ai][1][m][0]) + sumsq4(acc[ai][1][m][1]);
                        s0 += __shfl_xor(s0, 16); s0 += __shfl_xor(s0, 32); s1 += __shfl_xor(s1, 16); s1 += __shfl_xor(s1, 32);
                        if (fq == 0) { if (pn == 6) P6[row * 4 + wc] = s0 + s1; else if (pn == 8) P8[row * 4 + wc] = s0 + s1; else { P7[row * 8 + wc] = s0; if (wc == 0) P7[row * 8 + 4] = s1; } } }
#pragma unroll
                    for (int bj = 0; bj < 2; ++bj) {
                        const u32x4 w = pack8(acc[ai][bj][m][0], acc[ai][bj][m][1]); const int cc = 128 * bj + 32 * wc + 8 * fq;
                        if (pn < 6) *(u32x4*)(VA + row * 512 + (pn - 4) * 256 + cc) = w;
                        else if (pn == 6) *(u32x4*)(ZCQ + row * QLORA + cc) = w;
                        else if (pn == 8) *(u32x4*)(ZCKV + row * KVLORA + cc) = w;
                        else { if (bj == 0) *(u32x4*)(ZCQ + row * QLORA + 256 + cc) = w; else if (wc == 0) *(u32x4*)(ZKR + row * ROPED + 8 * fq) = w; }
                    }
                }
        }
    }
};

__device__ __forceinline__ void rope8(float (&v)[8], const LAS float* rope, int s  , int fq) {
    const int pos = (fq < 2) ? (s >> 6) : (s & 63);
    const f32x4 c0 = *(const LAS f32x4*)(rope + pos * 8), c1 = *(const LAS f32x4*)(rope + pos * 8 + 4), s0 = *(const LAS f32x4*)(rope + 512 + pos * 8), s1 = *(const LAS f32x4*)(rope + 512 + pos * 8 + 4);
    const float cs[8] = {c0[0], c0[1], c0[2], c0[3], c1[0], c1[1], c1[2], c1[3]}, sn[8] = {s0[0], s0[1], s0[2], s0[3], s1[0], s1[1], s1[2], s1[3]};
#pragma unroll
    for (int i = 0; i < 8; ++i) { const float o = __shfl_xor(v[i], 16); v[i] = (fq & 1) ? (o * sn[i] + v[i] * cs[i]) : (v[i] * cs[i] - o * sn[i]); }
}

struct EpiQ {
    static constexpr bool PERM = true, CHAIN = false;
    bf16_t* QB; const float *p6, *p7, *g; const LAS float* rope; LAS float* P;
    __device__ __forceinline__ void operator()(f32x4 (&acc)[2][2][4][2], const Unit& u, int wr, int wc, int fr, int fq) const {
        const int row0 = u.pm * BM + wr * 64 + fr; const bool isx = u.pm < MT_X;
        float r8[8];
#pragma unroll
        for (int i = 0; i < 8; ++i) { const size_t row = (size_t)(row0 + (i >> 2) * HALF + (i & 3) * 16); const f32x4 a = *(const f32x4*)(p6 + row * 4), b = *(const f32x4*)(p7 + row * 8);
            r8[i] = rsqrtf((((a[0] + a[1]) + (a[2] + a[3])) + ((b[0] + b[1]) + (b[2] + b[3]))) * (1.0f / QLORA) + RMS_EPS); }
        const int gq = (wc < 3) ? wc : 0;
        const f32x4 g0 = *(const f32x4*)(g + 32 * gq + 8 * fq), g1 = *(const f32x4*)(g + 32 * gq + 8 * fq + 4);
#pragma unroll
        for (int ai = 0; ai < 2; ++ai)
#pragma unroll
            for (int m = 0; m < 4; ++m) {
                const float r = r8[ai * 4 + m]; const int rl = ai * 64 + m * 16 + fr;
#pragma unroll
                for (int bj = 0; bj < 2; ++bj) {
                    float ss = (sumsq4(acc[ai][bj][m][0]) + sumsq4(acc[ai][bj][m][1])) * (r * r); ss += __shfl_xor(ss, 16); ss += __shfl_xor(ss, 32);
                    if (fq == 0) P[((wr * 128 + rl) * 2 + bj) * 4 + wc] = ss; }
            }
        EPI_BAR();
        if (wc < 3) {
#pragma unroll
            for (int ai = 0; ai < 2; ++ai)
#pragma unroll
                for (int m = 0; m < 4; ++m) {
                    const int row = row0 + ai * HALF + m * 16, rl = ai * 64 + m * 16 + fr; const float r = r8[ai * 4 + m];
#pragma unroll
                    for (int bj = 0; bj < 2; ++bj) {
                        const f32x4 p = *(const LAS f32x4*)(P + ((wr * 128 + rl) * 2 + bj) * 4);
                        const float rstd = r * rsqrtf(((p[0] + p[1]) + p[2]) * (1.0f / 96.0f) + RMS_EPS);
                        const f32x4 a = acc[ai][bj][m][0] * rstd * g0, b = acc[ai][bj][m][1] * rstd * g1;
                        float v[8] = {a[0], a[1], a[2], a[3], b[0], b[1], b[2], b[3]};
                        if (wc == 2 && isx) rope8(v, rope, row & (SEQ - 1), fq);
                        u32x4 w; w.x = cvt_pk_bf16(v[0], v[1]); w.y = cvt_pk_bf16(v[2], v[3]); w.z = cvt_pk_bf16(v[4], v[5]); w.w = cvt_pk_bf16(v[6], v[7]);
                        *(u32x4*)(QB + (size_t)row * 768 + (2 * u.pn + bj) * QKD + 32 * wc + 8 * fq) = w;
                    }
                    asm volatile("" ::: "memory");
                }
        }
    }
};

struct EpiKV {
    static constexpr bool PERM = true, CHAIN = false;
    bf16_t *KB, *VB; const bf16_t* ZKR; const float *p7, *p8, *g; const LAS float* rope; LAS float* P;
    __device__ __forceinline__ void operator()(f32x4 (&acc)[2][2][4][2], const Unit& u, int wr, int wc, int fr, int fq) const {
        const int row0 = u.pm * BM + wr * 64 + fr; const bool isx = u.pm < MT_X;
        float r8[8], k8[8]; u32x4 zk8[8];
#pragma unroll
        for (int i = 0; i < 8; ++i) { const int row = row0 + (i >> 2) * HALF + (i & 3) * 16; const f32x4 a = *(const f32x4*)(p8 + (size_t)row * 4);
            k8[i] = p7[(size_t)row * 8 + 4]; r8[i] = rsqrtf(((a[0] + a[1]) + (a[2] + a[3])) * (1.0f / KVLORA) + RMS_EPS);
            zk8[i] = (u32x4){0u, 0u, 0u, 0u}; if (wc == 2) zk8[i] = *(const u32x4*)(ZKR + (size_t)row * ROPED + 8 * fq); }
        const int gofs = (wc < 2) ? (32 * wc + 8 * fq) : (64 + 8 * fq);
        const f32x4 g0 = *(const f32x4*)(g + gofs), g1 = *(const f32x4*)(g + gofs + 4);
        if (wc < 2) {
#pragma unroll
            for (int ai = 0; ai < 2; ++ai)
#pragma unroll
                for (int m = 0; m < 4; ++m) { const float r = r8[ai * 4 + m]; const int rl = ai * 64 + m * 16 + fr;
#pragma unroll
                    for (int bj = 0; bj < 2; ++bj) { float ss = (sumsq4(acc[ai][bj][m][0]) + sumsq4(acc[ai][bj][m][1])) * (r * r); ss += __shfl_xor(ss, 16); ss += __shfl_xor(ss, 32);
                        if (fq == 0) P[((wr * 128 + rl) * 2 + bj) * 4 + wc] = ss + ((wc == 0) ? k8[ai * 4 + m] : 0.f); } }
        }
        EPI_BAR();
#pragma unroll
        for (int ai = 0; ai < 2; ++ai)
#pragma unroll
            for (int m = 0; m < 4; ++m) {
                const int row = row0 + ai * HALF + m * 16, rl = ai * 64 + m * 16 + fr;
                const float rr = r8[ai * 4 + m]; const u32x4 zk = zk8[ai * 4 + m];
#pragma unroll
                for (int bj = 0; bj < 2; ++bj) {
                    const int head = 2 * u.pn + bj;
                    const f32x4 p = *(const LAS f32x4*)(P + ((wr * 128 + rl) * 2 + bj) * 4);
                    const float rstd = rsqrtf((p[0] + p[1]) * (1.0f / 96.0f) + RMS_EPS);
                    if (wc < 2) {
                        *(u32x4*)(KB + (size_t)row * 768 + head * QKD + 32 * wc + 8 * fq) = pack8(acc[ai][bj][m][0] * (rr * rstd) * g0, acc[ai][bj][m][1] * (rr * rstd) * g1);
                    } else {
                        *(u32x4*)(VB + (size_t)row * 512 + head * 64 + 32 * (wc - 2) + 8 * fq) = pack8(acc[ai][bj][m][0] * rr, acc[ai][bj][m][1] * rr);
                        if (wc == 2) {
                            float v[8] = {bf_lo(zk.x) * rstd * g0[0], bf_hi(zk.x) * rstd * g0[1], bf_lo(zk.y) * rstd * g0[2], bf_hi(zk.y) * rstd * g0[3],
                                          bf_lo(zk.z) * rstd * g1[0], bf_hi(zk.z) * rstd * g1[1], bf_lo(zk.w) * rstd * g1[2], bf_hi(zk.w) * rstd * g1[3]};
                            if (isx) rope8(v, rope, row & (SEQ - 1), fq);
                            u32x4 w; w.x = cvt_pk_bf16(v[0], v[1]); w.y = cvt_pk_bf16(v[2], v[3]); w.z = cvt_pk_bf16(v[4], v[5]); w.w = cvt_pk_bf16(v[6], v[7]);
                            *(u32x4*)(KB + (size_t)row * 768 + head * QKD + 64 + 8 * fq) = w;
                        }
                    }
                }
                asm volatile("" ::: "memory");
            }
    }
};

struct EpiMerge {
    static constexpr bool PERM = true, CHAIN = true;
    const bf16_t* GATES; bf16_t* Y; float asc;
    __device__ __forceinline__ void operator()(f32x4 (&acc)[2][2][4][2], const Unit& u, int wr, int wc, int fr, int fq) const {
        const int row0 = u.pm * BM + wr * 64 + fr;
#pragma unroll
        for (int ai = 0; ai < 2; ++ai)
#pragma unroll
            for (int m = 0; m < 4; ++m) {
                const size_t row = (size_t)(row0 + ai * HALF + m * 16);
#pragma unroll
                for (int bj = 0; bj < 2; ++bj) {
                    const int col = u.pn * 256 + 128 * bj + 32 * wc + 8 * fq;
#if GATES_F8
                    const u32x2 gb = *(const u32x2*)((const unsigned char*)GATES + row * 2048 + 1024 + col);
                    const f32x4 b0 = fp8x4_f32(gb.x) * (1.0f / F8_SG), b1 = fp8x4_f32(gb.y) * (1.0f / F8_SG);
#else
                    const u32x4 gb = *(const u32x4*)(GATES + row * 2048 + 1024 + col);
                    const f32x4 b0 = (f32x4){bf_lo(gb.x), bf_hi(gb.x), bf_lo(gb.y), bf_hi(gb.y)}, b1 = (f32x4){bf_lo(gb.z), bf_hi(gb.z), bf_lo(gb.w), bf_hi(gb.w)};
#endif
                    if (u.kind == 0) {
#if GATES_F8
                        const u32x2 ga = *(const u32x2*)((const unsigned char*)GATES + row * 2048 + col);
                        const f32x4 a0 = fp8x4_f32(ga.x) * (1.0f / F8_SG), a1 = fp8x4_f32(ga.y) * (1.0f / F8_SG);
#else
                        const u32x4 ga = *(const u32x4*)(GATES + row * 2048 + col);
                        const f32x4 a0 = (f32x4){bf_lo(ga.x), bf_hi(ga.x), bf_lo(ga.y), bf_hi(ga.y)}, a1 = (f32x4){bf_lo(ga.z), bf_hi(ga.z), bf_lo(ga.w), bf_hi(ga.w)};
#endif
#pragma unroll
                        for (int j = 0; j < 4; ++j) { acc[ai][bj][m][0][j] *= a0[j] * __builtin_amdgcn_rcpf(b0[j]); acc[ai][bj][m][1][j] *= a1[j] * __builtin_amdgcn_rcpf(b1[j]); }
                    } else {
#if C2_F8
                        { const f32x4 y0 = acc[ai][bj][m][0] * b0 * (F8_SY * asc), y1 = acc[ai][bj][m][1] * b1 * (F8_SY * asc); u32x2 w; w.x = cvt_pk4_fp8(y0[0], y0[1], y0[2], y0[3]); w.y = cvt_pk4_fp8(y1[0], y1[1], y1[2], y1[3]);
                          *(u32x2*)((unsigned char*)Y + row * 1024 + col) = w; }
#else
                        *(u32x4*)(Y + row * 1024 + col) = pack8(acc[ai][bj][m][0] * b0 * asc, acc[ai][bj][m][1] * b1 * asc);
#endif
                    }
                }
            }
    }
};

struct EpiOut {
    static constexpr bool PERM = false, CHAIN = false;
    const float* xsrc; float* xdst; const float* csrc; float* cdst; const float* mod  ; int goff; float asc;
    __device__ __forceinline__ void operator()(f32x4 (&acc)[2][2][4][2], const Unit& u, int wr, int wc, int fr, int fq) const {
        const bool isx = u.pm < MT_X;
        const int rowt = (isx ? u.pm : u.pm - MT_X) * BM + wr * 64 + fr;
        const float* src = isx ? xsrc : csrc; float* dst = isx ? xdst : cdst;
        const float* gm = mod + (size_t)(isx ? (u.pm >> 3) : 16) * NMODC + goff;
        const int col0 = u.pn * BM + wc * 32 + 4 * fq;
        f32x4 gv[2][2];
#pragma unroll
        for (int bj = 0; bj < 2; ++bj)
#pragma unroll
            for (int n = 0; n < 2; ++n) gv[bj][n] = *(const f32x4*)(gm + col0 + bj * HALF + n * 16) * asc;
#pragma unroll
        for (int ai = 0; ai < 2; ++ai)
#pragma unroll
            for (int m = 0; m < 4; ++m) { const size_t off = (size_t)(rowt + ai * HALF + m * 16) * DM + col0;
#if XRES_BF16
                bf16_t* const xb = (bf16_t*)cdst + (size_t)(u.pm * BM + wr * 64 + fr + ai * HALF + m * 16) * DM + col0; (void)dst; const bool src_xb = (xsrc == nullptr);
#pragma unroll
                for (int bj = 0; bj < 2; ++bj)
#pragma unroll
                    for (int n = 0; n < 2; ++n) { f32x4 xs;
                        if (src_xb) { const u32x2 w = *(const u32x2*)(xb + bj * HALF + n * 16); xs = (f32x4){bf_lo(w.x), bf_hi(w.x), bf_lo(w.y), bf_hi(w.y)}; }
                        else xs = *(const f32x4*)(src + off + bj * HALF + n * 16);
                        const f32x4 r = xs + gv[bj][n] * acc[ai][bj][m][n]; u32x2 o; o.x = cvt_pk_bf16(r[0], r[1]); o.y = cvt_pk_bf16(r[2], r[3]); *(u32x2*)(xb + bj * HALF + n * 16) = o; }
#else
#pragma unroll
                for (int bj = 0; bj < 2; ++bj)
#pragma unroll
                    for (int n = 0; n < 2; ++n) { const f32x4 xs = *(const f32x4*)(src + off + bj * HALF + n * 16); *(f32x4*)(dst + off + bj * HALF + n * 16) = xs + gv[bj][n] * acc[ai][bj][m][n]; }
#endif
            }
    }
};

template <bool F8> struct EpiMoe1 {
    static constexpr bool PERM = true, CHAIN = false;
    bf16_t* HM; float ascale;
    __device__ __forceinline__ void operator()(f32x4 (&acc)[2][2][4][2], const Unit& u, int wr, int wc, int fr, int fq) const {
        const int row0 = u.pm * BM + wr * 64 + fr;
#pragma unroll
        for (int ai = 0; ai < 2; ++ai)
#pragma unroll
            for (int m = 0; m < 4; ++m) { const size_t row = (size_t)(row0 + ai * HALF + m * 16);
#pragma unroll
                for (int bj = 0; bj < 2; ++bj) { f32x4 p = acc[ai][bj][m][0], q = acc[ai][bj][m][1];
                    if (F8) { p = p * ascale; q = q * ascale; }
                    const float h0 = p[0] * sigmoidf_(p[0]) * p[1], h1 = p[2] * sigmoidf_(p[2]) * p[3], h2 = q[0] * sigmoidf_(q[0]) * q[1], h3 = q[2] * sigmoidf_(q[2]) * q[3];
                    const int col = u.pn * 128 + 64 * bj + 16 * wc + 4 * fq;
                    if (F8) *(unsigned*)((unsigned char*)HM + row * DM + col) = cvt_pk4_fp8(h0 * F8_SM, h1 * F8_SM, h2 * F8_SM, h3 * F8_SM);
                    else { u32x2 w; w.x = cvt_pk_bf16(h0, h1); w.y = cvt_pk_bf16(h2, h3); *(u32x2*)(HM + row * DM + col) = w; } }
            }
    }
};
struct EpiMoe2 {
    static constexpr bool PERM = true, CHAIN = false;
    bf16_t* YS; float ascale;
    __device__ __forceinline__ void operator()(f32x4 (&acc)[2][2][4][2], const Unit& u, int wr, int wc, int fr, int fq) const {
        const int row0 = u.pm * BM + wr * 64 + fr;
#pragma unroll
        for (int ai = 0; ai < 2; ++ai)
#pragma unroll
            for (int m = 0; m < 4; ++m) { const size_t row = (size_t)(row0 + ai * HALF + m * 16);
#pragma unroll
#if YS_F8
                for (int bj = 0; bj < 2; ++bj) { const f32x4 y0 = acc[ai][bj][m][0] * (ascale * F8_SYS), y1 = acc[ai][bj][m][1] * (ascale * F8_SYS); u32x2 w; w.x = cvt_pk4_fp8(y0[0], y0[1], y0[2], y0[3]); w.y = cvt_pk4_fp8(y1[0], y1[1], y1[2], y1[3]);
                    *(u32x2*)((unsigned char*)YS + row * DM + u.pn * 256 + 128 * bj + 32 * wc + 8 * fq) = w; } }
#else
                for (int bj = 0; bj < 2; ++bj) *(u32x4*)(YS + row * DM + u.pn * 256 + 128 * bj + 32 * wc + 8 * fq) = pack8(acc[ai][bj][m][0] * ascale, acc[ai][bj][m][1] * ascale); }
#endif
    }
};

struct SchedRect {
    const char* A; const char* B; size_t tstep; int nM, nN, G, c, nM2, pn2, npn2;
    __device__ __forceinline__ bool next(int i, Unit& u) const {
        const int L = i * G + c, mainc = nM * nN; u.kind = 0; u.e = 0;
        if (L < mainc) { rect_tile(L, nM, nN, u.pm, u.pn); return true; }
        const int Lx = L - mainc; if (Lx >= nM2 * npn2) return false;
        u.pm = nM + Lx / npn2; u.pn = pn2 + Lx % npn2; return true;
    }
    __device__ __forceinline__ const char* a_ptr(const Unit& u) const { return A + (size_t)u.pm * tstep; }
    __device__ __forceinline__ const char* b_ptr(const Unit& u) const { return B + (size_t)u.pn * tstep; }
};
struct SchedMerge {
    const char *OA, *OB, *WA, *WB; size_t tstep; int nM, nN, G, c;
    __device__ __forceinline__ bool next(int i, Unit& u) const {
        const int L = (i >> 1) * G + c; if (L >= nM * nN) return false;
        rect_tile(L, nM, nN, u.pm, u.pn); u.kind = i & 1; u.e = 0; return true;
    }
    __device__ __forceinline__ const char* a_ptr(const Unit& u) const { return (u.kind ? OB : OA) + (size_t)u.pm * tstep; }
    __device__ __forceinline__ const char* b_ptr(const Unit& u) const { return (u.kind ? WB : WA) + (size_t)u.pn * tstep; }
};
struct SchedMoe {
    const char* A; const char* W; size_t tstepA, wstride, tstepB; const LAS int* tile_e  ; int ntile, nN, G, c;
    __device__ __forceinline__ bool next(int i, Unit& u) const {
        const int L = i * G + c; if (L >= ntile * nN) return false;
        rect_tile(L, ntile, nN, u.pm, u.pn); u.kind = 0;
        u.e = __builtin_amdgcn_readfirstlane(tile_e[u.pm]); return true;
    }
    __device__ __forceinline__ const char* a_ptr(const Unit& u) const { return A + (size_t)u.pm * tstepA; }
    __device__ __forceinline__ const char* b_ptr(const Unit& u) const { return W + (size_t)u.e * wstride + (size_t)u.pn * tstepB; }
};
}
namespace att {
constexpr int NW = 8, QBLK = 32, KVBLK = 64, DV = 64;
constexpr int SHM_V = 16384, SHM_K = 16384;
constexpr int LDS_VOFF = 0, LDS_KOFF = 2 * SHM_V, LDS_WS = LDS_KOFF + 2 * SHM_K, LDS_OST = LDS_WS + NW * 64 * 4, LDS_BIAS = LDS_OST + NW * 4096, LDS_MASK = LDS_BIAS + 16 * 128 * 4, LDS_END = LDS_MASK + 64 * 64 * 4;
static_assert(LDS_END <= RING_BYTES, "attention LDS map");
template <int DQK> struct KL { static constexpr int PITCH = (DQK == 64) ? 128 : 256; };
#define KSWZ(row, colB) ((row) * KL<DQK>::PITCH + ((colB) ^ (((row) & ((DQK == 96) ? 15 : 7)) << 4)))
#define SBAR() __builtin_amdgcn_sched_barrier(0)
__device__ __forceinline__ int crow(int r, int hi) { return (r & 3) + 8 * (r >> 2) + 4 * hi; }
__device__ __forceinline__ int v_st(int k, int c) { const int kk = (k & ~0xC) | ((k & 4) << 1) | ((k & 8) >> 1); return ((kk >> 3) * 2 + (c >> 5)) * 512 + ((kk & 7) * 32 + (c & 31)) * 2; }
__device__ __forceinline__ int v_rd_base(int lane, int c) { const int hi = (lane >> 5) & 1, g = c + hi;
    return ((lane & 3) << 3) | (((lane >> 2) & 3) << 6) | (((lane >> 4) & 1) << 5) | ((g & 1) << 8) | ((g >> 1) << 11); }
constexpr int v_rd_off(int d0, int ks, int half) { return ((2 * ks + half) * 2 + d0) * 512; }
template <int OFF> __device__ __forceinline__ s16x4 tr_read(int vb) { s16x4 r; asm volatile("ds_read_b64_tr_b16 %0, %1 offset:%2" : "=&v"(r) : "v"(vb), "i"(OFF) : "memory"); return r; }

template <int D0> __device__ __forceinline__ void pv_one(f32x16& od, int vbA, int vbB, bf16x8 pa0, bf16x8 pa1, bf16x8 pa2, bf16x8 pa3) {
    const s16x4 l0 = tr_read<v_rd_off(D0, 0, 0)>(vbA), h0 = tr_read<v_rd_off(D0, 0, 1)>(vbA), l1 = tr_read<v_rd_off(D0, 1, 0)>(vbA), h1 = tr_read<v_rd_off(D0, 1, 1)>(vbA);
    const s16x4 l2 = tr_read<v_rd_off(D0, 0, 0)>(vbB), h2 = tr_read<v_rd_off(D0, 0, 1)>(vbB), l3 = tr_read<v_rd_off(D0, 1, 0)>(vbB), h3 = tr_read<v_rd_off(D0, 1, 1)>(vbB);
    asm volatile("s_waitcnt lgkmcnt(0)" ::: "memory"); SBAR();
#define PK(L, H) (bf16x8){L[0], L[1], L[2], L[3], H[0], H[1], H[2], H[3]}
    od = __builtin_amdgcn_mfma_f32_32x32x16_bf16(pa0, PK(l0, h0), od, 0, 0, 0);
    od = __builtin_amdgcn_mfma_f32_32x32x16_bf16(pa1, PK(l1, h1), od, 0, 0, 0);
    od = __builtin_amdgcn_mfma_f32_32x32x16_bf16(pa2, PK(l2, h2), od, 0, 0, 0);
    od = __builtin_amdgcn_mfma_f32_32x32x16_bf16(pa3, PK(l3, h3), od, 0, 0, 0);
#undef PK
}
__device__ __forceinline__ void pv_all(f32x16* o, int vbA, int vbB, bf16x8 pa0, bf16x8 pa1, bf16x8 pa2, bf16x8 pa3) { pv_one<0>(o[0], vbA, vbB, pa0, pa1, pa2, pa3); pv_one<1>(o[1], vbA, vbB, pa0, pa1, pa2, pa3); }

#define MX3(a, b, c) __builtin_fmaxf(__builtin_fmaxf((a), (b)), (c))
template <bool FIRST>
__device__ __forceinline__ void partialSM(f32x16& p0, f32x16& p1, float& m_reg, float& alpha, f32x16& negm, const float THR2) {
    float a = MX3(p0[0], p0[1], p1[0]), b = MX3(p0[2], p0[3], p1[1]); a = MX3(a, p1[2], p1[3]);
#pragma unroll
    for (int r = 4; r < 16; r += 4) { a = MX3(a, p0[r], p0[r + 1]); b = MX3(b, p0[r + 2], p0[r + 3]); a = MX3(a, p1[r], p1[r + 1]); b = MX3(b, p1[r + 2], p1[r + 3]); }
    float pmax = __builtin_fmaxf(a, b);
    { auto rr = __builtin_amdgcn_permlane32_swap(__float_as_uint(pmax), __float_as_uint(pmax), false, false); pmax = __builtin_fmaxf(__uint_as_float(rr[0]), __uint_as_float(rr[1])); }
    alpha = 1.f;
    if (FIRST || !__builtin_expect(__all(pmax <= THR2), 1)) {
        const float dl = FIRST ? pmax : __builtin_fmaxf(pmax, 0.f);
        m_reg += dl; alpha = FIRST ? 1.f : __builtin_amdgcn_exp2f(-dl);
#pragma unroll
        for (int r = 0; r < 16; ++r) { p0[r] -= dl; p1[r] -= dl; }
#pragma unroll
        for (int r = 0; r < 16; ++r) negm[r] = -m_reg;
    }
#pragma unroll
    for (int r = 0; r < 16; ++r) p0[r] = __builtin_amdgcn_exp2f(p0[r]);
}
__device__ __forceinline__ void finishSM(f32x16& p0, f32x16& p1, float alpha, float& l_reg, bf16x8& pa0, bf16x8& pa1, bf16x8& pa2, bf16x8& pa3) {
#pragma unroll
    for (int r = 0; r < 16; ++r) p1[r] = __builtin_amdgcn_exp2f(p1[r]);
    float ps = 0;
#pragma unroll
    for (int r = 0; r < 16; ++r) ps += p0[r];
#pragma unroll
    for (int r = 0; r < 16; ++r) ps += p1[r];
    { auto rr = __builtin_amdgcn_permlane32_swap(__float_as_uint(ps), __float_as_uint(ps), false, false); ps = __uint_as_float(rr[0]) + __uint_as_float(rr[1]); }
    l_reg = l_reg * alpha + ps;
#define PK4(P, BASE, OUT) do { unsigned a0 = cvt_pk_bf16(P[BASE + 0], P[BASE + 1]), a1 = cvt_pk_bf16(P[BASE + 2], P[BASE + 3]);   \
    unsigned b0 = cvt_pk_bf16(P[BASE + 4], P[BASE + 5]), b1 = cvt_pk_bf16(P[BASE + 6], P[BASE + 7]);                              \
    auto r0 = __builtin_amdgcn_permlane32_swap(a0, b0, false, false); auto r1 = __builtin_amdgcn_permlane32_swap(a1, b1, false, false); \
    u32x4 w = {r0[0], r1[0], r0[1], r1[1]}; OUT = *reinterpret_cast<bf16x8*>(&w); } while (0)
    PK4(p0, 0, pa0); PK4(p0, 8, pa1); PK4(p1, 0, pa2); PK4(p1, 8, pa3);
#undef PK4
}
template <int DQK> __device__ __forceinline__ void qkt(f32x16& p0, f32x16& p1, const char* Ks, int rowA, int rowB, const bf16x8* qr, const f32x16& negm, int hi) {
#pragma unroll
    for (int d0 = 0; d0 < DQK / 16; ++d0) { const int cb = (d0 * 16 + hi * 8) * 2;
        const bf16x8 b0 = *reinterpret_cast<const bf16x8*>(Ks + KSWZ(rowA, cb));
        const bf16x8 b1 = *reinterpret_cast<const bf16x8*>(Ks + KSWZ(rowB, cb));
        if (d0 == 0) { p0 = __builtin_amdgcn_mfma_f32_32x32x16_bf16(b0, qr[0], negm, 0, 0, 0); p1 = __builtin_amdgcn_mfma_f32_32x32x16_bf16(b1, qr[0], negm, 0, 0, 0); }
        else { p0 = __builtin_amdgcn_mfma_f32_32x32x16_bf16(b0, qr[d0], p0, 0, 0, 0); p1 = __builtin_amdgcn_mfma_f32_32x32x16_bf16(b1, qr[d0], p1, 0, 0, 0); } }
}

struct UnitArgs {
    const bf16_t* Q; int ldq; int qcol;
    const bf16_t* K; int ldk; int kcol;
    const bf16_t* V; int vcol;
    bf16_t* O; int ocol;
    int q0;
    int ctx0, loc0;
    int NT;
    int masked;
    int band, krow0;
    const float* bias;
    float C;
};

__device__ __forceinline__ void na_mask(f32x16& p0, f32x16& p1, const LAS float* bt, const LAS float* mk, int krA, int qrow, int qc, int kc0, int hi) {
    const int rs = min(max(qrow - 4, 0), 24);
    const int drA = ((krA >= rs) && (krA < rs + 8)) ? (krA - qrow + 7) : 15, drB = ((krA + 1 >= rs) && (krA + 1 < rs + 8)) ? (krA + 1 - qrow + 7) : 15;
    const LAS float* bA = bt + drA * 128 + (kc0 + 4 * hi - qc + 64); const LAS float* bB = bt + drB * 128 + (kc0 + 4 * hi - qc + 64);
    const LAS float* mq = mk + qc * 64 + kc0 + 4 * hi;
#pragma unroll
    for (int g = 0; g < 4; ++g) {
        const f32x4 m0 = *(const LAS f32x4*)(mq + 8 * g);
#pragma unroll
        for (int j = 0; j < 4; ++j) { p0[4 * g + j] = (p0[4 * g + j] + bA[8 * g + j]) + m0[j]; p1[4 * g + j] = (p1[4 * g + j] + bB[8 * g + j]) + m0[j]; }
    }
}
__device__ __forceinline__ void na_mask_table(char* lds) {
    LAS float* mk = (LAS float*)(lds + LDS_MASK);
    int t0 = threadIdx.x; asm volatile("" : "+v"(t0));
    for (int i = t0; i < 64 * 64; i += 512) { const int qc = i >> 6, kc = i & 63, cs = min(max(qc - 8, 0), 48); mk[i] = ((unsigned)(kc - cs) < 16u) ? 0.f : -1e30f; }
}

template <int DQK>
__device__ __forceinline__ void attn_unit(const UnitArgs& A, char* lds) {
    int tid = threadIdx.x; asm volatile("" : "+v"(tid));
    const int wid = tid >> 6, lane = tid & 63, r32 = lane & 31, hi = lane >> 5;
    char* V_lds = lds + LDS_VOFF; char* K_lds = lds + LDS_KOFF;
    float* ws = (float*)(lds + LDS_WS) + wid * 64; float* li_l = ws; float* al_l = ws + 32;
    const LAS float* bt = (const LAS float*)(lds + LDS_BIAS); const LAS float* mk = (const LAS float*)(lds + LDS_MASK);
    const float C = A.C, THR2 = 8.0f * 1.4426950408889634f;
    const bool msk = (DQK == 64) && A.masked;
    float m_reg = 0.f, l_reg = 0; f32x16 o[2] = {}; bf16x8 qr[DQK / 16]; f32x16 negm = f32x16{};
    if (msk) { for (int i = tid; i < 16 * 128; i += 512) { const int dr = i >> 7, d = (i & 127) - 64;
            ((LAS float*)(lds + LDS_BIAS))[i] = (dr == 15) ? -1e30f : ((d >= -15 && d <= 15) ? A.bias[dr * 31 + d + 15] * 1.4426950408889634f : 0.f); } }
    const int qrow = 4 * A.band + 2 * (wid >> 2) + (r32 >> 4), qc = 16 * (wid & 3) + (r32 & 15);
    const int kc0 = msk ? min(max(16 * (wid & 3) - 8, 0), 32) : 0;
    const int qtok = msk ? (A.q0 + 64 * (2 * (wid >> 2) + (r32 >> 4)) + qc) : (A.q0 + wid * QBLK + r32);
    const bf16_t* Qw = A.Q + (size_t)qtok * A.ldq + A.qcol + hi * 8;
#pragma unroll
    for (int d0 = 0; d0 < DQK / 16; ++d0) { const u32x4 w = *reinterpret_cast<const u32x4*>(Qw + d0 * 16);
        u32x4 t; t.x = cvt_pk_bf16(bf_lo(w.x) * C, bf_hi(w.x) * C); t.y = cvt_pk_bf16(bf_lo(w.y) * C, bf_hi(w.y) * C); t.z = cvt_pk_bf16(bf_lo(w.z) * C, bf_hi(w.z) * C); t.w = cvt_pk_bf16(bf_lo(w.w) * C, bf_hi(w.w) * C);
        qr[d0] = *reinterpret_cast<bf16x8*>(&t); }
    constexpr int CPR = DQK / 8;
    const int v0key = tid >> 3, vc = (tid & 7) * 8, vst0 = v_st(v0key, vc), vst1 = 8192 + vst0;
    const int k0key = tid / CPR, k0c = tid % CPR, k1id = tid + 512, k1key = k1id / CPR, k1c = k1id % CPR;
    const int vbS = (int)(uintptr_t)V_lds + v_rd_base(lane, 0);
    const int vbM = (int)(uintptr_t)V_lds + v_rd_base(lane, kc0 >> 3);
    bf16x8 sv0, sv1 = {}, sk0, sk1 = {};
#define LOCAL(t) (msk && (t) >= 4)
#define TROW(t) (((t) < 4) ? (A.ctx0 + 64 * (t)) : (A.loc0 + (msk ? 128 : 64) * ((t) - 4)))
#define K1ON(t) ((DQK == 96) ? (tid < 256) : LOCAL(t))
#define SLOAD(t) do { const int _r0 = TROW(t); sv0 = *reinterpret_cast<const bf16x8*>(A.V + (size_t)(_r0 + v0key) * 512 + A.vcol + vc); \
        sk0 = *reinterpret_cast<const bf16x8*>(A.K + (size_t)(_r0 + k0key) * A.ldk + A.kcol + k0c * 8); \
        if (K1ON(t)) sk1 = *reinterpret_cast<const bf16x8*>(A.K + (size_t)(_r0 + k1key) * A.ldk + A.kcol + k1c * 8); \
        if (LOCAL(t)) sv1 = *reinterpret_cast<const bf16x8*>(A.V + (size_t)(_r0 + 64 + v0key) * 512 + A.vcol + vc); } while (0)
#define SWRITE(b, t) do { *reinterpret_cast<bf16x8*>(V_lds + (b) * SHM_V + vst0) = sv0; *reinterpret_cast<bf16x8*>(K_lds + (b) * SHM_K + KSWZ(k0key, k0c * 16)) = sk0; \
        if (K1ON(t)) *reinterpret_cast<bf16x8*>(K_lds + (b) * SHM_K + KSWZ(k1key, k1c * 16)) = sk1; \
        if (LOCAL(t)) *reinterpret_cast<bf16x8*>(V_lds + (b) * SHM_V + vst1) = sv1; } while (0)
#define RESC(a) do { if (__any((a) < 1.f)) { if (hi == 0) al_l[r32] = (a); asm volatile("s_waitcnt lgkmcnt(0)" ::: "memory"); \
        _Pragma("unroll") for (int d = 0; d < 2; ++d) _Pragma("unroll") for (int r = 0; r < 16; ++r) o[d][r] *= al_l[crow(r, hi)]; } } while (0)
#define QKT(P0, P1, b, t) do { const int _ra = LOCAL(t) ? (kc0 + r32) : r32, _rb = LOCAL(t) ? (64 + kc0 + r32) : (32 + r32); \
        qkt<DQK>(P0, P1, K_lds + (b) * SHM_K, _ra, _rb, qr, negm, hi); if (LOCAL(t)) na_mask(P0, P1, bt, mk, A.krow0 + 2 * ((t) - 4), qrow, qc, kc0, hi); } while (0)
#define PV(b, t) do { const int _va = (LOCAL(t) ? vbM : vbS) + (b) * SHM_V, _vb = _va + (LOCAL(t) ? 8192 : 4096); pv_all(o, _va, _vb, pa0, pa1, pa2, pa3); } while (0)
    f32x16 pA0, pA1, pB0, pB1; float alA, alB; bf16x8 pa0, pa1, pa2, pa3; const int NT = A.NT;
    SLOAD(0); SWRITE(0, 0); __syncthreads();
    QKT(pA0, pA1, 0, 0); partialSM<true>(pA0, pA1, m_reg, alA, negm, THR2);
    SLOAD(1); SWRITE(1, 1); __syncthreads();
    for (int j = 1; j + 1 < NT; j += 2) {
        SBAR(); QKT(pB0, pB1, 1, j);
        finishSM(pA0, pA1, alA, l_reg, pa0, pa1, pa2, pa3); SBAR();
        SLOAD(j + 1); SBAR();
        PV(0, j - 1); partialSM<false>(pB0, pB1, m_reg, alB, negm, THR2);
        __syncthreads(); SWRITE(0, j + 1);
        RESC(alB); __syncthreads();
        SBAR(); QKT(pA0, pA1, 0, j + 1);
        finishSM(pB0, pB1, alB, l_reg, pa0, pa1, pa2, pa3); SBAR();
        SLOAD(j + 2); SBAR();
        PV(1, j); partialSM<false>(pA0, pA1, m_reg, alA, negm, THR2);
        __syncthreads(); SWRITE(1, j + 2);
        RESC(alA); __syncthreads();
    }
    SBAR(); QKT(pB0, pB1, 1, NT - 1);
    finishSM(pA0, pA1, alA, l_reg, pa0, pa1, pa2, pa3); SBAR();
    PV(0, NT - 2); partialSM<false>(pB0, pB1, m_reg, alB, negm, THR2);
    __syncthreads(); RESC(alB);
    finishSM(pB0, pB1, alB, l_reg, pa0, pa1, pa2, pa3); SBAR();
    PV(1, NT - 1);
    if (hi == 0) li_l[r32] = l_reg; asm volatile("s_waitcnt lgkmcnt(0)" ::: "memory");
    float rli[16];
#pragma unroll
    for (int r = 0; r < 16; ++r) rli[r] = __builtin_amdgcn_rcpf(li_l[crow(r, hi)]);
    bf16_t* stg = (bf16_t*)(lds + LDS_OST) + wid * 2048;
#pragma unroll
    for (int r = 0; r < 16; ++r) { const int orow = crow(r, hi);
#pragma unroll
        for (int d0 = 0; d0 < 2; ++d0) { const unsigned w = cvt_pk_bf16(o[d0][r] * rli[r], 0.f); stg[orow * 64 + d0 * 32 + r32] = (bf16_t)(w & 0xffffu); } }
    asm volatile("s_waitcnt lgkmcnt(0)" ::: "memory");
#pragma unroll
    for (int i = 0; i < 4; ++i) { const int row = i * 8 + (lane >> 3), ch = lane & 7; const u32x4 v = *(const u32x4*)(stg + row * 64 + ch * 8);
        const int otok = msk ? (A.q0 + 64 * (2 * (wid >> 2) + (row >> 4)) + 16 * (wid & 3) + (row & 15)) : (A.q0 + wid * QBLK + row);
#if MRG_F8
        { u32x2 o8; o8.x = cvt_pk4_fp8(bf_lo(v.x) * F8_SO, bf_hi(v.x) * F8_SO, bf_lo(v.y) * F8_SO, bf_hi(v.y) * F8_SO); o8.y = cvt_pk4_fp8(bf_lo(v.z) * F8_SO, bf_hi(v.z) * F8_SO, bf_lo(v.w) * F8_SO, bf_hi(v.w) * F8_SO);
          *(u32x2*)((unsigned char*)A.O + (size_t)otok * 512 + A.ocol + ch * 8) = o8; } }
#else
        *(u32x4*)(A.O + (size_t)otok * 512 + A.ocol + ch * 8) = v; }
#endif
    __syncthreads();
#undef LOCAL
#undef TROW
#undef K1ON
#undef SLOAD
#undef SWRITE
#undef RESC
#undef QKT
#undef PV
}

constexpr int ML_K = 0, ML_V = 3 * 16384, ML_WS = ML_V + 4 * 8192, ML_OST = ML_WS + NW * 64 * 4, ML_END = ML_OST + NW * 4096;
static_assert(ML_END <= RING_BYTES, "latent attention LDS map");
#define MLBAR() asm volatile("s_waitcnt lgkmcnt(0)\n\ts_barrier" ::: "memory")
__device__ __forceinline__ void mla_unit(const UnitArgs& A, char* lds) {
    constexpr int DQK = 96;
    int tid = threadIdx.x; asm volatile("" : "+v"(tid));
    const int wid = __builtin_amdgcn_readfirstlane(tid >> 6), lane = tid & 63, r32 = lane & 31, hi = lane >> 5, grp = wid >> 2;
    char* V_lds = lds + ML_V; char* K_lds = lds + ML_K;
    float* ws = (float*)(lds + ML_WS) + wid * 64; float* li_l = ws; float* al_l = ws + 32;
    const float C = A.C, THR2 = 8.0f * 1.4426950408889634f;
    float m_reg = 0.f, l_reg = 0; f32x16 o[2] = {}; bf16x8 qr[DQK / 16]; f32x16 negm = f32x16{};
    const bf16_t* Qw = A.Q + (size_t)(A.q0 + wid * QBLK + r32) * A.ldq + A.qcol + hi * 8;
#pragma unroll
    for (int d0 = 0; d0 < DQK / 16; ++d0) { const u32x4 w = *reinterpret_cast<const u32x4*>(Qw + d0 * 16);
        u32x4 t; t.x = cvt_pk_bf16(bf_lo(w.x) * C, bf_hi(w.x) * C); t.y = cvt_pk_bf16(bf_lo(w.y) * C, bf_hi(w.y) * C); t.z = cvt_pk_bf16(bf_lo(w.z) * C, bf_hi(w.z) * C); t.w = cvt_pk_bf16(bf_lo(w.w) * C, bf_hi(w.w) * C);
        qr[d0] = *reinterpret_cast<bf16x8*>(&t); }
    unsigned voffK[2], voffV;
#pragma unroll
    for (int i = 0; i < 2; ++i) { const int R = 4 * (2 * wid + i) + (lane >> 4), pos = lane & 15; int c = pos ^ (R & 15); c = (c >= 12) ? c - 4 : c; voffK[i] = (unsigned)(R * A.ldk + A.kcol + c * 8) * 2u; }
    { const int kk = 8 * wid + ((lane & 31) >> 2), k = (kk & ~0xC) | ((kk & 4) << 1) | ((kk & 8) >> 1), c = 32 * (lane >> 5) + 8 * (lane & 3); voffV = (unsigned)(k * 512 + A.vcol + c) * 2u; }
    const int vbS = (int)(uintptr_t)V_lds + v_rd_base(lane, 0);
#define TROW(t) (((t) < 4) ? (A.ctx0 + 64 * (t)) : (A.loc0 + 64 * ((t) - 4)))
#define KB3(t) ((t) - 3 * (((t) * 43) >> 7))
#define DMA(t) do { const int _r0 = TROW(t); const char* const _gk = (const char*)(A.K + (size_t)_r0 * A.ldk); const char* const _gv = (const char*)(A.V + (size_t)_r0 * 512); \
        LAS unsigned char* const _lk = (LAS unsigned char*)(K_lds) + KB3(t) * 16384 + wid * 2048; LAS unsigned char* const _lv = (LAS unsigned char*)(V_lds) + ((t) & 3) * 8192 + wid * 1024; \
        __builtin_amdgcn_global_load_lds((const unsigned*)(_gk + voffK[0]), (LAS unsigned*)(_lk), 16, 0, 0); \
        __builtin_amdgcn_global_load_lds((const unsigned*)(_gk + voffK[1]), (LAS unsigned*)(_lk + 1024), 16, 0, 0); \
        __builtin_amdgcn_global_load_lds((const unsigned*)(_gv + voffV), (LAS unsigned*)(_lv), 16, 0, 0); } while (0)
    f32x16 p0, p1; bf16x8 pa0, pa1, pa2, pa3; const int NT = A.NT;
#define VSEG(j, FIRST) do { float _al; \
        partialSM<FIRST>(p0, p1, m_reg, _al, negm, THR2); finishSM(p0, p1, _al, l_reg, pa0, pa1, pa2, pa3); \
        if (!(FIRST)) { if (__any(_al < 1.f)) { if (hi == 0) al_l[r32] = _al; asm volatile("s_waitcnt lgkmcnt(0)" ::: "memory"); \
            _Pragma("unroll") for (int d = 0; d < 2; ++d) _Pragma("unroll") for (int r = 0; r < 16; ++r) o[d][r] *= al_l[crow(r, hi)]; } } } while (0)
#define PK(L, H) (bf16x8){L[0], L[1], L[2], L[3], H[0], H[1], H[2], H[3]}
#define RD128(dst, addr, OFF) asm volatile("ds_read_b128 %0, %1 offset:%2" : "=&v"(dst) : "v"(addr), "i"(OFF) : "memory")
#define WAIT2(N, x, y) asm volatile("s_waitcnt lgkmcnt(" #N ")" : "+v"(x), "+v"(y) :: "memory")
#define WAIT4(N, x, y, z, w) asm volatile("s_waitcnt lgkmcnt(" #N ")" : "+v"(x), "+v"(y), "+v"(z), "+v"(w) :: "memory")
#define MF(A_, B_, C_) __builtin_amdgcn_mfma_f32_32x32x16_bf16(A_, B_, C_, 0, 0, 0)
#define MSEG(j, SCORE) do { const int _va = vbS + ((j) & 3) * 8192, _vb = _va + 4096; \
        s16x4 a0 = tr_read<v_rd_off(0, 0, 0)>(_va), a1 = tr_read<v_rd_off(0, 0, 1)>(_va), a2 = tr_read<v_rd_off(0, 1, 0)>(_va), a3 = tr_read<v_rd_off(0, 1, 1)>(_va); \
        s16x4 a4 = tr_read<v_rd_off(0, 0, 0)>(_vb), a5 = tr_read<v_rd_off(0, 0, 1)>(_vb), a6 = tr_read<v_rd_off(0, 1, 0)>(_vb), a7 = tr_read<v_rd_off(0, 1, 1)>(_vb); \
        s16x4 c0, c1, c2, c3, c4, c5, c6, c7; \
        if (SCORE) { const int _kb = kls + KB3((j) + 1) * 16384; bf16x8 k0a, k0b, k1a, k1b, k2a, k2b, k3a, k3b, k4a, k4b, k5a, k5b; \
            RD128(k0a, _kb + ka0, 0); RD128(k0b, _kb + ka0, 8192); RD128(k1a, _kb + ka1, 0); RD128(k1b, _kb + ka1, 8192); RD128(k2a, _kb + ka2, 0); RD128(k2b, _kb + ka2, 8192); \
            WAIT2(4, k0a, k0b); p0 = MF(k0a, qr[0], negm); p1 = MF(k0b, qr[0], negm); \
            RD128(k3a, _kb + ka3, 0); RD128(k3b, _kb + ka3, 8192); WAIT2(4, k1a, k1b); p0 = MF(k1a, qr[1], p0); p1 = MF(k1b, qr[1], p1); \
            RD128(k4a, _kb + ka4, 0); RD128(k4b, _kb + ka4, 8192); WAIT2(4, k2a, k2b); p0 = MF(k2a, qr[2], p0); p1 = MF(k2b, qr[2], p1); \
            RD128(k5a, _kb + ka5, 0); RD128(k5b, _kb + ka5, 8192); WAIT2(4, k3a, k3b); p0 = MF(k3a, qr[3], p0); p1 = MF(k3b, qr[3], p1); \
            c0 = tr_read<v_rd_off(1, 0, 0)>(_va); c1 = tr_read<v_rd_off(1, 0, 1)>(_va); c2 = tr_read<v_rd_off(1, 1, 0)>(_va); c3 = tr_read<v_rd_off(1, 1, 1)>(_va); \
            WAIT2(6, k4a, k4b); p0 = MF(k4a, qr[4], p0); p1 = MF(k4b, qr[4], p1); \
            c4 = tr_read<v_rd_off(1, 0, 0)>(_vb); c5 = tr_read<v_rd_off(1, 0, 1)>(_vb); c6 = tr_read<v_rd_off(1, 1, 0)>(_vb); c7 = tr_read<v_rd_off(1, 1, 1)>(_vb); \
            WAIT2(8, k5a, k5b); p0 = MF(k5a, qr[5], p0); p1 = MF(k5b, qr[5], p1); \
        } else { \
            c0 = tr_read<v_rd_off(1, 0, 0)>(_va); c1 = tr_read<v_rd_off(1, 0, 1)>(_va); c2 = tr_read<v_rd_off(1, 1, 0)>(_va); c3 = tr_read<v_rd_off(1, 1, 1)>(_va); \
            c4 = tr_read<v_rd_off(1, 0, 0)>(_vb); c5 = tr_read<v_rd_off(1, 0, 1)>(_vb); c6 = tr_read<v_rd_off(1, 1, 0)>(_vb); c7 = tr_read<v_rd_off(1, 1, 1)>(_vb); } \
        WAIT4(8, a0, a1, a2, a3); WAIT4(8, a4, a5, a6, a7); \
        o[0] = MF(pa0, PK(a0, a1), o[0]); o[0] = MF(pa1, PK(a2, a3), o[0]); o[0] = MF(pa2, PK(a4, a5), o[0]); o[0] = MF(pa3, PK(a6, a7), o[0]); \
        WAIT4(4, c0, c1, c2, c3); o[1] = MF(pa0, PK(c0, c1), o[1]); o[1] = MF(pa1, PK(c2, c3), o[1]); \
        WAIT4(0, c4, c5, c6, c7); o[1] = MF(pa2, PK(c4, c5), o[1]); o[1] = MF(pa3, PK(c6, c7), o[1]); \
        if ((j) + 3 < NT) { DMA((j) + 3); asm volatile("s_waitcnt vmcnt(3)" ::: "memory"); } else asm volatile("s_waitcnt vmcnt(0)" ::: "memory"); } while (0)
    const int kls = (int)(uintptr_t)K_lds;
    const int ka0 = KSWZ(r32, 0 * 32 + hi * 16), ka1 = KSWZ(r32, 1 * 32 + hi * 16), ka2 = KSWZ(r32, 2 * 32 + hi * 16), ka3 = KSWZ(r32, 3 * 32 + hi * 16), ka4 = KSWZ(r32, 4 * 32 + hi * 16), ka5 = KSWZ(r32, 5 * 32 + hi * 16);
    DMA(0); DMA(1); DMA(2); asm volatile("s_waitcnt vmcnt(3)" ::: "memory");
    MLBAR();
    if (grp == 1) MLBAR();
    qkt<DQK>(p0, p1, K_lds + KB3(0) * 16384, r32, 32 + r32, qr, negm, hi); MLBAR();
    VSEG(0, true); MLBAR(); MSEG(0, true); MLBAR();
    for (int j = 1; j + 1 < NT; ++j) { VSEG(j, false); MLBAR(); MSEG(j, true); MLBAR(); }
    VSEG(NT - 1, false); MLBAR(); MSEG(NT - 1, false); MLBAR();
    if (grp == 0) MLBAR();
#undef VSEG
#undef MSEG
#undef PK
#undef RD128
#undef WAIT2
#undef WAIT4
#undef MF
    if (hi == 0) li_l[r32] = l_reg; asm volatile("s_waitcnt lgkmcnt(0)" ::: "memory");
    float rli[16];
#pragma unroll
    for (int r = 0; r < 16; ++r) rli[r] = __builtin_amdgcn_rcpf(li_l[crow(r, hi)]);
    bf16_t* stg = (bf16_t*)(lds + ML_OST) + wid * 2048;
#pragma unroll
    for (int r = 0; r < 16; ++r) { const int orow = crow(r, hi);
#pragma unroll
        for (int d0 = 0; d0 < 2; ++d0) { const unsigned w = cvt_pk_bf16(o[d0][r] * rli[r], 0.f); stg[orow * 64 + d0 * 32 + r32] = (bf16_t)(w & 0xffffu); } }
    asm volatile("s_waitcnt lgkmcnt(0)" ::: "memory");
#pragma unroll
    for (int i = 0; i < 4; ++i) { const int row = i * 8 + (lane >> 3), ch = lane & 7; const u32x4 v = *(const u32x4*)(stg + row * 64 + ch * 8); const int otok = A.q0 + wid * QBLK + row;
#if MRG_F8
        { u32x2 o8; o8.x = cvt_pk4_fp8(bf_lo(v.x) * F8_SO, bf_hi(v.x) * F8_SO, bf_lo(v.y) * F8_SO, bf_hi(v.y) * F8_SO); o8.y = cvt_pk4_fp8(bf_lo(v.z) * F8_SO, bf_hi(v.z) * F8_SO, bf_lo(v.w) * F8_SO, bf_hi(v.w) * F8_SO);
          *(u32x2*)((unsigned char*)A.O + (size_t)otok * 512 + A.ocol + ch * 8) = o8; } }
#else
        *(u32x4*)(A.O + (size_t)otok * 512 + A.ocol + ch * 8) = v; }
#endif
    MLBAR();
#undef TROW
#undef KB3
#undef DMA
}
#undef MLBAR
#undef KSWZ
#undef SBAR
}
struct Frame {
    LAS unsigned char* lds;
    int tid, lane, wave, vcu, G;
};
#define CAS __attribute__((address_space(4)))
__device__ __forceinline__ const CAS char* karg() { return (const CAS char*)__builtin_amdgcn_kernarg_segment_ptr(); }
template <int I> __device__ __forceinline__ const float* in_ptr() { unsigned off = I * 8; asm volatile("" : "+s"(off)); return *(const float* const CAS*)(karg() + off); }
__device__ __forceinline__ float* out_ptr() { unsigned off = 26 * 8; asm volatile("" : "+s"(off)); return *(float* const CAS*)(karg() + off); }
__device__ __forceinline__ unsigned char* ws_ptr() { unsigned off = 27 * 8; asm volatile("" : "+s"(off)); return *(unsigned char* const CAS*)(karg() + off); }
enum { I_X = 0, I_C, I_CTX, I_CCTX, I_WADA, I_BADA, I_NMIXG, I_NFFNG, I_WIN, I_NAQG, I_NAKG, I_RPB, I_CQG, I_WUQ, I_CKVG, I_WUKV, I_QG, I_KG, I_WOA, I_WOB, I_WOUT, I_WR, I_RB, I_W1, I_W3, I_W2 };

#define LDS_WAIT() asm volatile("s_waitcnt lgkmcnt(0)" ::: "memory")

__device__ __forceinline__ int win_src_col(int np) {
    const int pn = np >> 8, cc = np & 255;
    if (pn < 4) { const int part = pn >> 1, tq = pn & 1, bj = cc >> 7, wc = (cc >> 5) & 3, i = cc & 31; return part * 512 + (4 * tq + wc) * 64 + 32 * bj + i; }
    if (pn < 6) return 1024 + (pn - 4) * 256 + cc;
    if (pn == 6) return 1536 + cc;
    if (pn == 7) return cc < 128 ? 1792 + cc : (cc < 160 ? 2176 + (cc - 128) : -1);
    if (pn == 8) return 1920 + cc;
    return 2208 + (pn - 9) * 256 + cc;
}
template <bool F8 = false>
__device__ __forceinline__ void conv_item(const float* src, size_t ld, int dcol, int dstep, const float* gain, bf16_t* WT, int K, int k0, int n0, LAS float* scr, int lane) {
    const int kr = lane >> 4;
    f32x4 v[16];
#pragma unroll
    for (int i = 0; i < 16; ++i) { v[i] = (f32x4){0.f, 0.f, 0.f, 0.f}; if (src) v[i] = __builtin_nontemporal_load((const f32x4*)(src + (size_t)(k0 + 4 * i + kr) * ld)); }
#pragma unroll
    for (int i = 0; i < 16; ++i) { const int kk = 4 * i + kr;
        if (gain) v[i] = v[i] * gain[k0 + kk];
        LAS float* s = scr + kk * 65 + dcol; s[0] = v[i][0]; s[dstep] = v[i][1]; s[2 * dstep] = v[i][2]; s[3 * dstep] = v[i][3]; }
    LDS_WAIT(); asm volatile("" ::: "memory");
    const int c = lane & 7;
#pragma unroll
    for (int j = 0; j < 8; ++j) { const int n = (lane >> 3) + 8 * j; const LAS float* s = scr + (8 * c) * 65 + n;
        if (F8) { u32x2 o; o.x = cvt_pk4_fp8(s[0 * 65] * F8_SW, s[1 * 65] * F8_SW, s[2 * 65] * F8_SW, s[3 * 65] * F8_SW); o.y = cvt_pk4_fp8(s[4 * 65] * F8_SW, s[5 * 65] * F8_SW, s[6 * 65] * F8_SW, s[7 * 65] * F8_SW);
            *(u32x2*)((unsigned char*)WT + (size_t)(n0 + n) * K + k0 + 8 * c) = o; }
        else { u32x4 o; o.x = cvt_pk_bf16(s[0 * 65], s[1 * 65]); o.y = cvt_pk_bf16(s[2 * 65], s[3 * 65]); o.z = cvt_pk_bf16(s[4 * 65], s[5 * 65]); o.w = cvt_pk_bf16(s[6 * 65], s[7 * 65]);
            *(u32x4*)(WT + (size_t)(n0 + n) * K + k0 + 8 * c) = o; } }
    LDS_WAIT(); asm volatile("" ::: "memory");
}
__device__ __forceinline__ void p0_convert(Frame& F) {
    LAS float* scr = (LAS float*)(F.lds + F.wave * 16640);
    const int gw = F.vcu * 8 + F.wave, NGW = F.G * 8, lane = F.lane, q16 = lane & 15;
    constexpr int I_IN = 16 * 68, I_UQ = 6 * 16, I_UKV = 4 * 16, I_OA = 8 * 16, I_OUT = 16 * 16, I_13 = 16 * 32 * NEXP, I_2 = 16 * 16 * NEXP;
    constexpr int PER_L = I_IN + I_UQ + I_UKV + 2 * I_OA + I_OUT + I_13 + I_2;
    unsigned char* const ws = ws_ptr();
    for (int it = gw; it < NLAYER * PER_L; it += NGW) {
        const int l = it / PER_L; int r = it - l * PER_L;
        if (r < I_IN) { const int kb = r / 68, nb = r % 68, sc = win_src_col(nb * 64 + 4 * q16);
#if A2_F8
            if ((kb ^ nb) & 1) continue;
            { const float* const sp = sc >= 0 ? in_ptr<I_WIN>() + (size_t)l * DM * INC + sc : nullptr; bf16_t* const wt8 = (bf16_t*)(ws + WS_WIN + (size_t)l * INP * DM); const int k0 = (kb & ~1) * 64;
              conv_item<true>(sp, INC, 4 * q16, 1, nullptr, wt8, DM, k0, nb * 64, scr, lane); conv_item<true>(sp, INC, 4 * q16, 1, nullptr, wt8, DM, k0 + 64, nb * 64, scr, lane); }
#else
            conv_item(sc >= 0 ? in_ptr<I_WIN>() + (size_t)l * DM * INC + sc : nullptr, INC, 4 * q16, 1, nullptr, (bf16_t*)(ws + WS_WIN) + (size_t)l * INP * DM, DM, kb * 64, nb * 64, scr, lane);
#endif
            continue; } r -= I_IN;
        if (r < I_UQ) { const int kb = r / 16, nb = r % 16, np = nb * 64 + 4 * q16, hh = np >> 7, dd = np & 127;
            conv_item(dd < QKD ? in_ptr<I_WUQ>() + (size_t)l * QLORA * 768 + hh * QKD + dd : nullptr, 768, 4 * q16, 1, in_ptr<I_CQG>() + l * QLORA, (bf16_t*)(ws + WS_WUQ) + (size_t)l * 1024 * QLORA, QLORA, kb * 64, nb * 64, scr, lane); continue; } r -= I_UQ;
        if (r < I_UKV) { const int kb = r / 16, nb = r % 16;
            conv_item(in_ptr<I_WUKV>() + (size_t)l * KVLORA * 1024 + nb * 64 + 4 * q16, 1024, 4 * q16, 1, in_ptr<I_CKVG>() + l * KVLORA, (bf16_t*)(ws + WS_WUKV) + (size_t)l * 1024 * KVLORA, KVLORA, kb * 64, nb * 64, scr, lane); continue; } r -= I_UKV;
        if (r < 2 * I_OA) { const int w = r / I_OA, rr = r % I_OA, kb = rr / 16, nb = rr % 16;
#if MRG_F8
            if ((kb ^ nb) & 1) continue;
            { const float* const sp = (w ? in_ptr<I_WOB>() : in_ptr<I_WOA>()) + (size_t)l * 512 * DM + nb * 64 + 4 * q16; bf16_t* const wt8 = (bf16_t*)(ws + (w ? WS_WOB : WS_WOA) + (size_t)l * 1024 * 512); const int k0 = (kb & ~1) * 64;
              conv_item<true>(sp, DM, 4 * q16, 1, nullptr, wt8, 512, k0, nb * 64, scr, lane); conv_item<true>(sp, DM, 4 * q16, 1, nullptr, wt8, 512, k0 + 64, nb * 64, scr, lane); }
#else
            conv_item((w ? in_ptr<I_WOB>() : in_ptr<I_WOA>()) + (size_t)l * 512 * DM + nb * 64 + 4 * q16, DM, 4 * q16, 1, nullptr, (bf16_t*)(ws + (w ? WS_WOB : WS_WOA)) + (size_t)l * 1024 * 512, 512, kb * 64, nb * 64, scr, lane);
#endif
            continue; } r -= 2 * I_OA;
        if (r < I_OUT) { const int kb = r / 16, nb = r % 16;
#if C2_F8
            if ((kb ^ nb) & 1) continue;
            { const float* const sp = in_ptr<I_WOUT>() + (size_t)l * DM * DM + nb * 64 + 4 * q16; bf16_t* const wt8 = (bf16_t*)(ws + WS_WOUT + (size_t)l * DM * DM); const int k0 = (kb & ~1) * 64;
              conv_item<true>(sp, DM, 4 * q16, 1, nullptr, wt8, DM, k0, nb * 64, scr, lane); conv_item<true>(sp, DM, 4 * q16, 1, nullptr, wt8, DM, k0 + 64, nb * 64, scr, lane); }
#else
            conv_item(in_ptr<I_WOUT>() + (size_t)l * DM * DM + nb * 64 + 4 * q16, DM, 4 * q16, 1, nullptr, (bf16_t*)(ws + WS_WOUT) + (size_t)l * DM * DM, DM, kb * 64, nb * 64, scr, lane);
#endif
            continue; } r -= I_OUT;
        if (r < I_13) { const int e = r / 512, rr = r % 512, kb = rr / 32, nb = rr % 32;
            const float* base = ((q16 < 8) ? in_ptr<I_W1>() : in_ptr<I_W3>()) + ((size_t)l * NEXP + e) * DM * DM + nb * 32 + 4 * (q16 & 7);
            bf16_t* const wt = (bf16_t*)(ws + WS_W13) + ((size_t)l * NEXP) * 2048 * DM;
            if (F8LAYER(l)) { if ((kb ^ (e >> 2)) & 1) continue;
                const int k0 = (kb & ~1) * 64;
                conv_item<true>(base, DM, 8 * (q16 & 7) + (q16 >> 3), 2, nullptr, (bf16_t*)((unsigned char*)wt + (size_t)e * 2048 * DM), DM, k0, nb * 64, scr, lane);
                conv_item<true>(base, DM, 8 * (q16 & 7) + (q16 >> 3), 2, nullptr, (bf16_t*)((unsigned char*)wt + (size_t)e * 2048 * DM), DM, k0 + 64, nb * 64, scr, lane); }
            else conv_item(base, DM, 8 * (q16 & 7) + (q16 >> 3), 2, nullptr, wt + (size_t)e * 2048 * DM, DM, kb * 64, nb * 64, scr, lane);
            continue; } r -= I_13;
        { const int e = r / 256, rr = r % 256, kb = rr / 16, nb = rr % 16;
            const float* const src2 = in_ptr<I_W2>() + ((size_t)l * NEXP + e) * DM * DM + nb * 64 + 4 * q16; bf16_t* const wt = (bf16_t*)(ws + WS_W2) + ((size_t)l * NEXP) * DM * DM;
            if (F8LAYER(l)) { if ((kb ^ (e >> 3)) & 1) continue; const int k0 = (kb & ~1) * 64;
                conv_item<true>(src2, DM, 4 * q16, 1, nullptr, (bf16_t*)((unsigned char*)wt + (size_t)e * DM * DM), DM, k0, nb * 64, scr, lane);
                conv_item<true>(src2, DM, 4 * q16, 1, nullptr, (bf16_t*)((unsigned char*)wt + (size_t)e * DM * DM), DM, k0 + 64, nb * 64, scr, lane); }
            else conv_item(src2, DM, 4 * q16, 1, nullptr, wt + (size_t)e * DM * DM, DM, kb * 64, nb * 64, scr, lane); }
    }
}
__device__ __forceinline__ void p0_ada(Frame& F) {
    if ((int)blockIdx.x >= 2 * 96) return;
    unsigned char* const ws = ws_ptr(); const float* const cin = in_ptr<I_C>(); const float* const cctx = in_ptr<I_CCTX>(); const float* const wada = in_ptr<I_WADA>(); const float* const bada = in_ptr<I_BADA>();
    LAS float* sct = (LAS float*)F.lds;
    LAS float* red = (LAS float*)(F.lds + 1024 * 20 * 4);
    for (int idx = F.tid; idx < 17 * 1024; idx += 512) { const int r = idx >> 10, d = idx & 1023; const float v = (r < 16) ? cin[r * DM + d] : cctx[d]; sct[d * 20 + r] = v * (1.0f / (1.0f + expf(-v))); }
    __syncthreads();
    float* MOD = (float*)(ws + WS_MOD);
    for (int task = blockIdx.x; task < 2 * 96; task += F.G) {
        const int l = task / 96, cb = task % 96, col = cb * 64 + F.lane;
        const float* wa = wada + (size_t)l * DM * NMODC + col;
        float acc[17];
#pragma unroll
        for (int r = 0; r < 17; ++r) acc[r] = 0.f;
        for (int k = F.wave * 128; k < F.wave * 128 + 128; ++k) { const float wv = wa[(size_t)k * NMODC];
#pragma unroll
            for (int r = 0; r < 17; ++r) acc[r] += sct[k * 20 + r] * wv; }
#pragma unroll
        for (int r = 0; r < 17; ++r) red[(F.wave * 17 + r) * 64 + F.lane] = acc[r];
        __syncthreads();
        for (int idx = F.tid; idx < 17 * 64; idx += 512) { const int r = idx >> 6, cl = idx & 63; float s = bada[l * NMODC + cb * 64 + cl];
#pragma unroll
            for (int w = 0; w < 8; ++w) s += red[(w * 17 + r) * 64 + cl];
            MOD[((size_t)l * 17 + r) * NMODC + cb * 64 + cl] = s; }
        __syncthreads();
    }
    if (blockIdx.x == 0) { float* rope = (float*)(ws + WS_ROPE); const int pos = F.tid >> 3, i = F.tid & 7;
        const float inv = exp2f(-(float)i * 0.125f * 13.287712379549449f);
        const float ang = (float)pos * inv; const float rev = ang * 0.15915494309189535f, fr = rev - floorf(rev); rope[pos * 8 + i] = __builtin_amdgcn_cosf(fr); rope[512 + pos * 8 + i] = __builtin_amdgcn_sinf(fr); }
}

__device__ __forceinline__ void load_row(const float* xrow, int lane, f32x4 (&v)[4]) {
#pragma unroll
    for (int j = 0; j < 4; ++j) v[j] = *((const f32x4*)xrow + lane + 64 * j);
}
__device__ __forceinline__ void load_xrow(const unsigned char* ws, const float* xcur, int t, int lane, f32x4 (&v)[4]) {
#if XRES_BF16
    const u32x2* r = (const u32x2*)((const bf16_t*)(ws + WS_XB) + (size_t)t * DM);
#pragma unroll
    for (int j = 0; j < 4; ++j) { const u32x2 w = r[lane + 64 * j]; v[j] = (f32x4){bf_lo(w.x), bf_hi(w.x), bf_lo(w.y), bf_hi(w.y)}; }
#else
    load_row((t < TX) ? xcur + (size_t)t * DM : (const float*)(ws + WS_XC) + (size_t)(t - TX) * DM, lane, v);
#endif
}
__device__ __forceinline__ float row_rstd(const f32x4 (&v)[4]) {
    float s = 0.f;
#pragma unroll
    for (int j = 0; j < 4; ++j) s += (v[j][0] * v[j][0] + v[j][1] * v[j][1]) + (v[j][2] * v[j][2] + v[j][3] * v[j][3]);
    return rsqrtf(wave_sum(s) * (1.0f / DM) + RMS_EPS);
}
__device__ __forceinline__ void normmod(const f32x4 (&v)[4], float rstd, const float* g, const float* sh, const float* sc, int lane, f32x4 (&h)[4]) {
#pragma unroll
    for (int j = 0; j < 4; ++j) { const f32x4 gv = *((const f32x4*)g + lane + 64 * j), shv = *((const f32x4*)sh + lane + 64 * j), scv = *((const f32x4*)sc + lane + 64 * j);
        h[j] = v[j] * rstd * gv * (scv + 1.0f) + shv; }
}
__device__ __forceinline__ void store_row_h(unsigned char* Hb, int t, int lane, const f32x4 (&h)[4]) {
#if A2_F8
#pragma unroll
    for (int j = 0; j < 4; ++j) *((unsigned*)(Hb + (size_t)t * DM) + lane + 64 * j) = cvt_pk4_fp8(h[j][0] * F8_SH, h[j][1] * F8_SH, h[j][2] * F8_SH, h[j][3] * F8_SH);
#else
#pragma unroll
    for (int j = 0; j < 4; ++j) { u32x2 w; w.x = cvt_pk_bf16(h[j][0], h[j][1]); w.y = cvt_pk_bf16(h[j][2], h[j][3]); *((u32x2*)((bf16_t*)Hb + (size_t)t * DM) + lane + 64 * j) = w; }
#endif
}
__device__ __forceinline__ void store_row_bf16(bf16_t* orow, int lane, const f32x4 (&h)[4]) {
#pragma unroll
    for (int j = 0; j < 4; ++j) { u32x2 w; w.x = cvt_pk_bf16(h[j][0], h[j][1]); w.y = cvt_pk_bf16(h[j][2], h[j][3]); *((u32x2*)orow + lane + 64 * j) = w; }
}
__device__ __forceinline__ void p0_hrows(Frame& F) {
    unsigned char* const ws = ws_ptr(); const float* const xin = in_ptr<I_X>(); const float* const cxin = in_ptr<I_CTX>(); const float* const gmix = in_ptr<I_NMIXG>();
    const int gw = F.vcu * 8 + F.wave, NGW = F.G * 8; const float* MOD = (const float*)(ws + WS_MOD); bf16_t* H = (bf16_t*)(ws + WS_H);
    for (int t = gw; t < TALL; t += NGW) {
        const float* xr = (t < TX) ? xin + (size_t)t * DM : cxin + (size_t)(t - TX) * DM;
        const float* md = MOD + (size_t)((t < TX) ? (t >> 11) : 16) * NMODC;
        f32x4 v[4], h[4]; load_row(xr, F.lane, v); const float rstd = row_rstd(v);
        normmod(v, rstd, gmix, md, md + DM, F.lane, h); store_row_h((unsigned char*)H, t, F.lane, h);
    }
}
__device__ __forceinline__ void stats_phase(Frame& F, int ntok) {
    unsigned char* const ws = ws_ptr();
    const int gw = F.vcu * 8 + F.wave, NGW = F.G * 8, lane = F.lane;
    const bf16_t* ZCQ = (const bf16_t*)(ws + WS_ZCQ); const bf16_t* ZCKV = (const bf16_t*)(ws + WS_ZCKV); const bf16_t* ZKR = (const bf16_t*)(ws + WS_ZKR);
    float* RSCQ = (float*)(ws + WS_RSCQ); float* RSCKV = (float*)(ws + WS_RSCKV); float* SSKR = (float*)(ws + WS_SSKR);
    for (int t = gw; t < ntok; t += NGW) {
        float a = 0.f, b = 0.f, c = 0.f;
        if (lane < 48) { const u32x4 w = *(const u32x4*)(ZCQ + (size_t)t * QLORA + 8 * lane); a = (bf_lo(w.x) * bf_lo(w.x) + bf_hi(w.x) * bf_hi(w.x)) + (bf_lo(w.y) * bf_lo(w.y) + bf_hi(w.y) * bf_hi(w.y)) + (bf_lo(w.z) * bf_lo(w.z) + bf_hi(w.z) * bf_hi(w.z)) + (bf_lo(w.w) * bf_lo(w.w) + bf_hi(w.w) * bf_hi(w.w)); }
        if (lane < 32) { const u32x4 w = *(const u32x4*)(ZCKV + (size_t)t * KVLORA + 8 * lane); b = (bf_lo(w.x) * bf_lo(w.x) + bf_hi(w.x) * bf_hi(w.x)) + (bf_lo(w.y) * bf_lo(w.y) + bf_hi(w.y) * bf_hi(w.y)) + (bf_lo(w.z) * bf_lo(w.z) + bf_hi(w.z) * bf_hi(w.z)) + (bf_lo(w.w) * bf_lo(w.w) + bf_hi(w.w) * bf_hi(w.w)); }
        if (lane < 4) { const u32x4 w = *(const u32x4*)(ZKR + (size_t)t * ROPED + 8 * lane); c = (bf_lo(w.x) * bf_lo(w.x) + bf_hi(w.x) * bf_hi(w.x)) + (bf_lo(w.y) * bf_lo(w.y) + bf_hi(w.y) * bf_hi(w.y)) + (bf_lo(w.z) * bf_lo(w.z) + bf_hi(w.z) * bf_hi(w.z)) + (bf_lo(w.w) * bf_lo(w.w) + bf_hi(w.w) * bf_hi(w.w)); }
        a = wave_sum(a); b = wave_sum(b); c = wave_sum(c);
        if (lane == 0) { RSCQ[t] = rsqrtf(a * (1.0f / QLORA) + RMS_EPS); RSCKV[t] = rsqrtf(b * (1.0f / KVLORA) + RMS_EPS); SSKR[t] = c; }
    }
}

__device__ __forceinline__ void p1_router_operands(Frame& F) {
    unsigned char* const ws = ws_ptr(); const float* const wr = in_ptr<I_WR>();
    const float* MODA = (const float*)(ws + WS_MOD);
    u32x4* WRF = (u32x4*)(ws + WS_WRF); float* RBP = (float*)(ws + WS_RBP);
    const int gw = F.vcu * 8 + F.wave, NGW = F.G * 8, lane = F.lane;
    for (int it = gw; it < NLAYER * 17 * 8 * 4 * 4; it += NGW) {
        const int j = it & 3, ks = (it >> 2) & 3, w = (it >> 4) & 7, lb = it >> 7, l = lb / 17, b = lb % 17;
        const float* g = in_ptr<I_NFFNG>() + l * DM; const float* sc = MODA + ((size_t)l * 17 + b) * NMODC + 4 * DM;
        const int k0 = w * 128 + 32 * ks + 8 * (lane >> 4); float x[8];
#pragma unroll
        for (int i = 0; i < 8; ++i) x[i] = wr[(k0 + i) * NEXP + 16 * j + (lane & 15)] * (g[k0 + i] * (sc[k0 + i] + 1.0f));
        u32x4 h, lo_;
#pragma unroll
        for (int i = 0; i < 4; ++i) { const unsigned hw = cvt_pk_bf16(x[2 * i], x[2 * i + 1]); h[i] = hw; lo_[i] = cvt_pk_bf16(x[2 * i] - bf_lo(hw), x[2 * i + 1] - bf_hi(hw)); }
        WRF[((size_t)it * 2 + 0) * 64 + lane] = h; WRF[((size_t)it * 2 + 1) * 64 + lane] = lo_;
    }
    for (int it = gw; it < NLAYER * 17 * 8; it += NGW) {
        const int pr = it & 7, lb = it >> 3, l = lb / 17, b = lb % 17; const float* sh = MODA + ((size_t)l * 17 + b) * NMODC + 3 * DM;
        float s0 = 0.f, s1 = 0.f, s2 = 0.f, s3 = 0.f;
        for (int k = pr * 128; k < pr * 128 + 128; k += 4) { s0 += sh[k] * wr[k * NEXP + lane]; s1 += sh[k + 1] * wr[(k + 1) * NEXP + lane]; s2 += sh[k + 2] * wr[(k + 2) * NEXP + lane]; s3 += sh[k + 3] * wr[(k + 3) * NEXP + lane]; }
        RBP[(size_t)it * 64 + lane] = (s0 + s1) + (s2 + s3);
    }
}
#if XRES_BF16
__device__ __forceinline__ void route_phase(Frame& F, int l, int ntok, int dummy = 0) {
    unsigned char* const ws = ws_ptr();
    LAS float* part = (LAS float*)F.lds;
    LAS float* ssq = (LAS float*)(F.lds + 32768);
    LAS float* logit = (LAS float*)(F.lds + 32768 + 512);
    LAS float* biasl = (LAS float*)(F.lds + 32768 + 512 + 4096);
    LAS float* sgl = biasl + 64;
    const float rbias = in_ptr<I_RB>()[F.lane];
    int* TOKE = (int*)(ws + WS_TOKE); float* TOKW = (float*)(ws + WS_TOKW); int* TOKP = (int*)(ws + WS_TOKP); float* RSTD2 = (float*)(ws + WS_RSTD2);
    unsigned* cnt = (unsigned*)(ws + WS_CTL) + CW_CNT + l * 2048 + (dummy ? 1024 : 0);
    const bf16_t* XB = (const bf16_t*)(ws + WS_XB);
    const int lane = F.lane, w = F.wave, tid = F.tid;
    const int nstep = ntok / 16, per = (nstep + F.G - 1) / F.G, s0 = (int)blockIdx.x * per, s1 = min(s0 + per, nstep);
    int curb = -1; bf16x8 wh[4][4], wl[4][4];
#pragma unroll
    for (int ks = 0; ks < 4; ++ks)
#pragma unroll
        for (int j = 0; j < 4; ++j) { wh[ks][j] = bf16x8{}; wl[ks][j] = bf16x8{}; }
    int pt = -1, pp1 = 0, pp2 = 0;
    bf16x8 a[4];
    if (s0 < s1) { const bf16_t* xa = XB + (size_t)(s0 * 16 + (lane & 15)) * DM + w * 128 + 8 * (lane >> 4);
#pragma unroll
        for (int ks = 0; ks < 4; ++ks) a[ks] = *reinterpret_cast<const bf16x8*>(xa + 32 * ks); }
    for (int it = s0; it < s1; ++it) {
        const int T0 = it * 16, b = (T0 < TX) ? (T0 >> 11) : 16;
        bf16x8 an[4];
        { const int itn = (it + 1 < s1) ? it + 1 : it; const bf16_t* xa = XB + (size_t)(itn * 16 + (lane & 15)) * DM + w * 128 + 8 * (lane >> 4);
#pragma unroll
          for (int ks = 0; ks < 4; ++ks) an[ks] = *reinterpret_cast<const bf16x8*>(xa + 32 * ks); }
        if (b != curb) { curb = b;
            int ln = lane; asm volatile("" : "+v"(ln));
            const u32x4* wf = (const u32x4*)(ws + WS_WRF) + ((size_t)((l * 17 + b) * 8 + w) * 16 * 2) * 64 + ln;
#pragma unroll
            for (int ks = 0; ks < 4; ++ks)
#pragma unroll
                for (int j = 0; j < 4; ++j) { const u32x4 h = wf[((ks * 4 + j) * 2 + 0) * 64], lo_ = wf[((ks * 4 + j) * 2 + 1) * 64];
                    wh[ks][j] = *reinterpret_cast<const bf16x8*>(&h); wl[ks][j] = *reinterpret_cast<const bf16x8*>(&lo_); }
            __syncthreads();
            if (tid < 64) { const float* rb = (const float*)(ws + WS_RBP) + (size_t)(l * 17 + b) * 8 * 64 + tid; float sb = 0.f;
#pragma unroll
                for (int pr = 0; pr < 8; ++pr) sb += rb[pr * 64];
                biasl[tid] = sb; }
        }
        { float sq = 0.f;
#pragma unroll
          for (int ks = 0; ks < 4; ++ks) { const u32x4 u = *reinterpret_cast<const u32x4*>(&a[ks]);
#pragma unroll
              for (int i = 0; i < 4; ++i) { const float lo2 = bf_lo(u[i]), hi2 = bf_hi(u[i]); sq += lo2 * lo2 + hi2 * hi2; } }
          sq += __shfl_xor(sq, 16); sq += __shfl_xor(sq, 32);
          if (lane < 16) ssq[w * 16 + lane] = sq;
          f32x4 acc[4];
#pragma unroll
          for (int j = 0; j < 4; ++j) acc[j] = (f32x4){0.f, 0.f, 0.f, 0.f};
#pragma unroll
          for (int ks = 0; ks < 4; ++ks)
#pragma unroll
              for (int j = 0; j < 4; ++j) { acc[j] = __builtin_amdgcn_mfma_f32_16x16x32_bf16(a[ks], wl[ks][j], acc[j], 0, 0, 0); acc[j] = __builtin_amdgcn_mfma_f32_16x16x32_bf16(a[ks], wh[ks][j], acc[j], 0, 0, 0); }
#pragma unroll
          for (int j = 0; j < 4; ++j)
#pragma unroll
              for (int q = 0; q < 4; ++q) part[(w * 16 + 4 * (lane >> 4) + q) * 64 + 16 * j + (lane & 15)] = acc[j][q]; }
        __syncthreads();
#pragma unroll
        for (int k = 0; k < 2; ++k) { const int idx = tid + 512 * k, t = idx >> 6, e = idx & 63; float s = 0.f, q2 = 0.f;
#pragma unroll
            for (int ww = 0; ww < 8; ++ww) { s += part[(ww * 16 + t) * 64 + e]; q2 += ssq[ww * 16 + t]; }
            const float rstd = rsqrtf(q2 * (1.0f / DM) + RMS_EPS);
            { const float sg = 1.0f / (1.0f + expf(-(s * rstd + biasl[e]))); sgl[t * 64 + e] = sg; logit[t * 64 + e] = sg + rbias; }
            if (e == 0) { const int tg = T0 + t; RSTD2[(tg >> 4) * 32 + (tg & 15)] = rstd; } }
        __syncthreads();
        if (pt >= 0) { TOKP[2 * pt] = pp1; TOKP[2 * pt + 1] = pp2; pt = -1; }
        if (lane < 16) { const int tl = 2 * w + (lane >> 3), grp = lane & 7, t = T0 + tl;
            const f32x4 v0 = *(const LAS f32x4*)(logit + tl * 64 + 8 * grp), v1 = *(const LAS f32x4*)(logit + tl * 64 + 8 * grp + 4);
            const float vv[8] = {v0[0], v0[1], v0[2], v0[3], v1[0], v1[1], v1[2], v1[3]};
            float m1 = -3.0e38f, m2 = -3.0e38f; int i1 = 0, i2 = 0;
#pragma unroll
            for (int j = 0; j < 8; ++j) { if (vv[j] > m1) { m2 = m1; i2 = i1; m1 = vv[j]; i1 = j; } else if (vv[j] > m2) { m2 = vv[j]; i2 = j; } }
            float best = m1 + m2; int gsel = grp;
#define RT_STEP(CTRL) do { const float ob = __int_as_float(__builtin_amdgcn_update_dpp(0, __float_as_int(best), CTRL, 0xF, 0xF, false)); const int og = __builtin_amdgcn_update_dpp(0, gsel, CTRL, 0xF, 0xF, false); \
                if (ob > best || (ob == best && og < gsel)) { best = ob; gsel = og; } } while (0)
            RT_STEP(0xB1); RT_STEP(0x4E); RT_STEP(0x141);
#undef RT_STEP
            if (grp == gsel) { const int e1 = 8 * grp + i1, e2 = 8 * grp + i2; const float s1 = sgl[tl * 64 + e1], s2 = sgl[tl * 64 + e2], inv = 1.0f / (s1 + s2);
                pp1 = (int)atomicAdd(cnt + e1 * 16, 1u); pp2 = (int)atomicAdd(cnt + e2 * 16, 1u); pt = t;
                TOKE[2 * t] = e1; TOKE[2 * t + 1] = e2; TOKW[2 * t] = s1 * inv; TOKW[2 * t + 1] = s2 * inv; }
        }
#pragma unroll
        for (int ks = 0; ks < 4; ++ks) a[ks] = an[ks];
    }
    if (pt >= 0) { TOKP[2 * pt] = pp1; TOKP[2 * pt + 1] = pp2; }
}
#else
__device__ __forceinline__ void route_phase(Frame& F, int l, int ntok, int dummy = 0) {
    unsigned char* const ws = ws_ptr(); const float* const xcur = out_ptr();
    constexpr int HP = DM + 4;
    LAS float* h2t = (LAS float*)F.lds;
    LAS float* part = (LAS float*)(F.lds + 66560);
    LAS float* logit = (LAS float*)(F.lds + 66560 + 32768);
    const float* MOD = (const float*)(ws + WS_MOD) + (size_t)l * 17 * NMODC;
    const float* g = in_ptr<I_NFFNG>() + l * DM; const float* wr = in_ptr<I_WR>(); const float rbias = in_ptr<I_RB>()[F.lane];
    int* TOKE = (int*)(ws + WS_TOKE); float* TOKW = (float*)(ws + WS_TOKW); int* TOKP = (int*)(ws + WS_TOKP); float* RSTD2 = (float*)(ws + WS_RSTD2);
    unsigned* cnt = (unsigned*)(ws + WS_CTL) + CW_CNT + l * 2048 + (dummy ? 1024 : 0);
    const int lane = F.lane, w = F.wave;
    bf16x8 wh[4][4], wl[4][4];
#pragma unroll
    for (int ks = 0; ks < 4; ++ks)
#pragma unroll
        for (int j = 0; j < 4; ++j) { float x[8];
#pragma unroll
            for (int i = 0; i < 8; ++i) x[i] = wr[(w * 128 + 32 * ks + 8 * (lane >> 4) + i) * NEXP + 16 * j + (lane & 15)];
            u32x4 h, lo_;
#pragma unroll
            for (int i = 0; i < 4; ++i) { const unsigned hw = cvt_pk_bf16(x[2 * i], x[2 * i + 1]); h[i] = hw; lo_[i] = cvt_pk_bf16(x[2 * i] - bf_lo(hw), x[2 * i + 1] - bf_hi(hw)); }
            wh[ks][j] = *reinterpret_cast<bf16x8*>(&h); wl[ks][j] = *reinterpret_cast<bf16x8*>(&lo_); }
    for (int it = blockIdx.x; it < ntok / 16; it += F.G) {
        const int T0 = it * 16;
#pragma unroll
        for (int tt = 0; tt < 2; ++tt) { const int tl = 2 * w + tt, t = T0 + tl;
            const float* md = MOD + (size_t)((t < TX) ? (t >> 11) : 16) * NMODC;
            f32x4 v[4], h[4]; load_xrow(ws, xcur, t, lane, v); const float rstd = row_rstd(v); if (lane == 0) RSTD2[(t >> 4) * 32 + (t & 15)] = rstd;
            normmod(v, rstd, g, md + 3 * DM, md + 4 * DM, lane, h);
#pragma unroll
            for (int j = 0; j < 4; ++j) *(LAS f32x4*)(h2t + tl * HP + 4 * lane + 256 * j) = h[j];
        }
        __syncthreads();
        { f32x4 acc[4];
#pragma unroll
          for (int j = 0; j < 4; ++j) acc[j] = (f32x4){0.f, 0.f, 0.f, 0.f};
          const LAS float* ha = h2t + (lane & 15) * HP + w * 128 + 8 * (lane >> 4);
#pragma unroll
          for (int ks = 0; ks < 4; ++ks) { const f32x4 x0 = *(const LAS f32x4*)(ha + 32 * ks), x1 = *(const LAS f32x4*)(ha + 32 * ks + 4);
              u32x4 h, lo_;
              h[0] = cvt_pk_bf16(x0[0], x0[1]); h[1] = cvt_pk_bf16(x0[2], x0[3]); h[2] = cvt_pk_bf16(x1[0], x1[1]); h[3] = cvt_pk_bf16(x1[2], x1[3]);
              lo_[0] = cvt_pk_bf16(x0[0] - bf_lo(h[0]), x0[1] - bf_hi(h[0])); lo_[1] = cvt_pk_bf16(x0[2] - bf_lo(h[1]), x0[3] - bf_hi(h[1]));
              lo_[2] = cvt_pk_bf16(x1[0] - bf_lo(h[2]), x1[1] - bf_hi(h[2])); lo_[3] = cvt_pk_bf16(x1[2] - bf_lo(h[3]), x1[3] - bf_hi(h[3]));
              const bf16x8 ah = *reinterpret_cast<bf16x8*>(&h), al = *reinterpret_cast<bf16x8*>(&lo_);
#pragma unroll
              for (int j = 0; j < 4; ++j) { acc[j] = __builtin_amdgcn_mfma_f32_16x16x32_bf16(al, wh[ks][j], acc[j], 0, 0, 0); acc[j] = __builtin_amdgcn_mfma_f32_16x16x32_bf16(ah, wl[ks][j], acc[j], 0, 0, 0);
                  acc[j] = __builtin_amdgcn_mfma_f32_16x16x32_bf16(ah, wh[ks][j], acc[j], 0, 0, 0); } }
#pragma unroll
          for (int j = 0; j < 4; ++j)
#pragma unroll
              for (int q = 0; q < 4; ++q) part[(w * 16 + 4 * (lane >> 4) + q) * 64 + 16 * j + (lane & 15)] = acc[j][q]; }
        __syncthreads();
#pragma unroll
        for (int k = 0; k < 2; ++k) { const int idx = F.tid + 512 * k, t = idx >> 6, e = idx & 63; float s = 0.f;
#pragma unroll
            for (int ww = 0; ww < 8; ++ww) s += part[(ww * 16 + t) * 64 + e];
            logit[t * 64 + e] = s; }
        __syncthreads();
#pragma unroll
        for (int tt = 0; tt < 2; ++tt) { const int tl = 2 * w + tt, t = T0 + tl;
            const float sg = 1.0f / (1.0f + expf(-logit[tl * 64 + lane])); const float bs = sg + rbias;
            float m1 = -3.0e38f, m2 = -3.0e38f; int i1 = 0, i2 = 0;
#pragma unroll
            for (int j = 0; j < 8; ++j) { const float vv = __shfl(bs, (lane & ~7) + j); if (vv > m1) { m2 = m1; i2 = i1; m1 = vv; i1 = j; } else if (vv > m2) { m2 = vv; i2 = j; } }
            const float gs = m1 + m2; float best = -3.0e38f; int gsel = 0;
#pragma unroll
            for (int j = 0; j < 8; ++j) { const float vv = __shfl(gs, 8 * j); if (vv > best) { best = vv; gsel = j; } }
            const int e1 = gsel * 8 + __shfl(i1, gsel * 8), e2 = gsel * 8 + __shfl(i2, gsel * 8);
            const float s1 = __shfl(sg, e1), s2 = __shfl(sg, e2), inv = 1.0f / (s1 + s2);
            if (lane == 0) { const int p1 = (int)atomicAdd(cnt + e1 * 16, 1u), p2 = (int)atomicAdd(cnt + e2 * 16, 1u);
                TOKE[2 * t] = e1; TOKE[2 * t + 1] = e2; TOKW[2 * t] = s1 * inv; TOKW[2 * t + 1] = s2 * inv; TOKP[2 * t] = p1; TOKP[2 * t + 1] = p2; }
        }
        __syncthreads();
    }
}
#endif
__device__ __forceinline__ void expert_offsets(Frame& F, unsigned char* ws, int l, LAS int* offl, bool publish) {
    if (F.wave == 0) {
        const unsigned c = __hip_atomic_load((unsigned*)(ws + WS_CTL) + CW_CNT + l * 2048 + F.lane * 16, RLX_AGENT);
        const int pad = (int)((c + 255u) & ~255u); int incl = pad;
#pragma unroll
        for (int o = 1; o < 64; o <<= 1) { const int v = __shfl_up(incl, o); if (F.lane >= o) incl += v; }
        offl[F.lane] = incl - pad; if (F.lane == 63) offl[64] = incl;
        if (publish) { int* TILEE = (int*)(ws + WS_TILEE); for (int t = (incl - pad) >> 8; t < (incl >> 8); ++t) TILEE[t] = F.lane; if (F.lane == 63) TILEE[511] = incl >> 8; }
    }
    __syncthreads();
}
__device__ __forceinline__ void scatter_phase(Frame& F, int l, int ntok, bool f8) {
    unsigned char* const ws = ws_ptr(); const float* const xcur = out_ptr();
    LAS int* offl = (LAS int*)(F.lds + 1024);
    expert_offsets(F, ws, l, offl, blockIdx.x == 0);
    const int gw = F.vcu * 8 + F.wave, NGW = F.G * 8, lane = F.lane;
    const float* MOD = (const float*)(ws + WS_MOD) + (size_t)l * 17 * NMODC; const float* g = in_ptr<I_NFFNG>() + l * DM;
    const int* TOKE = (const int*)(ws + WS_TOKE); const int* TOKP = (const int*)(ws + WS_TOKP); const float* RSTD2 = (const float*)(ws + WS_RSTD2); bf16_t* HS = (bf16_t*)(ws + WS_HS);
    for (int t = gw; t < ntok; t += NGW) {
        const float* md = MOD + (size_t)((t < TX) ? (t >> 11) : 16) * NMODC;
        f32x4 v[4], h[4]; load_xrow(ws, xcur, t, lane, v); normmod(v, RSTD2[(t >> 4) * 32 + (t & 15)], g, md + 3 * DM, md + 4 * DM, lane, h);
        const int s1 = offl[TOKE[2 * t]] + TOKP[2 * t], s2 = offl[TOKE[2 * t + 1]] + TOKP[2 * t + 1];
        if (f8) {
#pragma unroll
            for (int j = 0; j < 4; ++j) { const unsigned w = cvt_pk4_fp8(h[j][0] * F8_SH, h[j][1] * F8_SH, h[j][2] * F8_SH, h[j][3] * F8_SH);
                *((unsigned*)((unsigned char*)HS + (size_t)s1 * DM) + lane + 64 * j) = w; *((unsigned*)((unsigned char*)HS + (size_t)s2 * DM) + lane + 64 * j) = w; }
        } else { store_row_bf16(HS + (size_t)s1 * DM, lane, h); store_row_bf16(HS + (size_t)s2 * DM, lane, h); }
    }
}
__device__ __forceinline__ void combine_phase(Frame& F, int l, int ntok, bool last) {
    unsigned char* const ws = ws_ptr(); float* const xcur = out_ptr();
    LAS int* offl = (LAS int*)(F.lds + 1024);
    expert_offsets(F, ws, l, offl, false);
    const int gw = F.vcu * 8 + F.wave, NGW = F.G * 8, lane = F.lane;
    const float* MOD = (const float*)(ws + WS_MOD) + (size_t)l * 17 * NMODC; float* XC = (float*)(ws + WS_XC);
    const int* TOKE = (const int*)(ws + WS_TOKE); const int* TOKP = (const int*)(ws + WS_TOKP); const float* TOKW = (const float*)(ws + WS_TOKW);
    const bf16_t* YS = (const bf16_t*)(ws + WS_YS); bf16_t* H = (bf16_t*)(ws + WS_H);
    for (int t = gw; t < ntok; t += NGW) {
        float* xr = (t < TX) ? xcur + (size_t)t * DM : XC + (size_t)(t - TX) * DM; const int bi = (t < TX) ? (t >> 11) : 16; const float* md = MOD + (size_t)bi * NMODC;
        const int s1 = offl[TOKE[2 * t]] + TOKP[2 * t], s2 = offl[TOKE[2 * t + 1]] + TOKP[2 * t + 1]; const float w1 = TOKW[2 * t], w2 = TOKW[2 * t + 1];
        f32x4 v[4]; load_xrow(ws, xcur, t, lane, v);
#pragma unroll
        for (int j = 0; j < 4; ++j) {
            const f32x4 gf = *((const f32x4*)(md + 5 * DM) + lane + 64 * j);
#if YS_F8
            const unsigned a = *((const unsigned*)((const unsigned char*)YS + (size_t)s1 * DM) + lane + 64 * j), b = *((const unsigned*)((const unsigned char*)YS + (size_t)s2 * DM) + lane + 64 * j);
            const f32x4 y = fp8x4_f32(a) * (w1 * (1.0f / F8_SYS)) + fp8x4_f32(b) * (w2 * (1.0f / F8_SYS));
#else
            const u32x2 a = *((const u32x2*)(YS + (size_t)s1 * DM) + lane + 64 * j), b = *((const u32x2*)(YS + (size_t)s2 * DM) + lane + 64 * j);
            const f32x4 y = (f32x4){bf_lo(a.x), bf_hi(a.x), bf_lo(a.y), bf_hi(a.y)} * w1 + (f32x4){bf_lo(b.x), bf_hi(b.x), bf_lo(b.y), bf_hi(b.y)} * w2;
#endif
            v[j] = v[j] + gf * y;
#if XRES_BF16
            if (last) *((f32x4*)xr + lane + 64 * j) = v[j];
            else { u32x2 w; w.x = cvt_pk_bf16(v[j][0], v[j][1]); w.y = cvt_pk_bf16(v[j][2], v[j][3]); *((u32x2*)((bf16_t*)(ws + WS_XB) + (size_t)t * DM) + lane + 64 * j) = w; }
#else
            *((f32x4*)xr + lane + 64 * j) = v[j];
#endif
        }
        if (!last) { const float* md2 = MOD + (size_t)17 * NMODC + (size_t)bi * NMODC; f32x4 h[4]; const float rstd = row_rstd(v);
            normmod(v, rstd, in_ptr<I_NMIXG>() + (l + 1) * DM, md2, md2 + DM, lane, h); store_row_h((unsigned char*)H, t, lane, h); }
    }
}
constexpr int NPHASE = 2 + 11 * NLAYER;
struct Args { const float* in[26]; float* out; unsigned char* ws; int ph_lo, ph_hi; };

__device__ __attribute__((noinline)) void grid_barrier_fn(GAS unsigned* barw, unsigned x, LAS unsigned* st) { XcdBarrier b; b.bar = (unsigned*)barw; b.x = x; b.st = (volatile LAS unsigned*)st; xcd_barrier(b); }

__global__ void __launch_bounds__(512, 2) fwd_kernel(Args args) {
    extern __shared__ __attribute__((aligned(16))) unsigned char lds_raw[];
    Frame F;
    F.lds = (LAS unsigned char*)lds_raw;
    F.tid = threadIdx.x; F.lane = F.tid & 63; F.wave = __builtin_amdgcn_readfirstlane(F.tid >> 6);
    F.G = gridDim.x; { const int bx = blockIdx.x; F.vcu = (F.G % 8 == 0) ? (bx % 8) * (F.G / 8) + bx / 8 : bx; }
    volatile LAS unsigned* MISC = (volatile LAS unsigned*)(F.lds + MISC_OFF);
    if (F.tid < 64) MISC[F.tid] = 0u;
    __syncthreads();
    const int lo = args.ph_lo, hi = args.ph_hi;
#if MK_SPLIT
#define GRID_BAR() do { } while (0)
#else
    XcdBarrier bar = xcd_barrier_post((unsigned*)(ws_ptr() + WS_CTL) + CW_BAR, MISC + 8);
#define GRID_BAR() grid_barrier_fn((GAS unsigned*)bar.bar, bar.x, (LAS unsigned*)bar.st)
#endif
#ifndef PH_MASK
#define PH_MASK 0xFFFFFFFFu
#endif
#define PHK(k) ((k) < 2 ? (k) : 2 + ((k) - 2) % 11)
#define IN(k) (((PH_MASK >> PHK(k)) & 1u) && lo <= (k) && (k) < hi)
#ifndef PH_DUP
#define PH_DUP 0u
#endif
#define REP0(k) for (int rep_ = 0; rep_ < (((PH_DUP >> (k)) & 1u) ? 2 : 1); ++rep_)
#define REPL(n) for (int rep_ = 0; rep_ < ((((PH_DUP >> (2 + (n))) & 1u) && ((n) != 5 || l == 0)) ? 2 : 1); ++rep_)
#ifdef BAR_DUP
#define SEAM(k) do { if (IN(k) && IN((k) + 1)) { for (int b_ = 0; b_ < 1 + BAR_DUP; ++b_) GRID_BAR(); } } while (0)
#else
#define SEAM(k) do { if (IN(k) && IN((k) + 1)) GRID_BAR(); } while (0)
#endif
#define FRESH() Frame Fp = F; int G = F.G, c = (int)blockIdx.x; asm volatile("" : "+v"(Fp.tid), "+v"(Fp.lane)); asm volatile("" : "+s"(Fp.wave), "+s"(Fp.vcu), "+s"(Fp.G), "+s"(G), "+s"(c))

    if (IN(0)) REP0(0) { FRESH(); (void)G; (void)c; p0_convert(Fp); __syncthreads(); p0_ada(Fp); }
    SEAM(0);
    if (IN(1)) REP0(1) { FRESH(); (void)G; (void)c; p0_hrows(Fp);
#if XRES_BF16
        p1_router_operands(Fp);
#endif
    }
    SEAM(1);

    for (int l = 0; l < NLAYER; ++l) {
        const int base = 2 + 11 * l; const bool last = (l == NLAYER - 1);
        const int mt_act = last ? MT_X : MT_ALL;
        const int ntok = last ? TX : TALL;
        if (IN(base + 0)) REPL(0) {
            FRESH(); unsigned char* const ws = ws_ptr();
#if A2_F8
            pg8::SchedRect S{(const char*)(ws + WS_H), (const char*)(ws + WS_WIN + (size_t)l * INP * DM), (size_t)256 * DM, mt_act, 17, G, c, MT_ALL - mt_act, 2, 7};
            pg8::EpiIn E{(bf16_t*)(ws + WS_QA), (bf16_t*)(ws + WS_KA), (bf16_t*)(ws + WS_VA), (bf16_t*)(ws + WS_ZCQ), (bf16_t*)(ws + WS_ZCKV), (bf16_t*)(ws + WS_ZKR), (bf16_t*)(ws + WS_GATES),
                         in_ptr<I_NAQG>() + l * 64, in_ptr<I_NAKG>() + l * 64, (float*)(ws + WS_PART6), (float*)(ws + WS_PART7), (float*)(ws + WS_PART8), 1.0f / (F8_SH * F8_SW)};
            pg8::gemm_phase<true>(Fp.lds, DM / 2, S, E);
#else
            pg8::SchedRect S{(const char*)(ws + WS_H), (const char*)((bf16_t*)(ws + WS_WIN) + (size_t)l * INP * DM), (size_t)256 * DM * 2, mt_act, 17, G, c, MT_ALL - mt_act, 2, 7};
            pg8::EpiIn E{(bf16_t*)(ws + WS_QA), (bf16_t*)(ws + WS_KA), (bf16_t*)(ws + WS_VA), (bf16_t*)(ws + WS_ZCQ), (bf16_t*)(ws + WS_ZCKV), (bf16_t*)(ws + WS_ZKR), (bf16_t*)(ws + WS_GATES),
                         in_ptr<I_NAQG>() + l * 64, in_ptr<I_NAKG>() + l * 64, (float*)(ws + WS_PART6), (float*)(ws + WS_PART7), (float*)(ws + WS_PART8), 1.0f};
            pg8::gemm_phase(Fp.lds, DM, S, E);
#endif
        }
        SEAM(base + 0);
        if (IN(base + 2)) REPL(2) {
            FRESH();
            LAS float* const ropeL = (LAS float*)(Fp.lds + EPI_OFF + 8192);
            { const float* const rg = (const float*)(ws_ptr() + WS_ROPE); ropeL[Fp.tid] = rg[Fp.tid]; ropeL[512 + Fp.tid] = rg[512 + Fp.tid]; __syncthreads(); }
#ifndef NO_EQ
            { unsigned char* const ws = ws_ptr();
              pg8::SchedRect S{(const char*)(ws + WS_ZCQ), (const char*)((bf16_t*)(ws + WS_WUQ) + (size_t)l * 1024 * QLORA), (size_t)256 * QLORA * 2, mt_act, 4, G, c, 0, 0, 1};
              pg8::EpiQ E{(bf16_t*)(ws + WS_QB), (const float*)(ws + WS_PART6), (const float*)(ws + WS_PART7), in_ptr<I_QG>() + l * QKD, ropeL, (LAS float*)(Fp.lds + EPI_OFF)};
              pg8::gemm_phase(Fp.lds, QLORA, S, E); }
#endif
#ifndef NO_EKV
            { unsigned char* const ws = ws_ptr();
              pg8::SchedRect S{(const char*)(ws + WS_ZCKV), (const char*)((bf16_t*)(ws + WS_WUKV) + (size_t)l * 1024 * KVLORA), (size_t)256 * KVLORA * 2, MT_ALL, 4, G, c, 0, 0, 1};
              pg8::EpiKV E{(bf16_t*)(ws + WS_KB), (bf16_t*)(ws + WS_VB), (const bf16_t*)(ws + WS_ZKR), (const float*)(ws + WS_PART7), (const float*)(ws + WS_PART8), in_ptr<I_KG>() + l * QKD, ropeL, (LAS float*)(Fp.lds + EPI_OFF)};
              pg8::gemm_phase(Fp.lds, KVLORA, S, E); }
#endif
        }
        SEAM(base + 2);
        if (IN(base + 3)) REPL(3) {
            FRESH(); (void)c;
            const float C64 = 0.125f * 1.4426950408889634f, C96 = 0.10206207261596575f * 1.4426950408889634f;
            for (int r2_ = 0; r2_ < (((PH_DUP >> 20) & 1u) ? 2 : 1); ++r2_)
            { unsigned char* const ws = ws_ptr();
#if HEAD_PAIR
              for (int w_ = 2 * Fp.vcu; w_ < 2 * (512 + 128); w_ = (w_ & 1) ? w_ + 2 * G - 1 : w_ + 1) { const int u = w_ >> 1, hp = w_ & 1;
#else
              for (int u = Fp.vcu; u < 1024 + 256; u += G) {
#endif
                att::UnitArgs A; A.Q = (const bf16_t*)(ws + WS_QB); A.ldq = 768; A.K = (const bf16_t*)(ws + WS_KB); A.ldk = 768; A.V = (const bf16_t*)(ws + WS_VB); A.O = (bf16_t*)(ws + WS_OB);
                A.masked = 0; A.band = 0; A.krow0 = 0; A.bias = nullptr; A.C = C96;
#if HEAD_PAIR
                if (u < 512) { const int bh = 2 * (u >> 3) + hp, qb = u & 7, b = bh >> 3, h = bh & 7;
                    A.qcol = h * QKD; A.kcol = h * QKD; A.vcol = h * 64; A.ocol = h * 64; A.q0 = b * SEQ + qb * 256; A.ctx0 = TX + b * CTXL; A.loc0 = b * SEQ; A.NT = 36; }
                else { const int v = u - 512; if (last || !(v & 1)) continue; const int bh = 2 * (v >> 1) + hp, b = bh >> 3, h = bh & 7;
#else
                if (u < 1024) { const int bh = u >> 3, qb = u & 7, b = bh >> 3, h = bh & 7;
                    A.qcol = h * QKD; A.kcol = h * QKD; A.vcol = h * 64; A.ocol = h * 64; A.q0 = b * SEQ + qb * 256; A.ctx0 = TX + b * CTXL; A.loc0 = b * SEQ; A.NT = 36; }
                else { const int v = u - 1024; if (last || !(v & 1)) continue; const int bh = v >> 1, b = bh >> 3, h = bh & 7;
#endif
                    A.qcol = h * QKD; A.kcol = h * QKD; A.vcol = h * 64; A.ocol = h * 64; A.q0 = TX + b * CTXL; A.ctx0 = TX + b * CTXL; A.loc0 = 0; A.NT = 4; }
                att::mla_unit(A, (char*)lds_raw);
              } }
            for (int r3_ = 0; r3_ < (((PH_DUP >> 21) & 1u) ? 2 : 1); ++r3_)
            { unsigned char* const ws = ws_ptr(); const float* const rpb = in_ptr<I_RPB>();
              att::na_mask_table((char*)lds_raw);
#if HEAD_PAIR
              for (int w_ = 2 * Fp.vcu; w_ < 2 * (512 + 128); w_ = (w_ & 1) ? w_ + 2 * G - 1 : w_ + 1) { const int u = w_ >> 1, hp = w_ & 1;
#else
              for (int u = Fp.vcu; u < 1024 + 256; u += G) {
#endif
                att::UnitArgs A; A.Q = (const bf16_t*)(ws + WS_QA); A.ldq = 512; A.K = (const bf16_t*)(ws + WS_KA); A.ldk = 512; A.V = (const bf16_t*)(ws + WS_VA); A.O = (bf16_t*)(ws + WS_OA); A.C = C64;
#if HEAD_PAIR
                if (u < 512) { const int bh = 2 * (u >> 3) + hp, band = u & 7, b = bh >> 3, h = bh & 7;
#else
                if (u < 1024) { const int bh = u >> 3, band = u & 7, b = bh >> 3, h = bh & 7;
#endif
                    A.qcol = h * 64; A.kcol = h * 64; A.vcol = h * 64; A.ocol = h * 64; A.q0 = b * SEQ + band * 256; A.ctx0 = TX + b * CTXL;
                    A.krow0 = min(max(4 * band - 4, 0), 20); A.loc0 = b * SEQ + 64 * A.krow0; A.NT = 10; A.masked = 1; A.band = band; A.bias = rpb + ((size_t)l * NHEAD + h) * 15 * 31; }
#if HEAD_PAIR
                else { const int v = u - 512; if (last || (v & 1)) continue; const int bh = 2 * (v >> 1) + hp, b = bh >> 3, h = bh & 7;
#else
                else { const int v = u - 1024; if (last || (v & 1)) continue; const int bh = v >> 1, b = bh >> 3, h = bh & 7;
#endif
                    A.qcol = h * 64; A.kcol = h * 64; A.vcol = h * 64; A.ocol = h * 64; A.q0 = TX + b * CTXL; A.ctx0 = TX + b * CTXL; A.loc0 = 0; A.NT = 4; A.masked = 0; A.band = 0; A.krow0 = 0; A.bias = nullptr; }
                att::attn_unit<64>(A, (char*)lds_raw);
              } }
        }
        SEAM(base + 3);
        if (IN(base + 4)) REPL(4) {
            FRESH(); unsigned char* const ws = ws_ptr();
#if MRG_F8
            pg8::SchedMerge S{(const char*)(ws + WS_OA), (const char*)(ws + WS_OB), (const char*)(ws + WS_WOA + (size_t)l * 1024 * 512), (const char*)(ws + WS_WOB + (size_t)l * 1024 * 512),
                              (size_t)256 * 512, mt_act, 4, G, c};
            pg8::EpiMerge E{(const bf16_t*)(ws + WS_GATES), (bf16_t*)(ws + WS_Y), 1.0f / (F8_SO * F8_SW)};
            pg8::gemm_phase<true>(Fp.lds, 256, S, E);
#else
            pg8::SchedMerge S{(const char*)(ws + WS_OA), (const char*)(ws + WS_OB), (const char*)((bf16_t*)(ws + WS_WOA) + (size_t)l * 1024 * 512), (const char*)((bf16_t*)(ws + WS_WOB) + (size_t)l * 1024 * 512),
                              (size_t)256 * 512 * 2, mt_act, 4, G, c};
            pg8::EpiMerge E{(const bf16_t*)(ws + WS_GATES), (bf16_t*)(ws + WS_Y), 1.0f};
            pg8::gemm_phase(Fp.lds, 512, S, E);
#endif
        }
        SEAM(base + 4);
        if (IN(base + 5)) REPL(5) {
            FRESH(); unsigned char* const ws = ws_ptr(); float* const outp = out_ptr();
#if C2_F8
            pg8::SchedRect S{(const char*)(ws + WS_Y), (const char*)(ws + WS_WOUT + (size_t)l * DM * DM), (size_t)256 * DM, mt_act, 4, G, c, 0, 0, 1};
            #if XRES_BF16
            pg8::EpiOut E{(l == 0) ? in_ptr<I_X>() : (const float*)nullptr, outp, in_ptr<I_CTX>(), (float*)(ws + WS_XB), (const float*)(ws + WS_MOD) + (size_t)l * 17 * NMODC, 2 * DM, 1.0f / (F8_SY * F8_SW)};
#else
            pg8::EpiOut E{(l == 0) ? in_ptr<I_X>() : (const float*)outp, outp, in_ptr<I_CTX>(), (float*)(ws + WS_XC), (const float*)(ws + WS_MOD) + (size_t)l * 17 * NMODC, 2 * DM, 1.0f / (F8_SY * F8_SW)};
#endif
            pg8::gemm_phase<true>(Fp.lds, DM / 2, S, E);
#else
            pg8::SchedRect S{(const char*)(ws + WS_Y), (const char*)((bf16_t*)(ws + WS_WOUT) + (size_t)l * DM * DM), (size_t)256 * DM * 2, mt_act, 4, G, c, 0, 0, 1};
            #if XRES_BF16
            pg8::EpiOut E{(l == 0) ? in_ptr<I_X>() : (const float*)nullptr, outp, in_ptr<I_CTX>(), (float*)(ws + WS_XB), (const float*)(ws + WS_MOD) + (size_t)l * 17 * NMODC, 2 * DM, 1.0f};
#else
            pg8::EpiOut E{(l == 0) ? in_ptr<I_X>() : (const float*)outp, outp, in_ptr<I_CTX>(), (float*)(ws + WS_XC), (const float*)(ws + WS_MOD) + (size_t)l * 17 * NMODC, 2 * DM, 1.0f};
#endif
            pg8::gemm_phase(Fp.lds, DM, S, E);
#endif
        }
        SEAM(base + 5);
        if (IN(base + 6)) REPL(6) { FRESH(); (void)G; (void)c; route_phase(Fp, l, ntok, ((PH_DUP >> 8) & 1u) && rep_ == 0); }
        SEAM(base + 6);
        if (IN(base + 7)) REPL(7) { FRESH(); (void)G; (void)c; scatter_phase(Fp, l, ntok, F8LAYER(l)); }
        SEAM(base + 7);
        if (IN(base + 8)) REPL(8) {
            FRESH(); unsigned char* const ws = ws_ptr();
            LAS int* const tle = (LAS int*)(Fp.lds + EPI_OFF + 16384); tle[Fp.tid] = ld_i32_agent((const int*)(ws + WS_TILEE) + Fp.tid); __syncthreads();
            const int ntile = __builtin_amdgcn_readfirstlane(tle[511]);
            const char* const w13 = (const char*)((bf16_t*)(ws + WS_W13) + (size_t)l * NEXP * 2048 * DM);
#ifdef ONLY_BF16
            if (false) {} else
#endif
#ifdef ONLY_F8
            if (true)
#else
            if (F8LAYER(l))
#endif
            { pg8::SchedMoe S{(const char*)(ws + WS_HS), w13, (size_t)256 * DM, (size_t)2048 * DM, (size_t)256 * DM, tle, ntile, 8, G, c};
                pg8::EpiMoe1<true> E{(bf16_t*)(ws + WS_HMID), 1.0f / (F8_SH * F8_SW)};
                pg8::gemm_phase<true>(Fp.lds, DM / 2, S, E); }
            else { pg8::SchedMoe S{(const char*)(ws + WS_HS), w13, (size_t)256 * DM * 2, (size_t)2048 * DM * 2, (size_t)256 * DM * 2, tle, ntile, 8, G, c};
                pg8::EpiMoe1<false> E{(bf16_t*)(ws + WS_HMID), 1.0f};
                pg8::gemm_phase(Fp.lds, DM, S, E); }
        }
        SEAM(base + 8);
        if (IN(base + 9)) REPL(9) {
            FRESH(); unsigned char* const ws = ws_ptr();
            LAS int* const tle = (LAS int*)(Fp.lds + EPI_OFF + 16384); tle[Fp.tid] = ld_i32_agent((const int*)(ws + WS_TILEE) + Fp.tid); __syncthreads();
            const int ntile = __builtin_amdgcn_readfirstlane(tle[511]);
            const char* const w2 = (const char*)((bf16_t*)(ws + WS_W2) + (size_t)l * NEXP * DM * DM);
            if (F8LAYER(l)) { pg8::SchedMoe S{(const char*)(ws + WS_HMID), w2, (size_t)256 * DM, (size_t)DM * DM, (size_t)256 * DM, tle, ntile, 4, G, c};
                pg8::EpiMoe2 E{(bf16_t*)(ws + WS_YS), 1.0f / (F8_SM * F8_SW)};
                pg8::gemm_phase<true>(Fp.lds, DM / 2, S, E); }
            else { pg8::SchedMoe S{(const char*)(ws + WS_HMID), w2, (size_t)256 * DM * 2, (size_t)DM * DM * 2, (size_t)256 * DM * 2, tle, ntile, 4, G, c};
                pg8::EpiMoe2 E{(bf16_t*)(ws + WS_YS), 1.0f};
                pg8::gemm_phase(Fp.lds, DM, S, E); }
        }
        SEAM(base + 9);
        if (IN(base + 10)) REPL(10) { FRESH(); (void)G; (void)c; combine_phase(Fp, l, ntok, last); }
        if (!last) SEAM(base + 10);
    }
#undef IN
#undef SEAM
#undef GRID_BAR
}

extern "C" void kernel_launch(void* const* d_in, const int* in_sizes, int n_in, void* d_out, int out_size, void* d_ws, size_t ws_size, hipStream_t stream) {
    static int grid = 0;
    if (grid == 0) {
        if (n_in != 26 || out_size != TX * DM || ws_size < WS_END) { fprintf(stderr, "kernel_launch: unexpected problem (n_in %d, out %d, ws %zu < %zu); nothing launched\n", n_in, out_size, ws_size, (size_t)WS_END); grid = -1; return; }
        int dev = 0, cus = 0, per_cu = 0;
        if (hipGetDevice(&dev) != hipSuccess || hipDeviceGetAttribute(&cus, hipDeviceAttributeMultiprocessorCount, dev) != hipSuccess) { grid = -1; return; }
        if (hipFuncSetAttribute((const void*)fwd_kernel, hipFuncAttributeMaxDynamicSharedMemorySize, LDS_BYTES) != hipSuccess) { fprintf(stderr, "kernel_launch: hipFuncSetAttribute failed\n"); grid = -1; return; }
        if (hipOccupancyMaxActiveBlocksPerMultiprocessor(&per_cu, (const void*)fwd_kernel, 512, LDS_BYTES) != hipSuccess || per_cu < 1) fprintf(stderr, "kernel_launch: occupancy query reports %d blocks per CU\n", per_cu);
        (void)hipGetLastError();
        grid = cus;
    }
    if (grid < 0) return;
    (void)in_sizes;
    (void)hipMemsetAsync((char*)d_ws + WS_CTL, 0, CTL_BYTES, stream);
    Args a{};
    for (int i = 0; i < 26; ++i) a.in[i] = (const float*)d_in[i];
    a.out = (float*)d_out; a.ws = (unsigned char*)d_ws;
#if MK_SPLIT
    for (int p = 0; p < NPHASE; ++p) { a.ph_lo = p; a.ph_hi = p + 1; hipLaunchKernelGGL(fwd_kernel, dim3(grid), dim3(512), LDS_BYTES, stream, a); }
#else
    a.ph_lo = 0; a.ph_hi = NPHASE;
    hipLaunchKernelGGL(fwd_kernel, dim3(grid), dim3(512), LDS_BYTES, stream, a);
#endif
    const hipError_t le = hipPeekAtLastError();
    if (le != hipSuccess) fprintf(stderr, "kernel_launch: launch failed: %s\n", hipGetErrorName(le));
}
```
